# Optimizing an MI355X kernel written in HIP

```python
import jax, jax.numpy as jnp
from jax import lax
import numpy as np

D_MODEL = 1024
BATCH = 8
SEQ = 4096
DEPTH = 1

N_HEADS = 8
HEAD_DIM = 64
ATTN_WIDTH = N_HEADS * HEAD_DIM
KV_RANK = 128
IDX_HEADS = 8
IDX_DIM = 64
TOPK_MAX = 256
Q_BLOCK = 128
CHUNK = 128
GMLP_GROUPS = 4
GMLP_GROUP_DIM = 128
GMLP_WIDTH = GMLP_GROUPS * GMLP_GROUP_DIM
NUM_BUCKETS = 32
MAX_DISTANCE = 128
N_GROUPS = 4
EXPERTS_PER_GROUP = 8
N_EXPERTS = N_GROUPS * EXPERTS_PER_GROUP
TOP_K_INNER = 2
D_FF_EXPERT = 256
EPS = 1e-6
IN_SIZES = (ATTN_WIDTH, KV_RANK, IDX_HEADS * IDX_DIM, IDX_DIM, IDX_HEADS, GMLP_WIDTH, GMLP_WIDTH, D_MODEL, D_MODEL)
IN_COLS = ATTN_WIDTH + KV_RANK + IDX_HEADS * IDX_DIM + IDX_DIM + IDX_HEADS + 2 * GMLP_WIDTH + 2 * D_MODEL

kernel_name = "hybrid_dsa_gmlp_hmoe"


def rms_norm(x, g):
    xf = x.astype(jnp.float32)
    y = xf * lax.rsqrt(jnp.mean(xf * xf, axis=-1, keepdims=True) + EPS)
    return y.astype(x.dtype) * g


def layer_norm(x, g, b):
    xf = x.astype(jnp.float32)
    mu = jnp.mean(xf, axis=-1, keepdims=True)
    var = jnp.mean(jnp.square(xf - mu), axis=-1, keepdims=True)
    return ((xf - mu) * lax.rsqrt(var + EPS)).astype(x.dtype) * g + b


def t5_bucket(n):
    max_exact = NUM_BUCKETS // 2
    nf = jnp.maximum(n, 1).astype(jnp.float32)
    large = max_exact + (jnp.log(nf / max_exact) / np.float32(np.log(MAX_DISTANCE / max_exact)) * (NUM_BUCKETS - max_exact)).astype(jnp.int32)
    large = jnp.minimum(large, NUM_BUCKETS - 1)
    return jnp.where(n < max_exact, n, large)


def sparse_attention(q_lat, q_idx, w_idx, c_kv, k_idx, rel_bias):
    B, T = c_kv.shape[:2]
    nb = T // Q_BLOCK
    topk = min(TOPK_MAX, T // 4)
    scale = HEAD_DIM ** -0.5
    s_pos = jnp.arange(T, dtype=jnp.int32)

    def to_blocks(a):
        return jnp.moveaxis(a.reshape((B, nb, Q_BLOCK) + a.shape[2:]), 1, 0)

    def block(args):
        blk, ql, qi, wi = args
        t_pos = blk * Q_BLOCK + jnp.arange(Q_BLOCK, dtype=jnp.int32)
        rel = jax.nn.relu(jnp.einsum('bqhd,bsd->bqhs', qi, k_idx))
        index = jnp.einsum('bqhs,bqh->bqs', rel, wi)
        causal = s_pos[None, :] <= t_pos[:, None]
        index = jnp.where(causal[None], index, -jnp.inf)
        _, sel = lax.top_k(index, topk)
        c_sel = jax.vmap(lambda c, i: c[i])(c_kv, sel)
        dist = t_pos[None, :, None] - sel
        valid = dist >= 0
        bias = rel_bias[t5_bucket(jnp.maximum(dist, 0))]
        scores = jnp.einsum('bqhr,bqkr->bqhk', ql, c_sel).astype(jnp.float32) * scale
        scores = scores + jnp.transpose(bias, (0, 1, 3, 2)).astype(jnp.float32)
        scores = jnp.where(valid[:, :, None, :], scores, -jnp.inf)
        p = jax.nn.softmax(scores, axis=-1).astype(c_sel.dtype)
        return jnp.einsum('bqhk,bqkr->bqhr', p, c_sel)

    out = lax.map(block, (jnp.arange(nb, dtype=jnp.int32), to_blocks(q_lat), to_blocks(q_idx), to_blocks(w_idx)))
    return jnp.moveaxis(out, 0, 1).reshape(B, T, N_HEADS, KV_RANK)


def chunked_gmlp(u, v, ln_g, ln_b, w_s, b_s):
    B, T = u.shape[:2]
    u = jax.nn.gelu(u)
    v = layer_norm(jax.nn.gelu(v), ln_g, ln_b)
    vc = v.reshape(B, T // CHUNK, CHUNK, GMLP_GROUPS, GMLP_GROUP_DIM)
    mask = jnp.tril(jnp.ones((CHUNK, CHUNK), dtype=bool))
    ws = jnp.where(mask[None], w_s, 0.0)
    s = jnp.einsum('gij,bcjge->bcige', ws, vc) + jnp.transpose(b_s)[None, None, :, :, None]
    return u * s.reshape(B, T, GMLP_WIDTH)


def hier_moe(h, rg_w, rg_b, re_w, re_b, w_gate, w_up, w_down):
    N = h.shape[0]
    gp = jax.nn.softmax((h @ rg_w + rg_b).astype(jnp.float32), axis=-1)
    g_w, g_idx = lax.top_k(gp, 1)
    el = (h @ re_w + re_b).reshape(N, N_GROUPS, EXPERTS_PER_GROUP)
    el = jnp.take_along_axis(el, g_idx[:, :, None], axis=1)[:, 0]
    ep = jax.nn.softmax(el.astype(jnp.float32), axis=-1)
    e_w, e_idx = lax.top_k(ep, TOP_K_INNER)
    e_w = g_w * e_w / jnp.sum(e_w, axis=-1, keepdims=True)
    eid = g_idx * EXPERTS_PER_GROUP + e_idx
    comb = jnp.sum(jax.nn.one_hot(eid, N_EXPERTS, dtype=jnp.float32) * e_w[..., None], axis=1).astype(h.dtype)
    y = jnp.zeros_like(h)
    for e in range(N_EXPERTS):
        he = jax.nn.silu(h @ w_gate[e]) * (h @ w_up[e])
        y = y + comb[:, e:e + 1] * (he @ w_down[e])
    return y


def setup_inputs(seed: int = 0) -> dict:
    key = jax.random.key(seed)
    ks = jax.random.split(key, 24)

    def nrm(k, shape, s):
        return jax.random.normal(k, shape, jnp.float32) * s

    return {
        "x": nrm(ks[0], (BATCH, SEQ, D_MODEL), 1.0),
        "w_in": nrm(ks[1], (DEPTH, D_MODEL, IN_COLS), D_MODEL ** -0.5),
        "kv_norm_g": 1.0 + nrm(ks[2], (DEPTH, KV_RANK), 0.01),
        "w_uk": nrm(ks[3], (DEPTH, KV_RANK, N_HEADS, HEAD_DIM), KV_RANK ** -0.5),
        "w_uv": nrm(ks[4], (DEPTH, KV_RANK, N_HEADS, HEAD_DIM), KV_RANK ** -0.5),
        "rel_bias": nrm(ks[5], (NUM_BUCKETS, N_HEADS), 0.5),
        "ln_v_g": 1.0 + nrm(ks[6], (DEPTH, GMLP_WIDTH), 0.01),
        "ln_v_b": nrm(ks[7], (DEPTH, GMLP_WIDTH), 0.01),
        "w_spatial": nrm(ks[8], (DEPTH, GMLP_GROUPS, CHUNK, CHUNK), CHUNK ** -0.5),
        "b_spatial": 1.0 + nrm(ks[9], (DEPTH, GMLP_GROUPS, CHUNK), 0.01),
        "w_proj_a": nrm(ks[10], (DEPTH, ATTN_WIDTH, D_MODEL), ATTN_WIDTH ** -0.5),
        "w_proj_b": nrm(ks[11], (DEPTH, GMLP_WIDTH, D_MODEL), GMLP_WIDTH ** -0.5),
        "w_out": nrm(ks[12], (DEPTH, D_MODEL, D_MODEL), D_MODEL ** -0.5),
        "norm1_g": 1.0 + nrm(ks[13], (DEPTH, D_MODEL), 0.01),
        "norm2_g": 1.0 + nrm(ks[14], (DEPTH, D_MODEL), 0.01),
        "router_group_w": nrm(ks[15], (DEPTH, D_MODEL, N_GROUPS), D_MODEL ** -0.5),
        "router_group_b": nrm(ks[16], (DEPTH, N_GROUPS), 0.01),
        "router_expert_w": nrm(ks[17], (DEPTH, D_MODEL, N_EXPERTS), D_MODEL ** -0.5),
        "router_expert_b": nrm(ks[18], (DEPTH, N_EXPERTS), 0.01),
        "w_gate": nrm(ks[19], (DEPTH, N_EXPERTS, D_MODEL, D_FF_EXPERT), D_MODEL ** -0.5),
        "w_up": nrm(ks[20], (DEPTH, N_EXPERTS, D_MODEL, D_FF_EXPERT), D_MODEL ** -0.5),
        "w_down": nrm(ks[21], (DEPTH, N_EXPERTS, D_FF_EXPERT, D_MODEL), D_FF_EXPERT ** -0.5),
        "final_norm_g": 1.0 + nrm(ks[22], (D_MODEL,), 0.01),
    }


def reference(x, w_in, kv_norm_g, w_uk, w_uv, rel_bias, ln_v_g, ln_v_b, w_spatial, b_spatial, w_proj_a, w_proj_b, w_out, norm1_g, norm2_g, router_group_w, router_group_b, router_expert_w, router_expert_b, w_gate, w_up, w_down, final_norm_g):
    B, T, D = x.shape
    splits = [int(c) for c in np.cumsum(IN_SIZES)[:-1]]
    idx_scale = (IDX_HEADS ** -0.5) * (IDX_DIM ** -0.5)
    for l in range(DEPTH):
        h = rms_norm(x, norm1_g[l])
        proj = h @ w_in[l]
        q, ckv, qi, ki, wi, u, v, ga, gb = jnp.split(proj, splits, axis=-1)
        q = q.reshape(B, T, N_HEADS, HEAD_DIM)
        c_kv = rms_norm(ckv, kv_norm_g[l])
        q_lat = jnp.einsum('bthd,rhd->bthr', q, w_uk[l])
        q_idx = qi.reshape(B, T, IDX_HEADS, IDX_DIM)
        w_idx = wi * idx_scale
        o_lat = sparse_attention(q_lat, q_idx, w_idx, c_kv, ki, rel_bias)
        o_a = jnp.einsum('bthr,rhd->bthd', o_lat, w_uv[l]).reshape(B, T, ATTN_WIDTH)
        y_a = o_a @ w_proj_a[l]
        y_b = chunked_gmlp(u, v, ln_v_g[l], ln_v_b[l], w_spatial[l], b_spatial[l]) @ w_proj_b[l]
        merged = jax.nn.sigmoid(ga) * y_a + jax.nn.sigmoid(gb) * y_b
        x = x + merged @ w_out[l]
        h2 = rms_norm(x, norm2_g[l]).reshape(B * T, D)
        y = hier_moe(h2, router_group_w[l], router_group_b[l], router_expert_w[l], router_expert_b[l], w_gate[l], w_up[l], w_down[l])
        x = x + y.reshape(B, T, D)
    return rms_norm(x, final_norm_g)
```

```cpp
#include <hip/hip_runtime.h>
#include <cstdio>
#include <cstdint>
__device__ __forceinline__ int opaque_tid(const int wv) { int l; asm volatile("v_mbcnt_lo_u32_b32 %0, -1, 0\n\tv_mbcnt_hi_u32_b32 %0, -1, %0" : "=v"(l)); return (wv << 6) + l; }
#define LAS __attribute__((address_space(3)))
namespace pg8 {
#define PG8_LAS __attribute__((address_space(3)))
typedef unsigned short bf16_t;
typedef short bf16x8 __attribute__((ext_vector_type(8)));
typedef float f32x4 __attribute__((ext_vector_type(4)));
typedef unsigned u32x4 __attribute__((ext_vector_type(4)));
constexpr int BM = 256, BK = 64, HALF = 128, HTB = HALF * BK * 2  , STAGE_BYTES = 8 * HTB, NXCD = 8, WGM = 8;

__host__ __device__ __forceinline__ int lds_byte(int r, int c) { const int st = (r >> 4) * 2 + (c >> 5), rr = r & 15, cc = c & 31, ob = rr * 64 + cc * 2; return st * 1024 + (ob ^ (((ob >> 9) & 1) << 5)); }
__host__ __device__ __forceinline__ void stage_rc(int b, int& R, int& C) { const int st = b / 1024, sb = b % 1024, swz = sb ^ (((sb >> 9) & 1) << 5); R = (st >> 1) * 16 + swz / 64; C = (st & 1) * 32 + (swz % 64) / 2; }
__host__ __device__ __forceinline__ int perm32(int rho) { const int n = rho >> 4, i = rho & 15; return 8 * (i >> 2) + 4 * n + (i & 3); }

struct Unit { int pm, pn; };
struct Gemm { const bf16_t* A; const bf16_t* Bt; int M, N, K; };

struct StaticOrder {
    int nM, nN, nwg, G, c;
    __host__ __device__ void init(int M, int N, int G_, int c_) { nM = M / BM; nN = N / BM; nwg = nM * nN; G = G_; c = c_; }
    __host__ __device__ bool next(int i, Unit& u) const {
        const long L = (long)i * G + c; if (L >= nwg) return false;
        int wgid = (int)L; { const int q = nwg / NXCD, r = nwg % NXCD, xcd = wgid % NXCD, off = wgid / NXCD; wgid = (xcd < r ? xcd * (q + 1) : r * (q + 1) + (xcd - r) * q) + off; }
        const int nig = WGM * nN, gid = wgid / nig, fm = gid * WGM, gsz = (nM - fm) < WGM ? (nM - fm) : WGM;
        u.pm = fm + ((wgid % nig) % gsz); u.pn = (wgid % nig) / gsz; return true;
    }
    __device__ __forceinline__ void a_ready(const Unit&) const {}
    __device__ __forceinline__ void done(const Unit&) const {}
};

__device__ __forceinline__ unsigned cvt_pk_bf16(float lo, float hi) { unsigned r; asm volatile("v_cvt_pk_bf16_f32 %0, %1, %2" : "=v"(r) : "v"(lo), "v"(hi)); return r; }
typedef float f32x2 __attribute__((ext_vector_type(2)));
template <class Epi, class Sched, bool ALIGN_EPI = false, bool SP2 = false>
__device__ __forceinline__ void gemm_phase(PG8_LAS unsigned char* lds, const Gemm g, const Sched& S, const Epi& E, const int wv) {
    const int tid = opaque_tid(wv), wid = __builtin_amdgcn_readfirstlane(tid >> 6), lane = tid & 63, wr = wid >> 2, wc = wid & 3, fr = lane & 15, fq = lane >> 4;
    const int K = g.K, nt = K / BK;
    unsigned voffA[2], voffB[2];
#pragma unroll
    for (int i = 0; i < 2; ++i) { int R, C; stage_rc(tid * 16 + i * 8192, R, C); const int Rb = Epi::PERM ? ((R & ~31) + perm32(R & 31)) : R;
        voffA[i] = (unsigned)(R * K + C) * 2u; voffB[i] = (unsigned)(Rb * K + C) * 2u; }
    const size_t kstep = (size_t)(BK * 2);
    const size_t hstep = (size_t)HALF * K * 2;
    const size_t tstep = 2 * hstep;
    const unsigned ldsw = (unsigned)wid * 1024u;
    const int aoff = lds_byte(wr * 64 + fr, fq * 8), boff = lds_byte(wc * 32 + fr, fq * 8);
#define PG8_SA(b, h) (((b) * 2 + (h)) * HTB)
#define PG8_SB(b, h) ((4 + (b) * 2 + (h)) * HTB)
#define PG8_STAGE(bufoff, gbase, voff) do { _Pragma("unroll") for (int _i = 0; _i < 2; ++_i) \
        __builtin_amdgcn_global_load_lds((const unsigned*)((const char*)(gbase) + (voff)[_i]), (PG8_LAS unsigned*)(lds + (bufoff) + ldsw + _i * 8192), 16, 0, 0); } while (0)
#define PG8_LDA(dst, b, h) do { _Pragma("unroll") for (int m = 0; m < 4; ++m) _Pragma("unroll") for (int k = 0; k < 2; ++k) dst[m][k] = *(const PG8_LAS bf16x8*)(lds + PG8_SA(b, h) + aoff + m * 2048 + k * 1024); } while (0)
#define PG8_LDB(dst, b, h) do { _Pragma("unroll") for (int n = 0; n < 2; ++n) _Pragma("unroll") for (int k = 0; k < 2; ++k) dst[n][k] = *(const PG8_LAS bf16x8*)(lds + PG8_SB(b, h) + boff + n * 2048 + k * 1024); } while (0)
#define PG8_MMA(ai, bj, At, Bt) do { __builtin_amdgcn_s_setprio(1); _Pragma("unroll") for (int m = 0; m < 4; ++m) _Pragma("unroll") for (int n = 0; n < 2; ++n) _Pragma("unroll") for (int k = 0; k < 2; ++k) \
        acc[ai][bj][m][n] = __builtin_amdgcn_mfma_f32_16x16x32_bf16(Bt[n][k], At[m][k], acc[ai][bj][m][n], 0, 0, 0); __builtin_amdgcn_s_setprio(0); } while (0)
#define PG8_WAIT_V(n) asm volatile("s_waitcnt vmcnt(" #n ")" ::: "memory")
#define PG8_WAIT_L(n) asm volatile("s_waitcnt lgkmcnt(" #n ")" ::: "memory")
#define PG8_BAR __builtin_amdgcn_s_barrier()
#define PG8_SCHED __builtin_amdgcn_sched_barrier(0)
    Unit cur, nxt; int ui = 0;
    if (!S.next(0, cur)) return;
    f32x4 acc[2][2][4][2];
#pragma unroll
    for (int a = 0; a < 2; ++a)
#pragma unroll
        for (int b = 0; b < 2; ++b)
#pragma unroll
            for (int m = 0; m < 4; ++m)
#pragma unroll
                for (int n = 0; n < 2; ++n) acc[a][b][m][n] = (f32x4){0.f, 0.f, 0.f, 0.f};
    bf16x8 At[4][2], B0[2][2], B1[2][2];
    const char* cA = (const char*)g.A + (size_t)cur.pm * tstep; const char* cB = (const char*)g.Bt + (size_t)cur.pn * tstep;
    S.a_ready(cur);
    if constexpr (SP2) {
        PG8_STAGE(PG8_SB(0, 0), cB, voffB); PG8_STAGE(PG8_SB(0, 1), cB + hstep, voffB); PG8_STAGE(PG8_SA(0, 0), cA, voffA); PG8_STAGE(PG8_SA(0, 1), cA + hstep, voffA);
        if (wr == 1) PG8_BAR;
        PG8_WAIT_V(2); PG8_BAR;
        PG8_STAGE(PG8_SB(1, 0), cB + kstep, voffB); PG8_STAGE(PG8_SA(1, 0), cA + kstep, voffA); PG8_STAGE(PG8_SB(1, 1), cB + hstep + kstep, voffB);
        PG8_WAIT_V(6); PG8_BAR;
    } else {
        PG8_STAGE(PG8_SB(0, 0), cB, voffB); PG8_STAGE(PG8_SA(0, 0), cA, voffA); PG8_STAGE(PG8_SB(0, 1), cB + hstep, voffB); PG8_STAGE(PG8_SA(0, 1), cA + hstep, voffA);
        if (wr == 1) PG8_BAR;
        PG8_WAIT_V(4); PG8_BAR;
        PG8_STAGE(PG8_SB(1, 0), cB + kstep, voffB); PG8_STAGE(PG8_SA(1, 0), cA + kstep, voffA); PG8_STAGE(PG8_SB(1, 1), cB + hstep + kstep, voffB);
        PG8_WAIT_V(6); PG8_BAR;
    }
    for (;;) {
        const bool has_next = S.next(ui + 1, nxt);
        const char* nA = has_next ? (const char*)g.A + (size_t)nxt.pm * tstep : cA; const char* nB = has_next ? (const char*)g.Bt + (size_t)nxt.pn * tstep : cB;
        for (int t = 0; t < nt; t += 2) {
            const bool last = (t == nt - 2);
            const char* a1 = cA + (size_t)(t + 1) * kstep;
            const char* a2 = last ? nA : cA + (size_t)(t + 2) * kstep; const char* b2 = last ? nB : cB + (size_t)(t + 2) * kstep;
            const char* a3 = a2 + kstep; const char* b3 = b2 + kstep;
            if (last && has_next) S.a_ready(nxt);
            if constexpr (SP2) {
            PG8_LDB(B0, 0, 0); PG8_LDB(B1, 0, 1); PG8_SCHED; PG8_LDA(At, 0, 0); PG8_STAGE(PG8_SA(1, 1), a1 + hstep, voffA);
            PG8_WAIT_V(8); PG8_WAIT_L(0); PG8_BAR; PG8_MMA(0, 0, At, B0); PG8_MMA(0, 1, At, B1); PG8_BAR; PG8_SCHED;
            PG8_LDA(At, 0, 1); PG8_STAGE(PG8_SB(0, 0), b2, voffB); PG8_STAGE(PG8_SB(0, 1), b2 + hstep, voffB); PG8_STAGE(PG8_SA(0, 0), a2, voffA);
            PG8_WAIT_V(8); PG8_WAIT_L(0); PG8_BAR; PG8_MMA(1, 0, At, B0); PG8_MMA(1, 1, At, B1); PG8_BAR; PG8_SCHED;
            PG8_LDB(B0, 1, 0); PG8_LDB(B1, 1, 1); PG8_SCHED; PG8_LDA(At, 1, 0); PG8_STAGE(PG8_SA(0, 1), a2 + hstep, voffA);
            PG8_WAIT_V(8); PG8_WAIT_L(0); PG8_BAR; PG8_MMA(0, 0, At, B0); PG8_MMA(0, 1, At, B1); PG8_BAR; PG8_SCHED;
            PG8_LDA(At, 1, 1); PG8_STAGE(PG8_SB(1, 0), b3, voffB); PG8_STAGE(PG8_SB(1, 1), b3 + hstep, voffB); PG8_STAGE(PG8_SA(1, 0), a3, voffA);
            PG8_WAIT_V(8); PG8_WAIT_L(0); PG8_BAR; PG8_MMA(1, 0, At, B0); PG8_MMA(1, 1, At, B1); PG8_BAR; PG8_SCHED;
            } else {
            PG8_LDB(B0, 0, 0); PG8_SCHED; PG8_LDA(At, 0, 0); PG8_STAGE(PG8_SA(1, 1), a1 + hstep, voffA);
            PG8_WAIT_L(8); PG8_BAR; PG8_WAIT_L(0); PG8_MMA(0, 0, At, B0); PG8_BAR; PG8_SCHED;
            PG8_LDB(B1, 0, 1); PG8_STAGE(PG8_SB(0, 0), b2, voffB);
            PG8_BAR; PG8_WAIT_L(0); PG8_MMA(0, 1, At, B1); PG8_BAR;
            PG8_LDA(At, 0, 1); PG8_STAGE(PG8_SA(0, 0), a2, voffA);
            PG8_BAR; PG8_WAIT_L(0); PG8_MMA(1, 0, At, B0); PG8_BAR; PG8_SCHED;
            PG8_STAGE(PG8_SB(0, 1), b2 + hstep, voffB);
            PG8_WAIT_V(6); PG8_BAR; PG8_MMA(1, 1, At, B1); PG8_BAR;
            PG8_LDB(B0, 1, 0); PG8_SCHED; PG8_LDA(At, 1, 0); PG8_STAGE(PG8_SA(0, 1), a2 + hstep, voffA);
            PG8_WAIT_L(8); PG8_BAR; PG8_WAIT_L(0); PG8_MMA(0, 0, At, B0); PG8_BAR; PG8_SCHED;
            PG8_LDB(B1, 1, 1); PG8_STAGE(PG8_SB(1, 0), b3, voffB);
            PG8_BAR; PG8_WAIT_L(0); PG8_MMA(0, 1, At, B1); PG8_BAR;
            PG8_LDA(At, 1, 1); PG8_STAGE(PG8_SA(1, 0), a3, voffA);
            PG8_BAR; PG8_WAIT_L(0); PG8_MMA(1, 0, At, B0); PG8_BAR; PG8_SCHED;
            PG8_STAGE(PG8_SB(1, 1), b3 + hstep, voffB);
            PG8_WAIT_V(6); PG8_BAR; PG8_MMA(1, 1, At, B1); PG8_BAR;
            }
        }
        if constexpr (ALIGN_EPI) { if (wr == 0) PG8_BAR; }
        if constexpr (!Epi::AFTER_DRAIN) { E(acc, cur, wr, wc, fr, fq); S.done(cur); }
        if (!has_next) break;
#pragma unroll
        for (int a = 0; a < 2; ++a)
#pragma unroll
            for (int b = 0; b < 2; ++b)
#pragma unroll
                for (int m = 0; m < 4; ++m)
#pragma unroll
                    for (int n = 0; n < 2; ++n) acc[a][b][m][n] = (f32x4){0.f, 0.f, 0.f, 0.f};
        cur = nxt; cA = nA; cB = nB; ++ui;
        if constexpr (ALIGN_EPI) { if (wr == 1) PG8_BAR; }
    }
    PG8_WAIT_V(0);
    if constexpr (!ALIGN_EPI) { if (wr == 0) PG8_BAR; }
    PG8_BAR;
    if constexpr (Epi::AFTER_DRAIN) { E.fused(acc, cur, wr, wc, fr, fq, lds, wid, lane); S.done(cur); }
#undef PG8_SA
#undef PG8_SB
#undef PG8_STAGE
#undef PG8_LDA
#undef PG8_LDB
#undef PG8_MMA
#undef PG8_WAIT_V
#undef PG8_WAIT_L
#undef PG8_BAR
#undef PG8_SCHED
}
}
#define XB_TMO      128
#define XB_XCNT(j)  (256  + 64 * (j))
#define XB_XSUB(j)  (1280 + 64 * (j))
#define XB_XGEN(j)  (2304 + 64 * (j))
#define XB_TOP      3328
#define XB_TOPGEN   3392
#define XCD_BAR_WORDS 3456
#define XB_SPIN_CAP (1u << 18)

__device__ __forceinline__ unsigned xb_ld(unsigned* p)              { return __hip_atomic_load(p, __ATOMIC_RELAXED, __HIP_MEMORY_SCOPE_AGENT); }
__device__ __forceinline__ unsigned xb_add(unsigned* p, unsigned v) { return __hip_atomic_fetch_add(p, v, __ATOMIC_RELAXED, __HIP_MEMORY_SCOPE_AGENT); }
__device__ __forceinline__ unsigned xb_xcc_id() { return (unsigned)__builtin_amdgcn_s_getreg((3 << 11) | 20) & 0xFu; }
#define XB_SPIN(cond, bar) do { unsigned _sp = 0; while (cond) { __builtin_amdgcn_s_sleep(1); \
    if ((++_sp & 255u) == 0u) { if (xb_ld(&(bar)[XB_TMO])) break; if (_sp > XB_SPIN_CAP) { atomicAdd(&(bar)[XB_TMO], 1u); break; } } } } while (0)

struct XcdBarrier {
    unsigned* bar; unsigned x; int wv;
    volatile LAS unsigned* st;
};

__device__ __forceinline__ XcdBarrier xcd_barrier_post(unsigned* bar, volatile LAS unsigned* st, int wv) {
    XcdBarrier b; b.bar = bar; b.x = xb_xcc_id(); b.st = st; b.wv = wv;
    if (opaque_tid(wv) == 0) (void)xb_add(&bar[XB_XCNT(b.x)], 1u);
    return b;
}
__device__ __forceinline__ void xcd_barrier_complete(unsigned* bar, unsigned x, unsigned& nloc, unsigned& nx) {
    const unsigned G = gridDim.x * gridDim.y * gridDim.z;
    unsigned sum, cnt, mine, sp = 0u;
    for (;;) {
        sum = 0u; cnt = 0u; mine = 0u;
#pragma unroll
        for (unsigned j = 0; j < 16; ++j) { const unsigned c = xb_ld(&bar[XB_XCNT(j)]); sum += c; cnt += (c > 0u) ? 1u : 0u; mine = (j == x) ? c : mine; }
        if (sum == G) break;
        __builtin_amdgcn_s_sleep(1);
        if ((++sp & 255u) == 0u) { if (xb_ld(&bar[XB_TMO])) break; if (sp > XB_SPIN_CAP) { atomicAdd(&bar[XB_TMO], 1u); break; } }
    }
    nloc = mine > 0u ? mine : 1u; nx = cnt > 0u ? cnt : 1u;
}

__device__ __forceinline__ void xcd_barrier(const XcdBarrier& b) {
    asm volatile("s_waitcnt vmcnt(0)" ::: "memory");
    __syncthreads();
    if (opaque_tid(b.wv) == 0) {
        unsigned* bar = b.bar;
        __builtin_amdgcn_s_waitcnt(0);
        unsigned nloc = b.st[0], nx = b.st[1];
        if (nloc == 0u) { xcd_barrier_complete(bar, b.x, nloc, nx); b.st[0] = nloc; b.st[1] = nx; }
        const unsigned old = xb_add(&bar[XB_XSUB(b.x)], 1u);
        const unsigned gen = old / nloc;
        if (old + 1u == (gen + 1u) * nloc) {
            __builtin_amdgcn_fence(__ATOMIC_RELEASE, "agent");
            asm volatile("s_waitcnt vmcnt(0)" ::: "memory");
            const unsigned og = xb_add(&bar[XB_TOP], 1u);
            const unsigned tg = og / nx;
            if (og + 1u == (tg + 1u) * nx) xb_add(&bar[XB_TOPGEN], 1u);
            else XB_SPIN(xb_ld(&bar[XB_TOPGEN]) == tg, bar);
            __builtin_amdgcn_fence(__ATOMIC_ACQUIRE, "agent");
            xb_add(&bar[XB_XGEN(b.x)], 1u);
            asm volatile("s_waitcnt vmcnt(0)" ::: "memory");
        } else {
            XB_SPIN(xb_ld(&bar[XB_XGEN(b.x)]) == gen, bar);
            __builtin_amdgcn_fence(__ATOMIC_ACQUIRE, "agent");
            asm volatile("s_waitcnt vmcnt(0)" ::: "memory");
        }
    }
    __syncthreads();
}

typedef unsigned short bf16_t;
typedef short bf16x8 __attribute__((ext_vector_type(8)));
typedef short bf16x4 __attribute__((ext_vector_type(4)));
typedef float f32x4 __attribute__((ext_vector_type(4)));
typedef float f32x16 __attribute__((ext_vector_type(16)));
typedef unsigned u32x4 __attribute__((ext_vector_type(4)));
typedef unsigned u32x2 __attribute__((ext_vector_type(2)));

constexpr int NB = 8, T = 4096, D = 1024, M = NB * T;
constexpr int INC = 4296;
constexpr int NIN = 19 * 256;
constexpr float EPS = 1e-6f;
constexpr int NPOS = 73728;
constexpr int NWAVES = 8, NTHR = 512;
constexpr int LDS_BYTES = 147456;

constexpr size_t MiB = 1u << 20;
constexpr size_t WS_CTL = 0, CTL_ZERO_BYTES = 65536;
constexpr size_t WS_WIN = 1 * MiB, WS_WOUT = 11 * MiB, WS_WPB = 13 * MiB, WS_WOV = 14 * MiB, WS_WSB = 16 * MiB, WS_WRT = 16 * MiB + 262144, WS_WGU = 17 * MiB, WS_WD = 49 * MiB;
constexpr size_t WS_A = 65 * MiB;
constexpr size_t WS_B = 129 * MiB;
constexpr size_t WS_GA = 193 * MiB, WS_GB = 257 * MiB;
constexpr size_t WS_C = 321 * MiB;
constexpr size_t WS_DQ = 385 * MiB;
constexpr size_t WS_CKVR = 417 * MiB, WS_CKVB = 433 * MiB, WS_KI = 441 * MiB, WS_WI = 445 * MiB, WS_SEL = 446 * MiB;
constexpr size_t WS_MOE = 462 * MiB;
constexpr size_t WS_END = 464 * MiB;

constexpr int CW_BAR = 4096;
constexpr int CW_CNT = 8192, CW_CUR = 8256;

struct P {
    const float *x, *w_in, *kv_g, *w_uk, *w_uv, *rel_bias, *ln_g, *ln_b, *w_sp, *b_sp, *w_pa, *w_pb, *w_out, *n1g, *n2g, *rg_w, *rg_b, *re_w, *re_b, *w_gate, *w_up, *w_down, *fg;
    float* out;
    unsigned* ctl;
    bf16_t *WinT, *WoutT, *WpbT, *WovT, *WSB, *WguT, *WdT;
    float* WrT;
    bf16_t *HB, *QL, *QI, *CKVB, *KI, *UB, *VB, *GAB, *GBB, *OL, *US, *MB, *MG, *H2B, *H2S, *HE, *YS;
    float *CKVR, *WI, *EW;
    unsigned short* SEL;
    int *EID, *PTOK, *MOEI, *GU, *DN;
};

__device__ __forceinline__ unsigned f2bf(float f) { unsigned u = __builtin_bit_cast(unsigned, f); return (u + 0x7fffu + ((u >> 16) & 1u)) >> 16; }
__device__ __forceinline__ unsigned pk2(float lo, float hi) { return f2bf(lo) | (f2bf(hi) << 16); }
__device__ __forceinline__ float bflo(unsigned w) { return __builtin_bit_cast(float, w << 16); }
__device__ __forceinline__ float bfhi(unsigned w) { return __builtin_bit_cast(float, w & 0xffff0000u); }
__device__ __forceinline__ float bf2f(unsigned short b) { return __builtin_bit_cast(float, (unsigned)b << 16); }
__device__ __forceinline__ float wave_sum(float v) {
#pragma unroll
    for (int o = 1; o < 64; o <<= 1) v += __shfl_xor(v, o);
    return v;
}
#define LDS_WAIT() asm volatile("s_waitcnt lgkmcnt(0)" ::: "memory")
__device__ __forceinline__ float gelu_t(float x) { const float z = 0.7978845608f * (x + 0.044715f * x * x * x); return x / (1.f + __expf(-2.f * z)); }
__device__ __forceinline__ float sigm(float x) { return 1.f / (1.f + __expf(-x)); }
__device__ __forceinline__ unsigned off_b(unsigned row, unsigned ch) { return 256u * row + 16u * (ch ^ (((row & 3) << 2) | ((row >> 2) & 3))); }
__device__ __forceinline__ bf16x4 tr_read(unsigned lds_addr) { bf16x4 r; asm volatile("ds_read_b64_tr_b16 %0, %1\n\ts_waitcnt lgkmcnt(0)" : "=&v"(r) : "v"(lds_addr) : "memory"); return r; }
__device__ __forceinline__ bf16x8 cat4(bf16x4 a, bf16x4 b) { bf16x8 r; r[0] = a[0]; r[1] = a[1]; r[2] = a[2]; r[3] = a[3]; r[4] = b[0]; r[5] = b[1]; r[6] = b[2]; r[7] = b[3]; return r; }
__device__ __forceinline__ unsigned lds_addr_of(LAS unsigned char* p) { return (unsigned)(unsigned long long)p; }

__device__ __forceinline__ void st8bf(bf16_t* p, const pg8::f32x4& a, const pg8::f32x4& b) {
    u32x4 w; w.x = pg8::cvt_pk_bf16(a[0], a[1]); w.y = pg8::cvt_pk_bf16(a[2], a[3]); w.z = pg8::cvt_pk_bf16(b[0], b[1]); w.w = pg8::cvt_pk_bf16(b[2], b[3]);
    *(u32x4*)p = w;
}
__device__ __forceinline__ void ld8bf(const bf16_t* p, pg8::f32x4& a, pg8::f32x4& b) {
    const u32x4 w = *(const u32x4*)p;
    a[0] = bflo(w.x); a[1] = bfhi(w.x); a[2] = bflo(w.y); a[3] = bfhi(w.y); b[0] = bflo(w.z); b[1] = bfhi(w.z); b[2] = bflo(w.w); b[3] = bfhi(w.w);
}

struct EpiIn {
    static constexpr bool PERM = true, AFTER_DRAIN = false;
    bf16_t *QL, *QI, *KI, *UB, *VB, *GAB, *GBB; float *CKVR, *WI;
    __device__ __forceinline__ void operator()(const pg8::f32x4 (&acc)[2][2][4][2], const pg8::Unit& u, int wr, int wc, int fr, int fq) const {
        const int row0 = u.pm * 256 + wr * 64 + fr, pn = u.pn, c8 = wc * 32 + 8 * fq;
        int mode; bf16_t* dst; int ld;
        if (pn < 4)       { mode = 0; dst = QL + pn * 256; ld = 1024; }
        else if (pn < 6)  { mode = 0; dst = QI + (pn - 4) * 256; ld = 512; }
        else if (pn == 6) { mode = 3; dst = KI; ld = 64; }
        else if (pn < 9)  { mode = 1; dst = UB + (pn - 7) * 256; ld = 512; }
        else if (pn < 11) { mode = 1; dst = VB + (pn - 9) * 256; ld = 512; }
        else if (pn < 15) { mode = 2; dst = GAB + (pn - 11) * 256; ld = 1024; }
        else              { mode = 2; dst = GBB + (pn - 15) * 256; ld = 1024; }
#pragma unroll
        for (int ai = 0; ai < 2; ++ai)
#pragma unroll
            for (int m = 0; m < 4; ++m) {
                const size_t row = (size_t)(row0 + ai * 128 + m * 16);
#pragma unroll
                for (int bj = 0; bj < 2; ++bj) {
                    pg8::f32x4 v0 = acc[ai][bj][m][0], v1 = acc[ai][bj][m][1];
                    if (mode == 3) {
                        if (bj == 0) { float* c = CKVR + row * 128 + c8; *(pg8::f32x4*)c = v0; *(pg8::f32x4*)(c + 4) = v1; }
                        else if (c8 < 64) st8bf(KI + row * 64 + c8, v0, v1);
                        else if (c8 == 64) { float* c = WI + row * 8; *(pg8::f32x4*)c = v0 * 0.044194174f; *(pg8::f32x4*)(c + 4) = v1 * 0.044194174f; }
                    } else {
                        if (mode == 1) {
#pragma unroll
                            for (int j = 0; j < 4; ++j) { v0[j] = gelu_t(v0[j]); v1[j] = gelu_t(v1[j]); }
                        } else if (mode == 2) {
#pragma unroll
                            for (int j = 0; j < 4; ++j) { v0[j] = sigm(v0[j]); v1[j] = sigm(v1[j]); }
                        }
                        st8bf(dst + row * ld + bj * 128 + c8, v0, v1);
                    }
                }
            }
    }
};

struct EpiMB {
    static constexpr bool PERM = true, AFTER_DRAIN = false;
    const bf16_t* G; bf16_t* O;
    __device__ __forceinline__ void operator()(const pg8::f32x4 (&acc)[2][2][4][2], const pg8::Unit& u, int wr, int wc, int fr, int fq) const {
        const int row0 = u.pm * 256 + wr * 64 + fr, col0 = u.pn * 256 + wc * 32 + 8 * fq;
#pragma unroll
        for (int ai = 0; ai < 2; ++ai)
#pragma unroll
            for (int m = 0; m < 4; ++m)
#pragma unroll
                for (int bj = 0; bj < 2; ++bj) {
                    const size_t o = (size_t)(row0 + ai * 128 + m * 16) * 1024 + col0 + bj * 128;
                    pg8::f32x4 g0, g1; ld8bf(G + o, g0, g1);
                    st8bf(O + o, acc[ai][bj][m][0] * g0, acc[ai][bj][m][1] * g1);
                }
    }
};
struct EpiMG {
    static constexpr bool PERM = true, AFTER_DRAIN = false;
    const bf16_t *G, *MBp; bf16_t* O;
    __device__ __forceinline__ void operator()(const pg8::f32x4 (&acc)[2][2][4][2], const pg8::Unit& u, int wr, int wc, int fr, int fq) const {
        const int row0 = u.pm * 256 + wr * 64 + fr, col0 = u.pn * 256 + wc * 32 + 8 * fq;
#pragma unroll
        for (int ai = 0; ai < 2; ++ai)
#pragma unroll
            for (int m = 0; m < 4; ++m)
#pragma unroll
                for (int bj = 0; bj < 2; ++bj) {
                    const size_t o = (size_t)(row0 + ai * 128 + m * 16) * 1024 + col0 + bj * 128;
                    pg8::f32x4 g0, g1, b0, b1; ld8bf(G + o, g0, g1); ld8bf(MBp + o, b0, b1);
                    st8bf(O + o, acc[ai][bj][m][0] * g0 + b0, acc[ai][bj][m][1] * g1 + b1);
                }
    }
};
struct EpiX1 {
    static constexpr bool PERM = true, AFTER_DRAIN = false;
    const float* X; float* O;
    __device__ __forceinline__ void operator()(const pg8::f32x4 (&acc)[2][2][4][2], const pg8::Unit& u, int wr, int wc, int fr, int fq) const {
        const int row0 = u.pm * 256 + wr * 64 + fr, col0 = u.pn * 256 + wc * 32 + 8 * fq;
#pragma unroll
        for (int ai = 0; ai < 2; ++ai)
#pragma unroll
            for (int m = 0; m < 4; ++m)
#pragma unroll
                for (int bj = 0; bj < 2; ++bj) {
                    const size_t o = (size_t)(row0 + ai * 128 + m * 16) * 1024 + col0 + bj * 128;
                    const pg8::f32x4 x0 = *(const pg8::f32x4*)(X + o), x1 = *(const pg8::f32x4*)(X + o + 4);
                    *(pg8::f32x4*)(O + o) = x0 + acc[ai][bj][m][0]; *(pg8::f32x4*)(O + o + 4) = x1 + acc[ai][bj][m][1];
                }
    }
};
struct EpiHE {
    static constexpr bool PERM = true, AFTER_DRAIN = false;
    bf16_t* HE;
    __device__ __forceinline__ void operator()(const pg8::f32x4 (&acc)[2][2][4][2], const pg8::Unit& u, int wr, int wc, int fr, int fq) const {
        const int row0 = u.pm * 256 + wr * 64 + fr, col0 = (u.pn & 1) * 128 + wc * 32 + 8 * fq;
#pragma unroll
        for (int ai = 0; ai < 2; ++ai)
#pragma unroll
            for (int m = 0; m < 4; ++m) {
                pg8::f32x4 h0, h1;
#pragma unroll
                for (int j = 0; j < 4; ++j) {
                    const float g0 = acc[ai][0][m][0][j], g1 = acc[ai][0][m][1][j];
                    h0[j] = g0 * sigm(g0) * acc[ai][1][m][0][j]; h1[j] = g1 * sigm(g1) * acc[ai][1][m][1][j];
                }
                st8bf(HE + (size_t)(row0 + ai * 128 + m * 16) * 256 + col0, h0, h1);
            }
    }
};
struct EpiDown {
    static constexpr bool PERM = true, AFTER_DRAIN = false;
    const int* PTOK; const float* EW; bf16_t* YS;
    __device__ __forceinline__ void operator()(const pg8::f32x4 (&acc)[2][2][4][2], const pg8::Unit& u, int wr, int wc, int fr, int fq) const {
        const int row0 = u.pm * 256 + wr * 64 + fr, col0 = (u.pn & 3) * 256 + wc * 32 + 8 * fq;
#pragma unroll
        for (int ai = 0; ai < 2; ++ai)
#pragma unroll
            for (int m = 0; m < 4; ++m) {
                const int ts = PTOK[row0 + ai * 128 + m * 16];
                if (ts >= 0) {
                    const float w = EW[ts];
                    bf16_t* d = YS + ((size_t)(ts & 1) * M + (size_t)(ts >> 1)) * 1024 + col0;
#pragma unroll
                    for (int bj = 0; bj < 2; ++bj) st8bf(d + bj * 128, acc[ai][bj][m][0] * w, acc[ai][bj][m][1] * w);
                }
            }
    }
};
struct TableOrder {
    const int* tab; const int* nunits; int G, c;
    __device__ __forceinline__ bool next(int i, pg8::Unit& u) const {
        const int idx = i * G + c; const int n = __builtin_nontemporal_load(nunits);
        if (idx >= n) return false;
        u.pm = tab[2 * idx]; u.pn = tab[2 * idx + 1]; return true;
    }
    __device__ __forceinline__ void a_ready(const pg8::Unit&) const {}
    __device__ __forceinline__ void done(const pg8::Unit&) const {}
};

__device__ __forceinline__ void tr_item(const float* src, int ld, int K, int NC, bf16_t* dst, LAS float* scr, int item, int lane) {
    const int nblk = NC / 32, kb = item / nblk, nb = item % nblk, k0 = 64 * kb, n0 = 32 * nb;
#pragma unroll 8
    for (int i = 0; i < 32; ++i) { const int kk = 2 * i + (lane >> 5); scr[kk * 33 + (lane & 31)] = src[(size_t)(k0 + kk) * ld + n0 + (lane & 31)]; }
    LDS_WAIT();
    const int c = lane & 7;
#pragma unroll
    for (int j = 0; j < 4; ++j) { const int n = (lane >> 3) + 8 * j; const LAS float* s = scr + (8 * c) * 33 + n;
        u32x4 o; o.x = pk2(s[0 * 33], s[1 * 33]); o.y = pk2(s[2 * 33], s[3 * 33]); o.z = pk2(s[4 * 33], s[5 * 33]); o.w = pk2(s[6 * 33], s[7 * 33]);
        *(u32x4*)(dst + (size_t)(n0 + n) * K + k0 + 8 * c) = o; }
    LDS_WAIT();
}

__device__ __forceinline__ void ph_prep(const P& p, LAS unsigned char* lds, const int wv) {
    const int tid = opaque_tid(wv), lane = tid & 63, wave = __builtin_amdgcn_readfirstlane(tid >> 6);
    LAS float* scr = (LAS float*)(lds + wave * 16384);
    const int gw = blockIdx.x * NWAVES + wave, NGW = gridDim.x * NWAVES;
    const int gt = blockIdx.x * NTHR + tid, NGT = gridDim.x * NTHR;
    {
        const int c0s[7] = {640, 512, 1152, 1224, 1736, 2248, 3272};
        const int ncs[7] = {512, 128, 64, 512, 512, 1024, 1024};
        const int r0s[7] = {1024, 1536, 1664, 1792, 2304, 2816, 3840};
#pragma unroll
        for (int s = 0; s < 7; ++s) {
            const int nit = 16 * (ncs[s] / 32);
            for (int it = gw; it < nit; it += NGW) tr_item(p.w_in + c0s[s], INC, 1024, ncs[s], p.WinT + (size_t)r0s[s] * 1024, scr, it, lane);
        }
    }
    for (int i = gt; i < 64 * 1024; i += NGT) { const int j = i >> 10, k = i & 1023; p.WinT[(size_t)(1728 + j) * 1024 + k] = j < 8 ? (bf16_t)f2bf(p.w_in[(size_t)k * INC + 1216 + j]) : (bf16_t)0; }
    for (int it = gw; it < 512; it += NGW) tr_item(p.w_out, 1024, 1024, 1024, p.WoutT, scr, it, lane);
    for (int it = gw; it < 256; it += NGW) tr_item(p.w_pb, 1024, 512, 1024, p.WpbT, scr, it, lane);
    for (int it = gw; it < 8192; it += NGW) {
        const int sub = it & 63, q = it >> 6, gu = q & 1, j = (q >> 1) & 1, e = q >> 2;
        const float* src = (gu ? p.w_up : p.w_gate) + (size_t)e * 262144 + 128 * j;
        tr_item(src, 256, 1024, 128, p.WguT + ((size_t)e * 512 + j * 256 + gu * 128) * 1024, scr, sub, lane);
    }
    for (int it = gw; it < 4096; it += NGW) { const int sub = it & 127, e = it >> 7; tr_item(p.w_down + (size_t)e * 262144, 1024, 256, 1024, p.WdT + (size_t)e * 262144, scr, sub, lane); }
    for (int i = gt; i < 1024 * 1024; i += NGT) {
        const int n = i >> 10, k = i & 1023, h = n >> 7, r = n & 127;
        const float* a = p.w_in + (size_t)k * INC + h * 64; const float* b = p.w_uk + (size_t)(r * 8 + h) * 64;
        float s = 0.f;
#pragma unroll 16
        for (int d = 0; d < 64; ++d) s += a[d] * b[d];
        p.WinT[(size_t)n * 1024 + k] = (bf16_t)f2bf(0.125f * s);
    }
    for (int i = gt; i < 1024 * 1024; i += NGT) {
        const int n = i >> 10, k = i & 1023, h = k >> 7, r = k & 127;
        const float* a = p.w_uv + (size_t)(r * 8 + h) * 64; const float* b = p.w_pa + (size_t)(h * 64) * 1024 + n;
        float s = 0.f;
#pragma unroll 16
        for (int d = 0; d < 64; ++d) s += a[d] * b[(size_t)d * 1024];
        p.WovT[(size_t)n * 1024 + k] = (bf16_t)f2bf(s);
    }
    for (int i = gt; i < 4 * 128 * 128; i += NGT) { const int jj = i & 127, ii = (i >> 7) & 127; p.WSB[i] = jj <= ii ? (bf16_t)f2bf(p.w_sp[i]) : (bf16_t)0; }
    for (int i = gt; i < 36 * 1024; i += NGT) { const int c = i >> 10, k = i & 1023; p.WrT[i] = c < 4 ? p.rg_w[k * 4 + c] : p.re_w[k * 32 + (c - 4)]; }
    for (int m = gw; m < M; m += NGW) {
        const f32x4* xr = (const f32x4*)(p.x + (size_t)m * D) + lane;
        f32x4 v[4]; float s = 0.f;
#pragma unroll
        for (int j = 0; j < 4; ++j) { v[j] = xr[64 * j]; s += (v[j].x * v[j].x + v[j].y * v[j].y) + (v[j].z * v[j].z + v[j].w * v[j].w); }
        const float rinv = 1.0f / sqrtf(wave_sum(s) * (1.f / D) + EPS);
        unsigned long long* o8 = (unsigned long long*)(p.HB + (size_t)m * D) + lane;
#pragma unroll
        for (int j = 0; j < 4; ++j) { const f32x4 g = ((const f32x4*)p.n1g)[lane + 64 * j]; const f32x4 o = v[j] * rinv * g;
            o8[64 * j] = (unsigned long long)pk2(o.x, o.y) | ((unsigned long long)pk2(o.z, o.w) << 32); }
    }
}

__device__ __forceinline__ void ph_ckvnorm(const P& p, const int wv) {
    const int tid = opaque_tid(wv), lane = tid & 63, wave = tid >> 6;
    const int gw = blockIdx.x * NWAVES + wave, NGW = gridDim.x * NWAVES;
    const float g0 = p.kv_g[2 * lane], g1 = p.kv_g[2 * lane + 1];
    for (int m = gw; m < M; m += NGW) {
        const float2 v = ((const float2*)(p.CKVR + (size_t)m * 128))[lane];
        const float rinv = 1.0f / sqrtf(wave_sum(v.x * v.x + v.y * v.y) * (1.f / 128.f) + EPS);
        ((unsigned*)(p.CKVB + (size_t)m * 128))[lane] = pk2(v.x * rinv * g0, v.y * rinv * g1);
    }
}

__device__ __forceinline__ unsigned fkey(float x) { x = x + 0.0f; const unsigned u = __builtin_bit_cast(unsigned, x); return (u & 0x80000000u) ? ~u : (u | 0x80000000u); }

__device__ __forceinline__ void select_row(const LAS float* row, int n, LAS unsigned* hist, unsigned short* out, int lane) {
    if (n <= 256) {
#pragma unroll
        for (int i = 0; i < 4; ++i) { const int k = lane + 64 * i; out[k] = (unsigned short)(k < n ? k : 0); }
        return;
    }
    unsigned prefix = 0; int need = 256;
    const unsigned long long lt = (1ull << lane) - 1ull;
#pragma unroll 1
    for (int pass = 3; pass >= 0; --pass) {
#pragma unroll
        for (int i = 0; i < 4; ++i) hist[lane + 64 * i] = 0u;
        LDS_WAIT();
        const int shift = pass * 8;
        for (int i = lane; i < n; i += 64) {
            const unsigned k = fkey(row[i]);
            const bool match = (pass == 3) || ((k >> (shift + 8)) == prefix);
            if (match) __hip_atomic_fetch_add(hist + ((k >> shift) & 255u), 1u, __ATOMIC_RELAXED, __HIP_MEMORY_SCOPE_WORKGROUP);
        }
        LDS_WAIT();
        const unsigned c0 = hist[4 * lane], c1 = hist[4 * lane + 1], c2 = hist[4 * lane + 2], c3 = hist[4 * lane + 3];
        const unsigned s = c0 + c1 + c2 + c3;
        unsigned incl = s;
#pragma unroll
        for (int o = 1; o < 64; o <<= 1) { const unsigned t = __shfl_down(incl, o); if (lane + o < 64) incl += t; }
        const unsigned excl = incl - s;
        const bool mine = (excl < (unsigned)need) && (incl >= (unsigned)need);
        unsigned bin = 0, above = 0;
        if (mine) {
            unsigned run = excl;
            if (run + c3 >= (unsigned)need) { bin = 4 * lane + 3; above = run; }
            else { run += c3;
                if (run + c2 >= (unsigned)need) { bin = 4 * lane + 2; above = run; }
                else { run += c2;
                    if (run + c1 >= (unsigned)need) { bin = 4 * lane + 1; above = run; }
                    else { run += c1; bin = 4 * lane; above = run; } } }
        }
        const unsigned long long bm = __ballot(mine);
        const int src = bm ? (int)__builtin_ctzll(bm) : 0;
        bin = __shfl(bin, src); above = __shfl(above, src);
        need -= (int)above; prefix = (prefix << 8) | bin;
        LDS_WAIT();
    }
    const unsigned Tk = prefix;
    int cnt = 0, eq_taken = 0;
    for (int i0 = 0; i0 < n; i0 += 64) {
        const int i = i0 + lane; const bool valid = i < n;
        const unsigned k = valid ? fkey(row[i]) : 0u;
        const bool gtk = valid && (k > Tk), eqk = valid && (k == Tk);
        const unsigned long long beq = __ballot(eqk);
        const int eq_rank = eq_taken + __builtin_popcountll(beq & lt);
        const bool take = gtk || (eqk && eq_rank < need);
        const unsigned long long bt = __ballot(take);
        const int pos = cnt + __builtin_popcountll(bt & lt);
        if (take && pos < 256) out[pos] = (unsigned short)i;
        cnt += __builtin_popcountll(bt); eq_taken += __builtin_popcountll(beq);
    }
}

__device__ __forceinline__ void ph_index(const P& p, LAS unsigned char* lds, const int wv) {
    LAS float* Irow = (LAS float*)lds;
    LAS unsigned* hist = (LAS unsigned*)(lds + 131072);
    const int tid = opaque_tid(wv), lane = tid & 63, wave = __builtin_amdgcn_readfirstlane(tid >> 6);
    const int hh = lane >> 5, n = lane & 31;
    const int rho = lane & 31, qlA = 2 * ((rho >> 2) & 1) + (rho >> 4), hdA = (rho & 3) + 4 * ((rho >> 3) & 1);
    for (int u = blockIdx.x; u < 4096; u += gridDim.x) {
        const int b = u & 7, tb = 511 - (u >> 3), t0 = tb * 8; const size_t mb = (size_t)b * T;
        bf16x8 A[2][4]; float wq[2][16];
#pragma unroll
        for (int mt = 0; mt < 2; ++mt) {
            const bf16_t* src = p.QI + (mb + t0 + mt * 4 + qlA) * 512 + hdA * 64 + 8 * hh;
#pragma unroll
            for (int s = 0; s < 4; ++s) A[mt][s] = *(const bf16x8*)(src + 16 * s);
#pragma unroll
            for (int c = 0; c < 2; ++c) {
                const float* wp = p.WI + (mb + t0 + mt * 4 + 2 * hh + c) * 8;
                const f32x4 w0 = *(const f32x4*)wp, w1 = *(const f32x4*)(wp + 4);
#pragma unroll
                for (int j = 0; j < 4; ++j) { wq[mt][c * 8 + j] = w0[j]; wq[mt][c * 8 + 4 + j] = w1[j]; }
            }
        }
        const int nkt = (t0 + 8 + 31) >> 5;
        for (int kt = wave; kt < nkt; kt += NWAVES) {
            const int key = kt * 32 + n;
            const bf16_t* kp = p.KI + (mb + key) * 64 + 8 * hh;
            bf16x8 B[4];
#pragma unroll
            for (int s = 0; s < 4; ++s) B[s] = *(const bf16x8*)(kp + 16 * s);
#pragma unroll
            for (int mt = 0; mt < 2; ++mt) {
                f32x16 acc;
#pragma unroll
                for (int j = 0; j < 16; ++j) acc[j] = 0.f;
#pragma unroll
                for (int s = 0; s < 4; ++s) acc = __builtin_amdgcn_mfma_f32_32x32x16_bf16(A[mt][s], B[s], acc, 0, 0, 0);
#pragma unroll
                for (int c = 0; c < 2; ++c) {
                    float v = 0.f;
#pragma unroll
                    for (int h = 0; h < 8; ++h) v += wq[mt][c * 8 + h] * fmaxf(acc[c * 8 + h], 0.f);
                    Irow[(mt * 4 + 2 * hh + c) * 4096 + key] = v;
                }
            }
        }
        __syncthreads();
        select_row(Irow + wave * 4096, t0 + wave + 1, hist + wave * 256, p.SEL + (mb + t0 + wave) * 256, lane);
        __syncthreads();
    }
}

__device__ __forceinline__ void ph_attn(const P& p, LAS unsigned char* lds, const int wv) {
    const int tid = opaque_tid(wv), lane = tid & 63, wave = __builtin_amdgcn_readfirstlane(tid >> 6);
    LAS unsigned char* tile = lds + wave * 16384;
    LAS unsigned char* tblb = lds + 131072;
    LAS float* bias = (LAS float*)(lds + 131072 + 128);
    for (int i = tid; i < 128; i += NTHR) {
        int bk = i;
        if (i >= 16) { const float nf = (float)i; bk = 16 + (int)(logf(nf / 16.f) / 2.0794415f * 16.f); if (bk > 31) bk = 31; }
        tblb[i] = (unsigned char)bk;
    }
    for (int i = tid; i < 256; i += NTHR) bias[i] = p.rel_bias[i];
    __syncthreads();
    const int g = lane >> 4, hcol = lane & 15, q4 = (lane & 15) >> 2, p4 = lane & 3;
    const unsigned tbase = lds_addr_of(tile);
    for (int m = blockIdx.x * NWAVES + wave; m < M; m += gridDim.x * NWAVES) {
        const int t = m & (T - 1); const size_t mb = (size_t)(m >> 12) * T;
        const int nvalid = t + 1 < 256 ? t + 1 : 256;
        const unsigned short* selp = p.SEL + (size_t)m * 256;
        bf16x8 qf[4];
#pragma unroll
        for (int s = 0; s < 4; ++s) {
            bf16x8 z;
#pragma unroll
            for (int j = 0; j < 8; ++j) z[j] = 0;
            qf[s] = hcol < 8 ? *(const bf16x8*)(p.QL + (size_t)m * 1024 + hcol * 128 + 32 * s + 8 * g) : z;
        }
        f32x4 sc[16];
        float mx = -INFINITY;
#pragma unroll
        for (int tau = 0; tau < 16; ++tau) {
            const int kpA = 16 * tau + hcol; const int keyA = kpA < nvalid ? (int)selp[kpA] : 0;
            const bf16_t* crow = p.CKVB + (mb + keyA) * 128 + 8 * g;
            f32x4 acc = {0.f, 0.f, 0.f, 0.f};
#pragma unroll
            for (int s = 0; s < 4; ++s) acc = __builtin_amdgcn_mfma_f32_16x16x32_bf16(*(const bf16x8*)(crow + 32 * s), qf[s], acc, 0, 0, 0);
#pragma unroll
            for (int r = 0; r < 4; ++r) {
                const int kp = 16 * tau + 4 * g + r;
                if (kp < nvalid) { const int dist = t - (int)selp[kp]; const int bk = dist < 128 ? (int)tblb[dist] : 31; acc[r] += bias[bk * 8 + (hcol & 7)]; mx = fmaxf(mx, acc[r]); }
                else acc[r] = -INFINITY;
            }
            sc[tau] = acc;
        }
        mx = fmaxf(mx, __shfl_xor(mx, 16)); mx = fmaxf(mx, __shfl_xor(mx, 32));
        float sum = 0.f;
#pragma unroll
        for (int tau = 0; tau < 16; ++tau)
#pragma unroll
            for (int r = 0; r < 4; ++r) { const float e = __expf(sc[tau][r] - mx); sc[tau][r] = e; sum += e; }
        sum += __shfl_xor(sum, 16); sum += __shfl_xor(sum, 32);
        const float inv = 1.f / sum;
        bf16x8 pf[8];
#pragma unroll
        for (int ks = 0; ks < 8; ++ks) {
            u32x4 w; w.x = pk2(sc[2 * ks][0] * inv, sc[2 * ks][1] * inv); w.y = pk2(sc[2 * ks][2] * inv, sc[2 * ks][3] * inv);
            w.z = pk2(sc[2 * ks + 1][0] * inv, sc[2 * ks + 1][1] * inv); w.w = pk2(sc[2 * ks + 1][2] * inv, sc[2 * ks + 1][3] * inv);
            pf[ks] = __builtin_bit_cast(bf16x8, w);
        }
        f32x4 o[8];
#pragma unroll
        for (int rt = 0; rt < 8; ++rt) o[rt] = (f32x4){0.f, 0.f, 0.f, 0.f};
#pragma unroll
        for (int c = 0; c < 4; ++c) {
#pragma unroll
            for (int i0 = 0; i0 < 16; i0 += 4) {
#pragma unroll
                for (int i = i0; i < i0 + 4; ++i) {
                    const int piece = i * 64 + lane, row = piece >> 4, ch = piece & 15, kp = 64 * c + row;
                    const int key = kp < nvalid ? (int)selp[kp] : 0;
                    const u32x4 v = *(const u32x4*)(p.CKVB + (mb + key) * 128 + ch * 8);
                    *(LAS u32x4*)(tile + off_b(row, ch)) = v;
                }
                asm volatile("" ::: "memory");
            }
            LDS_WAIT();
#pragma unroll
            for (int ksl = 0; ksl < 2; ++ksl) {
#pragma unroll
                for (int rt = 0; rt < 8; ++rt) {
                    const unsigned row0 = 32 * ksl + 4 * g + q4, ch = 2 * rt + (p4 >> 1);
                    const bf16x4 a0 = tr_read(tbase + off_b(row0, ch) + 8 * (p4 & 1));
                    const bf16x4 a1 = tr_read(tbase + off_b(row0 + 16, ch) + 8 * (p4 & 1));
                    o[rt] = __builtin_amdgcn_mfma_f32_16x16x32_bf16(cat4(a0, a1), pf[2 * c + ksl], o[rt], 0, 0, 0);
                }
            }
        }
        if (hcol < 8) {
#pragma unroll
            for (int rt = 0; rt < 8; ++rt) {
                u32x2 w; w.x = pk2(o[rt][0], o[rt][1]); w.y = pk2(o[rt][2], o[rt][3]);
                *(u32x2*)(p.OL + (size_t)m * 1024 + hcol * 128 + 16 * rt + 4 * g) = w;
            }
        }
    }
}

__device__ __forceinline__ void ph_gmlp(const P& p, LAS unsigned char* lds, const int wv) {
    const int tid = opaque_tid(wv), lane = tid & 63, wave = __builtin_amdgcn_readfirstlane(tid >> 6);
    LAS unsigned char* vt = lds;
    LAS float* st = (LAS float*)(lds + 32768);
    const unsigned vbase = lds_addr_of(vt);
    const int g4 = lane >> 4, q4 = (lane & 15) >> 2, p4 = lane & 3;
    for (int u = blockIdx.x; u < 256; u += gridDim.x) {
        const size_t m0 = (size_t)u * 128;
        for (int rr = 0; rr < 16; ++rr) {
            const int row = 16 * wave + rr;
            const u32x4 w = *(const u32x4*)(p.VB + (m0 + row) * 512 + lane * 8);
            const float x0 = bflo(w.x), x1 = bfhi(w.x), x2 = bflo(w.y), x3 = bfhi(w.y), x4 = bflo(w.z), x5 = bfhi(w.z), x6 = bflo(w.w), x7 = bfhi(w.w);
            const float mean = wave_sum(((x0 + x1) + (x2 + x3)) + ((x4 + x5) + (x6 + x7))) * (1.f / 512.f);
            const float d0 = x0 - mean, d1 = x1 - mean, d2 = x2 - mean, d3 = x3 - mean, d4 = x4 - mean, d5 = x5 - mean, d6 = x6 - mean, d7 = x7 - mean;
            const float var = wave_sum(((d0 * d0 + d1 * d1) + (d2 * d2 + d3 * d3)) + ((d4 * d4 + d5 * d5) + (d6 * d6 + d7 * d7))) * (1.f / 512.f);
            if (lane == 0) { st[2 * row] = mean; st[2 * row + 1] = 1.0f / sqrtf(var + EPS); }
        }
        __syncthreads();
#pragma unroll 1
        for (int g = 0; g < 4; ++g) {
#pragma unroll
            for (int i = 0; i < 4; ++i) {
                const int piece = i * NTHR + tid, row = piece >> 4, ch = piece & 15;
                const u32x4 w = *(const u32x4*)(p.VB + (m0 + row) * 512 + g * 128 + ch * 8);
                const float mean = st[2 * row], rstd = st[2 * row + 1];
                const f32x4 ga = *(const f32x4*)(p.ln_g + g * 128 + ch * 8), gb = *(const f32x4*)(p.ln_g + g * 128 + ch * 8 + 4);
                const f32x4 ba = *(const f32x4*)(p.ln_b + g * 128 + ch * 8), bb = *(const f32x4*)(p.ln_b + g * 128 + ch * 8 + 4);
                u32x4 o;
                o.x = pk2((bflo(w.x) - mean) * rstd * ga[0] + ba[0], (bfhi(w.x) - mean) * rstd * ga[1] + ba[1]);
                o.y = pk2((bflo(w.y) - mean) * rstd * ga[2] + ba[2], (bfhi(w.y) - mean) * rstd * ga[3] + ba[3]);
                o.z = pk2((bflo(w.z) - mean) * rstd * gb[0] + bb[0], (bfhi(w.z) - mean) * rstd * gb[1] + bb[1]);
                o.w = pk2((bflo(w.w) - mean) * rstd * gb[2] + bb[2], (bfhi(w.w) - mean) * rstd * gb[3] + bb[3]);
                *(LAS u32x4*)(vt + off_b(row, ch)) = o;
            }
            __syncthreads();
            f32x4 acc[8];
#pragma unroll
            for (int et = 0; et < 8; ++et) acc[et] = (f32x4){0.f, 0.f, 0.f, 0.f};
            const int nks = ((16 * wave + 15) >> 5) + 1;
#pragma unroll
            for (int ks = 0; ks < 4; ++ks) {
                if (ks < nks) {
                    const bf16x8 a = *(const bf16x8*)(p.WSB + ((size_t)g * 128 + 16 * wave + (lane & 15)) * 128 + 32 * ks + 8 * g4);
#pragma unroll
                    for (int et = 0; et < 8; ++et) {
                        const unsigned r0 = 32 * ks + 8 * g4 + q4, ch = 2 * et + (p4 >> 1);
                        const bf16x4 b0 = tr_read(vbase + off_b(r0, ch) + 8 * (p4 & 1));
                        const bf16x4 b1 = tr_read(vbase + off_b(r0 + 4, ch) + 8 * (p4 & 1));
                        acc[et] = __builtin_amdgcn_mfma_f32_16x16x32_bf16(a, cat4(b0, b1), acc[et], 0, 0, 0);
                    }
                }
            }
#pragma unroll
            for (int r = 0; r < 4; ++r) {
                const int i = 16 * wave + 4 * g4 + r; const float bs = p.b_sp[g * 128 + i];
#pragma unroll
                for (int et = 0; et < 8; ++et) {
                    const size_t o = (m0 + i) * 512 + g * 128 + 16 * et + (lane & 15);
                    p.US[o] = (bf16_t)f2bf(bf2f(p.UB[o]) * (acc[et][r] + bs));
                }
            }
            __syncthreads();
        }
    }
}

__device__ __forceinline__ void ph_router(const P& p, const int wv) {
    const int tid = opaque_tid(wv), lane = tid & 63, wave = tid >> 6;
    const int gw = blockIdx.x * NWAVES + wave, NGW = gridDim.x * NWAVES;
    const float* X1 = p.out;
    for (int m = gw; m < M; m += NGW) {
        f32x4 hv[4];
        {
            const f32x4* xr = (const f32x4*)(X1 + (size_t)m * D) + lane;
            float s = 0.f;
#pragma unroll
            for (int j = 0; j < 4; ++j) { hv[j] = xr[64 * j]; s += (hv[j].x * hv[j].x + hv[j].y * hv[j].y) + (hv[j].z * hv[j].z + hv[j].w * hv[j].w); }
            const float rinv = 1.0f / sqrtf(wave_sum(s) * (1.f / D) + EPS);
            unsigned long long* o8 = (unsigned long long*)(p.H2B + (size_t)m * D) + lane;
#pragma unroll
            for (int j = 0; j < 4; ++j) { const f32x4 g = ((const f32x4*)p.n2g)[lane + 64 * j]; hv[j] = hv[j] * rinv * g;
                o8[64 * j] = (unsigned long long)pk2(hv[j].x, hv[j].y) | ((unsigned long long)pk2(hv[j].z, hv[j].w) << 32); }
        }
        float gl[4];
#pragma unroll
        for (int c = 0; c < 4; ++c) {
            float s = 0.f;
#pragma unroll
            for (int j = 0; j < 4; ++j) { const f32x4 w = ((const f32x4*)(p.WrT + c * 1024))[lane + 64 * j]; s += (hv[j].x * w.x + hv[j].y * w.y) + (hv[j].z * w.z + hv[j].w * w.w); }
            gl[c] = wave_sum(s) + p.rg_b[c];
        }
        int gi = 0; float gm = gl[0];
#pragma unroll
        for (int i = 1; i < 4; ++i) if (gl[i] > gm) { gm = gl[i]; gi = i; }
        gi = __builtin_amdgcn_readfirstlane(gi);
        float gs = 0.f;
#pragma unroll
        for (int i = 0; i < 4; ++i) gs += __expf(gl[i] - gm);
        const float gwt = 1.f / gs;
        float el[8];
#pragma unroll
        for (int c = 0; c < 8; ++c) {
            const float* wr = p.WrT + (size_t)(4 + gi * 8 + c) * 1024;
            float s = 0.f;
#pragma unroll
            for (int j = 0; j < 4; ++j) { const f32x4 w = ((const f32x4*)wr)[lane + 64 * j]; s += (hv[j].x * w.x + hv[j].y * w.y) + (hv[j].z * w.z + hv[j].w * w.w); }
            el[c] = wave_sum(s) + p.re_b[gi * 8 + c];
        }
        int i1 = 0; float m1 = el[0];
#pragma unroll
        for (int j = 1; j < 8; ++j) if (el[j] > m1) { m1 = el[j]; i1 = j; }
        int i2 = 0; float m2 = -INFINITY;
#pragma unroll
        for (int j = 0; j < 8; ++j) if (j != i1 && el[j] > m2) { m2 = el[j]; i2 = j; }
        const float e2r = __expf(m2 - m1), e1 = 1.f / (1.f + e2r), e2 = e2r * e1;
        if (lane == 0) {
            const int ea = gi * 8 + i1, eb = gi * 8 + i2;
            p.EID[2 * m] = ea; p.EID[2 * m + 1] = eb;
            p.EW[2 * m] = gwt * e1; p.EW[2 * m + 1] = gwt * e2;
            atomicAdd(p.ctl + CW_CNT + ea, 1u); atomicAdd(p.ctl + CW_CNT + eb, 1u);
        }
    }
}

__device__ __forceinline__ void ph_scan(const P& p, LAS unsigned char* lds, const int wv) {
    if (blockIdx.x != 0) return;
    const int tid = opaque_tid(wv);
    LAS int* s = (LAS int*)lds;
    if (tid < 32) s[tid] = (int)__hip_atomic_load(p.ctl + CW_CNT + tid, __ATOMIC_RELAXED, __HIP_MEMORY_SCOPE_AGENT);
    __syncthreads();
    if (tid == 0) { int off = 0; for (int e = 0; e < 32; ++e) { s[32 + e] = off; off += (s[e] + 255) >> 8; } s[64] = off; }
    __syncthreads();
    const int ntiles = s[64];
    if (tid < 32) { p.MOEI[tid] = s[32 + tid] * 256; p.MOEI[32 + tid] = s[32 + tid]; }
    if (tid == 0) { p.MOEI[64] = ntiles; p.MOEI[65] = ntiles * 2; p.MOEI[66] = ntiles * 4; }
    for (int rt = tid; rt < ntiles; rt += NTHR) {
        int e = 0;
        for (int k = 0; k < 32; ++k) { const int tb = s[32 + k], nt = (s[k] + 255) >> 8; if (rt >= tb && rt < tb + nt) e = k; }
        p.GU[4 * rt + 0] = rt; p.GU[4 * rt + 1] = e * 2; p.GU[4 * rt + 2] = rt; p.GU[4 * rt + 3] = e * 2 + 1;
#pragma unroll
        for (int j = 0; j < 4; ++j) { p.DN[8 * rt + 2 * j] = rt; p.DN[8 * rt + 2 * j + 1] = e * 4 + j; }
    }
    for (int e = 0; e < 32; ++e) {
        const int lo = s[32 + e] * 256 + s[e], hi = (s[32 + e] + ((s[e] + 255) >> 8)) * 256;
        for (int i = lo + tid; i < hi; i += NTHR) p.PTOK[i] = -1;
    }
}

__device__ __forceinline__ void ph_scatter(const P& p, const int wv) {
    const int tid = opaque_tid(wv), lane = tid & 63, wave = tid >> 6;
    const int gw = blockIdx.x * NWAVES + wave, NGW = gridDim.x * NWAVES;
    for (int ts = gw; ts < 2 * M; ts += NGW) {
        int pos = 0;
        if (lane == 0) { const int e = p.EID[ts]; pos = p.MOEI[e] + (int)atomicAdd(p.ctl + CW_CUR + e, 1u); p.PTOK[pos] = ts; }
        pos = __shfl(pos, 0);
        const u32x4* src = (const u32x4*)(p.H2B + (size_t)(ts >> 1) * D); u32x4* dst = (u32x4*)(p.H2S + (size_t)pos * D);
        dst[lane] = src[lane]; dst[lane + 64] = src[lane + 64];
    }
}

__device__ __forceinline__ void ph_final(const P& p, const int wv) {
    const int tid = opaque_tid(wv), lane = tid & 63, wave = tid >> 6;
    const int gw = blockIdx.x * NWAVES + wave, NGW = gridDim.x * NWAVES;
    for (int m = gw; m < M; m += NGW) {
        f32x4* xr = (f32x4*)(p.out + (size_t)m * D) + lane;
        const u32x2* y0 = (const u32x2*)(p.YS + (size_t)m * D) + lane; const u32x2* y1 = (const u32x2*)(p.YS + ((size_t)M + m) * D) + lane;
        f32x4 v[4]; float s = 0.f;
#pragma unroll
        for (int j = 0; j < 4; ++j) {
            v[j] = xr[64 * j]; const u32x2 a = y0[64 * j], b = y1[64 * j];
            v[j].x += bflo(a.x) + bflo(b.x); v[j].y += bfhi(a.x) + bfhi(b.x); v[j].z += bflo(a.y) + bflo(b.y); v[j].w += bfhi(a.y) + bfhi(b.y);
            s += (v[j].x * v[j].x + v[j].y * v[j].y) + (v[j].z * v[j].z + v[j].w * v[j].w);
        }
        const float rinv = 1.0f / sqrtf(wave_sum(s) * (1.f / D) + EPS);
#pragma unroll
        for (int j = 0; j < 4; ++j) { const f32x4 g = ((const f32x4*)p.fg)[lane + 64 * j]; xr[64 * j] = v[j] * rinv * g; }
    }
}

__device__ __forceinline__ void ph_gemm_in(const P& p, LAS unsigned char* lds, const int wv) {
    pg8::Gemm g{p.HB, p.WinT, M, NIN, 1024}; pg8::StaticOrder S; S.init(M, NIN, gridDim.x, (int)blockIdx.x);
    EpiIn E{p.QL, p.QI, p.KI, p.UB, p.VB, p.GAB, p.GBB, p.CKVR, p.WI};
    pg8::gemm_phase<EpiIn, pg8::StaticOrder, true, true>(lds, g, S, E, wv);
}
__device__ __forceinline__ void ph_gemm_yb(const P& p, LAS unsigned char* lds, const int wv) {
    pg8::Gemm g{p.US, p.WpbT, M, 1024, 512}; pg8::StaticOrder S; S.init(M, 1024, gridDim.x, (int)blockIdx.x);
    EpiMB E{p.GBB, p.MB};
    pg8::gemm_phase<EpiMB, pg8::StaticOrder, true, true>(lds, g, S, E, wv);
}
__device__ __forceinline__ void ph_gemm_ya(const P& p, LAS unsigned char* lds, const int wv) {
    pg8::Gemm g{p.OL, p.WovT, M, 1024, 1024}; pg8::StaticOrder S; S.init(M, 1024, gridDim.x, (int)blockIdx.x);
    EpiMG E{p.GAB, p.MB, p.MG};
    pg8::gemm_phase<EpiMG, pg8::StaticOrder, true, true>(lds, g, S, E, wv);
}
__device__ __forceinline__ void ph_gemm_out(const P& p, LAS unsigned char* lds, const int wv) {
    pg8::Gemm g{p.MG, p.WoutT, M, 1024, 1024}; pg8::StaticOrder S; S.init(M, 1024, gridDim.x, (int)blockIdx.x);
    EpiX1 E{p.x, p.out};
    pg8::gemm_phase<EpiX1, pg8::StaticOrder, true, true>(lds, g, S, E, wv);
}
__device__ __forceinline__ void ph_gemm_gu(const P& p, LAS unsigned char* lds, const int wv) {
    pg8::Gemm g{p.H2S, p.WguT, NPOS, 32 * 512, 1024}; TableOrder S{p.GU, p.MOEI + 65, (int)gridDim.x, (int)blockIdx.x};
    EpiHE E{p.HE};
    pg8::gemm_phase<EpiHE, TableOrder, true, true>(lds, g, S, E, wv);
}
__device__ __forceinline__ void ph_gemm_dn(const P& p, LAS unsigned char* lds, const int wv) {
    pg8::Gemm g{p.HE, p.WdT, NPOS, 32 * 1024, 256}; TableOrder S{p.DN, p.MOEI + 66, (int)gridDim.x, (int)blockIdx.x};
    EpiDown E{p.PTOK, p.EW, p.YS};
    pg8::gemm_phase<EpiDown, TableOrder, true, true>(lds, g, S, E, wv);
}

constexpr int NPHASE = 15;
template <int PH> __device__ __forceinline__ void run_phase(const P& p, LAS unsigned char* lds, const int wv) {
    if constexpr (PH == 0) ph_prep(p, lds, wv);
    if constexpr (PH == 1) ph_gemm_in(p, lds, wv);
    if constexpr (PH == 2) ph_ckvnorm(p, wv);
    if constexpr (PH == 3) ph_index(p, lds, wv);
    if constexpr (PH == 4) ph_attn(p, lds, wv);
    if constexpr (PH == 5) ph_gmlp(p, lds, wv);
    if constexpr (PH == 6) ph_gemm_yb(p, lds, wv);
    if constexpr (PH == 7) ph_gemm_ya(p, lds, wv);
    if constexpr (PH == 8) ph_gemm_out(p, lds, wv);
    if constexpr (PH == 9) ph_router(p, wv);
    if constexpr (PH == 10) ph_scan(p, lds, wv);
    if constexpr (PH == 11) ph_scatter(p, wv);
    if constexpr (PH == 12) ph_gemm_gu(p, lds, wv);
    if constexpr (PH == 13) ph_gemm_dn(p, lds, wv);
    if constexpr (PH == 14) ph_final(p, wv);
}
template <int PH> __global__ void __launch_bounds__(NTHR, 2) k_phase(P p) {
    extern __shared__ __attribute__((aligned(16))) unsigned char lds_raw[];
    run_phase<PH>(p, (LAS unsigned char*)lds_raw, __builtin_amdgcn_readfirstlane(threadIdx.x >> 6));
}

constexpr int MISC_OFF = LDS_BYTES - 256;
__global__ void __launch_bounds__(NTHR, 2) k_mega(P p) {
    extern __shared__ __attribute__((aligned(16))) unsigned char lds_raw[];
    LAS unsigned char* lds = (LAS unsigned char*)lds_raw;
    volatile LAS unsigned* MISC = (volatile LAS unsigned*)(lds + MISC_OFF);
    int wv = __builtin_amdgcn_readfirstlane(threadIdx.x >> 6); asm volatile("" : "+s"(wv));
    if (threadIdx.x < 64) MISC[threadIdx.x] = 0u;
    __syncthreads();
    XcdBarrier bar = xcd_barrier_post(p.ctl + CW_BAR, MISC, wv);
    run_phase<0>(p, lds, wv);  xcd_barrier(bar);
    run_phase<1>(p, lds, wv);  xcd_barrier(bar);
    run_phase<2>(p, lds, wv);
    run_phase<3>(p, lds, wv);  xcd_barrier(bar);
    run_phase<4>(p, lds, wv);  __syncthreads();
    run_phase<5>(p, lds, wv);  xcd_barrier(bar);
    run_phase<6>(p, lds, wv);
    run_phase<7>(p, lds, wv);  xcd_barrier(bar);
    run_phase<8>(p, lds, wv);  xcd_barrier(bar);
    run_phase<9>(p, lds, wv);  xcd_barrier(bar);
    run_phase<10>(p, lds, wv); xcd_barrier(bar);
    run_phase<11>(p, lds, wv); xcd_barrier(bar);
    run_phase<12>(p, lds, wv); xcd_barrier(bar);
    run_phase<13>(p, lds, wv); xcd_barrier(bar);
    run_phase<14>(p, lds, wv);
}

extern "C" void kernel_launch(void* const* d_in, const int* in_sizes, int n_in, void* d_out, int out_size, void* d_ws, size_t ws_size, hipStream_t stream) {
    static int grid = 0; static bool first = true;
    if (grid == 0) {
        if (n_in != 23 || in_sizes[0] != M * D || out_size != M * D || ws_size < WS_END) { fprintf(stderr, "kernel_launch: unexpected shapes (n_in %d, in0 %d, out %d, ws %zu)\n", n_in, n_in > 0 ? in_sizes[0] : -1, out_size, ws_size); grid = -1; return; }
        int dev = 0, cus = 0;
        if (hipGetDevice(&dev) != hipSuccess || hipDeviceGetAttribute(&cus, hipDeviceAttributeMultiprocessorCount, dev) != hipSuccess) { grid = -1; return; }
        grid = cus;
    }
    if (grid < 0) return;
    unsigned char* ws = (unsigned char*)d_ws;
    (void)hipMemsetAsync(ws + WS_CTL, 0, CTL_ZERO_BYTES, stream);
    P p{};
    const float* const* in = (const float* const*)d_in;
    p.x = in[0]; p.w_in = in[1]; p.kv_g = in[2]; p.w_uk = in[3]; p.w_uv = in[4]; p.rel_bias = in[5]; p.ln_g = in[6]; p.ln_b = in[7]; p.w_sp = in[8]; p.b_sp = in[9];
    p.w_pa = in[10]; p.w_pb = in[11]; p.w_out = in[12]; p.n1g = in[13]; p.n2g = in[14]; p.rg_w = in[15]; p.rg_b = in[16]; p.re_w = in[17]; p.re_b = in[18];
    p.w_gate = in[19]; p.w_up = in[20]; p.w_down = in[21]; p.fg = in[22];
    p.out = (float*)d_out; p.ctl = (unsigned*)(ws + WS_CTL);
    p.WinT = (bf16_t*)(ws + WS_WIN); p.WoutT = (bf16_t*)(ws + WS_WOUT); p.WpbT = (bf16_t*)(ws + WS_WPB); p.WovT = (bf16_t*)(ws + WS_WOV); p.WSB = (bf16_t*)(ws + WS_WSB);
    p.WguT = (bf16_t*)(ws + WS_WGU); p.WdT = (bf16_t*)(ws + WS_WD); p.WrT = (float*)(ws + WS_WRT);
    p.HB = (bf16_t*)(ws + WS_A); p.OL = (bf16_t*)(ws + WS_A); p.H2B = (bf16_t*)(ws + WS_A);
    p.QL = (bf16_t*)(ws + WS_B); p.MB = (bf16_t*)(ws + WS_B); p.H2S = (bf16_t*)(ws + WS_B); p.YS = (bf16_t*)(ws + WS_B);
    p.GAB = (bf16_t*)(ws + WS_GA); p.GBB = (bf16_t*)(ws + WS_GB);
    p.UB = (bf16_t*)(ws + WS_C); p.VB = (bf16_t*)(ws + WS_C + 32 * MiB); p.MG = (bf16_t*)(ws + WS_C); p.HE = (bf16_t*)(ws + WS_C);
    p.QI = (bf16_t*)(ws + WS_DQ); p.US = (bf16_t*)(ws + WS_DQ);
    p.CKVR = (float*)(ws + WS_CKVR); p.CKVB = (bf16_t*)(ws + WS_CKVB); p.KI = (bf16_t*)(ws + WS_KI); p.WI = (float*)(ws + WS_WI); p.SEL = (unsigned short*)(ws + WS_SEL);
    p.EID = (int*)(ws + WS_MOE); p.EW = (float*)(ws + WS_MOE + 262144); p.PTOK = (int*)(ws + WS_MOE + 524288); p.MOEI = (int*)(ws + WS_MOE + 1048576);
    p.GU = (int*)(ws + WS_MOE + 1048576 + 4096); p.DN = (int*)(ws + WS_MOE + 1048576 + 4096 + 8192);
    if (first) { (void)hipFuncSetAttribute((const void*)k_mega, hipFuncAttributeMaxDynamicSharedMemorySize, LDS_BYTES); first = false; }
    hipLaunchKernelGGL(k_mega, dim3(grid), dim3(NTHR), LDS_BYTES, stream, p);
}
```

```cpp
#include <hip/hip_runtime.h>
#include <cstdio>
#include <cstdint>
__device__ __forceinline__ int opaque_tid(const int wv) { int l; asm volatile("v_mbcnt_lo_u32_b32 %0, -1, 0\n\tv_mbcnt_hi_u32_b32 %0, -1, %0" : "=v"(l)); return (wv << 6) + l; }
#define LAS __attribute__((address_space(3)))
namespace pg8 {
#define PG8_LAS __attribute__((address_space(3)))
typedef unsigned short bf16_t;
typedef short bf16x8 __attribute__((ext_vector_type(8)));
typedef float f32x4 __attribute__((ext_vector_type(4)));
typedef unsigned u32x4 __attribute__((ext_vector_type(4)));
constexpr int BM = 256, BK = 64, HALF = 128, HTB = HALF * BK * 2  , STAGE_BYTES = 8 * HTB, NXCD = 8, WGM = 8;

__host__ __device__ __forceinline__ int lds_byte(int r, int c) { const int st = (r >> 4) * 2 + (c >> 5), rr = r & 15, cc = c & 31, ob = rr * 64 + cc * 2; return st * 1024 + (ob ^ (((ob >> 9) & 1) << 5)); }
__host__ __device__ __forceinline__ void stage_rc(int b, int& R, int& C) { const int st = b / 1024, sb = b % 1024, swz = sb ^ (((sb >> 9) & 1) << 5); R = (st >> 1) * 16 + swz / 64; C = (st & 1) * 32 + (swz % 64) / 2; }
__host__ __device__ __forceinline__ int perm32(int rho) { const int n = rho >> 4, i = rho & 15; return 8 * (i >> 2) + 4 * n + (i & 3); }

struct Unit { int pm, pn; };
struct Gemm { const bf16_t* A; const bf16_t* Bt; int M, N, K; };

struct StaticOrder {
    int nM, nN, nwg, G, c;
    __host__ __device__ void init(int M, int N, int G_, int c_) { nM = M / BM; nN = N / BM; nwg = nM * nN; G = G_; c = c_; }
    __host__ __device__ bool next(int i, Unit& u) const {
        const long L = (long)i * G + c; if (L >= nwg) return false;
        int wgid = (int)L; { const int q = nwg / NXCD, r = nwg % NXCD, xcd = wgid % NXCD, off = wgid / NXCD; wgid = (xcd < r ? xcd * (q + 1) : r * (q + 1) + (xcd - r) * q) + off; }
        const int nig = WGM * nN, gid = wgid / nig, fm = gid * WGM, gsz = (nM - fm) < WGM ? (nM - fm) : WGM;
        u.pm = fm + ((wgid % nig) % gsz); u.pn = (wgid % nig) / gsz; return true;
    }
    __device__ __forceinline__ void a_ready(const Unit&) const {}
    __device__ __forceinline__ void done(const Unit&) const {}
};

__device__ __forceinline__ unsigned cvt_pk_bf16(float lo, float hi) { unsigned r; asm volatile("v_cvt_pk_bf16_f32 %0, %1, %2" : "=v"(r) : "v"(lo), "v"(hi)); return r; }
typedef float f32x2 __attribute__((ext_vector_type(2)));
template <class Epi, class Sched, bool ALIGN_EPI = false, bool SP2 = false>
__device__ __forceinline__ void gemm_phase(PG8_LAS unsigned char* lds, const Gemm g, const Sched& S, const Epi& E, const int wv) {
    const int tid = opaque_tid(wv), wid = __builtin_amdgcn_readfirstlane(tid >> 6), lane = tid & 63, wr = wid >> 2, wc = wid & 3, fr = lane & 15, fq = lane >> 4;
    const int K = g.K, nt = K / BK;
    unsigned voffA[2], voffB[2];
#pragma unroll
    for (int i = 0; i < 2; ++i) { int R, C; stage_rc(tid * 16 + i * 8192, R, C); const int Rb = Epi::PERM ? ((R & ~31) + perm32(R & 31)) : R;
        voffA[i] = (unsigned)(R * K + C) * 2u; voffB[i] = (unsigned)(Rb * K + C) * 2u; }
    const size_t kstep = (size_t)(BK * 2);
    const size_t hstep = (size_t)HALF * K * 2;
    const size_t tstep = 2 * hstep;
    const unsigned ldsw = (unsigned)wid * 1024u;
    const int aoff = lds_byte(wr * 64 + fr, fq * 8), boff = lds_byte(wc * 32 + fr, fq * 8);
#define PG8_SA(b, h) (((b) * 2 + (h)) * HTB)
#define PG8_SB(b, h) ((4 + (b) * 2 + (h)) * HTB)
#define PG8_STAGE(bufoff, gbase, voff) do { _Pragma("unroll") for (int _i = 0; _i < 2; ++_i) \
        __builtin_amdgcn_global_load_lds((const unsigned*)((const char*)(gbase) + (voff)[_i]), (PG8_LAS unsigned*)(lds + (bufoff) + ldsw + _i * 8192), 16, 0, 0); } while (0)
#define PG8_LDA(dst, b, h) do { _Pragma("unroll") for (int m = 0; m < 4; ++m) _Pragma("unroll") for (int k = 0; k < 2; ++k) dst[m][k] = *(const PG8_LAS bf16x8*)(lds + PG8_SA(b, h) + aoff + m * 2048 + k * 1024); } while (0)
#define PG8_LDB(dst, b, h) do { _Pragma("unroll") for (int n = 0; n < 2; ++n) _Pragma("unroll") for (int k = 0; k < 2; ++k) dst[n][k] = *(const PG8_LAS bf16x8*)(lds + PG8_SB(b, h) + boff + n * 2048 + k * 1024); } while (0)
#define PG8_MMA(ai, bj, At, Bt) do { __builtin_amdgcn_s_setprio(1); _Pragma("unroll") for (int m = 0; m < 4; ++m) _Pragma("unroll") for (int n = 0; n < 2; ++n) _Pragma("unroll") for (int k = 0; k < 2; ++k) \
        acc[ai][bj][m][n] = __builtin_amdgcn_mfma_f32_16x16x32_bf16(Bt[n][k], At[m][k], acc[ai][bj][m][n], 0, 0, 0); __builtin_amdgcn_s_setprio(0); } while (0)
#define PG8_WAIT_V(n) asm volatile("s_waitcnt vmcnt(" #n ")" ::: "memory")
#define PG8_WAIT_L(n) asm volatile("s_waitcnt lgkmcnt(" #n ")" ::: "memory")
#define PG8_BAR __builtin_amdgcn_s_barrier()
#define PG8_SCHED __builtin_amdgcn_sched_barrier(0)
    Unit cur, nxt; int ui = 0;
    if (!S.next(0, cur)) return;
    f32x4 acc[2][2][4][2];
#pragma unroll
    for (int a = 0; a < 2; ++a)
#pragma unroll
        for (int b = 0; b < 2; ++b)
#pragma unroll
            for (int m = 0; m < 4; ++m)
#pragma unroll
                for (int n = 0; n < 2; ++n) acc[a][b][m][n] = (f32x4){0.f, 0.f, 0.f, 0.f};
    bf16x8 At[4][2], B0[2][2], B1[2][2];
    const char* cA = (const char*)g.A + (size_t)cur.pm * tstep; const char* cB = (const char*)g.Bt + (size_t)cur.pn * tstep;
    S.a_ready(cur);
    if constexpr (SP2) {
        PG8_STAGE(PG8_SB(0, 0), cB, voffB); PG8_STAGE(PG8_SB(0, 1), cB + hstep, voffB); PG8_STAGE(PG8_SA(0, 0), cA, voffA); PG8_STAGE(PG8_SA(0, 1), cA + hstep, voffA);
        if (wr == 1) PG8_BAR;
        PG8_WAIT_V(2); PG8_BAR;
        PG8_STAGE(PG8_SB(1, 0), cB + kstep, voffB); PG8_STAGE(PG8_SA(1, 0), cA + kstep, voffA); PG8_STAGE(PG8_SB(1, 1), cB + hstep + kstep, voffB);
        PG8_WAIT_V(6); PG8_BAR;
    } else {
        PG8_STAGE(PG8_SB(0, 0), cB, voffB); PG8_STAGE(PG8_SA(0, 0), cA, voffA); PG8_STAGE(PG8_SB(0, 1), cB + hstep, voffB); PG8_STAGE(PG8_SA(0, 1), cA + hstep, voffA);
        if (wr == 1) PG8_BAR;
        PG8_WAIT_V(4); PG8_BAR;
        PG8_STAGE(PG8_SB(1, 0), cB + kstep, voffB); PG8_STAGE(PG8_SA(1, 0), cA + kstep, voffA); PG8_STAGE(PG8_SB(1, 1), cB + hstep + kstep, voffB);
        PG8_WAIT_V(6); PG8_BAR;
    }
    for (;;) {
        const bool has_next = S.next(ui + 1, nxt);
        const char* nA = has_next ? (const char*)g.A + (size_t)nxt.pm * tstep : cA; const char* nB = has_next ? (const char*)g.Bt + (size_t)nxt.pn * tstep : cB;
        for (int t = 0; t < nt; t += 2) {
            const bool last = (t == nt - 2);
            const char* a1 = cA + (size_t)(t + 1) * kstep;
            const char* a2 = last ? nA : cA + (size_t)(t + 2) * kstep; const char* b2 = last ? nB : cB + (size_t)(t + 2) * kstep;
            const char* a3 = a2 + kstep; const char* b3 = b2 + kstep;
            if (last && has_next) S.a_ready(nxt);
            if constexpr (SP2) {
            PG8_LDB(B0, 0, 0); PG8_LDB(B1, 0, 1); PG8_SCHED; PG8_LDA(At, 0, 0); PG8_STAGE(PG8_SA(1, 1), a1 + hstep, voffA);
            PG8_WAIT_V(8); PG8_WAIT_L(0); PG8_BAR; PG8_MMA(0, 0, At, B0); PG8_MMA(0, 1, At, B1); PG8_BAR; PG8_SCHED;
            PG8_LDA(At, 0, 1); PG8_STAGE(PG8_SB(0, 0), b2, voffB); PG8_STAGE(PG8_SB(0, 1), b2 + hstep, voffB); PG8_STAGE(PG8_SA(0, 0), a2, voffA);
            PG8_WAIT_V(8); PG8_WAIT_L(0); PG8_BAR; PG8_MMA(1, 0, At, B0); PG8_MMA(1, 1, At, B1); PG8_BAR; PG8_SCHED;
            PG8_LDB(B0, 1, 0); PG8_LDB(B1, 1, 1); PG8_SCHED; PG8_LDA(At, 1, 0); PG8_STAGE(PG8_SA(0, 1), a2 + hstep, voffA);
            PG8_WAIT_V(8); PG8_WAIT_L(0); PG8_BAR; PG8_MMA(0, 0, At, B0); PG8_MMA(0, 1, At, B1); PG8_BAR; PG8_SCHED;
            PG8_LDA(At, 1, 1); PG8_STAGE(PG8_SB(1, 0), b3, voffB); PG8_STAGE(PG8_SB(1, 1), b3 + hstep, voffB); PG8_STAGE(PG8_SA(1, 0), a3, voffA);
            PG8_WAIT_V(8); PG8_WAIT_L(0); PG8_BAR; PG8_MMA(1, 0, At, B0); PG8_MMA(1, 1, At, B1); PG8_BAR; PG8_SCHED;
            } else {
            PG8_LDB(B0, 0, 0); PG8_SCHED; PG8_LDA(At, 0, 0); PG8_STAGE(PG8_SA(1, 1), a1 + hstep, voffA);
            PG8_WAIT_L(8); PG8_BAR; PG8_WAIT_L(0); PG8_MMA(0, 0, At, B0); PG8_BAR; PG8_SCHED;
            PG8_LDB(B1, 0, 1); PG8_STAGE(PG8_SB(0, 0), b2, voffB);
            PG8_BAR; PG8_WAIT_L(0); PG8_MMA(0, 1, At, B1); PG8_BAR;
            PG8_LDA(At, 0, 1); PG8_STAGE(PG8_SA(0, 0), a2, voffA);
            PG8_BAR; PG8_WAIT_L(0); PG8_MMA(1, 0, At, B0); PG8_BAR; PG8_SCHED;
            PG8_STAGE(PG8_SB(0, 1), b2 + hstep, voffB);
            PG8_WAIT_V(6); PG8_BAR; PG8_MMA(1, 1, At, B1); PG8_BAR;
            PG8_LDB(B0, 1, 0); PG8_SCHED; PG8_LDA(At, 1, 0); PG8_STAGE(PG8_SA(0, 1), a2 + hstep, voffA);
            PG8_WAIT_L(8); PG8_BAR; PG8_WAIT_L(0); PG8_MMA(0, 0, At, B0); PG8_BAR; PG8_SCHED;
            PG8_LDB(B1, 1, 1); PG8_STAGE(PG8_SB(1, 0), b3, voffB);
            PG8_BAR; PG8_WAIT_L(0); PG8_MMA(0, 1, At, B1); PG8_BAR;
            PG8_LDA(At, 1, 1); PG8_STAGE(PG8_SA(1, 0), a3, voffA);
            PG8_BAR; PG8_WAIT_L(0); PG8_MMA(1, 0, At, B0); PG8_BAR; PG8_SCHED;
            PG8_STAGE(PG8_SB(1, 1), b3 + hstep, voffB);
            PG8_WAIT_V(6); PG8_BAR; PG8_MMA(1, 1, At, B1); PG8_BAR;
            }
        }
        if constexpr (ALIGN_EPI) { if (wr == 0) PG8_BAR; }
        if constexpr (!Epi::AFTER_DRAIN) { E(acc, cur, wr, wc, fr, fq); S.done(cur); }
        if (!has_next) break;
#pragma unroll
        for (int a = 0; a < 2; ++a)
#pragma unroll
            for (int b = 0; b < 2; ++b)
#pragma unroll
                for (int m = 0; m < 4; ++m)
#pragma unroll
                    for (int n = 0; n < 2; ++n) acc[a][b][m][n] = (f32x4){0.f, 0.f, 0.f, 0.f};
        cur = nxt; cA = nA; cB = nB; ++ui;
        if constexpr (ALIGN_EPI) { if (wr == 1) PG8_BAR; }
    }
    PG8_WAIT_V(0);
    if constexpr (!ALIGN_EPI) { if (wr == 0) PG8_BAR; }
    PG8_BAR;
    if constexpr (Epi::AFTER_DRAIN) { E.fused(acc, cur, wr, wc, fr, fq, lds, wid, lane); S.done(cur); }
#undef PG8_SA
#undef PG8_SB
#undef PG8_STAGE
#undef PG8_LDA
#undef PG8_LDB
#undef PG8_MMA
#undef PG8_WAIT_V
#undef PG8_WAIT_L
#undef PG8_BAR
#undef PG8_SCHED
}
}
#define XB_TMO      128
#define XB_XCNT(j)  (256  + 64 * (j))
#define XB_XSUB(j)  (1280 + 64 * (j))
#define XB_XGEN(j)  (2304 + 64 * (j))
#define XB_TOP      3328
#define XB_TOPGEN   3392
#define XCD_BAR_WORDS 3456
#define XB_SPIN_CAP (1u << 18)

__device__ __forceinline__ unsigned xb_ld(unsigned* p)              { return __hip_atomic_load(p, __ATOMIC_RELAXED, __HIP_MEMORY_SCOPE_AGENT); }
__device__ __forceinline__ unsigned xb_add(unsigned* p, unsigned v) { return __hip_atomic_fetch_add(p, v, __ATOMIC_RELAXED, __HIP_MEMORY_SCOPE_AGENT); }
__device__ __forceinline__ unsigned xb_xcc_id() { return (unsigned)__builtin_amdgcn_s_getreg((3 << 11) | 20) & 0xFu; }
#define XB_SPIN(cond, bar) do { unsigned _sp = 0; while (cond) { __builtin_amdgcn_s_sleep(1); \
    if ((++_sp & 255u) == 0u) { if (xb_ld(&(bar)[XB_TMO])) break; if (_sp > XB_SPIN_CAP) { atomicAdd(&(bar)[XB_TMO], 1u); break; } } } } while (0)

struct XcdBarrier {
    unsigned* bar; unsigned x; int wv;
    volatile LAS unsigned* st;
};

__device__ __forceinline__ XcdBarrier xcd_barrier_post(unsigned* bar, volatile LAS unsigned* st, int wv) {
    XcdBarrier b; b.bar = bar; b.x = xb_xcc_id(); b.st = st; b.wv = wv;
    if (opaque_tid(wv) == 0) (void)xb_add(&bar[XB_XCNT(b.x)], 1u);
    return b;
}
__device__ __forceinline__ void xcd_barrier_complete(unsigned* bar, unsigned x, unsigned& nloc, unsigned& nx) {
    const unsigned G = gridDim.x * gridDim.y * gridDim.z;
    unsigned sum, cnt, mine, sp = 0u;
    for (;;) {
        sum = 0u; cnt = 0u; mine = 0u;
#pragma unroll
        for (unsigned j = 0; j < 16; ++j) { const unsigned c = xb_ld(&bar[XB_XCNT(j)]); sum += c; cnt += (c > 0u) ? 1u : 0u; mine = (j == x) ? c : mine; }
        if (sum == G) break;
        __builtin_amdgcn_s_sleep(1);
        if ((++sp & 255u) == 0u) { if (xb_ld(&bar[XB_TMO])) break; if (sp > XB_SPIN_CAP) { atomicAdd(&bar[XB_TMO], 1u); break; } }
    }
    nloc = mine > 0u ? mine : 1u; nx = cnt > 0u ? cnt : 1u;
}

__device__ __forceinline__ void xcd_barrier(const XcdBarrier& b) {
    asm volatile("s_waitcnt vmcnt(0)" ::: "memory");
    __syncthreads();
    if (opaque_tid(b.wv) == 0) {
        unsigned* bar = b.bar;
        __builtin_amdgcn_s_waitcnt(0);
        unsigned nloc = b.st[0], nx = b.st[1];
        if (nloc == 0u) { xcd_barrier_complete(bar, b.x, nloc, nx); b.st[0] = nloc; b.st[1] = nx; }
        const unsigned old = xb_add(&bar[XB_XSUB(b.x)], 1u);
        const unsigned gen = old / nloc;
        if (old + 1u == (gen + 1u) * nloc) {
            __builtin_amdgcn_fence(__ATOMIC_RELEASE, "agent");
            asm volatile("s_waitcnt vmcnt(0)" ::: "memory");
            const unsigned og = xb_add(&bar[XB_TOP], 1u);
            const unsigned tg = og / nx;
            if (og + 1u == (tg + 1u) * nx) xb_add(&bar[XB_TOPGEN], 1u);
            else XB_SPIN(xb_ld(&bar[XB_TOPGEN]) == tg, bar);
            __builtin_amdgcn_fence(__ATOMIC_ACQUIRE, "agent");
            xb_add(&bar[XB_XGEN(b.x)], 1u);
            asm volatile("s_waitcnt vmcnt(0)" ::: "memory");
        } else {
            XB_SPIN(xb_ld(&bar[XB_XGEN(b.x)]) == gen, bar);
            __builtin_amdgcn_fence(__ATOMIC_ACQUIRE, "agent");
            asm volatile("s_waitcnt vmcnt(0)" ::: "memory");
        }
    }
    __syncthreads();
}

typedef unsigned short bf16_t;
typedef short bf16x8 __attribute__((ext_vector_type(8)));
typedef short bf16x4 __attribute__((ext_vector_type(4)));
typedef float f32x4 __attribute__((ext_vector_type(4)));
typedef float f32x16 __attribute__((ext_vector_type(16)));
typedef unsigned u32x4 __attribute__((ext_vector_type(4)));
typedef unsigned u32x2 __attribute__((ext_vector_type(2)));

constexpr int NB = 8, T = 4096, D = 1024, M = NB * T;
constexpr int INC = 4296;
constexpr int NIN = 19 * 256;
constexpr float EPS = 1e-6f;
constexpr int NPOS = 73728;
constexpr int NWAVES = 8, NTHR = 512;
constexpr int LDS_BYTES = 147456;

constexpr size_t MiB = 1u << 20;
constexpr size_t WS_CTL = 0, CTL_ZERO_BYTES = 65536;
constexpr size_t WS_WIN = 1 * MiB, WS_WOUT = 11 * MiB, WS_WPB = 13 * MiB, WS_WOV = 14 * MiB, WS_WSB = 16 * MiB, WS_WRT = 16 * MiB + 262144, WS_WGU = 17 * MiB, WS_WD = 49 * MiB;
constexpr size_t WS_A = 65 * MiB;
constexpr size_t WS_B = 129 * MiB;
constexpr size_t WS_GA = 193 * MiB, WS_GB = 257 * MiB;
constexpr size_t WS_C = 321 * MiB;
constexpr size_t WS_DQ = 385 * MiB;
constexpr size_t WS_CKVR = 417 * MiB, WS_CKVB = 433 * MiB, WS_KI = 441 * MiB, WS_WI = 445 * MiB, WS_SEL = 446 * MiB;
constexpr size_t WS_MOE = 462 * MiB;
constexpr size_t WS_END = 464 * MiB;

constexpr int CW_BAR = 4096;
constexpr int CW_CNT = 8192, CW_CUR = 8256;

struct P {
    const float *x, *w_in, *kv_g, *w_uk, *w_uv, *rel_bias, *ln_g, *ln_b, *w_sp, *b_sp, *w_pa, *w_pb, *w_out, *n1g, *n2g, *rg_w, *rg_b, *re_w, *re_b, *w_gate, *w_up, *w_down, *fg;
    float* out;
    unsigned* ctl;
    bf16_t *WinT, *WoutT, *WpbT, *WovT, *WSB, *WguT, *WdT;
    float* WrT;
    bf16_t *HB, *QL, *QI, *CKVB, *KI, *UB, *VB, *GAB, *GBB, *OL, *US, *MB, *MG, *H2B, *H2S, *HE, *YS;
    float *CKVR, *WI, *EW;
    unsigned short* SEL;
    int *EID, *PTOK, *MOEI, *GU, *DN, *BLKCNT, *CB;
};

__device__ __forceinline__ unsigned f2bf(float f) { unsigned u = __builtin_bit_cast(unsigned, f); return (u + 0x7fffu + ((u >> 16) & 1u)) >> 16; }
__device__ __forceinline__ unsigned pk2(float lo, float hi) { return f2bf(lo) | (f2bf(hi) << 16); }
__device__ __forceinline__ float bflo(unsigned w) { return __builtin_bit_cast(float, w << 16); }
__device__ __forceinline__ float bfhi(unsigned w) { return __builtin_bit_cast(float, w & 0xffff0000u); }
__device__ __forceinline__ float bf2f(unsigned short b) { return __builtin_bit_cast(float, (unsigned)b << 16); }
__device__ __forceinline__ float wave_sum(float v) {
#pragma unroll
    for (int o = 1; o < 64; o <<= 1) v += __shfl_xor(v, o);
    return v;
}
#define LDS_WAIT() asm volatile("s_waitcnt lgkmcnt(0)" ::: "memory")
__device__ __forceinline__ float gelu_t(float x) { const float z = 0.7978845608f * (x + 0.044715f * x * x * x); return x / (1.f + __expf(-2.f * z)); }
__device__ __forceinline__ float sigm(float x) { return 1.f / (1.f + __expf(-x)); }
__device__ __forceinline__ unsigned off_b(unsigned row, unsigned ch) { return 256u * row + 16u * (ch ^ (((row & 3) << 2) | ((row >> 2) & 3))); }
__device__ __forceinline__ bf16x4 tr_read(unsigned lds_addr) { bf16x4 r; asm volatile("ds_read_b64_tr_b16 %0, %1\n\ts_waitcnt lgkmcnt(0)" : "=&v"(r) : "v"(lds_addr) : "memory"); return r; }
__device__ __forceinline__ bf16x8 cat4(bf16x4 a, bf16x4 b) { bf16x8 r; r[0] = a[0]; r[1] = a[1]; r[2] = a[2]; r[3] = a[3]; r[4] = b[0]; r[5] = b[1]; r[6] = b[2]; r[7] = b[3]; return r; }
__device__ __forceinline__ unsigned lds_addr_of(LAS unsigned char* p) { return (unsigned)(unsigned long long)p; }

__device__ __forceinline__ void st8bf(bf16_t* p, const pg8::f32x4& a, const pg8::f32x4& b) {
    u32x4 w; w.x = pg8::cvt_pk_bf16(a[0], a[1]); w.y = pg8::cvt_pk_bf16(a[2], a[3]); w.z = pg8::cvt_pk_bf16(b[0], b[1]); w.w = pg8::cvt_pk_bf16(b[2], b[3]);
    *(u32x4*)p = w;
}
__device__ __forceinline__ void ld8bf(const bf16_t* p, pg8::f32x4& a, pg8::f32x4& b) {
    const u32x4 w = *(const u32x4*)p;
    a[0] = bflo(w.x); a[1] = bfhi(w.x); a[2] = bflo(w.y); a[3] = bfhi(w.y); b[0] = bflo(w.z); b[1] = bfhi(w.z); b[2] = bflo(w.w); b[3] = bfhi(w.w);
}

struct EpiIn {
    static constexpr bool PERM = true, AFTER_DRAIN = false;
    bf16_t *QL, *QI, *KI, *UB, *VB, *GAB, *GBB; float *CKVR, *WI;
    __device__ __forceinline__ void operator()(const pg8::f32x4 (&acc)[2][2][4][2], const pg8::Unit& u, int wr, int wc, int fr, int fq) const {
        const int row0 = u.pm * 256 + wr * 64 + fr, pn = u.pn, c8 = wc * 32 + 8 * fq;
        int mode; bf16_t* dst; int ld;
        if (pn < 4)       { mode = 0; dst = QL + pn * 256; ld = 1024; }
        else if (pn < 6)  { mode = 0; dst = QI + (pn - 4) * 256; ld = 512; }
        else if (pn == 6) { mode = 3; dst = KI; ld = 64; }
        else if (pn < 9)  { mode = 1; dst = UB + (pn - 7) * 256; ld = 512; }
        else if (pn < 11) { mode = 1; dst = VB + (pn - 9) * 256; ld = 512; }
        else if (pn < 15) { mode = 2; dst = GAB + (pn - 11) * 256; ld = 1024; }
        else              { mode = 2; dst = GBB + (pn - 15) * 256; ld = 1024; }
#pragma unroll
        for (int ai = 0; ai < 2; ++ai)
#pragma unroll
            for (int m = 0; m < 4; ++m) {
                const size_t row = (size_t)(row0 + ai * 128 + m * 16);
#pragma unroll
                for (int bj = 0; bj < 2; ++bj) {
                    pg8::f32x4 v0 = acc[ai][bj][m][0], v1 = acc[ai][bj][m][1];
                    if (mode == 3) {
                        if (bj == 0) { float* c = CKVR + row * 128 + c8; *(pg8::f32x4*)c = v0; *(pg8::f32x4*)(c + 4) = v1; }
                        else if (c8 < 64) st8bf(KI + row * 64 + c8, v0, v1);
                        else if (c8 == 64) { float* c = WI + row * 8; *(pg8::f32x4*)c = v0 * 0.044194174f; *(pg8::f32x4*)(c + 4) = v1 * 0.044194174f; }
                    } else {
                        if (mode == 1) {
#pragma unroll
                            for (int j = 0; j < 4; ++j) { v0[j] = gelu_t(v0[j]); v1[j] = gelu_t(v1[j]); }
                        } else if (mode == 2) {
#pragma unroll
                            for (int j = 0; j < 4; ++j) { v0[j] = sigm(v0[j]); v1[j] = sigm(v1[j]); }
                        }
                        st8bf(dst + row * ld + bj * 128 + c8, v0, v1);
                    }
                }
            }
    }
};

struct EpiMB {
    static constexpr bool PERM = true, AFTER_DRAIN = false;
    const bf16_t* G; bf16_t* O;
    __device__ __forceinline__ void operator()(const pg8::f32x4 (&acc)[2][2][4][2], const pg8::Unit& u, int wr, int wc, int fr, int fq) const {
        const int row0 = u.pm * 256 + wr * 64 + fr, col0 = u.pn * 256 + wc * 32 + 8 * fq;
#pragma unroll
        for (int ai = 0; ai < 2; ++ai)
#pragma unroll
            for (int m = 0; m < 4; ++m)
#pragma unroll
                for (int bj = 0; bj < 2; ++bj) {
                    const size_t o = (size_t)(row0 + ai * 128 + m * 16) * 1024 + col0 + bj * 128;
                    pg8::f32x4 g0, g1; ld8bf(G + o, g0, g1);
                    st8bf(O + o, acc[ai][bj][m][0] * g0, acc[ai][bj][m][1] * g1);
                }
    }
};
struct EpiMG {
    static constexpr bool PERM = true, AFTER_DRAIN = false;
    const bf16_t *G, *MBp; bf16_t* O;
    __device__ __forceinline__ void operator()(const pg8::f32x4 (&acc)[2][2][4][2], const pg8::Unit& u, int wr, int wc, int fr, int fq) const {
        const int row0 = u.pm * 256 + wr * 64 + fr, col0 = u.pn * 256 + wc * 32 + 8 * fq;
#pragma unroll
        for (int ai = 0; ai < 2; ++ai)
#pragma unroll
            for (int m = 0; m < 4; ++m)
#pragma unroll
                for (int bj = 0; bj < 2; ++bj) {
                    const size_t o = (size_t)(row0 + ai * 128 + m * 16) * 1024 + col0 + bj * 128;
                    pg8::f32x4 g0, g1, b0, b1; ld8bf(G + o, g0, g1); ld8bf(MBp + o, b0, b1);
                    st8bf(O + o, acc[ai][bj][m][0] * g0 + b0, acc[ai][bj][m][1] * g1 + b1);
                }
    }
};
struct EpiX1 {
    static constexpr bool PERM = true, AFTER_DRAIN = false;
    const float* X; float* O;
    __device__ __forceinline__ void operator()(const pg8::f32x4 (&acc)[2][2][4][2], const pg8::Unit& u, int wr, int wc, int fr, int fq) const {
        const int row0 = u.pm * 256 + wr * 64 + fr, col0 = u.pn * 256 + wc * 32 + 8 * fq;
#pragma unroll
        for (int ai = 0; ai < 2; ++ai)
#pragma unroll
            for (int m = 0; m < 4; ++m)
#pragma unroll
                for (int bj = 0; bj < 2; ++bj) {
                    const size_t o = (size_t)(row0 + ai * 128 + m * 16) * 1024 + col0 + bj * 128;
                    const pg8::f32x4 x0 = *(const pg8::f32x4*)(X + o), x1 = *(const pg8::f32x4*)(X + o + 4);
                    *(pg8::f32x4*)(O + o) = x0 + acc[ai][bj][m][0]; *(pg8::f32x4*)(O + o + 4) = x1 + acc[ai][bj][m][1];
                }
    }
};
struct EpiHE {
    static constexpr bool PERM = true, AFTER_DRAIN = false;
    bf16_t* HE;
    __device__ __forceinline__ void operator()(const pg8::f32x4 (&acc)[2][2][4][2], const pg8::Unit& u, int wr, int wc, int fr, int fq) const {
        const int row0 = u.pm * 256 + wr * 64 + fr, col0 = (u.pn & 1) * 128 + wc * 32 + 8 * fq;
#pragma unroll
        for (int ai = 0; ai < 2; ++ai)
#pragma unroll
            for (int m = 0; m < 4; ++m) {
                pg8::f32x4 h0, h1;
#pragma unroll
                for (int j = 0; j < 4; ++j) {
                    const float g0 = acc[ai][0][m][0][j], g1 = acc[ai][0][m][1][j];
                    h0[j] = g0 * sigm(g0) * acc[ai][1][m][0][j]; h1[j] = g1 * sigm(g1) * acc[ai][1][m][1][j];
                }
                st8bf(HE + (size_t)(row0 + ai * 128 + m * 16) * 256 + col0, h0, h1);
            }
    }
};
struct EpiDown {
    static constexpr bool PERM = true, AFTER_DRAIN = false;
    const int* PTOK; const float* EW; bf16_t* YS;
    __device__ __forceinline__ void operator()(const pg8::f32x4 (&acc)[2][2][4][2], const pg8::Unit& u, int wr, int wc, int fr, int fq) const {
        const int row0 = u.pm * 256 + wr * 64 + fr, col0 = (u.pn & 3) * 256 + wc * 32 + 8 * fq;
#pragma unroll
        for (int ai = 0; ai < 2; ++ai)
#pragma unroll
            for (int m = 0; m < 4; ++m) {
                const int ts = PTOK[row0 + ai * 128 + m * 16];
                if (ts >= 0) {
                    const float w = EW[ts];
                    bf16_t* d = YS + ((size_t)(ts & 1) * M + (size_t)(ts >> 1)) * 1024 + col0;
#pragma unroll
                    for (int bj = 0; bj < 2; ++bj) st8bf(d + bj * 128, acc[ai][bj][m][0] * w, acc[ai][bj][m][1] * w);
                }
            }
    }
};
struct TableOrder {
    const int* tab; const int* nunits; int G, c;
    __device__ __forceinline__ bool next(int i, pg8::Unit& u) const {
        const int idx = i * G + c; const int n = __builtin_nontemporal_load(nunits);
        if (idx >= n) return false;
        u.pm = tab[2 * idx]; u.pn = tab[2 * idx + 1]; return true;
    }
    __device__ __forceinline__ void a_ready(const pg8::Unit&) const {}
    __device__ __forceinline__ void done(const pg8::Unit&) const {}
};

__device__ __forceinline__ void tr_item(const float* src, int ld, int K, int NC, bf16_t* dst, LAS float* scr, int item, int lane) {
    const int nblk = NC / 32, kb = item / nblk, nb = item % nblk, k0 = 64 * kb, n0 = 32 * nb;
#pragma unroll 8
    for (int i = 0; i < 32; ++i) { const int kk = 2 * i + (lane >> 5); scr[kk * 33 + (lane & 31)] = src[(size_t)(k0 + kk) * ld + n0 + (lane & 31)]; }
    LDS_WAIT();
    const int c = lane & 7;
#pragma unroll
    for (int j = 0; j < 4; ++j) { const int n = (lane >> 3) + 8 * j; const LAS float* s = scr + (8 * c) * 33 + n;
        u32x4 o; o.x = pk2(s[0 * 33], s[1 * 33]); o.y = pk2(s[2 * 33], s[3 * 33]); o.z = pk2(s[4 * 33], s[5 * 33]); o.w = pk2(s[6 * 33], s[7 * 33]);
        *(u32x4*)(dst + (size_t)(n0 + n) * K + k0 + 8 * c) = o; }
    LDS_WAIT();
}

__device__ __forceinline__ void ph_prep(const P& p, LAS unsigned char* lds, const int wv) {
    const int tid = opaque_tid(wv), lane = tid & 63, wave = __builtin_amdgcn_readfirstlane(tid >> 6);
    LAS float* scr = (LAS float*)(lds + wave * 16384);
    const int gw = blockIdx.x * NWAVES + wave, NGW = gridDim.x * NWAVES;
    const int gt = blockIdx.x * NTHR + tid, NGT = gridDim.x * NTHR;
    {
        const int c0s[7] = {640, 512, 1152, 1224, 1736, 2248, 3272};
        const int ncs[7] = {512, 128, 64, 512, 512, 1024, 1024};
        const int r0s[7] = {1024, 1536, 1664, 1792, 2304, 2816, 3840};
#pragma unroll
        for (int s = 0; s < 7; ++s) {
            const int nit = 16 * (ncs[s] / 32);
            for (int it = gw; it < nit; it += NGW) tr_item(p.w_in + c0s[s], INC, 1024, ncs[s], p.WinT + (size_t)r0s[s] * 1024, scr, it, lane);
        }
    }
    for (int i = gt; i < 64 * 1024; i += NGT) { const int j = i >> 10, k = i & 1023; p.WinT[(size_t)(1728 + j) * 1024 + k] = j < 8 ? (bf16_t)f2bf(p.w_in[(size_t)k * INC + 1216 + j]) : (bf16_t)0; }
    for (int it = gw; it < 512; it += NGW) tr_item(p.w_out, 1024, 1024, 1024, p.WoutT, scr, it, lane);
    for (int it = gw; it < 256; it += NGW) tr_item(p.w_pb, 1024, 512, 1024, p.WpbT, scr, it, lane);
    for (int it = gw; it < 8192; it += NGW) {
        const int sub = it & 63, q = it >> 6, gu = q & 1, j = (q >> 1) & 1, e = q >> 2;
        const float* src = (gu ? p.w_up : p.w_gate) + (size_t)e * 262144 + 128 * j;
        tr_item(src, 256, 1024, 128, p.WguT + ((size_t)e * 512 + j * 256 + gu * 128) * 1024, scr, sub, lane);
    }
    for (int it = gw; it < 4096; it += NGW) { const int sub = it & 127, e = it >> 7; tr_item(p.w_down + (size_t)e * 262144, 1024, 256, 1024, p.WdT + (size_t)e * 262144, scr, sub, lane); }
    for (int i = gt; i < 1024 * 1024; i += NGT) {
        const int n = i >> 10, k = i & 1023, h = n >> 7, r = n & 127;
        const float* a = p.w_in + (size_t)k * INC + h * 64; const float* b = p.w_uk + (size_t)(r * 8 + h) * 64;
        float s = 0.f;
#pragma unroll 16
        for (int d = 0; d < 64; ++d) s += a[d] * b[d];
        p.WinT[(size_t)n * 1024 + k] = (bf16_t)f2bf(0.125f * s);
    }
    for (int i = gt; i < 1024 * 1024; i += NGT) {
        const int n = i >> 10, k = i & 1023, h = k >> 7, r = k & 127;
        const float* a = p.w_uv + (size_t)(r * 8 + h) * 64; const float* b = p.w_pa + (size_t)(h * 64) * 1024 + n;
        float s = 0.f;
#pragma unroll 16
        for (int d = 0; d < 64; ++d) s += a[d] * b[(size_t)d * 1024];
        p.WovT[(size_t)n * 1024 + k] = (bf16_t)f2bf(s);
    }
    for (int i = gt; i < 4 * 128 * 128; i += NGT) { const int jj = i & 127, ii = (i >> 7) & 127; p.WSB[i] = jj <= ii ? (bf16_t)f2bf(p.w_sp[i]) : (bf16_t)0; }
    for (int i = gt; i < 36 * 1024; i += NGT) { const int c = i >> 10, k = i & 1023; p.WrT[i] = c < 4 ? p.rg_w[k * 4 + c] : p.re_w[k * 32 + (c - 4)]; }
    for (int m = gw; m < M; m += NGW) {
        const f32x4* xr = (const f32x4*)(p.x + (size_t)m * D) + lane;
        f32x4 v[4]; float s = 0.f;
#pragma unroll
        for (int j = 0; j < 4; ++j) { v[j] = xr[64 * j]; s += (v[j].x * v[j].x + v[j].y * v[j].y) + (v[j].z * v[j].z + v[j].w * v[j].w); }
        const float rinv = 1.0f / sqrtf(wave_sum(s) * (1.f / D) + EPS);
        unsigned long long* o8 = (unsigned long long*)(p.HB + (size_t)m * D) + lane;
#pragma unroll
        for (int j = 0; j < 4; ++j) { const f32x4 g = ((const f32x4*)p.n1g)[lane + 64 * j]; const f32x4 o = v[j] * rinv * g;
            o8[64 * j] = (unsigned long long)pk2(o.x, o.y) | ((unsigned long long)pk2(o.z, o.w) << 32); }
    }
}

__device__ __forceinline__ void ph_ckvnorm(const P& p, const int wv) {
    const int tid = opaque_tid(wv), lane = tid & 63, wave = tid >> 6;
    const int gw = blockIdx.x * NWAVES + wave, NGW = gridDim.x * NWAVES;
    const float g0 = p.kv_g[2 * lane], g1 = p.kv_g[2 * lane + 1];
    for (int m = gw; m < M; m += NGW) {
        const float2 v = ((const float2*)(p.CKVR + (size_t)m * 128))[lane];
        const float rinv = 1.0f / sqrtf(wave_sum(v.x * v.x + v.y * v.y) * (1.f / 128.f) + EPS);
        ((unsigned*)(p.CKVB + (size_t)m * 128))[lane] = pk2(v.x * rinv * g0, v.y * rinv * g1);
    }
}

__device__ __forceinline__ unsigned fkey(float x) { x = x + 0.0f; const unsigned u = __builtin_bit_cast(unsigned, x); return (u & 0x80000000u) ? ~u : (u | 0x80000000u); }

__device__ __forceinline__ void select_row(const LAS float* row, int n, LAS unsigned* hist, unsigned short* out, int lane) {
    if (n <= 256) {
#pragma unroll
        for (int i = 0; i < 4; ++i) { const int k = lane + 64 * i; out[k] = (unsigned short)(k < n ? k : 0); }
        return;
    }
    unsigned prefix = 0; int need = 256;
    const unsigned long long lt = (1ull << lane) - 1ull;
#pragma unroll 1
    for (int pass = 3; pass >= 0; --pass) {
#pragma unroll
        for (int i = 0; i < 4; ++i) hist[lane + 64 * i] = 0u;
        LDS_WAIT();
        const int shift = pass * 8;
        for (int i = lane; i < n; i += 64) {
            const unsigned k = fkey(row[i]);
            const bool match = (pass == 3) || ((k >> (shift + 8)) == prefix);
            if (match) __hip_atomic_fetch_add(hist + ((k >> shift) & 255u), 1u, __ATOMIC_RELAXED, __HIP_MEMORY_SCOPE_WORKGROUP);
        }
        LDS_WAIT();
        const unsigned c0 = hist[4 * lane], c1 = hist[4 * lane + 1], c2 = hist[4 * lane + 2], c3 = hist[4 * lane + 3];
        const unsigned s = c0 + c1 + c2 + c3;
        unsigned incl = s;
#pragma unroll
        for (int o = 1; o < 64; o <<= 1) { const unsigned t = __shfl_down(incl, o); if (lane + o < 64) incl += t; }
        const unsigned excl = incl - s;
        const bool mine = (excl < (unsigned)need) && (incl >= (unsigned)need);
        unsigned bin = 0, above = 0;
        if (mine) {
            unsigned run = excl;
            if (run + c3 >= (unsigned)need) { bin = 4 * lane + 3; above = run; }
            else { run += c3;
                if (run + c2 >= (unsigned)need) { bin = 4 * lane + 2; above = run; }
                else { run += c2;
                    if (run + c1 >= (unsigned)need) { bin = 4 * lane + 1; above = run; }
                    else { run += c1; bin = 4 * lane; above = run; } } }
        }
        const unsigned long long bm = __ballot(mine);
        const int src = bm ? (int)__builtin_ctzll(bm) : 0;
        bin = __shfl(bin, src); above = __shfl(above, src);
        need -= (int)above; prefix = (prefix << 8) | bin;
        LDS_WAIT();
    }
    const unsigned Tk = prefix;
    int cnt = 0, eq_taken = 0;
    for (int i0 = 0; i0 < n; i0 += 64) {
        const int i = i0 + lane; const bool valid = i < n;
        const unsigned k = valid ? fkey(row[i]) : 0u;
        const bool gtk = valid && (k > Tk), eqk = valid && (k == Tk);
        const unsigned long long beq = __ballot(eqk);
        const int eq_rank = eq_taken + __builtin_popcountll(beq & lt);
        const bool take = gtk || (eqk && eq_rank < need);
        const unsigned long long bt = __ballot(take);
        const int pos = cnt + __builtin_popcountll(bt & lt);
        if (take && pos < 256) out[pos] = (unsigned short)i;
        cnt += __builtin_popcountll(bt); eq_taken += __builtin_popcountll(beq);
    }
}

__device__ __forceinline__ void ph_index(const P& p, LAS unsigned char* lds, const int wv) {
    LAS float* Irow = (LAS float*)lds;
    LAS unsigned* hist = (LAS unsigned*)(lds + 131072);
    const int tid = opaque_tid(wv), lane = tid & 63, wave = __builtin_amdgcn_readfirstlane(tid >> 6);
    const int hh = lane >> 5, n = lane & 31;
    const int rho = lane & 31, qlA = 2 * ((rho >> 2) & 1) + (rho >> 4), hdA = (rho & 3) + 4 * ((rho >> 3) & 1);
    for (int u = blockIdx.x; u < 4096; u += gridDim.x) {
        const int b = u & 7, tb = 511 - (u >> 3), t0 = tb * 8; const size_t mb = (size_t)b * T;
        bf16x8 A[2][4]; float wq[2][16];
#pragma unroll
        for (int mt = 0; mt < 2; ++mt) {
            const bf16_t* src = p.QI + (mb + t0 + mt * 4 + qlA) * 512 + hdA * 64 + 8 * hh;
#pragma unroll
            for (int s = 0; s < 4; ++s) A[mt][s] = *(const bf16x8*)(src + 16 * s);
#pragma unroll
            for (int c = 0; c < 2; ++c) {
                const float* wp = p.WI + (mb + t0 + mt * 4 + 2 * hh + c) * 8;
                const f32x4 w0 = *(const f32x4*)wp, w1 = *(const f32x4*)(wp + 4);
#pragma unroll
                for (int j = 0; j < 4; ++j) { wq[mt][c * 8 + j] = w0[j]; wq[mt][c * 8 + 4 + j] = w1[j]; }
            }
        }
        const int nkt = (t0 + 8 + 31) >> 5;
        for (int kt = wave; kt < nkt; kt += NWAVES) {
            const int key = kt * 32 + n;
            const bf16_t* kp = p.KI + (mb + key) * 64 + 8 * hh;
            bf16x8 B[4];
#pragma unroll
            for (int s = 0; s < 4; ++s) B[s] = *(const bf16x8*)(kp + 16 * s);
#pragma unroll
            for (int mt = 0; mt < 2; ++mt) {
                f32x16 acc;
#pragma unroll
                for (int j = 0; j < 16; ++j) acc[j] = 0.f;
#pragma unroll
                for (int s = 0; s < 4; ++s) acc = __builtin_amdgcn_mfma_f32_32x32x16_bf16(A[mt][s], B[s], acc, 0, 0, 0);
#pragma unroll
                for (int c = 0; c < 2; ++c) {
                    float v = 0.f;
#pragma unroll
                    for (int h = 0; h < 8; ++h) v += wq[mt][c * 8 + h] * fmaxf(acc[c * 8 + h], 0.f);
                    Irow[(mt * 4 + 2 * hh + c) * 4096 + key] = v;
                }
            }
        }
        __syncthreads();
        select_row(Irow + wave * 4096, t0 + wave + 1, hist + wave * 256, p.SEL + (mb + t0 + wave) * 256, lane);
        __syncthreads();
    }
}

__device__ __forceinline__ bf16x4 tr16(const LAS unsigned char* a) { return __builtin_amdgcn_ds_read_tr16_b64_v4i16((LAS bf16x4*)a); }
__device__ __forceinline__ void ph_attn(const P& p, LAS unsigned char* lds, const int wv) {
    const int tid = opaque_tid(wv), lane = tid & 63, wave = __builtin_amdgcn_readfirstlane(tid >> 6);
    LAS unsigned char* buf = lds + wave * 8192;
    LAS unsigned char* selL = lds + 65536 + wave * 512;
    LAS unsigned char* tblb = lds + 69632;
    LAS float* bias = (LAS float*)(lds + 69632 + 128);
    LAS float* cst = (LAS float*)(lds + 69632 + 128 + 1024);
    for (int i = tid; i < 128; i += NTHR) {
        int bk = i;
        if (i >= 16) { const float nf = (float)i; bk = 16 + (int)(logf(nf / 16.f) / 2.0794415f * 16.f); if (bk > 31) bk = 31; }
        tblb[i] = (unsigned char)bk;
    }
    for (int i = tid; i < 256; i += NTHR) bias[i] = p.rel_bias[i];
    if (wave == 0) {
        float gm = fmaxf(fabsf(p.kv_g[lane]), fabsf(p.kv_g[lane + 64]));
        float bm = fmaxf(fmaxf(fabsf(p.rel_bias[lane]), fabsf(p.rel_bias[lane + 64])), fmaxf(fabsf(p.rel_bias[lane + 128]), fabsf(p.rel_bias[lane + 192])));
#pragma unroll
        for (int o = 1; o < 64; o <<= 1) { gm = fmaxf(gm, __shfl_xor(gm, o)); bm = fmaxf(bm, __shfl_xor(bm, o)); }
        if (lane == 0) { cst[0] = 11.3137085f * gm * 1.01f; cst[1] = bm; }
    }
    __syncthreads();
    const int g = lane >> 4, hcol = lane & 15, q4 = hcol >> 2, p4 = lane & 3;
    const float cmax = cst[0], bmax = cst[1];
    const int G = gridDim.x, bx = blockIdx.x, vcu = (G % 8 == 0) ? (bx % 8) * (G / 8) + bx / 8 : bx;
    for (int qc = vcu; qc < M / 128; qc += G) {
#pragma unroll 1
        for (int qi = 0; qi < 16; ++qi) {
            const int m = qc * 128 + wave * 16 + qi;
            const int t = m & (T - 1); const size_t mb = (size_t)(m >> 12) * T;
            const int nvalid = t + 1 < 256 ? t + 1 : 256;
            const u32x2 sv = *(const u32x2*)(p.SEL + (size_t)m * 256 + 4 * lane);
            bf16x8 qf[4];
#pragma unroll
            for (int s = 0; s < 4; ++s) {
                bf16x8 z;
#pragma unroll
                for (int j = 0; j < 8; ++j) z[j] = 0;
                qf[s] = hcol < 8 ? *(const bf16x8*)(p.QL + (size_t)m * 1024 + hcol * 128 + 32 * s + 8 * g) : z;
            }
            *(LAS u32x2*)(selL + lane * 8) = sv;
            float ss = 0.f;
#pragma unroll
            for (int s = 0; s < 4; ++s)
#pragma unroll
                for (int j = 0; j < 8; ++j) { const float v = bf2f((unsigned short)qf[s][j]); ss += v * v; }
            ss += __shfl_xor(ss, 16); ss += __shfl_xor(ss, 32);
            const float mh = sqrtf(ss) * cmax + bmax;
            bf16x8 st[2][4];
#define ATT_LOAD_CHUNK(c) do { _Pragma("unroll") for (int tau = 0; tau < 2; ++tau) { const int kp = 32 * (c) + 16 * tau + hcol; \
                const int key = kp < nvalid ? (int)*(const LAS unsigned short*)(selL + 2 * kp) : 0; const bf16_t* crow = p.CKVB + (mb + key) * 128 + 8 * g; \
                _Pragma("unroll") for (int s = 0; s < 4; ++s) st[tau][s] = *(const bf16x8*)(crow + 32 * s); } } while (0)
            ATT_LOAD_CHUNK(0);
            f32x4 o[8];
#pragma unroll
            for (int rt = 0; rt < 8; ++rt) o[rt] = (f32x4){0.f, 0.f, 0.f, 0.f};
            float lsum = 0.f;
#pragma unroll 1
            for (int c = 0; c < 8; ++c) {
                f32x4 acc[2];
#pragma unroll
                for (int tau = 0; tau < 2; ++tau) {
                    acc[tau] = (f32x4){0.f, 0.f, 0.f, 0.f};
#pragma unroll
                    for (int s = 0; s < 4; ++s) {
                        *(LAS bf16x8*)(buf + off_b(16 * tau + hcol, 4 * s + g)) = st[tau][s];
                        acc[tau] = __builtin_amdgcn_mfma_f32_16x16x32_bf16(st[tau][s], qf[s], acc[tau], 0, 0, 0);
                    }
                }
                if (c < 7) ATT_LOAD_CHUNK(c + 1);
                float pr[2][4];
#pragma unroll
                for (int tau = 0; tau < 2; ++tau) {
                    const int kp0 = 32 * c + 16 * tau + 4 * g;
                    const u32x2 kk = *(const LAS u32x2*)(selL + 2 * kp0);
                    const int keys[4] = {(int)(kk.x & 0xffffu), (int)(kk.x >> 16), (int)(kk.y & 0xffffu), (int)(kk.y >> 16)};
#pragma unroll
                    for (int r = 0; r < 4; ++r) {
                        const int dist = t - keys[r]; const bool valid = (kp0 + r) < nvalid;
                        const int dcl = dist < 0 ? 0 : (dist > 127 ? 127 : dist);
                        const int bk = dist < 128 ? (int)tblb[dcl] : 31;
                        const float e = __expf(acc[tau][r] + bias[bk * 8 + (hcol & 7)] - mh);
                        pr[tau][r] = valid ? e : 0.f; lsum += pr[tau][r];
                    }
                }
                u32x4 pw; pw.x = pk2(pr[0][0], pr[0][1]); pw.y = pk2(pr[0][2], pr[0][3]); pw.z = pk2(pr[1][0], pr[1][1]); pw.w = pk2(pr[1][2], pr[1][3]);
                const bf16x8 pf = __builtin_bit_cast(bf16x8, pw);
#pragma unroll
                for (int rt = 0; rt < 8; ++rt) {
                    const unsigned row0 = 4 * g + q4, ch = 2 * rt + (p4 >> 1);
                    const bf16x4 a0 = tr16(buf + off_b(row0, ch) + 8 * (p4 & 1));
                    const bf16x4 a1 = tr16(buf + off_b(row0 + 16, ch) + 8 * (p4 & 1));
                    o[rt] = __builtin_amdgcn_mfma_f32_16x16x32_bf16(cat4(a0, a1), pf, o[rt], 0, 0, 0);
                }
            }
#undef ATT_LOAD_CHUNK
            lsum += __shfl_xor(lsum, 16); lsum += __shfl_xor(lsum, 32);
            const float inv = 1.f / lsum;
            if (hcol < 8) {
#pragma unroll
                for (int rt = 0; rt < 8; ++rt) {
                    u32x2 w; w.x = pk2(o[rt][0] * inv, o[rt][1] * inv); w.y = pk2(o[rt][2] * inv, o[rt][3] * inv);
                    *(u32x2*)(p.OL + (size_t)m * 1024 + hcol * 128 + 16 * rt + 4 * g) = w;
                }
            }
        }
    }
}

__device__ __forceinline__ void ph_gmlp(const P& p, LAS unsigned char* lds, const int wv) {
    const int tid = opaque_tid(wv), lane = tid & 63, wave = __builtin_amdgcn_readfirstlane(tid >> 6);
    LAS unsigned char* vt = lds;
    LAS float* st = (LAS float*)(lds + 32768);
    const unsigned vbase = lds_addr_of(vt);
    const int g4 = lane >> 4, q4 = (lane & 15) >> 2, p4 = lane & 3;
    for (int u = blockIdx.x; u < 256; u += gridDim.x) {
        const size_t m0 = (size_t)u * 128;
        for (int rr = 0; rr < 16; ++rr) {
            const int row = 16 * wave + rr;
            const u32x4 w = *(const u32x4*)(p.VB + (m0 + row) * 512 + lane * 8);
            const float x0 = bflo(w.x), x1 = bfhi(w.x), x2 = bflo(w.y), x3 = bfhi(w.y), x4 = bflo(w.z), x5 = bfhi(w.z), x6 = bflo(w.w), x7 = bfhi(w.w);
            const float mean = wave_sum(((x0 + x1) + (x2 + x3)) + ((x4 + x5) + (x6 + x7))) * (1.f / 512.f);
            const float d0 = x0 - mean, d1 = x1 - mean, d2 = x2 - mean, d3 = x3 - mean, d4 = x4 - mean, d5 = x5 - mean, d6 = x6 - mean, d7 = x7 - mean;
            const float var = wave_sum(((d0 * d0 + d1 * d1) + (d2 * d2 + d3 * d3)) + ((d4 * d4 + d5 * d5) + (d6 * d6 + d7 * d7))) * (1.f / 512.f);
            if (lane == 0) { st[2 * row] = mean; st[2 * row + 1] = 1.0f / sqrtf(var + EPS); }
        }
        __syncthreads();
#pragma unroll 1
        for (int g = 0; g < 4; ++g) {
#pragma unroll
            for (int i = 0; i < 4; ++i) {
                const int piece = i * NTHR + tid, row = piece >> 4, ch = piece & 15;
                const u32x4 w = *(const u32x4*)(p.VB + (m0 + row) * 512 + g * 128 + ch * 8);
                const float mean = st[2 * row], rstd = st[2 * row + 1];
                const f32x4 ga = *(const f32x4*)(p.ln_g + g * 128 + ch * 8), gb = *(const f32x4*)(p.ln_g + g * 128 + ch * 8 + 4);
                const f32x4 ba = *(const f32x4*)(p.ln_b + g * 128 + ch * 8), bb = *(const f32x4*)(p.ln_b + g * 128 + ch * 8 + 4);
                u32x4 o;
                o.x = pk2((bflo(w.x) - mean) * rstd * ga[0] + ba[0], (bfhi(w.x) - mean) * rstd * ga[1] + ba[1]);
                o.y = pk2((bflo(w.y) - mean) * rstd * ga[2] + ba[2], (bfhi(w.y) - mean) * rstd * ga[3] + ba[3]);
                o.z = pk2((bflo(w.z) - mean) * rstd * gb[0] + bb[0], (bfhi(w.z) - mean) * rstd * gb[1] + bb[1]);
                o.w = pk2((bflo(w.w) - mean) * rstd * gb[2] + bb[2], (bfhi(w.w) - mean) * rstd * gb[3] + bb[3]);
                *(LAS u32x4*)(vt + off_b(row, ch)) = o;
            }
            __syncthreads();
            f32x4 acc[8];
#pragma unroll
            for (int et = 0; et < 8; ++et) acc[et] = (f32x4){0.f, 0.f, 0.f, 0.f};
            const int nks = ((16 * wave + 15) >> 5) + 1;
#pragma unroll
            for (int ks = 0; ks < 4; ++ks) {
                if (ks < nks) {
                    const bf16x8 a = *(const bf16x8*)(p.WSB + ((size_t)g * 128 + 16 * wave + (lane & 15)) * 128 + 32 * ks + 8 * g4);
#pragma unroll
                    for (int et = 0; et < 8; ++et) {
                        const unsigned r0 = 32 * ks + 8 * g4 + q4, ch = 2 * et + (p4 >> 1);
                        const bf16x4 b0 = tr_read(vbase + off_b(r0, ch) + 8 * (p4 & 1));
                        const bf16x4 b1 = tr_read(vbase + off_b(r0 + 4, ch) + 8 * (p4 & 1));
                        acc[et] = __builtin_amdgcn_mfma_f32_16x16x32_bf16(a, cat4(b0, b1), acc[et], 0, 0, 0);
                    }
                }
            }
#pragma unroll
            for (int r = 0; r < 4; ++r) {
                const int i = 16 * wave + 4 * g4 + r; const float bs = p.b_sp[g * 128 + i];
#pragma unroll
                for (int et = 0; et < 8; ++et) {
                    const size_t o = (m0 + i) * 512 + g * 128 + 16 * et + (lane & 15);
                    p.US[o] = (bf16_t)f2bf(bf2f(p.UB[o]) * (acc[et][r] + bs));
                }
            }
            __syncthreads();
        }
    }
}

__device__ __forceinline__ float dot16(const f32x4 (&hv)[4], const float* wr, int lane) {
    float s = 0.f;
#pragma unroll
    for (int j = 0; j < 4; ++j) { const f32x4 w = ((const f32x4*)wr)[lane + 64 * j]; s += (hv[j].x * w.x + hv[j].y * w.y) + (hv[j].z * w.z + hv[j].w * w.w); }
    return s;
}
__device__ __forceinline__ void ph_router(const P& p, LAS unsigned char* lds, const int wv) {
    const int tid = opaque_tid(wv), lane = tid & 63, wave = __builtin_amdgcn_readfirstlane(tid >> 6);
    LAS unsigned* cnt = (LAS unsigned*)lds;
    const float* X1 = p.out;
    for (int c = blockIdx.x; c < M / 128; c += gridDim.x) {
        if (tid < 32) cnt[tid] = 0u;
        __syncthreads();
#pragma unroll 1
        for (int it = 0; it < 8; ++it) {
            const int m = c * 128 + wave * 16 + it * 2;
            f32x4 hv[2][4];
#pragma unroll
            for (int rr = 0; rr < 2; ++rr) {
                const f32x4* xr = (const f32x4*)(X1 + (size_t)(m + rr) * D) + lane;
#pragma unroll
                for (int j = 0; j < 4; ++j) hv[rr][j] = xr[64 * j];
            }
#pragma unroll
            for (int rr = 0; rr < 2; ++rr) {
                float s = 0.f;
#pragma unroll
                for (int j = 0; j < 4; ++j) s += (hv[rr][j].x * hv[rr][j].x + hv[rr][j].y * hv[rr][j].y) + (hv[rr][j].z * hv[rr][j].z + hv[rr][j].w * hv[rr][j].w);
                const float rinv = 1.0f / sqrtf(wave_sum(s) * (1.f / D) + EPS);
                unsigned long long* o8 = (unsigned long long*)(p.H2B + (size_t)(m + rr) * D) + lane;
#pragma unroll
                for (int j = 0; j < 4; ++j) { const f32x4 g = ((const f32x4*)p.n2g)[lane + 64 * j]; hv[rr][j] = hv[rr][j] * rinv * g;
                    o8[64 * j] = (unsigned long long)pk2(hv[rr][j].x, hv[rr][j].y) | ((unsigned long long)pk2(hv[rr][j].z, hv[rr][j].w) << 32); }
            }
            float gl[2][4];
#pragma unroll
            for (int cc = 0; cc < 4; ++cc) {
#pragma unroll
                for (int rr = 0; rr < 2; ++rr) gl[rr][cc] = dot16(hv[rr], p.WrT + cc * 1024, lane);
                asm volatile("" ::: "memory");
            }
#pragma unroll
            for (int rr = 0; rr < 2; ++rr)
#pragma unroll
                for (int cc = 0; cc < 4; ++cc) gl[rr][cc] = wave_sum(gl[rr][cc]) + p.rg_b[cc];
            int gi[2]; float gwt[2];
#pragma unroll
            for (int rr = 0; rr < 2; ++rr) {
                int g = 0; float gm = gl[rr][0];
#pragma unroll
                for (int i = 1; i < 4; ++i) if (gl[rr][i] > gm) { gm = gl[rr][i]; g = i; }
                float gs = 0.f;
#pragma unroll
                for (int i = 0; i < 4; ++i) gs += __expf(gl[rr][i] - gm);
                gi[rr] = __builtin_amdgcn_readfirstlane(g); gwt[rr] = 1.f / gs;
            }
            float el[2][8];
#pragma unroll
            for (int cc = 0; cc < 8; ++cc) {
#pragma unroll
                for (int rr = 0; rr < 2; ++rr) el[rr][cc] = dot16(hv[rr], p.WrT + (size_t)(4 + gi[rr] * 8 + cc) * 1024, lane);
                asm volatile("" ::: "memory");
            }
#pragma unroll
            for (int rr = 0; rr < 2; ++rr)
#pragma unroll
                for (int cc = 0; cc < 8; ++cc) el[rr][cc] = wave_sum(el[rr][cc]) + p.re_b[gi[rr] * 8 + cc];
#pragma unroll
            for (int rr = 0; rr < 2; ++rr) {
                int i1 = 0; float m1 = el[rr][0];
#pragma unroll
                for (int j = 1; j < 8; ++j) if (el[rr][j] > m1) { m1 = el[rr][j]; i1 = j; }
                int i2 = 0; float m2 = -INFINITY;
#pragma unroll
                for (int j = 0; j < 8; ++j) if (j != i1 && el[rr][j] > m2) { m2 = el[rr][j]; i2 = j; }
                const float e2r = __expf(m2 - m1), e1 = 1.f / (1.f + e2r), e2 = e2r * e1;
                if (lane == 0) {
                    const int ea = gi[rr] * 8 + i1, eb = gi[rr] * 8 + i2;
                    p.EID[2 * (m + rr)] = ea; p.EID[2 * (m + rr) + 1] = eb;
                    p.EW[2 * (m + rr)] = gwt[rr] * e1; p.EW[2 * (m + rr) + 1] = gwt[rr] * e2;
                    __hip_atomic_fetch_add(cnt + ea, 1u, __ATOMIC_RELAXED, __HIP_MEMORY_SCOPE_WORKGROUP);
                    __hip_atomic_fetch_add(cnt + eb, 1u, __ATOMIC_RELAXED, __HIP_MEMORY_SCOPE_WORKGROUP);
                }
            }
        }
        __syncthreads();
        if (tid < 32) p.BLKCNT[c * 32 + tid] = (int)cnt[tid];
        __syncthreads();
    }
}

__device__ __forceinline__ void ph_scan(const P& p, LAS unsigned char* lds, const int wv) {
    if (blockIdx.x != 0) return;
    const int tid = opaque_tid(wv);
    LAS int* s = (LAS int*)lds;
    const int e = tid & 31, part = tid >> 5;
    int loc[16]; int sum = 0;
#pragma unroll
    for (int i = 0; i < 16; ++i) { loc[i] = p.BLKCNT[(part * 16 + i) * 32 + e]; sum += loc[i]; }
    s[128 + part * 32 + e] = sum;
    __syncthreads();
    if (tid < 32) { int t = 0; for (int k = 0; k < 16; ++k) { const int v = s[128 + k * 32 + tid]; s[128 + k * 32 + tid] = t; t += v; } s[tid] = t; }
    __syncthreads();
    if (tid == 0) { int off = 0; for (int k = 0; k < 32; ++k) { s[32 + k] = off; off += (s[k] + 255) >> 8; } s[64] = off; }
    __syncthreads();
    const int ntiles = s[64];
    {
        int run = s[32 + e] * 256 + s[128 + part * 32 + e];
#pragma unroll
        for (int i = 0; i < 16; ++i) { p.CB[(part * 16 + i) * 32 + e] = run; run += loc[i]; }
    }
    if (tid < 32) { p.MOEI[tid] = s[32 + tid] * 256; p.MOEI[32 + tid] = s[32 + tid]; }
    if (tid == 0) { p.MOEI[64] = ntiles; p.MOEI[65] = ntiles * 2; p.MOEI[66] = ntiles * 4; }
    for (int rt = tid; rt < ntiles; rt += NTHR) {
        int ex = 0;
        for (int k = 0; k < 32; ++k) { const int tb = s[32 + k], nt = (s[k] + 255) >> 8; if (rt >= tb && rt < tb + nt) ex = k; }
        p.GU[4 * rt + 0] = rt; p.GU[4 * rt + 1] = ex * 2; p.GU[4 * rt + 2] = rt; p.GU[4 * rt + 3] = ex * 2 + 1;
#pragma unroll
        for (int j = 0; j < 4; ++j) { p.DN[8 * rt + 2 * j] = rt; p.DN[8 * rt + 2 * j + 1] = ex * 4 + j; }
    }
    for (int k = 0; k < 32; ++k) {
        const int lo = s[32 + k] * 256 + s[k], hi = (s[32 + k] + ((s[k] + 255) >> 8)) * 256;
        for (int i = lo + tid; i < hi; i += NTHR) p.PTOK[i] = -1;
    }
}

__device__ __forceinline__ void ph_scatter(const P& p, LAS unsigned char* lds, const int wv) {
    const int tid = opaque_tid(wv), lane = tid & 63, wave = __builtin_amdgcn_readfirstlane(tid >> 6);
    LAS int* se = (LAS int*)lds;
    for (int c = blockIdx.x; c < M / 128; c += gridDim.x) {
        int e = 0;
        if (tid < 256) { e = p.EID[c * 256 + tid]; se[tid] = e; }
        __syncthreads();
        if (tid < 256) {
            int rank = 0;
            for (int t = 0; t < tid; ++t) rank += (se[t] == e) ? 1 : 0;
            const int pos = p.CB[c * 32 + e] + rank;
            se[256 + tid] = pos; p.PTOK[pos] = c * 256 + tid;
        }
        __syncthreads();
#pragma unroll 4
        for (int i = 0; i < 32; ++i) {
            const int t = wave * 32 + i, pos = se[256 + t];
            const u32x4* src = (const u32x4*)(p.H2B + (size_t)(c * 128 + (t >> 1)) * D); u32x4* dst = (u32x4*)(p.H2S + (size_t)pos * D);
            const u32x4 a = src[lane], b = src[lane + 64];
            dst[lane] = a; dst[lane + 64] = b;
        }
        __syncthreads();
    }
}

__device__ __forceinline__ void ph_final(const P& p, const int wv) {
    const int tid = opaque_tid(wv), lane = tid & 63, wave = tid >> 6;
    const int gw = blockIdx.x * NWAVES + wave, NGW = gridDim.x * NWAVES;
    for (int m4 = gw; m4 < M / 4; m4 += NGW) {
        f32x4 v[4][4]; float s[4];
#pragma unroll
        for (int rr = 0; rr < 4; ++rr) {
            const int m = 4 * m4 + rr;
            const f32x4* xr = (const f32x4*)(p.out + (size_t)m * D) + lane;
            const u32x2* y0 = (const u32x2*)(p.YS + (size_t)m * D) + lane; const u32x2* y1 = (const u32x2*)(p.YS + ((size_t)M + m) * D) + lane;
            s[rr] = 0.f;
#pragma unroll
            for (int j = 0; j < 4; ++j) {
                v[rr][j] = xr[64 * j]; const u32x2 a = y0[64 * j], b = y1[64 * j];
                v[rr][j].x += bflo(a.x) + bflo(b.x); v[rr][j].y += bfhi(a.x) + bfhi(b.x); v[rr][j].z += bflo(a.y) + bflo(b.y); v[rr][j].w += bfhi(a.y) + bfhi(b.y);
                s[rr] += (v[rr][j].x * v[rr][j].x + v[rr][j].y * v[rr][j].y) + (v[rr][j].z * v[rr][j].z + v[rr][j].w * v[rr][j].w);
            }
        }
#pragma unroll
        for (int rr = 0; rr < 4; ++rr) {
            const float rinv = 1.0f / sqrtf(wave_sum(s[rr]) * (1.f / D) + EPS);
            f32x4* xr = (f32x4*)(p.out + (size_t)(4 * m4 + rr) * D) + lane;
#pragma unroll
            for (int j = 0; j < 4; ++j) { const f32x4 g = ((const f32x4*)p.fg)[lane + 64 * j]; xr[64 * j] = v[rr][j] * rinv * g; }
        }
    }
}

__device__ __forceinline__ void ph_gemm_in(const P& p, LAS unsigned char* lds, const int wv) {
    pg8::Gemm g{p.HB, p.WinT, M, NIN, 1024}; pg8::StaticOrder S; S.init(M, NIN, gridDim.x, (int)blockIdx.x);
    EpiIn E{p.QL, p.QI, p.KI, p.UB, p.VB, p.GAB, p.GBB, p.CKVR, p.WI};
    pg8::gemm_phase<EpiIn, pg8::StaticOrder, true, true>(lds, g, S, E, wv);
}
__device__ __forceinline__ void ph_gemm_yb(const P& p, LAS unsigned char* lds, const int wv) {
    pg8::Gemm g{p.US, p.WpbT, M, 1024, 512}; pg8::StaticOrder S; S.init(M, 1024, gridDim.x, (int)blockIdx.x);
    EpiMB E{p.GBB, p.MB};
    pg8::gemm_phase<EpiMB, pg8::StaticOrder, true, true>(lds, g, S, E, wv);
}
__device__ __forceinline__ void ph_gemm_ya(const P& p, LAS unsigned char* lds, const int wv) {
    pg8::Gemm g{p.OL, p.WovT, M, 1024, 1024}; pg8::StaticOrder S; S.init(M, 1024, gridDim.x, (int)blockIdx.x);
    EpiMG E{p.GAB, p.MB, p.MG};
    pg8::gemm_phase<EpiMG, pg8::StaticOrder, true, true>(lds, g, S, E, wv);
}
__device__ __forceinline__ void ph_gemm_out(const P& p, LAS unsigned char* lds, const int wv) {
    pg8::Gemm g{p.MG, p.WoutT, M, 1024, 1024}; pg8::StaticOrder S; S.init(M, 1024, gridDim.x, (int)blockIdx.x);
    EpiX1 E{p.x, p.out};
    pg8::gemm_phase<EpiX1, pg8::StaticOrder, true, true>(lds, g, S, E, wv);
}
__device__ __forceinline__ void ph_gemm_gu(const P& p, LAS unsigned char* lds, const int wv) {
    pg8::Gemm g{p.H2S, p.WguT, NPOS, 32 * 512, 1024}; TableOrder S{p.GU, p.MOEI + 65, (int)gridDim.x, (int)blockIdx.x};
    EpiHE E{p.HE};
    pg8::gemm_phase<EpiHE, TableOrder, true, true>(lds, g, S, E, wv);
}
__device__ __forceinline__ void ph_gemm_dn(const P& p, LAS unsigned char* lds, const int wv) {
    pg8::Gemm g{p.HE, p.WdT, NPOS, 32 * 1024, 256}; TableOrder S{p.DN, p.MOEI + 66, (int)gridDim.x, (int)blockIdx.x};
    EpiDown E{p.PTOK, p.EW, p.YS};
    pg8::gemm_phase<EpiDown, TableOrder, true, true>(lds, g, S, E, wv);
}

constexpr int NPHASE = 15;
template <int PH> __device__ __forceinline__ void run_phase(const P& p, LAS unsigned char* lds, const int wv) {
    if constexpr (PH == 0) ph_prep(p, lds, wv);
    if constexpr (PH == 1) ph_gemm_in(p, lds, wv);
    if constexpr (PH == 2) ph_ckvnorm(p, wv);
    if constexpr (PH == 3) ph_index(p, lds, wv);
    if constexpr (PH == 4) ph_attn(p, lds, wv);
    if constexpr (PH == 5) ph_gmlp(p, lds, wv);
    if constexpr (PH == 6) ph_gemm_yb(p, lds, wv);
    if constexpr (PH == 7) ph_gemm_ya(p, lds, wv);
    if constexpr (PH == 8) ph_gemm_out(p, lds, wv);
    if constexpr (PH == 9) ph_router(p, lds, wv);
    if constexpr (PH == 10) ph_scan(p, lds, wv);
    if constexpr (PH == 11) ph_scatter(p, lds, wv);
    if constexpr (PH == 12) ph_gemm_gu(p, lds, wv);
    if constexpr (PH == 13) ph_gemm_dn(p, lds, wv);
    if constexpr (PH == 14) ph_final(p, wv);
}
template <int PH> __global__ void __launch_bounds__(NTHR, 2) k_phase(P p) {
    extern __shared__ __attribute__((aligned(16))) unsigned char lds_raw[];
    run_phase<PH>(p, (LAS unsigned char*)lds_raw, __builtin_amdgcn_readfirstlane(threadIdx.x >> 6));
}

constexpr int MISC_OFF = LDS_BYTES - 256;
__global__ void __launch_bounds__(NTHR, 2) k_mega(P p) {
    extern __shared__ __attribute__((aligned(16))) unsigned char lds_raw[];
    LAS unsigned char* lds = (LAS unsigned char*)lds_raw;
    volatile LAS unsigned* MISC = (volatile LAS unsigned*)(lds + MISC_OFF);
    int wv = __builtin_amdgcn_readfirstlane(threadIdx.x >> 6); asm volatile("" : "+s"(wv));
    if (threadIdx.x < 64) MISC[threadIdx.x] = 0u;
    __syncthreads();
    XcdBarrier bar = xcd_barrier_post(p.ctl + CW_BAR, MISC, wv);
    run_phase<0>(p, lds, wv);
#if defined(DUP0)
    __syncthreads(); run_phase<0>(p, lds, wv);
#endif
    xcd_barrier(bar);
    run_phase<1>(p, lds, wv);
#if defined(DUP1)
    __syncthreads(); run_phase<1>(p, lds, wv);
#endif
    xcd_barrier(bar);
    run_phase<2>(p, lds, wv);
    run_phase<3>(p, lds, wv);
#if defined(DUP3)
    __syncthreads(); run_phase<3>(p, lds, wv);
#endif
    xcd_barrier(bar);
    run_phase<4>(p, lds, wv);  __syncthreads();
#if defined(DUP4)
    run_phase<4>(p, lds, wv);  __syncthreads();
#endif
    run_phase<5>(p, lds, wv);
#if defined(DUP5)
    __syncthreads(); run_phase<5>(p, lds, wv);
#endif
    xcd_barrier(bar);
    run_phase<6>(p, lds, wv);
    run_phase<7>(p, lds, wv);  xcd_barrier(bar);
    run_phase<8>(p, lds, wv);
#if defined(DUP678)
    __syncthreads(); run_phase<6>(p, lds, wv); run_phase<7>(p, lds, wv); xcd_barrier(bar); run_phase<8>(p, lds, wv);
#endif
    xcd_barrier(bar);
    run_phase<9>(p, lds, wv);  xcd_barrier(bar);
    run_phase<10>(p, lds, wv); xcd_barrier(bar);
    run_phase<11>(p, lds, wv); xcd_barrier(bar);
    run_phase<12>(p, lds, wv);
#if defined(DUP12)
    __syncthreads(); run_phase<12>(p, lds, wv);
#endif
    xcd_barrier(bar);
    run_phase<13>(p, lds, wv);
#if defined(DUP13)
    __syncthreads(); run_phase<13>(p, lds, wv);
#endif
    xcd_barrier(bar);
    run_phase<14>(p, lds, wv);
}

extern "C" void kernel_launch(void* const* d_in, const int* in_sizes, int n_in, void* d_out, int out_size, void* d_ws, size_t ws_size, hipStream_t stream) {
    static int grid = 0; static bool first = true;
    if (grid == 0) {
        if (n_in != 23 || in_sizes[0] != M * D || out_size != M * D || ws_size < WS_END) { fprintf(stderr, "kernel_launch: unexpected shapes (n_in %d, in0 %d, out %d, ws %zu)\n", n_in, n_in > 0 ? in_sizes[0] : -1, out_size, ws_size); grid = -1; return; }
        int dev = 0, cus = 0;
        if (hipGetDevice(&dev) != hipSuccess || hipDeviceGetAttribute(&cus, hipDeviceAttributeMultiprocessorCount, dev) != hipSuccess) { grid = -1; return; }
        grid = cus;
    }
    if (grid < 0) return;
    unsigned char* ws = (unsigned char*)d_ws;
    (void)hipMemsetAsync(ws + WS_CTL, 0, CTL_ZERO_BYTES, stream);
    P p{};
    const float* const* in = (const float* const*)d_in;
    p.x = in[0]; p.w_in = in[1]; p.kv_g = in[2]; p.w_uk = in[3]; p.w_uv = in[4]; p.rel_bias = in[5]; p.ln_g = in[6]; p.ln_b = in[7]; p.w_sp = in[8]; p.b_sp = in[9];
    p.w_pa = in[10]; p.w_pb = in[11]; p.w_out = in[12]; p.n1g = in[13]; p.n2g = in[14]; p.rg_w = in[15]; p.rg_b = in[16]; p.re_w = in[17]; p.re_b = in[18];
    p.w_gate = in[19]; p.w_up = in[20]; p.w_down = in[21]; p.fg = in[22];
    p.out = (float*)d_out; p.ctl = (unsigned*)(ws + WS_CTL);
    p.WinT = (bf16_t*)(ws + WS_WIN); p.WoutT = (bf16_t*)(ws + WS_WOUT); p.WpbT = (bf16_t*)(ws + WS_WPB); p.WovT = (bf16_t*)(ws + WS_WOV); p.WSB = (bf16_t*)(ws + WS_WSB);
    p.WguT = (bf16_t*)(ws + WS_WGU); p.WdT = (bf16_t*)(ws + WS_WD); p.WrT = (float*)(ws + WS_WRT);
    p.HB = (bf16_t*)(ws + WS_A); p.OL = (bf16_t*)(ws + WS_A); p.H2B = (bf16_t*)(ws + WS_A);
    p.QL = (bf16_t*)(ws + WS_B); p.MB = (bf16_t*)(ws + WS_B); p.H2S = (bf16_t*)(ws + WS_B); p.YS = (bf16_t*)(ws + WS_B);
    p.GAB = (bf16_t*)(ws + WS_GA); p.GBB = (bf16_t*)(ws + WS_GB);
    p.UB = (bf16_t*)(ws + WS_C); p.VB = (bf16_t*)(ws + WS_C + 32 * MiB); p.MG = (bf16_t*)(ws + WS_C); p.HE = (bf16_t*)(ws + WS_C);
    p.QI = (bf16_t*)(ws + WS_DQ); p.US = (bf16_t*)(ws + WS_DQ);
    p.CKVR = (float*)(ws + WS_CKVR); p.CKVB = (bf16_t*)(ws + WS_CKVB); p.KI = (bf16_t*)(ws + WS_KI); p.WI = (float*)(ws + WS_WI); p.SEL = (unsigned short*)(ws + WS_SEL);
    p.EID = (int*)(ws + WS_MOE); p.EW = (float*)(ws + WS_MOE + 262144); p.PTOK = (int*)(ws + WS_MOE + 524288); p.MOEI = (int*)(ws + WS_MOE + 1048576);
    p.GU = (int*)(ws + WS_MOE + 1048576 + 4096); p.BLKCNT = (int*)(ws + WS_MOE + 1048576 + 65536); p.CB = (int*)(ws + WS_MOE + 1048576 + 131072); p.DN = (int*)(ws + WS_MOE + 1048576 + 4096 + 8192);
    if (first) { (void)hipFuncSetAttribute((const void*)k_mega, hipFuncAttributeMaxDynamicSharedMemorySize, LDS_BYTES); first = false; }
    hipLaunchKernelGGL(k_mega, dim3(grid), dim3(NTHR), LDS_BYTES, stream, p);
}
```

```cpp
#include <hip/hip_runtime.h>
#include <cstdio>
#include <cstdint>
__device__ __forceinline__ int opaque_tid(const int wv) { int l; asm volatile("v_mbcnt_lo_u32_b32 %0, -1, 0\n\tv_mbcnt_hi_u32_b32 %0, -1, %0" : "=v"(l)); return (wv << 6) + l; }
#define LAS __attribute__((address_space(3)))
namespace pg8 {
#define PG8_LAS __attribute__((address_space(3)))
typedef unsigned short bf16_t;
typedef short bf16x8 __attribute__((ext_vector_type(8)));
typedef float f32x4 __attribute__((ext_vector_type(4)));
typedef unsigned u32x4 __attribute__((ext_vector_type(4)));
constexpr int BM = 256, BK = 64, HALF = 128, HTB = HALF * BK * 2  , STAGE_BYTES = 8 * HTB, NXCD = 8, WGM = 8;

__host__ __device__ __forceinline__ int lds_byte(int r, int c) { const int st = (r >> 4) * 2 + (c >> 5), rr = r & 15, cc = c & 31, ob = rr * 64 + cc * 2; return st * 1024 + (ob ^ (((ob >> 9) & 1) << 5)); }
__host__ __device__ __forceinline__ void stage_rc(int b, int& R, int& C) { const int st = b / 1024, sb = b % 1024, swz = sb ^ (((sb >> 9) & 1) << 5); R = (st >> 1) * 16 + swz / 64; C = (st & 1) * 32 + (swz % 64) / 2; }
__host__ __device__ __forceinline__ int perm32(int rho) { const int n = rho >> 4, i = rho & 15; return 8 * (i >> 2) + 4 * n + (i & 3); }

struct Unit { int pm, pn; };
struct Gemm { const bf16_t* A; const bf16_t* Bt; int M, N, K; };

struct StaticOrder {
    int nM, nN, nwg, G, c;
    __host__ __device__ void init(int M, int N, int G_, int c_) { nM = M / BM; nN = N / BM; nwg = nM * nN; G = G_; c = c_; }
    __host__ __device__ bool next(int i, Unit& u) const {
        const long L = (long)i * G + c; if (L >= nwg) return false;
        int wgid = (int)L; { const int q = nwg / NXCD, r = nwg % NXCD, xcd = wgid % NXCD, off = wgid / NXCD; wgid = (xcd < r ? xcd * (q + 1) : r * (q + 1) + (xcd - r) * q) + off; }
        const int nig = WGM * nN, gid = wgid / nig, fm = gid * WGM, gsz = (nM - fm) < WGM ? (nM - fm) : WGM;
        u.pm = fm + ((wgid % nig) % gsz); u.pn = (wgid % nig) / gsz; return true;
    }
    __device__ __forceinline__ void a_ready(const Unit&) const {}
    __device__ __forceinline__ void done(const Unit&) const {}
};

__device__ __forceinline__ unsigned cvt_pk_bf16(float lo, float hi) { unsigned r; asm volatile("v_cvt_pk_bf16_f32 %0, %1, %2" : "=v"(r) : "v"(lo), "v"(hi)); return r; }
typedef float f32x2 __attribute__((ext_vector_type(2)));
template <class Epi, class Sched, bool ALIGN_EPI = false, bool SP2 = false>
__device__ __forceinline__ void gemm_phase(PG8_LAS unsigned char* lds, const Gemm g, const Sched& S, const Epi& E, const int wv) {
    const int tid = opaque_tid(wv), wid = __builtin_amdgcn_readfirstlane(tid >> 6), lane = tid & 63, wr = wid >> 2, wc = wid & 3, fr = lane & 15, fq = lane >> 4;
    const int K = g.K, nt = K / BK;
    unsigned voffA[2], voffB[2];
#pragma unroll
    for (int i = 0; i < 2; ++i) { int R, C; stage_rc(tid * 16 + i * 8192, R, C); const int Rb = Epi::PERM ? ((R & ~31) + perm32(R & 31)) : R;
        voffA[i] = (unsigned)(R * K + C) * 2u; voffB[i] = (unsigned)(Rb * K + C) * 2u; }
    const size_t kstep = (size_t)(BK * 2);
    const size_t hstep = (size_t)HALF * K * 2;
    const size_t tstep = 2 * hstep;
    const unsigned ldsw = (unsigned)wid * 1024u;
    const int aoff = lds_byte(wr * 64 + fr, fq * 8), boff = lds_byte(wc * 32 + fr, fq * 8);
#define PG8_SA(b, h) (((b) * 2 + (h)) * HTB)
#define PG8_SB(b, h) ((4 + (b) * 2 + (h)) * HTB)
#define PG8_STAGE(bufoff, gbase, voff) do { _Pragma("unroll") for (int _i = 0; _i < 2; ++_i) \
        __builtin_amdgcn_global_load_lds((const unsigned*)((const char*)(gbase) + (voff)[_i]), (PG8_LAS unsigned*)(lds + (bufoff) + ldsw + _i * 8192), 16, 0, 0); } while (0)
#define PG8_LDA(dst, b, h) do { _Pragma("unroll") for (int m = 0; m < 4; ++m) _Pragma("unroll") for (int k = 0; k < 2; ++k) dst[m][k] = *(const PG8_LAS bf16x8*)(lds + PG8_SA(b, h) + aoff + m * 2048 + k * 1024); } while (0)
#define PG8_LDB(dst, b, h) do { _Pragma("unroll") for (int n = 0; n < 2; ++n) _Pragma("unroll") for (int k = 0; k < 2; ++k) dst[n][k] = *(const PG8_LAS bf16x8*)(lds + PG8_SB(b, h) + boff + n * 2048 + k * 1024); } while (0)
#define PG8_MMA(ai, bj, At, Bt) do { __builtin_amdgcn_s_setprio(1); _Pragma("unroll") for (int m = 0; m < 4; ++m) _Pragma("unroll") for (int n = 0; n < 2; ++n) _Pragma("unroll") for (int k = 0; k < 2; ++k) \
        acc[ai][bj][m][n] = __builtin_amdgcn_mfma_f32_16x16x32_bf16(Bt[n][k], At[m][k], acc[ai][bj][m][n], 0, 0, 0); __builtin_amdgcn_s_setprio(0); } while (0)
#define PG8_WAIT_V(n) asm volatile("s_waitcnt vmcnt(" #n ")" ::: "memory")
#define PG8_WAIT_L(n) asm volatile("s_waitcnt lgkmcnt(" #n ")" ::: "memory")
#define PG8_BAR __builtin_amdgcn_s_barrier()
#define PG8_SCHED __builtin_amdgcn_sched_barrier(0)
    Unit cur, nxt; int ui = 0;
    if (!S.next(0, cur)) return;
    f32x4 acc[2][2][4][2];
#pragma unroll
    for (int a = 0; a < 2; ++a)
#pragma unroll
        for (int b = 0; b < 2; ++b)
#pragma unroll
            for (int m = 0; m < 4; ++m)
#pragma unroll
                for (int n = 0; n < 2; ++n) acc[a][b][m][n] = (f32x4){0.f, 0.f, 0.f, 0.f};
    bf16x8 At[4][2], B0[2][2], B1[2][2];
    const char* cA = (const char*)g.A + (size_t)cur.pm * tstep; const char* cB = (const char*)g.Bt + (size_t)cur.pn * tstep;
    S.a_ready(cur);
    if constexpr (SP2) {
        PG8_STAGE(PG8_SB(0, 0), cB, voffB); PG8_STAGE(PG8_SB(0, 1), cB + hstep, voffB); PG8_STAGE(PG8_SA(0, 0), cA, voffA); PG8_STAGE(PG8_SA(0, 1), cA + hstep, voffA);
        if (wr == 1) PG8_BAR;
        PG8_WAIT_V(2); PG8_BAR;
        PG8_STAGE(PG8_SB(1, 0), cB + kstep, voffB); PG8_STAGE(PG8_SA(1, 0), cA + kstep, voffA); PG8_STAGE(PG8_SB(1, 1), cB + hstep + kstep, voffB);
        PG8_WAIT_V(6); PG8_BAR;
    } else {
        PG8_STAGE(PG8_SB(0, 0), cB, voffB); PG8_STAGE(PG8_SA(0, 0), cA, voffA); PG8_STAGE(PG8_SB(0, 1), cB + hstep, voffB); PG8_STAGE(PG8_SA(0, 1), cA + hstep, voffA);
        if (wr == 1) PG8_BAR;
        PG8_WAIT_V(4); PG8_BAR;
        PG8_STAGE(PG8_SB(1, 0), cB + kstep, voffB); PG8_STAGE(PG8_SA(1, 0), cA + kstep, voffA); PG8_STAGE(PG8_SB(1, 1), cB + hstep + kstep, voffB);
        PG8_WAIT_V(6); PG8_BAR;
    }
    for (;;) {
        const bool has_next = S.next(ui + 1, nxt);
        const char* nA = has_next ? (const char*)g.A + (size_t)nxt.pm * tstep : cA; const char* nB = has_next ? (const char*)g.Bt + (size_t)nxt.pn * tstep : cB;
        for (int t = 0; t < nt; t += 2) {
            const bool last = (t == nt - 2);
            const char* a1 = cA + (size_t)(t + 1) * kstep;
            const char* a2 = last ? nA : cA + (size_t)(t + 2) * kstep; const char* b2 = last ? nB : cB + (size_t)(t + 2) * kstep;
            const char* a3 = a2 + kstep; const char* b3 = b2 + kstep;
            if (last && has_next) S.a_ready(nxt);
            if constexpr (SP2) {
            PG8_LDB(B0, 0, 0); PG8_LDB(B1, 0, 1); PG8_SCHED; PG8_LDA(At, 0, 0); PG8_STAGE(PG8_SA(1, 1), a1 + hstep, voffA);
            PG8_WAIT_V(8); PG8_WAIT_L(0); PG8_BAR; PG8_MMA(0, 0, At, B0); PG8_MMA(0, 1, At, B1); PG8_BAR; PG8_SCHED;
            PG8_LDA(At, 0, 1); PG8_STAGE(PG8_SB(0, 0), b2, voffB); PG8_STAGE(PG8_SB(0, 1), b2 + hstep, voffB); PG8_STAGE(PG8_SA(0, 0), a2, voffA);
            PG8_WAIT_V(8); PG8_WAIT_L(0); PG8_BAR; PG8_MMA(1, 0, At, B0); PG8_MMA(1, 1, At, B1); PG8_BAR; PG8_SCHED;
            PG8_LDB(B0, 1, 0); PG8_LDB(B1, 1, 1); PG8_SCHED; PG8_LDA(At, 1, 0); PG8_STAGE(PG8_SA(0, 1), a2 + hstep, voffA);
            PG8_WAIT_V(8); PG8_WAIT_L(0); PG8_BAR; PG8_MMA(0, 0, At, B0); PG8_MMA(0, 1, At, B1); PG8_BAR; PG8_SCHED;
            PG8_LDA(At, 1, 1); PG8_STAGE(PG8_SB(1, 0), b3, voffB); PG8_STAGE(PG8_SB(1, 1), b3 + hstep, voffB); PG8_STAGE(PG8_SA(1, 0), a3, voffA);
            PG8_WAIT_V(8); PG8_WAIT_L(0); PG8_BAR; PG8_MMA(1, 0, At, B0); PG8_MMA(1, 1, At, B1); PG8_BAR; PG8_SCHED;
            } else {
            PG8_LDB(B0, 0, 0); PG8_SCHED; PG8_LDA(At, 0, 0); PG8_STAGE(PG8_SA(1, 1), a1 + hstep, voffA);
            PG8_WAIT_L(8); PG8_BAR; PG8_WAIT_L(0); PG8_MMA(0, 0, At, B0); PG8_BAR; PG8_SCHED;
            PG8_LDB(B1, 0, 1); PG8_STAGE(PG8_SB(0, 0), b2, voffB);
            PG8_BAR; PG8_WAIT_L(0); PG8_MMA(0, 1, At, B1); PG8_BAR;
            PG8_LDA(At, 0, 1); PG8_STAGE(PG8_SA(0, 0), a2, voffA);
            PG8_BAR; PG8_WAIT_L(0); PG8_MMA(1, 0, At, B0); PG8_BAR; PG8_SCHED;
            PG8_STAGE(PG8_SB(0, 1), b2 + hstep, voffB);
            PG8_WAIT_V(6); PG8_BAR; PG8_MMA(1, 1, At, B1); PG8_BAR;
            PG8_LDB(B0, 1, 0); PG8_SCHED; PG8_LDA(At, 1, 0); PG8_STAGE(PG8_SA(0, 1), a2 + hstep, voffA);
            PG8_WAIT_L(8); PG8_BAR; PG8_WAIT_L(0); PG8_MMA(0, 0, At, B0); PG8_BAR; PG8_SCHED;
            PG8_LDB(B1, 1, 1); PG8_STAGE(PG8_SB(1, 0), b3, voffB);
            PG8_BAR; PG8_WAIT_L(0); PG8_MMA(0, 1, At, B1); PG8_BAR;
            PG8_LDA(At, 1, 1); PG8_STAGE(PG8_SA(1, 0), a3, voffA);
            PG8_BAR; PG8_WAIT_L(0); PG8_MMA(1, 0, At, B0); PG8_BAR; PG8_SCHED;
            PG8_STAGE(PG8_SB(1, 1), b3 + hstep, voffB);
            PG8_WAIT_V(6); PG8_BAR; PG8_MMA(1, 1, At, B1); PG8_BAR;
            }
        }
        if constexpr (ALIGN_EPI) { if (wr == 0) PG8_BAR; }
        if constexpr (!Epi::AFTER_DRAIN) { E(acc, cur, wr, wc, fr, fq); S.done(cur); }
        if (!has_next) break;
#pragma unroll
        for (int a = 0; a < 2; ++a)
#pragma unroll
            for (int b = 0; b < 2; ++b)
#pragma unroll
                for (int m = 0; m < 4; ++m)
#pragma unroll
                    for (int n = 0; n < 2; ++n) acc[a][b][m][n] = (f32x4){0.f, 0.f, 0.f, 0.f};
        cur = nxt; cA = nA; cB = nB; ++ui;
        if constexpr (ALIGN_EPI) { if (wr == 1) PG8_BAR; }
    }
    PG8_WAIT_V(0);
    if constexpr (!ALIGN_EPI) { if (wr == 0) PG8_BAR; }
    PG8_BAR;
    if constexpr (Epi::AFTER_DRAIN) { E.fused(acc, cur, wr, wc, fr, fq, lds, wid, lane); S.done(cur); }
#undef PG8_SA
#undef PG8_SB
#undef PG8_STAGE
#undef PG8_LDA
#undef PG8_LDB
#undef PG8_MMA
#undef PG8_WAIT_V
#undef PG8_WAIT_L
#undef PG8_BAR
#undef PG8_SCHED
}
}
#define XB_TMO      128
#define XB_XCNT(j)  (256  + 64 * (j))
#define XB_XSUB(j)  (1280 + 64 * (j))
#define XB_XGEN(j)  (2304 + 64 * (j))
#define XB_TOP      3328
#define XB_TOPGEN   3392
#define XCD_BAR_WORDS 3456
#define XB_SPIN_CAP (1u << 18)

__device__ __forceinline__ unsigned xb_ld(unsigned* p)              { return __hip_atomic_load(p, __ATOMIC_RELAXED, __HIP_MEMORY_SCOPE_AGENT); }
__device__ __forceinline__ unsigned xb_add(unsigned* p, unsigned v) { return __hip_atomic_fetch_add(p, v, __ATOMIC_RELAXED, __HIP_MEMORY_SCOPE_AGENT); }
__device__ __forceinline__ unsigned xb_xcc_id() { return (unsigned)__builtin_amdgcn_s_getreg((3 << 11) | 20) & 0xFu; }
#define XB_SPIN(cond, bar) do { unsigned _sp = 0; while (cond) { __builtin_amdgcn_s_sleep(1); \
    if ((++_sp & 255u) == 0u) { if (xb_ld(&(bar)[XB_TMO])) break; if (_sp > XB_SPIN_CAP) { atomicAdd(&(bar)[XB_TMO], 1u); break; } } } } while (0)

struct XcdBarrier {
    unsigned* bar; unsigned x; int wv;
    volatile LAS unsigned* st;
};

__device__ __forceinline__ XcdBarrier xcd_barrier_post(unsigned* bar, volatile LAS unsigned* st, int wv) {
    XcdBarrier b; b.bar = bar; b.x = xb_xcc_id(); b.st = st; b.wv = wv;
    if (opaque_tid(wv) == 0) (void)xb_add(&bar[XB_XCNT(b.x)], 1u);
    return b;
}
__device__ __forceinline__ void xcd_barrier_complete(unsigned* bar, unsigned x, unsigned& nloc, unsigned& nx) {
    const unsigned G = gridDim.x * gridDim.y * gridDim.z;
    unsigned sum, cnt, mine, sp = 0u;
    for (;;) {
        sum = 0u; cnt = 0u; mine = 0u;
#pragma unroll
        for (unsigned j = 0; j < 16; ++j) { const unsigned c = xb_ld(&bar[XB_XCNT(j)]); sum += c; cnt += (c > 0u) ? 1u : 0u; mine = (j == x) ? c : mine; }
        if (sum == G) break;
        __builtin_amdgcn_s_sleep(1);
        if ((++sp & 255u) == 0u) { if (xb_ld(&bar[XB_TMO])) break; if (sp > XB_SPIN_CAP) { atomicAdd(&bar[XB_TMO], 1u); break; } }
    }
    nloc = mine > 0u ? mine : 1u; nx = cnt > 0u ? cnt : 1u;
}

__device__ __forceinline__ void xcd_barrier(const XcdBarrier& b) {
    asm volatile("s_waitcnt vmcnt(0)" ::: "memory");
    __syncthreads();
    if (opaque_tid(b.wv) == 0) {
        unsigned* bar = b.bar;
        __builtin_amdgcn_s_waitcnt(0);
        unsigned nloc = b.st[0], nx = b.st[1];
        if (nloc == 0u) { xcd_barrier_complete(bar, b.x, nloc, nx); b.st[0] = nloc; b.st[1] = nx; }
        const unsigned old = xb_add(&bar[XB_XSUB(b.x)], 1u);
        const unsigned gen = old / nloc;
        if (old + 1u == (gen + 1u) * nloc) {
            __builtin_amdgcn_fence(__ATOMIC_RELEASE, "agent");
            asm volatile("s_waitcnt vmcnt(0)" ::: "memory");
            const unsigned og = xb_add(&bar[XB_TOP], 1u);
            const unsigned tg = og / nx;
            if (og + 1u == (tg + 1u) * nx) xb_add(&bar[XB_TOPGEN], 1u);
            else XB_SPIN(xb_ld(&bar[XB_TOPGEN]) == tg, bar);
            __builtin_amdgcn_fence(__ATOMIC_ACQUIRE, "agent");
            xb_add(&bar[XB_XGEN(b.x)], 1u);
            asm volatile("s_waitcnt vmcnt(0)" ::: "memory");
        } else {
            XB_SPIN(xb_ld(&bar[XB_XGEN(b.x)]) == gen, bar);
            __builtin_amdgcn_fence(__ATOMIC_ACQUIRE, "agent");
            asm volatile("s_waitcnt vmcnt(0)" ::: "memory");
        }
    }
    __syncthreads();
}

typedef unsigned short bf16_t;
typedef short bf16x8 __attribute__((ext_vector_type(8)));
typedef short bf16x4 __attribute__((ext_vector_type(4)));
typedef float f32x4 __attribute__((ext_vector_type(4)));
typedef float f32x16 __attribute__((ext_vector_type(16)));
typedef unsigned u32x4 __attribute__((ext_vector_type(4)));
typedef unsigned u32x2 __attribute__((ext_vector_type(2)));

constexpr int NB = 8, T = 4096, D = 1024, M = NB * T;
constexpr int INC = 4296;
constexpr int NIN = 19 * 256;
constexpr float EPS = 1e-6f;
constexpr int NPOS = 73728;
constexpr int NWAVES = 8, NTHR = 512;
constexpr int LDS_BYTES = 163840;

constexpr size_t MiB = 1u << 20;
constexpr size_t WS_CTL = 0, CTL_ZERO_BYTES = 65536;
constexpr size_t WS_WIN = 1 * MiB, WS_WOUT = 11 * MiB, WS_WPB = 13 * MiB, WS_WOV = 14 * MiB, WS_WSB = 16 * MiB, WS_WRT = 16 * MiB + 262144, WS_WGU = 17 * MiB, WS_WD = 49 * MiB;
constexpr size_t WS_A = 65 * MiB;
constexpr size_t WS_B = 129 * MiB;
constexpr size_t WS_GA = 193 * MiB, WS_GB = 257 * MiB;
constexpr size_t WS_C = 321 * MiB;
constexpr size_t WS_DQ = 385 * MiB;
constexpr size_t WS_CKVR = 417 * MiB, WS_CKVB = 433 * MiB, WS_KI = 441 * MiB, WS_WI = 445 * MiB, WS_SEL = 446 * MiB;
constexpr size_t WS_MOE = 462 * MiB;
constexpr size_t WS_END = 464 * MiB;

constexpr int CW_BAR = 4096;
constexpr int CW_CNT = 8192, CW_CUR = 8256;

struct P {
    const float *x, *w_in, *kv_g, *w_uk, *w_uv, *rel_bias, *ln_g, *ln_b, *w_sp, *b_sp, *w_pa, *w_pb, *w_out, *n1g, *n2g, *rg_w, *rg_b, *re_w, *re_b, *w_gate, *w_up, *w_down, *fg;
    float* out;
    unsigned* ctl;
    bf16_t *WinT, *WoutT, *WpbT, *WovT, *WSB, *WguT, *WdT;
    float* WrT;
    bf16_t *HB, *QL, *QI, *CKVB, *KI, *UB, *VB, *GAB, *GBB, *OL, *US, *MB, *MG, *H2B, *H2S, *HE, *YS;
    float *CKVR, *WI, *EW, *IDXROW;
    unsigned short* SEL;
    int *EID, *PTOK, *MOEI, *GU, *DN, *BLKCNT, *CB;
};

__device__ __forceinline__ unsigned f2bf(float f) { unsigned u = __builtin_bit_cast(unsigned, f); return (u + 0x7fffu + ((u >> 16) & 1u)) >> 16; }
__device__ __forceinline__ unsigned pk2(float lo, float hi) { return f2bf(lo) | (f2bf(hi) << 16); }
__device__ __forceinline__ float bflo(unsigned w) { return __builtin_bit_cast(float, w << 16); }
__device__ __forceinline__ float bfhi(unsigned w) { return __builtin_bit_cast(float, w & 0xffff0000u); }
__device__ __forceinline__ float bf2f(unsigned short b) { return __builtin_bit_cast(float, (unsigned)b << 16); }
__device__ __forceinline__ float wave_sum(float v) {
#pragma unroll
    for (int o = 1; o < 64; o <<= 1) v += __shfl_xor(v, o);
    return v;
}
#define LDS_WAIT() asm volatile("s_waitcnt lgkmcnt(0)" ::: "memory")
__device__ __forceinline__ float gelu_t(float x) { const float z = 0.7978845608f * (x + 0.044715f * x * x * x); return x / (1.f + __expf(-2.f * z)); }
__device__ __forceinline__ float sigm(float x) { return 1.f / (1.f + __expf(-x)); }
__device__ __forceinline__ unsigned off_b(unsigned row, unsigned ch) { return 256u * row + 16u * (ch ^ (((row & 3) << 2) | ((row >> 2) & 3))); }
__device__ __forceinline__ bf16x4 tr_read(unsigned lds_addr) { bf16x4 r; asm volatile("ds_read_b64_tr_b16 %0, %1\n\ts_waitcnt lgkmcnt(0)" : "=&v"(r) : "v"(lds_addr) : "memory"); return r; }
__device__ __forceinline__ bf16x8 cat4(bf16x4 a, bf16x4 b) { bf16x8 r; r[0] = a[0]; r[1] = a[1]; r[2] = a[2]; r[3] = a[3]; r[4] = b[0]; r[5] = b[1]; r[6] = b[2]; r[7] = b[3]; return r; }
__device__ __forceinline__ unsigned lds_addr_of(LAS unsigned char* p) { return (unsigned)(unsigned long long)p; }

__device__ __forceinline__ void st8bf(bf16_t* p, const pg8::f32x4& a, const pg8::f32x4& b) {
    u32x4 w; w.x = pg8::cvt_pk_bf16(a[0], a[1]); w.y = pg8::cvt_pk_bf16(a[2], a[3]); w.z = pg8::cvt_pk_bf16(b[0], b[1]); w.w = pg8::cvt_pk_bf16(b[2], b[3]);
    *(u32x4*)p = w;
}
__device__ __forceinline__ void ld8bf(const bf16_t* p, pg8::f32x4& a, pg8::f32x4& b) {
    const u32x4 w = *(const u32x4*)p;
    a[0] = bflo(w.x); a[1] = bfhi(w.x); a[2] = bflo(w.y); a[3] = bfhi(w.y); b[0] = bflo(w.z); b[1] = bfhi(w.z); b[2] = bflo(w.w); b[3] = bfhi(w.w);
}

struct EpiIn {
    static constexpr bool PERM = true, AFTER_DRAIN = false;
    bf16_t *QL, *QI, *KI, *UB, *VB, *GAB, *GBB; float *CKVR, *WI;
    __device__ __forceinline__ void operator()(const pg8::f32x4 (&acc)[2][2][4][2], const pg8::Unit& u, int wr, int wc, int fr, int fq) const {
        const int row0 = u.pm * 256 + wr * 64 + fr, pn = u.pn, c8 = wc * 32 + 8 * fq;
        int mode; bf16_t* dst; int ld;
        if (pn < 4)       { mode = 0; dst = QL + pn * 256; ld = 1024; }
        else if (pn < 6)  { mode = 0; dst = QI + (pn - 4) * 256; ld = 512; }
        else if (pn == 6) { mode = 3; dst = KI; ld = 64; }
        else if (pn < 9)  { mode = 1; dst = UB + (pn - 7) * 256; ld = 512; }
        else if (pn < 11) { mode = 1; dst = VB + (pn - 9) * 256; ld = 512; }
        else if (pn < 15) { mode = 2; dst = GAB + (pn - 11) * 256; ld = 1024; }
        else              { mode = 2; dst = GBB + (pn - 15) * 256; ld = 1024; }
#pragma unroll
        for (int ai = 0; ai < 2; ++ai)
#pragma unroll
            for (int m = 0; m < 4; ++m) {
                const size_t row = (size_t)(row0 + ai * 128 + m * 16);
#pragma unroll
                for (int bj = 0; bj < 2; ++bj) {
                    pg8::f32x4 v0 = acc[ai][bj][m][0], v1 = acc[ai][bj][m][1];
                    if (mode == 3) {
                        if (bj == 0) { float* c = CKVR + row * 128 + c8; *(pg8::f32x4*)c = v0; *(pg8::f32x4*)(c + 4) = v1; }
                        else if (c8 < 64) st8bf(KI + row * 64 + c8, v0, v1);
                        else if (c8 == 64) { float* c = WI + row * 8; *(pg8::f32x4*)c = v0 * 0.044194174f; *(pg8::f32x4*)(c + 4) = v1 * 0.044194174f; }
                    } else {
                        if (mode == 1) {
#pragma unroll
                            for (int j = 0; j < 4; ++j) { v0[j] = gelu_t(v0[j]); v1[j] = gelu_t(v1[j]); }
                        } else if (mode == 2) {
#pragma unroll
                            for (int j = 0; j < 4; ++j) { v0[j] = sigm(v0[j]); v1[j] = sigm(v1[j]); }
                        }
                        st8bf(dst + row * ld + bj * 128 + c8, v0, v1);
                    }
                }
            }
    }
};

struct EpiMB {
    static constexpr bool PERM = true, AFTER_DRAIN = false;
    const bf16_t* G; bf16_t* O;
    __device__ __forceinline__ void operator()(const pg8::f32x4 (&acc)[2][2][4][2], const pg8::Unit& u, int wr, int wc, int fr, int fq) const {
        const int row0 = u.pm * 256 + wr * 64 + fr, col0 = u.pn * 256 + wc * 32 + 8 * fq;
#pragma unroll
        for (int ai = 0; ai < 2; ++ai)
#pragma unroll
            for (int m = 0; m < 4; ++m)
#pragma unroll
                for (int bj = 0; bj < 2; ++bj) {
                    const size_t o = (size_t)(row0 + ai * 128 + m * 16) * 1024 + col0 + bj * 128;
                    pg8::f32x4 g0, g1; ld8bf(G + o, g0, g1);
                    st8bf(O + o, acc[ai][bj][m][0] * g0, acc[ai][bj][m][1] * g1);
                }
    }
};
struct EpiMG {
    static constexpr bool PERM = true, AFTER_DRAIN = false;
    const bf16_t *G, *MBp; bf16_t* O;
    __device__ __forceinline__ void operator()(const pg8::f32x4 (&acc)[2][2][4][2], const pg8::Unit& u, int wr, int wc, int fr, int fq) const {
        const int row0 = u.pm * 256 + wr * 64 + fr, col0 = u.pn * 256 + wc * 32 + 8 * fq;
#pragma unroll
        for (int ai = 0; ai < 2; ++ai)
#pragma unroll
            for (int m = 0; m < 4; ++m)
#pragma unroll
                for (int bj = 0; bj < 2; ++bj) {
                    const size_t o = (size_t)(row0 + ai * 128 + m * 16) * 1024 + col0 + bj * 128;
                    pg8::f32x4 g0, g1, b0, b1; ld8bf(G + o, g0, g1); ld8bf(MBp + o, b0, b1);
                    st8bf(O + o, acc[ai][bj][m][0] * g0 + b0, acc[ai][bj][m][1] * g1 + b1);
                }
    }
};
struct EpiX1 {
    static constexpr bool PERM = true, AFTER_DRAIN = false;
    const float* X; float* O;
    __device__ __forceinline__ void operator()(const pg8::f32x4 (&acc)[2][2][4][2], const pg8::Unit& u, int wr, int wc, int fr, int fq) const {
        const int row0 = u.pm * 256 + wr * 64 + fr, col0 = u.pn * 256 + wc * 32 + 8 * fq;
#pragma unroll
        for (int ai = 0; ai < 2; ++ai)
#pragma unroll
            for (int m = 0; m < 4; ++m)
#pragma unroll
                for (int bj = 0; bj < 2; ++bj) {
                    const size_t o = (size_t)(row0 + ai * 128 + m * 16) * 1024 + col0 + bj * 128;
                    const pg8::f32x4 x0 = *(const pg8::f32x4*)(X + o), x1 = *(const pg8::f32x4*)(X + o + 4);
                    *(pg8::f32x4*)(O + o) = x0 + acc[ai][bj][m][0]; *(pg8::f32x4*)(O + o + 4) = x1 + acc[ai][bj][m][1];
                }
    }
};
struct EpiHE {
    static constexpr bool PERM = true, AFTER_DRAIN = false;
    bf16_t* HE;
    __device__ __forceinline__ void operator()(const pg8::f32x4 (&acc)[2][2][4][2], const pg8::Unit& u, int wr, int wc, int fr, int fq) const {
        const int row0 = u.pm * 256 + wr * 64 + fr, col0 = (u.pn & 1) * 128 + wc * 32 + 8 * fq;
#pragma unroll
        for (int ai = 0; ai < 2; ++ai)
#pragma unroll
            for (int m = 0; m < 4; ++m) {
                pg8::f32x4 h0, h1;
#pragma unroll
                for (int j = 0; j < 4; ++j) {
                    const float g0 = acc[ai][0][m][0][j], g1 = acc[ai][0][m][1][j];
                    h0[j] = g0 * sigm(g0) * acc[ai][1][m][0][j]; h1[j] = g1 * sigm(g1) * acc[ai][1][m][1][j];
                }
                st8bf(HE + (size_t)(row0 + ai * 128 + m * 16) * 256 + col0, h0, h1);
            }
    }
};
struct EpiDown {
    static constexpr bool PERM = true, AFTER_DRAIN = false;
    const int* PTOK; const float* EW; bf16_t* YS;
    __device__ __forceinline__ void operator()(const pg8::f32x4 (&acc)[2][2][4][2], const pg8::Unit& u, int wr, int wc, int fr, int fq) const {
        const int row0 = u.pm * 256 + wr * 64 + fr, col0 = (u.pn & 3) * 256 + wc * 32 + 8 * fq;
#pragma unroll
        for (int ai = 0; ai < 2; ++ai)
#pragma unroll
            for (int m = 0; m < 4; ++m) {
                const int ts = PTOK[row0 + ai * 128 + m * 16];
                if (ts >= 0) {
                    const float w = EW[ts];
                    bf16_t* d = YS + ((size_t)(ts & 1) * M + (size_t)(ts >> 1)) * 1024 + col0;
#pragma unroll
                    for (int bj = 0; bj < 2; ++bj) st8bf(d + bj * 128, acc[ai][bj][m][0] * w, acc[ai][bj][m][1] * w);
                }
            }
    }
};
struct TableOrder {
    const int* tab; const int* nunits; int G, c;
    __device__ __forceinline__ bool next(int i, pg8::Unit& u) const {
        const int idx = i * G + c; const int n = __builtin_nontemporal_load(nunits);
        if (idx >= n) return false;
        u.pm = tab[2 * idx]; u.pn = tab[2 * idx + 1]; return true;
    }
    __device__ __forceinline__ void a_ready(const pg8::Unit&) const {}
    __device__ __forceinline__ void done(const pg8::Unit&) const {}
};

__device__ __forceinline__ void tr_item(const float* src, int ld, int K, int NC, bf16_t* dst, LAS float* scr, int item, int lane) {
    const int nblk = NC / 32, kb = item / nblk, nb = item % nblk, k0 = 64 * kb, n0 = 32 * nb;
#pragma unroll 8
    for (int i = 0; i < 32; ++i) { const int kk = 2 * i + (lane >> 5); scr[kk * 33 + (lane & 31)] = src[(size_t)(k0 + kk) * ld + n0 + (lane & 31)]; }
    LDS_WAIT();
    const int c = lane & 7;
#pragma unroll
    for (int j = 0; j < 4; ++j) { const int n = (lane >> 3) + 8 * j; const LAS float* s = scr + (8 * c) * 33 + n;
        u32x4 o; o.x = pk2(s[0 * 33], s[1 * 33]); o.y = pk2(s[2 * 33], s[3 * 33]); o.z = pk2(s[4 * 33], s[5 * 33]); o.w = pk2(s[6 * 33], s[7 * 33]);
        *(u32x4*)(dst + (size_t)(n0 + n) * K + k0 + 8 * c) = o; }
    LDS_WAIT();
}

__device__ __forceinline__ void ph_prep(const P& p, LAS unsigned char* lds, const int wv) {
    const int tid = opaque_tid(wv), lane = tid & 63, wave = __builtin_amdgcn_readfirstlane(tid >> 6);
    LAS float* scr = (LAS float*)(lds + wave * 16384);
    const int gw = blockIdx.x * NWAVES + wave, NGW = gridDim.x * NWAVES;
    const int gt = blockIdx.x * NTHR + tid, NGT = gridDim.x * NTHR;
    {
        const int c0s[7] = {640, 512, 1152, 1224, 1736, 2248, 3272};
        const int ncs[7] = {512, 128, 64, 512, 512, 1024, 1024};
        const int r0s[7] = {1024, 1536, 1664, 1792, 2304, 2816, 3840};
#pragma unroll
        for (int s = 0; s < 7; ++s) {
            const int nit = 16 * (ncs[s] / 32);
            for (int it = gw; it < nit; it += NGW) tr_item(p.w_in + c0s[s], INC, 1024, ncs[s], p.WinT + (size_t)r0s[s] * 1024, scr, it, lane);
        }
    }
    for (int i = gt; i < 64 * 1024; i += NGT) { const int j = i >> 10, k = i & 1023; p.WinT[(size_t)(1728 + j) * 1024 + k] = j < 8 ? (bf16_t)f2bf(p.w_in[(size_t)k * INC + 1216 + j]) : (bf16_t)0; }
    for (int it = gw; it < 512; it += NGW) tr_item(p.w_out, 1024, 1024, 1024, p.WoutT, scr, it, lane);
    for (int it = gw; it < 256; it += NGW) tr_item(p.w_pb, 1024, 512, 1024, p.WpbT, scr, it, lane);
    for (int it = gw; it < 8192; it += NGW) {
        const int sub = it & 63, q = it >> 6, gu = q & 1, j = (q >> 1) & 1, e = q >> 2;
        const float* src = (gu ? p.w_up : p.w_gate) + (size_t)e * 262144 + 128 * j;
        tr_item(src, 256, 1024, 128, p.WguT + ((size_t)e * 512 + j * 256 + gu * 128) * 1024, scr, sub, lane);
    }
    for (int it = gw; it < 4096; it += NGW) { const int sub = it & 127, e = it >> 7; tr_item(p.w_down + (size_t)e * 262144, 1024, 256, 1024, p.WdT + (size_t)e * 262144, scr, sub, lane); }
    for (int i = gt; i < 1024 * 1024; i += NGT) {
        const int n = i >> 10, k = i & 1023, h = n >> 7, r = n & 127;
        const float* a = p.w_in + (size_t)k * INC + h * 64; const float* b = p.w_uk + (size_t)(r * 8 + h) * 64;
        float s = 0.f;
#pragma unroll 16
        for (int d = 0; d < 64; ++d) s += a[d] * b[d];
        p.WinT[(size_t)n * 1024 + k] = (bf16_t)f2bf(0.125f * s);
    }
    for (int i = gt; i < 1024 * 1024; i += NGT) {
        const int n = i >> 10, k = i & 1023, h = k >> 7, r = k & 127;
        const float* a = p.w_uv + (size_t)(r * 8 + h) * 64; const float* b = p.w_pa + (size_t)(h * 64) * 1024 + n;
        float s = 0.f;
#pragma unroll 16
        for (int d = 0; d < 64; ++d) s += a[d] * b[(size_t)d * 1024];
        p.WovT[(size_t)n * 1024 + k] = (bf16_t)f2bf(s);
    }
    for (int i = gt; i < 4 * 128 * 128; i += NGT) { const int jj = i & 127, ii = (i >> 7) & 127; p.WSB[i] = jj <= ii ? (bf16_t)f2bf(p.w_sp[i]) : (bf16_t)0; }
    for (int i = gt; i < 36 * 1024; i += NGT) { const int c = i >> 10, k = i & 1023; p.WrT[i] = c < 4 ? p.rg_w[k * 4 + c] : p.re_w[k * 32 + (c - 4)]; }
    for (int m = gw; m < M; m += NGW) {
        const f32x4* xr = (const f32x4*)(p.x + (size_t)m * D) + lane;
        f32x4 v[4]; float s = 0.f;
#pragma unroll
        for (int j = 0; j < 4; ++j) { v[j] = xr[64 * j]; s += (v[j].x * v[j].x + v[j].y * v[j].y) + (v[j].z * v[j].z + v[j].w * v[j].w); }
        const float rinv = 1.0f / sqrtf(wave_sum(s) * (1.f / D) + EPS);
        unsigned long long* o8 = (unsigned long long*)(p.HB + (size_t)m * D) + lane;
#pragma unroll
        for (int j = 0; j < 4; ++j) { const f32x4 g = ((const f32x4*)p.n1g)[lane + 64 * j]; const f32x4 o = v[j] * rinv * g;
            o8[64 * j] = (unsigned long long)pk2(o.x, o.y) | ((unsigned long long)pk2(o.z, o.w) << 32); }
    }
}

__device__ __forceinline__ void ph_ckvnorm(const P& p, const int wv) {
    const int tid = opaque_tid(wv), lane = tid & 63, wave = tid >> 6;
    const int gw = blockIdx.x * NWAVES + wave, NGW = gridDim.x * NWAVES;
    const float g0 = p.kv_g[2 * lane], g1 = p.kv_g[2 * lane + 1];
    for (int m4 = gw; m4 < M / 4; m4 += NGW) {
        float2 v[4]; float ss[4];
#pragma unroll
        for (int r = 0; r < 4; ++r) v[r] = ((const float2*)(p.CKVR + (size_t)(4 * m4 + r) * 128))[lane];
#pragma unroll
        for (int r = 0; r < 4; ++r) ss[r] = v[r].x * v[r].x + v[r].y * v[r].y;
#pragma unroll
        for (int o = 1; o < 64; o <<= 1) {
#pragma unroll
            for (int r = 0; r < 4; ++r) ss[r] += __shfl_xor(ss[r], o);
        }
#pragma unroll
        for (int r = 0; r < 4; ++r) { const float rinv = 1.0f / sqrtf(ss[r] * (1.f / 128.f) + EPS);
            ((unsigned*)(p.CKVB + (size_t)(4 * m4 + r) * 128))[lane] = pk2(v[r].x * rinv * g0, v[r].y * rinv * g1); }
    }
}

__device__ __forceinline__ unsigned qbin(float x) { return (unsigned)(int)__builtin_fminf(__builtin_fmaxf((x + 8.0f) * 64.0f, 0.0f), 1023.0f); }
__device__ __forceinline__ unsigned fkey(float x) { x = x + 0.0f; const unsigned u = __builtin_bit_cast(unsigned, x); return (u & 0x80000000u) ? ~u : (u | 0x80000000u); }

__device__ __forceinline__ void select_row(const LAS float* row, int n, LAS unsigned* hist, unsigned short* out, int lane) {
    if (n <= 256) {
#pragma unroll
        for (int i = 0; i < 4; ++i) { const int k = lane + 64 * i; out[k] = (unsigned short)(k < n ? k : 0); }
        return;
    }
    unsigned prefix = 0; int need = 256;
    const unsigned long long lt = (1ull << lane) - 1ull;
#pragma unroll 1
    for (int pass = 3; pass >= 0; --pass) {
#pragma unroll
        for (int i = 0; i < 4; ++i) hist[lane + 64 * i] = 0u;
        LDS_WAIT();
        const int shift = pass * 8;
        for (int i = lane; i < n; i += 64) {
            const unsigned k = fkey(row[i]);
            const bool match = (pass == 3) || ((k >> (shift + 8)) == prefix);
            if (match) __hip_atomic_fetch_add(hist + ((k >> shift) & 255u), 1u, __ATOMIC_RELAXED, __HIP_MEMORY_SCOPE_WORKGROUP);
        }
        LDS_WAIT();
        const unsigned c0 = hist[4 * lane], c1 = hist[4 * lane + 1], c2 = hist[4 * lane + 2], c3 = hist[4 * lane + 3];
        const unsigned s = c0 + c1 + c2 + c3;
        unsigned incl = s;
#pragma unroll
        for (int o = 1; o < 64; o <<= 1) { const unsigned t = __shfl_down(incl, o); if (lane + o < 64) incl += t; }
        const unsigned excl = incl - s;
        const bool mine = (excl < (unsigned)need) && (incl >= (unsigned)need);
        unsigned bin = 0, above = 0;
        if (mine) {
            unsigned run = excl;
            if (run + c3 >= (unsigned)need) { bin = 4 * lane + 3; above = run; }
            else { run += c3;
                if (run + c2 >= (unsigned)need) { bin = 4 * lane + 2; above = run; }
                else { run += c2;
                    if (run + c1 >= (unsigned)need) { bin = 4 * lane + 1; above = run; }
                    else { run += c1; bin = 4 * lane; above = run; } } }
        }
        const unsigned long long bm = __ballot(mine);
        const int src = bm ? (int)__builtin_ctzll(bm) : 0;
        bin = __shfl(bin, src); above = __shfl(above, src);
        need -= (int)above; prefix = (prefix << 8) | bin;
        LDS_WAIT();
    }
    const unsigned Tk = prefix;
    int cnt = 0, eq_taken = 0;
    for (int i0 = 0; i0 < n; i0 += 64) {
        const int i = i0 + lane; const bool valid = i < n;
        const unsigned k = valid ? fkey(row[i]) : 0u;
        const bool gtk = valid && (k > Tk), eqk = valid && (k == Tk);
        const unsigned long long beq = __ballot(eqk);
        const int eq_rank = eq_taken + __builtin_popcountll(beq & lt);
        const bool take = gtk || (eqk && eq_rank < need);
        const unsigned long long bt = __ballot(take);
        const int pos = cnt + __builtin_popcountll(bt & lt);
        if (take && pos < 256) out[pos] = (unsigned short)i;
        cnt += __builtin_popcountll(bt); eq_taken += __builtin_popcountll(beq);
    }
}

__device__ __forceinline__ void select_row4(const LAS float* row, int n, LAS unsigned* hist, LAS unsigned* h2, unsigned short* out, int lane) {
    if (n <= 256) {
#pragma unroll
        for (int i = 0; i < 4; ++i) { const int k = lane + 64 * i; out[k] = (unsigned short)(k < n ? k : 0); }
#pragma unroll
        for (int i = 0; i < 8; ++i) hist[lane + 64 * i] = 0u;
        return;
    }
    const unsigned long long lt = (1ull << lane) - 1ull;
    unsigned b1, above;
    {
        const u32x4 w0 = *(const LAS u32x4*)(hist + 8 * lane), w1 = *(const LAS u32x4*)(hist + 8 * lane + 4);
        unsigned c[16];
        c[0] = w0.x & 0xffffu; c[1] = w0.x >> 16; c[2] = w0.y & 0xffffu; c[3] = w0.y >> 16; c[4] = w0.z & 0xffffu; c[5] = w0.z >> 16; c[6] = w0.w & 0xffffu; c[7] = w0.w >> 16;
        c[8] = w1.x & 0xffffu; c[9] = w1.x >> 16; c[10] = w1.y & 0xffffu; c[11] = w1.y >> 16; c[12] = w1.z & 0xffffu; c[13] = w1.z >> 16; c[14] = w1.w & 0xffffu; c[15] = w1.w >> 16;
        unsigned s = 0;
#pragma unroll
        for (int j = 0; j < 16; ++j) s += c[j];
        unsigned incl = s;
#pragma unroll
        for (int o = 1; o < 64; o <<= 1) { const unsigned t = __shfl_down(incl, o); if (lane + o < 64) incl += t; }
        const unsigned excl = incl - s;
        const bool mine = (excl < 256u) && (incl >= 256u);
        unsigned bin = 0, ab = 0, run = excl; bool found = false;
#pragma unroll
        for (int j = 15; j >= 0; --j) { if (!found && run + c[j] >= 256u) { bin = 16 * lane + j; ab = run; found = true; } if (!found) run += c[j]; }
        const unsigned long long bm = __ballot(mine);
        const int src = bm ? (int)__builtin_ctzll(bm) : 0;
        b1 = __shfl(bin, src); above = __shfl(ab, src);
    }
    LDS_WAIT();
    int need = 256 - (int)above;
    LAS unsigned short* cand = (LAS unsigned short*)hist;
    const int nblk = (n + 255) >> 8;
    int C = 0;
    for (int blk = 0; blk < nblk; ++blk) {
        const f32x4 v = *(const LAS f32x4*)(row + blk * 256 + 4 * lane);
        bool ge[4]; unsigned long long bl[4];
#pragma unroll
        for (int e = 0; e < 4; ++e) { ge[e] = (blk * 256 + 4 * lane + e < n) && (qbin(v[e]) >= b1); bl[e] = __ballot(ge[e]); }
        const int below = __builtin_popcountll(bl[0] & lt) + __builtin_popcountll(bl[1] & lt) + __builtin_popcountll(bl[2] & lt) + __builtin_popcountll(bl[3] & lt);
        int pos = C + below;
#pragma unroll
        for (int e = 0; e < 4; ++e) { if (ge[e]) { if (pos < 768) cand[pos] = (unsigned short)(blk * 256 + 4 * lane + e); ++pos; } }
        C += __builtin_popcountll(bl[0]) + __builtin_popcountll(bl[1]) + __builtin_popcountll(bl[2]) + __builtin_popcountll(bl[3]);
    }
    LDS_WAIT();
    if (C > 512) {
        select_row(row, n, h2, out, lane);
#pragma unroll
        for (int i = 0; i < 8; ++i) hist[lane + 64 * i] = 0u;
        return;
    }
    int ci[8]; unsigned ck[8]; bool cgt[8], ceq[8];
#pragma unroll
    for (int k = 0; k < 8; ++k) { const int j = lane + 64 * k; ci[k] = j < C ? (int)cand[j] : -1; }
#pragma unroll
    for (int k = 0; k < 8; ++k) { const float v = row[ci[k] < 0 ? 0 : ci[k]]; const unsigned bb = qbin(v); ck[k] = fkey(v); cgt[k] = ci[k] >= 0 && bb > b1; ceq[k] = ci[k] >= 0 && bb == b1; }
    unsigned prefix = 0;
#pragma unroll 1
    for (int pass = 3; pass >= 0; --pass) {
#pragma unroll
        for (int i = 0; i < 4; ++i) h2[lane + 64 * i] = 0u;
        LDS_WAIT();
        const int shift = pass * 8;
#pragma unroll
        for (int k = 0; k < 8; ++k) {
            const bool match = ceq[k] && ((pass == 3) || ((ck[k] >> (shift + 8)) == prefix));
            if (match) __hip_atomic_fetch_add(h2 + ((ck[k] >> shift) & 255u), 1u, __ATOMIC_RELAXED, __HIP_MEMORY_SCOPE_WORKGROUP);
        }
        LDS_WAIT();
        const unsigned c0 = h2[4 * lane], c1 = h2[4 * lane + 1], c2 = h2[4 * lane + 2], c3 = h2[4 * lane + 3];
        const unsigned s = c0 + c1 + c2 + c3;
        unsigned incl = s;
#pragma unroll
        for (int o = 1; o < 64; o <<= 1) { const unsigned t = __shfl_down(incl, o); if (lane + o < 64) incl += t; }
        const unsigned excl = incl - s;
        const bool mine = (excl < (unsigned)need) && (incl >= (unsigned)need);
        unsigned bin = 0, ab = 0;
        if (mine) {
            unsigned run = excl;
            if (run + c3 >= (unsigned)need) { bin = 4 * lane + 3; ab = run; }
            else { run += c3;
                if (run + c2 >= (unsigned)need) { bin = 4 * lane + 2; ab = run; }
                else { run += c2;
                    if (run + c1 >= (unsigned)need) { bin = 4 * lane + 1; ab = run; }
                    else { run += c1; bin = 4 * lane; ab = run; } } }
        }
        const unsigned long long bm = __ballot(mine);
        const int src = bm ? (int)__builtin_ctzll(bm) : 0;
        bin = __shfl(bin, src); ab = __shfl(ab, src);
        need -= (int)ab; prefix = (prefix << 8) | bin;
        LDS_WAIT();
    }
    const unsigned Tk = prefix;
    bool tk[8]; int ne = 0;
#pragma unroll
    for (int k = 0; k < 8; ++k) { tk[k] = ceq[k] && ck[k] == Tk; ne += __builtin_popcountll(__ballot(tk[k])); }
    if (ne > need) {
        bool keep[8];
#pragma unroll
        for (int k = 0; k < 8; ++k) keep[k] = false;
        for (int r = 0; r < need; ++r) {
            int mn = 0x7fffffff;
#pragma unroll
            for (int k = 0; k < 8; ++k) if (tk[k] && !keep[k] && ci[k] < mn) mn = ci[k];
#pragma unroll
            for (int o = 1; o < 64; o <<= 1) { const int t = __shfl_xor(mn, o); mn = t < mn ? t : mn; }
#pragma unroll
            for (int k = 0; k < 8; ++k) if (tk[k] && ci[k] == mn) keep[k] = true;
        }
#pragma unroll
        for (int k = 0; k < 8; ++k) tk[k] = keep[k];
    }
    LAS unsigned short* outL = cand + 768;
    int cnt = 0;
#pragma unroll
    for (int k = 0; k < 8; ++k) {
        const bool take = cgt[k] || (ceq[k] && ck[k] > Tk) || tk[k];
        const unsigned long long bt = __ballot(take);
        const int pos = cnt + __builtin_popcountll(bt & lt);
        if (take && pos < 256) outL[pos] = (unsigned short)ci[k];
        cnt += __builtin_popcountll(bt);
    }
    LDS_WAIT();
    *(u32x2*)(out + 4 * lane) = *(const LAS u32x2*)(outL + 4 * lane);
    LDS_WAIT();
#pragma unroll
    for (int i = 0; i < 8; ++i) hist[lane + 64 * i] = 0u;
}

__device__ __forceinline__ void ph_index(const P& p, LAS unsigned char* lds, const int wv) {
    LAS float* Irow = (LAS float*)lds;
    LAS unsigned* hist = (LAS unsigned*)(lds + 131072);
    LAS unsigned* h2 = (LAS unsigned*)(lds + 131072 + 16384);
    const int tid = opaque_tid(wv), lane = tid & 63, wave = __builtin_amdgcn_readfirstlane(tid >> 6);
    const int hh = lane >> 5, n = lane & 31;
    const int rho = lane & 31, qlA = 2 * ((rho >> 2) & 1) + (rho >> 4), hdA = (rho & 3) + 4 * ((rho >> 3) & 1);
#pragma unroll
    for (int i = 0; i < 8; ++i) hist[tid + NTHR * i] = 0u;
    bf16x8 A[2][4]; float wq[2][16]; bf16x8 B0[4], B1[4], B2[4];
#define IDX_LOAD_B(dst, kt_) do { const bf16_t* kp_ = p.KI + (mb + (size_t)(kt_) * 32 + n) * 64 + 8 * hh; \
        _Pragma("unroll") for (int s = 0; s < 4; ++s) dst[s] = *(const bf16x8*)(kp_ + 16 * s); } while (0)
#define IDX_LOAD_UNIT(u_) do { const int b_ = (u_) & 7, t0_ = (511 - ((u_) >> 3)) * 8; const size_t mb = (size_t)b_ * T; const int nkt_ = (t0_ + 8 + 31) >> 5; \
        _Pragma("unroll") for (int mt = 0; mt < 2; ++mt) { const bf16_t* src = p.QI + (mb + t0_ + mt * 4 + qlA) * 512 + hdA * 64 + 8 * hh; \
            _Pragma("unroll") for (int s = 0; s < 4; ++s) A[mt][s] = *(const bf16x8*)(src + 16 * s); \
            _Pragma("unroll") for (int c = 0; c < 2; ++c) { const float* wp = p.WI + (mb + t0_ + mt * 4 + 2 * hh + c) * 8; const f32x4 w0 = *(const f32x4*)wp, w1 = *(const f32x4*)(wp + 4); \
                _Pragma("unroll") for (int j = 0; j < 4; ++j) { wq[mt][c * 8 + j] = w0[j]; wq[mt][c * 8 + 4 + j] = w1[j]; } } } \
        if (wave < nkt_) IDX_LOAD_B(B0, wave); if (wave + NWAVES < nkt_) IDX_LOAD_B(B1, wave + NWAVES); if (wave + 2 * NWAVES < nkt_) IDX_LOAD_B(B2, wave + 2 * NWAVES); } while (0)
    if ((int)blockIdx.x < 4096) IDX_LOAD_UNIT((int)blockIdx.x);
    __syncthreads();
    for (int u = blockIdx.x; u < 4096; u += gridDim.x) {
        const int b = u & 7, tb = 511 - (u >> 3), t0 = tb * 8; const size_t mb = (size_t)b * T;
        const int nkt = (t0 + 8 + 31) >> 5;
#if defined(IDX_DUP_SCORE)
#pragma unroll 1
        for (int rep = 0; rep < 2; ++rep) {
        if (rep == 1) { if (wave < nkt) IDX_LOAD_B(B0, wave); if (wave + NWAVES < nkt) IDX_LOAD_B(B1, wave + NWAVES); if (wave + 2 * NWAVES < nkt) IDX_LOAD_B(B2, wave + 2 * NWAVES); }
#else
        { const int rep = 1;
#endif
#pragma unroll 1
        for (int kt = wave; kt < nkt; kt += NWAVES) {
            const int key = kt * 32 + n;
#pragma unroll
            for (int mt = 0; mt < 2; ++mt) {
                f32x16 acc;
#pragma unroll
                for (int j = 0; j < 16; ++j) acc[j] = 0.f;
#pragma unroll
                for (int s = 0; s < 4; ++s) acc = __builtin_amdgcn_mfma_f32_32x32x16_bf16(A[mt][s], B0[s], acc, 0, 0, 0);
#pragma unroll
                for (int c = 0; c < 2; ++c) {
                    float v = 0.f;
#pragma unroll
                    for (int h = 0; h < 8; ++h) v += wq[mt][c * 8 + h] * fmaxf(acc[c * 8 + h], 0.f);
                    const int r = mt * 4 + 2 * hh + c;
                    Irow[r * 4096 + key] = v;
                    if (key <= t0 + r) { const unsigned bin = qbin(v); __hip_atomic_fetch_add(hist + r * 512 + (bin >> 1), (unsigned)rep << ((bin & 1u) * 16u), __ATOMIC_RELAXED, __HIP_MEMORY_SCOPE_WORKGROUP); }
                }
            }
#pragma unroll
            for (int s = 0; s < 4; ++s) { B0[s] = B1[s]; B1[s] = B2[s]; }
            if (kt + 3 * NWAVES < nkt) IDX_LOAD_B(B2, kt + 3 * NWAVES);
        }
        }
        if (u + (int)gridDim.x < 4096) IDX_LOAD_UNIT(u + (int)gridDim.x);
        __syncthreads();
        select_row4(Irow + wave * 4096, t0 + wave + 1, hist + wave * 512, h2 + wave * 320, p.SEL + (mb + t0 + wave) * 256, lane);
        __syncthreads();
    }
#undef IDX_LOAD_B
#undef IDX_LOAD_UNIT
}

__device__ __forceinline__ bf16x4 tr16(const LAS unsigned char* a) { return __builtin_amdgcn_ds_read_tr16_b64_v4i16((LAS bf16x4*)a); }
__device__ __forceinline__ void ph_attn(const P& p, LAS unsigned char* lds, const int wv) {
    const int tid = opaque_tid(wv), lane = tid & 63, wave = __builtin_amdgcn_readfirstlane(tid >> 6);
    LAS unsigned char* buf = lds + wave * 8192;
    LAS unsigned char* selL = lds + 65536 + wave * 512;
    LAS unsigned char* tblb = lds + 69632;
    LAS float* bias = (LAS float*)(lds + 69632 + 128);
    LAS float* cst = (LAS float*)(lds + 69632 + 128 + 1024);
    for (int i = tid; i < 128; i += NTHR) {
        int bk = i;
        if (i >= 16) { const float nf = (float)i; bk = 16 + (int)(logf(nf / 16.f) / 2.0794415f * 16.f); if (bk > 31) bk = 31; }
        tblb[i] = (unsigned char)bk;
    }
    for (int i = tid; i < 256; i += NTHR) bias[i] = p.rel_bias[i];
    if (wave == 0) {
        float gm = fmaxf(fabsf(p.kv_g[lane]), fabsf(p.kv_g[lane + 64]));
        float bm = fmaxf(fmaxf(fabsf(p.rel_bias[lane]), fabsf(p.rel_bias[lane + 64])), fmaxf(fabsf(p.rel_bias[lane + 128]), fabsf(p.rel_bias[lane + 192])));
#pragma unroll
        for (int o = 1; o < 64; o <<= 1) { gm = fmaxf(gm, __shfl_xor(gm, o)); bm = fmaxf(bm, __shfl_xor(bm, o)); }
        if (lane == 0) { cst[0] = 11.3137085f * gm * 1.01f; cst[1] = bm; }
    }
    __syncthreads();
    const int g = lane >> 4, hcol = lane & 15, q4 = hcol >> 2, p4 = lane & 3;
    const float cmax = cst[0], bmax = cst[1];
    const int G = gridDim.x, bx = blockIdx.x, vcu = (G % 8 == 0) ? (bx % 8) * (G / 8) + bx / 8 : bx;
    for (int qc = vcu; qc < M / 128; qc += G) {
#pragma unroll 1
        for (int qi = 0; qi < 16; ++qi) {
            const int m = qc * 128 + wave * 16 + qi;
            const int t = m & (T - 1); const size_t mb = (size_t)(m >> 12) * T;
            const int nvalid = t + 1 < 256 ? t + 1 : 256;
            const u32x2 sv = *(const u32x2*)(p.SEL + (size_t)m * 256 + 4 * lane);
            bf16x8 qf[4];
#pragma unroll
            for (int s = 0; s < 4; ++s) {
                bf16x8 z;
#pragma unroll
                for (int j = 0; j < 8; ++j) z[j] = 0;
                qf[s] = hcol < 8 ? *(const bf16x8*)(p.QL + (size_t)m * 1024 + hcol * 128 + 32 * s + 8 * g) : z;
            }
            *(LAS u32x2*)(selL + lane * 8) = sv;
            float ss = 0.f;
#pragma unroll
            for (int s = 0; s < 4; ++s)
#pragma unroll
                for (int j = 0; j < 8; ++j) { const float v = bf2f((unsigned short)qf[s][j]); ss += v * v; }
            ss += __shfl_xor(ss, 16); ss += __shfl_xor(ss, 32);
            const float mh = sqrtf(ss) * cmax + bmax;
            bf16x8 st[2][4];
#define ATT_LOAD_CHUNK(c) do { _Pragma("unroll") for (int tau = 0; tau < 2; ++tau) { const int kp = 32 * (c) + 16 * tau + hcol; \
                const int key = kp < nvalid ? (int)*(const LAS unsigned short*)(selL + 2 * kp) : 0; const bf16_t* crow = p.CKVB + (mb + key) * 128 + 8 * g; \
                _Pragma("unroll") for (int s = 0; s < 4; ++s) st[tau][s] = *(const bf16x8*)(crow + 32 * s); } } while (0)
            ATT_LOAD_CHUNK(0);
            f32x4 o[8];
#pragma unroll
            for (int rt = 0; rt < 8; ++rt) o[rt] = (f32x4){0.f, 0.f, 0.f, 0.f};
            float lsum = 0.f;
#pragma unroll 1
            for (int c = 0; c < 8; ++c) {
                f32x4 acc[2];
#pragma unroll
                for (int tau = 0; tau < 2; ++tau) {
                    acc[tau] = (f32x4){0.f, 0.f, 0.f, 0.f};
#pragma unroll
                    for (int s = 0; s < 4; ++s) {
                        *(LAS bf16x8*)(buf + off_b(16 * tau + hcol, 4 * s + g)) = st[tau][s];
                        acc[tau] = __builtin_amdgcn_mfma_f32_16x16x32_bf16(st[tau][s], qf[s], acc[tau], 0, 0, 0);
                    }
                }
                if (c < 7) ATT_LOAD_CHUNK(c + 1);
                float pr[2][4];
#pragma unroll
                for (int tau = 0; tau < 2; ++tau) {
                    const int kp0 = 32 * c + 16 * tau + 4 * g;
                    const u32x2 kk = *(const LAS u32x2*)(selL + 2 * kp0);
                    const int keys[4] = {(int)(kk.x & 0xffffu), (int)(kk.x >> 16), (int)(kk.y & 0xffffu), (int)(kk.y >> 16)};
#pragma unroll
                    for (int r = 0; r < 4; ++r) {
                        const int dist = t - keys[r]; const bool valid = (kp0 + r) < nvalid;
                        const int dcl = dist < 0 ? 0 : (dist > 127 ? 127 : dist);
                        const int bk = dist < 128 ? (int)tblb[dcl] : 31;
                        const float e = __expf(acc[tau][r] + bias[bk * 8 + (hcol & 7)] - mh);
                        pr[tau][r] = valid ? e : 0.f; lsum += pr[tau][r];
                    }
                }
                u32x4 pw; pw.x = pk2(pr[0][0], pr[0][1]); pw.y = pk2(pr[0][2], pr[0][3]); pw.z = pk2(pr[1][0], pr[1][1]); pw.w = pk2(pr[1][2], pr[1][3]);
                const bf16x8 pf = __builtin_bit_cast(bf16x8, pw);
#pragma unroll
                for (int rt = 0; rt < 8; ++rt) {
                    const unsigned row0 = 4 * g + q4, ch = 2 * rt + (p4 >> 1);
                    const bf16x4 a0 = tr16(buf + off_b(row0, ch) + 8 * (p4 & 1));
                    const bf16x4 a1 = tr16(buf + off_b(row0 + 16, ch) + 8 * (p4 & 1));
                    o[rt] = __builtin_amdgcn_mfma_f32_16x16x32_bf16(cat4(a0, a1), pf, o[rt], 0, 0, 0);
                }
            }
#undef ATT_LOAD_CHUNK
            lsum += __shfl_xor(lsum, 16); lsum += __shfl_xor(lsum, 32);
            const float inv = 1.f / lsum;
            if (hcol < 8) {
#pragma unroll
                for (int rt = 0; rt < 8; ++rt) {
                    u32x2 w; w.x = pk2(o[rt][0] * inv, o[rt][1] * inv); w.y = pk2(o[rt][2] * inv, o[rt][3] * inv);
                    *(u32x2*)(p.OL + (size_t)m * 1024 + hcol * 128 + 16 * rt + 4 * g) = w;
                }
            }
        }
    }
}

struct Cand8 { float v[8]; int id[8]; unsigned bn[8]; bool ok[8]; };

__device__ __forceinline__ void coarse_thr(const Cand8& c, LAS unsigned* hist, int lane, unsigned& b1, unsigned& above) {
#pragma unroll
    for (int k = 0; k < 8; ++k) if (c.ok[k]) __hip_atomic_fetch_add(hist + (c.bn[k] >> 1), 1u << ((c.bn[k] & 1u) * 16u), __ATOMIC_RELAXED, __HIP_MEMORY_SCOPE_WORKGROUP);
    LDS_WAIT();
    const u32x4 w0 = *(const LAS u32x4*)(hist + 8 * lane), w1 = *(const LAS u32x4*)(hist + 8 * lane + 4);
    unsigned cc[16];
    cc[0] = w0.x & 0xffffu; cc[1] = w0.x >> 16; cc[2] = w0.y & 0xffffu; cc[3] = w0.y >> 16; cc[4] = w0.z & 0xffffu; cc[5] = w0.z >> 16; cc[6] = w0.w & 0xffffu; cc[7] = w0.w >> 16;
    cc[8] = w1.x & 0xffffu; cc[9] = w1.x >> 16; cc[10] = w1.y & 0xffffu; cc[11] = w1.y >> 16; cc[12] = w1.z & 0xffffu; cc[13] = w1.z >> 16; cc[14] = w1.w & 0xffffu; cc[15] = w1.w >> 16;
    unsigned s = 0;
#pragma unroll
    for (int j = 0; j < 16; ++j) s += cc[j];
    unsigned incl = s;
#pragma unroll
    for (int o = 1; o < 64; o <<= 1) { const unsigned t = __shfl_down(incl, o); if (lane + o < 64) incl += t; }
    const unsigned excl = incl - s;
    const bool mine = (excl < 256u) && (incl >= 256u);
    unsigned bin = 0, ab = 0, run = excl; bool found = false;
#pragma unroll
    for (int j = 15; j >= 0; --j) { if (!found && run + cc[j] >= 256u) { bin = 16 * lane + j; ab = run; found = true; } if (!found) run += cc[j]; }
    const unsigned long long bm = __ballot(mine);
    const int src = bm ? (int)__builtin_ctzll(bm) : 0;
    b1 = __shfl(bin, src); above = __shfl(ab, src);
    LDS_WAIT();
}

__device__ __forceinline__ void exact_take(const Cand8& c, unsigned b1, int need, LAS unsigned* h2, int lane, bool (&take)[8]) {
    unsigned ck[8]; bool ceq[8];
#pragma unroll
    for (int k = 0; k < 8; ++k) { ck[k] = fkey(c.v[k]); ceq[k] = c.ok[k] && c.bn[k] == b1; }
    unsigned prefix = 0;
#pragma unroll 1
    for (int pass = 3; pass >= 0; --pass) {
#pragma unroll
        for (int i = 0; i < 4; ++i) h2[lane + 64 * i] = 0u;
        LDS_WAIT();
        const int shift = pass * 8;
#pragma unroll
        for (int k = 0; k < 8; ++k) {
            const bool match = ceq[k] && ((pass == 3) || ((ck[k] >> (shift + 8)) == prefix));
            if (match) __hip_atomic_fetch_add(h2 + ((ck[k] >> shift) & 255u), 1u, __ATOMIC_RELAXED, __HIP_MEMORY_SCOPE_WORKGROUP);
        }
        LDS_WAIT();
        const unsigned c0 = h2[4 * lane], c1 = h2[4 * lane + 1], c2 = h2[4 * lane + 2], c3 = h2[4 * lane + 3];
        const unsigned s = c0 + c1 + c2 + c3;
        unsigned incl = s;
#pragma unroll
        for (int o = 1; o < 64; o <<= 1) { const unsigned t = __shfl_down(incl, o); if (lane + o < 64) incl += t; }
        const unsigned excl = incl - s;
        const bool mine = (excl < (unsigned)need) && (incl >= (unsigned)need);
        unsigned bin = 0, ab = 0;
        if (mine) {
            unsigned run = excl;
            if (run + c3 >= (unsigned)need) { bin = 4 * lane + 3; ab = run; }
            else { run += c3;
                if (run + c2 >= (unsigned)need) { bin = 4 * lane + 2; ab = run; }
                else { run += c2;
                    if (run + c1 >= (unsigned)need) { bin = 4 * lane + 1; ab = run; }
                    else { run += c1; bin = 4 * lane; ab = run; } } }
        }
        const unsigned long long bm = __ballot(mine);
        const int src = bm ? (int)__builtin_ctzll(bm) : 0;
        bin = __shfl(bin, src); ab = __shfl(ab, src);
        need -= (int)ab; prefix = (prefix << 8) | bin;
        LDS_WAIT();
    }
    const unsigned Tk = prefix;
    bool tk[8]; int ne = 0;
#pragma unroll
    for (int k = 0; k < 8; ++k) { tk[k] = ceq[k] && ck[k] == Tk; ne += __builtin_popcountll(__ballot(tk[k])); }
    if (ne > need) {
        bool keep[8];
#pragma unroll
        for (int k = 0; k < 8; ++k) keep[k] = false;
        for (int r = 0; r < need; ++r) {
            int mn = 0x7fffffff;
#pragma unroll
            for (int k = 0; k < 8; ++k) if (tk[k] && !keep[k] && c.id[k] < mn) mn = c.id[k];
#pragma unroll
            for (int o = 1; o < 64; o <<= 1) { const int t = __shfl_xor(mn, o); mn = t < mn ? t : mn; }
#pragma unroll
            for (int k = 0; k < 8; ++k) if (tk[k] && c.id[k] == mn) keep[k] = true;
        }
#pragma unroll
        for (int k = 0; k < 8; ++k) tk[k] = keep[k];
    }
#pragma unroll
    for (int k = 0; k < 8; ++k) take[k] = (c.ok[k] && c.bn[k] > b1) || (ceq[k] && ck[k] > Tk) || tk[k];
}


__device__ __forceinline__ void select_row_g(const float* row, int n, LAS unsigned* hist, unsigned short* out, int lane) {
    unsigned prefix = 0; int need = 256;
    const unsigned long long lt = (1ull << lane) - 1ull;
#pragma unroll 1
    for (int pass = 3; pass >= 0; --pass) {
#pragma unroll
        for (int i = 0; i < 4; ++i) hist[lane + 64 * i] = 0u;
        LDS_WAIT();
        const int shift = pass * 8;
        for (int i = lane; i < n; i += 64) {
            const unsigned k = fkey(row[i]);
            const bool match = (pass == 3) || ((k >> (shift + 8)) == prefix);
            if (match) __hip_atomic_fetch_add(hist + ((k >> shift) & 255u), 1u, __ATOMIC_RELAXED, __HIP_MEMORY_SCOPE_WORKGROUP);
        }
        LDS_WAIT();
        const unsigned c0 = hist[4 * lane], c1 = hist[4 * lane + 1], c2 = hist[4 * lane + 2], c3 = hist[4 * lane + 3];
        const unsigned s = c0 + c1 + c2 + c3;
        unsigned incl = s;
#pragma unroll
        for (int o = 1; o < 64; o <<= 1) { const unsigned t = __shfl_down(incl, o); if (lane + o < 64) incl += t; }
        const unsigned excl = incl - s;
        const bool mine = (excl < (unsigned)need) && (incl >= (unsigned)need);
        unsigned bin = 0, above = 0;
        if (mine) {
            unsigned run = excl;
            if (run + c3 >= (unsigned)need) { bin = 4 * lane + 3; above = run; }
            else { run += c3;
                if (run + c2 >= (unsigned)need) { bin = 4 * lane + 2; above = run; }
                else { run += c2;
                    if (run + c1 >= (unsigned)need) { bin = 4 * lane + 1; above = run; }
                    else { run += c1; bin = 4 * lane; above = run; } } }
        }
        const unsigned long long bm = __ballot(mine);
        const int src = bm ? (int)__builtin_ctzll(bm) : 0;
        bin = __shfl(bin, src); above = __shfl(above, src);
        need -= (int)above; prefix = (prefix << 8) | bin;
        LDS_WAIT();
    }
    const unsigned Tk = prefix;
    int cnt = 0, eq_taken = 0;
    for (int i0 = 0; i0 < n; i0 += 64) {
        const int i = i0 + lane; const bool valid = i < n;
        const unsigned k = valid ? fkey(row[i]) : 0u;
        const bool gtk = valid && (k > Tk), eqk = valid && (k == Tk);
        const unsigned long long beq = __ballot(eqk);
        const int eq_rank = eq_taken + __builtin_popcountll(beq & lt);
        const bool take = gtk || (eqk && eq_rank < need);
        const unsigned long long bt = __ballot(take);
        const int pos = cnt + __builtin_popcountll(bt & lt);
        if (take && pos < 256) out[pos] = (unsigned short)i;
        cnt += __builtin_popcountll(bt); eq_taken += __builtin_popcountll(beq);
    }
}

constexpr int IDX_CAP = 336;
__device__ __forceinline__ void ph_index6(const P& p, LAS unsigned char* lds, const int wv) {
    const int tid = opaque_tid(wv), lane = tid & 63, wave = __builtin_amdgcn_readfirstlane(tid >> 6);
    LAS unsigned char* KS = lds;
    LAS unsigned char* QR = lds + 32768 + wave * 4 * 2048;
    LAS unsigned* h2 = (LAS unsigned*)(lds + 98304) + wave * 256;
    const int hh = lane >> 5, n = lane & 31;
    const int rho = lane & 31, qlA = 2 * ((rho >> 2) & 1) + (rho >> 4), hdA = (rho & 3) + 4 * ((rho >> 3) & 1);
    const unsigned long long lt = (1ull << lane) - 1ull;
    const unsigned lt32 = (1u << n) - 1u;
    for (int gq = blockIdx.x; gq < 1024; gq += gridDim.x) {
        const int b = gq & 7, t0 = (127 - (gq >> 3)) * 32; const size_t mb = (size_t)b * T;
        const int tw = t0 + 4 * wave;
        bf16x8 A[4]; float wq[16];
        {
            const bf16_t* src = p.QI + (mb + tw + qlA) * 512 + hdA * 64 + 8 * hh;
#pragma unroll
            for (int s = 0; s < 4; ++s) A[s] = *(const bf16x8*)(src + 16 * s);
#pragma unroll
            for (int c = 0; c < 2; ++c) {
                const float* wp = p.WI + (mb + tw + 2 * hh + c) * 8;
                const f32x4 w0 = *(const f32x4*)wp, w1 = *(const f32x4*)(wp + 4);
#pragma unroll
                for (int j = 0; j < 4; ++j) { wq[c * 8 + j] = w0[j]; wq[c * 8 + 4 + j] = w1[j]; }
            }
        }
#pragma unroll
        for (int i = 0; i < 8; ++i) *(LAS u32x4*)(QR + (lane + 64 * i) * 16) = (u32x4){0u, 0u, 0u, 0u};
#pragma unroll
        for (int s = 0; s < 4; ++s) asm volatile("" :: "v"(A[s]));
#pragma unroll
        for (int j = 0; j < 16; ++j) asm volatile("" :: "v"(wq[j]));
        int cnt[4]; unsigned b1q[4], abq[4];
#pragma unroll
        for (int q = 0; q < 4; ++q) { cnt[q] = 0; b1q[q] = 0u; abq[q] = 0u; }
        const int nst = (t0 + 32 + 127) >> 7;
        const int qme = 2 * hh;
        const LAS unsigned char* myq = QR + qme * 2048;
#pragma unroll 1
        for (int sweep = 0; sweep < 2; ++sweep) {
            u32x4 sr[2];
#pragma unroll
            for (int i = 0; i < 2; ++i) { const int idx = tid + NTHR * i, row = idx >> 3, ch = idx & 7; sr[i] = *(const u32x4*)(p.KI + (mb + row) * 64 + ch * 8); }
#pragma unroll
            for (int i = 0; i < 2; ++i) { const int idx = tid + NTHR * i, row = idx >> 3, ch = idx & 7; *(LAS u32x4*)(KS + row * 128 + 16 * (ch ^ (row & 7))) = sr[i]; }
            __syncthreads();
#pragma unroll 1
            for (int st = 0; st < nst; ++st) {
                if (st + 1 < nst) {
#pragma unroll
                    for (int i = 0; i < 2; ++i) { const int idx = tid + NTHR * i, row = idx >> 3, ch = idx & 7; sr[i] = *(const u32x4*)(p.KI + (mb + (st + 1) * 128 + row) * 64 + ch * 8); }
                }
                const LAS unsigned char* kb = KS + (st & 1) * 16384;
#pragma unroll 1
                for (int tl = 0; tl < 4; ++tl) {
                    const int key0 = st * 128 + tl * 32;
                    if (key0 > tw + 3) break;
                    const int row = tl * 32 + n, key = key0 + n;
                    f32x16 acc;
#pragma unroll
                    for (int j = 0; j < 16; ++j) acc[j] = 0.f;
#pragma unroll
                    for (int s = 0; s < 4; ++s) {
                        const bf16x8 Bf = *(const LAS bf16x8*)(kb + row * 128 + 16 * ((2 * s + hh) ^ (row & 7)));
                        acc = __builtin_amdgcn_mfma_f32_32x32x16_bf16(A[s], Bf, acc, 0, 0, 0);
                    }
#pragma unroll
                    for (int c = 0; c < 2; ++c) {
                        float v = 0.f;
#pragma unroll
                        for (int h = 0; h < 8; ++h) v += wq[c * 8 + h] * fmaxf(acc[c * 8 + h], 0.f);
                        const unsigned bn = qbin(v);
                        const bool causal = key <= tw + qme + c;
                        if (sweep == 0) {
                            if (causal) __hip_atomic_fetch_add((LAS unsigned*)(myq + c * 2048) + (bn >> 1), 1u << ((bn & 1u) * 16u), __ATOMIC_RELAXED, __HIP_MEMORY_SCOPE_WORKGROUP);
                        } else {
                            const unsigned bl = hh ? b1q[2 + c] : b1q[c];
                            const bool pass = causal && (bn >= bl);
                            const unsigned long long mk = __ballot(pass);
                            const unsigned lo = (unsigned)mk, hi = (unsigned)(mk >> 32);
                            const int rank = hh ? __builtin_popcount(hi & lt32) : __builtin_popcount(lo & lt32);
                            const int pos = (hh ? cnt[2 + c] : cnt[c]) + rank;
                            if (pass && pos < IDX_CAP) { LAS unsigned char* qr = QR + (qme + c) * 2048; ((LAS float*)qr)[pos] = v; ((LAS unsigned short*)(qr + IDX_CAP * 4))[pos] = (unsigned short)key; }
                            cnt[c] += __builtin_popcount(lo); cnt[2 + c] += __builtin_popcount(hi);
                        }
                    }
                }
                if (st + 1 < nst) {
#pragma unroll
                    for (int i = 0; i < 2; ++i) { const int idx = tid + NTHR * i, row = idx >> 3, ch = idx & 7; *(LAS u32x4*)(KS + ((st + 1) & 1) * 16384 + row * 128 + 16 * (ch ^ (row & 7))) = sr[i]; }
                }
                __syncthreads();
            }
            if (sweep == 0) {
                LDS_WAIT();
#pragma unroll 1
                for (int q = 0; q < 4; ++q) {
                    unsigned b1 = 0u, above = 0u;
                    if (tw + q + 1 > 256) {
                        const LAS unsigned* hist = (const LAS unsigned*)(QR + q * 2048);
                        const u32x4 w0 = *(const LAS u32x4*)(hist + 8 * lane), w1 = *(const LAS u32x4*)(hist + 8 * lane + 4);
                        unsigned cc[16];
                        cc[0] = w0.x & 0xffffu; cc[1] = w0.x >> 16; cc[2] = w0.y & 0xffffu; cc[3] = w0.y >> 16; cc[4] = w0.z & 0xffffu; cc[5] = w0.z >> 16; cc[6] = w0.w & 0xffffu; cc[7] = w0.w >> 16;
                        cc[8] = w1.x & 0xffffu; cc[9] = w1.x >> 16; cc[10] = w1.y & 0xffffu; cc[11] = w1.y >> 16; cc[12] = w1.z & 0xffffu; cc[13] = w1.z >> 16; cc[14] = w1.w & 0xffffu; cc[15] = w1.w >> 16;
                        unsigned s = 0;
#pragma unroll
                        for (int j = 0; j < 16; ++j) s += cc[j];
                        unsigned incl = s;
#pragma unroll
                        for (int o = 1; o < 64; o <<= 1) { const unsigned t = __shfl_down(incl, o); if (lane + o < 64) incl += t; }
                        const unsigned excl = incl - s;
                        const bool mine = (excl < 256u) && (incl >= 256u);
                        unsigned bin = 0, ab = 0, run = excl; bool found = false;
#pragma unroll
                        for (int j = 15; j >= 0; --j) { if (!found && run + cc[j] >= 256u) { bin = 16 * lane + j; ab = run; found = true; } if (!found) run += cc[j]; }
                        const unsigned long long bm = __ballot(mine);
                        const int src = bm ? (int)__builtin_ctzll(bm) : 0;
                        b1 = __shfl(bin, src); above = __shfl(ab, src);
                    }
#pragma unroll
                    for (int qq = 0; qq < 4; ++qq) { b1q[qq] = qq == q ? b1 : b1q[qq]; abq[qq] = qq == q ? above : abq[qq]; }
                }
                LDS_WAIT();
            }
        }
        LDS_WAIT();
#pragma unroll 1
        for (int q = 0; q < 4; ++q) {
            unsigned short* out = p.SEL + (mb + tw + q) * 256;
            const int nq = tw + q + 1;
            const int cq = q == 0 ? cnt[0] : q == 1 ? cnt[1] : q == 2 ? cnt[2] : cnt[3];
            const unsigned b1 = q == 0 ? b1q[0] : q == 1 ? b1q[1] : q == 2 ? b1q[2] : b1q[3];
            const unsigned above = q == 0 ? abq[0] : q == 1 ? abq[1] : q == 2 ? abq[2] : abq[3];
            if (nq <= 256) {
#pragma unroll
                for (int i = 0; i < 4; ++i) { const int k = lane + 64 * i; out[k] = (unsigned short)(k < nq ? k : 0); }
            } else if (cq <= IDX_CAP) {
                const LAS float* cv = (const LAS float*)(QR + q * 2048); const LAS unsigned short* cix = (const LAS unsigned short*)(QR + q * 2048 + IDX_CAP * 4);
                Cand8 c;
#pragma unroll
                for (int k = 0; k < 8; ++k) { const int j = lane + 64 * k; c.ok[k] = j < cq; c.v[k] = c.ok[k] ? cv[j] : 0.f; c.id[k] = c.ok[k] ? (int)cix[j] : 0; c.bn[k] = qbin(c.v[k]); }
                bool take[8];
                exact_take(c, b1, 256 - (int)above, h2, lane, take);
                LDS_WAIT();
                LAS unsigned short* outL = (LAS unsigned short*)(QR + q * 2048);
                int np = 0;
#pragma unroll
                for (int k = 0; k < 8; ++k) {
                    const unsigned long long bt = __ballot(take[k]);
                    const int pos = np + __builtin_popcountll(bt & lt);
                    if (take[k] && pos < 256) outL[pos] = (unsigned short)c.id[k];
                    np += __builtin_popcountll(bt);
                }
                LDS_WAIT();
                *(u32x2*)(out + 4 * lane) = *(const LAS u32x2*)(outL + 4 * lane);
                LDS_WAIT();
            } else {
                float* grow = p.IDXROW + (size_t)(blockIdx.x * NWAVES + wave) * 4096;
                const bf16_t* qsrc = p.QI + (mb + tw + q) * 512; const float* wsrc = p.WI + (mb + tw + q) * 8;
                for (int key = lane; key < nq; key += 64) {
                    const bf16_t* kr = p.KI + (mb + key) * 64;
                    float sc = 0.f;
                    for (int h = 0; h < 8; ++h) { float d = 0.f; for (int e = 0; e < 64; ++e) d += bf2f(qsrc[h * 64 + e]) * bf2f(kr[e]); sc += wsrc[h] * fmaxf(d, 0.f); }
                    grow[key] = sc;
                }
                asm volatile("s_waitcnt vmcnt(0)" ::: "memory");
                select_row_g(grow, nq, h2, out, lane);
            }
        }
        __syncthreads();
    }
}

__device__ __forceinline__ void ph_gmlp(const P& p, LAS unsigned char* lds, const int wv) {
    const int tid = opaque_tid(wv), lane = tid & 63, wave = __builtin_amdgcn_readfirstlane(tid >> 6);
    LAS unsigned char* vt = lds;
    LAS float* st = (LAS float*)(lds + 32768);
    const unsigned vbase = lds_addr_of(vt);
    const int g4 = lane >> 4, q4 = (lane & 15) >> 2, p4 = lane & 3;
    for (int u = blockIdx.x; u < 256; u += gridDim.x) {
        const size_t m0 = (size_t)u * 128;
        for (int rr = 0; rr < 16; ++rr) {
            const int row = 16 * wave + rr;
            const u32x4 w = *(const u32x4*)(p.VB + (m0 + row) * 512 + lane * 8);
            const float x0 = bflo(w.x), x1 = bfhi(w.x), x2 = bflo(w.y), x3 = bfhi(w.y), x4 = bflo(w.z), x5 = bfhi(w.z), x6 = bflo(w.w), x7 = bfhi(w.w);
            const float mean = wave_sum(((x0 + x1) + (x2 + x3)) + ((x4 + x5) + (x6 + x7))) * (1.f / 512.f);
            const float d0 = x0 - mean, d1 = x1 - mean, d2 = x2 - mean, d3 = x3 - mean, d4 = x4 - mean, d5 = x5 - mean, d6 = x6 - mean, d7 = x7 - mean;
            const float var = wave_sum(((d0 * d0 + d1 * d1) + (d2 * d2 + d3 * d3)) + ((d4 * d4 + d5 * d5) + (d6 * d6 + d7 * d7))) * (1.f / 512.f);
            if (lane == 0) { st[2 * row] = mean; st[2 * row + 1] = 1.0f / sqrtf(var + EPS); }
        }
        __syncthreads();
#pragma unroll 1
        for (int g = 0; g < 4; ++g) {
#pragma unroll
            for (int i = 0; i < 4; ++i) {
                const int piece = i * NTHR + tid, row = piece >> 4, ch = piece & 15;
                const u32x4 w = *(const u32x4*)(p.VB + (m0 + row) * 512 + g * 128 + ch * 8);
                const float mean = st[2 * row], rstd = st[2 * row + 1];
                const f32x4 ga = *(const f32x4*)(p.ln_g + g * 128 + ch * 8), gb = *(const f32x4*)(p.ln_g + g * 128 + ch * 8 + 4);
                const f32x4 ba = *(const f32x4*)(p.ln_b + g * 128 + ch * 8), bb = *(const f32x4*)(p.ln_b + g * 128 + ch * 8 + 4);
                u32x4 o;
                o.x = pk2((bflo(w.x) - mean) * rstd * ga[0] + ba[0], (bfhi(w.x) - mean) * rstd * ga[1] + ba[1]);
                o.y = pk2((bflo(w.y) - mean) * rstd * ga[2] + ba[2], (bfhi(w.y) - mean) * rstd * ga[3] + ba[3]);
                o.z = pk2((bflo(w.z) - mean) * rstd * gb[0] + bb[0], (bfhi(w.z) - mean) * rstd * gb[1] + bb[1]);
                o.w = pk2((bflo(w.w) - mean) * rstd * gb[2] + bb[2], (bfhi(w.w) - mean) * rstd * gb[3] + bb[3]);
                *(LAS u32x4*)(vt + off_b(row, ch)) = o;
            }
            __syncthreads();
            f32x4 acc[8];
#pragma unroll
            for (int et = 0; et < 8; ++et) acc[et] = (f32x4){0.f, 0.f, 0.f, 0.f};
            const int nks = ((16 * wave + 15) >> 5) + 1;
#pragma unroll
            for (int ks = 0; ks < 4; ++ks) {
                if (ks < nks) {
                    const bf16x8 a = *(const bf16x8*)(p.WSB + ((size_t)g * 128 + 16 * wave + (lane & 15)) * 128 + 32 * ks + 8 * g4);
#pragma unroll
                    for (int et = 0; et < 8; ++et) {
                        const unsigned r0 = 32 * ks + 8 * g4 + q4, ch = 2 * et + (p4 >> 1);
                        const bf16x4 b0 = tr_read(vbase + off_b(r0, ch) + 8 * (p4 & 1));
                        const bf16x4 b1 = tr_read(vbase + off_b(r0 + 4, ch) + 8 * (p4 & 1));
                        acc[et] = __builtin_amdgcn_mfma_f32_16x16x32_bf16(a, cat4(b0, b1), acc[et], 0, 0, 0);
                    }
                }
            }
#pragma unroll
            for (int r = 0; r < 4; ++r) {
                const int i = 16 * wave + 4 * g4 + r; const float bs = p.b_sp[g * 128 + i];
#pragma unroll
                for (int et = 0; et < 8; ++et) {
                    const size_t o = (m0 + i) * 512 + g * 128 + 16 * et + (lane & 15);
                    p.US[o] = (bf16_t)f2bf(bf2f(p.UB[o]) * (acc[et][r] + bs));
                }
            }
            __syncthreads();
        }
    }
}

__device__ __forceinline__ float dot16(const f32x4 (&hv)[4], const LAS float* wr, int lane) {
    float s = 0.f;
#pragma unroll
    for (int j = 0; j < 4; ++j) { const f32x4 w = ((const LAS f32x4*)wr)[lane + 64 * j]; s += (hv[j].x * w.x + hv[j].y * w.y) + (hv[j].z * w.z + hv[j].w * w.w); }
    return s;
}
__device__ __forceinline__ void ph_router(const P& p, LAS unsigned char* lds, const int wv) {
    const int tid = opaque_tid(wv), lane = tid & 63, wave = __builtin_amdgcn_readfirstlane(tid >> 6);
    LAS float* WL = (LAS float*)lds;
    LAS unsigned* cnt = (LAS unsigned*)(lds + 147456);
    const float* X1 = p.out;
    for (int i = tid; i < 36 * 256; i += NTHR) ((LAS f32x4*)WL)[i] = ((const f32x4*)p.WrT)[i];
    __syncthreads();
    for (int c = blockIdx.x; c < M / 128; c += gridDim.x) {
        if (tid < 32) cnt[tid] = 0u;
        __syncthreads();
#pragma unroll 1
        for (int it = 0; it < 8; ++it) {
            const int m = c * 128 + wave * 16 + it * 2;
            f32x4 hv[2][4];
#pragma unroll
            for (int rr = 0; rr < 2; ++rr) {
                const f32x4* xr = (const f32x4*)(X1 + (size_t)(m + rr) * D) + lane;
#pragma unroll
                for (int j = 0; j < 4; ++j) hv[rr][j] = xr[64 * j];
            }
#pragma unroll
            for (int rr = 0; rr < 2; ++rr) {
                float s = 0.f;
#pragma unroll
                for (int j = 0; j < 4; ++j) s += (hv[rr][j].x * hv[rr][j].x + hv[rr][j].y * hv[rr][j].y) + (hv[rr][j].z * hv[rr][j].z + hv[rr][j].w * hv[rr][j].w);
                const float rinv = 1.0f / sqrtf(wave_sum(s) * (1.f / D) + EPS);
                unsigned long long* o8 = (unsigned long long*)(p.H2B + (size_t)(m + rr) * D) + lane;
#pragma unroll
                for (int j = 0; j < 4; ++j) { const f32x4 g = ((const f32x4*)p.n2g)[lane + 64 * j]; hv[rr][j] = hv[rr][j] * rinv * g;
                    o8[64 * j] = (unsigned long long)pk2(hv[rr][j].x, hv[rr][j].y) | ((unsigned long long)pk2(hv[rr][j].z, hv[rr][j].w) << 32); }
            }
            float gl[2][4];
#pragma unroll
            for (int cc = 0; cc < 4; ++cc) {
#pragma unroll
                for (int rr = 0; rr < 2; ++rr) gl[rr][cc] = dot16(hv[rr], WL + cc * 1024, lane);
                asm volatile("" ::: "memory");
            }
#pragma unroll
            for (int rr = 0; rr < 2; ++rr)
#pragma unroll
                for (int cc = 0; cc < 4; ++cc) gl[rr][cc] = wave_sum(gl[rr][cc]) + p.rg_b[cc];
            int gi[2]; float gwt[2];
#pragma unroll
            for (int rr = 0; rr < 2; ++rr) {
                int g = 0; float gm = gl[rr][0];
#pragma unroll
                for (int i = 1; i < 4; ++i) if (gl[rr][i] > gm) { gm = gl[rr][i]; g = i; }
                float gs = 0.f;
#pragma unroll
                for (int i = 0; i < 4; ++i) gs += __expf(gl[rr][i] - gm);
                gi[rr] = __builtin_amdgcn_readfirstlane(g); gwt[rr] = 1.f / gs;
            }
            float el[2][8];
#pragma unroll
            for (int cc = 0; cc < 8; ++cc) {
#pragma unroll
                for (int rr = 0; rr < 2; ++rr) el[rr][cc] = dot16(hv[rr], WL + (4 + gi[rr] * 8 + cc) * 1024, lane);
                asm volatile("" ::: "memory");
            }
#pragma unroll
            for (int rr = 0; rr < 2; ++rr)
#pragma unroll
                for (int cc = 0; cc < 8; ++cc) el[rr][cc] = wave_sum(el[rr][cc]) + p.re_b[gi[rr] * 8 + cc];
#pragma unroll
            for (int rr = 0; rr < 2; ++rr) {
                int i1 = 0; float m1 = el[rr][0];
#pragma unroll
                for (int j = 1; j < 8; ++j) if (el[rr][j] > m1) { m1 = el[rr][j]; i1 = j; }
                int i2 = 0; float m2 = -INFINITY;
#pragma unroll
                for (int j = 0; j < 8; ++j) if (j != i1 && el[rr][j] > m2) { m2 = el[rr][j]; i2 = j; }
                const float e2r = __expf(m2 - m1), e1 = 1.f / (1.f + e2r), e2 = e2r * e1;
                if (lane == 0) {
                    const int ea = gi[rr] * 8 + i1, eb = gi[rr] * 8 + i2;
                    p.EID[2 * (m + rr)] = ea; p.EID[2 * (m + rr) + 1] = eb;
                    p.EW[2 * (m + rr)] = gwt[rr] * e1; p.EW[2 * (m + rr) + 1] = gwt[rr] * e2;
                    __hip_atomic_fetch_add(cnt + ea, 1u, __ATOMIC_RELAXED, __HIP_MEMORY_SCOPE_WORKGROUP);
                    __hip_atomic_fetch_add(cnt + eb, 1u, __ATOMIC_RELAXED, __HIP_MEMORY_SCOPE_WORKGROUP);
                }
            }
        }
        __syncthreads();
        if (tid < 32) p.BLKCNT[c * 32 + tid] = (int)cnt[tid];
        __syncthreads();
    }
}

__device__ __forceinline__ void ph_scan(const P& p, LAS unsigned char* lds, const int wv) {
    if (blockIdx.x != 0) return;
    const int tid = opaque_tid(wv);
    LAS int* s = (LAS int*)lds;
    const int e = tid & 31, part = tid >> 5;
    int loc[16]; int sum = 0;
#pragma unroll
    for (int i = 0; i < 16; ++i) { loc[i] = p.BLKCNT[(part * 16 + i) * 32 + e]; sum += loc[i]; }
    s[128 + part * 32 + e] = sum;
    __syncthreads();
    if (tid < 32) { int t = 0; for (int k = 0; k < 16; ++k) { const int v = s[128 + k * 32 + tid]; s[128 + k * 32 + tid] = t; t += v; } s[tid] = t; }
    __syncthreads();
    if (tid == 0) { int off = 0; for (int k = 0; k < 32; ++k) { s[32 + k] = off; off += (s[k] + 255) >> 8; } s[64] = off; }
    __syncthreads();
    const int ntiles = s[64];
    {
        int run = s[32 + e] * 256 + s[128 + part * 32 + e];
#pragma unroll
        for (int i = 0; i < 16; ++i) { p.CB[(part * 16 + i) * 32 + e] = run; run += loc[i]; }
    }
    if (tid < 32) { p.MOEI[tid] = s[32 + tid] * 256; p.MOEI[32 + tid] = s[32 + tid]; }
    if (tid == 0) { p.MOEI[64] = ntiles; p.MOEI[65] = ntiles * 2; p.MOEI[66] = ntiles * 4; }
    for (int rt = tid; rt < ntiles; rt += NTHR) {
        int ex = 0;
        for (int k = 0; k < 32; ++k) { const int tb = s[32 + k], nt = (s[k] + 255) >> 8; if (rt >= tb && rt < tb + nt) ex = k; }
        p.GU[4 * rt + 0] = rt; p.GU[4 * rt + 1] = ex * 2; p.GU[4 * rt + 2] = rt; p.GU[4 * rt + 3] = ex * 2 + 1;
#pragma unroll
        for (int j = 0; j < 4; ++j) { p.DN[8 * rt + 2 * j] = rt; p.DN[8 * rt + 2 * j + 1] = ex * 4 + j; }
    }
    for (int k = 0; k < 32; ++k) {
        const int lo = s[32 + k] * 256 + s[k], hi = (s[32 + k] + ((s[k] + 255) >> 8)) * 256;
        for (int i = lo + tid; i < hi; i += NTHR) p.PTOK[i] = -1;
    }
}

__device__ __forceinline__ void ph_scatter(const P& p, LAS unsigned char* lds, const int wv) {
    const int tid = opaque_tid(wv), lane = tid & 63, wave = __builtin_amdgcn_readfirstlane(tid >> 6);
    LAS int* se = (LAS int*)lds;
    for (int c = blockIdx.x; c < M / 128; c += gridDim.x) {
        int e = 0;
        if (tid < 256) { e = p.EID[c * 256 + tid]; se[tid] = e; }
        __syncthreads();
        if (tid < 256) {
            int rank = 0;
            for (int t = 0; t < tid; ++t) rank += (se[t] == e) ? 1 : 0;
            const int pos = p.CB[c * 32 + e] + rank;
            se[256 + tid] = pos; p.PTOK[pos] = c * 256 + tid;
        }
        __syncthreads();
#pragma unroll 4
        for (int i = 0; i < 32; ++i) {
            const int t = wave * 32 + i, pos = se[256 + t];
            const u32x4* src = (const u32x4*)(p.H2B + (size_t)(c * 128 + (t >> 1)) * D); u32x4* dst = (u32x4*)(p.H2S + (size_t)pos * D);
            const u32x4 a = src[lane], b = src[lane + 64];
            dst[lane] = a; dst[lane + 64] = b;
        }
        __syncthreads();
    }
}

template <bool DRY> __device__ __forceinline__ void ph_final(const P& p, const int wv) {
    const int tid = opaque_tid(wv), lane = tid & 63, wave = tid >> 6;
    const int gw = blockIdx.x * NWAVES + wave, NGW = gridDim.x * NWAVES;
    for (int m4 = gw; m4 < M / 4; m4 += NGW) {
        f32x4 v[4][4]; float s[4];
#pragma unroll
        for (int rr = 0; rr < 4; ++rr) {
            const int m = 4 * m4 + rr;
            const f32x4* xr = (const f32x4*)(p.out + (size_t)m * D) + lane;
            const u32x2* y0 = (const u32x2*)(p.YS + (size_t)m * D) + lane; const u32x2* y1 = (const u32x2*)(p.YS + ((size_t)M + m) * D) + lane;
            s[rr] = 0.f;
#pragma unroll
            for (int j = 0; j < 4; ++j) {
                v[rr][j] = xr[64 * j]; const u32x2 a = y0[64 * j], b = y1[64 * j];
                v[rr][j].x += bflo(a.x) + bflo(b.x); v[rr][j].y += bfhi(a.x) + bfhi(b.x); v[rr][j].z += bflo(a.y) + bflo(b.y); v[rr][j].w += bfhi(a.y) + bfhi(b.y);
                s[rr] += (v[rr][j].x * v[rr][j].x + v[rr][j].y * v[rr][j].y) + (v[rr][j].z * v[rr][j].z + v[rr][j].w * v[rr][j].w);
            }
        }
#pragma unroll
        for (int rr = 0; rr < 4; ++rr) {
            const float rinv = 1.0f / sqrtf(wave_sum(s[rr]) * (1.f / D) + EPS);
            f32x4* xr = (f32x4*)((DRY ? (float*)p.GBB : p.out) + (size_t)(4 * m4 + rr) * D) + lane;
#pragma unroll
            for (int j = 0; j < 4; ++j) { const f32x4 g = ((const f32x4*)p.fg)[lane + 64 * j]; xr[64 * j] = v[rr][j] * rinv * g; }
        }
    }
}

__device__ __forceinline__ void ph_gemm_in(const P& p, LAS unsigned char* lds, const int wv) {
    pg8::Gemm g{p.HB, p.WinT, M, NIN, 1024}; pg8::StaticOrder S; S.init(M, NIN, gridDim.x, (int)blockIdx.x);
    EpiIn E{p.QL, p.QI, p.KI, p.UB, p.VB, p.GAB, p.GBB, p.CKVR, p.WI};
    pg8::gemm_phase<EpiIn, pg8::StaticOrder, true, true>(lds, g, S, E, wv);
}
__device__ __forceinline__ void ph_gemm_yb(const P& p, LAS unsigned char* lds, const int wv) {
    pg8::Gemm g{p.US, p.WpbT, M, 1024, 512}; pg8::StaticOrder S; S.init(M, 1024, gridDim.x, (int)blockIdx.x);
    EpiMB E{p.GBB, p.MB};
    pg8::gemm_phase<EpiMB, pg8::StaticOrder, true, true>(lds, g, S, E, wv);
}
__device__ __forceinline__ void ph_gemm_ya(const P& p, LAS unsigned char* lds, const int wv) {
    pg8::Gemm g{p.OL, p.WovT, M, 1024, 1024}; pg8::StaticOrder S; S.init(M, 1024, gridDim.x, (int)blockIdx.x);
    EpiMG E{p.GAB, p.MB, p.MG};
    pg8::gemm_phase<EpiMG, pg8::StaticOrder, true, true>(lds, g, S, E, wv);
}
__device__ __forceinline__ void ph_gemm_out(const P& p, LAS unsigned char* lds, const int wv) {
    pg8::Gemm g{p.MG, p.WoutT, M, 1024, 1024}; pg8::StaticOrder S; S.init(M, 1024, gridDim.x, (int)blockIdx.x);
    EpiX1 E{p.x, p.out};
    pg8::gemm_phase<EpiX1, pg8::StaticOrder, true, true>(lds, g, S, E, wv);
}
__device__ __forceinline__ void ph_gemm_gu(const P& p, LAS unsigned char* lds, const int wv) {
    pg8::Gemm g{p.H2S, p.WguT, NPOS, 32 * 512, 1024}; TableOrder S{p.GU, p.MOEI + 65, (int)gridDim.x, (int)blockIdx.x};
    EpiHE E{p.HE};
    pg8::gemm_phase<EpiHE, TableOrder, true, true>(lds, g, S, E, wv);
}
__device__ __forceinline__ void ph_gemm_dn(const P& p, LAS unsigned char* lds, const int wv) {
    pg8::Gemm g{p.HE, p.WdT, NPOS, 32 * 1024, 256}; TableOrder S{p.DN, p.MOEI + 66, (int)gridDim.x, (int)blockIdx.x};
    EpiDown E{p.PTOK, p.EW, p.YS};
    pg8::gemm_phase<EpiDown, TableOrder, true, true>(lds, g, S, E, wv);
}

constexpr int NPHASE = 15;
template <int PH> __device__ __forceinline__ void run_phase(const P& p, LAS unsigned char* lds, const int wv) {
    if constexpr (PH == 0) ph_prep(p, lds, wv);
    if constexpr (PH == 1) ph_gemm_in(p, lds, wv);
    if constexpr (PH == 2) ph_ckvnorm(p, wv);
    if constexpr (PH == 3) ph_index(p, lds, wv);
    if constexpr (PH == 4) ph_attn(p, lds, wv);
    if constexpr (PH == 5) ph_gmlp(p, lds, wv);
    if constexpr (PH == 6) ph_gemm_yb(p, lds, wv);
    if constexpr (PH == 7) ph_gemm_ya(p, lds, wv);
    if constexpr (PH == 8) ph_gemm_out(p, lds, wv);
    if constexpr (PH == 9) ph_router(p, lds, wv);
    if constexpr (PH == 10) ph_scan(p, lds, wv);
    if constexpr (PH == 11) ph_scatter(p, lds, wv);
    if constexpr (PH == 12) ph_gemm_gu(p, lds, wv);
    if constexpr (PH == 13) ph_gemm_dn(p, lds, wv);
    if constexpr (PH == 14) ph_final<false>(p, wv);
}
template <int PH> __global__ void __launch_bounds__(NTHR, 2) k_phase(P p) {
    extern __shared__ __attribute__((aligned(16))) unsigned char lds_raw[];
    run_phase<PH>(p, (LAS unsigned char*)lds_raw, __builtin_amdgcn_readfirstlane(threadIdx.x >> 6));
}

constexpr int MISC_OFF = LDS_BYTES - 256;
__global__ void __launch_bounds__(NTHR, 2) k_mega(P p) {
    extern __shared__ __attribute__((aligned(16))) unsigned char lds_raw[];
    LAS unsigned char* lds = (LAS unsigned char*)lds_raw;
    volatile LAS unsigned* MISC = (volatile LAS unsigned*)(lds + MISC_OFF);
    int wv = __builtin_amdgcn_readfirstlane(threadIdx.x >> 6); asm volatile("" : "+s"(wv));
    if (threadIdx.x < 64) MISC[threadIdx.x] = 0u;
    __syncthreads();
    XcdBarrier bar = xcd_barrier_post(p.ctl + CW_BAR, MISC, wv);
    run_phase<0>(p, lds, wv);
#if defined(DUP0)
    __syncthreads(); run_phase<0>(p, lds, wv);
#endif
    xcd_barrier(bar);
    run_phase<1>(p, lds, wv);
#if defined(DUP1)
    __syncthreads(); run_phase<1>(p, lds, wv);
#endif
    xcd_barrier(bar);
    run_phase<2>(p, lds, wv);
#if defined(DUP2)
    run_phase<2>(p, lds, wv);
#endif
    run_phase<3>(p, lds, wv);
#if defined(DUP3)
    __syncthreads(); run_phase<3>(p, lds, wv);
#endif
    xcd_barrier(bar);
    run_phase<4>(p, lds, wv);  __syncthreads();
#if defined(DUP4)
    run_phase<4>(p, lds, wv);  __syncthreads();
#endif
    run_phase<5>(p, lds, wv);
#if defined(DUP5)
    __syncthreads(); run_phase<5>(p, lds, wv);
#endif
    xcd_barrier(bar);
    run_phase<6>(p, lds, wv);
    run_phase<7>(p, lds, wv);  xcd_barrier(bar);
    run_phase<8>(p, lds, wv);
#if defined(DUP678)
    __syncthreads(); run_phase<6>(p, lds, wv); run_phase<7>(p, lds, wv); xcd_barrier(bar); run_phase<8>(p, lds, wv);
#endif
    xcd_barrier(bar);
    run_phase<9>(p, lds, wv);
#if defined(DUP9)
    __syncthreads(); run_phase<9>(p, lds, wv);
#endif
    xcd_barrier(bar);
    run_phase<10>(p, lds, wv);
#if defined(DUP10)
    __syncthreads(); run_phase<10>(p, lds, wv);
#endif
    xcd_barrier(bar);
    run_phase<11>(p, lds, wv);
#if defined(DUP11)
    __syncthreads(); run_phase<11>(p, lds, wv);
#endif
    xcd_barrier(bar);
    run_phase<12>(p, lds, wv);
#if defined(DUP12)
    __syncthreads(); run_phase<12>(p, lds, wv);
#endif
    xcd_barrier(bar);
    run_phase<13>(p, lds, wv);
#if defined(DUP13)
    __syncthreads(); run_phase<13>(p, lds, wv);
#endif
    xcd_barrier(bar);
#if defined(XBAR10)
    for (int i = 0; i < 10; ++i) xcd_barrier(bar);
#endif
#if defined(DUP14)
    ph_final<true>(p, wv); __syncthreads();
#endif
    run_phase<14>(p, lds, wv);
}

extern "C" void kernel_launch(void* const* d_in, const int* in_sizes, int n_in, void* d_out, int out_size, void* d_ws, size_t ws_size, hipStream_t stream) {
    static int grid = 0; static bool first = true;
    if (grid == 0) {
        if (n_in != 23 || in_sizes[0] != M * D || out_size != M * D || ws_size < WS_END) { fprintf(stderr, "kernel_launch: unexpected shapes (n_in %d, in0 %d, out %d, ws %zu)\n", n_in, n_in > 0 ? in_sizes[0] : -1, out_size, ws_size); grid = -1; return; }
        int dev = 0, cus = 0;
        if (hipGetDevice(&dev) != hipSuccess || hipDeviceGetAttribute(&cus, hipDeviceAttributeMultiprocessorCount, dev) != hipSuccess) { grid = -1; return; }
        grid = cus;
    }
    if (grid < 0) return;
    unsigned char* ws = (unsigned char*)d_ws;
    (void)hipMemsetAsync(ws + WS_CTL, 0, CTL_ZERO_BYTES, stream);
    P p{};
    const float* const* in = (const float* const*)d_in;
    p.x = in[0]; p.w_in = in[1]; p.kv_g = in[2]; p.w_uk = in[3]; p.w_uv = in[4]; p.rel_bias = in[5]; p.ln_g = in[6]; p.ln_b = in[7]; p.w_sp = in[8]; p.b_sp = in[9];
    p.w_pa = in[10]; p.w_pb = in[11]; p.w_out = in[12]; p.n1g = in[13]; p.n2g = in[14]; p.rg_w = in[15]; p.rg_b = in[16]; p.re_w = in[17]; p.re_b = in[18];
    p.w_gate = in[19]; p.w_up = in[20]; p.w_down = in[21]; p.fg = in[22];
    p.out = (float*)d_out; p.ctl = (unsigned*)(ws + WS_CTL);
    p.WinT = (bf16_t*)(ws + WS_WIN); p.WoutT = (bf16_t*)(ws + WS_WOUT); p.WpbT = (bf16_t*)(ws + WS_WPB); p.WovT = (bf16_t*)(ws + WS_WOV); p.WSB = (bf16_t*)(ws + WS_WSB);
    p.WguT = (bf16_t*)(ws + WS_WGU); p.WdT = (bf16_t*)(ws + WS_WD); p.WrT = (float*)(ws + WS_WRT);
    p.HB = (bf16_t*)(ws + WS_A); p.OL = (bf16_t*)(ws + WS_A); p.H2B = (bf16_t*)(ws + WS_A);
    p.QL = (bf16_t*)(ws + WS_B); p.MB = (bf16_t*)(ws + WS_B); p.H2S = (bf16_t*)(ws + WS_B); p.YS = (bf16_t*)(ws + WS_B);
    p.GAB = (bf16_t*)(ws + WS_GA); p.GBB = (bf16_t*)(ws + WS_GB);
    p.UB = (bf16_t*)(ws + WS_C); p.VB = (bf16_t*)(ws + WS_C + 32 * MiB); p.MG = (bf16_t*)(ws + WS_C); p.HE = (bf16_t*)(ws + WS_C);
    p.QI = (bf16_t*)(ws + WS_DQ); p.US = (bf16_t*)(ws + WS_DQ);
    p.CKVR = (float*)(ws + WS_CKVR); p.CKVB = (bf16_t*)(ws + WS_CKVB); p.KI = (bf16_t*)(ws + WS_KI); p.WI = (float*)(ws + WS_WI); p.SEL = (unsigned short*)(ws + WS_SEL);
    p.EID = (int*)(ws + WS_MOE); p.EW = (float*)(ws + WS_MOE + 262144); p.PTOK = (int*)(ws + WS_MOE + 524288); p.MOEI = (int*)(ws + WS_MOE + 1048576);
    p.GU = (int*)(ws + WS_MOE + 1048576 + 4096); p.BLKCNT = (int*)(ws + WS_MOE + 1048576 + 65536); p.IDXROW = (float*)(ws + WS_A); p.CB = (int*)(ws + WS_MOE + 1048576 + 131072); p.DN = (int*)(ws + WS_MOE + 1048576 + 4096 + 8192);
    if (first) { (void)hipFuncSetAttribute((const void*)k_mega, hipFuncAttributeMaxDynamicSharedMemorySize, LDS_BYTES); first = false; }
    hipLaunchKernelGGL(k_mega, dim3(grid), dim3(NTHR), LDS_BYTES, stream, p);
}
```

```cpp
#include <hip/hip_runtime.h>
#include <cstdio>
#include <cstdint>
__device__ __forceinline__ int opaque_tid(const int wv) { int l; asm volatile("v_mbcnt_lo_u32_b32 %0, -1, 0\n\tv_mbcnt_hi_u32_b32 %0, -1, %0" : "=v"(l)); return (wv << 6) + l; }
#define LAS __attribute__((address_space(3)))
namespace pg8 {
#define PG8_LAS __attribute__((address_space(3)))
typedef unsigned short bf16_t;
typedef short bf16x8 __attribute__((ext_vector_type(8)));
typedef float f32x4 __attribute__((ext_vector_type(4)));
typedef unsigned u32x4 __attribute__((ext_vector_type(4)));
constexpr int BM = 256, BK = 64, HALF = 128, HTB = HALF * BK * 2  , STAGE_BYTES = 8 * HTB, NXCD = 8, WGM = 8;

__host__ __device__ __forceinline__ int lds_byte(int r, int c) { const int st = (r >> 4) * 2 + (c >> 5), rr = r & 15, cc = c & 31, ob = rr * 64 + cc * 2; return st * 1024 + (ob ^ (((ob >> 9) & 1) << 5)); }
__host__ __device__ __forceinline__ void stage_rc(int b, int& R, int& C) { const int st = b / 1024, sb = b % 1024, swz = sb ^ (((sb >> 9) & 1) << 5); R = (st >> 1) * 16 + swz / 64; C = (st & 1) * 32 + (swz % 64) / 2; }
__host__ __device__ __forceinline__ int perm32(int rho) { const int n = rho >> 4, i = rho & 15; return 8 * (i >> 2) + 4 * n + (i & 3); }

struct Unit { int pm, pn; };
struct Gemm { const bf16_t* A; const bf16_t* Bt; int M, N, K; };

struct StaticOrder {
    static constexpr bool GATHER = false;
    int nM, nN, nwg, G, c;
    __host__ __device__ void init(int M, int N, int G_, int c_) { nM = M / BM; nN = N / BM; nwg = nM * nN; G = G_; c = c_; }
    __host__ __device__ bool next(int i, Unit& u) const {
        const long L = (long)i * G + c; if (L >= nwg) return false;
        int wgid = (int)L; { const int q = nwg / NXCD, r = nwg % NXCD, xcd = wgid % NXCD, off = wgid / NXCD; wgid = (xcd < r ? xcd * (q + 1) : r * (q + 1) + (xcd - r) * q) + off; }
        const int nig = WGM * nN, gid = wgid / nig, fm = gid * WGM, gsz = (nM - fm) < WGM ? (nM - fm) : WGM;
        u.pm = fm + ((wgid % nig) % gsz); u.pn = (wgid % nig) / gsz; return true;
    }
    __device__ __forceinline__ int arow(int r) const { return r; }
    __device__ __forceinline__ void a_ready(const Unit&) const {}
    __device__ __forceinline__ void done(const Unit&) const {}
};

__device__ __forceinline__ unsigned cvt_pk_bf16(float lo, float hi) { unsigned r; asm volatile("v_cvt_pk_bf16_f32 %0, %1, %2" : "=v"(r) : "v"(lo), "v"(hi)); return r; }
typedef float f32x2 __attribute__((ext_vector_type(2)));
template <class Epi, class Sched, bool ALIGN_EPI = false, bool SP2 = false>
__device__ __forceinline__ void gemm_phase(PG8_LAS unsigned char* lds, const Gemm g, const Sched& S, const Epi& E, const int wv) {
    const int tid = opaque_tid(wv), wid = __builtin_amdgcn_readfirstlane(tid >> 6), lane = tid & 63, wr = wid >> 2, wc = wid & 3, fr = lane & 15, fq = lane >> 4;
    const int K = g.K, nt = K / BK;
    unsigned voffA[2], voffB[2];
#pragma unroll
    for (int i = 0; i < 2; ++i) { int R, C; stage_rc(tid * 16 + i * 8192, R, C); const int Rb = Epi::PERM ? ((R & ~31) + perm32(R & 31)) : R;
        voffA[i] = (unsigned)(R * K + C) * 2u; voffB[i] = (unsigned)(Rb * K + C) * 2u; }
    static_assert(!Sched::GATHER || SP2, "gathered A rows: SP2 loop only");
    unsigned gcur[2][2], gnxt[2][2]; int gR[2], gC[2];
    if constexpr (Sched::GATHER) {
#pragma unroll
        for (int i = 0; i < 2; ++i) { stage_rc(tid * 16 + i * 8192, gR[i], gC[i]); }
    }
#define PG8_GOFF(dst, u_) do { _Pragma("unroll") for (int h_ = 0; h_ < 2; ++h_) _Pragma("unroll") for (int i_ = 0; i_ < 2; ++i_) \
        dst[h_][i_] = ((unsigned)S.arow((u_).pm * BM + h_ * HALF + gR[i_]) * (unsigned)K + (unsigned)gC[i_]) * 2u; } while (0)
    const size_t kstep = (size_t)(BK * 2);
    const size_t hstep = (size_t)HALF * K * 2;
    const size_t tstep = 2 * hstep;
    const unsigned ldsw = (unsigned)wid * 1024u;
    const int aoff = lds_byte(wr * 64 + fr, fq * 8), boff = lds_byte(wc * 32 + fr, fq * 8);
#define PG8_SA(b, h) (((b) * 2 + (h)) * HTB)
#define PG8_SB(b, h) ((4 + (b) * 2 + (h)) * HTB)
#define PG8_STAGE(bufoff, gbase, voff) do { _Pragma("unroll") for (int _i = 0; _i < 2; ++_i) \
        __builtin_amdgcn_global_load_lds((const unsigned*)((const char*)(gbase) + (voff)[_i]), (PG8_LAS unsigned*)(lds + (bufoff) + ldsw + _i * 8192), 16, 0, 0); } while (0)
#define PG8_LDA(dst, b, h) do { _Pragma("unroll") for (int m = 0; m < 4; ++m) _Pragma("unroll") for (int k = 0; k < 2; ++k) dst[m][k] = *(const PG8_LAS bf16x8*)(lds + PG8_SA(b, h) + aoff + m * 2048 + k * 1024); } while (0)
#define PG8_LDB(dst, b, h) do { _Pragma("unroll") for (int n = 0; n < 2; ++n) _Pragma("unroll") for (int k = 0; k < 2; ++k) dst[n][k] = *(const PG8_LAS bf16x8*)(lds + PG8_SB(b, h) + boff + n * 2048 + k * 1024); } while (0)
#define PG8_MMA(ai, bj, At, Bt) do { __builtin_amdgcn_s_setprio(1); _Pragma("unroll") for (int m = 0; m < 4; ++m) _Pragma("unroll") for (int n = 0; n < 2; ++n) _Pragma("unroll") for (int k = 0; k < 2; ++k) \
        acc[ai][bj][m][n] = __builtin_amdgcn_mfma_f32_16x16x32_bf16(Bt[n][k], At[m][k], acc[ai][bj][m][n], 0, 0, 0); __builtin_amdgcn_s_setprio(0); } while (0)
#define PG8_WAIT_V(n) asm volatile("s_waitcnt vmcnt(" #n ")" ::: "memory")
#define PG8_WAIT_L(n) asm volatile("s_waitcnt lgkmcnt(" #n ")" ::: "memory")
#define PG8_BAR __builtin_amdgcn_s_barrier()
#define PG8_SCHED __builtin_amdgcn_sched_barrier(0)
    Unit cur, nxt; int ui = 0;
    if (!S.next(0, cur)) return;
    f32x4 acc[2][2][4][2];
#pragma unroll
    for (int a = 0; a < 2; ++a)
#pragma unroll
        for (int b = 0; b < 2; ++b)
#pragma unroll
            for (int m = 0; m < 4; ++m)
#pragma unroll
                for (int n = 0; n < 2; ++n) acc[a][b][m][n] = (f32x4){0.f, 0.f, 0.f, 0.f};
    bf16x8 At[4][2], B0[2][2], B1[2][2];
    const char* cA = Sched::GATHER ? (const char*)g.A : (const char*)g.A + (size_t)cur.pm * tstep; const char* cB = (const char*)g.Bt + (size_t)cur.pn * tstep;
    S.a_ready(cur);
    if constexpr (Sched::GATHER) { PG8_GOFF(gcur, cur); }
#define PG8_STAGE_A(bufoff, base_, h_, koff_, GO_) do { if constexpr (Sched::GATHER) { PG8_STAGE(bufoff, (const char*)g.A + (koff_), GO_[h_]); } else { PG8_STAGE(bufoff, (base_) + (h_) * hstep + (koff_), voffA); } } while (0)
    if constexpr (SP2) {
        PG8_STAGE(PG8_SB(0, 0), cB, voffB); PG8_STAGE(PG8_SB(0, 1), cB + hstep, voffB); PG8_STAGE_A(PG8_SA(0, 0), cA, 0, 0, gcur); PG8_STAGE_A(PG8_SA(0, 1), cA, 1, 0, gcur);
        if (wr == 1) PG8_BAR;
        PG8_WAIT_V(2); PG8_BAR;
        PG8_STAGE(PG8_SB(1, 0), cB + kstep, voffB); PG8_STAGE_A(PG8_SA(1, 0), cA, 0, kstep, gcur); PG8_STAGE(PG8_SB(1, 1), cB + hstep + kstep, voffB);
        PG8_WAIT_V(6); PG8_BAR;
    } else {
        PG8_STAGE(PG8_SB(0, 0), cB, voffB); PG8_STAGE(PG8_SA(0, 0), cA, voffA); PG8_STAGE(PG8_SB(0, 1), cB + hstep, voffB); PG8_STAGE(PG8_SA(0, 1), cA + hstep, voffA);
        if (wr == 1) PG8_BAR;
        PG8_WAIT_V(4); PG8_BAR;
        PG8_STAGE(PG8_SB(1, 0), cB + kstep, voffB); PG8_STAGE(PG8_SA(1, 0), cA + kstep, voffA); PG8_STAGE(PG8_SB(1, 1), cB + hstep + kstep, voffB);
        PG8_WAIT_V(6); PG8_BAR;
    }
    for (;;) {
        const bool has_next = S.next(ui + 1, nxt);
        const char* nA = Sched::GATHER ? cA : (has_next ? (const char*)g.A + (size_t)nxt.pm * tstep : cA); const char* nB = has_next ? (const char*)g.Bt + (size_t)nxt.pn * tstep : cB;
        if constexpr (Sched::GATHER) { if (has_next) { PG8_GOFF(gnxt, nxt); } else { _Pragma("unroll") for (int h_ = 0; h_ < 2; ++h_) _Pragma("unroll") for (int i_ = 0; i_ < 2; ++i_) gnxt[h_][i_] = gcur[h_][i_]; } }
        for (int t = 0; t < nt; t += 2) {
            const bool last = (t == nt - 2);
            const char* a1 = cA + (size_t)(t + 1) * kstep;
            const char* a2 = last ? nA : cA + (size_t)(t + 2) * kstep; const char* b2 = last ? nB : cB + (size_t)(t + 2) * kstep;
            const char* a3 = a2 + kstep; const char* b3 = b2 + kstep;
            unsigned g2[2][2];
            if constexpr (Sched::GATHER) { _Pragma("unroll") for (int h_ = 0; h_ < 2; ++h_) _Pragma("unroll") for (int i_ = 0; i_ < 2; ++i_) g2[h_][i_] = last ? gnxt[h_][i_] : gcur[h_][i_]; }
            const size_t k1 = (size_t)(t + 1) * kstep, k2 = last ? (size_t)0 : (size_t)(t + 2) * kstep, k3 = k2 + kstep;
            if (last && has_next) S.a_ready(nxt);
            if constexpr (SP2) {
            PG8_LDB(B0, 0, 0); PG8_LDB(B1, 0, 1); PG8_SCHED; PG8_LDA(At, 0, 0); if constexpr (Sched::GATHER) { PG8_STAGE(PG8_SA(1, 1), (const char*)g.A + k1, gcur[1]); } else { PG8_STAGE(PG8_SA(1, 1), a1 + hstep, voffA); }
            PG8_WAIT_V(8); PG8_WAIT_L(0); PG8_BAR; PG8_MMA(0, 0, At, B0); PG8_MMA(0, 1, At, B1); PG8_BAR; PG8_SCHED;
            PG8_LDA(At, 0, 1); PG8_STAGE(PG8_SB(0, 0), b2, voffB); PG8_STAGE(PG8_SB(0, 1), b2 + hstep, voffB); if constexpr (Sched::GATHER) { PG8_STAGE(PG8_SA(0, 0), (const char*)g.A + k2, g2[0]); } else { PG8_STAGE(PG8_SA(0, 0), a2, voffA); }
            PG8_WAIT_V(8); PG8_WAIT_L(0); PG8_BAR; PG8_MMA(1, 0, At, B0); PG8_MMA(1, 1, At, B1); PG8_BAR; PG8_SCHED;
            PG8_LDB(B0, 1, 0); PG8_LDB(B1, 1, 1); PG8_SCHED; PG8_LDA(At, 1, 0); if constexpr (Sched::GATHER) { PG8_STAGE(PG8_SA(0, 1), (const char*)g.A + k2, g2[1]); } else { PG8_STAGE(PG8_SA(0, 1), a2 + hstep, voffA); }
            PG8_WAIT_V(8); PG8_WAIT_L(0); PG8_BAR; PG8_MMA(0, 0, At, B0); PG8_MMA(0, 1, At, B1); PG8_BAR; PG8_SCHED;
            PG8_LDA(At, 1, 1); PG8_STAGE(PG8_SB(1, 0), b3, voffB); PG8_STAGE(PG8_SB(1, 1), b3 + hstep, voffB); if constexpr (Sched::GATHER) { PG8_STAGE(PG8_SA(1, 0), (const char*)g.A + k3, g2[0]); } else { PG8_STAGE(PG8_SA(1, 0), a3, voffA); }
            PG8_WAIT_V(8); PG8_WAIT_L(0); PG8_BAR; PG8_MMA(1, 0, At, B0); PG8_MMA(1, 1, At, B1); PG8_BAR; PG8_SCHED;
            } else {
            PG8_LDB(B0, 0, 0); PG8_SCHED; PG8_LDA(At, 0, 0); PG8_STAGE(PG8_SA(1, 1), a1 + hstep, voffA);
            PG8_WAIT_L(8); PG8_BAR; PG8_WAIT_L(0); PG8_MMA(0, 0, At, B0); PG8_BAR; PG8_SCHED;
            PG8_LDB(B1, 0, 1); PG8_STAGE(PG8_SB(0, 0), b2, voffB);
            PG8_BAR; PG8_WAIT_L(0); PG8_MMA(0, 1, At, B1); PG8_BAR;
            PG8_LDA(At, 0, 1); PG8_STAGE(PG8_SA(0, 0), a2, voffA);
            PG8_BAR; PG8_WAIT_L(0); PG8_MMA(1, 0, At, B0); PG8_BAR; PG8_SCHED;
            PG8_STAGE(PG8_SB(0, 1), b2 + hstep, voffB);
            PG8_WAIT_V(6); PG8_BAR; PG8_MMA(1, 1, At, B1); PG8_BAR;
            PG8_LDB(B0, 1, 0); PG8_SCHED; PG8_LDA(At, 1, 0); PG8_STAGE(PG8_SA(0, 1), a2 + hstep, voffA);
            PG8_WAIT_L(8); PG8_BAR; PG8_WAIT_L(0); PG8_MMA(0, 0, At, B0); PG8_BAR; PG8_SCHED;
            PG8_LDB(B1, 1, 1); PG8_STAGE(PG8_SB(1, 0), b3, voffB);
            PG8_BAR; PG8_WAIT_L(0); PG8_MMA(0, 1, At, B1); PG8_BAR;
            PG8_LDA(At, 1, 1); PG8_STAGE(PG8_SA(1, 0), a3, voffA);
            PG8_BAR; PG8_WAIT_L(0); PG8_MMA(1, 0, At, B0); PG8_BAR; PG8_SCHED;
            PG8_STAGE(PG8_SB(1, 1), b3 + hstep, voffB);
            PG8_WAIT_V(6); PG8_BAR; PG8_MMA(1, 1, At, B1); PG8_BAR;
            }
        }
        if constexpr (ALIGN_EPI) { if (wr == 0) PG8_BAR; }
        if constexpr (!Epi::AFTER_DRAIN) { E(acc, cur, wr, wc, fr, fq); S.done(cur); }
        if (!has_next) break;
#pragma unroll
        for (int a = 0; a < 2; ++a)
#pragma unroll
            for (int b = 0; b < 2; ++b)
#pragma unroll
                for (int m = 0; m < 4; ++m)
#pragma unroll
                    for (int n = 0; n < 2; ++n) acc[a][b][m][n] = (f32x4){0.f, 0.f, 0.f, 0.f};
        cur = nxt; cA = nA; cB = nB; ++ui;
        if constexpr (Sched::GATHER) { _Pragma("unroll") for (int h_ = 0; h_ < 2; ++h_) _Pragma("unroll") for (int i_ = 0; i_ < 2; ++i_) gcur[h_][i_] = gnxt[h_][i_]; }
        if constexpr (ALIGN_EPI) { if (wr == 1) PG8_BAR; }
    }
    PG8_WAIT_V(0);
    if constexpr (!ALIGN_EPI) { if (wr == 0) PG8_BAR; }
    PG8_BAR;
    if constexpr (Epi::AFTER_DRAIN) { E.fused(acc, cur, wr, wc, fr, fq, lds, wid, lane); S.done(cur); }
#undef PG8_SA
#undef PG8_SB
#undef PG8_STAGE
#undef PG8_STAGE_A
#undef PG8_GOFF
#undef PG8_LDA
#undef PG8_LDB
#undef PG8_MMA
#undef PG8_WAIT_V
#undef PG8_WAIT_L
#undef PG8_BAR
#undef PG8_SCHED
}
}
#define XB_TMO      128
#define XB_XCNT(j)  (256  + 64 * (j))
#define XB_XSUB(j)  (1280 + 64 * (j))
#define XB_XGEN(j)  (2304 + 64 * (j))
#define XB_TOP      3328
#define XB_TOPGEN   3392
#define XCD_BAR_WORDS 3456
#define XB_SPIN_CAP (1u << 18)

__device__ __forceinline__ unsigned xb_ld(unsigned* p)              { return __hip_atomic_load(p, __ATOMIC_RELAXED, __HIP_MEMORY_SCOPE_AGENT); }
__device__ __forceinline__ unsigned xb_add(unsigned* p, unsigned v) { return __hip_atomic_fetch_add(p, v, __ATOMIC_RELAXED, __HIP_MEMORY_SCOPE_AGENT); }
__device__ __forceinline__ unsigned xb_xcc_id() { return (unsigned)__builtin_amdgcn_s_getreg((3 << 11) | 20) & 0xFu; }
#define XB_SPIN(cond, bar) do { unsigned _sp = 0; while (cond) { __builtin_amdgcn_s_sleep(1); \
    if ((++_sp & 255u) == 0u) { if (xb_ld(&(bar)[XB_TMO])) break; if (_sp > XB_SPIN_CAP) { atomicAdd(&(bar)[XB_TMO], 1u); break; } } } } while (0)

struct XcdBarrier {
    unsigned* bar; unsigned x; int wv;
    volatile LAS unsigned* st;
};

__device__ __forceinline__ XcdBarrier xcd_barrier_post(unsigned* bar, volatile LAS unsigned* st, int wv) {
    XcdBarrier b; b.bar = bar; b.x = xb_xcc_id(); b.st = st; b.wv = wv;
    if (opaque_tid(wv) == 0) (void)xb_add(&bar[XB_XCNT(b.x)], 1u);
    return b;
}
__device__ __forceinline__ void xcd_barrier_complete(unsigned* bar, unsigned x, unsigned& nloc, unsigned& nx) {
    const unsigned G = gridDim.x * gridDim.y * gridDim.z;
    unsigned sum, cnt, mine, sp = 0u;
    for (;;) {
        sum = 0u; cnt = 0u; mine = 0u;
#pragma unroll
        for (unsigned j = 0; j < 16; ++j) { const unsigned c = xb_ld(&bar[XB_XCNT(j)]); sum += c; cnt += (c > 0u) ? 1u : 0u; mine = (j == x) ? c : mine; }
        if (sum == G) break;
        __builtin_amdgcn_s_sleep(1);
        if ((++sp & 255u) == 0u) { if (xb_ld(&bar[XB_TMO])) break; if (sp > XB_SPIN_CAP) { atomicAdd(&bar[XB_TMO], 1u); break; } }
    }
    nloc = mine > 0u ? mine : 1u; nx = cnt > 0u ? cnt : 1u;
}

__device__ __forceinline__ void xcd_barrier(const XcdBarrier& b) {
    asm volatile("s_waitcnt vmcnt(0)" ::: "memory");
    __syncthreads();
    if (opaque_tid(b.wv) == 0) {
        unsigned* bar = b.bar;
        __builtin_amdgcn_s_waitcnt(0);
        unsigned nloc = b.st[0], nx = b.st[1];
        if (nloc == 0u) { xcd_barrier_complete(bar, b.x, nloc, nx); b.st[0] = nloc; b.st[1] = nx; }
        const unsigned old = xb_add(&bar[XB_XSUB(b.x)], 1u);
        const unsigned gen = old / nloc;
        if (old + 1u == (gen + 1u) * nloc) {
            __builtin_amdgcn_fence(__ATOMIC_RELEASE, "agent");
            asm volatile("s_waitcnt vmcnt(0)" ::: "memory");
            const unsigned og = xb_add(&bar[XB_TOP], 1u);
            const unsigned tg = og / nx;
            if (og + 1u == (tg + 1u) * nx) xb_add(&bar[XB_TOPGEN], 1u);
            else XB_SPIN(xb_ld(&bar[XB_TOPGEN]) == tg, bar);
            __builtin_amdgcn_fence(__ATOMIC_ACQUIRE, "agent");
            xb_add(&bar[XB_XGEN(b.x)], 1u);
            asm volatile("s_waitcnt vmcnt(0)" ::: "memory");
        } else {
            XB_SPIN(xb_ld(&bar[XB_XGEN(b.x)]) == gen, bar);
            __builtin_amdgcn_fence(__ATOMIC_ACQUIRE, "agent");
            asm volatile("s_waitcnt vmcnt(0)" ::: "memory");
        }
    }
    __syncthreads();
}

typedef unsigned short bf16_t;
typedef short bf16x8 __attribute__((ext_vector_type(8)));
typedef short bf16x4 __attribute__((ext_vector_type(4)));
typedef float f32x4 __attribute__((ext_vector_type(4)));
typedef float f32x16 __attribute__((ext_vector_type(16)));
typedef unsigned u32x4 __attribute__((ext_vector_type(4)));
typedef unsigned u32x2 __attribute__((ext_vector_type(2)));

constexpr int NB = 8, T = 4096, D = 1024, M = NB * T;
constexpr int INC = 4296;
constexpr int NIN = 19 * 256;
constexpr float EPS = 1e-6f;
constexpr int NPOS = 73728;
constexpr int NWAVES = 8, NTHR = 512;
constexpr int LDS_BYTES = 163840;

constexpr size_t MiB = 1u << 20;
constexpr size_t WS_CTL = 0, CTL_ZERO_BYTES = 65536;
constexpr size_t WS_WIN = 1 * MiB, WS_WOUT = 11 * MiB, WS_WPB = 13 * MiB, WS_WOV = 14 * MiB, WS_WSB = 16 * MiB, WS_WRT = 16 * MiB + 262144, WS_WGU = 17 * MiB, WS_WD = 49 * MiB;
constexpr size_t WS_A = 65 * MiB;
constexpr size_t WS_B = 129 * MiB;
constexpr size_t WS_GA = 193 * MiB, WS_GB = 257 * MiB;
constexpr size_t WS_C = 321 * MiB;
constexpr size_t WS_DQ = 385 * MiB;
constexpr size_t WS_CKVR = 417 * MiB, WS_CKVB = 433 * MiB, WS_KI = 441 * MiB, WS_WI = 445 * MiB, WS_SEL = 446 * MiB;
constexpr size_t WS_MOE = 462 * MiB;
constexpr size_t WS_END = 464 * MiB;

constexpr int CW_BAR = 4096;
constexpr int CW_CNT = 8192, CW_CUR = 8256;

struct P {
    const float *x, *w_in, *kv_g, *w_uk, *w_uv, *rel_bias, *ln_g, *ln_b, *w_sp, *b_sp, *w_pa, *w_pb, *w_out, *n1g, *n2g, *rg_w, *rg_b, *re_w, *re_b, *w_gate, *w_up, *w_down, *fg;
    float* out;
    unsigned* ctl;
    bf16_t *WinT, *WoutT, *WpbT, *WovT, *WSB, *WguT, *WdT;
    float* WrT;
    bf16_t *HB, *QL, *QI, *CKVB, *KI, *UB, *VB, *GAB, *GBB, *OL, *US, *MB, *MG, *H2B, *H2S, *HE, *YS;
    float *CKVR, *WI, *EW, *IDXROW;
    unsigned short* SEL;
    int *EID, *PTOK, *MOEI, *GU, *DN, *BLKCNT, *CB;
};

__device__ __forceinline__ unsigned f2bf(float f) { unsigned u = __builtin_bit_cast(unsigned, f); return (u + 0x7fffu + ((u >> 16) & 1u)) >> 16; }
__device__ __forceinline__ unsigned pk2(float lo, float hi) { return f2bf(lo) | (f2bf(hi) << 16); }
__device__ __forceinline__ float bflo(unsigned w) { return __builtin_bit_cast(float, w << 16); }
__device__ __forceinline__ float bfhi(unsigned w) { return __builtin_bit_cast(float, w & 0xffff0000u); }
__device__ __forceinline__ float bf2f(unsigned short b) { return __builtin_bit_cast(float, (unsigned)b << 16); }
__device__ __forceinline__ float wave_sum(float v) {
#pragma unroll
    for (int o = 1; o < 64; o <<= 1) v += __shfl_xor(v, o);
    return v;
}
#define LDS_WAIT() asm volatile("s_waitcnt lgkmcnt(0)" ::: "memory")
__device__ __forceinline__ float gelu_t(float x) { const float z = 0.7978845608f * (x + 0.044715f * x * x * x); return x / (1.f + __expf(-2.f * z)); }
__device__ __forceinline__ float sigm(float x) { return 1.f / (1.f + __expf(-x)); }
__device__ __forceinline__ unsigned off_b(unsigned row, unsigned ch) { return 256u * row + 16u * (ch ^ (((row & 3) << 2) | ((row >> 2) & 3))); }
__device__ __forceinline__ bf16x4 tr_read(unsigned lds_addr) { bf16x4 r; asm volatile("ds_read_b64_tr_b16 %0, %1\n\ts_waitcnt lgkmcnt(0)" : "=&v"(r) : "v"(lds_addr) : "memory"); return r; }
__device__ __forceinline__ bf16x8 cat4(bf16x4 a, bf16x4 b) { bf16x8 r; r[0] = a[0]; r[1] = a[1]; r[2] = a[2]; r[3] = a[3]; r[4] = b[0]; r[5] = b[1]; r[6] = b[2]; r[7] = b[3]; return r; }
__device__ __forceinline__ unsigned lds_addr_of(LAS unsigned char* p) { return (unsigned)(unsigned long long)p; }

__device__ __forceinline__ void st8bf(bf16_t* p, const pg8::f32x4& a, const pg8::f32x4& b) {
    u32x4 w; w.x = pg8::cvt_pk_bf16(a[0], a[1]); w.y = pg8::cvt_pk_bf16(a[2], a[3]); w.z = pg8::cvt_pk_bf16(b[0], b[1]); w.w = pg8::cvt_pk_bf16(b[2], b[3]);
    *(u32x4*)p = w;
}
__device__ __forceinline__ void ld8bf(const bf16_t* p, pg8::f32x4& a, pg8::f32x4& b) {
    const u32x4 w = *(const u32x4*)p;
    a[0] = bflo(w.x); a[1] = bfhi(w.x); a[2] = bflo(w.y); a[3] = bfhi(w.y); b[0] = bflo(w.z); b[1] = bfhi(w.z); b[2] = bflo(w.w); b[3] = bfhi(w.w);
}

struct EpiIn {
    static constexpr bool PERM = true, AFTER_DRAIN = false;
    bf16_t *QL, *QI, *KI, *UB, *VB, *GAB, *GBB; float *CKVR, *WI;
    __device__ __forceinline__ void operator()(const pg8::f32x4 (&acc)[2][2][4][2], const pg8::Unit& u, int wr, int wc, int fr, int fq) const {
        const int row0 = u.pm * 256 + wr * 64 + fr, pn = u.pn, c8 = wc * 32 + 8 * fq;
        int mode; bf16_t* dst; int ld;
        if (pn < 4)       { mode = 0; dst = QL + pn * 256; ld = 1024; }
        else if (pn < 6)  { mode = 0; dst = QI + (pn - 4) * 256; ld = 512; }
        else if (pn == 6) { mode = 3; dst = KI; ld = 64; }
        else if (pn < 9)  { mode = 1; dst = UB + (pn - 7) * 256; ld = 512; }
        else if (pn < 11) { mode = 1; dst = VB + (pn - 9) * 256; ld = 512; }
        else if (pn < 15) { mode = 2; dst = GAB + (pn - 11) * 256; ld = 1024; }
        else              { mode = 2; dst = GBB + (pn - 15) * 256; ld = 1024; }
#pragma unroll
        for (int ai = 0; ai < 2; ++ai)
#pragma unroll
            for (int m = 0; m < 4; ++m) {
                const size_t row = (size_t)(row0 + ai * 128 + m * 16);
#pragma unroll
                for (int bj = 0; bj < 2; ++bj) {
                    pg8::f32x4 v0 = acc[ai][bj][m][0], v1 = acc[ai][bj][m][1];
                    if (mode == 3) {
                        if (bj == 0) { float* c = CKVR + row * 128 + c8; *(pg8::f32x4*)c = v0; *(pg8::f32x4*)(c + 4) = v1; }
                        else if (c8 < 64) st8bf(KI + row * 64 + c8, v0, v1);
                        else if (c8 == 64) { float* c = WI + row * 8; *(pg8::f32x4*)c = v0 * 0.044194174f; *(pg8::f32x4*)(c + 4) = v1 * 0.044194174f; }
                    } else {
                        if (mode == 1) {
#pragma unroll
                            for (int j = 0; j < 4; ++j) { v0[j] = gelu_t(v0[j]); v1[j] = gelu_t(v1[j]); }
                        } else if (mode == 2) {
#pragma unroll
                            for (int j = 0; j < 4; ++j) { v0[j] = sigm(v0[j]); v1[j] = sigm(v1[j]); }
                        }
                        st8bf(dst + row * ld + bj * 128 + c8, v0, v1);
                    }
                }
            }
    }
};

struct EpiMB {
    static constexpr bool PERM = true, AFTER_DRAIN = false;
    const bf16_t* G; bf16_t* O;
    __device__ __forceinline__ void operator()(const pg8::f32x4 (&acc)[2][2][4][2], const pg8::Unit& u, int wr, int wc, int fr, int fq) const {
        const int row0 = u.pm * 256 + wr * 64 + fr, col0 = u.pn * 256 + wc * 32 + 8 * fq;
#pragma unroll
        for (int ai = 0; ai < 2; ++ai)
#pragma unroll
            for (int m = 0; m < 4; ++m)
#pragma unroll
                for (int bj = 0; bj < 2; ++bj) {
                    const size_t o = (size_t)(row0 + ai * 128 + m * 16) * 1024 + col0 + bj * 128;
                    pg8::f32x4 g0, g1; ld8bf(G + o, g0, g1);
                    st8bf(O + o, acc[ai][bj][m][0] * g0, acc[ai][bj][m][1] * g1);
                }
    }
};
struct EpiMG {
    static constexpr bool PERM = true, AFTER_DRAIN = false;
    const bf16_t *G, *MBp; bf16_t* O;
    __device__ __forceinline__ void operator()(const pg8::f32x4 (&acc)[2][2][4][2], const pg8::Unit& u, int wr, int wc, int fr, int fq) const {
        const int row0 = u.pm * 256 + wr * 64 + fr, col0 = u.pn * 256 + wc * 32 + 8 * fq;
#pragma unroll
        for (int ai = 0; ai < 2; ++ai)
#pragma unroll
            for (int m = 0; m < 4; ++m)
#pragma unroll
                for (int bj = 0; bj < 2; ++bj) {
                    const size_t o = (size_t)(row0 + ai * 128 + m * 16) * 1024 + col0 + bj * 128;
                    pg8::f32x4 g0, g1, b0, b1; ld8bf(G + o, g0, g1); ld8bf(MBp + o, b0, b1);
                    st8bf(O + o, acc[ai][bj][m][0] * g0 + b0, acc[ai][bj][m][1] * g1 + b1);
                }
    }
};
struct EpiX1 {
    static constexpr bool PERM = true, AFTER_DRAIN = false;
    const float* X; float* O;
    __device__ __forceinline__ void operator()(const pg8::f32x4 (&acc)[2][2][4][2], const pg8::Unit& u, int wr, int wc, int fr, int fq) const {
        const int row0 = u.pm * 256 + wr * 64 + fr, col0 = u.pn * 256 + wc * 32 + 8 * fq;
#pragma unroll
        for (int ai = 0; ai < 2; ++ai)
#pragma unroll
            for (int m = 0; m < 4; ++m)
#pragma unroll
                for (int bj = 0; bj < 2; ++bj) {
                    const size_t o = (size_t)(row0 + ai * 128 + m * 16) * 1024 + col0 + bj * 128;
                    const pg8::f32x4 x0 = *(const pg8::f32x4*)(X + o), x1 = *(const pg8::f32x4*)(X + o + 4);
                    *(pg8::f32x4*)(O + o) = x0 + acc[ai][bj][m][0]; *(pg8::f32x4*)(O + o + 4) = x1 + acc[ai][bj][m][1];
                }
    }
};
struct EpiHE {
    static constexpr bool PERM = true, AFTER_DRAIN = false;
    bf16_t* HE;
    __device__ __forceinline__ void operator()(const pg8::f32x4 (&acc)[2][2][4][2], const pg8::Unit& u, int wr, int wc, int fr, int fq) const {
        const int row0 = u.pm * 256 + wr * 64 + fr, col0 = (u.pn & 1) * 128 + wc * 32 + 8 * fq;
#pragma unroll
        for (int ai = 0; ai < 2; ++ai)
#pragma unroll
            for (int m = 0; m < 4; ++m) {
                pg8::f32x4 h0, h1;
#pragma unroll
                for (int j = 0; j < 4; ++j) {
                    const float g0 = acc[ai][0][m][0][j], g1 = acc[ai][0][m][1][j];
                    h0[j] = g0 * sigm(g0) * acc[ai][1][m][0][j]; h1[j] = g1 * sigm(g1) * acc[ai][1][m][1][j];
                }
                st8bf(HE + (size_t)(row0 + ai * 128 + m * 16) * 256 + col0, h0, h1);
            }
    }
};
struct EpiDown {
    static constexpr bool PERM = true, AFTER_DRAIN = false;
    const int* PTOK; const float* EW; bf16_t* YS;
    __device__ __forceinline__ void operator()(const pg8::f32x4 (&acc)[2][2][4][2], const pg8::Unit& u, int wr, int wc, int fr, int fq) const {
        const int row0 = u.pm * 256 + wr * 64 + fr, col0 = (u.pn & 3) * 256 + wc * 32 + 8 * fq;
#pragma unroll
        for (int ai = 0; ai < 2; ++ai)
#pragma unroll
            for (int m = 0; m < 4; ++m) {
                const int ts = PTOK[row0 + ai * 128 + m * 16];
                if (ts >= 0) {
                    const float w = EW[ts];
                    bf16_t* d = YS + ((size_t)(ts & 1) * M + (size_t)(ts >> 1)) * 1024 + col0;
#pragma unroll
                    for (int bj = 0; bj < 2; ++bj) st8bf(d + bj * 128, acc[ai][bj][m][0] * w, acc[ai][bj][m][1] * w);
                }
            }
    }
};
struct TableOrder {
    static constexpr bool GATHER = false;
    const int* tab; const int* nunits; int G, c;
    __device__ __forceinline__ int arow(int r) const { return r; }
    __device__ __forceinline__ bool next(int i, pg8::Unit& u) const {
        const int idx = i * G + c; const int n = __builtin_nontemporal_load(nunits);
        if (idx >= n) return false;
        u.pm = tab[2 * idx]; u.pn = tab[2 * idx + 1]; return true;
    }
    __device__ __forceinline__ void a_ready(const pg8::Unit&) const {}
    __device__ __forceinline__ void done(const pg8::Unit&) const {}
};

struct TableGatherOrder {
    static constexpr bool GATHER = true;
    const int* tab; const int* nunits; const int* ptok; int G, c;
    __device__ __forceinline__ bool next(int i, pg8::Unit& u) const {
        const int idx = i * G + c; const int n = __builtin_nontemporal_load(nunits);
        if (idx >= n) return false;
        u.pm = tab[2 * idx]; u.pn = tab[2 * idx + 1]; return true;
    }
    __device__ __forceinline__ int arow(int r) const { const int ts = ptok[r]; return ts < 0 ? 0 : (ts >> 1); }
    __device__ __forceinline__ void a_ready(const pg8::Unit&) const {}
    __device__ __forceinline__ void done(const pg8::Unit&) const {}
};

__device__ __forceinline__ void tr_item(const float* src, int ld, int K, int NC, bf16_t* dst, LAS float* scr, int item, int lane) {
    const int nblk = NC / 32, kb = item / nblk, nb = item % nblk, k0 = 64 * kb, n0 = 32 * nb;
    float tv[32];
#pragma unroll
    for (int i = 0; i < 32; ++i) tv[i] = src[(size_t)(k0 + 2 * i + (lane >> 5)) * ld + n0 + (lane & 31)];
#pragma unroll
    for (int i = 0; i < 32; ++i) scr[(2 * i + (lane >> 5)) * 33 + (lane & 31)] = tv[i];
    LDS_WAIT();
    const int c = lane & 7;
#pragma unroll
    for (int j = 0; j < 4; ++j) { const int n = (lane >> 3) + 8 * j; const LAS float* s = scr + (8 * c) * 33 + n;
        u32x4 o; o.x = pk2(s[0 * 33], s[1 * 33]); o.y = pk2(s[2 * 33], s[3 * 33]); o.z = pk2(s[4 * 33], s[5 * 33]); o.w = pk2(s[6 * 33], s[7 * 33]);
        *(u32x4*)(dst + (size_t)(n0 + n) * K + k0 + 8 * c) = o; }
    LDS_WAIT();
}

__device__ __forceinline__ void ph_prep(const P& p, LAS unsigned char* lds, const int wv) {
    const int tid = opaque_tid(wv), lane = tid & 63, wave = __builtin_amdgcn_readfirstlane(tid >> 6);
    LAS float* scr = (LAS float*)(lds + wave * 16384);
    const int gw = blockIdx.x * NWAVES + wave, NGW = gridDim.x * NWAVES;
    const int gt = blockIdx.x * NTHR + tid, NGT = gridDim.x * NTHR;
    {
        const int c0s[7] = {640, 512, 1152, 1224, 1736, 2248, 3272};
        const int ncs[7] = {512, 128, 64, 512, 512, 1024, 1024};
        const int r0s[7] = {1024, 1536, 1664, 1792, 2304, 2816, 3840};
#pragma unroll
        for (int s = 0; s < 7; ++s) {
            const int nit = 16 * (ncs[s] / 32);
            for (int it = gw; it < nit; it += NGW) tr_item(p.w_in + c0s[s], INC, 1024, ncs[s], p.WinT + (size_t)r0s[s] * 1024, scr, it, lane);
        }
    }
    for (int i = gt; i < 64 * 1024; i += NGT) { const int j = i >> 10, k = i & 1023; p.WinT[(size_t)(1728 + j) * 1024 + k] = j < 8 ? (bf16_t)f2bf(p.w_in[(size_t)k * INC + 1216 + j]) : (bf16_t)0; }
    for (int it = gw; it < 512; it += NGW) tr_item(p.w_out, 1024, 1024, 1024, p.WoutT, scr, it, lane);
    for (int it = gw; it < 256; it += NGW) tr_item(p.w_pb, 1024, 512, 1024, p.WpbT, scr, it, lane);
    for (int it = gw; it < 8192; it += NGW) {
        const int sub = it & 63, q = it >> 6, gu = q & 1, j = (q >> 1) & 1, e = q >> 2;
        const float* src = (gu ? p.w_up : p.w_gate) + (size_t)e * 262144 + 128 * j;
        tr_item(src, 256, 1024, 128, p.WguT + ((size_t)e * 512 + j * 256 + gu * 128) * 1024, scr, sub, lane);
    }
    for (int it = gw; it < 4096; it += NGW) { const int sub = it & 127, e = it >> 7; tr_item(p.w_down + (size_t)e * 262144, 1024, 256, 1024, p.WdT + (size_t)e * 262144, scr, sub, lane); }
    for (int it = gw; it < 1024; it += NGW) {
        const int h = it >> 7, kt = (it >> 2) & 31, rt = it & 3, i = lane & 31, hf = lane >> 5;
        const f32x4* ap = (const f32x4*)(p.w_in + (size_t)(kt * 32 + i) * INC + h * 64 + 32 * hf);
        const f32x4* bp = (const f32x4*)(p.w_uk + (size_t)((rt * 32 + i) * 8 + h) * 64 + 32 * hf);
        f32x4 av[8], bv[8];
#pragma unroll
        for (int j = 0; j < 8; ++j) { av[j] = ap[j]; bv[j] = bp[j]; }
        f32x16 acc;
#pragma unroll
        for (int j = 0; j < 16; ++j) acc[j] = 0.f;
#pragma unroll
        for (int j = 0; j < 8; ++j)
#pragma unroll
            for (int e = 0; e < 4; ++e) acc = __builtin_amdgcn_mfma_f32_32x32x2f32(av[j][e], bv[j][e], acc, 0, 0, 0);
#pragma unroll
        for (int g4 = 0; g4 < 4; ++g4) {
            u32x2 w; w.x = pk2(0.125f * acc[4 * g4], 0.125f * acc[4 * g4 + 1]); w.y = pk2(0.125f * acc[4 * g4 + 2], 0.125f * acc[4 * g4 + 3]);
            *(u32x2*)(p.WinT + (size_t)(h * 128 + rt * 32 + i) * 1024 + kt * 32 + 8 * g4 + 4 * hf) = w;
        }
    }
    for (int it = gw; it < 1024; it += NGW) {
        const int h = it >> 7, nt = (it >> 2) & 31, rt = it & 3, i = lane & 31, hf = lane >> 5;
        const f32x4* ap = (const f32x4*)(p.w_uv + (size_t)((rt * 32 + i) * 8 + h) * 64 + 32 * hf);
        const float* bp = p.w_pa + (size_t)(h * 64 + 32 * hf) * 1024 + nt * 32 + i;
        f32x4 av[8]; float bv[32];
#pragma unroll
        for (int j = 0; j < 8; ++j) av[j] = ap[j];
#pragma unroll
        for (int j = 0; j < 32; ++j) bv[j] = bp[(size_t)j * 1024];
        f32x16 acc;
#pragma unroll
        for (int j = 0; j < 16; ++j) acc[j] = 0.f;
#pragma unroll
        for (int j = 0; j < 8; ++j)
#pragma unroll
            for (int e = 0; e < 4; ++e) acc = __builtin_amdgcn_mfma_f32_32x32x2f32(av[j][e], bv[4 * j + e], acc, 0, 0, 0);
#pragma unroll
        for (int g4 = 0; g4 < 4; ++g4) {
            u32x2 w; w.x = pk2(acc[4 * g4], acc[4 * g4 + 1]); w.y = pk2(acc[4 * g4 + 2], acc[4 * g4 + 3]);
            *(u32x2*)(p.WovT + (size_t)(nt * 32 + i) * 1024 + h * 128 + rt * 32 + 8 * g4 + 4 * hf) = w;
        }
    }
    for (int i = gt; i < 4 * 128 * 128; i += NGT) { const int jj = i & 127, ii = (i >> 7) & 127; p.WSB[i] = jj <= ii ? (bf16_t)f2bf(p.w_sp[i]) : (bf16_t)0; }
    for (int i = gt; i < 36 * 1024; i += NGT) { const int c = i >> 10, k = i & 1023; p.WrT[i] = c < 4 ? p.rg_w[k * 4 + c] : p.re_w[k * 32 + (c - 4)]; }
    for (int m4 = gw; m4 < M / 4; m4 += NGW) {
        f32x4 v[4][4]; float ss[4];
#pragma unroll
        for (int r = 0; r < 4; ++r) { const f32x4* xr = (const f32x4*)(p.x + (size_t)(4 * m4 + r) * D) + lane;
#pragma unroll
            for (int j = 0; j < 4; ++j) v[r][j] = xr[64 * j]; }
#pragma unroll
        for (int r = 0; r < 4; ++r) { ss[r] = 0.f;
#pragma unroll
            for (int j = 0; j < 4; ++j) ss[r] += (v[r][j].x * v[r][j].x + v[r][j].y * v[r][j].y) + (v[r][j].z * v[r][j].z + v[r][j].w * v[r][j].w); }
#pragma unroll
        for (int o = 1; o < 64; o <<= 1) {
#pragma unroll
            for (int r = 0; r < 4; ++r) ss[r] += __shfl_xor(ss[r], o);
        }
#pragma unroll
        for (int r = 0; r < 4; ++r) {
            const float rinv = 1.0f / sqrtf(ss[r] * (1.f / D) + EPS);
            unsigned long long* o8 = (unsigned long long*)(p.HB + (size_t)(4 * m4 + r) * D) + lane;
#pragma unroll
            for (int j = 0; j < 4; ++j) { const f32x4 g = ((const f32x4*)p.n1g)[lane + 64 * j]; const f32x4 o = v[r][j] * rinv * g;
                o8[64 * j] = (unsigned long long)pk2(o.x, o.y) | ((unsigned long long)pk2(o.z, o.w) << 32); }
        }
    }
}

__device__ __forceinline__ void ph_ckvnorm(const P& p, const int wv) {
    const int tid = opaque_tid(wv), lane = tid & 63, wave = tid >> 6;
    const int gw = blockIdx.x * NWAVES + wave, NGW = gridDim.x * NWAVES;
    const float g0 = p.kv_g[2 * lane], g1 = p.kv_g[2 * lane + 1];
    for (int m4 = gw; m4 < M / 4; m4 += NGW) {
        float2 v[4]; float ss[4];
#pragma unroll
        for (int r = 0; r < 4; ++r) v[r] = ((const float2*)(p.CKVR + (size_t)(4 * m4 + r) * 128))[lane];
#pragma unroll
        for (int r = 0; r < 4; ++r) ss[r] = v[r].x * v[r].x + v[r].y * v[r].y;
#pragma unroll
        for (int o = 1; o < 64; o <<= 1) {
#pragma unroll
            for (int r = 0; r < 4; ++r) ss[r] += __shfl_xor(ss[r], o);
        }
#pragma unroll
        for (int r = 0; r < 4; ++r) { const float rinv = 1.0f / sqrtf(ss[r] * (1.f / 128.f) + EPS);
            ((unsigned*)(p.CKVB + (size_t)(4 * m4 + r) * 128))[lane] = pk2(v[r].x * rinv * g0, v[r].y * rinv * g1); }
    }
}

__device__ __forceinline__ unsigned qbin(float x) { return (unsigned)(int)__builtin_fminf(__builtin_fmaxf((x + 8.0f) * 64.0f, 0.0f), 1023.0f); }
__device__ __forceinline__ unsigned fkey(float x) { x = x + 0.0f; const unsigned u = __builtin_bit_cast(unsigned, x); return (u & 0x80000000u) ? ~u : (u | 0x80000000u); }

__device__ __forceinline__ void select_row(const LAS float* row, int n, LAS unsigned* hist, unsigned short* out, int lane) {
    if (n <= 256) {
#pragma unroll
        for (int i = 0; i < 4; ++i) { const int k = lane + 64 * i; out[k] = (unsigned short)(k < n ? k : 0); }
        return;
    }
    unsigned prefix = 0; int need = 256;
    const unsigned long long lt = (1ull << lane) - 1ull;
#pragma unroll 1
    for (int pass = 3; pass >= 0; --pass) {
#pragma unroll
        for (int i = 0; i < 4; ++i) hist[lane + 64 * i] = 0u;
        LDS_WAIT();
        const int shift = pass * 8;
        for (int i = lane; i < n; i += 64) {
            const unsigned k = fkey(row[i]);
            const bool match = (pass == 3) || ((k >> (shift + 8)) == prefix);
            if (match) __hip_atomic_fetch_add(hist + ((k >> shift) & 255u), 1u, __ATOMIC_RELAXED, __HIP_MEMORY_SCOPE_WORKGROUP);
        }
        LDS_WAIT();
        const unsigned c0 = hist[4 * lane], c1 = hist[4 * lane + 1], c2 = hist[4 * lane + 2], c3 = hist[4 * lane + 3];
        const unsigned s = c0 + c1 + c2 + c3;
        unsigned incl = s;
#pragma unroll
        for (int o = 1; o < 64; o <<= 1) { const unsigned t = __shfl_down(incl, o); if (lane + o < 64) incl += t; }
        const unsigned excl = incl - s;
        const bool mine = (excl < (unsigned)need) && (incl >= (unsigned)need);
        unsigned bin = 0, above = 0;
        if (mine) {
            unsigned run = excl;
            if (run + c3 >= (unsigned)need) { bin = 4 * lane + 3; above = run; }
            else { run += c3;
                if (run + c2 >= (unsigned)need) { bin = 4 * lane + 2; above = run; }
                else { run += c2;
                    if (run + c1 >= (unsigned)need) { bin = 4 * lane + 1; above = run; }
                    else { run += c1; bin = 4 * lane; above = run; } } }
        }
        const unsigned long long bm = __ballot(mine);
        const int src = bm ? (int)__builtin_ctzll(bm) : 0;
        bin = __shfl(bin, src); above = __shfl(above, src);
        need -= (int)above; prefix = (prefix << 8) | bin;
        LDS_WAIT();
    }
    const unsigned Tk = prefix;
    int cnt = 0, eq_taken = 0;
    for (int i0 = 0; i0 < n; i0 += 64) {
        const int i = i0 + lane; const bool valid = i < n;
        const unsigned k = valid ? fkey(row[i]) : 0u;
        const bool gtk = valid && (k > Tk), eqk = valid && (k == Tk);
        const unsigned long long beq = __ballot(eqk);
        const int eq_rank = eq_taken + __builtin_popcountll(beq & lt);
        const bool take = gtk || (eqk && eq_rank < need);
        const unsigned long long bt = __ballot(take);
        const int pos = cnt + __builtin_popcountll(bt & lt);
        if (take && pos < 256) out[pos] = (unsigned short)i;
        cnt += __builtin_popcountll(bt); eq_taken += __builtin_popcountll(beq);
    }
}

__device__ __forceinline__ void select_row4(const LAS float* row, int n, LAS unsigned* hist, LAS unsigned* h2, unsigned short* out, int lane) {
    if (n <= 256) {
#pragma unroll
        for (int i = 0; i < 4; ++i) { const int k = lane + 64 * i; out[k] = (unsigned short)(k < n ? k : 0); }
#pragma unroll
        for (int i = 0; i < 8; ++i) hist[lane + 64 * i] = 0u;
        return;
    }
    const unsigned long long lt = (1ull << lane) - 1ull;
    unsigned b1, above;
    {
        const u32x4 w0 = *(const LAS u32x4*)(hist + 8 * lane), w1 = *(const LAS u32x4*)(hist + 8 * lane + 4);
        unsigned c[16];
        c[0] = w0.x & 0xffffu; c[1] = w0.x >> 16; c[2] = w0.y & 0xffffu; c[3] = w0.y >> 16; c[4] = w0.z & 0xffffu; c[5] = w0.z >> 16; c[6] = w0.w & 0xffffu; c[7] = w0.w >> 16;
        c[8] = w1.x & 0xffffu; c[9] = w1.x >> 16; c[10] = w1.y & 0xffffu; c[11] = w1.y >> 16; c[12] = w1.z & 0xffffu; c[13] = w1.z >> 16; c[14] = w1.w & 0xffffu; c[15] = w1.w >> 16;
        unsigned s = 0;
#pragma unroll
        for (int j = 0; j < 16; ++j) s += c[j];
        unsigned incl = s;
#pragma unroll
        for (int o = 1; o < 64; o <<= 1) { const unsigned t = __shfl_down(incl, o); if (lane + o < 64) incl += t; }
        const unsigned excl = incl - s;
        const bool mine = (excl < 256u) && (incl >= 256u);
        unsigned bin = 0, ab = 0, run = excl; bool found = false;
#pragma unroll
        for (int j = 15; j >= 0; --j) { if (!found && run + c[j] >= 256u) { bin = 16 * lane + j; ab = run; found = true; } if (!found) run += c[j]; }
        const unsigned long long bm = __ballot(mine);
        const int src = bm ? (int)__builtin_ctzll(bm) : 0;
        b1 = __shfl(bin, src); above = __shfl(ab, src);
    }
    LDS_WAIT();
    int need = 256 - (int)above;
    LAS unsigned short* cand = (LAS unsigned short*)hist;
    const int nblk = (n + 255) >> 8;
    int C = 0;
    for (int blk = 0; blk < nblk; ++blk) {
        const f32x4 v = *(const LAS f32x4*)(row + blk * 256 + 4 * lane);
        bool ge[4]; unsigned long long bl[4];
#pragma unroll
        for (int e = 0; e < 4; ++e) { ge[e] = (blk * 256 + 4 * lane + e < n) && (qbin(v[e]) >= b1); bl[e] = __ballot(ge[e]); }
        const int below = __builtin_popcountll(bl[0] & lt) + __builtin_popcountll(bl[1] & lt) + __builtin_popcountll(bl[2] & lt) + __builtin_popcountll(bl[3] & lt);
        int pos = C + below;
#pragma unroll
        for (int e = 0; e < 4; ++e) { if (ge[e]) { if (pos < 768) cand[pos] = (unsigned short)(blk * 256 + 4 * lane + e); ++pos; } }
        C += __builtin_popcountll(bl[0]) + __builtin_popcountll(bl[1]) + __builtin_popcountll(bl[2]) + __builtin_popcountll(bl[3]);
    }
    LDS_WAIT();
    if (C > 512) {
        select_row(row, n, h2, out, lane);
#pragma unroll
        for (int i = 0; i < 8; ++i) hist[lane + 64 * i] = 0u;
        return;
    }
    int ci[8]; unsigned ck[8]; bool cgt[8], ceq[8];
#pragma unroll
    for (int k = 0; k < 8; ++k) { const int j = lane + 64 * k; ci[k] = j < C ? (int)cand[j] : -1; }
#pragma unroll
    for (int k = 0; k < 8; ++k) { const float v = row[ci[k] < 0 ? 0 : ci[k]]; const unsigned bb = qbin(v); ck[k] = fkey(v); cgt[k] = ci[k] >= 0 && bb > b1; ceq[k] = ci[k] >= 0 && bb == b1; }
    unsigned prefix = 0;
#pragma unroll 1
    for (int pass = 3; pass >= 0; --pass) {
#pragma unroll
        for (int i = 0; i < 4; ++i) h2[lane + 64 * i] = 0u;
        LDS_WAIT();
        const int shift = pass * 8;
#pragma unroll
        for (int k = 0; k < 8; ++k) {
            const bool match = ceq[k] && ((pass == 3) || ((ck[k] >> (shift + 8)) == prefix));
            if (match) __hip_atomic_fetch_add(h2 + ((ck[k] >> shift) & 255u), 1u, __ATOMIC_RELAXED, __HIP_MEMORY_SCOPE_WORKGROUP);
        }
        LDS_WAIT();
        const unsigned c0 = h2[4 * lane], c1 = h2[4 * lane + 1], c2 = h2[4 * lane + 2], c3 = h2[4 * lane + 3];
        const unsigned s = c0 + c1 + c2 + c3;
        unsigned incl = s;
#pragma unroll
        for (int o = 1; o < 64; o <<= 1) { const unsigned t = __shfl_down(incl, o); if (lane + o < 64) incl += t; }
        const unsigned excl = incl - s;
        const bool mine = (excl < (unsigned)need) && (incl >= (unsigned)need);
        unsigned bin = 0, ab = 0;
        if (mine) {
            unsigned run = excl;
            if (run + c3 >= (unsigned)need) { bin = 4 * lane + 3; ab = run; }
            else { run += c3;
                if (run + c2 >= (unsigned)need) { bin = 4 * lane + 2; ab = run; }
                else { run += c2;
                    if (run + c1 >= (unsigned)need) { bin = 4 * lane + 1; ab = run; }
                    else { run += c1; bin = 4 * lane; ab = run; } } }
        }
        const unsigned long long bm = __ballot(mine);
        const int src = bm ? (int)__builtin_ctzll(bm) : 0;
        bin = __shfl(bin, src); ab = __shfl(ab, src);
        need -= (int)ab; prefix = (prefix << 8) | bin;
        LDS_WAIT();
    }
    const unsigned Tk = prefix;
    bool tk[8]; int ne = 0;
#pragma unroll
    for (int k = 0; k < 8; ++k) { tk[k] = ceq[k] && ck[k] == Tk; ne += __builtin_popcountll(__ballot(tk[k])); }
    if (ne > need) {
        bool keep[8];
#pragma unroll
        for (int k = 0; k < 8; ++k) keep[k] = false;
        for (int r = 0; r < need; ++r) {
            int mn = 0x7fffffff;
#pragma unroll
            for (int k = 0; k < 8; ++k) if (tk[k] && !keep[k] && ci[k] < mn) mn = ci[k];
#pragma unroll
            for (int o = 1; o < 64; o <<= 1) { const int t = __shfl_xor(mn, o); mn = t < mn ? t : mn; }
#pragma unroll
            for (int k = 0; k < 8; ++k) if (tk[k] && ci[k] == mn) keep[k] = true;
        }
#pragma unroll
        for (int k = 0; k < 8; ++k) tk[k] = keep[k];
    }
    LAS unsigned short* outL = cand + 768;
    int cnt = 0;
#pragma unroll
    for (int k = 0; k < 8; ++k) {
        const bool take = cgt[k] || (ceq[k] && ck[k] > Tk) || tk[k];
        const unsigned long long bt = __ballot(take);
        const int pos = cnt + __builtin_popcountll(bt & lt);
        if (take && pos < 256) outL[pos] = (unsigned short)ci[k];
        cnt += __builtin_popcountll(bt);
    }
    LDS_WAIT();
    *(u32x2*)(out + 4 * lane) = *(const LAS u32x2*)(outL + 4 * lane);
    LDS_WAIT();
#pragma unroll
    for (int i = 0; i < 8; ++i) hist[lane + 64 * i] = 0u;
}

__device__ __forceinline__ void ph_index(const P& p, LAS unsigned char* lds, const int wv) {
    LAS float* Irow = (LAS float*)lds;
    LAS unsigned* hist = (LAS unsigned*)(lds + 131072);
    LAS unsigned* h2 = (LAS unsigned*)(lds + 131072 + 16384);
    const int tid = opaque_tid(wv), lane = tid & 63, wave = __builtin_amdgcn_readfirstlane(tid >> 6);
    const int hh = lane >> 5, n = lane & 31;
    const int rho = lane & 31, qlA = 2 * ((rho >> 2) & 1) + (rho >> 4), hdA = (rho & 3) + 4 * ((rho >> 3) & 1);
#pragma unroll
    for (int i = 0; i < 8; ++i) hist[tid + NTHR * i] = 0u;
    bf16x8 A[2][4]; float wq[2][16]; bf16x8 B0[4], B1[4], B2[4];
#define IDX_LOAD_B(dst, kt_) do { const bf16_t* kp_ = p.KI + (mb + (size_t)(kt_) * 32 + n) * 64 + 8 * hh; \
        _Pragma("unroll") for (int s = 0; s < 4; ++s) dst[s] = *(const bf16x8*)(kp_ + 16 * s); } while (0)
#define IDX_LOAD_UNIT(u_) do { const int b_ = (u_) & 7, t0_ = (511 - ((u_) >> 3)) * 8; const size_t mb = (size_t)b_ * T; const int nkt_ = (t0_ + 8 + 31) >> 5; \
        _Pragma("unroll") for (int mt = 0; mt < 2; ++mt) { const bf16_t* src = p.QI + (mb + t0_ + mt * 4 + qlA) * 512 + hdA * 64 + 8 * hh; \
            _Pragma("unroll") for (int s = 0; s < 4; ++s) A[mt][s] = *(const bf16x8*)(src + 16 * s); \
            _Pragma("unroll") for (int c = 0; c < 2; ++c) { const float* wp = p.WI + (mb + t0_ + mt * 4 + 2 * hh + c) * 8; const f32x4 w0 = *(const f32x4*)wp, w1 = *(const f32x4*)(wp + 4); \
                _Pragma("unroll") for (int j = 0; j < 4; ++j) { wq[mt][c * 8 + j] = w0[j]; wq[mt][c * 8 + 4 + j] = w1[j]; } } } \
        if (wave < nkt_) IDX_LOAD_B(B0, wave); if (wave + NWAVES < nkt_) IDX_LOAD_B(B1, wave + NWAVES); if (wave + 2 * NWAVES < nkt_) IDX_LOAD_B(B2, wave + 2 * NWAVES); } while (0)
    if ((int)blockIdx.x < 4096) IDX_LOAD_UNIT((int)blockIdx.x);
    __syncthreads();
    for (int u = blockIdx.x; u < 4096; u += gridDim.x) {
        const int b = u & 7, tb = 511 - (u >> 3), t0 = tb * 8; const size_t mb = (size_t)b * T;
        const int nkt = (t0 + 8 + 31) >> 5;
#if defined(IDX_DUP_SCORE)
#pragma unroll 1
        for (int rep = 0; rep < 2; ++rep) {
        if (rep == 1) { if (wave < nkt) IDX_LOAD_B(B0, wave); if (wave + NWAVES < nkt) IDX_LOAD_B(B1, wave + NWAVES); if (wave + 2 * NWAVES < nkt) IDX_LOAD_B(B2, wave + 2 * NWAVES); }
#else
        { const int rep = 1;
#endif
#pragma unroll 1
        for (int kt = wave; kt < nkt; kt += NWAVES) {
            const int key = kt * 32 + n;
#pragma unroll
            for (int mt = 0; mt < 2; ++mt) {
                f32x16 acc;
#pragma unroll
                for (int j = 0; j < 16; ++j) acc[j] = 0.f;
#pragma unroll
                for (int s = 0; s < 4; ++s) acc = __builtin_amdgcn_mfma_f32_32x32x16_bf16(A[mt][s], B0[s], acc, 0, 0, 0);
#pragma unroll
                for (int c = 0; c < 2; ++c) {
                    float v = 0.f;
#pragma unroll
                    for (int h = 0; h < 8; ++h) v += wq[mt][c * 8 + h] * fmaxf(acc[c * 8 + h], 0.f);
                    const int r = mt * 4 + 2 * hh + c;
                    Irow[r * 4096 + key] = v;
                    if (key <= t0 + r) { const unsigned bin = qbin(v); __hip_atomic_fetch_add(hist + r * 512 + (bin >> 1), (unsigned)rep << ((bin & 1u) * 16u), __ATOMIC_RELAXED, __HIP_MEMORY_SCOPE_WORKGROUP); }
                }
            }
#pragma unroll
            for (int s = 0; s < 4; ++s) { B0[s] = B1[s]; B1[s] = B2[s]; }
            if (kt + 3 * NWAVES < nkt) IDX_LOAD_B(B2, kt + 3 * NWAVES);
        }
        }
        if (u + (int)gridDim.x < 4096) IDX_LOAD_UNIT(u + (int)gridDim.x);
        __syncthreads();
        select_row4(Irow + wave * 4096, t0 + wave + 1, hist + wave * 512, h2 + wave * 320, p.SEL + (mb + t0 + wave) * 256, lane);
        __syncthreads();
    }
#undef IDX_LOAD_B
#undef IDX_LOAD_UNIT
}

__device__ __forceinline__ bf16x4 tr16(const LAS unsigned char* a) { return __builtin_amdgcn_ds_read_tr16_b64_v4i16((LAS bf16x4*)a); }
__device__ __forceinline__ void ph_attn(const P& p, LAS unsigned char* lds, const int wv) {
    const int tid = opaque_tid(wv), lane = tid & 63, wave = __builtin_amdgcn_readfirstlane(tid >> 6);
    LAS unsigned char* buf = lds + wave * 8192;
    LAS unsigned char* selL = lds + 65536 + wave * 1024;
    LAS unsigned char* tblb = lds + 73728;
    LAS float* bias = (LAS float*)(lds + 73728 + 128);
    LAS float* cst = (LAS float*)(lds + 73728 + 128 + 4096);
    for (int i = tid; i < 1024; i += NTHR) {
        const int d = i >> 3; int bk = d;
        if (d >= 16) { const float nf = (float)d; bk = 16 + (int)(logf(nf / 16.f) / 2.0794415f * 16.f); if (bk > 31) bk = 31; }
        bias[i] = p.rel_bias[bk * 8 + (i & 7)];
    }
    if (wave == 0) {
        float gm = fmaxf(fabsf(p.kv_g[lane]), fabsf(p.kv_g[lane + 64]));
        float bm = fmaxf(fmaxf(fabsf(p.rel_bias[lane]), fabsf(p.rel_bias[lane + 64])), fmaxf(fabsf(p.rel_bias[lane + 128]), fabsf(p.rel_bias[lane + 192])));
#pragma unroll
        for (int o = 1; o < 64; o <<= 1) { gm = fmaxf(gm, __shfl_xor(gm, o)); bm = fmaxf(bm, __shfl_xor(bm, o)); }
        if (lane == 0) { cst[0] = 11.3137085f * gm * 1.01f; cst[1] = bm; }
    }
    __syncthreads();
    const int g = lane >> 4, hcol = lane & 15, q4 = hcol >> 2, p4 = lane & 3;
    const float cmax = cst[0], bmax = cst[1];
    const int G = gridDim.x, bx = blockIdx.x, vcu = (G % 8 == 0) ? (bx % 8) * (G / 8) + bx / 8 : bx;
#define ATT_QF_LOAD(dst, mm) do { _Pragma("unroll") for (int s = 0; s < 4; ++s) { bf16x8 z; _Pragma("unroll") for (int j = 0; j < 8; ++j) z[j] = 0; \
        dst[s] = hcol < 8 ? *(const bf16x8*)(p.QL + (size_t)(mm) * 1024 + hcol * 128 + 32 * s + 8 * g) : z; } } while (0)
#define ATT_LOAD_CHUNK(ST_, selp_, c_, nv_) do { _Pragma("unroll") for (int i = 0; i < 8; ++i) { const int kp = 32 * (c_) + 4 * i + g; \
        const int key = (int)*(const LAS unsigned short*)((selp_) + 2 * kp); \
        ST_[i >> 2][i & 3] = *(const bf16x8*)(p.CKVB + (mb + key) * 128 + 8 * hcol); } } while (0)
    for (int qc = vcu; qc < M / 128; qc += G) {
        const int m0 = qc * 128 + wave * 16;
        const size_t mb = (size_t)(m0 >> 12) * T;
        u32x2 sv = *(const u32x2*)(p.SEL + (size_t)m0 * 256 + 4 * lane);
        bf16x8 qf[4], qfn[4], sA[2][4], sB[2][4], sC[2][4];
        ATT_QF_LOAD(qfn, m0);
        *(LAS u32x2*)(selL + lane * 8) = sv;
        LDS_WAIT();
        { const int t0 = m0 & (T - 1); const int nv0 = t0 + 1 < 256 ? t0 + 1 : 256; ATT_LOAD_CHUNK(sA, selL, 0, nv0); ATT_LOAD_CHUNK(sB, selL, 1, nv0); }
        sv = *(const u32x2*)(p.SEL + (size_t)(m0 + 1) * 256 + 4 * lane);
        f32x4 o[8]; float lsum = 0.f, mh = 0.f;
#pragma unroll
        for (int rt = 0; rt < 8; ++rt) o[rt] = (f32x4){0.f, 0.f, 0.f, 0.f};
#define ATT_BODY(gc_, SCUR, SPRE) do { const int gc = (gc_); if (gc < 128) { \
            const int qi = gc >> 3, c = gc & 7, m = m0 + qi; \
            const int t = m & (T - 1); const int nvalid = t + 1 < 256 ? t + 1 : 256; \
            const LAS unsigned char* selc = selL + (qi & 1) * 512; \
            if (c == 0) { \
                _Pragma("unroll") for (int s = 0; s < 4; ++s) qf[s] = qfn[s]; \
                float ss = 0.f; \
                _Pragma("unroll") for (int s = 0; s < 4; ++s) _Pragma("unroll") for (int j = 0; j < 8; ++j) { const float v = bf2f((unsigned short)qf[s][j]); ss += v * v; } \
                ss += __shfl_xor(ss, 16); ss += __shfl_xor(ss, 32); \
                mh = sqrtf(ss) * cmax + bmax; \
                if (qi < 15) ATT_QF_LOAD(qfn, m + 1); \
            } \
            f32x4 acc[2]; \
            _Pragma("unroll") for (int i = 0; i < 8; ++i) *(LAS bf16x8*)(buf + off_b(4 * i + g, hcol)) = SCUR[i >> 2][i & 3]; \
            _Pragma("unroll") for (int tau = 0; tau < 2; ++tau) { \
                acc[tau] = (f32x4){0.f, 0.f, 0.f, 0.f}; \
                _Pragma("unroll") for (int s = 0; s < 4; ++s) \
                    acc[tau] = __builtin_amdgcn_mfma_f32_16x16x32_bf16(*(const LAS bf16x8*)(buf + off_b(16 * tau + hcol, 4 * s + g)), qf[s], acc[tau], 0, 0, 0); \
            } \
            if (c == 3 && qi < 15) { \
                *(LAS u32x2*)(selL + ((qi + 1) & 1) * 512 + lane * 8) = sv; \
                if (qi < 14) sv = *(const u32x2*)(p.SEL + (size_t)(m + 2) * 256 + 4 * lane); \
            } \
            if (gc + 2 < 128) { \
                const int nqi = (gc + 2) >> 3, nc = (gc + 2) & 7, tn = (m0 + nqi) & (T - 1); const int nvn = tn + 1 < 256 ? tn + 1 : 256; \
                ATT_LOAD_CHUNK(SPRE, selL + (nqi & 1) * 512, nc, nvn); \
            } \
            float pr[2][4]; \
            _Pragma("unroll") for (int tau = 0; tau < 2; ++tau) { \
                const int kp0 = 32 * c + 16 * tau + 4 * g; \
                const u32x2 kk = *(const LAS u32x2*)(selc + 2 * kp0); \
                const int keys[4] = {(int)(kk.x & 0xffffu), (int)(kk.x >> 16), (int)(kk.y & 0xffffu), (int)(kk.y >> 16)}; \
                _Pragma("unroll") for (int r = 0; r < 4; ++r) { \
                    const int dist = t - keys[r]; const bool valid = (kp0 + r) < nvalid; \
                    const int dcl = dist > 127 ? 127 : dist; \
                    const float e = __expf(acc[tau][r] + bias[dcl * 8 + (hcol & 7)] - mh); \
                    pr[tau][r] = valid ? e : 0.f; lsum += pr[tau][r]; \
                } \
            } \
            u32x4 pw; pw.x = pk2(pr[0][0], pr[0][1]); pw.y = pk2(pr[0][2], pr[0][3]); pw.z = pk2(pr[1][0], pr[1][1]); pw.w = pk2(pr[1][2], pr[1][3]); \
            const bf16x8 pf = __builtin_bit_cast(bf16x8, pw); \
            _Pragma("unroll") for (int rt = 0; rt < 8; ++rt) { \
                const unsigned row0 = 4 * g + q4, ch = 2 * rt + (p4 >> 1); \
                const bf16x4 a0 = tr16(buf + off_b(row0, ch) + 8 * (p4 & 1)); \
                const bf16x4 a1 = tr16(buf + off_b(row0 + 16, ch) + 8 * (p4 & 1)); \
                o[rt] = __builtin_amdgcn_mfma_f32_16x16x32_bf16(cat4(a0, a1), pf, o[rt], 0, 0, 0); \
            } \
            if (c == 7) { \
                lsum += __shfl_xor(lsum, 16); lsum += __shfl_xor(lsum, 32); \
                const float inv = 1.f / lsum; \
                if (hcol < 8) { \
                    _Pragma("unroll") for (int rt = 0; rt < 8; ++rt) { \
                        u32x2 w; w.x = pk2(o[rt][0] * inv, o[rt][1] * inv); w.y = pk2(o[rt][2] * inv, o[rt][3] * inv); \
                        *(u32x2*)(p.OL + (size_t)m * 1024 + hcol * 128 + 16 * rt + 4 * g) = w; \
                    } \
                } \
                _Pragma("unroll") for (int rt = 0; rt < 8; ++rt) o[rt] = (f32x4){0.f, 0.f, 0.f, 0.f}; \
                lsum = 0.f; \
            } } } while (0)
#pragma unroll 1
        for (int g3 = 0; g3 < 129; g3 += 3) {
            ATT_BODY(g3, sA, sC);
            ATT_BODY(g3 + 1, sB, sA);
            ATT_BODY(g3 + 2, sC, sB);
        }
#undef ATT_BODY
    }
#undef ATT_LOAD_CHUNK
#undef ATT_QF_LOAD
}

struct Cand8 { float v[8]; int id[8]; unsigned bn[8]; bool ok[8]; };

__device__ __forceinline__ void coarse_thr(const Cand8& c, LAS unsigned* hist, int lane, unsigned& b1, unsigned& above) {
#pragma unroll
    for (int k = 0; k < 8; ++k) if (c.ok[k]) __hip_atomic_fetch_add(hist + (c.bn[k] >> 1), 1u << ((c.bn[k] & 1u) * 16u), __ATOMIC_RELAXED, __HIP_MEMORY_SCOPE_WORKGROUP);
    LDS_WAIT();
    const u32x4 w0 = *(const LAS u32x4*)(hist + 8 * lane), w1 = *(const LAS u32x4*)(hist + 8 * lane + 4);
    unsigned cc[16];
    cc[0] = w0.x & 0xffffu; cc[1] = w0.x >> 16; cc[2] = w0.y & 0xffffu; cc[3] = w0.y >> 16; cc[4] = w0.z & 0xffffu; cc[5] = w0.z >> 16; cc[6] = w0.w & 0xffffu; cc[7] = w0.w >> 16;
    cc[8] = w1.x & 0xffffu; cc[9] = w1.x >> 16; cc[10] = w1.y & 0xffffu; cc[11] = w1.y >> 16; cc[12] = w1.z & 0xffffu; cc[13] = w1.z >> 16; cc[14] = w1.w & 0xffffu; cc[15] = w1.w >> 16;
    unsigned s = 0;
#pragma unroll
    for (int j = 0; j < 16; ++j) s += cc[j];
    unsigned incl = s;
#pragma unroll
    for (int o = 1; o < 64; o <<= 1) { const unsigned t = __shfl_down(incl, o); if (lane + o < 64) incl += t; }
    const unsigned excl = incl - s;
    const bool mine = (excl < 256u) && (incl >= 256u);
    unsigned bin = 0, ab = 0, run = excl; bool found = false;
#pragma unroll
    for (int j = 15; j >= 0; --j) { if (!found && run + cc[j] >= 256u) { bin = 16 * lane + j; ab = run; found = true; } if (!found) run += cc[j]; }
    const unsigned long long bm = __ballot(mine);
    const int src = bm ? (int)__builtin_ctzll(bm) : 0;
    b1 = __shfl(bin, src); above = __shfl(ab, src);
    LDS_WAIT();
}

__device__ __forceinline__ void exact_take(const Cand8& c, unsigned b1, int need, LAS unsigned* h2, int lane, bool (&take)[8]) {
    unsigned ck[8]; bool ceq[8];
#pragma unroll
    for (int k = 0; k < 8; ++k) { ck[k] = fkey(c.v[k]); ceq[k] = c.ok[k] && c.bn[k] == b1; }
    unsigned prefix = 0;
#pragma unroll 1
    for (int pass = 3; pass >= 0; --pass) {
#pragma unroll
        for (int i = 0; i < 4; ++i) h2[lane + 64 * i] = 0u;
        LDS_WAIT();
        const int shift = pass * 8;
#pragma unroll
        for (int k = 0; k < 8; ++k) {
            const bool match = ceq[k] && ((pass == 3) || ((ck[k] >> (shift + 8)) == prefix));
            if (match) __hip_atomic_fetch_add(h2 + ((ck[k] >> shift) & 255u), 1u, __ATOMIC_RELAXED, __HIP_MEMORY_SCOPE_WORKGROUP);
        }
        LDS_WAIT();
        const unsigned c0 = h2[4 * lane], c1 = h2[4 * lane + 1], c2 = h2[4 * lane + 2], c3 = h2[4 * lane + 3];
        const unsigned s = c0 + c1 + c2 + c3;
        unsigned incl = s;
#pragma unroll
        for (int o = 1; o < 64; o <<= 1) { const unsigned t = __shfl_down(incl, o); if (lane + o < 64) incl += t; }
        const unsigned excl = incl - s;
        const bool mine = (excl < (unsigned)need) && (incl >= (unsigned)need);
        unsigned bin = 0, ab = 0;
        if (mine) {
            unsigned run = excl;
            if (run + c3 >= (unsigned)need) { bin = 4 * lane + 3; ab = run; }
            else { run += c3;
                if (run + c2 >= (unsigned)need) { bin = 4 * lane + 2; ab = run; }
                else { run += c2;
                    if (run + c1 >= (unsigned)need) { bin = 4 * lane + 1; ab = run; }
                    else { run += c1; bin = 4 * lane; ab = run; } } }
        }
        const unsigned long long bm = __ballot(mine);
        const int src = bm ? (int)__builtin_ctzll(bm) : 0;
        bin = __shfl(bin, src); ab = __shfl(ab, src);
        need -= (int)ab; prefix = (prefix << 8) | bin;
        LDS_WAIT();
    }
    const unsigned Tk = prefix;
    bool tk[8]; int ne = 0;
#pragma unroll
    for (int k = 0; k < 8; ++k) { tk[k] = ceq[k] && ck[k] == Tk; ne += __builtin_popcountll(__ballot(tk[k])); }
    if (ne > need) {
        bool keep[8];
#pragma unroll
        for (int k = 0; k < 8; ++k) keep[k] = false;
        for (int r = 0; r < need; ++r) {
            int mn = 0x7fffffff;
#pragma unroll
            for (int k = 0; k < 8; ++k) if (tk[k] && !keep[k] && c.id[k] < mn) mn = c.id[k];
#pragma unroll
            for (int o = 1; o < 64; o <<= 1) { const int t = __shfl_xor(mn, o); mn = t < mn ? t : mn; }
#pragma unroll
            for (int k = 0; k < 8; ++k) if (tk[k] && c.id[k] == mn) keep[k] = true;
        }
#pragma unroll
        for (int k = 0; k < 8; ++k) tk[k] = keep[k];
    }
#pragma unroll
    for (int k = 0; k < 8; ++k) take[k] = (c.ok[k] && c.bn[k] > b1) || (ceq[k] && ck[k] > Tk) || tk[k];
}


__device__ __forceinline__ void select_row_g(const float* row, int n, LAS unsigned* hist, unsigned short* out, int lane) {
    unsigned prefix = 0; int need = 256;
    const unsigned long long lt = (1ull << lane) - 1ull;
#pragma unroll 1
    for (int pass = 3; pass >= 0; --pass) {
#pragma unroll
        for (int i = 0; i < 4; ++i) hist[lane + 64 * i] = 0u;
        LDS_WAIT();
        const int shift = pass * 8;
        for (int i = lane; i < n; i += 64) {
            const unsigned k = fkey(row[i]);
            const bool match = (pass == 3) || ((k >> (shift + 8)) == prefix);
            if (match) __hip_atomic_fetch_add(hist + ((k >> shift) & 255u), 1u, __ATOMIC_RELAXED, __HIP_MEMORY_SCOPE_WORKGROUP);
        }
        LDS_WAIT();
        const unsigned c0 = hist[4 * lane], c1 = hist[4 * lane + 1], c2 = hist[4 * lane + 2], c3 = hist[4 * lane + 3];
        const unsigned s = c0 + c1 + c2 + c3;
        unsigned incl = s;
#pragma unroll
        for (int o = 1; o < 64; o <<= 1) { const unsigned t = __shfl_down(incl, o); if (lane + o < 64) incl += t; }
        const unsigned excl = incl - s;
        const bool mine = (excl < (unsigned)need) && (incl >= (unsigned)need);
        unsigned bin = 0, above = 0;
        if (mine) {
            unsigned run = excl;
            if (run + c3 >= (unsigned)need) { bin = 4 * lane + 3; above = run; }
            else { run += c3;
                if (run + c2 >= (unsigned)need) { bin = 4 * lane + 2; above = run; }
                else { run += c2;
                    if (run + c1 >= (unsigned)need) { bin = 4 * lane + 1; above = run; }
                    else { run += c1; bin = 4 * lane; above = run; } } }
        }
        const unsigned long long bm = __ballot(mine);
        const int src = bm ? (int)__builtin_ctzll(bm) : 0;
        bin = __shfl(bin, src); above = __shfl(above, src);
        need -= (int)above; prefix = (prefix << 8) | bin;
        LDS_WAIT();
    }
    const unsigned Tk = prefix;
    int cnt = 0, eq_taken = 0;
    for (int i0 = 0; i0 < n; i0 += 64) {
        const int i = i0 + lane; const bool valid = i < n;
        const unsigned k = valid ? fkey(row[i]) : 0u;
        const bool gtk = valid && (k > Tk), eqk = valid && (k == Tk);
        const unsigned long long beq = __ballot(eqk);
        const int eq_rank = eq_taken + __builtin_popcountll(beq & lt);
        const bool take = gtk || (eqk && eq_rank < need);
        const unsigned long long bt = __ballot(take);
        const int pos = cnt + __builtin_popcountll(bt & lt);
        if (take && pos < 256) out[pos] = (unsigned short)i;
        cnt += __builtin_popcountll(bt); eq_taken += __builtin_popcountll(beq);
    }
}

constexpr int IDX_CAP = 336;
__device__ __forceinline__ void ph_index6(const P& p, LAS unsigned char* lds, const int wv) {
    const int tid = opaque_tid(wv), lane = tid & 63, wave = __builtin_amdgcn_readfirstlane(tid >> 6);
    LAS unsigned char* KS = lds;
    LAS unsigned char* QR = lds + 32768 + wave * 4 * 2048;
    LAS unsigned* h2 = (LAS unsigned*)(lds + 98304) + wave * 256;
    const int hh = lane >> 5, n = lane & 31;
    const int rho = lane & 31, qlA = 2 * ((rho >> 2) & 1) + (rho >> 4), hdA = (rho & 3) + 4 * ((rho >> 3) & 1);
    const unsigned long long lt = (1ull << lane) - 1ull;
    const unsigned lt32 = (1u << n) - 1u;
    for (int gq = blockIdx.x; gq < 1024; gq += gridDim.x) {
        const int b = gq & 7, t0 = (127 - (gq >> 3)) * 32; const size_t mb = (size_t)b * T;
        const int tw = t0 + 4 * wave;
        bf16x8 A[4]; float wq[16];
        {
            const bf16_t* src = p.QI + (mb + tw + qlA) * 512 + hdA * 64 + 8 * hh;
#pragma unroll
            for (int s = 0; s < 4; ++s) A[s] = *(const bf16x8*)(src + 16 * s);
#pragma unroll
            for (int c = 0; c < 2; ++c) {
                const float* wp = p.WI + (mb + tw + 2 * hh + c) * 8;
                const f32x4 w0 = *(const f32x4*)wp, w1 = *(const f32x4*)(wp + 4);
#pragma unroll
                for (int j = 0; j < 4; ++j) { wq[c * 8 + j] = w0[j]; wq[c * 8 + 4 + j] = w1[j]; }
            }
        }
#pragma unroll
        for (int i = 0; i < 8; ++i) *(LAS u32x4*)(QR + (lane + 64 * i) * 16) = (u32x4){0u, 0u, 0u, 0u};
#pragma unroll
        for (int s = 0; s < 4; ++s) asm volatile("" :: "v"(A[s]));
#pragma unroll
        for (int j = 0; j < 16; ++j) asm volatile("" :: "v"(wq[j]));
        int cnt[4]; unsigned b1q[4], abq[4];
#pragma unroll
        for (int q = 0; q < 4; ++q) { cnt[q] = 0; b1q[q] = 0u; abq[q] = 0u; }
        const int nst = (t0 + 32 + 127) >> 7;
        const int qme = 2 * hh;
        const LAS unsigned char* myq = QR + qme * 2048;
#pragma unroll 1
        for (int sweep = 0; sweep < 2; ++sweep) {
            u32x4 sr[2];
#pragma unroll
            for (int i = 0; i < 2; ++i) { const int idx = tid + NTHR * i, row = idx >> 3, ch = idx & 7; sr[i] = *(const u32x4*)(p.KI + (mb + row) * 64 + ch * 8); }
#pragma unroll
            for (int i = 0; i < 2; ++i) { const int idx = tid + NTHR * i, row = idx >> 3, ch = idx & 7; *(LAS u32x4*)(KS + row * 128 + 16 * (ch ^ (row & 7))) = sr[i]; }
            __syncthreads();
#pragma unroll 1
            for (int st = 0; st < nst; ++st) {
                if (st + 1 < nst) {
#pragma unroll
                    for (int i = 0; i < 2; ++i) { const int idx = tid + NTHR * i, row = idx >> 3, ch = idx & 7; sr[i] = *(const u32x4*)(p.KI + (mb + (st + 1) * 128 + row) * 64 + ch * 8); }
                }
                const LAS unsigned char* kb = KS + (st & 1) * 16384;
#pragma unroll 1
                for (int tl = 0; tl < 4; ++tl) {
                    const int key0 = st * 128 + tl * 32;
                    if (key0 > tw + 3) break;
                    const int row = tl * 32 + n, key = key0 + n;
                    f32x16 acc;
#pragma unroll
                    for (int j = 0; j < 16; ++j) acc[j] = 0.f;
#pragma unroll
                    for (int s = 0; s < 4; ++s) {
                        const bf16x8 Bf = *(const LAS bf16x8*)(kb + row * 128 + 16 * ((2 * s + hh) ^ (row & 7)));
                        acc = __builtin_amdgcn_mfma_f32_32x32x16_bf16(A[s], Bf, acc, 0, 0, 0);
                    }
#pragma unroll
                    for (int c = 0; c < 2; ++c) {
                        float v = 0.f;
#pragma unroll
                        for (int h = 0; h < 8; ++h) v += wq[c * 8 + h] * fmaxf(acc[c * 8 + h], 0.f);
                        const unsigned bn = qbin(v);
                        const bool causal = key <= tw + qme + c;
                        if (sweep == 0) {
                            if (causal) __hip_atomic_fetch_add((LAS unsigned*)(myq + c * 2048) + (bn >> 1), 1u << ((bn & 1u) * 16u), __ATOMIC_RELAXED, __HIP_MEMORY_SCOPE_WORKGROUP);
                        } else {
                            const unsigned bl = hh ? b1q[2 + c] : b1q[c];
                            const bool pass = causal && (bn >= bl);
                            const unsigned long long mk = __ballot(pass);
                            const unsigned lo = (unsigned)mk, hi = (unsigned)(mk >> 32);
                            const int rank = hh ? __builtin_popcount(hi & lt32) : __builtin_popcount(lo & lt32);
                            const int pos = (hh ? cnt[2 + c] : cnt[c]) + rank;
                            if (pass && pos < IDX_CAP) { LAS unsigned char* qr = QR + (qme + c) * 2048; ((LAS float*)qr)[pos] = v; ((LAS unsigned short*)(qr + IDX_CAP * 4))[pos] = (unsigned short)key; }
                            cnt[c] += __builtin_popcount(lo); cnt[2 + c] += __builtin_popcount(hi);
                        }
                    }
                }
                if (st + 1 < nst) {
#pragma unroll
                    for (int i = 0; i < 2; ++i) { const int idx = tid + NTHR * i, row = idx >> 3, ch = idx & 7; *(LAS u32x4*)(KS + ((st + 1) & 1) * 16384 + row * 128 + 16 * (ch ^ (row & 7))) = sr[i]; }
                }
                __syncthreads();
            }
            if (sweep == 0) {
                LDS_WAIT();
#pragma unroll 1
                for (int q = 0; q < 4; ++q) {
                    unsigned b1 = 0u, above = 0u;
                    if (tw + q + 1 > 256) {
                        const LAS unsigned* hist = (const LAS unsigned*)(QR + q * 2048);
                        const u32x4 w0 = *(const LAS u32x4*)(hist + 8 * lane), w1 = *(const LAS u32x4*)(hist + 8 * lane + 4);
                        unsigned cc[16];
                        cc[0] = w0.x & 0xffffu; cc[1] = w0.x >> 16; cc[2] = w0.y & 0xffffu; cc[3] = w0.y >> 16; cc[4] = w0.z & 0xffffu; cc[5] = w0.z >> 16; cc[6] = w0.w & 0xffffu; cc[7] = w0.w >> 16;
                        cc[8] = w1.x & 0xffffu; cc[9] = w1.x >> 16; cc[10] = w1.y & 0xffffu; cc[11] = w1.y >> 16; cc[12] = w1.z & 0xffffu; cc[13] = w1.z >> 16; cc[14] = w1.w & 0xffffu; cc[15] = w1.w >> 16;
                        unsigned s = 0;
#pragma unroll
                        for (int j = 0; j < 16; ++j) s += cc[j];
                        unsigned incl = s;
#pragma unroll
                        for (int o = 1; o < 64; o <<= 1) { const unsigned t = __shfl_down(incl, o); if (lane + o < 64) incl += t; }
                        const unsigned excl = incl - s;
                        const bool mine = (excl < 256u) && (incl >= 256u);
                        unsigned bin = 0, ab = 0, run = excl; bool found = false;
#pragma unroll
                        for (int j = 15; j >= 0; --j) { if (!found && run + cc[j] >= 256u) { bin = 16 * lane + j; ab = run; found = true; } if (!found) run += cc[j]; }
                        const unsigned long long bm = __ballot(mine);
                        const int src = bm ? (int)__builtin_ctzll(bm) : 0;
                        b1 = __shfl(bin, src); above = __shfl(ab, src);
                    }
#pragma unroll
                    for (int qq = 0; qq < 4; ++qq) { b1q[qq] = qq == q ? b1 : b1q[qq]; abq[qq] = qq == q ? above : abq[qq]; }
                }
                LDS_WAIT();
            }
        }
        LDS_WAIT();
#pragma unroll 1
        for (int q = 0; q < 4; ++q) {
            unsigned short* out = p.SEL + (mb + tw + q) * 256;
            const int nq = tw + q + 1;
            const int cq = q == 0 ? cnt[0] : q == 1 ? cnt[1] : q == 2 ? cnt[2] : cnt[3];
            const unsigned b1 = q == 0 ? b1q[0] : q == 1 ? b1q[1] : q == 2 ? b1q[2] : b1q[3];
            const unsigned above = q == 0 ? abq[0] : q == 1 ? abq[1] : q == 2 ? abq[2] : abq[3];
            if (nq <= 256) {
#pragma unroll
                for (int i = 0; i < 4; ++i) { const int k = lane + 64 * i; out[k] = (unsigned short)(k < nq ? k : 0); }
            } else if (cq <= IDX_CAP) {
                const LAS float* cv = (const LAS float*)(QR + q * 2048); const LAS unsigned short* cix = (const LAS unsigned short*)(QR + q * 2048 + IDX_CAP * 4);
                Cand8 c;
#pragma unroll
                for (int k = 0; k < 8; ++k) { const int j = lane + 64 * k; c.ok[k] = j < cq; c.v[k] = c.ok[k] ? cv[j] : 0.f; c.id[k] = c.ok[k] ? (int)cix[j] : 0; c.bn[k] = qbin(c.v[k]); }
                bool take[8];
                exact_take(c, b1, 256 - (int)above, h2, lane, take);
                LDS_WAIT();
                LAS unsigned short* outL = (LAS unsigned short*)(QR + q * 2048);
                int np = 0;
#pragma unroll
                for (int k = 0; k < 8; ++k) {
                    const unsigned long long bt = __ballot(take[k]);
                    const int pos = np + __builtin_popcountll(bt & lt);
                    if (take[k] && pos < 256) outL[pos] = (unsigned short)c.id[k];
                    np += __builtin_popcountll(bt);
                }
                LDS_WAIT();
                *(u32x2*)(out + 4 * lane) = *(const LAS u32x2*)(outL + 4 * lane);
                LDS_WAIT();
            } else {
                float* grow = p.IDXROW + (size_t)(blockIdx.x * NWAVES + wave) * 4096;
                const bf16_t* qsrc = p.QI + (mb + tw + q) * 512; const float* wsrc = p.WI + (mb + tw + q) * 8;
                for (int key = lane; key < nq; key += 64) {
                    const bf16_t* kr = p.KI + (mb + key) * 64;
                    float sc = 0.f;
                    for (int h = 0; h < 8; ++h) { float d = 0.f; for (int e = 0; e < 64; ++e) d += bf2f(qsrc[h * 64 + e]) * bf2f(kr[e]); sc += wsrc[h] * fmaxf(d, 0.f); }
                    grow[key] = sc;
                }
                asm volatile("s_waitcnt vmcnt(0)" ::: "memory");
                select_row_g(grow, nq, h2, out, lane);
            }
        }
        __syncthreads();
    }
}

__device__ __forceinline__ void ph_gmlp(const P& p, LAS unsigned char* lds, const int wv) {
    const int tid = opaque_tid(wv), lane = tid & 63, wave = __builtin_amdgcn_readfirstlane(tid >> 6);
    LAS unsigned char* vt = lds;
    LAS float* st = (LAS float*)(lds + 32768);
    const unsigned vbase = lds_addr_of(vt);
    const int g4 = lane >> 4, q4 = (lane & 15) >> 2, p4 = lane & 3;
    for (int u = blockIdx.x; u < 256; u += gridDim.x) {
        const size_t m0 = (size_t)u * 128;
        for (int rr = 0; rr < 16; ++rr) {
            const int row = 16 * wave + rr;
            const u32x4 w = *(const u32x4*)(p.VB + (m0 + row) * 512 + lane * 8);
            const float x0 = bflo(w.x), x1 = bfhi(w.x), x2 = bflo(w.y), x3 = bfhi(w.y), x4 = bflo(w.z), x5 = bfhi(w.z), x6 = bflo(w.w), x7 = bfhi(w.w);
            const float mean = wave_sum(((x0 + x1) + (x2 + x3)) + ((x4 + x5) + (x6 + x7))) * (1.f / 512.f);
            const float d0 = x0 - mean, d1 = x1 - mean, d2 = x2 - mean, d3 = x3 - mean, d4 = x4 - mean, d5 = x5 - mean, d6 = x6 - mean, d7 = x7 - mean;
            const float var = wave_sum(((d0 * d0 + d1 * d1) + (d2 * d2 + d3 * d3)) + ((d4 * d4 + d5 * d5) + (d6 * d6 + d7 * d7))) * (1.f / 512.f);
            if (lane == 0) { st[2 * row] = mean; st[2 * row + 1] = 1.0f / sqrtf(var + EPS); }
        }
        __syncthreads();
#pragma unroll 1
        for (int g = 0; g < 4; ++g) {
#pragma unroll
            for (int i = 0; i < 4; ++i) {
                const int piece = i * NTHR + tid, row = piece >> 4, ch = piece & 15;
                const u32x4 w = *(const u32x4*)(p.VB + (m0 + row) * 512 + g * 128 + ch * 8);
                const float mean = st[2 * row], rstd = st[2 * row + 1];
                const f32x4 ga = *(const f32x4*)(p.ln_g + g * 128 + ch * 8), gb = *(const f32x4*)(p.ln_g + g * 128 + ch * 8 + 4);
                const f32x4 ba = *(const f32x4*)(p.ln_b + g * 128 + ch * 8), bb = *(const f32x4*)(p.ln_b + g * 128 + ch * 8 + 4);
                u32x4 o;
                o.x = pk2((bflo(w.x) - mean) * rstd * ga[0] + ba[0], (bfhi(w.x) - mean) * rstd * ga[1] + ba[1]);
                o.y = pk2((bflo(w.y) - mean) * rstd * ga[2] + ba[2], (bfhi(w.y) - mean) * rstd * ga[3] + ba[3]);
                o.z = pk2((bflo(w.z) - mean) * rstd * gb[0] + bb[0], (bfhi(w.z) - mean) * rstd * gb[1] + bb[1]);
                o.w = pk2((bflo(w.w) - mean) * rstd * gb[2] + bb[2], (bfhi(w.w) - mean) * rstd * gb[3] + bb[3]);
                *(LAS u32x4*)(vt + off_b(row, ch)) = o;
            }
            __syncthreads();
            f32x4 acc[8];
#pragma unroll
            for (int et = 0; et < 8; ++et) acc[et] = (f32x4){0.f, 0.f, 0.f, 0.f};
            const int nks = ((16 * wave + 15) >> 5) + 1;
#pragma unroll
            for (int ks = 0; ks < 4; ++ks) {
                if (ks < nks) {
                    const bf16x8 a = *(const bf16x8*)(p.WSB + ((size_t)g * 128 + 16 * wave + (lane & 15)) * 128 + 32 * ks + 8 * g4);
#pragma unroll
                    for (int et = 0; et < 8; ++et) {
                        const unsigned r0 = 32 * ks + 8 * g4 + q4, ch = 2 * et + (p4 >> 1);
                        const bf16x4 b0 = tr_read(vbase + off_b(r0, ch) + 8 * (p4 & 1));
                        const bf16x4 b1 = tr_read(vbase + off_b(r0 + 4, ch) + 8 * (p4 & 1));
                        acc[et] = __builtin_amdgcn_mfma_f32_16x16x32_bf16(a, cat4(b0, b1), acc[et], 0, 0, 0);
                    }
                }
            }
#pragma unroll
            for (int r = 0; r < 4; ++r) {
                const int i = 16 * wave + 4 * g4 + r; const float bs = p.b_sp[g * 128 + i];
#pragma unroll
                for (int et = 0; et < 8; ++et) {
                    const size_t o = (m0 + i) * 512 + g * 128 + 16 * et + (lane & 15);
                    p.US[o] = (bf16_t)f2bf(bf2f(p.UB[o]) * (acc[et][r] + bs));
                }
            }
            __syncthreads();
        }
    }
}

__device__ __forceinline__ float dot16(const f32x4 (&hv)[4], const LAS float* wr, int lane) {
    float s = 0.f;
#pragma unroll
    for (int j = 0; j < 4; ++j) { const f32x4 w = ((const LAS f32x4*)wr)[lane + 64 * j]; s += (hv[j].x * w.x + hv[j].y * w.y) + (hv[j].z * w.z + hv[j].w * w.w); }
    return s;
}
__device__ __forceinline__ void ph_router(const P& p, LAS unsigned char* lds, const int wv) {
    const int tid = opaque_tid(wv), lane = tid & 63, wave = __builtin_amdgcn_readfirstlane(tid >> 6);
    LAS float* WL = (LAS float*)lds;
    LAS unsigned* cnt = (LAS unsigned*)(lds + 147456);
    const float* X1 = p.out;
    for (int i = tid; i < 36 * 256; i += NTHR) ((LAS f32x4*)WL)[i] = ((const f32x4*)p.WrT)[i];
    __syncthreads();
    for (int c = blockIdx.x; c < M / 128; c += gridDim.x) {
        if (tid < 32) cnt[tid] = 0u;
        __syncthreads();
#pragma unroll 1
        for (int it = 0; it < 8; ++it) {
            const int m = c * 128 + wave * 16 + it * 2;
            f32x4 hv[2][4];
#pragma unroll
            for (int rr = 0; rr < 2; ++rr) {
                const f32x4* xr = (const f32x4*)(X1 + (size_t)(m + rr) * D) + lane;
#pragma unroll
                for (int j = 0; j < 4; ++j) hv[rr][j] = xr[64 * j];
            }
#pragma unroll
            for (int rr = 0; rr < 2; ++rr) {
                float s = 0.f;
#pragma unroll
                for (int j = 0; j < 4; ++j) s += (hv[rr][j].x * hv[rr][j].x + hv[rr][j].y * hv[rr][j].y) + (hv[rr][j].z * hv[rr][j].z + hv[rr][j].w * hv[rr][j].w);
                const float rinv = 1.0f / sqrtf(wave_sum(s) * (1.f / D) + EPS);
                unsigned long long* o8 = (unsigned long long*)(p.H2B + (size_t)(m + rr) * D) + lane;
#pragma unroll
                for (int j = 0; j < 4; ++j) { const f32x4 g = ((const f32x4*)p.n2g)[lane + 64 * j]; hv[rr][j] = hv[rr][j] * rinv * g;
                    o8[64 * j] = (unsigned long long)pk2(hv[rr][j].x, hv[rr][j].y) | ((unsigned long long)pk2(hv[rr][j].z, hv[rr][j].w) << 32); }
            }
            float gl[2][4];
#pragma unroll
            for (int cc = 0; cc < 4; ++cc) {
#pragma unroll
                for (int rr = 0; rr < 2; ++rr) gl[rr][cc] = dot16(hv[rr], WL + cc * 1024, lane);
                asm volatile("" ::: "memory");
            }
#pragma unroll
            for (int rr = 0; rr < 2; ++rr)
#pragma unroll
                for (int cc = 0; cc < 4; ++cc) gl[rr][cc] = wave_sum(gl[rr][cc]) + p.rg_b[cc];
            int gi[2]; float gwt[2];
#pragma unroll
            for (int rr = 0; rr < 2; ++rr) {
                int g = 0; float gm = gl[rr][0];
#pragma unroll
                for (int i = 1; i < 4; ++i) if (gl[rr][i] > gm) { gm = gl[rr][i]; g = i; }
                float gs = 0.f;
#pragma unroll
                for (int i = 0; i < 4; ++i) gs += __expf(gl[rr][i] - gm);
                gi[rr] = __builtin_amdgcn_readfirstlane(g); gwt[rr] = 1.f / gs;
            }
            float el[2][8];
#pragma unroll
            for (int cc = 0; cc < 8; ++cc) {
#pragma unroll
                for (int rr = 0; rr < 2; ++rr) el[rr][cc] = dot16(hv[rr], WL + (4 + gi[rr] * 8 + cc) * 1024, lane);
                asm volatile("" ::: "memory");
            }
#pragma unroll
            for (int rr = 0; rr < 2; ++rr)
#pragma unroll
                for (int cc = 0; cc < 8; ++cc) el[rr][cc] = wave_sum(el[rr][cc]) + p.re_b[gi[rr] * 8 + cc];
#pragma unroll
            for (int rr = 0; rr < 2; ++rr) {
                int i1 = 0; float m1 = el[rr][0];
#pragma unroll
                for (int j = 1; j < 8; ++j) if (el[rr][j] > m1) { m1 = el[rr][j]; i1 = j; }
                int i2 = 0; float m2 = -INFINITY;
#pragma unroll
                for (int j = 0; j < 8; ++j) if (j != i1 && el[rr][j] > m2) { m2 = el[rr][j]; i2 = j; }
                const float e2r = __expf(m2 - m1), e1 = 1.f / (1.f + e2r), e2 = e2r * e1;
                if (lane == 0) {
                    const int ea = gi[rr] * 8 + i1, eb = gi[rr] * 8 + i2;
                    p.EID[2 * (m + rr)] = ea; p.EID[2 * (m + rr) + 1] = eb;
                    p.EW[2 * (m + rr)] = gwt[rr] * e1; p.EW[2 * (m + rr) + 1] = gwt[rr] * e2;
                    __hip_atomic_fetch_add(cnt + ea, 1u, __ATOMIC_RELAXED, __HIP_MEMORY_SCOPE_WORKGROUP);
                    __hip_atomic_fetch_add(cnt + eb, 1u, __ATOMIC_RELAXED, __HIP_MEMORY_SCOPE_WORKGROUP);
                }
            }
        }
        __syncthreads();
        if (tid < 32) p.BLKCNT[c * 32 + tid] = (int)cnt[tid];
        __syncthreads();
    }
}

__device__ __forceinline__ void ph_scan(const P& p, LAS unsigned char* lds, const int wv) {}
__device__ __forceinline__ void ph_scatter(const P& p, LAS unsigned char* lds, const int wv) {
    const int tid = opaque_tid(wv);
    LAS int* s = (LAS int*)lds;
    LAS int* se = s + 2048;
    const int e = tid & 31, part = tid >> 5;
    int loc[16]; int sum = 0;
#pragma unroll
    for (int i = 0; i < 16; ++i) { loc[i] = p.BLKCNT[(part * 16 + i) * 32 + e]; sum += loc[i]; }
    s[128 + part * 32 + e] = sum;
    __syncthreads();
    if (tid < 32) { int t = 0; for (int k = 0; k < 16; ++k) { const int v = s[128 + k * 32 + tid]; s[128 + k * 32 + tid] = t; t += v; } s[tid] = t; }
    __syncthreads();
    if (tid == 0) { int off = 0; for (int k = 0; k < 32; ++k) { s[32 + k] = off; off += (s[k] + 255) >> 8; } s[64] = off; }
    __syncthreads();
    if (blockIdx.x == 0) {
        const int ntiles = s[64];
        if (tid < 32) { p.MOEI[tid] = s[32 + tid] * 256; p.MOEI[32 + tid] = s[32 + tid]; }
        if (tid == 0) { p.MOEI[64] = ntiles; p.MOEI[65] = ntiles * 2; p.MOEI[66] = ntiles * 4; }
        for (int rt = tid; rt < ntiles; rt += NTHR) {
            int ex = 0;
            for (int k = 0; k < 32; ++k) { const int tb = s[32 + k], nt = (s[k] + 255) >> 8; if (rt >= tb && rt < tb + nt) ex = k; }
            p.GU[4 * rt + 0] = rt; p.GU[4 * rt + 1] = ex * 2; p.GU[4 * rt + 2] = rt; p.GU[4 * rt + 3] = ex * 2 + 1;
#pragma unroll
            for (int j = 0; j < 4; ++j) { p.DN[8 * rt + 2 * j] = rt; p.DN[8 * rt + 2 * j + 1] = ex * 4 + j; }
        }
        for (int k = 0; k < 32; ++k) {
            const int lo = s[32 + k] * 256 + s[k], hi = (s[32 + k] + ((s[k] + 255) >> 8)) * 256;
            for (int i = lo + tid; i < hi; i += NTHR) p.PTOK[i] = -1;
        }
    }
    for (int c = blockIdx.x; c < M / 128; c += gridDim.x) {
        if (part == (c >> 4)) {
            int run = s[32 + e] * 256 + s[128 + part * 32 + e];
#pragma unroll
            for (int i = 0; i < 16; ++i) run += (i < (c & 15)) ? loc[i] : 0;
            s[1024 + e] = run;
        }
        int ex = 0;
        if (tid < 256) { ex = p.EID[c * 256 + tid]; se[tid] = ex; }
        __syncthreads();
        if (tid < 256) {
            int rank = 0;
            for (int t = 0; t < tid; ++t) rank += (se[t] == ex) ? 1 : 0;
            p.PTOK[s[1024 + ex] + rank] = c * 256 + tid;
        }
        __syncthreads();
    }
}

template <bool DRY> __device__ __forceinline__ void ph_final(const P& p, const int wv) {
    const int tid = opaque_tid(wv), lane = tid & 63, wave = tid >> 6;
    const int gw = blockIdx.x * NWAVES + wave, NGW = gridDim.x * NWAVES;
    for (int m4 = gw; m4 < M / 4; m4 += NGW) {
        f32x4 v[4][4]; float s[4];
#pragma unroll
        for (int rr = 0; rr < 4; ++rr) {
            const int m = 4 * m4 + rr;
            const f32x4* xr = (const f32x4*)(p.out + (size_t)m * D) + lane;
            const u32x2* y0 = (const u32x2*)(p.YS + (size_t)m * D) + lane; const u32x2* y1 = (const u32x2*)(p.YS + ((size_t)M + m) * D) + lane;
            s[rr] = 0.f;
#pragma unroll
            for (int j = 0; j < 4; ++j) {
                v[rr][j] = xr[64 * j]; const u32x2 a = y0[64 * j], b = y1[64 * j];
                v[rr][j].x += bflo(a.x) + bflo(b.x); v[rr][j].y += bfhi(a.x) + bfhi(b.x); v[rr][j].z += bflo(a.y) + bflo(b.y); v[rr][j].w += bfhi(a.y) + bfhi(b.y);
                s[rr] += (v[rr][j].x * v[rr][j].x + v[rr][j].y * v[rr][j].y) + (v[rr][j].z * v[rr][j].z + v[rr][j].w * v[rr][j].w);
            }
        }
#pragma unroll
        for (int rr = 0; rr < 4; ++rr) {
            const float rinv = 1.0f / sqrtf(wave_sum(s[rr]) * (1.f / D) + EPS);
            f32x4* xr = (f32x4*)((DRY ? (float*)p.GBB : p.out) + (size_t)(4 * m4 + rr) * D) + lane;
#pragma unroll
            for (int j = 0; j < 4; ++j) { const f32x4 g = ((const f32x4*)p.fg)[lane + 64 * j]; xr[64 * j] = v[rr][j] * rinv * g; }
        }
    }
}

__device__ __forceinline__ void ph_gemm_in(const P& p, LAS unsigned char* lds, const int wv) {
    pg8::Gemm g{p.HB, p.WinT, M, NIN, 1024}; pg8::StaticOrder S; S.init(M, NIN, gridDim.x, (int)blockIdx.x);
    EpiIn E{p.QL, p.QI, p.KI, p.UB, p.VB, p.GAB, p.GBB, p.CKVR, p.WI};
    pg8::gemm_phase<EpiIn, pg8::StaticOrder, true, true>(lds, g, S, E, wv);
}
__device__ __forceinline__ void ph_gemm_yb(const P& p, LAS unsigned char* lds, const int wv) {
    pg8::Gemm g{p.US, p.WpbT, M, 1024, 512}; pg8::StaticOrder S; S.init(M, 1024, gridDim.x, (int)blockIdx.x);
    EpiMB E{p.GBB, p.MB};
    pg8::gemm_phase<EpiMB, pg8::StaticOrder, true, true>(lds, g, S, E, wv);
}
__device__ __forceinline__ void ph_gemm_ya(const P& p, LAS unsigned char* lds, const int wv) {
    pg8::Gemm g{p.OL, p.WovT, M, 1024, 1024}; pg8::StaticOrder S; S.init(M, 1024, gridDim.x, (int)blockIdx.x);
    EpiMG E{p.GAB, p.MB, p.MG};
    pg8::gemm_phase<EpiMG, pg8::StaticOrder, true, true>(lds, g, S, E, wv);
}
__device__ __forceinline__ void ph_gemm_out(const P& p, LAS unsigned char* lds, const int wv) {
    pg8::Gemm g{p.MG, p.WoutT, M, 1024, 1024}; pg8::StaticOrder S; S.init(M, 1024, gridDim.x, (int)blockIdx.x);
    EpiX1 E{p.x, p.out};
    pg8::gemm_phase<EpiX1, pg8::StaticOrder, true, true>(lds, g, S, E, wv);
}
__device__ __forceinline__ void ph_gemm_gu(const P& p, LAS unsigned char* lds, const int wv) {
    pg8::Gemm g{p.H2B, p.WguT, NPOS, 32 * 512, 1024}; TableGatherOrder S{p.GU, p.MOEI + 65, p.PTOK, (int)gridDim.x, (int)blockIdx.x};
    EpiHE E{p.HE};
    pg8::gemm_phase<EpiHE, TableGatherOrder, true, true>(lds, g, S, E, wv);
}
__device__ __forceinline__ void ph_gemm_dn(const P& p, LAS unsigned char* lds, const int wv) {
    pg8::Gemm g{p.HE, p.WdT, NPOS, 32 * 1024, 256}; TableOrder S{p.DN, p.MOEI + 66, (int)gridDim.x, (int)blockIdx.x};
    EpiDown E{p.PTOK, p.EW, p.YS};
    pg8::gemm_phase<EpiDown, TableOrder, true, true>(lds, g, S, E, wv);
}

constexpr int NPHASE = 15;
template <int PH> __device__ __forceinline__ void run_phase(const P& p, LAS unsigned char* lds, const int wv) {
    if constexpr (PH == 0) ph_prep(p, lds, wv);
    if constexpr (PH == 1) ph_gemm_in(p, lds, wv);
    if constexpr (PH == 2) ph_ckvnorm(p, wv);
    if constexpr (PH == 3) ph_index(p, lds, wv);
    if constexpr (PH == 4) ph_attn(p, lds, wv);
    if constexpr (PH == 5) ph_gmlp(p, lds, wv);
    if constexpr (PH == 6) ph_gemm_yb(p, lds, wv);
    if constexpr (PH == 7) ph_gemm_ya(p, lds, wv);
    if constexpr (PH == 8) ph_gemm_out(p, lds, wv);
    if constexpr (PH == 9) ph_router(p, lds, wv);
    if constexpr (PH == 10) ph_scan(p, lds, wv);
    if constexpr (PH == 11) ph_scatter(p, lds, wv);
    if constexpr (PH == 12) ph_gemm_gu(p, lds, wv);
    if constexpr (PH == 13) ph_gemm_dn(p, lds, wv);
    if constexpr (PH == 14) ph_final<false>(p, wv);
}
template <int PH> __global__ void __launch_bounds__(NTHR, 2) k_phase(P p) {
    extern __shared__ __attribute__((aligned(16))) unsigned char lds_raw[];
    run_phase<PH>(p, (LAS unsigned char*)lds_raw, __builtin_amdgcn_readfirstlane(threadIdx.x >> 6));
}

constexpr int MISC_OFF = LDS_BYTES - 256;
__global__ void __launch_bounds__(NTHR, 2) k_mega(P p) {
    extern __shared__ __attribute__((aligned(16))) unsigned char lds_raw[];
    LAS unsigned char* lds = (LAS unsigned char*)lds_raw;
    volatile LAS unsigned* MISC = (volatile LAS unsigned*)(lds + MISC_OFF);
    int wv = __builtin_amdgcn_readfirstlane(threadIdx.x >> 6); asm volatile("" : "+s"(wv));
    if (threadIdx.x < 64) MISC[threadIdx.x] = 0u;
    __syncthreads();
    XcdBarrier bar = xcd_barrier_post(p.ctl + CW_BAR, MISC, wv);
    run_phase<0>(p, lds, wv);
#if defined(DUP0)
    __syncthreads(); run_phase<0>(p, lds, wv);
#endif
    xcd_barrier(bar);
    run_phase<1>(p, lds, wv);
#if defined(DUP1)
    __syncthreads(); run_phase<1>(p, lds, wv);
#endif
    xcd_barrier(bar);
    run_phase<2>(p, lds, wv);
#if defined(DUP2)
    run_phase<2>(p, lds, wv);
#endif
    run_phase<3>(p, lds, wv);
#if defined(DUP3)
    __syncthreads(); run_phase<3>(p, lds, wv);
#endif
    xcd_barrier(bar);
    run_phase<4>(p, lds, wv);  __syncthreads();
#if defined(DUP4)
    run_phase<4>(p, lds, wv);  __syncthreads();
#endif
    run_phase<5>(p, lds, wv);
#if defined(DUP5)
    __syncthreads(); run_phase<5>(p, lds, wv);
#endif
    xcd_barrier(bar);
    run_phase<6>(p, lds, wv);
    run_phase<7>(p, lds, wv);  xcd_barrier(bar);
    run_phase<8>(p, lds, wv);
#if defined(DUP678)
    __syncthreads(); run_phase<6>(p, lds, wv); run_phase<7>(p, lds, wv); xcd_barrier(bar); run_phase<8>(p, lds, wv);
#endif
    xcd_barrier(bar);
    run_phase<9>(p, lds, wv);
#if defined(DUP9)
    __syncthreads(); run_phase<9>(p, lds, wv);
#endif
    xcd_barrier(bar);
    run_phase<11>(p, lds, wv);
#if defined(DUP11)
    __syncthreads(); run_phase<11>(p, lds, wv);
#endif
    xcd_barrier(bar);
    run_phase<12>(p, lds, wv);
#if defined(DUP12)
    __syncthreads(); run_phase<12>(p, lds, wv);
#endif
    xcd_barrier(bar);
    run_phase<13>(p, lds, wv);
#if defined(DUP13)
    __syncthreads(); run_phase<13>(p, lds, wv);
#endif
    xcd_barrier(bar);
#if defined(XBAR10)
    for (int i = 0; i < 10; ++i) xcd_barrier(bar);
#endif
#if defined(DUP14)
    ph_final<true>(p, wv); __syncthreads();
#endif
    run_phase<14>(p, lds, wv);
}

extern "C" void kernel_launch(void* const* d_in, const int* in_sizes, int n_in, void* d_out, int out_size, void* d_ws, size_t ws_size, hipStream_t stream) {
    static int grid = 0; static bool first = true;
    if (grid == 0) {
        if (n_in != 23 || in_sizes[0] != M * D || out_size != M * D || ws_size < WS_END) { fprintf(stderr, "kernel_launch: unexpected shapes (n_in %d, in0 %d, out %d, ws %zu)\n", n_in, n_in > 0 ? in_sizes[0] : -1, out_size, ws_size); grid = -1; return; }
        int dev = 0, cus = 0;
        if (hipGetDevice(&dev) != hipSuccess || hipDeviceGetAttribute(&cus, hipDeviceAttributeMultiprocessorCount, dev) != hipSuccess) { grid = -1; return; }
        grid = cus;
    }
    if (grid < 0) return;
    unsigned char* ws = (unsigned char*)d_ws;
    (void)hipMemsetAsync(ws + WS_CTL, 0, CTL_ZERO_BYTES, stream);
    P p{};
    const float* const* in = (const float* const*)d_in;
    p.x = in[0]; p.w_in = in[1]; p.kv_g = in[2]; p.w_uk = in[3]; p.w_uv = in[4]; p.rel_bias = in[5]; p.ln_g = in[6]; p.ln_b = in[7]; p.w_sp = in[8]; p.b_sp = in[9];
    p.w_pa = in[10]; p.w_pb = in[11]; p.w_out = in[12]; p.n1g = in[13]; p.n2g = in[14]; p.rg_w = in[15]; p.rg_b = in[16]; p.re_w = in[17]; p.re_b = in[18];
    p.w_gate = in[19]; p.w_up = in[20]; p.w_down = in[21]; p.fg = in[22];
    p.out = (float*)d_out; p.ctl = (unsigned*)(ws + WS_CTL);
    p.WinT = (bf16_t*)(ws + WS_WIN); p.WoutT = (bf16_t*)(ws + WS_WOUT); p.WpbT = (bf16_t*)(ws + WS_WPB); p.WovT = (bf16_t*)(ws + WS_WOV); p.WSB = (bf16_t*)(ws + WS_WSB);
    p.WguT = (bf16_t*)(ws + WS_WGU); p.WdT = (bf16_t*)(ws + WS_WD); p.WrT = (float*)(ws + WS_WRT);
    p.HB = (bf16_t*)(ws + WS_A); p.OL = (bf16_t*)(ws + WS_A); p.H2B = (bf16_t*)(ws + WS_A);
    p.QL = (bf16_t*)(ws + WS_B); p.MB = (bf16_t*)(ws + WS_B); p.H2S = (bf16_t*)(ws + WS_B); p.YS = (bf16_t*)(ws + WS_B);
    p.GAB = (bf16_t*)(ws + WS_GA); p.GBB = (bf16_t*)(ws + WS_GB);
    p.UB = (bf16_t*)(ws + WS_C); p.VB = (bf16_t*)(ws + WS_C + 32 * MiB); p.MG = (bf16_t*)(ws + WS_C); p.HE = (bf16_t*)(ws + WS_C);
    p.QI = (bf16_t*)(ws + WS_DQ); p.US = (bf16_t*)(ws + WS_DQ);
    p.CKVR = (float*)(ws + WS_CKVR); p.CKVB = (bf16_t*)(ws + WS_CKVB); p.KI = (bf16_t*)(ws + WS_KI); p.WI = (float*)(ws + WS_WI); p.SEL = (unsigned short*)(ws + WS_SEL);
    p.EID = (int*)(ws + WS_MOE); p.EW = (float*)(ws + WS_MOE + 262144); p.PTOK = (int*)(ws + WS_MOE + 524288); p.MOEI = (int*)(ws + WS_MOE + 1048576);
    p.GU = (int*)(ws + WS_MOE + 1048576 + 4096); p.BLKCNT = (int*)(ws + WS_MOE + 1048576 + 65536); p.IDXROW = (float*)(ws + WS_A); p.CB = (int*)(ws + WS_MOE + 1048576 + 131072); p.DN = (int*)(ws + WS_MOE + 1048576 + 4096 + 8192);
    if (first) { (void)hipFuncSetAttribute((const void*)k_mega, hipFuncAttributeMaxDynamicSharedMemorySize, LDS_BYTES); first = false; }
    hipLaunchKernelGGL(k_mega, dim3(grid), dim3(NTHR), LDS_BYTES, stream, p);
}
```

```cpp
#include <hip/hip_runtime.h>
#include <cstdio>
#include <cstdint>
__device__ __forceinline__ int opaque_tid(const int wv) { int l; asm volatile("v_mbcnt_lo_u32_b32 %0, -1, 0\n\tv_mbcnt_hi_u32_b32 %0, -1, %0" : "=v"(l)); return (wv << 6) + l; }
#define LAS __attribute__((address_space(3)))
namespace pg8 {
#define PG8_LAS __attribute__((address_space(3)))
typedef unsigned short bf16_t;
typedef short bf16x8 __attribute__((ext_vector_type(8)));
typedef float f32x4 __attribute__((ext_vector_type(4)));
typedef unsigned u32x4 __attribute__((ext_vector_type(4)));
constexpr int BM = 256, BK = 64, HALF = 128, HTB = HALF * BK * 2  , STAGE_BYTES = 8 * HTB, NXCD = 8, WGM = 8;

__host__ __device__ __forceinline__ int lds_byte(int r, int c) { const int st = (r >> 4) * 2 + (c >> 5), rr = r & 15, cc = c & 31, ob = rr * 64 + cc * 2; return st * 1024 + (ob ^ (((ob >> 9) & 1) << 5)); }
__host__ __device__ __forceinline__ void stage_rc(int b, int& R, int& C) { const int st = b / 1024, sb = b % 1024, swz = sb ^ (((sb >> 9) & 1) << 5); R = (st >> 1) * 16 + swz / 64; C = (st & 1) * 32 + (swz % 64) / 2; }
__host__ __device__ __forceinline__ int perm32(int rho) { const int n = rho >> 4, i = rho & 15; return 8 * (i >> 2) + 4 * n + (i & 3); }

struct Unit { int pm, pn; };
struct Gemm { const bf16_t* A; const bf16_t* Bt; int M, N, K; };

struct StaticOrder {
    static constexpr bool GATHER = false;
    int nM, nN, nwg, G, c;
    __host__ __device__ void init(int M, int N, int G_, int c_) { nM = M / BM; nN = N / BM; nwg = nM * nN; G = G_; c = c_; }
    __host__ __device__ bool next(int i, Unit& u) const {
        const long L = (long)i * G + c; if (L >= nwg) return false;
        int wgid = (int)L; { const int q = nwg / NXCD, r = nwg % NXCD, xcd = wgid % NXCD, off = wgid / NXCD; wgid = (xcd < r ? xcd * (q + 1) : r * (q + 1) + (xcd - r) * q) + off; }
        const int nig = WGM * nN, gid = wgid / nig, fm = gid * WGM, gsz = (nM - fm) < WGM ? (nM - fm) : WGM;
        u.pm = fm + ((wgid % nig) % gsz); u.pn = (wgid % nig) / gsz; return true;
    }
    __device__ __forceinline__ int arow(int r) const { return r; }
    __device__ __forceinline__ void a_ready(const Unit&) const {}
    __device__ __forceinline__ void done(const Unit&) const {}
};

__device__ __forceinline__ unsigned cvt_pk_bf16(float lo, float hi) { unsigned r; asm volatile("v_cvt_pk_bf16_f32 %0, %1, %2" : "=v"(r) : "v"(lo), "v"(hi)); return r; }
typedef float f32x2 __attribute__((ext_vector_type(2)));
template <class Epi, class Sched, bool ALIGN_EPI = false, bool SP2 = false>
__device__ __forceinline__ void gemm_phase(PG8_LAS unsigned char* lds, const Gemm g, const Sched& S, const Epi& E, const int wv) {
    const int tid = opaque_tid(wv), wid = __builtin_amdgcn_readfirstlane(tid >> 6), lane = tid & 63, wr = wid >> 2, wc = wid & 3, fr = lane & 15, fq = lane >> 4;
    const int K = g.K, nt = K / BK;
    unsigned voffA[2], voffB[2];
#pragma unroll
    for (int i = 0; i < 2; ++i) { int R, C; stage_rc(tid * 16 + i * 8192, R, C); const int Rb = Epi::PERM ? ((R & ~31) + perm32(R & 31)) : R;
        voffA[i] = (unsigned)(R * K + C) * 2u; voffB[i] = (unsigned)(Rb * K + C) * 2u; }
    static_assert(!Sched::GATHER || SP2, "gathered A rows: SP2 loop only");
    unsigned gcur[2][2], gnxt[2][2]; int gR[2], gC[2];
    if constexpr (Sched::GATHER) {
#pragma unroll
        for (int i = 0; i < 2; ++i) { stage_rc(tid * 16 + i * 8192, gR[i], gC[i]); }
    }
#define PG8_GOFF(dst, u_) do { _Pragma("unroll") for (int h_ = 0; h_ < 2; ++h_) _Pragma("unroll") for (int i_ = 0; i_ < 2; ++i_) \
        dst[h_][i_] = ((unsigned)S.arow((u_).pm * BM + h_ * HALF + gR[i_]) * (unsigned)K + (unsigned)gC[i_]) * 2u; } while (0)
    const size_t kstep = (size_t)(BK * 2);
    const size_t hstep = (size_t)HALF * K * 2;
    const size_t tstep = 2 * hstep;
    const unsigned ldsw = (unsigned)wid * 1024u;
    const int aoff = lds_byte(wr * 64 + fr, fq * 8), boff = lds_byte(wc * 32 + fr, fq * 8);
#define PG8_SA(b, h) (((b) * 2 + (h)) * HTB)
#define PG8_SB(b, h) ((4 + (b) * 2 + (h)) * HTB)
#define PG8_STAGE(bufoff, gbase, voff) do { _Pragma("unroll") for (int _i = 0; _i < 2; ++_i) \
        __builtin_amdgcn_global_load_lds((const unsigned*)((const char*)(gbase) + (voff)[_i]), (PG8_LAS unsigned*)(lds + (bufoff) + ldsw + _i * 8192), 16, 0, 0); } while (0)
#define PG8_LDA(dst, b, h) do { _Pragma("unroll") for (int m = 0; m < 4; ++m) _Pragma("unroll") for (int k = 0; k < 2; ++k) dst[m][k] = *(const PG8_LAS bf16x8*)(lds + PG8_SA(b, h) + aoff + m * 2048 + k * 1024); } while (0)
#define PG8_LDB(dst, b, h) do { _Pragma("unroll") for (int n = 0; n < 2; ++n) _Pragma("unroll") for (int k = 0; k < 2; ++k) dst[n][k] = *(const PG8_LAS bf16x8*)(lds + PG8_SB(b, h) + boff + n * 2048 + k * 1024); } while (0)
#define PG8_MMA(ai, bj, At, Bt) do { __builtin_amdgcn_s_setprio(1); _Pragma("unroll") for (int m = 0; m < 4; ++m) _Pragma("unroll") for (int n = 0; n < 2; ++n) _Pragma("unroll") for (int k = 0; k < 2; ++k) \
        acc[ai][bj][m][n] = __builtin_amdgcn_mfma_f32_16x16x32_bf16(Bt[n][k], At[m][k], acc[ai][bj][m][n], 0, 0, 0); __builtin_amdgcn_s_setprio(0); } while (0)
#define PG8_WAIT_V(n) asm volatile("s_waitcnt vmcnt(" #n ")" ::: "memory")
#define PG8_WAIT_L(n) asm volatile("s_waitcnt lgkmcnt(" #n ")" ::: "memory")
#define PG8_BAR __builtin_amdgcn_s_barrier()
#define PG8_SCHED __builtin_amdgcn_sched_barrier(0)
    Unit cur, nxt; int ui = 0;
    if (!S.next(0, cur)) return;
    f32x4 acc[2][2][4][2];
#pragma unroll
    for (int a = 0; a < 2; ++a)
#pragma unroll
        for (int b = 0; b < 2; ++b)
#pragma unroll
            for (int m = 0; m < 4; ++m)
#pragma unroll
                for (int n = 0; n < 2; ++n) acc[a][b][m][n] = (f32x4){0.f, 0.f, 0.f, 0.f};
    bf16x8 At[4][2], B0[2][2], B1[2][2];
    const char* cA = Sched::GATHER ? (const char*)g.A : (const char*)g.A + (size_t)cur.pm * tstep; const char* cB = (const char*)g.Bt + (size_t)cur.pn * tstep;
    S.a_ready(cur);
    if constexpr (Sched::GATHER) { PG8_GOFF(gcur, cur); }
#define PG8_STAGE_A(bufoff, base_, h_, koff_, GO_) do { if constexpr (Sched::GATHER) { PG8_STAGE(bufoff, (const char*)g.A + (koff_), GO_[h_]); } else { PG8_STAGE(bufoff, (base_) + (h_) * hstep + (koff_), voffA); } } while (0)
    if constexpr (SP2) {
        PG8_STAGE(PG8_SB(0, 0), cB, voffB); PG8_STAGE(PG8_SB(0, 1), cB + hstep, voffB); PG8_STAGE_A(PG8_SA(0, 0), cA, 0, 0, gcur); PG8_STAGE_A(PG8_SA(0, 1), cA, 1, 0, gcur);
        if (wr == 1) PG8_BAR;
        PG8_WAIT_V(2); PG8_BAR;
        PG8_STAGE(PG8_SB(1, 0), cB + kstep, voffB); PG8_STAGE_A(PG8_SA(1, 0), cA, 0, kstep, gcur); PG8_STAGE(PG8_SB(1, 1), cB + hstep + kstep, voffB);
        PG8_WAIT_V(6); PG8_BAR;
    } else {
        PG8_STAGE(PG8_SB(0, 0), cB, voffB); PG8_STAGE(PG8_SA(0, 0), cA, voffA); PG8_STAGE(PG8_SB(0, 1), cB + hstep, voffB); PG8_STAGE(PG8_SA(0, 1), cA + hstep, voffA);
        if (wr == 1) PG8_BAR;
        PG8_WAIT_V(4); PG8_BAR;
        PG8_STAGE(PG8_SB(1, 0), cB + kstep, voffB); PG8_STAGE(PG8_SA(1, 0), cA + kstep, voffA); PG8_STAGE(PG8_SB(1, 1), cB + hstep + kstep, voffB);
        PG8_WAIT_V(6); PG8_BAR;
    }
    for (;;) {
        const bool has_next = S.next(ui + 1, nxt);
        const char* nA = Sched::GATHER ? cA : (has_next ? (const char*)g.A + (size_t)nxt.pm * tstep : cA); const char* nB = has_next ? (const char*)g.Bt + (size_t)nxt.pn * tstep : cB;
        if constexpr (Sched::GATHER) { if (has_next) { PG8_GOFF(gnxt, nxt); } else { _Pragma("unroll") for (int h_ = 0; h_ < 2; ++h_) _Pragma("unroll") for (int i_ = 0; i_ < 2; ++i_) gnxt[h_][i_] = gcur[h_][i_]; } }
        for (int t = 0; t < nt; t += 2) {
            const bool last = (t == nt - 2);
            const char* a1 = cA + (size_t)(t + 1) * kstep;
            const char* a2 = last ? nA : cA + (size_t)(t + 2) * kstep; const char* b2 = last ? nB : cB + (size_t)(t + 2) * kstep;
            const char* a3 = a2 + kstep; const char* b3 = b2 + kstep;
            unsigned g2[2][2];
            if constexpr (Sched::GATHER) { _Pragma("unroll") for (int h_ = 0; h_ < 2; ++h_) _Pragma("unroll") for (int i_ = 0; i_ < 2; ++i_) g2[h_][i_] = last ? gnxt[h_][i_] : gcur[h_][i_]; }
            const size_t k1 = (size_t)(t + 1) * kstep, k2 = last ? (size_t)0 : (size_t)(t + 2) * kstep, k3 = k2 + kstep;
            if (last && has_next) S.a_ready(nxt);
            if constexpr (SP2) {
            PG8_LDB(B0, 0, 0); PG8_LDB(B1, 0, 1); PG8_SCHED; PG8_LDA(At, 0, 0); if constexpr (Sched::GATHER) { PG8_STAGE(PG8_SA(1, 1), (const char*)g.A + k1, gcur[1]); } else { PG8_STAGE(PG8_SA(1, 1), a1 + hstep, voffA); }
            PG8_WAIT_V(8); PG8_WAIT_L(0); PG8_BAR; PG8_MMA(0, 0, At, B0); PG8_MMA(0, 1, At, B1); PG8_BAR; PG8_SCHED;
            PG8_LDA(At, 0, 1); PG8_STAGE(PG8_SB(0, 0), b2, voffB); PG8_STAGE(PG8_SB(0, 1), b2 + hstep, voffB); if constexpr (Sched::GATHER) { PG8_STAGE(PG8_SA(0, 0), (const char*)g.A + k2, g2[0]); } else { PG8_STAGE(PG8_SA(0, 0), a2, voffA); }
            PG8_WAIT_V(8); PG8_WAIT_L(0); PG8_BAR; PG8_MMA(1, 0, At, B0); PG8_MMA(1, 1, At, B1); PG8_BAR; PG8_SCHED;
            PG8_LDB(B0, 1, 0); PG8_LDB(B1, 1, 1); PG8_SCHED; PG8_LDA(At, 1, 0); if constexpr (Sched::GATHER) { PG8_STAGE(PG8_SA(0, 1), (const char*)g.A + k2, g2[1]); } else { PG8_STAGE(PG8_SA(0, 1), a2 + hstep, voffA); }
            PG8_WAIT_V(8); PG8_WAIT_L(0); PG8_BAR; PG8_MMA(0, 0, At, B0); PG8_MMA(0, 1, At, B1); PG8_BAR; PG8_SCHED;
            PG8_LDA(At, 1, 1); PG8_STAGE(PG8_SB(1, 0), b3, voffB); PG8_STAGE(PG8_SB(1, 1), b3 + hstep, voffB); if constexpr (Sched::GATHER) { PG8_STAGE(PG8_SA(1, 0), (const char*)g.A + k3, g2[0]); } else { PG8_STAGE(PG8_SA(1, 0), a3, voffA); }
            PG8_WAIT_V(8); PG8_WAIT_L(0); PG8_BAR; PG8_MMA(1, 0, At, B0); PG8_MMA(1, 1, At, B1); PG8_BAR; PG8_SCHED;
            } else {
            PG8_LDB(B0, 0, 0); PG8_SCHED; PG8_LDA(At, 0, 0); PG8_STAGE(PG8_SA(1, 1), a1 + hstep, voffA);
            PG8_WAIT_L(8); PG8_BAR; PG8_WAIT_L(0); PG8_MMA(0, 0, At, B0); PG8_BAR; PG8_SCHED;
            PG8_LDB(B1, 0, 1); PG8_STAGE(PG8_SB(0, 0), b2, voffB);
            PG8_BAR; PG8_WAIT_L(0); PG8_MMA(0, 1, At, B1); PG8_BAR;
            PG8_LDA(At, 0, 1); PG8_STAGE(PG8_SA(0, 0), a2, voffA);
            PG8_BAR; PG8_WAIT_L(0); PG8_MMA(1, 0, At, B0); PG8_BAR; PG8_SCHED;
            PG8_STAGE(PG8_SB(0, 1), b2 + hstep, voffB);
            PG8_WAIT_V(6); PG8_BAR; PG8_MMA(1, 1, At, B1); PG8_BAR;
            PG8_LDB(B0, 1, 0); PG8_SCHED; PG8_LDA(At, 1, 0); PG8_STAGE(PG8_SA(0, 1), a2 + hstep, voffA);
            PG8_WAIT_L(8); PG8_BAR; PG8_WAIT_L(0); PG8_MMA(0, 0, At, B0); PG8_BAR; PG8_SCHED;
            PG8_LDB(B1, 1, 1); PG8_STAGE(PG8_SB(1, 0), b3, voffB);
            PG8_BAR; PG8_WAIT_L(0); PG8_MMA(0, 1, At, B1); PG8_BAR;
            PG8_LDA(At, 1, 1); PG8_STAGE(PG8_SA(1, 0), a3, voffA);
            PG8_BAR; PG8_WAIT_L(0); PG8_MMA(1, 0, At, B0); PG8_BAR; PG8_SCHED;
            PG8_STAGE(PG8_SB(1, 1), b3 + hstep, voffB);
            PG8_WAIT_V(6); PG8_BAR; PG8_MMA(1, 1, At, B1); PG8_BAR;
            }
        }
        if constexpr (ALIGN_EPI) { if (wr == 0) PG8_BAR; }
        if constexpr (!Epi::AFTER_DRAIN) { E(acc, cur, wr, wc, fr, fq); S.done(cur); }
        if (!has_next) break;
#pragma unroll
        for (int a = 0; a < 2; ++a)
#pragma unroll
            for (int b = 0; b < 2; ++b)
#pragma unroll
                for (int m = 0; m < 4; ++m)
#pragma unroll
                    for (int n = 0; n < 2; ++n) acc[a][b][m][n] = (f32x4){0.f, 0.f, 0.f, 0.f};
        cur = nxt; cA = nA; cB = nB; ++ui;
        if constexpr (Sched::GATHER) { _Pragma("unroll") for (int h_ = 0; h_ < 2; ++h_) _Pragma("unroll") for (int i_ = 0; i_ < 2; ++i_) gcur[h_][i_] = gnxt[h_][i_]; }
        if constexpr (ALIGN_EPI) { if (wr == 1) PG8_BAR; }
    }
    PG8_WAIT_V(0);
    if constexpr (!ALIGN_EPI) { if (wr == 0) PG8_BAR; }
    PG8_BAR;
    if constexpr (Epi::AFTER_DRAIN) { E.fused(acc, cur, wr, wc, fr, fq, lds, wid, lane); S.done(cur); }
#undef PG8_SA
#undef PG8_SB
#undef PG8_STAGE
#undef PG8_STAGE_A
#undef PG8_GOFF
#undef PG8_LDA
#undef PG8_LDB
#undef PG8_MMA
#undef PG8_WAIT_V
#undef PG8_WAIT_L
#undef PG8_BAR
#undef PG8_SCHED
}
}
#define XB_TMO      128
#define XB_XCNT(j)  (256  + 64 * (j))
#define XB_XSUB(j)  (1280 + 64 * (j))
#define XB_XGEN(j)  (2304 + 64 * (j))
#define XB_TOP      3328
#define XB_TOPGEN   3392
#define XCD_BAR_WORDS 3456
#define XB_SPIN_CAP (1u << 18)

__device__ __forceinline__ unsigned xb_ld(unsigned* p)              { return __hip_atomic_load(p, __ATOMIC_RELAXED, __HIP_MEMORY_SCOPE_AGENT); }
__device__ __forceinline__ unsigned xb_add(unsigned* p, unsigned v) { return __hip_atomic_fetch_add(p, v, __ATOMIC_RELAXED, __HIP_MEMORY_SCOPE_AGENT); }
__device__ __forceinline__ unsigned xb_xcc_id() { return (unsigned)__builtin_amdgcn_s_getreg((3 << 11) | 20) & 0xFu; }
#define XB_SPIN(cond, bar) do { unsigned _sp = 0; while (cond) { __builtin_amdgcn_s_sleep(1); \
    if ((++_sp & 255u) == 0u) { if (xb_ld(&(bar)[XB_TMO])) break; if (_sp > XB_SPIN_CAP) { atomicAdd(&(bar)[XB_TMO], 1u); break; } } } } while (0)

struct XcdBarrier {
    unsigned* bar; unsigned x; int wv;
    volatile LAS unsigned* st;
};

__device__ __forceinline__ XcdBarrier xcd_barrier_post(unsigned* bar, volatile LAS unsigned* st, int wv) {
    XcdBarrier b; b.bar = bar; b.x = xb_xcc_id(); b.st = st; b.wv = wv;
    if (opaque_tid(wv) == 0) (void)xb_add(&bar[XB_XCNT(b.x)], 1u);
    return b;
}
__device__ __forceinline__ void xcd_barrier_complete(unsigned* bar, unsigned x, unsigned& nloc, unsigned& nx) {
    const unsigned G = gridDim.x * gridDim.y * gridDim.z;
    unsigned sum, cnt, mine, sp = 0u;
    for (;;) {
        sum = 0u; cnt = 0u; mine = 0u;
#pragma unroll
        for (unsigned j = 0; j < 16; ++j) { const unsigned c = xb_ld(&bar[XB_XCNT(j)]); sum += c; cnt += (c > 0u) ? 1u : 0u; mine = (j == x) ? c : mine; }
        if (sum == G) break;
        __builtin_amdgcn_s_sleep(1);
        if ((++sp & 255u) == 0u) { if (xb_ld(&bar[XB_TMO])) break; if (sp > XB_SPIN_CAP) { atomicAdd(&bar[XB_TMO], 1u); break; } }
    }
    nloc = mine > 0u ? mine : 1u; nx = cnt > 0u ? cnt : 1u;
}

__device__ __forceinline__ void xcd_barrier(const XcdBarrier& b) {
    asm volatile("s_waitcnt vmcnt(0)" ::: "memory");
    __syncthreads();
    if (opaque_tid(b.wv) == 0) {
        unsigned* bar = b.bar;
        __builtin_amdgcn_s_waitcnt(0);
        unsigned nloc = b.st[0], nx = b.st[1];
        if (nloc == 0u) { xcd_barrier_complete(bar, b.x, nloc, nx); b.st[0] = nloc; b.st[1] = nx; }
        const unsigned old = xb_add(&bar[XB_XSUB(b.x)], 1u);
        const unsigned gen = old / nloc;
        if (old + 1u == (gen + 1u) * nloc) {
            __builtin_amdgcn_fence(__ATOMIC_RELEASE, "agent");
            asm volatile("s_waitcnt vmcnt(0)" ::: "memory");
            const unsigned og = xb_add(&bar[XB_TOP], 1u);
            const unsigned tg = og / nx;
            if (og + 1u == (tg + 1u) * nx) xb_add(&bar[XB_TOPGEN], 1u);
            else XB_SPIN(xb_ld(&bar[XB_TOPGEN]) == tg, bar);
            __builtin_amdgcn_fence(__ATOMIC_ACQUIRE, "agent");
            xb_add(&bar[XB_XGEN(b.x)], 1u);
            asm volatile("s_waitcnt vmcnt(0)" ::: "memory");
        } else {
            XB_SPIN(xb_ld(&bar[XB_XGEN(b.x)]) == gen, bar);
            __builtin_amdgcn_fence(__ATOMIC_ACQUIRE, "agent");
            asm volatile("s_waitcnt vmcnt(0)" ::: "memory");
        }
    }
    __syncthreads();
}

typedef unsigned short bf16_t;
typedef short bf16x8 __attribute__((ext_vector_type(8)));
typedef short bf16x4 __attribute__((ext_vector_type(4)));
typedef float f32x4 __attribute__((ext_vector_type(4)));
typedef float f32x2 __attribute__((ext_vector_type(2)));
typedef float f32x16 __attribute__((ext_vector_type(16)));
typedef unsigned u32x4 __attribute__((ext_vector_type(4)));
typedef unsigned u32x2 __attribute__((ext_vector_type(2)));

constexpr int NB = 8, T = 4096, D = 1024, M = NB * T;
constexpr int INC = 4296;
constexpr int NIN = 19 * 256;
constexpr float EPS = 1e-6f;
constexpr int NPOS = 73728;
constexpr int NWAVES = 8, NTHR = 512;
constexpr int LDS_BYTES = 163840;

constexpr size_t MiB = 1u << 20;
constexpr size_t WS_CTL = 0, CTL_ZERO_BYTES = 65536;
constexpr size_t WS_WIN = 1 * MiB, WS_WOUT = 11 * MiB, WS_WPB = 13 * MiB, WS_WOV = 14 * MiB, WS_WSB = 16 * MiB, WS_WRT = 16 * MiB + 262144, WS_WGU = 17 * MiB, WS_WD = 49 * MiB;
constexpr size_t WS_A = 65 * MiB;
constexpr size_t WS_B = 129 * MiB;
constexpr size_t WS_GA = 193 * MiB, WS_GB = 257 * MiB;
constexpr size_t WS_C = 321 * MiB;
constexpr size_t WS_DQ = 385 * MiB;
constexpr size_t WS_CKVR = 417 * MiB, WS_CKVB = 433 * MiB, WS_KI = 441 * MiB, WS_WI = 445 * MiB, WS_SEL = 446 * MiB;
constexpr size_t WS_MOE = 462 * MiB;
constexpr size_t WS_END = 464 * MiB;

constexpr int CW_BAR = 4096;
constexpr int CW_CNT = 8192, CW_CUR = 8256;

struct P {
    const float *x, *w_in, *kv_g, *w_uk, *w_uv, *rel_bias, *ln_g, *ln_b, *w_sp, *b_sp, *w_pa, *w_pb, *w_out, *n1g, *n2g, *rg_w, *rg_b, *re_w, *re_b, *w_gate, *w_up, *w_down, *fg;
    float* out;
    unsigned* ctl;
    bf16_t *WinT, *WoutT, *WpbT, *WovT, *WSB, *WguT, *WdT;
    float* WrT;
    bf16_t *HB, *QL, *QI, *CKVB, *KI, *UB, *VB, *GAB, *GBB, *OL, *US, *MB, *MG, *H2B, *H2S, *HE, *YS;
    float *CKVR, *WI, *EW, *IDXROW;
    unsigned short* SEL;
    int *EID, *PTOK, *MOEI, *GU, *DN, *BLKCNT, *CB;
};

__device__ __forceinline__ unsigned f2bf(float f) { unsigned u = __builtin_bit_cast(unsigned, f); return (u + 0x7fffu + ((u >> 16) & 1u)) >> 16; }
__device__ __forceinline__ unsigned pk2(float lo, float hi) { return f2bf(lo) | (f2bf(hi) << 16); }
__device__ __forceinline__ float bflo(unsigned w) { return __builtin_bit_cast(float, w << 16); }
__device__ __forceinline__ float bfhi(unsigned w) { return __builtin_bit_cast(float, w & 0xffff0000u); }
__device__ __forceinline__ float bf2f(unsigned short b) { return __builtin_bit_cast(float, (unsigned)b << 16); }
__device__ __forceinline__ float wave_sum(float v) {
#pragma unroll
    for (int o = 1; o < 64; o <<= 1) v += __shfl_xor(v, o);
    return v;
}
#define LDS_WAIT() asm volatile("s_waitcnt lgkmcnt(0)" ::: "memory")
__device__ __forceinline__ float sigm(float x) { return __builtin_amdgcn_rcpf(1.f + __builtin_amdgcn_exp2f(-1.4426950409f * x)); }
__device__ __forceinline__ float gelu_t(float x) { const float x2 = x * x; return x * __builtin_amdgcn_rcpf(1.f + __builtin_amdgcn_exp2f(x * (-2.3022082f - 0.1029432f * x2))); }
__device__ __forceinline__ unsigned off_b(unsigned row, unsigned ch) { return 256u * row + 16u * (ch ^ (((row & 3) << 2) | ((row >> 2) & 3))); }
__device__ __forceinline__ bf16x4 tr_read(unsigned lds_addr) { bf16x4 r; asm volatile("ds_read_b64_tr_b16 %0, %1\n\ts_waitcnt lgkmcnt(0)" : "=&v"(r) : "v"(lds_addr) : "memory"); return r; }
__device__ __forceinline__ bf16x8 cat4(bf16x4 a, bf16x4 b) { bf16x8 r; r[0] = a[0]; r[1] = a[1]; r[2] = a[2]; r[3] = a[3]; r[4] = b[0]; r[5] = b[1]; r[6] = b[2]; r[7] = b[3]; return r; }
__device__ __forceinline__ unsigned lds_addr_of(LAS unsigned char* p) { return (unsigned)(unsigned long long)p; }

__device__ __forceinline__ void st8bf(bf16_t* p, const pg8::f32x4& a, const pg8::f32x4& b) {
    u32x4 w; w.x = pg8::cvt_pk_bf16(a[0], a[1]); w.y = pg8::cvt_pk_bf16(a[2], a[3]); w.z = pg8::cvt_pk_bf16(b[0], b[1]); w.w = pg8::cvt_pk_bf16(b[2], b[3]);
    *(u32x4*)p = w;
}
__device__ __forceinline__ void ld8bf(const bf16_t* p, pg8::f32x4& a, pg8::f32x4& b) {
    const u32x4 w = *(const u32x4*)p;
    a[0] = bflo(w.x); a[1] = bfhi(w.x); a[2] = bflo(w.y); a[3] = bfhi(w.y); b[0] = bflo(w.z); b[1] = bfhi(w.z); b[2] = bflo(w.w); b[3] = bfhi(w.w);
}

struct EpiIn {
    static constexpr bool PERM = true, AFTER_DRAIN = false;
    bf16_t *QL, *QI, *KI, *UB, *VB, *GAB, *GBB; float *CKVR, *WI;
    __device__ __forceinline__ void operator()(const pg8::f32x4 (&acc)[2][2][4][2], const pg8::Unit& u, int wr, int wc, int fr, int fq) const {
        const int row0 = u.pm * 256 + wr * 64 + fr, pn = u.pn, c8 = wc * 32 + 8 * fq;
        int mode; bf16_t* dst; int ld;
        if (pn < 4)       { mode = 0; dst = QL + pn * 256; ld = 1024; }
        else if (pn < 6)  { mode = 0; dst = QI + (pn - 4) * 256; ld = 512; }
        else if (pn == 6) { mode = 3; dst = KI; ld = 64; }
        else if (pn < 9)  { mode = 1; dst = UB + (pn - 7) * 256; ld = 512; }
        else if (pn < 11) { mode = 1; dst = VB + (pn - 9) * 256; ld = 512; }
        else if (pn < 15) { mode = 2; dst = GAB + (pn - 11) * 256; ld = 1024; }
        else              { mode = 2; dst = GBB + (pn - 15) * 256; ld = 1024; }
#pragma unroll
        for (int ai = 0; ai < 2; ++ai)
#pragma unroll
            for (int m = 0; m < 4; ++m) {
                const size_t row = (size_t)(row0 + ai * 128 + m * 16);
#pragma unroll
                for (int bj = 0; bj < 2; ++bj) {
                    pg8::f32x4 v0 = acc[ai][bj][m][0], v1 = acc[ai][bj][m][1];
                    if (mode == 3) {
                        if (bj == 0) { float* c = CKVR + row * 128 + c8; *(pg8::f32x4*)c = v0; *(pg8::f32x4*)(c + 4) = v1; }
                        else if (c8 < 64) st8bf(KI + row * 64 + c8, v0, v1);
                        else if (c8 == 64) { float* c = WI + row * 8; *(pg8::f32x4*)c = v0 * 0.044194174f; *(pg8::f32x4*)(c + 4) = v1 * 0.044194174f; }
                    } else {
                        if (mode == 1) {
#pragma unroll
                            for (int j = 0; j < 4; ++j) { v0[j] = gelu_t(v0[j]); v1[j] = gelu_t(v1[j]); }
                        } else if (mode == 2) {
#pragma unroll
                            for (int j = 0; j < 4; ++j) { v0[j] = sigm(v0[j]); v1[j] = sigm(v1[j]); }
                        }
                        st8bf(dst + row * ld + bj * 128 + c8, v0, v1);
                    }
                }
            }
    }
};

struct EpiMB {
    static constexpr bool PERM = true, AFTER_DRAIN = false;
    const bf16_t* G; bf16_t* O;
    __device__ __forceinline__ void operator()(const pg8::f32x4 (&acc)[2][2][4][2], const pg8::Unit& u, int wr, int wc, int fr, int fq) const {
        const int row0 = u.pm * 256 + wr * 64 + fr, col0 = u.pn * 256 + wc * 32 + 8 * fq;
#pragma unroll
        for (int ai = 0; ai < 2; ++ai)
#pragma unroll
            for (int m = 0; m < 4; ++m)
#pragma unroll
                for (int bj = 0; bj < 2; ++bj) {
                    const size_t o = (size_t)(row0 + ai * 128 + m * 16) * 1024 + col0 + bj * 128;
                    pg8::f32x4 g0, g1; ld8bf(G + o, g0, g1);
                    st8bf(O + o, acc[ai][bj][m][0] * g0, acc[ai][bj][m][1] * g1);
                }
    }
};
struct EpiMG {
    static constexpr bool PERM = true, AFTER_DRAIN = false;
    const bf16_t *G, *MBp; bf16_t* O;
    __device__ __forceinline__ void operator()(const pg8::f32x4 (&acc)[2][2][4][2], const pg8::Unit& u, int wr, int wc, int fr, int fq) const {
        const int row0 = u.pm * 256 + wr * 64 + fr, col0 = u.pn * 256 + wc * 32 + 8 * fq;
#pragma unroll
        for (int ai = 0; ai < 2; ++ai)
#pragma unroll
            for (int m = 0; m < 4; ++m)
#pragma unroll
                for (int bj = 0; bj < 2; ++bj) {
                    const size_t o = (size_t)(row0 + ai * 128 + m * 16) * 1024 + col0 + bj * 128;
                    pg8::f32x4 g0, g1, b0, b1; ld8bf(G + o, g0, g1); ld8bf(MBp + o, b0, b1);
                    st8bf(O + o, acc[ai][bj][m][0] * g0 + b0, acc[ai][bj][m][1] * g1 + b1);
                }
    }
};
struct EpiX1 {
    static constexpr bool PERM = true, AFTER_DRAIN = false;
    const float* X; float* O;
    __device__ __forceinline__ void operator()(const pg8::f32x4 (&acc)[2][2][4][2], const pg8::Unit& u, int wr, int wc, int fr, int fq) const {
        const int row0 = u.pm * 256 + wr * 64 + fr, col0 = u.pn * 256 + wc * 32 + 8 * fq;
#pragma unroll
        for (int ai = 0; ai < 2; ++ai)
#pragma unroll
            for (int m = 0; m < 4; ++m)
#pragma unroll
                for (int bj = 0; bj < 2; ++bj) {
                    const size_t o = (size_t)(row0 + ai * 128 + m * 16) * 1024 + col0 + bj * 128;
                    const pg8::f32x4 x0 = *(const pg8::f32x4*)(X + o), x1 = *(const pg8::f32x4*)(X + o + 4);
                    *(pg8::f32x4*)(O + o) = x0 + acc[ai][bj][m][0]; *(pg8::f32x4*)(O + o + 4) = x1 + acc[ai][bj][m][1];
                }
    }
};
struct EpiHE {
    static constexpr bool PERM = true, AFTER_DRAIN = false;
    bf16_t* HE;
    __device__ __forceinline__ void operator()(const pg8::f32x4 (&acc)[2][2][4][2], const pg8::Unit& u, int wr, int wc, int fr, int fq) const {
        const int row0 = u.pm * 256 + wr * 64 + fr, col0 = (u.pn & 1) * 128 + wc * 32 + 8 * fq;
#pragma unroll
        for (int ai = 0; ai < 2; ++ai)
#pragma unroll
            for (int m = 0; m < 4; ++m) {
                pg8::f32x4 h0, h1;
#pragma unroll
                for (int j = 0; j < 4; ++j) {
                    const float g0 = acc[ai][0][m][0][j], g1 = acc[ai][0][m][1][j];
                    h0[j] = g0 * sigm(g0) * acc[ai][1][m][0][j]; h1[j] = g1 * sigm(g1) * acc[ai][1][m][1][j];
                }
                st8bf(HE + (size_t)(row0 + ai * 128 + m * 16) * 256 + col0, h0, h1);
            }
    }
};
struct EpiDown {
    static constexpr bool PERM = true, AFTER_DRAIN = false;
    const int* PTOK; const float* EW; bf16_t* YS;
    __device__ __forceinline__ void operator()(const pg8::f32x4 (&acc)[2][2][4][2], const pg8::Unit& u, int wr, int wc, int fr, int fq) const {
        const int row0 = u.pm * 256 + wr * 64 + fr, col0 = (u.pn & 3) * 256 + wc * 32 + 8 * fq;
#pragma unroll
        for (int ai = 0; ai < 2; ++ai)
#pragma unroll
            for (int m = 0; m < 4; ++m) {
                const int ts = PTOK[row0 + ai * 128 + m * 16];
                if (ts >= 0) {
                    const float w = EW[ts];
                    bf16_t* d = YS + ((size_t)(ts & 1) * M + (size_t)(ts >> 1)) * 1024 + col0;
#pragma unroll
                    for (int bj = 0; bj < 2; ++bj) st8bf(d + bj * 128, acc[ai][bj][m][0] * w, acc[ai][bj][m][1] * w);
                }
            }
    }
};
struct TableOrder {
    static constexpr bool GATHER = false;
    const int* tab; const int* nunits; int G, c;
    __device__ __forceinline__ int arow(int r) const { return r; }
    __device__ __forceinline__ bool next(int i, pg8::Unit& u) const {
        const int idx = i * G + c; const int n = __builtin_nontemporal_load(nunits);
        if (idx >= n) return false;
        u.pm = tab[2 * idx]; u.pn = tab[2 * idx + 1]; return true;
    }
    __device__ __forceinline__ void a_ready(const pg8::Unit&) const {}
    __device__ __forceinline__ void done(const pg8::Unit&) const {}
};

struct TableGatherOrder {
    static constexpr bool GATHER = true;
    const int* tab; const int* nunits; const int* ptok; int G, c;
    __device__ __forceinline__ bool next(int i, pg8::Unit& u) const {
        const int idx = i * G + c; const int n = __builtin_nontemporal_load(nunits);
        if (idx >= n) return false;
        u.pm = tab[2 * idx]; u.pn = tab[2 * idx + 1]; return true;
    }
    __device__ __forceinline__ int arow(int r) const { const int ts = ptok[r]; return ts < 0 ? 0 : (ts >> 1); }
    __device__ __forceinline__ void a_ready(const pg8::Unit&) const {}
    __device__ __forceinline__ void done(const pg8::Unit&) const {}
};

__device__ __forceinline__ void tr_item(const float* src, int ld, int K, int NC, bf16_t* dst, LAS float* scr, int item, int lane) {
    const int nblk = NC / 32, kb = item / nblk, nb = item % nblk, k0 = 64 * kb, n0 = 32 * nb;
    f32x4 tv[8];
    const int tr = lane >> 3, tc = (lane & 7) * 4;
    if ((((size_t)src) & 15) == 0 && (ld & 3) == 0) {
#pragma unroll
        for (int i = 0; i < 8; ++i) tv[i] = *(const f32x4*)(src + (size_t)(k0 + 8 * i + tr) * ld + n0 + tc);
    } else {
#pragma unroll
        for (int i = 0; i < 8; ++i) { const float* q = src + (size_t)(k0 + 8 * i + tr) * ld + n0 + tc; tv[i] = (f32x4){q[0], q[1], q[2], q[3]}; }
    }
#pragma unroll
    for (int i = 0; i < 8; ++i) { LAS float* d = scr + (8 * i + tr) * 33 + tc; d[0] = tv[i].x; d[1] = tv[i].y; d[2] = tv[i].z; d[3] = tv[i].w; }
    LDS_WAIT();
    const int c = lane & 7;
#pragma unroll
    for (int j = 0; j < 4; ++j) { const int n = (lane >> 3) + 8 * j; const LAS float* s = scr + (8 * c) * 33 + n;
        u32x4 o; o.x = pk2(s[0 * 33], s[1 * 33]); o.y = pk2(s[2 * 33], s[3 * 33]); o.z = pk2(s[4 * 33], s[5 * 33]); o.w = pk2(s[6 * 33], s[7 * 33]);
        *(u32x4*)(dst + (size_t)(n0 + n) * K + k0 + 8 * c) = o; }
    LDS_WAIT();
}

__device__ __forceinline__ void prep_gateup(const P& p, LAS unsigned char* lds, int w_idx, int nw, int wave, int lane) {
    LAS float* scr = (LAS float*)(lds + wave * 16384);
    for (int it = w_idx; it < 8192; it += nw) {
        const int sub = it & 63, q = it >> 6, gu = q & 1, j = (q >> 1) & 1, e = q >> 2;
        const float* src = (gu ? p.w_up : p.w_gate) + (size_t)e * 262144 + 128 * j;
        tr_item(src, 256, 1024, 128, p.WguT + ((size_t)e * 512 + j * 256 + gu * 128) * 1024, scr, sub, lane);
    }
}

__device__ __forceinline__ void ph_prep(const P& p, LAS unsigned char* lds, const int wv) {
    const int tid = opaque_tid(wv), lane = tid & 63, wave = __builtin_amdgcn_readfirstlane(tid >> 6);
    LAS float* scr = (LAS float*)(lds + wave * 16384);
    const int gw = blockIdx.x * NWAVES + wave, NGW = gridDim.x * NWAVES;
    const int gt = blockIdx.x * NTHR + tid, NGT = gridDim.x * NTHR;
    {
        const int c0s[7] = {640, 512, 1152, 1224, 1736, 2248, 3272};
        const int ncs[7] = {512, 128, 64, 512, 512, 1024, 1024};
        const int r0s[7] = {1024, 1536, 1664, 1792, 2304, 2816, 3840};
#pragma unroll
        for (int s = 0; s < 7; ++s) {
            const int nit = 16 * (ncs[s] / 32);
            for (int it = gw; it < nit; it += NGW) tr_item(p.w_in + c0s[s], INC, 1024, ncs[s], p.WinT + (size_t)r0s[s] * 1024, scr, it, lane);
        }
    }
    for (int i = gt; i < 64 * 1024; i += NGT) { const int j = i >> 10, k = i & 1023; p.WinT[(size_t)(1728 + j) * 1024 + k] = j < 8 ? (bf16_t)f2bf(p.w_in[(size_t)k * INC + 1216 + j]) : (bf16_t)0; }
    for (int it = gw; it < 512; it += NGW) tr_item(p.w_out, 1024, 1024, 1024, p.WoutT, scr, it, lane);
    for (int it = gw; it < 256; it += NGW) tr_item(p.w_pb, 1024, 512, 1024, p.WpbT, scr, it, lane);
    for (int it = gw; it < 4096; it += NGW) { const int sub = it & 127, e = it >> 7; tr_item(p.w_down + (size_t)e * 262144, 1024, 256, 1024, p.WdT + (size_t)e * 262144, scr, sub, lane); }
    for (int it = gw; it < 1024; it += NGW) {
        const int h = it >> 7, kt = (it >> 2) & 31, rt = it & 3, i = lane & 31, hf = lane >> 5;
        const f32x4* ap = (const f32x4*)(p.w_in + (size_t)(kt * 32 + i) * INC + h * 64 + 32 * hf);
        const f32x4* bp = (const f32x4*)(p.w_uk + (size_t)((rt * 32 + i) * 8 + h) * 64 + 32 * hf);
        f32x4 av[8], bv[8];
#pragma unroll
        for (int j = 0; j < 8; ++j) { av[j] = ap[j]; bv[j] = bp[j]; }
        f32x16 acc;
#pragma unroll
        for (int j = 0; j < 16; ++j) acc[j] = 0.f;
#pragma unroll
        for (int j = 0; j < 8; ++j)
#pragma unroll
            for (int e = 0; e < 4; ++e) acc = __builtin_amdgcn_mfma_f32_32x32x2f32(av[j][e], bv[j][e], acc, 0, 0, 0);
#pragma unroll
        for (int g4 = 0; g4 < 4; ++g4) {
            u32x2 w; w.x = pk2(0.125f * acc[4 * g4], 0.125f * acc[4 * g4 + 1]); w.y = pk2(0.125f * acc[4 * g4 + 2], 0.125f * acc[4 * g4 + 3]);
            *(u32x2*)(p.WinT + (size_t)(h * 128 + rt * 32 + i) * 1024 + kt * 32 + 8 * g4 + 4 * hf) = w;
        }
    }
    for (int it = gw; it < 1024; it += NGW) {
        const int h = it >> 7, nt = (it >> 2) & 31, rt = it & 3, i = lane & 31, hf = lane >> 5;
        const f32x4* ap = (const f32x4*)(p.w_uv + (size_t)((rt * 32 + i) * 8 + h) * 64 + 32 * hf);
        const float* bp = p.w_pa + (size_t)(h * 64 + 32 * hf) * 1024 + nt * 32 + i;
        f32x4 av[8]; float bv[32];
#pragma unroll
        for (int j = 0; j < 8; ++j) av[j] = ap[j];
#pragma unroll
        for (int j = 0; j < 32; ++j) bv[j] = bp[(size_t)j * 1024];
        f32x16 acc;
#pragma unroll
        for (int j = 0; j < 16; ++j) acc[j] = 0.f;
#pragma unroll
        for (int j = 0; j < 8; ++j)
#pragma unroll
            for (int e = 0; e < 4; ++e) acc = __builtin_amdgcn_mfma_f32_32x32x2f32(av[j][e], bv[4 * j + e], acc, 0, 0, 0);
#pragma unroll
        for (int g4 = 0; g4 < 4; ++g4) {
            u32x2 w; w.x = pk2(acc[4 * g4], acc[4 * g4 + 1]); w.y = pk2(acc[4 * g4 + 2], acc[4 * g4 + 3]);
            *(u32x2*)(p.WovT + (size_t)(nt * 32 + i) * 1024 + h * 128 + rt * 32 + 8 * g4 + 4 * hf) = w;
        }
    }
    for (int i = gt; i < 4 * 128 * 128; i += NGT) { const int jj = i & 127, ii = (i >> 7) & 127; p.WSB[i] = jj <= ii ? (bf16_t)f2bf(p.w_sp[i]) : (bf16_t)0; }
    for (int i = gt; i < 36 * 1024; i += NGT) { const int c = i >> 10, k = i & 1023; p.WrT[i] = c < 4 ? p.rg_w[k * 4 + c] : p.re_w[k * 32 + (c - 4)]; }
    for (int m4 = gw; m4 < M / 4; m4 += NGW) {
        f32x4 v[4][4]; float ss[4];
#pragma unroll
        for (int r = 0; r < 4; ++r) { const f32x4* xr = (const f32x4*)(p.x + (size_t)(4 * m4 + r) * D) + lane;
#pragma unroll
            for (int j = 0; j < 4; ++j) v[r][j] = xr[64 * j]; }
#pragma unroll
        for (int r = 0; r < 4; ++r) { ss[r] = 0.f;
#pragma unroll
            for (int j = 0; j < 4; ++j) ss[r] += (v[r][j].x * v[r][j].x + v[r][j].y * v[r][j].y) + (v[r][j].z * v[r][j].z + v[r][j].w * v[r][j].w); }
#pragma unroll
        for (int o = 1; o < 64; o <<= 1) {
#pragma unroll
            for (int r = 0; r < 4; ++r) ss[r] += __shfl_xor(ss[r], o);
        }
#pragma unroll
        for (int r = 0; r < 4; ++r) {
            const float rinv = 1.0f / sqrtf(ss[r] * (1.f / D) + EPS);
            unsigned long long* o8 = (unsigned long long*)(p.HB + (size_t)(4 * m4 + r) * D) + lane;
#pragma unroll
            for (int j = 0; j < 4; ++j) { const f32x4 g = ((const f32x4*)p.n1g)[lane + 64 * j]; const f32x4 o = v[r][j] * rinv * g;
                o8[64 * j] = (unsigned long long)pk2(o.x, o.y) | ((unsigned long long)pk2(o.z, o.w) << 32); }
        }
    }
}

__device__ __forceinline__ void ph_ckvnorm(const P& p, const int wv) {
    const int tid = opaque_tid(wv), lane = tid & 63, wave = tid >> 6;
    const int gw = blockIdx.x * NWAVES + wave, NGW = gridDim.x * NWAVES;
    const float g0 = p.kv_g[2 * lane], g1 = p.kv_g[2 * lane + 1];
    for (int m4 = gw; m4 < M / 4; m4 += NGW) {
        float2 v[4]; float ss[4];
#pragma unroll
        for (int r = 0; r < 4; ++r) v[r] = ((const float2*)(p.CKVR + (size_t)(4 * m4 + r) * 128))[lane];
#pragma unroll
        for (int r = 0; r < 4; ++r) ss[r] = v[r].x * v[r].x + v[r].y * v[r].y;
#pragma unroll
        for (int o = 1; o < 64; o <<= 1) {
#pragma unroll
            for (int r = 0; r < 4; ++r) ss[r] += __shfl_xor(ss[r], o);
        }
#pragma unroll
        for (int r = 0; r < 4; ++r) { const float rinv = 1.0f / sqrtf(ss[r] * (1.f / 128.f) + EPS);
            ((unsigned*)(p.CKVB + (size_t)(4 * m4 + r) * 128))[lane] = pk2(v[r].x * rinv * g0, v[r].y * rinv * g1); }
    }
}

__device__ __forceinline__ unsigned qbin(float x) { return (unsigned)(int)__builtin_fminf(__builtin_fmaxf((x + 8.0f) * 64.0f, 0.0f), 1023.0f); }
__device__ __forceinline__ unsigned fkey(float x) { x = x + 0.0f; const unsigned u = __builtin_bit_cast(unsigned, x); return (u & 0x80000000u) ? ~u : (u | 0x80000000u); }

__device__ __forceinline__ void select_row(const LAS float* row, int n, LAS unsigned* hist, unsigned short* out, int lane) {
    if (n <= 256) {
#pragma unroll
        for (int i = 0; i < 4; ++i) { const int k = lane + 64 * i; out[k] = (unsigned short)(k < n ? k : 0); }
        return;
    }
    unsigned prefix = 0; int need = 256;
    const unsigned long long lt = (1ull << lane) - 1ull;
#pragma unroll 1
    for (int pass = 3; pass >= 0; --pass) {
#pragma unroll
        for (int i = 0; i < 4; ++i) hist[lane + 64 * i] = 0u;
        LDS_WAIT();
        const int shift = pass * 8;
        for (int i = lane; i < n; i += 64) {
            const unsigned k = fkey(row[i]);
            const bool match = (pass == 3) || ((k >> (shift + 8)) == prefix);
            if (match) __hip_atomic_fetch_add(hist + ((k >> shift) & 255u), 1u, __ATOMIC_RELAXED, __HIP_MEMORY_SCOPE_WORKGROUP);
        }
        LDS_WAIT();
        const unsigned c0 = hist[4 * lane], c1 = hist[4 * lane + 1], c2 = hist[4 * lane + 2], c3 = hist[4 * lane + 3];
        const unsigned s = c0 + c1 + c2 + c3;
        unsigned incl = s;
#pragma unroll
        for (int o = 1; o < 64; o <<= 1) { const unsigned t = __shfl_down(incl, o); if (lane + o < 64) incl += t; }
        const unsigned excl = incl - s;
        const bool mine = (excl < (unsigned)need) && (incl >= (unsigned)need);
        unsigned bin = 0, above = 0;
        if (mine) {
            unsigned run = excl;
            if (run + c3 >= (unsigned)need) { bin = 4 * lane + 3; above = run; }
            else { run += c3;
                if (run + c2 >= (unsigned)need) { bin = 4 * lane + 2; above = run; }
                else { run += c2;
                    if (run + c1 >= (unsigned)need) { bin = 4 * lane + 1; above = run; }
                    else { run += c1; bin = 4 * lane; above = run; } } }
        }
        const unsigned long long bm = __ballot(mine);
        const int src = bm ? (int)__builtin_ctzll(bm) : 0;
        bin = __shfl(bin, src); above = __shfl(above, src);
        need -= (int)above; prefix = (prefix << 8) | bin;
        LDS_WAIT();
    }
    const unsigned Tk = prefix;
    int cnt = 0, eq_taken = 0;
    for (int i0 = 0; i0 < n; i0 += 64) {
        const int i = i0 + lane; const bool valid = i < n;
        const unsigned k = valid ? fkey(row[i]) : 0u;
        const bool gtk = valid && (k > Tk), eqk = valid && (k == Tk);
        const unsigned long long beq = __ballot(eqk);
        const int eq_rank = eq_taken + __builtin_popcountll(beq & lt);
        const bool take = gtk || (eqk && eq_rank < need);
        const unsigned long long bt = __ballot(take);
        const int pos = cnt + __builtin_popcountll(bt & lt);
        if (take && pos < 256) out[pos] = (unsigned short)i;
        cnt += __builtin_popcountll(bt); eq_taken += __builtin_popcountll(beq);
    }
}

__device__ __forceinline__ void select_row4(const LAS float* row, int n, LAS unsigned* hist, LAS unsigned* h2, unsigned short* out, int lane) {
    if (n <= 256) {
#pragma unroll
        for (int i = 0; i < 4; ++i) { const int k = lane + 64 * i; out[k] = (unsigned short)(k < n ? k : 0); }
#pragma unroll
        for (int i = 0; i < 8; ++i) hist[lane + 64 * i] = 0u;
        return;
    }
    const unsigned long long lt = (1ull << lane) - 1ull;
    unsigned b1, above;
    {
        const u32x4 w0 = *(const LAS u32x4*)(hist + 8 * lane), w1 = *(const LAS u32x4*)(hist + 8 * lane + 4);
        unsigned c[16];
        c[0] = w0.x & 0xffffu; c[1] = w0.x >> 16; c[2] = w0.y & 0xffffu; c[3] = w0.y >> 16; c[4] = w0.z & 0xffffu; c[5] = w0.z >> 16; c[6] = w0.w & 0xffffu; c[7] = w0.w >> 16;
        c[8] = w1.x & 0xffffu; c[9] = w1.x >> 16; c[10] = w1.y & 0xffffu; c[11] = w1.y >> 16; c[12] = w1.z & 0xffffu; c[13] = w1.z >> 16; c[14] = w1.w & 0xffffu; c[15] = w1.w >> 16;
        unsigned s = 0;
#pragma unroll
        for (int j = 0; j < 16; ++j) s += c[j];
        unsigned incl = s;
#pragma unroll
        for (int o = 1; o < 64; o <<= 1) { const unsigned t = __shfl_down(incl, o); if (lane + o < 64) incl += t; }
        const unsigned excl = incl - s;
        const bool mine = (excl < 256u) && (incl >= 256u);
        unsigned bin = 0, ab = 0, run = excl; bool found = false;
#pragma unroll
        for (int j = 15; j >= 0; --j) { if (!found && run + c[j] >= 256u) { bin = 16 * lane + j; ab = run; found = true; } if (!found) run += c[j]; }
        const unsigned long long bm = __ballot(mine);
        const int src = bm ? (int)__builtin_ctzll(bm) : 0;
        b1 = __shfl(bin, src); above = __shfl(ab, src);
    }
    LDS_WAIT();
    int need = 256 - (int)above;
    LAS unsigned short* cand = (LAS unsigned short*)hist;
    const int nblk = (n + 255) >> 8;
    int C = 0;
    for (int blk = 0; blk < nblk; ++blk) {
        const f32x4 v = *(const LAS f32x4*)(row + blk * 256 + 4 * lane);
        bool ge[4]; unsigned long long bl[4];
#pragma unroll
        for (int e = 0; e < 4; ++e) { ge[e] = (blk * 256 + 4 * lane + e < n) && (qbin(v[e]) >= b1); bl[e] = __ballot(ge[e]); }
        const int below = __builtin_popcountll(bl[0] & lt) + __builtin_popcountll(bl[1] & lt) + __builtin_popcountll(bl[2] & lt) + __builtin_popcountll(bl[3] & lt);
        int pos = C + below;
#pragma unroll
        for (int e = 0; e < 4; ++e) { if (ge[e]) { if (pos < 768) cand[pos] = (unsigned short)(blk * 256 + 4 * lane + e); ++pos; } }
        C += __builtin_popcountll(bl[0]) + __builtin_popcountll(bl[1]) + __builtin_popcountll(bl[2]) + __builtin_popcountll(bl[3]);
    }
    LDS_WAIT();
    if (C > 512) {
        select_row(row, n, h2, out, lane);
#pragma unroll
        for (int i = 0; i < 8; ++i) hist[lane + 64 * i] = 0u;
        return;
    }
    int ci[8]; unsigned ck[8]; bool cgt[8], ceq[8];
#pragma unroll
    for (int k = 0; k < 8; ++k) { const int j = lane + 64 * k; ci[k] = j < C ? (int)cand[j] : -1; }
#pragma unroll
    for (int k = 0; k < 8; ++k) { const float v = row[ci[k] < 0 ? 0 : ci[k]]; const unsigned bb = qbin(v); ck[k] = fkey(v); cgt[k] = ci[k] >= 0 && bb > b1; ceq[k] = ci[k] >= 0 && bb == b1; }
    unsigned prefix = 0;
#pragma unroll 1
    for (int pass = 3; pass >= 0; --pass) {
#pragma unroll
        for (int i = 0; i < 4; ++i) h2[lane + 64 * i] = 0u;
        LDS_WAIT();
        const int shift = pass * 8;
#pragma unroll
        for (int k = 0; k < 8; ++k) {
            const bool match = ceq[k] && ((pass == 3) || ((ck[k] >> (shift + 8)) == prefix));
            if (match) __hip_atomic_fetch_add(h2 + ((ck[k] >> shift) & 255u), 1u, __ATOMIC_RELAXED, __HIP_MEMORY_SCOPE_WORKGROUP);
        }
        LDS_WAIT();
        const unsigned c0 = h2[4 * lane], c1 = h2[4 * lane + 1], c2 = h2[4 * lane + 2], c3 = h2[4 * lane + 3];
        const unsigned s = c0 + c1 + c2 + c3;
        unsigned incl = s;
#pragma unroll
        for (int o = 1; o < 64; o <<= 1) { const unsigned t = __shfl_down(incl, o); if (lane + o < 64) incl += t; }
        const unsigned excl = incl - s;
        const bool mine = (excl < (unsigned)need) && (incl >= (unsigned)need);
        unsigned bin = 0, ab = 0;
        if (mine) {
            unsigned run = excl;
            if (run + c3 >= (unsigned)need) { bin = 4 * lane + 3; ab = run; }
            else { run += c3;
                if (run + c2 >= (unsigned)need) { bin = 4 * lane + 2; ab = run; }
                else { run += c2;
                    if (run + c1 >= (unsigned)need) { bin = 4 * lane + 1; ab = run; }
                    else { run += c1; bin = 4 * lane; ab = run; } } }
        }
        const unsigned long long bm = __ballot(mine);
        const int src = bm ? (int)__builtin_ctzll(bm) : 0;
        bin = __shfl(bin, src); ab = __shfl(ab, src);
        need -= (int)ab; prefix = (prefix << 8) | bin;
        LDS_WAIT();
    }
    const unsigned Tk = prefix;
    bool tk[8]; int ne = 0;
#pragma unroll
    for (int k = 0; k < 8; ++k) { tk[k] = ceq[k] && ck[k] == Tk; ne += __builtin_popcountll(__ballot(tk[k])); }
    if (ne > need) {
        bool keep[8];
#pragma unroll
        for (int k = 0; k < 8; ++k) keep[k] = false;
        for (int r = 0; r < need; ++r) {
            int mn = 0x7fffffff;
#pragma unroll
            for (int k = 0; k < 8; ++k) if (tk[k] && !keep[k] && ci[k] < mn) mn = ci[k];
#pragma unroll
            for (int o = 1; o < 64; o <<= 1) { const int t = __shfl_xor(mn, o); mn = t < mn ? t : mn; }
#pragma unroll
            for (int k = 0; k < 8; ++k) if (tk[k] && ci[k] == mn) keep[k] = true;
        }
#pragma unroll
        for (int k = 0; k < 8; ++k) tk[k] = keep[k];
    }
    LAS unsigned short* outL = cand + 768;
    int cnt = 0;
#pragma unroll
    for (int k = 0; k < 8; ++k) {
        const bool take = cgt[k] || (ceq[k] && ck[k] > Tk) || tk[k];
        const unsigned long long bt = __ballot(take);
        const int pos = cnt + __builtin_popcountll(bt & lt);
        if (take && pos < 256) outL[pos] = (unsigned short)ci[k];
        cnt += __builtin_popcountll(bt);
    }
    LDS_WAIT();
    *(u32x2*)(out + 4 * lane) = *(const LAS u32x2*)(outL + 4 * lane);
    LDS_WAIT();
#pragma unroll
    for (int i = 0; i < 8; ++i) hist[lane + 64 * i] = 0u;
}

__device__ __forceinline__ void ph_index(const P& p, LAS unsigned char* lds, const int wv) {
    LAS float* Irow = (LAS float*)lds;
    LAS unsigned* hist = (LAS unsigned*)(lds + 131072);
    LAS unsigned* h2 = (LAS unsigned*)(lds + 131072 + 16384);
    const int tid = opaque_tid(wv), lane = tid & 63, wave = __builtin_amdgcn_readfirstlane(tid >> 6);
    const int hh = lane >> 5, n = lane & 31;
    const int rho = lane & 31, qlA = 2 * ((rho >> 2) & 1) + (rho >> 4), hdA = (rho & 3) + 4 * ((rho >> 3) & 1);
#pragma unroll
    for (int i = 0; i < 8; ++i) hist[tid + NTHR * i] = 0u;
    bf16x8 A[2][4]; float wq[2][16]; bf16x8 B0[4], B1[4], B2[4];
#define IDX_LOAD_B(dst, kt_) do { const bf16_t* kp_ = p.KI + (mb + (size_t)(kt_) * 32 + n) * 64 + 8 * hh; \
        _Pragma("unroll") for (int s = 0; s < 4; ++s) dst[s] = *(const bf16x8*)(kp_ + 16 * s); } while (0)
#define IDX_LOAD_UNIT(u_) do { const int b_ = (u_) & 7, t0_ = (511 - ((u_) >> 3)) * 8; const size_t mb = (size_t)b_ * T; const int nkt_ = (t0_ + 8 + 31) >> 5; \
        _Pragma("unroll") for (int mt = 0; mt < 2; ++mt) { const bf16_t* src = p.QI + (mb + t0_ + mt * 4 + qlA) * 512 + hdA * 64 + 8 * hh; \
            _Pragma("unroll") for (int s = 0; s < 4; ++s) A[mt][s] = *(const bf16x8*)(src + 16 * s); \
            _Pragma("unroll") for (int c = 0; c < 2; ++c) { const float* wp = p.WI + (mb + t0_ + mt * 4 + 2 * hh + c) * 8; const f32x4 w0 = *(const f32x4*)wp, w1 = *(const f32x4*)(wp + 4); \
                _Pragma("unroll") for (int j = 0; j < 4; ++j) { wq[mt][c * 8 + j] = w0[j]; wq[mt][c * 8 + 4 + j] = w1[j]; } } } \
        if (wave < nkt_) IDX_LOAD_B(B0, wave); if (wave + NWAVES < nkt_) IDX_LOAD_B(B1, wave + NWAVES); if (wave + 2 * NWAVES < nkt_) IDX_LOAD_B(B2, wave + 2 * NWAVES); } while (0)
    if ((int)blockIdx.x < 4096) IDX_LOAD_UNIT((int)blockIdx.x);
    __syncthreads();
    for (int u = blockIdx.x; u < 4096; u += gridDim.x) {
        const int b = u & 7, tb = 511 - (u >> 3), t0 = tb * 8; const size_t mb = (size_t)b * T;
        const int nkt = (t0 + 8 + 31) >> 5;
#if defined(IDX_DUP_SCORE)
#pragma unroll 1
        for (int rep = 0; rep < 2; ++rep) {
        if (rep == 1) { if (wave < nkt) IDX_LOAD_B(B0, wave); if (wave + NWAVES < nkt) IDX_LOAD_B(B1, wave + NWAVES); if (wave + 2 * NWAVES < nkt) IDX_LOAD_B(B2, wave + 2 * NWAVES); }
#else
        { const int rep = 1;
#endif
#pragma unroll 1
        for (int kt = wave; kt < nkt; kt += NWAVES) {
            const int key = kt * 32 + n;
#pragma unroll
            for (int mt = 0; mt < 2; ++mt) {
                f32x16 acc;
#pragma unroll
                for (int j = 0; j < 16; ++j) acc[j] = 0.f;
#pragma unroll
                for (int s = 0; s < 4; ++s) acc = __builtin_amdgcn_mfma_f32_32x32x16_bf16(A[mt][s], B0[s], acc, 0, 0, 0);
#pragma unroll
                for (int c = 0; c < 2; ++c) {
                    float v = 0.f;
#pragma unroll
                    for (int h = 0; h < 8; ++h) v += wq[mt][c * 8 + h] * fmaxf(acc[c * 8 + h], 0.f);
                    const int r = mt * 4 + 2 * hh + c;
                    Irow[r * 4096 + key] = v;
                    if (key <= t0 + r) { const unsigned bin = qbin(v); __hip_atomic_fetch_add(hist + r * 512 + (bin >> 1), (unsigned)rep << ((bin & 1u) * 16u), __ATOMIC_RELAXED, __HIP_MEMORY_SCOPE_WORKGROUP); }
                }
            }
#pragma unroll
            for (int s = 0; s < 4; ++s) { B0[s] = B1[s]; B1[s] = B2[s]; }
            if (kt + 3 * NWAVES < nkt) IDX_LOAD_B(B2, kt + 3 * NWAVES);
        }
        }
        if (u + (int)gridDim.x < 4096) IDX_LOAD_UNIT(u + (int)gridDim.x);
        __syncthreads();
        select_row4(Irow + wave * 4096, t0 + wave + 1, hist + wave * 512, h2 + wave * 320, p.SEL + (mb + t0 + wave) * 256, lane);
        __syncthreads();
    }
#undef IDX_LOAD_B
#undef IDX_LOAD_UNIT
}

__device__ __forceinline__ bf16x4 tr16(const LAS unsigned char* a) { return __builtin_amdgcn_ds_read_tr16_b64_v4i16((LAS bf16x4*)a); }
__device__ __forceinline__ void ph_attn(const P& p, LAS unsigned char* lds, const int wv) {
    const int tid = opaque_tid(wv), lane = tid & 63, wave = __builtin_amdgcn_readfirstlane(tid >> 6);
    LAS unsigned char* buf = lds + wave * 8192;
    LAS unsigned char* selL = lds + 65536 + wave * 1024;
    LAS unsigned char* tblb = lds + 73728;
    LAS float* bias = (LAS float*)(lds + 73728 + 128);
    LAS float* cst = (LAS float*)(lds + 73728 + 128 + 4096);
    for (int i = tid; i < 1024; i += NTHR) {
        const int d = i >> 3; int bk = d;
        if (d >= 16) { const float nf = (float)d; bk = 16 + (int)(logf(nf / 16.f) / 2.0794415f * 16.f); if (bk > 31) bk = 31; }
        bias[i] = p.rel_bias[bk * 8 + (i & 7)];
    }
    if (wave == 0) {
        float gm = fmaxf(fabsf(p.kv_g[lane]), fabsf(p.kv_g[lane + 64]));
        float bm = fmaxf(fmaxf(fabsf(p.rel_bias[lane]), fabsf(p.rel_bias[lane + 64])), fmaxf(fabsf(p.rel_bias[lane + 128]), fabsf(p.rel_bias[lane + 192])));
#pragma unroll
        for (int o = 1; o < 64; o <<= 1) { gm = fmaxf(gm, __shfl_xor(gm, o)); bm = fmaxf(bm, __shfl_xor(bm, o)); }
        if (lane == 0) { cst[0] = 11.3137085f * gm * 1.01f; cst[1] = bm; }
    }
    __syncthreads();
    const int g = lane >> 4, hcol = lane & 15, q4 = hcol >> 2, p4 = lane & 3;
    const float cmax = cst[0], bmax = cst[1];
    const int G = gridDim.x, bx = blockIdx.x, vcu = (G % 8 == 0) ? (bx % 8) * (G / 8) + bx / 8 : bx;
#define ATT_QF_LOAD(dst, mm) do { _Pragma("unroll") for (int s = 0; s < 4; ++s) { bf16x8 z; _Pragma("unroll") for (int j = 0; j < 8; ++j) z[j] = 0; \
        dst[s] = hcol < 8 ? *(const bf16x8*)(p.QL + (size_t)(mm) * 1024 + hcol * 128 + 32 * s + 8 * g) : z; } } while (0)
#define ATT_LOAD_CHUNK(ST_, selp_, c_, nv_) do { _Pragma("unroll") for (int i = 0; i < 8; ++i) { const int kp = 32 * (c_) + 4 * i + g; \
        const int key = (int)*(const LAS unsigned short*)((selp_) + 2 * kp); \
        ST_[i >> 2][i & 3] = *(const bf16x8*)(p.CKVB + (mb + key) * 128 + 8 * hcol); } } while (0)
    for (int qc = vcu; qc < M / 128; qc += G) {
        const int m0 = qc * 128 + wave * 16;
        const size_t mb = (size_t)(m0 >> 12) * T;
        u32x2 sv = *(const u32x2*)(p.SEL + (size_t)m0 * 256 + 4 * lane);
        bf16x8 qf[4], qfn[4], sA[2][4], sB[2][4], sC[2][4];
        ATT_QF_LOAD(qfn, m0);
        *(LAS u32x2*)(selL + lane * 8) = sv;
        LDS_WAIT();
        { const int t0 = m0 & (T - 1); const int nv0 = t0 + 1 < 256 ? t0 + 1 : 256; ATT_LOAD_CHUNK(sA, selL, 0, nv0); ATT_LOAD_CHUNK(sB, selL, 1, nv0); }
        sv = *(const u32x2*)(p.SEL + (size_t)(m0 + 1) * 256 + 4 * lane);
        f32x4 o[8]; float lsum = 0.f, mh = 0.f;
#pragma unroll
        for (int rt = 0; rt < 8; ++rt) o[rt] = (f32x4){0.f, 0.f, 0.f, 0.f};
#define ATT_BODY(gc_, SCUR, SPRE) do { const int gc = (gc_); if (gc < 128) { \
            const int qi = gc >> 3, c = gc & 7, m = m0 + qi; \
            const int t = m & (T - 1); const int nvalid = t + 1 < 256 ? t + 1 : 256; \
            const LAS unsigned char* selc = selL + (qi & 1) * 512; \
            if (c == 0) { \
                _Pragma("unroll") for (int s = 0; s < 4; ++s) qf[s] = qfn[s]; \
                float ss = 0.f; \
                _Pragma("unroll") for (int s = 0; s < 4; ++s) _Pragma("unroll") for (int j = 0; j < 8; ++j) { const float v = bf2f((unsigned short)qf[s][j]); ss += v * v; } \
                ss += __shfl_xor(ss, 16); ss += __shfl_xor(ss, 32); \
                mh = sqrtf(ss) * cmax + bmax; \
                if (qi < 15) ATT_QF_LOAD(qfn, m + 1); \
            } \
            f32x4 acc[2]; \
            _Pragma("unroll") for (int i = 0; i < 8; ++i) *(LAS bf16x8*)(buf + off_b(4 * i + g, hcol)) = SCUR[i >> 2][i & 3]; \
            _Pragma("unroll") for (int tau = 0; tau < 2; ++tau) { \
                acc[tau] = (f32x4){0.f, 0.f, 0.f, 0.f}; \
                _Pragma("unroll") for (int s = 0; s < 4; ++s) \
                    acc[tau] = __builtin_amdgcn_mfma_f32_16x16x32_bf16(*(const LAS bf16x8*)(buf + off_b(16 * tau + hcol, 4 * s + g)), qf[s], acc[tau], 0, 0, 0); \
            } \
            if (c == 3 && qi < 15) { \
                *(LAS u32x2*)(selL + ((qi + 1) & 1) * 512 + lane * 8) = sv; \
                if (qi < 14) sv = *(const u32x2*)(p.SEL + (size_t)(m + 2) * 256 + 4 * lane); \
            } \
            if (gc + 2 < 128) { \
                const int nqi = (gc + 2) >> 3, nc = (gc + 2) & 7, tn = (m0 + nqi) & (T - 1); const int nvn = tn + 1 < 256 ? tn + 1 : 256; \
                ATT_LOAD_CHUNK(SPRE, selL + (nqi & 1) * 512, nc, nvn); \
            } \
            float pr[2][4]; \
            _Pragma("unroll") for (int tau = 0; tau < 2; ++tau) { \
                const int kp0 = 32 * c + 16 * tau + 4 * g; \
                const u32x2 kk = *(const LAS u32x2*)(selc + 2 * kp0); \
                const int keys[4] = {(int)(kk.x & 0xffffu), (int)(kk.x >> 16), (int)(kk.y & 0xffffu), (int)(kk.y >> 16)}; \
                _Pragma("unroll") for (int r = 0; r < 4; ++r) { \
                    const int dist = t - keys[r]; const bool valid = (kp0 + r) < nvalid; \
                    const int dcl = dist > 127 ? 127 : dist; \
                    const float e = __expf(acc[tau][r] + bias[dcl * 8 + (hcol & 7)] - mh); \
                    pr[tau][r] = valid ? e : 0.f; lsum += pr[tau][r]; \
                } \
            } \
            u32x4 pw; pw.x = pk2(pr[0][0], pr[0][1]); pw.y = pk2(pr[0][2], pr[0][3]); pw.z = pk2(pr[1][0], pr[1][1]); pw.w = pk2(pr[1][2], pr[1][3]); \
            const bf16x8 pf = __builtin_bit_cast(bf16x8, pw); \
            _Pragma("unroll") for (int rt = 0; rt < 8; ++rt) { \
                const unsigned row0 = 4 * g + q4, ch = 2 * rt + (p4 >> 1); \
                const bf16x4 a0 = tr16(buf + off_b(row0, ch) + 8 * (p4 & 1)); \
                const bf16x4 a1 = tr16(buf + off_b(row0 + 16, ch) + 8 * (p4 & 1)); \
                o[rt] = __builtin_amdgcn_mfma_f32_16x16x32_bf16(cat4(a0, a1), pf, o[rt], 0, 0, 0); \
            } \
            if (c == 7) { \
                lsum += __shfl_xor(lsum, 16); lsum += __shfl_xor(lsum, 32); \
                const float inv = 1.f / lsum; \
                if (hcol < 8) { \
                    _Pragma("unroll") for (int rt = 0; rt < 8; ++rt) { \
                        u32x2 w; w.x = pk2(o[rt][0] * inv, o[rt][1] * inv); w.y = pk2(o[rt][2] * inv, o[rt][3] * inv); \
                        *(u32x2*)(p.OL + (size_t)m * 1024 + hcol * 128 + 16 * rt + 4 * g) = w; \
                    } \
                } \
                _Pragma("unroll") for (int rt = 0; rt < 8; ++rt) o[rt] = (f32x4){0.f, 0.f, 0.f, 0.f}; \
                lsum = 0.f; \
            } } } while (0)
#pragma unroll 1
        for (int g3 = 0; g3 < 129; g3 += 3) {
            ATT_BODY(g3, sA, sC);
            ATT_BODY(g3 + 1, sB, sA);
            ATT_BODY(g3 + 2, sC, sB);
        }
#undef ATT_BODY
    }
#undef ATT_LOAD_CHUNK
#undef ATT_QF_LOAD
}

struct Cand8 { float v[8]; int id[8]; unsigned bn[8]; bool ok[8]; };

__device__ __forceinline__ void coarse_thr(const Cand8& c, LAS unsigned* hist, int lane, unsigned& b1, unsigned& above) {
#pragma unroll
    for (int k = 0; k < 8; ++k) if (c.ok[k]) __hip_atomic_fetch_add(hist + (c.bn[k] >> 1), 1u << ((c.bn[k] & 1u) * 16u), __ATOMIC_RELAXED, __HIP_MEMORY_SCOPE_WORKGROUP);
    LDS_WAIT();
    const u32x4 w0 = *(const LAS u32x4*)(hist + 8 * lane), w1 = *(const LAS u32x4*)(hist + 8 * lane + 4);
    unsigned cc[16];
    cc[0] = w0.x & 0xffffu; cc[1] = w0.x >> 16; cc[2] = w0.y & 0xffffu; cc[3] = w0.y >> 16; cc[4] = w0.z & 0xffffu; cc[5] = w0.z >> 16; cc[6] = w0.w & 0xffffu; cc[7] = w0.w >> 16;
    cc[8] = w1.x & 0xffffu; cc[9] = w1.x >> 16; cc[10] = w1.y & 0xffffu; cc[11] = w1.y >> 16; cc[12] = w1.z & 0xffffu; cc[13] = w1.z >> 16; cc[14] = w1.w & 0xffffu; cc[15] = w1.w >> 16;
    unsigned s = 0;
#pragma unroll
    for (int j = 0; j < 16; ++j) s += cc[j];
    unsigned incl = s;
#pragma unroll
    for (int o = 1; o < 64; o <<= 1) { const unsigned t = __shfl_down(incl, o); if (lane + o < 64) incl += t; }
    const unsigned excl = incl - s;
    const bool mine = (excl < 256u) && (incl >= 256u);
    unsigned bin = 0, ab = 0, run = excl; bool found = false;
#pragma unroll
    for (int j = 15; j >= 0; --j) { if (!found && run + cc[j] >= 256u) { bin = 16 * lane + j; ab = run; found = true; } if (!found) run += cc[j]; }
    const unsigned long long bm = __ballot(mine);
    const int src = bm ? (int)__builtin_ctzll(bm) : 0;
    b1 = __shfl(bin, src); above = __shfl(ab, src);
    LDS_WAIT();
}

__device__ __forceinline__ void exact_take(const Cand8& c, unsigned b1, int need, LAS unsigned* h2, int lane, bool (&take)[8]) {
    unsigned ck[8]; bool ceq[8];
#pragma unroll
    for (int k = 0; k < 8; ++k) { ck[k] = fkey(c.v[k]); ceq[k] = c.ok[k] && c.bn[k] == b1; }
    unsigned prefix = 0;
#pragma unroll 1
    for (int pass = 3; pass >= 0; --pass) {
#pragma unroll
        for (int i = 0; i < 4; ++i) h2[lane + 64 * i] = 0u;
        LDS_WAIT();
        const int shift = pass * 8;
#pragma unroll
        for (int k = 0; k < 8; ++k) {
            const bool match = ceq[k] && ((pass == 3) || ((ck[k] >> (shift + 8)) == prefix));
            if (match) __hip_atomic_fetch_add(h2 + ((ck[k] >> shift) & 255u), 1u, __ATOMIC_RELAXED, __HIP_MEMORY_SCOPE_WORKGROUP);
        }
        LDS_WAIT();
        const unsigned c0 = h2[4 * lane], c1 = h2[4 * lane + 1], c2 = h2[4 * lane + 2], c3 = h2[4 * lane + 3];
        const unsigned s = c0 + c1 + c2 + c3;
        unsigned incl = s;
#pragma unroll
        for (int o = 1; o < 64; o <<= 1) { const unsigned t = __shfl_down(incl, o); if (lane + o < 64) incl += t; }
        const unsigned excl = incl - s;
        const bool mine = (excl < (unsigned)need) && (incl >= (unsigned)need);
        unsigned bin = 0, ab = 0;
        if (mine) {
            unsigned run = excl;
            if (run + c3 >= (unsigned)need) { bin = 4 * lane + 3; ab = run; }
            else { run += c3;
                if (run + c2 >= (unsigned)need) { bin = 4 * lane + 2; ab = run; }
                else { run += c2;
                    if (run + c1 >= (unsigned)need) { bin = 4 * lane + 1; ab = run; }
                    else { run += c1; bin = 4 * lane; ab = run; } } }
        }
        const unsigned long long bm = __ballot(mine);
        const int src = bm ? (int)__builtin_ctzll(bm) : 0;
        bin = __shfl(bin, src); ab = __shfl(ab, src);
        need -= (int)ab; prefix = (prefix << 8) | bin;
        LDS_WAIT();
    }
    const unsigned Tk = prefix;
    bool tk[8]; int ne = 0;
#pragma unroll
    for (int k = 0; k < 8; ++k) { tk[k] = ceq[k] && ck[k] == Tk; ne += __builtin_popcountll(__ballot(tk[k])); }
    if (ne > need) {
        bool keep[8];
#pragma unroll
        for (int k = 0; k < 8; ++k) keep[k] = false;
        for (int r = 0; r < need; ++r) {
            int mn = 0x7fffffff;
#pragma unroll
            for (int k = 0; k < 8; ++k) if (tk[k] && !keep[k] && c.id[k] < mn) mn = c.id[k];
#pragma unroll
            for (int o = 1; o < 64; o <<= 1) { const int t = __shfl_xor(mn, o); mn = t < mn ? t : mn; }
#pragma unroll
            for (int k = 0; k < 8; ++k) if (tk[k] && c.id[k] == mn) keep[k] = true;
        }
#pragma unroll
        for (int k = 0; k < 8; ++k) tk[k] = keep[k];
    }
#pragma unroll
    for (int k = 0; k < 8; ++k) take[k] = (c.ok[k] && c.bn[k] > b1) || (ceq[k] && ck[k] > Tk) || tk[k];
}


__device__ __forceinline__ void select_row_g(const float* row, int n, LAS unsigned* hist, unsigned short* out, int lane) {
    unsigned prefix = 0; int need = 256;
    const unsigned long long lt = (1ull << lane) - 1ull;
#pragma unroll 1
    for (int pass = 3; pass >= 0; --pass) {
#pragma unroll
        for (int i = 0; i < 4; ++i) hist[lane + 64 * i] = 0u;
        LDS_WAIT();
        const int shift = pass * 8;
        for (int i = lane; i < n; i += 64) {
            const unsigned k = fkey(row[i]);
            const bool match = (pass == 3) || ((k >> (shift + 8)) == prefix);
            if (match) __hip_atomic_fetch_add(hist + ((k >> shift) & 255u), 1u, __ATOMIC_RELAXED, __HIP_MEMORY_SCOPE_WORKGROUP);
        }
        LDS_WAIT();
        const unsigned c0 = hist[4 * lane], c1 = hist[4 * lane + 1], c2 = hist[4 * lane + 2], c3 = hist[4 * lane + 3];
        const unsigned s = c0 + c1 + c2 + c3;
        unsigned incl = s;
#pragma unroll
        for (int o = 1; o < 64; o <<= 1) { const unsigned t = __shfl_down(incl, o); if (lane + o < 64) incl += t; }
        const unsigned excl = incl - s;
        const bool mine = (excl < (unsigned)need) && (incl >= (unsigned)need);
        unsigned bin = 0, above = 0;
        if (mine) {
            unsigned run = excl;
            if (run + c3 >= (unsigned)need) { bin = 4 * lane + 3; above = run; }
            else { run += c3;
                if (run + c2 >= (unsigned)need) { bin = 4 * lane + 2; above = run; }
                else { run += c2;
                    if (run + c1 >= (unsigned)need) { bin = 4 * lane + 1; above = run; }
                    else { run += c1; bin = 4 * lane; above = run; } } }
        }
        const unsigned long long bm = __ballot(mine);
        const int src = bm ? (int)__builtin_ctzll(bm) : 0;
        bin = __shfl(bin, src); above = __shfl(above, src);
        need -= (int)above; prefix = (prefix << 8) | bin;
        LDS_WAIT();
    }
    const unsigned Tk = prefix;
    int cnt = 0, eq_taken = 0;
    for (int i0 = 0; i0 < n; i0 += 64) {
        const int i = i0 + lane; const bool valid = i < n;
        const unsigned k = valid ? fkey(row[i]) : 0u;
        const bool gtk = valid && (k > Tk), eqk = valid && (k == Tk);
        const unsigned long long beq = __ballot(eqk);
        const int eq_rank = eq_taken + __builtin_popcountll(beq & lt);
        const bool take = gtk || (eqk && eq_rank < need);
        const unsigned long long bt = __ballot(take);
        const int pos = cnt + __builtin_popcountll(bt & lt);
        if (take && pos < 256) out[pos] = (unsigned short)i;
        cnt += __builtin_popcountll(bt); eq_taken += __builtin_popcountll(beq);
    }
}

constexpr int IDX_CAP = 336;
__device__ __forceinline__ void ph_index6(const P& p, LAS unsigned char* lds, const int wv) {
    const int tid = opaque_tid(wv), lane = tid & 63, wave = __builtin_amdgcn_readfirstlane(tid >> 6);
    LAS unsigned char* KS = lds;
    LAS unsigned char* QR = lds + 32768 + wave * 4 * 2048;
    LAS unsigned* h2 = (LAS unsigned*)(lds + 98304) + wave * 256;
    const int hh = lane >> 5, n = lane & 31;
    const int rho = lane & 31, qlA = 2 * ((rho >> 2) & 1) + (rho >> 4), hdA = (rho & 3) + 4 * ((rho >> 3) & 1);
    const unsigned long long lt = (1ull << lane) - 1ull;
    const unsigned lt32 = (1u << n) - 1u;
    for (int gq = blockIdx.x; gq < 1024; gq += gridDim.x) {
        const int b = gq & 7, t0 = (127 - (gq >> 3)) * 32; const size_t mb = (size_t)b * T;
        const int tw = t0 + 4 * wave;
        bf16x8 A[4]; float wq[16];
        {
            const bf16_t* src = p.QI + (mb + tw + qlA) * 512 + hdA * 64 + 8 * hh;
#pragma unroll
            for (int s = 0; s < 4; ++s) A[s] = *(const bf16x8*)(src + 16 * s);
#pragma unroll
            for (int c = 0; c < 2; ++c) {
                const float* wp = p.WI + (mb + tw + 2 * hh + c) * 8;
                const f32x4 w0 = *(const f32x4*)wp, w1 = *(const f32x4*)(wp + 4);
#pragma unroll
                for (int j = 0; j < 4; ++j) { wq[c * 8 + j] = w0[j]; wq[c * 8 + 4 + j] = w1[j]; }
            }
        }
#pragma unroll
        for (int i = 0; i < 8; ++i) *(LAS u32x4*)(QR + (lane + 64 * i) * 16) = (u32x4){0u, 0u, 0u, 0u};
#pragma unroll
        for (int s = 0; s < 4; ++s) asm volatile("" :: "v"(A[s]));
#pragma unroll
        for (int j = 0; j < 16; ++j) asm volatile("" :: "v"(wq[j]));
        int cnt[4]; unsigned b1q[4], abq[4];
#pragma unroll
        for (int q = 0; q < 4; ++q) { cnt[q] = 0; b1q[q] = 0u; abq[q] = 0u; }
        const int nst = (t0 + 32 + 127) >> 7;
        const int qme = 2 * hh;
        const LAS unsigned char* myq = QR + qme * 2048;
#pragma unroll 1
        for (int sweep = 0; sweep < 2; ++sweep) {
            u32x4 sr[2];
#pragma unroll
            for (int i = 0; i < 2; ++i) { const int idx = tid + NTHR * i, row = idx >> 3, ch = idx & 7; sr[i] = *(const u32x4*)(p.KI + (mb + row) * 64 + ch * 8); }
#pragma unroll
            for (int i = 0; i < 2; ++i) { const int idx = tid + NTHR * i, row = idx >> 3, ch = idx & 7; *(LAS u32x4*)(KS + row * 128 + 16 * (ch ^ (row & 7))) = sr[i]; }
            __syncthreads();
#pragma unroll 1
            for (int st = 0; st < nst; ++st) {
                if (st + 1 < nst) {
#pragma unroll
                    for (int i = 0; i < 2; ++i) { const int idx = tid + NTHR * i, row = idx >> 3, ch = idx & 7; sr[i] = *(const u32x4*)(p.KI + (mb + (st + 1) * 128 + row) * 64 + ch * 8); }
                }
                const LAS unsigned char* kb = KS + (st & 1) * 16384;
#pragma unroll 1
                for (int tl = 0; tl < 4; ++tl) {
                    const int key0 = st * 128 + tl * 32;
                    if (key0 > tw + 3) break;
                    const int row = tl * 32 + n, key = key0 + n;
                    f32x16 acc;
#pragma unroll
                    for (int j = 0; j < 16; ++j) acc[j] = 0.f;
#pragma unroll
                    for (int s = 0; s < 4; ++s) {
                        const bf16x8 Bf = *(const LAS bf16x8*)(kb + row * 128 + 16 * ((2 * s + hh) ^ (row & 7)));
                        acc = __builtin_amdgcn_mfma_f32_32x32x16_bf16(A[s], Bf, acc, 0, 0, 0);
                    }
#pragma unroll
                    for (int c = 0; c < 2; ++c) {
                        float v = 0.f;
#pragma unroll
                        for (int h = 0; h < 8; ++h) v += wq[c * 8 + h] * fmaxf(acc[c * 8 + h], 0.f);
                        const unsigned bn = qbin(v);
                        const bool causal = key <= tw + qme + c;
                        if (sweep == 0) {
                            if (causal) __hip_atomic_fetch_add((LAS unsigned*)(myq + c * 2048) + (bn >> 1), 1u << ((bn & 1u) * 16u), __ATOMIC_RELAXED, __HIP_MEMORY_SCOPE_WORKGROUP);
                        } else {
                            const unsigned bl = hh ? b1q[2 + c] : b1q[c];
                            const bool pass = causal && (bn >= bl);
                            const unsigned long long mk = __ballot(pass);
                            const unsigned lo = (unsigned)mk, hi = (unsigned)(mk >> 32);
                            const int rank = hh ? __builtin_popcount(hi & lt32) : __builtin_popcount(lo & lt32);
                            const int pos = (hh ? cnt[2 + c] : cnt[c]) + rank;
                            if (pass && pos < IDX_CAP) { LAS unsigned char* qr = QR + (qme + c) * 2048; ((LAS float*)qr)[pos] = v; ((LAS unsigned short*)(qr + IDX_CAP * 4))[pos] = (unsigned short)key; }
                            cnt[c] += __builtin_popcount(lo); cnt[2 + c] += __builtin_popcount(hi);
                        }
                    }
                }
                if (st + 1 < nst) {
#pragma unroll
                    for (int i = 0; i < 2; ++i) { const int idx = tid + NTHR * i, row = idx >> 3, ch = idx & 7; *(LAS u32x4*)(KS + ((st + 1) & 1) * 16384 + row * 128 + 16 * (ch ^ (row & 7))) = sr[i]; }
                }
                __syncthreads();
            }
            if (sweep == 0) {
                LDS_WAIT();
#pragma unroll 1
                for (int q = 0; q < 4; ++q) {
                    unsigned b1 = 0u, above = 0u;
                    if (tw + q + 1 > 256) {
                        const LAS unsigned* hist = (const LAS unsigned*)(QR + q * 2048);
                        const u32x4 w0 = *(const LAS u32x4*)(hist + 8 * lane), w1 = *(const LAS u32x4*)(hist + 8 * lane + 4);
                        unsigned cc[16];
                        cc[0] = w0.x & 0xffffu; cc[1] = w0.x >> 16; cc[2] = w0.y & 0xffffu; cc[3] = w0.y >> 16; cc[4] = w0.z & 0xffffu; cc[5] = w0.z >> 16; cc[6] = w0.w & 0xffffu; cc[7] = w0.w >> 16;
                        cc[8] = w1.x & 0xffffu; cc[9] = w1.x >> 16; cc[10] = w1.y & 0xffffu; cc[11] = w1.y >> 16; cc[12] = w1.z & 0xffffu; cc[13] = w1.z >> 16; cc[14] = w1.w & 0xffffu; cc[15] = w1.w >> 16;
                        unsigned s = 0;
#pragma unroll
                        for (int j = 0; j < 16; ++j) s += cc[j];
                        unsigned incl = s;
#pragma unroll
                        for (int o = 1; o < 64; o <<= 1) { const unsigned t = __shfl_down(incl, o); if (lane + o < 64) incl += t; }
                        const unsigned excl = incl - s;
                        const bool mine = (excl < 256u) && (incl >= 256u);
                        unsigned bin = 0, ab = 0, run = excl; bool found = false;
#pragma unroll
                        for (int j = 15; j >= 0; --j) { if (!found && run + cc[j] >= 256u) { bin = 16 * lane + j; ab = run; found = true; } if (!found) run += cc[j]; }
                        const unsigned long long bm = __ballot(mine);
                        const int src = bm ? (int)__builtin_ctzll(bm) : 0;
                        b1 = __shfl(bin, src); above = __shfl(ab, src);
                    }
#pragma unroll
                    for (int qq = 0; qq < 4; ++qq) { b1q[qq] = qq == q ? b1 : b1q[qq]; abq[qq] = qq == q ? above : abq[qq]; }
                }
                LDS_WAIT();
            }
        }
        LDS_WAIT();
#pragma unroll 1
        for (int q = 0; q < 4; ++q) {
            unsigned short* out = p.SEL + (mb + tw + q) * 256;
            const int nq = tw + q + 1;
            const int cq = q == 0 ? cnt[0] : q == 1 ? cnt[1] : q == 2 ? cnt[2] : cnt[3];
            const unsigned b1 = q == 0 ? b1q[0] : q == 1 ? b1q[1] : q == 2 ? b1q[2] : b1q[3];
            const unsigned above = q == 0 ? abq[0] : q == 1 ? abq[1] : q == 2 ? abq[2] : abq[3];
            if (nq <= 256) {
#pragma unroll
                for (int i = 0; i < 4; ++i) { const int k = lane + 64 * i; out[k] = (unsigned short)(k < nq ? k : 0); }
            } else if (cq <= IDX_CAP) {
                const LAS float* cv = (const LAS float*)(QR + q * 2048); const LAS unsigned short* cix = (const LAS unsigned short*)(QR + q * 2048 + IDX_CAP * 4);
                Cand8 c;
#pragma unroll
                for (int k = 0; k < 8; ++k) { const int j = lane + 64 * k; c.ok[k] = j < cq; c.v[k] = c.ok[k] ? cv[j] : 0.f; c.id[k] = c.ok[k] ? (int)cix[j] : 0; c.bn[k] = qbin(c.v[k]); }
                bool take[8];
                exact_take(c, b1, 256 - (int)above, h2, lane, take);
                LDS_WAIT();
                LAS unsigned short* outL = (LAS unsigned short*)(QR + q * 2048);
                int np = 0;
#pragma unroll
                for (int k = 0; k < 8; ++k) {
                    const unsigned long long bt = __ballot(take[k]);
                    const int pos = np + __builtin_popcountll(bt & lt);
                    if (take[k] && pos < 256) outL[pos] = (unsigned short)c.id[k];
                    np += __builtin_popcountll(bt);
                }
                LDS_WAIT();
                *(u32x2*)(out + 4 * lane) = *(const LAS u32x2*)(outL + 4 * lane);
                LDS_WAIT();
            } else {
                float* grow = p.IDXROW + (size_t)(blockIdx.x * NWAVES + wave) * 4096;
                const bf16_t* qsrc = p.QI + (mb + tw + q) * 512; const float* wsrc = p.WI + (mb + tw + q) * 8;
                for (int key = lane; key < nq; key += 64) {
                    const bf16_t* kr = p.KI + (mb + key) * 64;
                    float sc = 0.f;
                    for (int h = 0; h < 8; ++h) { float d = 0.f; for (int e = 0; e < 64; ++e) d += bf2f(qsrc[h * 64 + e]) * bf2f(kr[e]); sc += wsrc[h] * fmaxf(d, 0.f); }
                    grow[key] = sc;
                }
                asm volatile("s_waitcnt vmcnt(0)" ::: "memory");
                select_row_g(grow, nq, h2, out, lane);
            }
        }
        __syncthreads();
    }
}

__device__ __forceinline__ unsigned q16of(float x) { return (unsigned)(int)__builtin_fminf(__builtin_fmaxf((x + 8.0f) * 4096.0f, 0.0f), 65535.0f); }

__device__ __forceinline__ void select_row7(const LAS unsigned short* row, int n, LAS unsigned* hist, LAS unsigned* h2, unsigned short* out, int lane) {
    if (n <= 256) {
#pragma unroll
        for (int i = 0; i < 4; ++i) { const int k = lane + 64 * i; out[k] = (unsigned short)(k < n ? k : 0); }
#pragma unroll
        for (int i = 0; i < 8; ++i) hist[lane + 64 * i] = 0u;
        return;
    }
    const unsigned long long lt = (1ull << lane) - 1ull;
    unsigned b1, above;
    {
        const u32x4 w0 = *(const LAS u32x4*)(hist + 8 * lane), w1 = *(const LAS u32x4*)(hist + 8 * lane + 4);
        unsigned c[16];
        c[0] = w0.x & 0xffffu; c[1] = w0.x >> 16; c[2] = w0.y & 0xffffu; c[3] = w0.y >> 16; c[4] = w0.z & 0xffffu; c[5] = w0.z >> 16; c[6] = w0.w & 0xffffu; c[7] = w0.w >> 16;
        c[8] = w1.x & 0xffffu; c[9] = w1.x >> 16; c[10] = w1.y & 0xffffu; c[11] = w1.y >> 16; c[12] = w1.z & 0xffffu; c[13] = w1.z >> 16; c[14] = w1.w & 0xffffu; c[15] = w1.w >> 16;
        unsigned s = 0;
#pragma unroll
        for (int j = 0; j < 16; ++j) s += c[j];
        unsigned incl = s;
#pragma unroll
        for (int o = 1; o < 64; o <<= 1) { const unsigned t = __shfl_down(incl, o); if (lane + o < 64) incl += t; }
        const unsigned excl = incl - s;
        const bool mine = (excl < 256u) && (incl >= 256u);
        unsigned bin = 0, ab = 0, run = excl; bool found = false;
#pragma unroll
        for (int j = 15; j >= 0; --j) { if (!found && run + c[j] >= 256u) { bin = 16 * lane + j; ab = run; found = true; } if (!found) run += c[j]; }
        const unsigned long long bm = __ballot(mine);
        const int src = bm ? (int)__builtin_ctzll(bm) : 0;
        b1 = __shfl(bin, src); above = __shfl(ab, src);
    }
    LDS_WAIT();
    int need = 256 - (int)above;
    LAS unsigned short* cand = (LAS unsigned short*)hist;
    const int nblk = (n + 255) >> 8;
    const unsigned thr = b1 << 6;
    int C = 0;
    for (int blk = 0; blk < nblk; ++blk) {
        const u32x2 v = *(const LAS u32x2*)(row + blk * 256 + 4 * lane);
        const unsigned q[4] = {v.x & 0xffffu, v.x >> 16, v.y & 0xffffu, v.y >> 16};
        bool ge[4]; unsigned long long bl[4];
#pragma unroll
        for (int e = 0; e < 4; ++e) { ge[e] = (blk * 256 + 4 * lane + e < n) && (q[e] >= thr); bl[e] = __ballot(ge[e]); }
        const int below = __builtin_popcountll(bl[0] & lt) + __builtin_popcountll(bl[1] & lt) + __builtin_popcountll(bl[2] & lt) + __builtin_popcountll(bl[3] & lt);
        int pos = C + below;
#pragma unroll
        for (int e = 0; e < 4; ++e) { if (ge[e]) { if (pos < 768) cand[pos] = (unsigned short)(blk * 256 + 4 * lane + e); ++pos; } }
        C += __builtin_popcountll(bl[0]) + __builtin_popcountll(bl[1]) + __builtin_popcountll(bl[2]) + __builtin_popcountll(bl[3]);
    }
    LDS_WAIT();
    LAS unsigned short* outL = cand + 768;
    if (C <= 512) {
        int ci[8]; unsigned cq[8]; bool ceq[8];
#pragma unroll
        for (int k = 0; k < 8; ++k) { const int j = lane + 64 * k; ci[k] = j < C ? (int)cand[j] : -1; }
#pragma unroll
        for (int k = 0; k < 8; ++k) { cq[k] = ci[k] >= 0 ? (unsigned)row[ci[k]] : 0u; ceq[k] = ci[k] >= 0 && (cq[k] >> 6) == b1; }
        h2[lane] = 0u;
        LDS_WAIT();
#pragma unroll
        for (int k = 0; k < 8; ++k) if (ceq[k]) __hip_atomic_fetch_add(h2 + (cq[k] & 63u), 1u, __ATOMIC_RELAXED, __HIP_MEMORY_SCOPE_WORKGROUP);
        LDS_WAIT();
        const unsigned cme = h2[lane];
        unsigned incl = cme;
#pragma unroll
        for (int o = 1; o < 64; o <<= 1) { const unsigned t = __shfl_down(incl, o); if (lane + o < 64) incl += t; }
        const unsigned excl = incl - cme;
        const bool mine = (excl < (unsigned)need) && (incl >= (unsigned)need);
        const unsigned long long bm = __ballot(mine);
        const int src = bm ? (int)__builtin_ctzll(bm) : 0;
        const unsigned Tl = (unsigned)src;
        need -= (int)__shfl(excl, src);
        const unsigned Tq = (b1 << 6) | Tl;
        int eq_seen = 0, cnt = 0;
#pragma unroll
        for (int k = 0; k < 8; ++k) {
            const bool valid = ci[k] >= 0, eqk = valid && cq[k] == Tq;
            const unsigned long long beq = __ballot(eqk);
            const int eq_rank = eq_seen + __builtin_popcountll(beq & lt);
            const bool take = valid && (cq[k] > Tq || (eqk && eq_rank < need));
            const unsigned long long bt = __ballot(take);
            const int pos = cnt + __builtin_popcountll(bt & lt);
            if (take && pos < 256) outL[pos] = (unsigned short)ci[k];
            cnt += __builtin_popcountll(bt); eq_seen += __builtin_popcountll(beq);
        }
    } else {
        unsigned lo = 0u, hi = 65535u;
        while (lo < hi) {
            const unsigned mid = (lo + hi + 1u) >> 1;
            int cge = 0;
            for (int i = lane; i < n; i += 64) cge += ((unsigned)row[i] >= mid) ? 1 : 0;
#pragma unroll
            for (int o = 1; o < 64; o <<= 1) cge += __shfl_xor(cge, o);
            if (cge >= 256) lo = mid; else hi = mid - 1u;
        }
        const unsigned Tq = lo;
        int cgt = 0;
        for (int i = lane; i < n; i += 64) cgt += ((unsigned)row[i] > Tq) ? 1 : 0;
#pragma unroll
        for (int o = 1; o < 64; o <<= 1) cgt += __shfl_xor(cgt, o);
        const int needq = 256 - cgt;
        int cnt = 0, eq_seen = 0;
        for (int i0 = 0; i0 < n; i0 += 64) {
            const int i = i0 + lane; const bool valid = i < n;
            const unsigned qv = valid ? (unsigned)row[i] : 0u;
            const bool eqk = valid && qv == Tq;
            const unsigned long long beq = __ballot(eqk);
            const int eq_rank = eq_seen + __builtin_popcountll(beq & lt);
            const bool take = valid && (qv > Tq || (eqk && eq_rank < needq));
            const unsigned long long bt = __ballot(take);
            const int pos = cnt + __builtin_popcountll(bt & lt);
            if (take && pos < 256) outL[pos] = (unsigned short)i;
            cnt += __builtin_popcountll(bt); eq_seen += __builtin_popcountll(beq);
        }
    }
    LDS_WAIT();
    *(u32x2*)(out + 4 * lane) = *(const LAS u32x2*)(outL + 4 * lane);
    LDS_WAIT();
#pragma unroll
    for (int i = 0; i < 8; ++i) hist[lane + 64 * i] = 0u;
}

__device__ __forceinline__ void ph_index7(const P& p, LAS unsigned char* lds, const int wv) {
    LAS unsigned short* Irow = (LAS unsigned short*)lds;
    LAS unsigned* hist = (LAS unsigned*)(lds + 65536);
    LAS unsigned* h2 = (LAS unsigned*)(lds + 81920);
    const int tid = opaque_tid(wv), lane = tid & 63, wave = __builtin_amdgcn_readfirstlane(tid >> 6);
    LAS unsigned char* KSw = lds + 92160 + wave * 8192;
    const int hh = lane >> 5, n = lane & 31;
    const int rho = lane & 31, qlA = 2 * ((rho >> 2) & 1) + (rho >> 4), hdA = (rho & 3) + 4 * ((rho >> 3) & 1);
    const int srow = lane >> 3, sch = lane & 7;
#pragma unroll
    for (int i = 0; i < 8; ++i) hist[tid + NTHR * i] = 0u;
    bf16x8 A[2][4]; float wq[2][16]; u32x4 RA[4], RB[4];
#define IDX7_LOAD(R_, mb_, kt_) do { const bf16_t* kp_ = p.KI + ((mb_) + (size_t)(kt_) * 32 + srow) * 64 + sch * 8; \
        _Pragma("unroll") for (int i = 0; i < 4; ++i) R_[i] = *(const u32x4*)(kp_ + (size_t)i * 8 * 64); } while (0)
#define IDX7_LOAD_UNIT(u_) do { const int b_ = (u_) & 7, t0_ = (511 - ((u_) >> 3)) * 8; const size_t mb_ = (size_t)b_ * T; const int nkt_ = (t0_ + 8 + 31) >> 5; \
        _Pragma("unroll") for (int mt = 0; mt < 2; ++mt) { const bf16_t* src = p.QI + (mb_ + t0_ + mt * 4 + qlA) * 512 + hdA * 64 + 8 * hh; \
            _Pragma("unroll") for (int s = 0; s < 4; ++s) A[mt][s] = *(const bf16x8*)(src + 16 * s); \
            _Pragma("unroll") for (int c = 0; c < 2; ++c) { const float* wp = p.WI + (mb_ + t0_ + mt * 4 + 2 * hh + c) * 8; const f32x4 w0 = *(const f32x4*)wp, w1 = *(const f32x4*)(wp + 4); \
                _Pragma("unroll") for (int j = 0; j < 4; ++j) { wq[mt][c * 8 + j] = w0[j]; wq[mt][c * 8 + 4 + j] = w1[j]; } } } \
        if (wave < nkt_) IDX7_LOAD(RA, mb_, wave); if (wave + NWAVES < nkt_) IDX7_LOAD(RB, mb_, wave + NWAVES); } while (0)
    if ((int)blockIdx.x < 4096) IDX7_LOAD_UNIT((int)blockIdx.x);
    __syncthreads();
    for (int u = blockIdx.x; u < 4096; u += gridDim.x) {
        const int b = u & 7, tb = 511 - (u >> 3), t0 = tb * 8; const size_t mb = (size_t)b * T;
        const int nkt = (t0 + 8 + 31) >> 5;
#pragma unroll
        for (int mt = 0; mt < 2; ++mt) {
#pragma unroll
            for (int s = 0; s < 4; ++s) asm volatile("" :: "v"(A[mt][s]));
#pragma unroll
            for (int j = 0; j < 16; ++j) asm volatile("" :: "v"(wq[mt][j]));
        }
#define IDX7_BODY(kt_, R_, bf_) do { const int kt = (kt_); if (kt < nkt) { \
            LAS unsigned char* img = KSw + (bf_) * 4096; \
            _Pragma("unroll") for (int i = 0; i < 4; ++i) { const int row = 8 * i + srow; *(LAS u32x4*)(img + row * 128 + 16 * (sch ^ (row & 7))) = R_[i]; } \
            if (kt + 2 * NWAVES < nkt) IDX7_LOAD(R_, mb, kt + 2 * NWAVES); \
            bf16x8 Bf[4]; \
            _Pragma("unroll") for (int s = 0; s < 4; ++s) Bf[s] = *(const LAS bf16x8*)(img + n * 128 + 16 * ((2 * s + hh) ^ (n & 7))); \
            const int key = kt * 32 + n; \
            _Pragma("unroll") for (int mt = 0; mt < 2; ++mt) { \
                f32x16 acc; \
                _Pragma("unroll") for (int j = 0; j < 16; ++j) acc[j] = 0.f; \
                _Pragma("unroll") for (int s = 0; s < 4; ++s) acc = __builtin_amdgcn_mfma_f32_32x32x16_bf16(A[mt][s], Bf[s], acc, 0, 0, 0); \
                _Pragma("unroll") for (int c = 0; c < 2; ++c) { \
                    float v = 0.f; \
                    _Pragma("unroll") for (int h = 0; h < 8; ++h) { const float af = acc[c * 8 + h]; const int ai = __float_as_int(af); v = __builtin_fmaf(wq[mt][c * 8 + h], __int_as_float(ai > 0 ? ai : 0), v); } \
                    const int r = mt * 4 + 2 * hh + c; const unsigned q = q16of(v); \
                    Irow[r * 4096 + key] = (unsigned short)q; \
                    if (key <= t0 + r) { const unsigned bin = q >> 6; __hip_atomic_fetch_add(hist + r * 512 + (bin >> 1), 1u << ((bin & 1u) * 16u), __ATOMIC_RELAXED, __HIP_MEMORY_SCOPE_WORKGROUP); } \
                } \
            } } } while (0)
#pragma unroll 1
        for (int k0 = wave; k0 < nkt; k0 += 2 * NWAVES) {
            IDX7_BODY(k0, RA, 0);
            IDX7_BODY(k0 + NWAVES, RB, 1);
        }
#undef IDX7_BODY
        if (u + (int)gridDim.x < 4096) IDX7_LOAD_UNIT(u + (int)gridDim.x);
        LDS_WAIT(); __builtin_amdgcn_s_barrier();
        select_row7(Irow + wave * 4096, t0 + wave + 1, hist + wave * 512, h2 + wave * 320, p.SEL + (mb + t0 + wave) * 256, lane);
        LDS_WAIT(); __builtin_amdgcn_s_barrier();
    }
#undef IDX7_LOAD
#undef IDX7_LOAD_UNIT
}

__device__ __forceinline__ void ph_gmlp(const P& p, LAS unsigned char* lds, const int wv) {
    const int tid = opaque_tid(wv), lane = tid & 63, wave = __builtin_amdgcn_readfirstlane(tid >> 6);
    LAS unsigned char* vt = lds;
    LAS float* st = (LAS float*)(lds + 32768);
    const unsigned vbase = lds_addr_of(vt);
    const int g4 = lane >> 4, q4 = (lane & 15) >> 2, p4 = lane & 3;
    for (int u = blockIdx.x; u < 256; u += gridDim.x) {
        const size_t m0 = (size_t)u * 128;
        for (int rr = 0; rr < 16; ++rr) {
            const int row = 16 * wave + rr;
            const u32x4 w = *(const u32x4*)(p.VB + (m0 + row) * 512 + lane * 8);
            const float x0 = bflo(w.x), x1 = bfhi(w.x), x2 = bflo(w.y), x3 = bfhi(w.y), x4 = bflo(w.z), x5 = bfhi(w.z), x6 = bflo(w.w), x7 = bfhi(w.w);
            const float mean = wave_sum(((x0 + x1) + (x2 + x3)) + ((x4 + x5) + (x6 + x7))) * (1.f / 512.f);
            const float d0 = x0 - mean, d1 = x1 - mean, d2 = x2 - mean, d3 = x3 - mean, d4 = x4 - mean, d5 = x5 - mean, d6 = x6 - mean, d7 = x7 - mean;
            const float var = wave_sum(((d0 * d0 + d1 * d1) + (d2 * d2 + d3 * d3)) + ((d4 * d4 + d5 * d5) + (d6 * d6 + d7 * d7))) * (1.f / 512.f);
            if (lane == 0) { st[2 * row] = mean; st[2 * row + 1] = 1.0f / sqrtf(var + EPS); }
        }
        __syncthreads();
#pragma unroll 1
        for (int g = 0; g < 4; ++g) {
#pragma unroll
            for (int i = 0; i < 4; ++i) {
                const int piece = i * NTHR + tid, row = piece >> 4, ch = piece & 15;
                const u32x4 w = *(const u32x4*)(p.VB + (m0 + row) * 512 + g * 128 + ch * 8);
                const float mean = st[2 * row], rstd = st[2 * row + 1];
                const f32x4 ga = *(const f32x4*)(p.ln_g + g * 128 + ch * 8), gb = *(const f32x4*)(p.ln_g + g * 128 + ch * 8 + 4);
                const f32x4 ba = *(const f32x4*)(p.ln_b + g * 128 + ch * 8), bb = *(const f32x4*)(p.ln_b + g * 128 + ch * 8 + 4);
                u32x4 o;
                o.x = pk2((bflo(w.x) - mean) * rstd * ga[0] + ba[0], (bfhi(w.x) - mean) * rstd * ga[1] + ba[1]);
                o.y = pk2((bflo(w.y) - mean) * rstd * ga[2] + ba[2], (bfhi(w.y) - mean) * rstd * ga[3] + ba[3]);
                o.z = pk2((bflo(w.z) - mean) * rstd * gb[0] + bb[0], (bfhi(w.z) - mean) * rstd * gb[1] + bb[1]);
                o.w = pk2((bflo(w.w) - mean) * rstd * gb[2] + bb[2], (bfhi(w.w) - mean) * rstd * gb[3] + bb[3]);
                *(LAS u32x4*)(vt + off_b(row, ch)) = o;
            }
            __syncthreads();
            f32x4 acc[8];
#pragma unroll
            for (int et = 0; et < 8; ++et) acc[et] = (f32x4){0.f, 0.f, 0.f, 0.f};
            const int nks = ((16 * wave + 15) >> 5) + 1;
#pragma unroll
            for (int ks = 0; ks < 4; ++ks) {
                if (ks < nks) {
                    const bf16x8 a = *(const bf16x8*)(p.WSB + ((size_t)g * 128 + 16 * wave + (lane & 15)) * 128 + 32 * ks + 8 * g4);
#pragma unroll
                    for (int et = 0; et < 8; ++et) {
                        const unsigned r0 = 32 * ks + 8 * g4 + q4, ch = 2 * et + (p4 >> 1);
                        const bf16x4 b0 = tr_read(vbase + off_b(r0, ch) + 8 * (p4 & 1));
                        const bf16x4 b1 = tr_read(vbase + off_b(r0 + 4, ch) + 8 * (p4 & 1));
                        acc[et] = __builtin_amdgcn_mfma_f32_16x16x32_bf16(a, cat4(b0, b1), acc[et], 0, 0, 0);
                    }
                }
            }
#pragma unroll
            for (int r = 0; r < 4; ++r) {
                const int i = 16 * wave + 4 * g4 + r; const float bs = p.b_sp[g * 128 + i];
#pragma unroll
                for (int et = 0; et < 8; ++et) {
                    const size_t o = (m0 + i) * 512 + g * 128 + 16 * et + (lane & 15);
                    p.US[o] = (bf16_t)f2bf(bf2f(p.UB[o]) * (acc[et][r] + bs));
                }
            }
            __syncthreads();
        }
    }
}

__device__ __forceinline__ float dot16(const f32x4 (&hv)[4], const LAS float* wr, int lane) {
    float s = 0.f;
#pragma unroll
    for (int j = 0; j < 4; ++j) { const f32x4 w = ((const LAS f32x4*)wr)[lane + 64 * j]; s += (hv[j].x * w.x + hv[j].y * w.y) + (hv[j].z * w.z + hv[j].w * w.w); }
    return s;
}
__device__ __forceinline__ void ph_router(const P& p, LAS unsigned char* lds, const int wv) {
    const int tid = opaque_tid(wv), lane = tid & 63, wave = __builtin_amdgcn_readfirstlane(tid >> 6);
    LAS float* WL = (LAS float*)lds;
    LAS unsigned* cnt = (LAS unsigned*)(lds + 147456);
    const float* X1 = p.out;
    for (int i = tid; i < 36 * 256; i += NTHR) ((LAS f32x4*)WL)[i] = ((const f32x4*)p.WrT)[i];
    __syncthreads();
    for (int c = blockIdx.x; c < M / 128; c += gridDim.x) {
        if (tid < 32) cnt[tid] = 0u;
        __syncthreads();
#pragma unroll 1
        for (int it = 0; it < 8; ++it) {
            const int m = c * 128 + wave * 16 + it * 2;
            f32x4 hv[2][4];
#pragma unroll
            for (int rr = 0; rr < 2; ++rr) {
                const f32x4* xr = (const f32x4*)(X1 + (size_t)(m + rr) * D) + lane;
#pragma unroll
                for (int j = 0; j < 4; ++j) hv[rr][j] = xr[64 * j];
            }
#pragma unroll
            for (int rr = 0; rr < 2; ++rr) {
                float s = 0.f;
#pragma unroll
                for (int j = 0; j < 4; ++j) s += (hv[rr][j].x * hv[rr][j].x + hv[rr][j].y * hv[rr][j].y) + (hv[rr][j].z * hv[rr][j].z + hv[rr][j].w * hv[rr][j].w);
                const float rinv = 1.0f / sqrtf(wave_sum(s) * (1.f / D) + EPS);
                unsigned long long* o8 = (unsigned long long*)(p.H2B + (size_t)(m + rr) * D) + lane;
#pragma unroll
                for (int j = 0; j < 4; ++j) { const f32x4 g = ((const f32x4*)p.n2g)[lane + 64 * j]; hv[rr][j] = hv[rr][j] * rinv * g;
                    o8[64 * j] = (unsigned long long)pk2(hv[rr][j].x, hv[rr][j].y) | ((unsigned long long)pk2(hv[rr][j].z, hv[rr][j].w) << 32); }
            }
            float gl[2][4];
#pragma unroll
            for (int cc = 0; cc < 4; ++cc) {
#pragma unroll
                for (int rr = 0; rr < 2; ++rr) gl[rr][cc] = dot16(hv[rr], WL + cc * 1024, lane);
                asm volatile("" ::: "memory");
            }
#pragma unroll
            for (int rr = 0; rr < 2; ++rr)
#pragma unroll
                for (int cc = 0; cc < 4; ++cc) gl[rr][cc] = wave_sum(gl[rr][cc]) + p.rg_b[cc];
            int gi[2]; float gwt[2];
#pragma unroll
            for (int rr = 0; rr < 2; ++rr) {
                int g = 0; float gm = gl[rr][0];
#pragma unroll
                for (int i = 1; i < 4; ++i) if (gl[rr][i] > gm) { gm = gl[rr][i]; g = i; }
                float gs = 0.f;
#pragma unroll
                for (int i = 0; i < 4; ++i) gs += __expf(gl[rr][i] - gm);
                gi[rr] = __builtin_amdgcn_readfirstlane(g); gwt[rr] = 1.f / gs;
            }
            float el[2][8];
#pragma unroll
            for (int cc = 0; cc < 8; ++cc) {
#pragma unroll
                for (int rr = 0; rr < 2; ++rr) el[rr][cc] = dot16(hv[rr], WL + (4 + gi[rr] * 8 + cc) * 1024, lane);
                asm volatile("" ::: "memory");
            }
#pragma unroll
            for (int rr = 0; rr < 2; ++rr)
#pragma unroll
                for (int cc = 0; cc < 8; ++cc) el[rr][cc] = wave_sum(el[rr][cc]) + p.re_b[gi[rr] * 8 + cc];
#pragma unroll
            for (int rr = 0; rr < 2; ++rr) {
                int i1 = 0; float m1 = el[rr][0];
#pragma unroll
                for (int j = 1; j < 8; ++j) if (el[rr][j] > m1) { m1 = el[rr][j]; i1 = j; }
                int i2 = 0; float m2 = -INFINITY;
#pragma unroll
                for (int j = 0; j < 8; ++j) if (j != i1 && el[rr][j] > m2) { m2 = el[rr][j]; i2 = j; }
                const float e2r = __expf(m2 - m1), e1 = 1.f / (1.f + e2r), e2 = e2r * e1;
                if (lane == 0) {
                    const int ea = gi[rr] * 8 + i1, eb = gi[rr] * 8 + i2;
                    p.EID[2 * (m + rr)] = ea; p.EID[2 * (m + rr) + 1] = eb;
                    p.EW[2 * (m + rr)] = gwt[rr] * e1; p.EW[2 * (m + rr) + 1] = gwt[rr] * e2;
                    __hip_atomic_fetch_add(cnt + ea, 1u, __ATOMIC_RELAXED, __HIP_MEMORY_SCOPE_WORKGROUP);
                    __hip_atomic_fetch_add(cnt + eb, 1u, __ATOMIC_RELAXED, __HIP_MEMORY_SCOPE_WORKGROUP);
                }
            }
        }
        __syncthreads();
        if (tid < 32) p.BLKCNT[c * 32 + tid] = (int)cnt[tid];
        __syncthreads();
    }
}

__device__ __forceinline__ void ph_scan(const P& p, LAS unsigned char* lds, const int wv) {}
__device__ __forceinline__ void ph_scatter(const P& p, LAS unsigned char* lds, const int wv) {
    const int tid = opaque_tid(wv);
    LAS int* s = (LAS int*)lds;
    LAS int* se = s + 2048;
    const int e = tid & 31, part = tid >> 5;
    int loc[16]; int sum = 0;
#pragma unroll
    for (int i = 0; i < 16; ++i) { loc[i] = p.BLKCNT[(part * 16 + i) * 32 + e]; sum += loc[i]; }
    s[128 + part * 32 + e] = sum;
    __syncthreads();
    if (tid < 32) { int t = 0; for (int k = 0; k < 16; ++k) { const int v = s[128 + k * 32 + tid]; s[128 + k * 32 + tid] = t; t += v; } s[tid] = t; }
    __syncthreads();
    if (tid == 0) { int off = 0; for (int k = 0; k < 32; ++k) { s[32 + k] = off; off += (s[k] + 255) >> 8; } s[64] = off; }
    __syncthreads();
    if (blockIdx.x == 0) {
        const int ntiles = s[64];
        if (tid < 32) { p.MOEI[tid] = s[32 + tid] * 256; p.MOEI[32 + tid] = s[32 + tid]; }
        if (tid == 0) { p.MOEI[64] = ntiles; p.MOEI[65] = ntiles * 2; p.MOEI[66] = ntiles * 4; }
        for (int rt = tid; rt < ntiles; rt += NTHR) {
            int ex = 0;
            for (int k = 0; k < 32; ++k) { const int tb = s[32 + k], nt = (s[k] + 255) >> 8; if (rt >= tb && rt < tb + nt) ex = k; }
            p.GU[4 * rt + 0] = rt; p.GU[4 * rt + 1] = ex * 2; p.GU[4 * rt + 2] = rt; p.GU[4 * rt + 3] = ex * 2 + 1;
#pragma unroll
            for (int j = 0; j < 4; ++j) { p.DN[8 * rt + 2 * j] = rt; p.DN[8 * rt + 2 * j + 1] = ex * 4 + j; }
        }
        for (int k = 0; k < 32; ++k) {
            const int lo = s[32 + k] * 256 + s[k], hi = (s[32 + k] + ((s[k] + 255) >> 8)) * 256;
            for (int i = lo + tid; i < hi; i += NTHR) p.PTOK[i] = -1;
        }
    }
    for (int c = blockIdx.x; c < M / 128; c += gridDim.x) {
        if (part == (c >> 4)) {
            int run = s[32 + e] * 256 + s[128 + part * 32 + e];
#pragma unroll
            for (int i = 0; i < 16; ++i) run += (i < (c & 15)) ? loc[i] : 0;
            s[1024 + e] = run;
        }
        int ex = 0;
        if (tid < 256) { ex = p.EID[c * 256 + tid]; se[tid] = ex; }
        __syncthreads();
        if (tid < 256) {
            int rank = 0;
            for (int t = 0; t < tid; ++t) rank += (se[t] == ex) ? 1 : 0;
            p.PTOK[s[1024 + ex] + rank] = c * 256 + tid;
        }
        __syncthreads();
    }
}

template <bool DRY> __device__ __forceinline__ void ph_final(const P& p, const int wv) {
    const int tid = opaque_tid(wv), lane = tid & 63, wave = tid >> 6;
    const int gw = blockIdx.x * NWAVES + wave, NGW = gridDim.x * NWAVES;
    for (int m4 = gw; m4 < M / 4; m4 += NGW) {
        f32x4 v[4][4]; float s[4];
#pragma unroll
        for (int rr = 0; rr < 4; ++rr) {
            const int m = 4 * m4 + rr;
            const f32x4* xr = (const f32x4*)(p.out + (size_t)m * D) + lane;
            const u32x2* y0 = (const u32x2*)(p.YS + (size_t)m * D) + lane; const u32x2* y1 = (const u32x2*)(p.YS + ((size_t)M + m) * D) + lane;
            s[rr] = 0.f;
#pragma unroll
            for (int j = 0; j < 4; ++j) {
                v[rr][j] = xr[64 * j]; const u32x2 a = y0[64 * j], b = y1[64 * j];
                v[rr][j].x += bflo(a.x) + bflo(b.x); v[rr][j].y += bfhi(a.x) + bfhi(b.x); v[rr][j].z += bflo(a.y) + bflo(b.y); v[rr][j].w += bfhi(a.y) + bfhi(b.y);
                s[rr] += (v[rr][j].x * v[rr][j].x + v[rr][j].y * v[rr][j].y) + (v[rr][j].z * v[rr][j].z + v[rr][j].w * v[rr][j].w);
            }
        }
#pragma unroll
        for (int rr = 0; rr < 4; ++rr) {
            const float rinv = 1.0f / sqrtf(wave_sum(s[rr]) * (1.f / D) + EPS);
            f32x4* xr = (f32x4*)((DRY ? (float*)p.GBB : p.out) + (size_t)(4 * m4 + rr) * D) + lane;
#pragma unroll
            for (int j = 0; j < 4; ++j) { const f32x4 g = ((const f32x4*)p.fg)[lane + 64 * j]; xr[64 * j] = v[rr][j] * rinv * g; }
        }
    }
}

#ifndef GEMM_SP2
#define GEMM_SP2 true
#endif
__device__ __forceinline__ void ph_gemm_in(const P& p, LAS unsigned char* lds, const int wv) {
    pg8::Gemm g{p.HB, p.WinT, M, NIN, 1024}; pg8::StaticOrder S; S.init(M, NIN, gridDim.x, (int)blockIdx.x);
    EpiIn E{p.QL, p.QI, p.KI, p.UB, p.VB, p.GAB, p.GBB, p.CKVR, p.WI};
    pg8::gemm_phase<EpiIn, pg8::StaticOrder, true, GEMM_SP2>(lds, g, S, E, wv);
    {
        const int G = gridDim.x, nwg = (M / 256) * (NIN / 256), nextra = nwg % G;
        const int c = blockIdx.x, nshort = nextra == 0 ? G : G - nextra;
        if (nextra == 0 || c >= nextra) {
            const int tid = opaque_tid(wv), lane = tid & 63, wave = __builtin_amdgcn_readfirstlane(tid >> 6);
            __syncthreads();
            prep_gateup(p, lds, (nextra == 0 ? c : c - nextra) * NWAVES + wave, nshort * NWAVES, wave, lane);
        }
    }
}
__device__ __forceinline__ void ph_gemm_yb(const P& p, LAS unsigned char* lds, const int wv) {
    pg8::Gemm g{p.US, p.WpbT, M, 1024, 512}; pg8::StaticOrder S; S.init(M, 1024, gridDim.x, (int)blockIdx.x);
    EpiMB E{p.GBB, p.MB};
    pg8::gemm_phase<EpiMB, pg8::StaticOrder, true, GEMM_SP2>(lds, g, S, E, wv);
}
__device__ __forceinline__ void ph_gemm_ya(const P& p, LAS unsigned char* lds, const int wv) {
    pg8::Gemm g{p.OL, p.WovT, M, 1024, 1024}; pg8::StaticOrder S; S.init(M, 1024, gridDim.x, (int)blockIdx.x);
    EpiMG E{p.GAB, p.MB, p.MG};
    pg8::gemm_phase<EpiMG, pg8::StaticOrder, true, GEMM_SP2>(lds, g, S, E, wv);
}
__device__ __forceinline__ void ph_gemm_out(const P& p, LAS unsigned char* lds, const int wv) {
    pg8::Gemm g{p.MG, p.WoutT, M, 1024, 1024}; pg8::StaticOrder S; S.init(M, 1024, gridDim.x, (int)blockIdx.x);
    EpiX1 E{p.x, p.out};
    pg8::gemm_phase<EpiX1, pg8::StaticOrder, true, GEMM_SP2>(lds, g, S, E, wv);
}
__device__ __forceinline__ void ph_gemm_gu(const P& p, LAS unsigned char* lds, const int wv) {
    pg8::Gemm g{p.H2B, p.WguT, NPOS, 32 * 512, 1024}; TableGatherOrder S{p.GU, p.MOEI + 65, p.PTOK, (int)gridDim.x, (int)blockIdx.x};
    EpiHE E{p.HE};
    pg8::gemm_phase<EpiHE, TableGatherOrder, true, true>(lds, g, S, E, wv);
}
__device__ __forceinline__ void ph_gemm_dn(const P& p, LAS unsigned char* lds, const int wv) {
    pg8::Gemm g{p.HE, p.WdT, NPOS, 32 * 1024, 256}; TableOrder S{p.DN, p.MOEI + 66, (int)gridDim.x, (int)blockIdx.x};
    EpiDown E{p.PTOK, p.EW, p.YS};
    pg8::gemm_phase<EpiDown, TableOrder, true, GEMM_SP2>(lds, g, S, E, wv);
}

constexpr int NPHASE = 15;
template <int PH> __device__ __forceinline__ void run_phase(const P& p, LAS unsigned char* lds, const int wv) {
    if constexpr (PH == 0) ph_prep(p, lds, wv);
    if constexpr (PH == 1) ph_gemm_in(p, lds, wv);
    if constexpr (PH == 2) ph_ckvnorm(p, wv);
    if constexpr (PH == 3) ph_index7(p, lds, wv);
    if constexpr (PH == 4) ph_attn(p, lds, wv);
    if constexpr (PH == 5) ph_gmlp(p, lds, wv);
    if constexpr (PH == 6) ph_gemm_yb(p, lds, wv);
    if constexpr (PH == 7) ph_gemm_ya(p, lds, wv);
    if constexpr (PH == 8) ph_gemm_out(p, lds, wv);
    if constexpr (PH == 9) ph_router(p, lds, wv);
    if constexpr (PH == 10) ph_scan(p, lds, wv);
    if constexpr (PH == 11) ph_scatter(p, lds, wv);
    if constexpr (PH == 12) ph_gemm_gu(p, lds, wv);
    if constexpr (PH == 13) ph_gemm_dn(p, lds, wv);
    if constexpr (PH == 14) ph_final<false>(p, wv);
}
template <int PH> __global__ void __launch_bounds__(NTHR, 2) k_phase(P p) {
    extern __shared__ __attribute__((aligned(16))) unsigned char lds_raw[];
    run_phase<PH>(p, (LAS unsigned char*)lds_raw, __builtin_amdgcn_readfirstlane(threadIdx.x >> 6));
}

constexpr int MISC_OFF = LDS_BYTES - 256;
__global__ void __launch_bounds__(NTHR, 2) k_mega(P p) {
    extern __shared__ __attribute__((aligned(16))) unsigned char lds_raw[];
    LAS unsigned char* lds = (LAS unsigned char*)lds_raw;
    volatile LAS unsigned* MISC = (volatile LAS unsigned*)(lds + MISC_OFF);
    int wv = __builtin_amdgcn_readfirstlane(threadIdx.x >> 6); asm volatile("" : "+s"(wv));
    if (threadIdx.x < 64) MISC[threadIdx.x] = 0u;
    __syncthreads();
    XcdBarrier bar = xcd_barrier_post(p.ctl + CW_BAR, MISC, wv);
    run_phase<0>(p, lds, wv);
#if defined(DUP0)
    __syncthreads(); run_phase<0>(p, lds, wv);
#endif
    xcd_barrier(bar);
    run_phase<1>(p, lds, wv);
#if defined(DUP1)
    __syncthreads(); run_phase<1>(p, lds, wv);
#endif
    xcd_barrier(bar);
    run_phase<2>(p, lds, wv);
#if defined(DUP2)
    run_phase<2>(p, lds, wv);
#endif
    run_phase<3>(p, lds, wv);
#if defined(DUP3)
    __syncthreads(); run_phase<3>(p, lds, wv);
#endif
    xcd_barrier(bar);
    run_phase<4>(p, lds, wv);  __syncthreads();
#if defined(DUP4)
    run_phase<4>(p, lds, wv);  __syncthreads();
#endif
    run_phase<5>(p, lds, wv);
#if defined(DUP5)
    __syncthreads(); run_phase<5>(p, lds, wv);
#endif
    xcd_barrier(bar);
    run_phase<6>(p, lds, wv);
    run_phase<7>(p, lds, wv);  xcd_barrier(bar);
    run_phase<8>(p, lds, wv);
#if defined(DUP678)
    __syncthreads(); run_phase<6>(p, lds, wv); run_phase<7>(p, lds, wv); xcd_barrier(bar); run_phase<8>(p, lds, wv);
#endif
    xcd_barrier(bar);
    run_phase<9>(p, lds, wv);
#if defined(DUP9)
    __syncthreads(); run_phase<9>(p, lds, wv);
#endif
    xcd_barrier(bar);
    run_phase<11>(p, lds, wv);
#if defined(DUP11)
    __syncthreads(); run_phase<11>(p, lds, wv);
#endif
    xcd_barrier(bar);
    run_phase<12>(p, lds, wv);
#if defined(DUP12)
    __syncthreads(); run_phase<12>(p, lds, wv);
#endif
    xcd_barrier(bar);
    run_phase<13>(p, lds, wv);
#if defined(DUP13)
    __syncthreads(); run_phase<13>(p, lds, wv);
#endif
    xcd_barrier(bar);
#if defined(XBAR10)
    for (int i = 0; i < 10; ++i) xcd_barrier(bar);
#endif
#if defined(DUP14)
    ph_final<true>(p, wv); __syncthreads();
#endif
    run_phase<14>(p, lds, wv);
}

extern "C" void kernel_launch(void* const* d_in, const int* in_sizes, int n_in, void* d_out, int out_size, void* d_ws, size_t ws_size, hipStream_t stream) {
    static int grid = 0; static bool first = true;
    if (grid == 0) {
        if (n_in != 23 || in_sizes[0] != M * D || out_size != M * D || ws_size < WS_END) { fprintf(stderr, "kernel_launch: unexpected shapes (n_in %d, in0 %d, out %d, ws %zu)\n", n_in, n_in > 0 ? in_sizes[0] : -1, out_size, ws_size); grid = -1; return; }
        int dev = 0, cus = 0;
        if (hipGetDevice(&dev) != hipSuccess || hipDeviceGetAttribute(&cus, hipDeviceAttributeMultiprocessorCount, dev) != hipSuccess) { grid = -1; return; }
        grid = cus;
    }
    if (grid < 0) return;
    unsigned char* ws = (unsigned char*)d_ws;
    (void)hipMemsetAsync(ws + WS_CTL, 0, CTL_ZERO_BYTES, stream);
    P p{};
    const float* const* in = (const float* const*)d_in;
    p.x = in[0]; p.w_in = in[1]; p.kv_g = in[2]; p.w_uk = in[3]; p.w_uv = in[4]; p.rel_bias = in[5]; p.ln_g = in[6]; p.ln_b = in[7]; p.w_sp = in[8]; p.b_sp = in[9];
    p.w_pa = in[10]; p.w_pb = in[11]; p.w_out = in[12]; p.n1g = in[13]; p.n2g = in[14]; p.rg_w = in[15]; p.rg_b = in[16]; p.re_w = in[17]; p.re_b = in[18];
    p.w_gate = in[19]; p.w_up = in[20]; p.w_down = in[21]; p.fg = in[22];
    p.out = (float*)d_out; p.ctl = (unsigned*)(ws + WS_CTL);
    p.WinT = (bf16_t*)(ws + WS_WIN); p.WoutT = (bf16_t*)(ws + WS_WOUT); p.WpbT = (bf16_t*)(ws + WS_WPB); p.WovT = (bf16_t*)(ws + WS_WOV); p.WSB = (bf16_t*)(ws + WS_WSB);
    p.WguT = (bf16_t*)(ws + WS_WGU); p.WdT = (bf16_t*)(ws + WS_WD); p.WrT = (float*)(ws + WS_WRT);
    p.HB = (bf16_t*)(ws + WS_A); p.OL = (bf16_t*)(ws + WS_A); p.H2B = (bf16_t*)(ws + WS_A);
    p.QL = (bf16_t*)(ws + WS_B); p.MB = (bf16_t*)(ws + WS_B); p.H2S = (bf16_t*)(ws + WS_B); p.YS = (bf16_t*)(ws + WS_B);
    p.GAB = (bf16_t*)(ws + WS_GA); p.GBB = (bf16_t*)(ws + WS_GB);
    p.UB = (bf16_t*)(ws + WS_C); p.VB = (bf16_t*)(ws + WS_C + 32 * MiB); p.MG = (bf16_t*)(ws + WS_C); p.HE = (bf16_t*)(ws + WS_C);
    p.QI = (bf16_t*)(ws + WS_DQ); p.US = (bf16_t*)(ws + WS_DQ);
    p.CKVR = (float*)(ws + WS_CKVR); p.CKVB = (bf16_t*)(ws + WS_CKVB); p.KI = (bf16_t*)(ws + WS_KI); p.WI = (float*)(ws + WS_WI); p.SEL = (unsigned short*)(ws + WS_SEL);
    p.EID = (int*)(ws + WS_MOE); p.EW = (float*)(ws + WS_MOE + 262144); p.PTOK = (int*)(ws + WS_MOE + 524288); p.MOEI = (int*)(ws + WS_MOE + 1048576);
    p.GU = (int*)(ws + WS_MOE + 1048576 + 4096); p.BLKCNT = (int*)(ws + WS_MOE + 1048576 + 65536); p.IDXROW = (float*)(ws + WS_A); p.CB = (int*)(ws + WS_MOE + 1048576 + 131072); p.DN = (int*)(ws + WS_MOE + 1048576 + 4096 + 8192);
    if (first) { (void)hipFuncSetAttribute((const void*)k_mega, hipFuncAttributeMaxDynamicSharedMemorySize, LDS_BYTES); first = false; }
    hipLaunchKernelGGL(k_mega, dim3(grid), dim3(NTHR), LDS_BYTES, stream, p);
}
```

```cpp
#include <hip/hip_runtime.h>
#include <cstdio>
#include <cstdint>
__device__ __forceinline__ int opaque_tid(const int wv) { int l; asm volatile("v_mbcnt_lo_u32_b32 %0, -1, 0\n\tv_mbcnt_hi_u32_b32 %0, -1, %0" : "=v"(l)); return (wv << 6) + l; }
#define LAS __attribute__((address_space(3)))
namespace pg8 {
#define PG8_LAS __attribute__((address_space(3)))
typedef unsigned short bf16_t;
typedef short bf16x8 __attribute__((ext_vector_type(8)));
typedef float f32x4 __attribute__((ext_vector_type(4)));
typedef unsigned u32x4 __attribute__((ext_vector_type(4)));
constexpr int BM = 256, BK = 64, HALF = 128, HTB = HALF * BK * 2  , STAGE_BYTES = 8 * HTB, NXCD = 8, WGM = 8;

__host__ __device__ __forceinline__ int lds_byte(int r, int c) { const int st = (r >> 4) * 2 + (c >> 5), rr = r & 15, cc = c & 31, ob = rr * 64 + cc * 2; return st * 1024 + (ob ^ (((ob >> 9) & 1) << 5)); }
__host__ __device__ __forceinline__ void stage_rc(int b, int& R, int& C) { const int st = b / 1024, sb = b % 1024, swz = sb ^ (((sb >> 9) & 1) << 5); R = (st >> 1) * 16 + swz / 64; C = (st & 1) * 32 + (swz % 64) / 2; }
__host__ __device__ __forceinline__ int perm32(int rho) { const int n = rho >> 4, i = rho & 15; return 8 * (i >> 2) + 4 * n + (i & 3); }

struct Unit { int pm, pn; };
struct Gemm { const bf16_t* A; const bf16_t* Bt; int M, N, K; };

struct StaticOrder {
    static constexpr bool GATHER = false;
    int nM, nN, nwg, G, c;
    __host__ __device__ void init(int M, int N, int G_, int c_) { nM = M / BM; nN = N / BM; nwg = nM * nN; G = G_; c = c_; }
    __host__ __device__ bool next(int i, Unit& u) const {
        const long L = (long)i * G + c; if (L >= nwg) return false;
        int wgid = (int)L; { const int q = nwg / NXCD, r = nwg % NXCD, xcd = wgid % NXCD, off = wgid / NXCD; wgid = (xcd < r ? xcd * (q + 1) : r * (q + 1) + (xcd - r) * q) + off; }
        const int nig = WGM * nN, gid = wgid / nig, fm = gid * WGM, gsz = (nM - fm) < WGM ? (nM - fm) : WGM;
        u.pm = fm + ((wgid % nig) % gsz); u.pn = (wgid % nig) / gsz; return true;
    }
    __device__ __forceinline__ int arow(int r) const { return r; }
    __device__ __forceinline__ void a_ready(const Unit&) const {}
    __device__ __forceinline__ void done(const Unit&) const {}
};

__device__ __forceinline__ unsigned cvt_pk_bf16(float lo, float hi) { unsigned r; asm volatile("v_cvt_pk_bf16_f32 %0, %1, %2" : "=v"(r) : "v"(lo), "v"(hi)); return r; }
typedef float f32x2 __attribute__((ext_vector_type(2)));
template <class Epi, class Sched, bool ALIGN_EPI = false, bool SP2 = false>
__device__ __forceinline__ void gemm_phase(PG8_LAS unsigned char* lds, const Gemm g, const Sched& S, const Epi& E, const int wv) {
    const int tid = opaque_tid(wv), wid = __builtin_amdgcn_readfirstlane(tid >> 6), lane = tid & 63, wr = wid >> 2, wc = wid & 3, fr = lane & 15, fq = lane >> 4;
    const int K = g.K, nt = K / BK;
    unsigned voffA[2], voffB[2];
#pragma unroll
    for (int i = 0; i < 2; ++i) { int R, C; stage_rc(tid * 16 + i * 8192, R, C); const int Rb = Epi::PERM ? ((R & ~31) + perm32(R & 31)) : R;
        voffA[i] = (unsigned)(R * K + C) * 2u; voffB[i] = (unsigned)(Rb * K + C) * 2u; }
    static_assert(!Sched::GATHER || SP2, "gathered A rows: SP2 loop only");
    unsigned gcur[2][2], gnxt[2][2]; int gR[2], gC[2];
    if constexpr (Sched::GATHER) {
#pragma unroll
        for (int i = 0; i < 2; ++i) { stage_rc(tid * 16 + i * 8192, gR[i], gC[i]); }
    }
#define PG8_GOFF(dst, u_) do { _Pragma("unroll") for (int h_ = 0; h_ < 2; ++h_) _Pragma("unroll") for (int i_ = 0; i_ < 2; ++i_) \
        dst[h_][i_] = ((unsigned)S.arow((u_).pm * BM + h_ * HALF + gR[i_]) * (unsigned)K + (unsigned)gC[i_]) * 2u; } while (0)
    const size_t kstep = (size_t)(BK * 2);
    const size_t hstep = (size_t)HALF * K * 2;
    const size_t tstep = 2 * hstep;
    const unsigned ldsw = (unsigned)wid * 1024u;
    const int aoff = lds_byte(wr * 64 + fr, fq * 8), boff = lds_byte(wc * 32 + fr, fq * 8);
#define PG8_SA(b, h) (((b) * 2 + (h)) * HTB)
#define PG8_SB(b, h) ((4 + (b) * 2 + (h)) * HTB)
#define PG8_STAGE(bufoff, gbase, voff) do { _Pragma("unroll") for (int _i = 0; _i < 2; ++_i) \
        __builtin_amdgcn_global_load_lds((const unsigned*)((const char*)(gbase) + (voff)[_i]), (PG8_LAS unsigned*)(lds + (bufoff) + ldsw + _i * 8192), 16, 0, 0); } while (0)
#define PG8_LDA(dst, b, h) do { _Pragma("unroll") for (int m = 0; m < 4; ++m) _Pragma("unroll") for (int k = 0; k < 2; ++k) dst[m][k] = *(const PG8_LAS bf16x8*)(lds + PG8_SA(b, h) + aoff + m * 2048 + k * 1024); } while (0)
#define PG8_LDB(dst, b, h) do { _Pragma("unroll") for (int n = 0; n < 2; ++n) _Pragma("unroll") for (int k = 0; k < 2; ++k) dst[n][k] = *(const PG8_LAS bf16x8*)(lds + PG8_SB(b, h) + boff + n * 2048 + k * 1024); } while (0)
#define PG8_MMA(ai, bj, At, Bt) do { __builtin_amdgcn_s_setprio(1); _Pragma("unroll") for (int m = 0; m < 4; ++m) _Pragma("unroll") for (int n = 0; n < 2; ++n) _Pragma("unroll") for (int k = 0; k < 2; ++k) \
        acc[ai][bj][m][n] = __builtin_amdgcn_mfma_f32_16x16x32_bf16(Bt[n][k], At[m][k], acc[ai][bj][m][n], 0, 0, 0); __builtin_amdgcn_s_setprio(0); } while (0)
#define PG8_WAIT_V(n) asm volatile("s_waitcnt vmcnt(" #n ")" ::: "memory")
#define PG8_WAIT_L(n) asm volatile("s_waitcnt lgkmcnt(" #n ")" ::: "memory")
#define PG8_BAR __builtin_amdgcn_s_barrier()
#define PG8_SCHED __builtin_amdgcn_sched_barrier(0)
    Unit cur, nxt; int ui = 0;
    if (!S.next(0, cur)) return;
    f32x4 acc[2][2][4][2];
#pragma unroll
    for (int a = 0; a < 2; ++a)
#pragma unroll
        for (int b = 0; b < 2; ++b)
#pragma unroll
            for (int m = 0; m < 4; ++m)
#pragma unroll
                for (int n = 0; n < 2; ++n) acc[a][b][m][n] = (f32x4){0.f, 0.f, 0.f, 0.f};
    bf16x8 At[4][2], B0[2][2], B1[2][2];
    const char* cA = Sched::GATHER ? (const char*)g.A : (const char*)g.A + (size_t)cur.pm * tstep; const char* cB = (const char*)g.Bt + (size_t)cur.pn * tstep;
    S.a_ready(cur);
    if constexpr (Sched::GATHER) { PG8_GOFF(gcur, cur); }
#define PG8_STAGE_A(bufoff, base_, h_, koff_, GO_) do { if constexpr (Sched::GATHER) { PG8_STAGE(bufoff, (const char*)g.A + (koff_), GO_[h_]); } else { PG8_STAGE(bufoff, (base_) + (h_) * hstep + (koff_), voffA); } } while (0)
    if constexpr (SP2) {
        PG8_STAGE(PG8_SB(0, 0), cB, voffB); PG8_STAGE(PG8_SB(0, 1), cB + hstep, voffB); PG8_STAGE_A(PG8_SA(0, 0), cA, 0, 0, gcur); PG8_STAGE_A(PG8_SA(0, 1), cA, 1, 0, gcur);
        if (wr == 1) PG8_BAR;
        PG8_WAIT_V(2); PG8_BAR;
        PG8_STAGE(PG8_SB(1, 0), cB + kstep, voffB); PG8_STAGE_A(PG8_SA(1, 0), cA, 0, kstep, gcur); PG8_STAGE(PG8_SB(1, 1), cB + hstep + kstep, voffB);
        PG8_WAIT_V(6); PG8_BAR;
    } else {
        PG8_STAGE(PG8_SB(0, 0), cB, voffB); PG8_STAGE(PG8_SA(0, 0), cA, voffA); PG8_STAGE(PG8_SB(0, 1), cB + hstep, voffB); PG8_STAGE(PG8_SA(0, 1), cA + hstep, voffA);
        if (wr == 1) PG8_BAR;
        PG8_WAIT_V(4); PG8_BAR;
        PG8_STAGE(PG8_SB(1, 0), cB + kstep, voffB); PG8_STAGE(PG8_SA(1, 0), cA + kstep, voffA); PG8_STAGE(PG8_SB(1, 1), cB + hstep + kstep, voffB);
        PG8_WAIT_V(6); PG8_BAR;
    }
    for (;;) {
        const bool has_next = S.next(ui + 1, nxt);
        const char* nA = Sched::GATHER ? cA : (has_next ? (const char*)g.A + (size_t)nxt.pm * tstep : cA); const char* nB = has_next ? (const char*)g.Bt + (size_t)nxt.pn * tstep : cB;
        if constexpr (Sched::GATHER) { if (has_next) { PG8_GOFF(gnxt, nxt); } else { _Pragma("unroll") for (int h_ = 0; h_ < 2; ++h_) _Pragma("unroll") for (int i_ = 0; i_ < 2; ++i_) gnxt[h_][i_] = gcur[h_][i_]; } }
        for (int t = 0; t < nt; t += 2) {
            const bool last = (t == nt - 2);
            const char* a1 = cA + (size_t)(t + 1) * kstep;
            const char* a2 = last ? nA : cA + (size_t)(t + 2) * kstep; const char* b2 = last ? nB : cB + (size_t)(t + 2) * kstep;
            const char* a3 = a2 + kstep; const char* b3 = b2 + kstep;
            unsigned g2[2][2];
            if constexpr (Sched::GATHER) { _Pragma("unroll") for (int h_ = 0; h_ < 2; ++h_) _Pragma("unroll") for (int i_ = 0; i_ < 2; ++i_) g2[h_][i_] = last ? gnxt[h_][i_] : gcur[h_][i_]; }
            const size_t k1 = (size_t)(t + 1) * kstep, k2 = last ? (size_t)0 : (size_t)(t + 2) * kstep, k3 = k2 + kstep;
            if (last && has_next) S.a_ready(nxt);
            if constexpr (SP2) {
            PG8_LDB(B0, 0, 0); PG8_LDB(B1, 0, 1); PG8_SCHED; PG8_LDA(At, 0, 0); if constexpr (Sched::GATHER) { PG8_STAGE(PG8_SA(1, 1), (const char*)g.A + k1, gcur[1]); } else { PG8_STAGE(PG8_SA(1, 1), a1 + hstep, voffA); }
            PG8_WAIT_V(8); PG8_WAIT_L(0); PG8_BAR; PG8_MMA(0, 0, At, B0); PG8_MMA(0, 1, At, B1); PG8_BAR; PG8_SCHED;
            PG8_LDA(At, 0, 1); PG8_STAGE(PG8_SB(0, 0), b2, voffB); PG8_STAGE(PG8_SB(0, 1), b2 + hstep, voffB); if constexpr (Sched::GATHER) { PG8_STAGE(PG8_SA(0, 0), (const char*)g.A + k2, g2[0]); } else { PG8_STAGE(PG8_SA(0, 0), a2, voffA); }
            PG8_WAIT_V(8); PG8_WAIT_L(0); PG8_BAR; PG8_MMA(1, 0, At, B0); PG8_MMA(1, 1, At, B1); PG8_BAR; PG8_SCHED;
            PG8_LDB(B0, 1, 0); PG8_LDB(B1, 1, 1); PG8_SCHED; PG8_LDA(At, 1, 0); if constexpr (Sched::GATHER) { PG8_STAGE(PG8_SA(0, 1), (const char*)g.A + k2, g2[1]); } else { PG8_STAGE(PG8_SA(0, 1), a2 + hstep, voffA); }
            PG8_WAIT_V(8); PG8_WAIT_L(0); PG8_BAR; PG8_MMA(0, 0, At, B0); PG8_MMA(0, 1, At, B1); PG8_BAR; PG8_SCHED;
            PG8_LDA(At, 1, 1); PG8_STAGE(PG8_SB(1, 0), b3, voffB); PG8_STAGE(PG8_SB(1, 1), b3 + hstep, voffB); if constexpr (Sched::GATHER) { PG8_STAGE(PG8_SA(1, 0), (const char*)g.A + k3, g2[0]); } else { PG8_STAGE(PG8_SA(1, 0), a3, voffA); }
            PG8_WAIT_V(8); PG8_WAIT_L(0); PG8_BAR; PG8_MMA(1, 0, At, B0); PG8_MMA(1, 1, At, B1); PG8_BAR; PG8_SCHED;
            } else {
            PG8_LDB(B0, 0, 0); PG8_SCHED; PG8_LDA(At, 0, 0); PG8_STAGE(PG8_SA(1, 1), a1 + hstep, voffA);
            PG8_WAIT_L(8); PG8_BAR; PG8_WAIT_L(0); PG8_MMA(0, 0, At, B0); PG8_BAR; PG8_SCHED;
            PG8_LDB(B1, 0, 1); PG8_STAGE(PG8_SB(0, 0), b2, voffB);
            PG8_BAR; PG8_WAIT_L(0); PG8_MMA(0, 1, At, B1); PG8_BAR;
            PG8_LDA(At, 0, 1); PG8_STAGE(PG8_SA(0, 0), a2, voffA);
            PG8_BAR; PG8_WAIT_L(0); PG8_MMA(1, 0, At, B0); PG8_BAR; PG8_SCHED;
            PG8_STAGE(PG8_SB(0, 1), b2 + hstep, voffB);
            PG8_WAIT_V(6); PG8_BAR; PG8_MMA(1, 1, At, B1); PG8_BAR;
            PG8_LDB(B0, 1, 0); PG8_SCHED; PG8_LDA(At, 1, 0); PG8_STAGE(PG8_SA(0, 1), a2 + hstep, voffA);
            PG8_WAIT_L(8); PG8_BAR; PG8_WAIT_L(0); PG8_MMA(0, 0, At, B0); PG8_BAR; PG8_SCHED;
            PG8_LDB(B1, 1, 1); PG8_STAGE(PG8_SB(1, 0), b3, voffB);
            PG8_BAR; PG8_WAIT_L(0); PG8_MMA(0, 1, At, B1); PG8_BAR;
            PG8_LDA(At, 1, 1); PG8_STAGE(PG8_SA(1, 0), a3, voffA);
            PG8_BAR; PG8_WAIT_L(0); PG8_MMA(1, 0, At, B0); PG8_BAR; PG8_SCHED;
            PG8_STAGE(PG8_SB(1, 1), b3 + hstep, voffB);
            PG8_WAIT_V(6); PG8_BAR; PG8_MMA(1, 1, At, B1); PG8_BAR;
            }
        }
        if constexpr (ALIGN_EPI) { if (wr == 0) PG8_BAR; }
        if constexpr (!Epi::AFTER_DRAIN) { E(acc, cur, wr, wc, fr, fq); S.done(cur); }
        if (!has_next) break;
#pragma unroll
        for (int a = 0; a < 2; ++a)
#pragma unroll
            for (int b = 0; b < 2; ++b)
#pragma unroll
                for (int m = 0; m < 4; ++m)
#pragma unroll
                    for (int n = 0; n < 2; ++n) acc[a][b][m][n] = (f32x4){0.f, 0.f, 0.f, 0.f};
        cur = nxt; cA = nA; cB = nB; ++ui;
        if constexpr (Sched::GATHER) { _Pragma("unroll") for (int h_ = 0; h_ < 2; ++h_) _Pragma("unroll") for (int i_ = 0; i_ < 2; ++i_) gcur[h_][i_] = gnxt[h_][i_]; }
        if constexpr (ALIGN_EPI) { if (wr == 1) PG8_BAR; }
    }
    PG8_WAIT_V(0);
    if constexpr (!ALIGN_EPI) { if (wr == 0) PG8_BAR; }
    PG8_BAR;
    if constexpr (Epi::AFTER_DRAIN) { E.fused(acc, cur, wr, wc, fr, fq, lds, wid, lane); S.done(cur); }
#undef PG8_SA
#undef PG8_SB
#undef PG8_STAGE
#undef PG8_STAGE_A
#undef PG8_GOFF
#undef PG8_LDA
#undef PG8_LDB
#undef PG8_MMA
#undef PG8_WAIT_V
#undef PG8_WAIT_L
#undef PG8_BAR
#undef PG8_SCHED
}
}
#define XB_TMO      128
#define XB_XCNT(j)  (256  + 64 * (j))
#define XB_XSUB(j)  (1280 + 64 * (j))
#define XB_XGEN(j)  (2304 + 64 * (j))
#define XB_TOP      3328
#define XB_TOPGEN   3392
#define XCD_BAR_WORDS 3456
#define XB_SPIN_CAP (1u << 18)

__device__ __forceinline__ unsigned xb_ld(unsigned* p)              { return __hip_atomic_load(p, __ATOMIC_RELAXED, __HIP_MEMORY_SCOPE_AGENT); }
__device__ __forceinline__ unsigned xb_add(unsigned* p, unsigned v) { return __hip_atomic_fetch_add(p, v, __ATOMIC_RELAXED, __HIP_MEMORY_SCOPE_AGENT); }
__device__ __forceinline__ unsigned xb_xcc_id() { return (unsigned)__builtin_amdgcn_s_getreg((3 << 11) | 20) & 0xFu; }
#define XB_SPIN(cond, bar) do { unsigned _sp = 0; while (cond) { __builtin_amdgcn_s_sleep(1); \
    if ((++_sp & 255u) == 0u) { if (xb_ld(&(bar)[XB_TMO])) break; if (_sp > XB_SPIN_CAP) { atomicAdd(&(bar)[XB_TMO], 1u); break; } } } } while (0)

struct XcdBarrier {
    unsigned* bar; unsigned x; int wv;
    volatile LAS unsigned* st;
};

__device__ __forceinline__ XcdBarrier xcd_barrier_post(unsigned* bar, volatile LAS unsigned* st, int wv) {
    XcdBarrier b; b.bar = bar; b.x = xb_xcc_id(); b.st = st; b.wv = wv;
    if (opaque_tid(wv) == 0) (void)xb_add(&bar[XB_XCNT(b.x)], 1u);
    return b;
}
__device__ __forceinline__ void xcd_barrier_complete(unsigned* bar, unsigned x, unsigned& nloc, unsigned& nx) {
    const unsigned G = gridDim.x * gridDim.y * gridDim.z;
    unsigned sum, cnt, mine, sp = 0u;
    for (;;) {
        sum = 0u; cnt = 0u; mine = 0u;
#pragma unroll
        for (unsigned j = 0; j < 16; ++j) { const unsigned c = xb_ld(&bar[XB_XCNT(j)]); sum += c; cnt += (c > 0u) ? 1u : 0u; mine = (j == x) ? c : mine; }
        if (sum == G) break;
        __builtin_amdgcn_s_sleep(1);
        if ((++sp & 255u) == 0u) { if (xb_ld(&bar[XB_TMO])) break; if (sp > XB_SPIN_CAP) { atomicAdd(&bar[XB_TMO], 1u); break; } }
    }
    nloc = mine > 0u ? mine : 1u; nx = cnt > 0u ? cnt : 1u;
}

__device__ __forceinline__ void xcd_barrier(const XcdBarrier& b) {
    asm volatile("s_waitcnt vmcnt(0)" ::: "memory");
    __syncthreads();
    if (opaque_tid(b.wv) == 0) {
        unsigned* bar = b.bar;
        __builtin_amdgcn_s_waitcnt(0);
        unsigned nloc = b.st[0], nx = b.st[1];
        if (nloc == 0u) { xcd_barrier_complete(bar, b.x, nloc, nx); b.st[0] = nloc; b.st[1] = nx; }
        const unsigned old = xb_add(&bar[XB_XSUB(b.x)], 1u);
        const unsigned gen = old / nloc;
        if (old + 1u == (gen + 1u) * nloc) {
            __builtin_amdgcn_fence(__ATOMIC_RELEASE, "agent");
            asm volatile("s_waitcnt vmcnt(0)" ::: "memory");
            const unsigned og = xb_add(&bar[XB_TOP], 1u);
            const unsigned tg = og / nx;
            if (og + 1u == (tg + 1u) * nx) xb_add(&bar[XB_TOPGEN], 1u);
            else XB_SPIN(xb_ld(&bar[XB_TOPGEN]) == tg, bar);
            __builtin_amdgcn_fence(__ATOMIC_ACQUIRE, "agent");
            xb_add(&bar[XB_XGEN(b.x)], 1u);
            asm volatile("s_waitcnt vmcnt(0)" ::: "memory");
        } else {
            XB_SPIN(xb_ld(&bar[XB_XGEN(b.x)]) == gen, bar);
            __builtin_amdgcn_fence(__ATOMIC_ACQUIRE, "agent");
            asm volatile("s_waitcnt vmcnt(0)" ::: "memory");
        }
    }
    __syncthreads();
}

typedef unsigned short bf16_t;
typedef short bf16x8 __attribute__((ext_vector_type(8)));
typedef short bf16x4 __attribute__((ext_vector_type(4)));
typedef float f32x4 __attribute__((ext_vector_type(4)));
typedef float f32x2 __attribute__((ext_vector_type(2)));
typedef float f32x16 __attribute__((ext_vector_type(16)));
typedef unsigned u32x4 __attribute__((ext_vector_type(4)));
typedef unsigned u32x2 __attribute__((ext_vector_type(2)));

constexpr int NB = 8, T = 4096, D = 1024, M = NB * T;
constexpr int INC = 4296;
constexpr int NIN = 19 * 256;
constexpr float EPS = 1e-6f;
constexpr int NPOS = 73728;
constexpr int NWAVES = 8, NTHR = 512;
constexpr int LDS_BYTES = 163840;

constexpr size_t MiB = 1u << 20;
constexpr size_t WS_CTL = 0, CTL_ZERO_BYTES = 65536;
constexpr size_t WS_WIN = 1 * MiB, WS_WOUT = 11 * MiB, WS_WPB = 13 * MiB, WS_WOV = 14 * MiB, WS_WSB = 16 * MiB, WS_WRT = 16 * MiB + 262144, WS_WGU = 17 * MiB, WS_WD = 49 * MiB;
constexpr size_t WS_A = 65 * MiB;
constexpr size_t WS_B = 129 * MiB;
constexpr size_t WS_GA = 193 * MiB, WS_GB = 257 * MiB;
constexpr size_t WS_C = 321 * MiB;
constexpr size_t WS_DQ = 385 * MiB;
constexpr size_t WS_CKVR = 417 * MiB, WS_CKVB = 433 * MiB, WS_KI = 441 * MiB, WS_WI = 445 * MiB, WS_SEL = 446 * MiB;
constexpr size_t WS_MOE = 462 * MiB;
constexpr size_t WS_END = 464 * MiB;

constexpr int CW_BAR = 4096;
constexpr int CW_CNT = 8192, CW_CUR = 8256;

struct P {
    const float *x, *w_in, *kv_g, *w_uk, *w_uv, *rel_bias, *ln_g, *ln_b, *w_sp, *b_sp, *w_pa, *w_pb, *w_out, *n1g, *n2g, *rg_w, *rg_b, *re_w, *re_b, *w_gate, *w_up, *w_down, *fg;
    float* out;
    unsigned* ctl;
    bf16_t *WinT, *WoutT, *WpbT, *WovT, *WSB, *WguT, *WdT;
    float* WrT;
    bf16_t *HB, *QL, *QI, *CKVB, *KI, *UB, *VB, *GAB, *GBB, *OL, *US, *MB, *MG, *H2B, *H2S, *HE, *YS;
    float *CKVR, *WI, *EW, *IDXROW;
    unsigned short* SEL;
    int *EID, *PTOK, *MOEI, *GU, *DN, *BLKCNT, *CB;
};

__device__ __forceinline__ unsigned f2bf(float f) { unsigned u = __builtin_bit_cast(unsigned, f); return (u + 0x7fffu + ((u >> 16) & 1u)) >> 16; }
__device__ __forceinline__ unsigned pk2(float lo, float hi) { return f2bf(lo) | (f2bf(hi) << 16); }
__device__ __forceinline__ float bflo(unsigned w) { return __builtin_bit_cast(float, w << 16); }
__device__ __forceinline__ float bfhi(unsigned w) { return __builtin_bit_cast(float, w & 0xffff0000u); }
__device__ __forceinline__ float bf2f(unsigned short b) { return __builtin_bit_cast(float, (unsigned)b << 16); }
__device__ __forceinline__ float wave_sum(float v) {
#pragma unroll
    for (int o = 1; o < 64; o <<= 1) v += __shfl_xor(v, o);
    return v;
}
#define LDS_WAIT() asm volatile("s_waitcnt lgkmcnt(0)" ::: "memory")
__device__ __forceinline__ float sigm(float x) { return __builtin_amdgcn_rcpf(1.f + __builtin_amdgcn_exp2f(-1.4426950409f * x)); }
__device__ __forceinline__ float gelu_t(float x) { const float x2 = x * x; return x * __builtin_amdgcn_rcpf(1.f + __builtin_amdgcn_exp2f(x * (-2.3022082f - 0.1029432f * x2))); }
__device__ __forceinline__ unsigned off_b(unsigned row, unsigned ch) { return 256u * row + 16u * (ch ^ (((row & 3) << 2) | ((row >> 2) & 3))); }
__device__ __forceinline__ bf16x4 tr_read(unsigned lds_addr) { bf16x4 r; asm volatile("ds_read_b64_tr_b16 %0, %1\n\ts_waitcnt lgkmcnt(0)" : "=&v"(r) : "v"(lds_addr) : "memory"); return r; }
__device__ __forceinline__ bf16x8 cat4(bf16x4 a, bf16x4 b) { bf16x8 r; r[0] = a[0]; r[1] = a[1]; r[2] = a[2]; r[3] = a[3]; r[4] = b[0]; r[5] = b[1]; r[6] = b[2]; r[7] = b[3]; return r; }
__device__ __forceinline__ unsigned lds_addr_of(LAS unsigned char* p) { return (unsigned)(unsigned long long)p; }

__device__ __forceinline__ void st8bf(bf16_t* p, const pg8::f32x4& a, const pg8::f32x4& b) {
    u32x4 w; w.x = pg8::cvt_pk_bf16(a[0], a[1]); w.y = pg8::cvt_pk_bf16(a[2], a[3]); w.z = pg8::cvt_pk_bf16(b[0], b[1]); w.w = pg8::cvt_pk_bf16(b[2], b[3]);
    *(u32x4*)p = w;
}
__device__ __forceinline__ void ld8bf(const bf16_t* p, pg8::f32x4& a, pg8::f32x4& b) {
    const u32x4 w = *(const u32x4*)p;
    a[0] = bflo(w.x); a[1] = bfhi(w.x); a[2] = bflo(w.y); a[3] = bfhi(w.y); b[0] = bflo(w.z); b[1] = bfhi(w.z); b[2] = bflo(w.w); b[3] = bfhi(w.w);
}

struct EpiIn {
    static constexpr bool PERM = true, AFTER_DRAIN = false;
    bf16_t *QL, *QI, *KI, *UB, *VB, *GAB, *GBB; float *CKVR, *WI;
    __device__ __forceinline__ void operator()(const pg8::f32x4 (&acc)[2][2][4][2], const pg8::Unit& u, int wr, int wc, int fr, int fq) const {
        const int row0 = u.pm * 256 + wr * 64 + fr, pn = u.pn, c8 = wc * 32 + 8 * fq;
        int mode; bf16_t* dst; int ld;
        if (pn < 4)       { mode = 0; dst = QL + pn * 256; ld = 1024; }
        else if (pn < 6)  { mode = 0; dst = QI + (pn - 4) * 256; ld = 512; }
        else if (pn == 6) { mode = 3; dst = KI; ld = 64; }
        else if (pn < 9)  { mode = 1; dst = UB + (pn - 7) * 256; ld = 512; }
        else if (pn < 11) { mode = 1; dst = VB + (pn - 9) * 256; ld = 512; }
        else if (pn < 15) { mode = 2; dst = GAB + (pn - 11) * 256; ld = 1024; }
        else              { mode = 2; dst = GBB + (pn - 15) * 256; ld = 1024; }
#pragma unroll
        for (int ai = 0; ai < 2; ++ai)
#pragma unroll
            for (int m = 0; m < 4; ++m) {
                const size_t row = (size_t)(row0 + ai * 128 + m * 16);
#pragma unroll
                for (int bj = 0; bj < 2; ++bj) {
                    pg8::f32x4 v0 = acc[ai][bj][m][0], v1 = acc[ai][bj][m][1];
                    if (mode == 3) {
                        if (bj == 0) { float* c = CKVR + row * 128 + c8; *(pg8::f32x4*)c = v0; *(pg8::f32x4*)(c + 4) = v1; }
                        else if (c8 < 64) st8bf(KI + row * 64 + c8, v0, v1);
                        else if (c8 == 64) { float* c = WI + row * 8; *(pg8::f32x4*)c = v0 * 0.044194174f; *(pg8::f32x4*)(c + 4) = v1 * 0.044194174f; }
                    } else {
                        if (mode == 1) {
#pragma unroll
                            for (int j = 0; j < 4; ++j) { v0[j] = gelu_t(v0[j]); v1[j] = gelu_t(v1[j]); }
                        } else if (mode == 2) {
#pragma unroll
                            for (int j = 0; j < 4; ++j) { v0[j] = sigm(v0[j]); v1[j] = sigm(v1[j]); }
                        }
                        st8bf(dst + row * ld + bj * 128 + c8, v0, v1);
                    }
                }
            }
    }
};

struct EpiMB {
    static constexpr bool PERM = true, AFTER_DRAIN = false;
    const bf16_t* G; bf16_t* O;
    __device__ __forceinline__ void operator()(const pg8::f32x4 (&acc)[2][2][4][2], const pg8::Unit& u, int wr, int wc, int fr, int fq) const {
        const int row0 = u.pm * 256 + wr * 64 + fr, col0 = u.pn * 256 + wc * 32 + 8 * fq;
#pragma unroll
        for (int ai = 0; ai < 2; ++ai)
#pragma unroll
            for (int m = 0; m < 4; ++m)
#pragma unroll
                for (int bj = 0; bj < 2; ++bj) {
                    const size_t o = (size_t)(row0 + ai * 128 + m * 16) * 1024 + col0 + bj * 128;
                    pg8::f32x4 g0, g1; ld8bf(G + o, g0, g1);
                    st8bf(O + o, acc[ai][bj][m][0] * g0, acc[ai][bj][m][1] * g1);
                }
    }
};
struct EpiMG {
    static constexpr bool PERM = true, AFTER_DRAIN = false;
    const bf16_t *G, *MBp; bf16_t* O;
    __device__ __forceinline__ void operator()(const pg8::f32x4 (&acc)[2][2][4][2], const pg8::Unit& u, int wr, int wc, int fr, int fq) const {
        const int row0 = u.pm * 256 + wr * 64 + fr, col0 = u.pn * 256 + wc * 32 + 8 * fq;
#pragma unroll
        for (int ai = 0; ai < 2; ++ai)
#pragma unroll
            for (int m = 0; m < 4; ++m)
#pragma unroll
                for (int bj = 0; bj < 2; ++bj) {
                    const size_t o = (size_t)(row0 + ai * 128 + m * 16) * 1024 + col0 + bj * 128;
                    pg8::f32x4 g0, g1, b0, b1; ld8bf(G + o, g0, g1); ld8bf(MBp + o, b0, b1);
                    st8bf(O + o, acc[ai][bj][m][0] * g0 + b0, acc[ai][bj][m][1] * g1 + b1);
                }
    }
};
struct EpiX1 {
    static constexpr bool PERM = true, AFTER_DRAIN = false;
    const float* X; float* O;
    __device__ __forceinline__ void operator()(const pg8::f32x4 (&acc)[2][2][4][2], const pg8::Unit& u, int wr, int wc, int fr, int fq) const {
        const int row0 = u.pm * 256 + wr * 64 + fr, col0 = u.pn * 256 + wc * 32 + 8 * fq;
#pragma unroll
        for (int ai = 0; ai < 2; ++ai)
#pragma unroll
            for (int m = 0; m < 4; ++m)
#pragma unroll
                for (int bj = 0; bj < 2; ++bj) {
                    const size_t o = (size_t)(row0 + ai * 128 + m * 16) * 1024 + col0 + bj * 128;
                    const pg8::f32x4 x0 = *(const pg8::f32x4*)(X + o), x1 = *(const pg8::f32x4*)(X + o + 4);
                    *(pg8::f32x4*)(O + o) = x0 + acc[ai][bj][m][0]; *(pg8::f32x4*)(O + o + 4) = x1 + acc[ai][bj][m][1];
                }
    }
};
struct EpiHE {
    static constexpr bool PERM = true, AFTER_DRAIN = false;
    bf16_t* HE;
    __device__ __forceinline__ void operator()(const pg8::f32x4 (&acc)[2][2][4][2], const pg8::Unit& u, int wr, int wc, int fr, int fq) const {
        const int row0 = u.pm * 256 + wr * 64 + fr, col0 = (u.pn & 1) * 128 + wc * 32 + 8 * fq;
#pragma unroll
        for (int ai = 0; ai < 2; ++ai)
#pragma unroll
            for (int m = 0; m < 4; ++m) {
                pg8::f32x4 h0, h1;
#pragma unroll
                for (int j = 0; j < 4; ++j) {
                    const float g0 = acc[ai][0][m][0][j], g1 = acc[ai][0][m][1][j];
                    h0[j] = g0 * sigm(g0) * acc[ai][1][m][0][j]; h1[j] = g1 * sigm(g1) * acc[ai][1][m][1][j];
                }
                st8bf(HE + (size_t)(row0 + ai * 128 + m * 16) * 256 + col0, h0, h1);
            }
    }
};
struct EpiDown {
    static constexpr bool PERM = true, AFTER_DRAIN = false;
    const int* PTOK; const float* EW; bf16_t* YS;
    __device__ __forceinline__ void operator()(const pg8::f32x4 (&acc)[2][2][4][2], const pg8::Unit& u, int wr, int wc, int fr, int fq) const {
        const int row0 = u.pm * 256 + wr * 64 + fr, col0 = (u.pn & 3) * 256 + wc * 32 + 8 * fq;
#pragma unroll
        for (int ai = 0; ai < 2; ++ai)
#pragma unroll
            for (int m = 0; m < 4; ++m) {
                const int ts = PTOK[row0 + ai * 128 + m * 16];
                if (ts >= 0) {
                    const float w = EW[ts];
                    bf16_t* d = YS + ((size_t)(ts & 1) * M + (size_t)(ts >> 1)) * 1024 + col0;
#pragma unroll
                    for (int bj = 0; bj < 2; ++bj) st8bf(d + bj * 128, acc[ai][bj][m][0] * w, acc[ai][bj][m][1] * w);
                }
            }
    }
};
struct TableOrder {
    static constexpr bool GATHER = false;
    const int* tab; const int* nunits; int G, c;
    __device__ __forceinline__ int arow(int r) const { return r; }
    __device__ __forceinline__ bool next(int i, pg8::Unit& u) const {
        const int idx = i * G + c; const int n = __builtin_nontemporal_load(nunits);
        if (idx >= n) return false;
        u.pm = tab[2 * idx]; u.pn = tab[2 * idx + 1]; return true;
    }
    __device__ __forceinline__ void a_ready(const pg8::Unit&) const {}
    __device__ __forceinline__ void done(const pg8::Unit&) const {}
};

struct TableGatherOrder {
    static constexpr bool GATHER = true;
    const int* tab; const int* nunits; const int* ptok; int G, c;
    __device__ __forceinline__ bool next(int i, pg8::Unit& u) const {
        const int idx = i * G + c; const int n = __builtin_nontemporal_load(nunits);
        if (idx >= n) return false;
        u.pm = tab[2 * idx]; u.pn = tab[2 * idx + 1]; return true;
    }
    __device__ __forceinline__ int arow(int r) const { const int ts = ptok[r]; return ts < 0 ? 0 : (ts >> 1); }
    __device__ __forceinline__ void a_ready(const pg8::Unit&) const {}
    __device__ __forceinline__ void done(const pg8::Unit&) const {}
};

__device__ __forceinline__ void tr_item(const float* src, int ld, int K, int NC, bf16_t* dst, LAS float* scr, int item, int lane) {
    const int nblk = NC / 32, kb = item / nblk, nb = item % nblk, k0 = 64 * kb, n0 = 32 * nb;
    f32x4 tv[8];
    const int tr = lane >> 3, tc = (lane & 7) * 4;
    if ((((size_t)src) & 15) == 0 && (ld & 3) == 0) {
#pragma unroll
        for (int i = 0; i < 8; ++i) tv[i] = *(const f32x4*)(src + (size_t)(k0 + 8 * i + tr) * ld + n0 + tc);
    } else {
#pragma unroll
        for (int i = 0; i < 8; ++i) { const float* q = src + (size_t)(k0 + 8 * i + tr) * ld + n0 + tc; tv[i] = (f32x4){q[0], q[1], q[2], q[3]}; }
    }
#pragma unroll
    for (int i = 0; i < 8; ++i) { LAS float* d = scr + (8 * i + tr) * 33 + tc; d[0] = tv[i].x; d[1] = tv[i].y; d[2] = tv[i].z; d[3] = tv[i].w; }
    LDS_WAIT();
    const int c = lane & 7;
#pragma unroll
    for (int j = 0; j < 4; ++j) { const int n = (lane >> 3) + 8 * j; const LAS float* s = scr + (8 * c) * 33 + n;
        u32x4 o; o.x = pk2(s[0 * 33], s[1 * 33]); o.y = pk2(s[2 * 33], s[3 * 33]); o.z = pk2(s[4 * 33], s[5 * 33]); o.w = pk2(s[6 * 33], s[7 * 33]);
        *(u32x4*)(dst + (size_t)(n0 + n) * K + k0 + 8 * c) = o; }
    LDS_WAIT();
}

__device__ __forceinline__ void prep_gateup(const P& p, LAS unsigned char* lds, int w_idx, int nw, int wave, int lane) {
    LAS float* scr = (LAS float*)(lds + wave * 16384);
    for (int it = w_idx; it < 8192; it += nw) {
        const int sub = it & 63, q = it >> 6, gu = q & 1, j = (q >> 1) & 1, e = q >> 2;
        const float* src = (gu ? p.w_up : p.w_gate) + (size_t)e * 262144 + 128 * j;
        tr_item(src, 256, 1024, 128, p.WguT + ((size_t)e * 512 + j * 256 + gu * 128) * 1024, scr, sub, lane);
    }
}

__device__ __forceinline__ void ph_prep(const P& p, LAS unsigned char* lds, const int wv) {
    const int tid = opaque_tid(wv), lane = tid & 63, wave = __builtin_amdgcn_readfirstlane(tid >> 6);
    LAS float* scr = (LAS float*)(lds + wave * 16384);
    const int gw = blockIdx.x * NWAVES + wave, NGW = gridDim.x * NWAVES;
    const int gt = blockIdx.x * NTHR + tid, NGT = gridDim.x * NTHR;
    {
        const int c0s[7] = {640, 512, 1152, 1224, 1736, 2248, 3272};
        const int ncs[7] = {512, 128, 64, 512, 512, 1024, 1024};
        const int r0s[7] = {1024, 1536, 1664, 1792, 2304, 2816, 3840};
#pragma unroll
        for (int s = 0; s < 7; ++s) {
            const int nit = 16 * (ncs[s] / 32);
            for (int it = gw; it < nit; it += NGW) tr_item(p.w_in + c0s[s], INC, 1024, ncs[s], p.WinT + (size_t)r0s[s] * 1024, scr, it, lane);
        }
    }
    for (int i = gt; i < 64 * 1024; i += NGT) { const int j = i >> 10, k = i & 1023; p.WinT[(size_t)(1728 + j) * 1024 + k] = j < 8 ? (bf16_t)f2bf(p.w_in[(size_t)k * INC + 1216 + j]) : (bf16_t)0; }
    for (int it = gw; it < 512; it += NGW) tr_item(p.w_out, 1024, 1024, 1024, p.WoutT, scr, it, lane);
    for (int it = gw; it < 256; it += NGW) tr_item(p.w_pb, 1024, 512, 1024, p.WpbT, scr, it, lane);
    for (int it = gw; it < 4096; it += NGW) { const int sub = it & 127, e = it >> 7; tr_item(p.w_down + (size_t)e * 262144, 1024, 256, 1024, p.WdT + (size_t)e * 262144, scr, sub, lane); }
    for (int it = gw; it < 1024; it += NGW) {
        const int h = it >> 7, kt = (it >> 2) & 31, rt = it & 3, i = lane & 31, hf = lane >> 5;
        const f32x4* ap = (const f32x4*)(p.w_in + (size_t)(kt * 32 + i) * INC + h * 64 + 32 * hf);
        const f32x4* bp = (const f32x4*)(p.w_uk + (size_t)((rt * 32 + i) * 8 + h) * 64 + 32 * hf);
        f32x4 av[8], bv[8];
#pragma unroll
        for (int j = 0; j < 8; ++j) { av[j] = ap[j]; bv[j] = bp[j]; }
        f32x16 acc;
#pragma unroll
        for (int j = 0; j < 16; ++j) acc[j] = 0.f;
#pragma unroll
        for (int j = 0; j < 8; ++j)
#pragma unroll
            for (int e = 0; e < 4; ++e) acc = __builtin_amdgcn_mfma_f32_32x32x2f32(av[j][e], bv[j][e], acc, 0, 0, 0);
#pragma unroll
        for (int g4 = 0; g4 < 4; ++g4) {
            constexpr float QS = 0.125f * 1.4426950409f;
            u32x2 w; w.x = pk2(QS * acc[4 * g4], QS * acc[4 * g4 + 1]); w.y = pk2(QS * acc[4 * g4 + 2], QS * acc[4 * g4 + 3]);
            *(u32x2*)(p.WinT + (size_t)(h * 128 + rt * 32 + i) * 1024 + kt * 32 + 8 * g4 + 4 * hf) = w;
        }
    }
    for (int it = gw; it < 1024; it += NGW) {
        const int h = it >> 7, nt = (it >> 2) & 31, rt = it & 3, i = lane & 31, hf = lane >> 5;
        const f32x4* ap = (const f32x4*)(p.w_uv + (size_t)((rt * 32 + i) * 8 + h) * 64 + 32 * hf);
        const float* bp = p.w_pa + (size_t)(h * 64 + 32 * hf) * 1024 + nt * 32 + i;
        f32x4 av[8]; float bv[32];
#pragma unroll
        for (int j = 0; j < 8; ++j) av[j] = ap[j];
#pragma unroll
        for (int j = 0; j < 32; ++j) bv[j] = bp[(size_t)j * 1024];
        f32x16 acc;
#pragma unroll
        for (int j = 0; j < 16; ++j) acc[j] = 0.f;
#pragma unroll
        for (int j = 0; j < 8; ++j)
#pragma unroll
            for (int e = 0; e < 4; ++e) acc = __builtin_amdgcn_mfma_f32_32x32x2f32(av[j][e], bv[4 * j + e], acc, 0, 0, 0);
#pragma unroll
        for (int g4 = 0; g4 < 4; ++g4) {
            u32x2 w; w.x = pk2(acc[4 * g4], acc[4 * g4 + 1]); w.y = pk2(acc[4 * g4 + 2], acc[4 * g4 + 3]);
            *(u32x2*)(p.WovT + (size_t)(nt * 32 + i) * 1024 + h * 128 + rt * 32 + 8 * g4 + 4 * hf) = w;
        }
    }
    for (int i = gt; i < 4 * 128 * 128; i += NGT) { const int jj = i & 127, ii = (i >> 7) & 127; p.WSB[i] = jj <= ii ? (bf16_t)f2bf(p.w_sp[i]) : (bf16_t)0; }
    for (int i = gt; i < 36 * 1024; i += NGT) { const int c = i >> 10, k = i & 1023; p.WrT[i] = c < 4 ? p.rg_w[k * 4 + c] : p.re_w[k * 32 + (c - 4)]; }
    for (int m4 = gw; m4 < M / 4; m4 += NGW) {
        f32x4 v[4][4]; float ss[4];
#pragma unroll
        for (int r = 0; r < 4; ++r) { const f32x4* xr = (const f32x4*)(p.x + (size_t)(4 * m4 + r) * D) + lane;
#pragma unroll
            for (int j = 0; j < 4; ++j) v[r][j] = xr[64 * j]; }
#pragma unroll
        for (int r = 0; r < 4; ++r) { ss[r] = 0.f;
#pragma unroll
            for (int j = 0; j < 4; ++j) ss[r] += (v[r][j].x * v[r][j].x + v[r][j].y * v[r][j].y) + (v[r][j].z * v[r][j].z + v[r][j].w * v[r][j].w); }
#pragma unroll
        for (int o = 1; o < 64; o <<= 1) {
#pragma unroll
            for (int r = 0; r < 4; ++r) ss[r] += __shfl_xor(ss[r], o);
        }
#pragma unroll
        for (int r = 0; r < 4; ++r) {
            const float rinv = 1.0f / sqrtf(ss[r] * (1.f / D) + EPS);
            unsigned long long* o8 = (unsigned long long*)(p.HB + (size_t)(4 * m4 + r) * D) + lane;
#pragma unroll
            for (int j = 0; j < 4; ++j) { const f32x4 g = ((const f32x4*)p.n1g)[lane + 64 * j]; const f32x4 o = v[r][j] * rinv * g;
                o8[64 * j] = (unsigned long long)pk2(o.x, o.y) | ((unsigned long long)pk2(o.z, o.w) << 32); }
        }
    }
}

__device__ __forceinline__ void ph_ckvnorm(const P& p, const int wv) {
    const int tid = opaque_tid(wv), lane = tid & 63, wave = tid >> 6;
    const int gw = blockIdx.x * NWAVES + wave, NGW = gridDim.x * NWAVES;
    const float g0 = p.kv_g[2 * lane], g1 = p.kv_g[2 * lane + 1];
    for (int m4 = gw; m4 < M / 4; m4 += NGW) {
        float2 v[4]; float ss[4];
#pragma unroll
        for (int r = 0; r < 4; ++r) v[r] = ((const float2*)(p.CKVR + (size_t)(4 * m4 + r) * 128))[lane];
#pragma unroll
        for (int r = 0; r < 4; ++r) ss[r] = v[r].x * v[r].x + v[r].y * v[r].y;
#pragma unroll
        for (int o = 1; o < 64; o <<= 1) {
#pragma unroll
            for (int r = 0; r < 4; ++r) ss[r] += __shfl_xor(ss[r], o);
        }
#pragma unroll
        for (int r = 0; r < 4; ++r) { const float rinv = 1.0f / sqrtf(ss[r] * (1.f / 128.f) + EPS);
            ((unsigned*)(p.CKVB + (size_t)(4 * m4 + r) * 128))[lane] = pk2(v[r].x * rinv * g0, v[r].y * rinv * g1); }
    }
}

__device__ __forceinline__ unsigned qbin(float x) { return (unsigned)(int)__builtin_fminf(__builtin_fmaxf((x + 8.0f) * 64.0f, 0.0f), 1023.0f); }
__device__ __forceinline__ unsigned fkey(float x) { x = x + 0.0f; const unsigned u = __builtin_bit_cast(unsigned, x); return (u & 0x80000000u) ? ~u : (u | 0x80000000u); }

__device__ __forceinline__ void select_row(const LAS float* row, int n, LAS unsigned* hist, unsigned short* out, int lane) {
    if (n <= 256) {
#pragma unroll
        for (int i = 0; i < 4; ++i) { const int k = lane + 64 * i; out[k] = (unsigned short)(k < n ? k : 0); }
        return;
    }
    unsigned prefix = 0; int need = 256;
    const unsigned long long lt = (1ull << lane) - 1ull;
#pragma unroll 1
    for (int pass = 3; pass >= 0; --pass) {
#pragma unroll
        for (int i = 0; i < 4; ++i) hist[lane + 64 * i] = 0u;
        LDS_WAIT();
        const int shift = pass * 8;
        for (int i = lane; i < n; i += 64) {
            const unsigned k = fkey(row[i]);
            const bool match = (pass == 3) || ((k >> (shift + 8)) == prefix);
            if (match) __hip_atomic_fetch_add(hist + ((k >> shift) & 255u), 1u, __ATOMIC_RELAXED, __HIP_MEMORY_SCOPE_WORKGROUP);
        }
        LDS_WAIT();
        const unsigned c0 = hist[4 * lane], c1 = hist[4 * lane + 1], c2 = hist[4 * lane + 2], c3 = hist[4 * lane + 3];
        const unsigned s = c0 + c1 + c2 + c3;
        unsigned incl = s;
#pragma unroll
        for (int o = 1; o < 64; o <<= 1) { const unsigned t = __shfl_down(incl, o); if (lane + o < 64) incl += t; }
        const unsigned excl = incl - s;
        const bool mine = (excl < (unsigned)need) && (incl >= (unsigned)need);
        unsigned bin = 0, above = 0;
        if (mine) {
            unsigned run = excl;
            if (run + c3 >= (unsigned)need) { bin = 4 * lane + 3; above = run; }
            else { run += c3;
                if (run + c2 >= (unsigned)need) { bin = 4 * lane + 2; above = run; }
                else { run += c2;
                    if (run + c1 >= (unsigned)need) { bin = 4 * lane + 1; above = run; }
                    else { run += c1; bin = 4 * lane; above = run; } } }
        }
        const unsigned long long bm = __ballot(mine);
        const int src = bm ? (int)__builtin_ctzll(bm) : 0;
        bin = __shfl(bin, src); above = __shfl(above, src);
        need -= (int)above; prefix = (prefix << 8) | bin;
        LDS_WAIT();
    }
    const unsigned Tk = prefix;
    int cnt = 0, eq_taken = 0;
    for (int i0 = 0; i0 < n; i0 += 64) {
        const int i = i0 + lane; const bool valid = i < n;
        const unsigned k = valid ? fkey(row[i]) : 0u;
        const bool gtk = valid && (k > Tk), eqk = valid && (k == Tk);
        const unsigned long long beq = __ballot(eqk);
        const int eq_rank = eq_taken + __builtin_popcountll(beq & lt);
        const bool take = gtk || (eqk && eq_rank < need);
        const unsigned long long bt = __ballot(take);
        const int pos = cnt + __builtin_popcountll(bt & lt);
        if (take && pos < 256) out[pos] = (unsigned short)i;
        cnt += __builtin_popcountll(bt); eq_taken += __builtin_popcountll(beq);
    }
}

__device__ __forceinline__ void select_row4(const LAS float* row, int n, LAS unsigned* hist, LAS unsigned* h2, unsigned short* out, int lane) {
    if (n <= 256) {
#pragma unroll
        for (int i = 0; i < 4; ++i) { const int k = lane + 64 * i; out[k] = (unsigned short)(k < n ? k : 0); }
#pragma unroll
        for (int i = 0; i < 8; ++i) hist[lane + 64 * i] = 0u;
        return;
    }
    const unsigned long long lt = (1ull << lane) - 1ull;
    unsigned b1, above;
    {
        const u32x4 w0 = *(const LAS u32x4*)(hist + 8 * lane), w1 = *(const LAS u32x4*)(hist + 8 * lane + 4);
        unsigned c[16];
        c[0] = w0.x & 0xffffu; c[1] = w0.x >> 16; c[2] = w0.y & 0xffffu; c[3] = w0.y >> 16; c[4] = w0.z & 0xffffu; c[5] = w0.z >> 16; c[6] = w0.w & 0xffffu; c[7] = w0.w >> 16;
        c[8] = w1.x & 0xffffu; c[9] = w1.x >> 16; c[10] = w1.y & 0xffffu; c[11] = w1.y >> 16; c[12] = w1.z & 0xffffu; c[13] = w1.z >> 16; c[14] = w1.w & 0xffffu; c[15] = w1.w >> 16;
        unsigned s = 0;
#pragma unroll
        for (int j = 0; j < 16; ++j) s += c[j];
        unsigned incl = s;
#pragma unroll
        for (int o = 1; o < 64; o <<= 1) { const unsigned t = __shfl_down(incl, o); if (lane + o < 64) incl += t; }
        const unsigned excl = incl - s;
        const bool mine = (excl < 256u) && (incl >= 256u);
        unsigned bin = 0, ab = 0, run = excl; bool found = false;
#pragma unroll
        for (int j = 15; j >= 0; --j) { if (!found && run + c[j] >= 256u) { bin = 16 * lane + j; ab = run; found = true; } if (!found) run += c[j]; }
        const unsigned long long bm = __ballot(mine);
        const int src = bm ? (int)__builtin_ctzll(bm) : 0;
        b1 = __shfl(bin, src); above = __shfl(ab, src);
    }
    LDS_WAIT();
    int need = 256 - (int)above;
    LAS unsigned short* cand = (LAS unsigned short*)hist;
    const int nblk = (n + 255) >> 8;
    int C = 0;
    for (int blk = 0; blk < nblk; ++blk) {
        const f32x4 v = *(const LAS f32x4*)(row + blk * 256 + 4 * lane);
        bool ge[4]; unsigned long long bl[4];
#pragma unroll
        for (int e = 0; e < 4; ++e) { ge[e] = (blk * 256 + 4 * lane + e < n) && (qbin(v[e]) >= b1); bl[e] = __ballot(ge[e]); }
        const int below = __builtin_popcountll(bl[0] & lt) + __builtin_popcountll(bl[1] & lt) + __builtin_popcountll(bl[2] & lt) + __builtin_popcountll(bl[3] & lt);
        int pos = C + below;
#pragma unroll
        for (int e = 0; e < 4; ++e) { if (ge[e]) { if (pos < 768) cand[pos] = (unsigned short)(blk * 256 + 4 * lane + e); ++pos; } }
        C += __builtin_popcountll(bl[0]) + __builtin_popcountll(bl[1]) + __builtin_popcountll(bl[2]) + __builtin_popcountll(bl[3]);
    }
    LDS_WAIT();
    if (C > 512) {
        select_row(row, n, h2, out, lane);
#pragma unroll
        for (int i = 0; i < 8; ++i) hist[lane + 64 * i] = 0u;
        return;
    }
    int ci[8]; unsigned ck[8]; bool cgt[8], ceq[8];
#pragma unroll
    for (int k = 0; k < 8; ++k) { const int j = lane + 64 * k; ci[k] = j < C ? (int)cand[j] : -1; }
#pragma unroll
    for (int k = 0; k < 8; ++k) { const float v = row[ci[k] < 0 ? 0 : ci[k]]; const unsigned bb = qbin(v); ck[k] = fkey(v); cgt[k] = ci[k] >= 0 && bb > b1; ceq[k] = ci[k] >= 0 && bb == b1; }
    unsigned prefix = 0;
#pragma unroll 1
    for (int pass = 3; pass >= 0; --pass) {
#pragma unroll
        for (int i = 0; i < 4; ++i) h2[lane + 64 * i] = 0u;
        LDS_WAIT();
        const int shift = pass * 8;
#pragma unroll
        for (int k = 0; k < 8; ++k) {
            const bool match = ceq[k] && ((pass == 3) || ((ck[k] >> (shift + 8)) == prefix));
            if (match) __hip_atomic_fetch_add(h2 + ((ck[k] >> shift) & 255u), 1u, __ATOMIC_RELAXED, __HIP_MEMORY_SCOPE_WORKGROUP);
        }
        LDS_WAIT();
        const unsigned c0 = h2[4 * lane], c1 = h2[4 * lane + 1], c2 = h2[4 * lane + 2], c3 = h2[4 * lane + 3];
        const unsigned s = c0 + c1 + c2 + c3;
        unsigned incl = s;
#pragma unroll
        for (int o = 1; o < 64; o <<= 1) { const unsigned t = __shfl_down(incl, o); if (lane + o < 64) incl += t; }
        const unsigned excl = incl - s;
        const bool mine = (excl < (unsigned)need) && (incl >= (unsigned)need);
        unsigned bin = 0, ab = 0;
        if (mine) {
            unsigned run = excl;
            if (run + c3 >= (unsigned)need) { bin = 4 * lane + 3; ab = run; }
            else { run += c3;
                if (run + c2 >= (unsigned)need) { bin = 4 * lane + 2; ab = run; }
                else { run += c2;
                    if (run + c1 >= (unsigned)need) { bin = 4 * lane + 1; ab = run; }
                    else { run += c1; bin = 4 * lane; ab = run; } } }
        }
        const unsigned long long bm = __ballot(mine);
        const int src = bm ? (int)__builtin_ctzll(bm) : 0;
        bin = __shfl(bin, src); ab = __shfl(ab, src);
        need -= (int)ab; prefix = (prefix << 8) | bin;
        LDS_WAIT();
    }
    const unsigned Tk = prefix;
    bool tk[8]; int ne = 0;
#pragma unroll
    for (int k = 0; k < 8; ++k) { tk[k] = ceq[k] && ck[k] == Tk; ne += __builtin_popcountll(__ballot(tk[k])); }
    if (ne > need) {
        bool keep[8];
#pragma unroll
        for (int k = 0; k < 8; ++k) keep[k] = false;
        for (int r = 0; r < need; ++r) {
            int mn = 0x7fffffff;
#pragma unroll
            for (int k = 0; k < 8; ++k) if (tk[k] && !keep[k] && ci[k] < mn) mn = ci[k];
#pragma unroll
            for (int o = 1; o < 64; o <<= 1) { const int t = __shfl_xor(mn, o); mn = t < mn ? t : mn; }
#pragma unroll
            for (int k = 0; k < 8; ++k) if (tk[k] && ci[k] == mn) keep[k] = true;
        }
#pragma unroll
        for (int k = 0; k < 8; ++k) tk[k] = keep[k];
    }
    LAS unsigned short* outL = cand + 768;
    int cnt = 0;
#pragma unroll
    for (int k = 0; k < 8; ++k) {
        const bool take = cgt[k] || (ceq[k] && ck[k] > Tk) || tk[k];
        const unsigned long long bt = __ballot(take);
        const int pos = cnt + __builtin_popcountll(bt & lt);
        if (take && pos < 256) outL[pos] = (unsigned short)ci[k];
        cnt += __builtin_popcountll(bt);
    }
    LDS_WAIT();
    *(u32x2*)(out + 4 * lane) = *(const LAS u32x2*)(outL + 4 * lane);
    LDS_WAIT();
#pragma unroll
    for (int i = 0; i < 8; ++i) hist[lane + 64 * i] = 0u;
}

__device__ __forceinline__ void ph_index(const P& p, LAS unsigned char* lds, const int wv) {
    LAS float* Irow = (LAS float*)lds;
    LAS unsigned* hist = (LAS unsigned*)(lds + 131072);
    LAS unsigned* h2 = (LAS unsigned*)(lds + 131072 + 16384);
    const int tid = opaque_tid(wv), lane = tid & 63, wave = __builtin_amdgcn_readfirstlane(tid >> 6);
    const int hh = lane >> 5, n = lane & 31;
    const int rho = lane & 31, qlA = 2 * ((rho >> 2) & 1) + (rho >> 4), hdA = (rho & 3) + 4 * ((rho >> 3) & 1);
#pragma unroll
    for (int i = 0; i < 8; ++i) hist[tid + NTHR * i] = 0u;
    bf16x8 A[2][4]; float wq[2][16]; bf16x8 B0[4], B1[4], B2[4];
#define IDX_LOAD_B(dst, kt_) do { const bf16_t* kp_ = p.KI + (mb + (size_t)(kt_) * 32 + n) * 64 + 8 * hh; \
        _Pragma("unroll") for (int s = 0; s < 4; ++s) dst[s] = *(const bf16x8*)(kp_ + 16 * s); } while (0)
#define IDX_LOAD_UNIT(u_) do { const int b_ = (u_) & 7, t0_ = (511 - ((u_) >> 3)) * 8; const size_t mb = (size_t)b_ * T; const int nkt_ = (t0_ + 8 + 31) >> 5; \
        _Pragma("unroll") for (int mt = 0; mt < 2; ++mt) { const bf16_t* src = p.QI + (mb + t0_ + mt * 4 + qlA) * 512 + hdA * 64 + 8 * hh; \
            _Pragma("unroll") for (int s = 0; s < 4; ++s) A[mt][s] = *(const bf16x8*)(src + 16 * s); \
            _Pragma("unroll") for (int c = 0; c < 2; ++c) { const float* wp = p.WI + (mb + t0_ + mt * 4 + 2 * hh + c) * 8; const f32x4 w0 = *(const f32x4*)wp, w1 = *(const f32x4*)(wp + 4); \
                _Pragma("unroll") for (int j = 0; j < 4; ++j) { wq[mt][c * 8 + j] = w0[j]; wq[mt][c * 8 + 4 + j] = w1[j]; } } } \
        if (wave < nkt_) IDX_LOAD_B(B0, wave); if (wave + NWAVES < nkt_) IDX_LOAD_B(B1, wave + NWAVES); if (wave + 2 * NWAVES < nkt_) IDX_LOAD_B(B2, wave + 2 * NWAVES); } while (0)
    if ((int)blockIdx.x < 4096) IDX_LOAD_UNIT((int)blockIdx.x);
    __syncthreads();
    for (int u = blockIdx.x; u < 4096; u += gridDim.x) {
        const int b = u & 7, tb = 511 - (u >> 3), t0 = tb * 8; const size_t mb = (size_t)b * T;
        const int nkt = (t0 + 8 + 31) >> 5;
#if defined(IDX_DUP_SCORE)
#pragma unroll 1
        for (int rep = 0; rep < 2; ++rep) {
        if (rep == 1) { if (wave < nkt) IDX_LOAD_B(B0, wave); if (wave + NWAVES < nkt) IDX_LOAD_B(B1, wave + NWAVES); if (wave + 2 * NWAVES < nkt) IDX_LOAD_B(B2, wave + 2 * NWAVES); }
#else
        { const int rep = 1;
#endif
#pragma unroll 1
        for (int kt = wave; kt < nkt; kt += NWAVES) {
            const int key = kt * 32 + n;
#pragma unroll
            for (int mt = 0; mt < 2; ++mt) {
                f32x16 acc;
#pragma unroll
                for (int j = 0; j < 16; ++j) acc[j] = 0.f;
#pragma unroll
                for (int s = 0; s < 4; ++s) acc = __builtin_amdgcn_mfma_f32_32x32x16_bf16(A[mt][s], B0[s], acc, 0, 0, 0);
#pragma unroll
                for (int c = 0; c < 2; ++c) {
                    float v = 0.f;
#pragma unroll
                    for (int h = 0; h < 8; ++h) v += wq[mt][c * 8 + h] * fmaxf(acc[c * 8 + h], 0.f);
                    const int r = mt * 4 + 2 * hh + c;
                    Irow[r * 4096 + key] = v;
                    if (key <= t0 + r) { const unsigned bin = qbin(v); __hip_atomic_fetch_add(hist + r * 512 + (bin >> 1), (unsigned)rep << ((bin & 1u) * 16u), __ATOMIC_RELAXED, __HIP_MEMORY_SCOPE_WORKGROUP); }
                }
            }
#pragma unroll
            for (int s = 0; s < 4; ++s) { B0[s] = B1[s]; B1[s] = B2[s]; }
            if (kt + 3 * NWAVES < nkt) IDX_LOAD_B(B2, kt + 3 * NWAVES);
        }
        }
        if (u + (int)gridDim.x < 4096) IDX_LOAD_UNIT(u + (int)gridDim.x);
        __syncthreads();
        select_row4(Irow + wave * 4096, t0 + wave + 1, hist + wave * 512, h2 + wave * 320, p.SEL + (mb + t0 + wave) * 256, lane);
        __syncthreads();
    }
#undef IDX_LOAD_B
#undef IDX_LOAD_UNIT
}

__device__ __forceinline__ bf16x4 tr16(const LAS unsigned char* a) { return __builtin_amdgcn_ds_read_tr16_b64_v4i16((LAS bf16x4*)a); }
__device__ __forceinline__ void ph_attn(const P& p, LAS unsigned char* lds, const int wv) {
    const int tid = opaque_tid(wv), lane = tid & 63, wave = __builtin_amdgcn_readfirstlane(tid >> 6);
    LAS unsigned char* buf = lds + wave * 16384;
    LAS unsigned char* selL = lds + 131072 + wave * 2048;
    LAS unsigned char* selT = selL + 1024;
    LAS float* bias = (LAS float*)(lds + 147456);
    LAS float* cst = (LAS float*)(lds + 147456 + 4096);
    for (int i = tid; i < 1024; i += NTHR) {
        const int d = i >> 3; int bk = d;
        if (d >= 16) { const float nf = (float)d; bk = 16 + (int)(logf(nf / 16.f) / 2.0794415f * 16.f); if (bk > 31) bk = 31; }
        bias[i] = 1.4426950409f * p.rel_bias[bk * 8 + (i & 7)];
    }
    if (wave == 0) {
        float gm = fmaxf(fabsf(p.kv_g[lane]), fabsf(p.kv_g[lane + 64]));
        float bm = fmaxf(fmaxf(fabsf(p.rel_bias[lane]), fabsf(p.rel_bias[lane + 64])), fmaxf(fabsf(p.rel_bias[lane + 128]), fabsf(p.rel_bias[lane + 192])));
#pragma unroll
        for (int o = 1; o < 64; o <<= 1) { gm = fmaxf(gm, __shfl_xor(gm, o)); bm = fmaxf(bm, __shfl_xor(bm, o)); }
        if (lane == 0) { cst[0] = 11.3137085f * gm * 1.01f; cst[1] = 1.4426950409f * bm; }
    }
    __syncthreads();
    const int g = lane >> 4, hcol = lane & 15, q4 = hcol >> 2, p4 = lane & 3;
    const float cmax = cst[0], bmaxl = cst[1];
    const int G = gridDim.x, bx = blockIdx.x, vcu = (G % 8 == 0) ? (bx % 8) * (G / 8) + bx / 8 : bx;
#define ATT_QF_LOAD(dst, mm) do { _Pragma("unroll") for (int s = 0; s < 4; ++s) { bf16x8 z; _Pragma("unroll") for (int j = 0; j < 8; ++j) z[j] = 0; \
        dst[s] = hcol < 8 ? *(const bf16x8*)(p.QL + (size_t)(mm) * 1024 + hcol * 128 + 32 * s + 8 * g) : z; } } while (0)
#define ATT_DMA_CHUNK(img_, selt_, c_) do { const u32x4 k8 = *(const LAS u32x4*)((selt_) + 64 * (c_) + 16 * g);        \
        const unsigned kk8[8] = {k8.x & 0xffffu, k8.x >> 16, k8.y & 0xffffu, k8.y >> 16, k8.z & 0xffffu, k8.z >> 16, k8.w & 0xffffu, k8.w >> 16}; \
        _Pragma("unroll") for (int i = 0; i < 8; ++i) { \
        const unsigned sch = (unsigned)hcol ^ (((unsigned)g << 2) | (unsigned)(i & 3)); \
        __builtin_amdgcn_global_load_lds((const unsigned*)(ckb + (size_t)kk8[i] * 256u + sch * 16u), (LAS unsigned*)((img_) + i * 1024), 16, 0, 0); } } while (0)
#define ATT_SEL_WRITE(par_, sv_) do { *(LAS u32x2*)(selL + (par_) * 512 + lane * 8) = (sv_); \
        LAS unsigned short* tq = (LAS unsigned short*)(selT + (par_) * 512) + (lane >> 3) * 32 + (lane & 7); \
        tq[0] = (unsigned short)((sv_).x & 0xffffu); tq[8] = (unsigned short)((sv_).x >> 16); tq[16] = (unsigned short)((sv_).y & 0xffffu); tq[24] = (unsigned short)((sv_).y >> 16); } while (0)
    for (int qc = vcu; qc < M / 128; qc += G) {
        const int m0 = qc * 128 + wave * 16;
        const size_t mb = (size_t)(m0 >> 12) * T;
        const unsigned char* ckb = (const unsigned char*)(p.CKVB + mb * 128);
        u32x2 sv = *(const u32x2*)(p.SEL + (size_t)m0 * 256 + 4 * lane);
        bf16x8 qf[4], qfn[4];
        ATT_QF_LOAD(qfn, m0);
        ATT_SEL_WRITE(0, sv);
        LDS_WAIT();
        ATT_DMA_CHUNK(buf, selT, 0);
        sv = *(const u32x2*)(p.SEL + (size_t)(m0 + 1) * 256 + 4 * lane);
        f32x4 o[8]; float lsum = 0.f, mhl = 0.f;
#pragma unroll
        for (int rt = 0; rt < 8; ++rt) o[rt] = (f32x4){0.f, 0.f, 0.f, 0.f};
#define ATT_BODY(gc_, B_) do { const int gc = (gc_); \
            const int qi = gc >> 3, c = gc & 7, m = m0 + qi; \
            const int t = m & (T - 1); \
            const LAS unsigned char* selc = selL + (qi & 1) * 512; \
            const LAS unsigned char* img = buf + (B_) * 8192; \
            if (gc + 1 < 128) { const int nqi = (gc + 1) >> 3, nc = (gc + 1) & 7; ATT_DMA_CHUNK(buf + ((B_) ^ 1) * 8192, selT + (nqi & 1) * 512, nc); \
                __builtin_amdgcn_sched_barrier(0); asm volatile("s_waitcnt vmcnt(8)" ::: "memory"); } \
            else { __builtin_amdgcn_sched_barrier(0); asm volatile("s_waitcnt vmcnt(0)" ::: "memory"); } \
            __builtin_amdgcn_sched_barrier(0); \
            if (c == 0) { \
                _Pragma("unroll") for (int s = 0; s < 4; ++s) qf[s] = qfn[s]; \
                float ss = 0.f; \
                _Pragma("unroll") for (int s = 0; s < 4; ++s) _Pragma("unroll") for (int j = 0; j < 8; ++j) { const float v = bf2f((unsigned short)qf[s][j]); ss += v * v; } \
                ss += __shfl_xor(ss, 16); ss += __shfl_xor(ss, 32); \
                mhl = sqrtf(ss) * cmax + bmaxl; \
                if (qi < 15) ATT_QF_LOAD(qfn, m + 1); \
            } \
            if (c == 3 && qi < 15) { \
                ATT_SEL_WRITE((qi + 1) & 1, sv); \
                if (qi < 14) sv = *(const u32x2*)(p.SEL + (size_t)(m + 2) * 256 + 4 * lane); \
            } \
              \
            bf16x8 af[2][4]; u32x2 kk[2]; \
            _Pragma("unroll") for (int tau = 0; tau < 2; ++tau) { kk[tau] = *(const LAS u32x2*)(selc + 2 * (32 * c + 16 * tau + 4 * g)); \
                _Pragma("unroll") for (int s = 0; s < 4; ++s) af[tau][s] = *(const LAS bf16x8*)(img + off_b(16 * tau + hcol, 4 * s + g)); } \
            float bv[2][4]; \
            _Pragma("unroll") for (int tau = 0; tau < 2; ++tau) { \
                const int keys[4] = {(int)(kk[tau].x & 0xffffu), (int)(kk[tau].x >> 16), (int)(kk[tau].y & 0xffffu), (int)(kk[tau].y >> 16)}; \
                _Pragma("unroll") for (int r = 0; r < 4; ++r) { const int dist = t - keys[r]; const int dcl = dist > 127 ? 127 : dist; bv[tau][r] = bias[dcl * 8 + (hcol & 7)]; } \
            } \
            __builtin_amdgcn_sched_barrier(0); \
            f32x4 acc[2]; \
            _Pragma("unroll") for (int tau = 0; tau < 2; ++tau) { \
                acc[tau] = (f32x4){0.f, 0.f, 0.f, 0.f}; \
                _Pragma("unroll") for (int s = 0; s < 4; ++s) acc[tau] = __builtin_amdgcn_mfma_f32_16x16x32_bf16(af[tau][s], qf[s], acc[tau], 0, 0, 0); \
            } \
            bf16x4 ta[8][2]; \
            _Pragma("unroll") for (int rt = 0; rt < 8; ++rt) { \
                const unsigned row0 = 4 * g + q4, ch = 2 * rt + (p4 >> 1); \
                ta[rt][0] = tr16(img + off_b(row0, ch) + 8 * (p4 & 1)); ta[rt][1] = tr16(img + off_b(row0 + 16, ch) + 8 * (p4 & 1)); \
            } \
            __builtin_amdgcn_sched_barrier(0); \
            float pr[2][4]; \
            _Pragma("unroll") for (int tau = 0; tau < 2; ++tau) _Pragma("unroll") for (int r = 0; r < 4; ++r) pr[tau][r] = __builtin_amdgcn_exp2f(acc[tau][r] + bv[tau][r] - mhl); \
            if (t < 255) {                                           \
                _Pragma("unroll") for (int tau = 0; tau < 2; ++tau) _Pragma("unroll") for (int r = 0; r < 4; ++r) if (32 * c + 16 * tau + 4 * g + r > t) pr[tau][r] = 0.f; \
            } \
            lsum += ((pr[0][0] + pr[0][1]) + (pr[0][2] + pr[0][3])) + ((pr[1][0] + pr[1][1]) + (pr[1][2] + pr[1][3])); \
            u32x4 pw; pw.x = pg8::cvt_pk_bf16(pr[0][0], pr[0][1]); pw.y = pg8::cvt_pk_bf16(pr[0][2], pr[0][3]); pw.z = pg8::cvt_pk_bf16(pr[1][0], pr[1][1]); pw.w = pg8::cvt_pk_bf16(pr[1][2], pr[1][3]); \
            const bf16x8 pf = __builtin_bit_cast(bf16x8, pw); \
            _Pragma("unroll") for (int rt = 0; rt < 8; ++rt) o[rt] = __builtin_amdgcn_mfma_f32_16x16x32_bf16(cat4(ta[rt][0], ta[rt][1]), pf, o[rt], 0, 0, 0); \
            if (c == 7) { \
                lsum += __shfl_xor(lsum, 16); lsum += __shfl_xor(lsum, 32); \
                const float inv = __builtin_amdgcn_rcpf(lsum); \
                if (hcol < 8) { \
                    _Pragma("unroll") for (int rt = 0; rt < 8; ++rt) { \
                        u32x2 w; w.x = pg8::cvt_pk_bf16(o[rt][0] * inv, o[rt][1] * inv); w.y = pg8::cvt_pk_bf16(o[rt][2] * inv, o[rt][3] * inv); \
                        *(u32x2*)(p.OL + (size_t)m * 1024 + hcol * 128 + 16 * rt + 4 * g) = w; \
                    } \
                } \
                _Pragma("unroll") for (int rt = 0; rt < 8; ++rt) o[rt] = (f32x4){0.f, 0.f, 0.f, 0.f}; \
                lsum = 0.f; \
            } } while (0)
#pragma unroll 1
        for (int g2 = 0; g2 < 128; g2 += 2) {
            ATT_BODY(g2, 0);
            ATT_BODY(g2 + 1, 1);
        }
#undef ATT_BODY
        asm volatile("s_waitcnt vmcnt(0)" ::: "memory");
    }
#undef ATT_DMA_CHUNK
#undef ATT_SEL_WRITE
#undef ATT_QF_LOAD
}

struct Cand8 { float v[8]; int id[8]; unsigned bn[8]; bool ok[8]; };

__device__ __forceinline__ void coarse_thr(const Cand8& c, LAS unsigned* hist, int lane, unsigned& b1, unsigned& above) {
#pragma unroll
    for (int k = 0; k < 8; ++k) if (c.ok[k]) __hip_atomic_fetch_add(hist + (c.bn[k] >> 1), 1u << ((c.bn[k] & 1u) * 16u), __ATOMIC_RELAXED, __HIP_MEMORY_SCOPE_WORKGROUP);
    LDS_WAIT();
    const u32x4 w0 = *(const LAS u32x4*)(hist + 8 * lane), w1 = *(const LAS u32x4*)(hist + 8 * lane + 4);
    unsigned cc[16];
    cc[0] = w0.x & 0xffffu; cc[1] = w0.x >> 16; cc[2] = w0.y & 0xffffu; cc[3] = w0.y >> 16; cc[4] = w0.z & 0xffffu; cc[5] = w0.z >> 16; cc[6] = w0.w & 0xffffu; cc[7] = w0.w >> 16;
    cc[8] = w1.x & 0xffffu; cc[9] = w1.x >> 16; cc[10] = w1.y & 0xffffu; cc[11] = w1.y >> 16; cc[12] = w1.z & 0xffffu; cc[13] = w1.z >> 16; cc[14] = w1.w & 0xffffu; cc[15] = w1.w >> 16;
    unsigned s = 0;
#pragma unroll
    for (int j = 0; j < 16; ++j) s += cc[j];
    unsigned incl = s;
#pragma unroll
    for (int o = 1; o < 64; o <<= 1) { const unsigned t = __shfl_down(incl, o); if (lane + o < 64) incl += t; }
    const unsigned excl = incl - s;
    const bool mine = (excl < 256u) && (incl >= 256u);
    unsigned bin = 0, ab = 0, run = excl; bool found = false;
#pragma unroll
    for (int j = 15; j >= 0; --j) { if (!found && run + cc[j] >= 256u) { bin = 16 * lane + j; ab = run; found = true; } if (!found) run += cc[j]; }
    const unsigned long long bm = __ballot(mine);
    const int src = bm ? (int)__builtin_ctzll(bm) : 0;
    b1 = __shfl(bin, src); above = __shfl(ab, src);
    LDS_WAIT();
}

__device__ __forceinline__ void exact_take(const Cand8& c, unsigned b1, int need, LAS unsigned* h2, int lane, bool (&take)[8]) {
    unsigned ck[8]; bool ceq[8];
#pragma unroll
    for (int k = 0; k < 8; ++k) { ck[k] = fkey(c.v[k]); ceq[k] = c.ok[k] && c.bn[k] == b1; }
    unsigned prefix = 0;
#pragma unroll 1
    for (int pass = 3; pass >= 0; --pass) {
#pragma unroll
        for (int i = 0; i < 4; ++i) h2[lane + 64 * i] = 0u;
        LDS_WAIT();
        const int shift = pass * 8;
#pragma unroll
        for (int k = 0; k < 8; ++k) {
            const bool match = ceq[k] && ((pass == 3) || ((ck[k] >> (shift + 8)) == prefix));
            if (match) __hip_atomic_fetch_add(h2 + ((ck[k] >> shift) & 255u), 1u, __ATOMIC_RELAXED, __HIP_MEMORY_SCOPE_WORKGROUP);
        }
        LDS_WAIT();
        const unsigned c0 = h2[4 * lane], c1 = h2[4 * lane + 1], c2 = h2[4 * lane + 2], c3 = h2[4 * lane + 3];
        const unsigned s = c0 + c1 + c2 + c3;
        unsigned incl = s;
#pragma unroll
        for (int o = 1; o < 64; o <<= 1) { const unsigned t = __shfl_down(incl, o); if (lane + o < 64) incl += t; }
        const unsigned excl = incl - s;
        const bool mine = (excl < (unsigned)need) && (incl >= (unsigned)need);
        unsigned bin = 0, ab = 0;
        if (mine) {
            unsigned run = excl;
            if (run + c3 >= (unsigned)need) { bin = 4 * lane + 3; ab = run; }
            else { run += c3;
                if (run + c2 >= (unsigned)need) { bin = 4 * lane + 2; ab = run; }
                else { run += c2;
                    if (run + c1 >= (unsigned)need) { bin = 4 * lane + 1; ab = run; }
                    else { run += c1; bin = 4 * lane; ab = run; } } }
        }
        const unsigned long long bm = __ballot(mine);
        const int src = bm ? (int)__builtin_ctzll(bm) : 0;
        bin = __shfl(bin, src); ab = __shfl(ab, src);
        need -= (int)ab; prefix = (prefix << 8) | bin;
        LDS_WAIT();
    }
    const unsigned Tk = prefix;
    bool tk[8]; int ne = 0;
#pragma unroll
    for (int k = 0; k < 8; ++k) { tk[k] = ceq[k] && ck[k] == Tk; ne += __builtin_popcountll(__ballot(tk[k])); }
    if (ne > need) {
        bool keep[8];
#pragma unroll
        for (int k = 0; k < 8; ++k) keep[k] = false;
        for (int r = 0; r < need; ++r) {
            int mn = 0x7fffffff;
#pragma unroll
            for (int k = 0; k < 8; ++k) if (tk[k] && !keep[k] && c.id[k] < mn) mn = c.id[k];
#pragma unroll
            for (int o = 1; o < 64; o <<= 1) { const int t = __shfl_xor(mn, o); mn = t < mn ? t : mn; }
#pragma unroll
            for (int k = 0; k < 8; ++k) if (tk[k] && c.id[k] == mn) keep[k] = true;
        }
#pragma unroll
        for (int k = 0; k < 8; ++k) tk[k] = keep[k];
    }
#pragma unroll
    for (int k = 0; k < 8; ++k) take[k] = (c.ok[k] && c.bn[k] > b1) || (ceq[k] && ck[k] > Tk) || tk[k];
}


__device__ __forceinline__ void select_row_g(const float* row, int n, LAS unsigned* hist, unsigned short* out, int lane) {
    unsigned prefix = 0; int need = 256;
    const unsigned long long lt = (1ull << lane) - 1ull;
#pragma unroll 1
    for (int pass = 3; pass >= 0; --pass) {
#pragma unroll
        for (int i = 0; i < 4; ++i) hist[lane + 64 * i] = 0u;
        LDS_WAIT();
        const int shift = pass * 8;
        for (int i = lane; i < n; i += 64) {
            const unsigned k = fkey(row[i]);
            const bool match = (pass == 3) || ((k >> (shift + 8)) == prefix);
            if (match) __hip_atomic_fetch_add(hist + ((k >> shift) & 255u), 1u, __ATOMIC_RELAXED, __HIP_MEMORY_SCOPE_WORKGROUP);
        }
        LDS_WAIT();
        const unsigned c0 = hist[4 * lane], c1 = hist[4 * lane + 1], c2 = hist[4 * lane + 2], c3 = hist[4 * lane + 3];
        const unsigned s = c0 + c1 + c2 + c3;
        unsigned incl = s;
#pragma unroll
        for (int o = 1; o < 64; o <<= 1) { const unsigned t = __shfl_down(incl, o); if (lane + o < 64) incl += t; }
        const unsigned excl = incl - s;
        const bool mine = (excl < (unsigned)need) && (incl >= (unsigned)need);
        unsigned bin = 0, above = 0;
        if (mine) {
            unsigned run = excl;
            if (run + c3 >= (unsigned)need) { bin = 4 * lane + 3; above = run; }
            else { run += c3;
                if (run + c2 >= (unsigned)need) { bin = 4 * lane + 2; above = run; }
                else { run += c2;
                    if (run + c1 >= (unsigned)need) { bin = 4 * lane + 1; above = run; }
                    else { run += c1; bin = 4 * lane; above = run; } } }
        }
        const unsigned long long bm = __ballot(mine);
        const int src = bm ? (int)__builtin_ctzll(bm) : 0;
        bin = __shfl(bin, src); above = __shfl(above, src);
        need -= (int)above; prefix = (prefix << 8) | bin;
        LDS_WAIT();
    }
    const unsigned Tk = prefix;
    int cnt = 0, eq_taken = 0;
    for (int i0 = 0; i0 < n; i0 += 64) {
        const int i = i0 + lane; const bool valid = i < n;
        const unsigned k = valid ? fkey(row[i]) : 0u;
        const bool gtk = valid && (k > Tk), eqk = valid && (k == Tk);
        const unsigned long long beq = __ballot(eqk);
        const int eq_rank = eq_taken + __builtin_popcountll(beq & lt);
        const bool take = gtk || (eqk && eq_rank < need);
        const unsigned long long bt = __ballot(take);
        const int pos = cnt + __builtin_popcountll(bt & lt);
        if (take && pos < 256) out[pos] = (unsigned short)i;
        cnt += __builtin_popcountll(bt); eq_taken += __builtin_popcountll(beq);
    }
}

constexpr int IDX_CAP = 336;
__device__ __forceinline__ void ph_index6(const P& p, LAS unsigned char* lds, const int wv) {
    const int tid = opaque_tid(wv), lane = tid & 63, wave = __builtin_amdgcn_readfirstlane(tid >> 6);
    LAS unsigned char* KS = lds;
    LAS unsigned char* QR = lds + 32768 + wave * 4 * 2048;
    LAS unsigned* h2 = (LAS unsigned*)(lds + 98304) + wave * 256;
    const int hh = lane >> 5, n = lane & 31;
    const int rho = lane & 31, qlA = 2 * ((rho >> 2) & 1) + (rho >> 4), hdA = (rho & 3) + 4 * ((rho >> 3) & 1);
    const unsigned long long lt = (1ull << lane) - 1ull;
    const unsigned lt32 = (1u << n) - 1u;
    for (int gq = blockIdx.x; gq < 1024; gq += gridDim.x) {
        const int b = gq & 7, t0 = (127 - (gq >> 3)) * 32; const size_t mb = (size_t)b * T;
        const int tw = t0 + 4 * wave;
        bf16x8 A[4]; float wq[16];
        {
            const bf16_t* src = p.QI + (mb + tw + qlA) * 512 + hdA * 64 + 8 * hh;
#pragma unroll
            for (int s = 0; s < 4; ++s) A[s] = *(const bf16x8*)(src + 16 * s);
#pragma unroll
            for (int c = 0; c < 2; ++c) {
                const float* wp = p.WI + (mb + tw + 2 * hh + c) * 8;
                const f32x4 w0 = *(const f32x4*)wp, w1 = *(const f32x4*)(wp + 4);
#pragma unroll
                for (int j = 0; j < 4; ++j) { wq[c * 8 + j] = w0[j]; wq[c * 8 + 4 + j] = w1[j]; }
            }
        }
#pragma unroll
        for (int i = 0; i < 8; ++i) *(LAS u32x4*)(QR + (lane + 64 * i) * 16) = (u32x4){0u, 0u, 0u, 0u};
#pragma unroll
        for (int s = 0; s < 4; ++s) asm volatile("" :: "v"(A[s]));
#pragma unroll
        for (int j = 0; j < 16; ++j) asm volatile("" :: "v"(wq[j]));
        int cnt[4]; unsigned b1q[4], abq[4];
#pragma unroll
        for (int q = 0; q < 4; ++q) { cnt[q] = 0; b1q[q] = 0u; abq[q] = 0u; }
        const int nst = (t0 + 32 + 127) >> 7;
        const int qme = 2 * hh;
        const LAS unsigned char* myq = QR + qme * 2048;
#pragma unroll 1
        for (int sweep = 0; sweep < 2; ++sweep) {
            u32x4 sr[2];
#pragma unroll
            for (int i = 0; i < 2; ++i) { const int idx = tid + NTHR * i, row = idx >> 3, ch = idx & 7; sr[i] = *(const u32x4*)(p.KI + (mb + row) * 64 + ch * 8); }
#pragma unroll
            for (int i = 0; i < 2; ++i) { const int idx = tid + NTHR * i, row = idx >> 3, ch = idx & 7; *(LAS u32x4*)(KS + row * 128 + 16 * (ch ^ (row & 7))) = sr[i]; }
            __syncthreads();
#pragma unroll 1
            for (int st = 0; st < nst; ++st) {
                if (st + 1 < nst) {
#pragma unroll
                    for (int i = 0; i < 2; ++i) { const int idx = tid + NTHR * i, row = idx >> 3, ch = idx & 7; sr[i] = *(const u32x4*)(p.KI + (mb + (st + 1) * 128 + row) * 64 + ch * 8); }
                }
                const LAS unsigned char* kb = KS + (st & 1) * 16384;
#pragma unroll 1
                for (int tl = 0; tl < 4; ++tl) {
                    const int key0 = st * 128 + tl * 32;
                    if (key0 > tw + 3) break;
                    const int row = tl * 32 + n, key = key0 + n;
                    f32x16 acc;
#pragma unroll
                    for (int j = 0; j < 16; ++j) acc[j] = 0.f;
#pragma unroll
                    for (int s = 0; s < 4; ++s) {
                        const bf16x8 Bf = *(const LAS bf16x8*)(kb + row * 128 + 16 * ((2 * s + hh) ^ (row & 7)));
                        acc = __builtin_amdgcn_mfma_f32_32x32x16_bf16(A[s], Bf, acc, 0, 0, 0);
                    }
#pragma unroll
                    for (int c = 0; c < 2; ++c) {
                        float v = 0.f;
#pragma unroll
                        for (int h = 0; h < 8; ++h) v += wq[c * 8 + h] * fmaxf(acc[c * 8 + h], 0.f);
                        const unsigned bn = qbin(v);
                        const bool causal = key <= tw + qme + c;
                        if (sweep == 0) {
                            if (causal) __hip_atomic_fetch_add((LAS unsigned*)(myq + c * 2048) + (bn >> 1), 1u << ((bn & 1u) * 16u), __ATOMIC_RELAXED, __HIP_MEMORY_SCOPE_WORKGROUP);
                        } else {
                            const unsigned bl = hh ? b1q[2 + c] : b1q[c];
                            const bool pass = causal && (bn >= bl);
                            const unsigned long long mk = __ballot(pass);
                            const unsigned lo = (unsigned)mk, hi = (unsigned)(mk >> 32);
                            const int rank = hh ? __builtin_popcount(hi & lt32) : __builtin_popcount(lo & lt32);
                            const int pos = (hh ? cnt[2 + c] : cnt[c]) + rank;
                            if (pass && pos < IDX_CAP) { LAS unsigned char* qr = QR + (qme + c) * 2048; ((LAS float*)qr)[pos] = v; ((LAS unsigned short*)(qr + IDX_CAP * 4))[pos] = (unsigned short)key; }
                            cnt[c] += __builtin_popcount(lo); cnt[2 + c] += __builtin_popcount(hi);
                        }
                    }
                }
                if (st + 1 < nst) {
#pragma unroll
                    for (int i = 0; i < 2; ++i) { const int idx = tid + NTHR * i, row = idx >> 3, ch = idx & 7; *(LAS u32x4*)(KS + ((st + 1) & 1) * 16384 + row * 128 + 16 * (ch ^ (row & 7))) = sr[i]; }
                }
                __syncthreads();
            }
            if (sweep == 0) {
                LDS_WAIT();
#pragma unroll 1
                for (int q = 0; q < 4; ++q) {
                    unsigned b1 = 0u, above = 0u;
                    if (tw + q + 1 > 256) {
                        const LAS unsigned* hist = (const LAS unsigned*)(QR + q * 2048);
                        const u32x4 w0 = *(const LAS u32x4*)(hist + 8 * lane), w1 = *(const LAS u32x4*)(hist + 8 * lane + 4);
                        unsigned cc[16];
                        cc[0] = w0.x & 0xffffu; cc[1] = w0.x >> 16; cc[2] = w0.y & 0xffffu; cc[3] = w0.y >> 16; cc[4] = w0.z & 0xffffu; cc[5] = w0.z >> 16; cc[6] = w0.w & 0xffffu; cc[7] = w0.w >> 16;
                        cc[8] = w1.x & 0xffffu; cc[9] = w1.x >> 16; cc[10] = w1.y & 0xffffu; cc[11] = w1.y >> 16; cc[12] = w1.z & 0xffffu; cc[13] = w1.z >> 16; cc[14] = w1.w & 0xffffu; cc[15] = w1.w >> 16;
                        unsigned s = 0;
#pragma unroll
                        for (int j = 0; j < 16; ++j) s += cc[j];
                        unsigned incl = s;
#pragma unroll
                        for (int o = 1; o < 64; o <<= 1) { const unsigned t = __shfl_down(incl, o); if (lane + o < 64) incl += t; }
                        const unsigned excl = incl - s;
                        const bool mine = (excl < 256u) && (incl >= 256u);
                        unsigned bin = 0, ab = 0, run = excl; bool found = false;
#pragma unroll
                        for (int j = 15; j >= 0; --j) { if (!found && run + cc[j] >= 256u) { bin = 16 * lane + j; ab = run; found = true; } if (!found) run += cc[j]; }
                        const unsigned long long bm = __ballot(mine);
                        const int src = bm ? (int)__builtin_ctzll(bm) : 0;
                        b1 = __shfl(bin, src); above = __shfl(ab, src);
                    }
#pragma unroll
                    for (int qq = 0; qq < 4; ++qq) { b1q[qq] = qq == q ? b1 : b1q[qq]; abq[qq] = qq == q ? above : abq[qq]; }
                }
                LDS_WAIT();
            }
        }
        LDS_WAIT();
#pragma unroll 1
        for (int q = 0; q < 4; ++q) {
            unsigned short* out = p.SEL + (mb + tw + q) * 256;
            const int nq = tw + q + 1;
            const int cq = q == 0 ? cnt[0] : q == 1 ? cnt[1] : q == 2 ? cnt[2] : cnt[3];
            const unsigned b1 = q == 0 ? b1q[0] : q == 1 ? b1q[1] : q == 2 ? b1q[2] : b1q[3];
            const unsigned above = q == 0 ? abq[0] : q == 1 ? abq[1] : q == 2 ? abq[2] : abq[3];
            if (nq <= 256) {
#pragma unroll
                for (int i = 0; i < 4; ++i) { const int k = lane + 64 * i; out[k] = (unsigned short)(k < nq ? k : 0); }
            } else if (cq <= IDX_CAP) {
                const LAS float* cv = (const LAS float*)(QR + q * 2048); const LAS unsigned short* cix = (const LAS unsigned short*)(QR + q * 2048 + IDX_CAP * 4);
                Cand8 c;
#pragma unroll
                for (int k = 0; k < 8; ++k) { const int j = lane + 64 * k; c.ok[k] = j < cq; c.v[k] = c.ok[k] ? cv[j] : 0.f; c.id[k] = c.ok[k] ? (int)cix[j] : 0; c.bn[k] = qbin(c.v[k]); }
                bool take[8];
                exact_take(c, b1, 256 - (int)above, h2, lane, take);
                LDS_WAIT();
                LAS unsigned short* outL = (LAS unsigned short*)(QR + q * 2048);
                int np = 0;
#pragma unroll
                for (int k = 0; k < 8; ++k) {
                    const unsigned long long bt = __ballot(take[k]);
                    const int pos = np + __builtin_popcountll(bt & lt);
                    if (take[k] && pos < 256) outL[pos] = (unsigned short)c.id[k];
                    np += __builtin_popcountll(bt);
                }
                LDS_WAIT();
                *(u32x2*)(out + 4 * lane) = *(const LAS u32x2*)(outL + 4 * lane);
                LDS_WAIT();
            } else {
                float* grow = p.IDXROW + (size_t)(blockIdx.x * NWAVES + wave) * 4096;
                const bf16_t* qsrc = p.QI + (mb + tw + q) * 512; const float* wsrc = p.WI + (mb + tw + q) * 8;
                for (int key = lane; key < nq; key += 64) {
                    const bf16_t* kr = p.KI + (mb + key) * 64;
                    float sc = 0.f;
                    for (int h = 0; h < 8; ++h) { float d = 0.f; for (int e = 0; e < 64; ++e) d += bf2f(qsrc[h * 64 + e]) * bf2f(kr[e]); sc += wsrc[h] * fmaxf(d, 0.f); }
                    grow[key] = sc;
                }
                asm volatile("s_waitcnt vmcnt(0)" ::: "memory");
                select_row_g(grow, nq, h2, out, lane);
            }
        }
        __syncthreads();
    }
}

__device__ __forceinline__ unsigned q16of(float x) { return (unsigned)(int)__builtin_fminf(__builtin_fmaxf((x + 8.0f) * 4096.0f, 0.0f), 65535.0f); }

__device__ __forceinline__ void select_row7(const LAS unsigned short* row, int n, LAS unsigned* hist, LAS unsigned* h2, unsigned short* out, int lane) {
    if (n <= 256) {
#pragma unroll
        for (int i = 0; i < 4; ++i) { const int k = lane + 64 * i; out[k] = (unsigned short)(k < n ? k : 0); }
#pragma unroll
        for (int i = 0; i < 8; ++i) hist[lane + 64 * i] = 0u;
        return;
    }
    const unsigned long long lt = (1ull << lane) - 1ull;
    unsigned b1, above;
    {
        const u32x4 w0 = *(const LAS u32x4*)(hist + 8 * lane), w1 = *(const LAS u32x4*)(hist + 8 * lane + 4);
        unsigned c[16];
        c[0] = w0.x & 0xffffu; c[1] = w0.x >> 16; c[2] = w0.y & 0xffffu; c[3] = w0.y >> 16; c[4] = w0.z & 0xffffu; c[5] = w0.z >> 16; c[6] = w0.w & 0xffffu; c[7] = w0.w >> 16;
        c[8] = w1.x & 0xffffu; c[9] = w1.x >> 16; c[10] = w1.y & 0xffffu; c[11] = w1.y >> 16; c[12] = w1.z & 0xffffu; c[13] = w1.z >> 16; c[14] = w1.w & 0xffffu; c[15] = w1.w >> 16;
        unsigned s = 0;
#pragma unroll
        for (int j = 0; j < 16; ++j) s += c[j];
        unsigned incl = s;
#pragma unroll
        for (int o = 1; o < 64; o <<= 1) { const unsigned t = __shfl_down(incl, o); if (lane + o < 64) incl += t; }
        const unsigned excl = incl - s;
        const bool mine = (excl < 256u) && (incl >= 256u);
        unsigned bin = 0, ab = 0, run = excl; bool found = false;
#pragma unroll
        for (int j = 15; j >= 0; --j) { if (!found && run + c[j] >= 256u) { bin = 16 * lane + j; ab = run; found = true; } if (!found) run += c[j]; }
        const unsigned long long bm = __ballot(mine);
        const int src = bm ? (int)__builtin_ctzll(bm) : 0;
        b1 = __shfl(bin, src); above = __shfl(ab, src);
    }
    LDS_WAIT();
    int need = 256 - (int)above;
    LAS unsigned short* cand = (LAS unsigned short*)hist;
    const int nblk = (n + 255) >> 8;
    const unsigned thr = b1 << 6;
    int C = 0;
    for (int blk = 0; blk < nblk; ++blk) {
        const u32x2 v = *(const LAS u32x2*)(row + blk * 256 + 4 * lane);
        const unsigned q[4] = {v.x & 0xffffu, v.x >> 16, v.y & 0xffffu, v.y >> 16};
        bool ge[4]; unsigned long long bl[4];
#pragma unroll
        for (int e = 0; e < 4; ++e) { ge[e] = (blk * 256 + 4 * lane + e < n) && (q[e] >= thr); bl[e] = __ballot(ge[e]); }
        const int below = __builtin_popcountll(bl[0] & lt) + __builtin_popcountll(bl[1] & lt) + __builtin_popcountll(bl[2] & lt) + __builtin_popcountll(bl[3] & lt);
        int pos = C + below;
#pragma unroll
        for (int e = 0; e < 4; ++e) { if (ge[e]) { if (pos < 768) cand[pos] = (unsigned short)(blk * 256 + 4 * lane + e); ++pos; } }
        C += __builtin_popcountll(bl[0]) + __builtin_popcountll(bl[1]) + __builtin_popcountll(bl[2]) + __builtin_popcountll(bl[3]);
    }
    LDS_WAIT();
    LAS unsigned short* outL = cand + 768;
    if (C <= 512) {
        int ci[8]; unsigned cq[8]; bool ceq[8];
#pragma unroll
        for (int k = 0; k < 8; ++k) { const int j = lane + 64 * k; ci[k] = j < C ? (int)cand[j] : -1; }
#pragma unroll
        for (int k = 0; k < 8; ++k) { cq[k] = ci[k] >= 0 ? (unsigned)row[ci[k]] : 0u; ceq[k] = ci[k] >= 0 && (cq[k] >> 6) == b1; }
        h2[lane] = 0u;
        LDS_WAIT();
#pragma unroll
        for (int k = 0; k < 8; ++k) if (ceq[k]) __hip_atomic_fetch_add(h2 + (cq[k] & 63u), 1u, __ATOMIC_RELAXED, __HIP_MEMORY_SCOPE_WORKGROUP);
        LDS_WAIT();
        const unsigned cme = h2[lane];
        unsigned incl = cme;
#pragma unroll
        for (int o = 1; o < 64; o <<= 1) { const unsigned t = __shfl_down(incl, o); if (lane + o < 64) incl += t; }
        const unsigned excl = incl - cme;
        const bool mine = (excl < (unsigned)need) && (incl >= (unsigned)need);
        const unsigned long long bm = __ballot(mine);
        const int src = bm ? (int)__builtin_ctzll(bm) : 0;
        const unsigned Tl = (unsigned)src;
        need -= (int)__shfl(excl, src);
        const unsigned Tq = (b1 << 6) | Tl;
        int eq_seen = 0, cnt = 0;
#pragma unroll
        for (int k = 0; k < 8; ++k) {
            const bool valid = ci[k] >= 0, eqk = valid && cq[k] == Tq;
            const unsigned long long beq = __ballot(eqk);
            const int eq_rank = eq_seen + __builtin_popcountll(beq & lt);
            const bool take = valid && (cq[k] > Tq || (eqk && eq_rank < need));
            const unsigned long long bt = __ballot(take);
            const int pos = cnt + __builtin_popcountll(bt & lt);
            if (take && pos < 256) outL[pos] = (unsigned short)ci[k];
            cnt += __builtin_popcountll(bt); eq_seen += __builtin_popcountll(beq);
        }
    } else {
        unsigned lo = 0u, hi = 65535u;
        while (lo < hi) {
            const unsigned mid = (lo + hi + 1u) >> 1;
            int cge = 0;
            for (int i = lane; i < n; i += 64) cge += ((unsigned)row[i] >= mid) ? 1 : 0;
#pragma unroll
            for (int o = 1; o < 64; o <<= 1) cge += __shfl_xor(cge, o);
            if (cge >= 256) lo = mid; else hi = mid - 1u;
        }
        const unsigned Tq = lo;
        int cgt = 0;
        for (int i = lane; i < n; i += 64) cgt += ((unsigned)row[i] > Tq) ? 1 : 0;
#pragma unroll
        for (int o = 1; o < 64; o <<= 1) cgt += __shfl_xor(cgt, o);
        const int needq = 256 - cgt;
        int cnt = 0, eq_seen = 0;
        for (int i0 = 0; i0 < n; i0 += 64) {
            const int i = i0 + lane; const bool valid = i < n;
            const unsigned qv = valid ? (unsigned)row[i] : 0u;
            const bool eqk = valid && qv == Tq;
            const unsigned long long beq = __ballot(eqk);
            const int eq_rank = eq_seen + __builtin_popcountll(beq & lt);
            const bool take = valid && (qv > Tq || (eqk && eq_rank < needq));
            const unsigned long long bt = __ballot(take);
            const int pos = cnt + __builtin_popcountll(bt & lt);
            if (take && pos < 256) outL[pos] = (unsigned short)i;
            cnt += __builtin_popcountll(bt); eq_seen += __builtin_popcountll(beq);
        }
    }
    LDS_WAIT();
    *(u32x2*)(out + 4 * lane) = *(const LAS u32x2*)(outL + 4 * lane);
    LDS_WAIT();
#pragma unroll
    for (int i = 0; i < 8; ++i) hist[lane + 64 * i] = 0u;
}

__device__ __forceinline__ void ph_index7(const P& p, LAS unsigned char* lds, const int wv) {
    LAS unsigned short* Irow = (LAS unsigned short*)lds;
    LAS unsigned* hist = (LAS unsigned*)(lds + 65536);
    LAS unsigned* h2 = (LAS unsigned*)(lds + 81920);
    const int tid = opaque_tid(wv), lane = tid & 63, wave = __builtin_amdgcn_readfirstlane(tid >> 6);
    LAS unsigned char* KSw = lds + 92160 + wave * 8192;
    const int hh = lane >> 5, n = lane & 31;
    const int rho = lane & 31, qlA = 2 * ((rho >> 2) & 1) + (rho >> 4), hdA = (rho & 3) + 4 * ((rho >> 3) & 1);
    const int srow = lane >> 3, sch = lane & 7;
#pragma unroll
    for (int i = 0; i < 8; ++i) hist[tid + NTHR * i] = 0u;
    bf16x8 A[2][4]; float wq[2][16]; u32x4 RA[4], RB[4];
#define IDX7_LOAD(R_, mb_, kt_) do { const bf16_t* kp_ = p.KI + ((mb_) + (size_t)(kt_) * 32 + srow) * 64 + sch * 8; \
        _Pragma("unroll") for (int i = 0; i < 4; ++i) R_[i] = *(const u32x4*)(kp_ + (size_t)i * 8 * 64); } while (0)
#define IDX7_LOAD_UNIT(u_) do { const int b_ = (u_) & 7, t0_ = (511 - ((u_) >> 3)) * 8; const size_t mb_ = (size_t)b_ * T; const int nkt_ = (t0_ + 8 + 31) >> 5; \
        _Pragma("unroll") for (int mt = 0; mt < 2; ++mt) { const bf16_t* src = p.QI + (mb_ + t0_ + mt * 4 + qlA) * 512 + hdA * 64 + 8 * hh; \
            _Pragma("unroll") for (int s = 0; s < 4; ++s) A[mt][s] = *(const bf16x8*)(src + 16 * s); \
            _Pragma("unroll") for (int c = 0; c < 2; ++c) { const float* wp = p.WI + (mb_ + t0_ + mt * 4 + 2 * hh + c) * 8; const f32x4 w0 = *(const f32x4*)wp, w1 = *(const f32x4*)(wp + 4); \
                _Pragma("unroll") for (int j = 0; j < 4; ++j) { wq[mt][c * 8 + j] = w0[j]; wq[mt][c * 8 + 4 + j] = w1[j]; } } } \
        if (wave < nkt_) IDX7_LOAD(RA, mb_, wave); if (wave + NWAVES < nkt_) IDX7_LOAD(RB, mb_, wave + NWAVES); } while (0)
    if ((int)blockIdx.x < 4096) IDX7_LOAD_UNIT((int)blockIdx.x);
    __syncthreads();
    for (int u = blockIdx.x; u < 4096; u += gridDim.x) {
        const int b = u & 7, tb = 511 - (u >> 3), t0 = tb * 8; const size_t mb = (size_t)b * T;
        const int nkt = (t0 + 8 + 31) >> 5;
#pragma unroll
        for (int mt = 0; mt < 2; ++mt) {
#pragma unroll
            for (int s = 0; s < 4; ++s) asm volatile("" :: "v"(A[mt][s]));
#pragma unroll
            for (int j = 0; j < 16; ++j) asm volatile("" :: "v"(wq[mt][j]));
        }
#define IDX7_BODY(kt_, R_, bf_) do { const int kt = (kt_); if (kt < nkt) { \
            LAS unsigned char* img = KSw + (bf_) * 4096; \
            _Pragma("unroll") for (int i = 0; i < 4; ++i) { const int row = 8 * i + srow; *(LAS u32x4*)(img + row * 128 + 16 * (sch ^ (row & 7))) = R_[i]; } \
            if (kt + 2 * NWAVES < nkt) IDX7_LOAD(R_, mb, kt + 2 * NWAVES); \
            bf16x8 Bf[4]; \
            _Pragma("unroll") for (int s = 0; s < 4; ++s) Bf[s] = *(const LAS bf16x8*)(img + n * 128 + 16 * ((2 * s + hh) ^ (n & 7))); \
            const int key = kt * 32 + n; \
            _Pragma("unroll") for (int mt = 0; mt < 2; ++mt) { \
                f32x16 acc; \
                _Pragma("unroll") for (int j = 0; j < 16; ++j) acc[j] = 0.f; \
                _Pragma("unroll") for (int s = 0; s < 4; ++s) acc = __builtin_amdgcn_mfma_f32_32x32x16_bf16(A[mt][s], Bf[s], acc, 0, 0, 0); \
                _Pragma("unroll") for (int c = 0; c < 2; ++c) { \
                    float v = 0.f; \
                    _Pragma("unroll") for (int h = 0; h < 8; ++h) { const float af = acc[c * 8 + h]; const int ai = __float_as_int(af); v = __builtin_fmaf(wq[mt][c * 8 + h], __int_as_float(ai > 0 ? ai : 0), v); } \
                    const int r = mt * 4 + 2 * hh + c; const unsigned q = q16of(v); \
                    Irow[r * 4096 + key] = (unsigned short)q; \
                    if (key <= t0 + r) { const unsigned bin = q >> 6; __hip_atomic_fetch_add(hist + r * 512 + (bin >> 1), 1u << ((bin & 1u) * 16u), __ATOMIC_RELAXED, __HIP_MEMORY_SCOPE_WORKGROUP); } \
                } \
            } } } while (0)
#pragma unroll 1
        for (int k0 = wave; k0 < nkt; k0 += 2 * NWAVES) {
            IDX7_BODY(k0, RA, 0);
            IDX7_BODY(k0 + NWAVES, RB, 1);
        }
#undef IDX7_BODY
        if (u + (int)gridDim.x < 4096) IDX7_LOAD_UNIT(u + (int)gridDim.x);
        LDS_WAIT(); __builtin_amdgcn_s_barrier();
        select_row7(Irow + wave * 4096, t0 + wave + 1, hist + wave * 512, h2 + wave * 320, p.SEL + (mb + t0 + wave) * 256, lane);
        LDS_WAIT(); __builtin_amdgcn_s_barrier();
    }
#undef IDX7_LOAD
#undef IDX7_LOAD_UNIT
}

__device__ __forceinline__ void ph_gmlp(const P& p, LAS unsigned char* lds, const int wv) {
    const int tid = opaque_tid(wv), lane = tid & 63, wave = __builtin_amdgcn_readfirstlane(tid >> 6);
    LAS unsigned char* vt = lds;
    LAS float* st = (LAS float*)(lds + 32768);
    const int g4 = lane >> 4, q4 = (lane & 15) >> 2, p4 = lane & 3, ic = lane & 15;
    for (int u = blockIdx.x; u < 256; u += gridDim.x) {
        const size_t m0 = (size_t)u * 128;
#pragma unroll 1
        for (int r4 = 0; r4 < 4; ++r4) {
            float x[4][8], sm[4];
#pragma unroll
            for (int r = 0; r < 4; ++r) { const u32x4 w = *(const u32x4*)(p.VB + (m0 + 16 * wave + 4 * r4 + r) * 512 + lane * 8);
                x[r][0] = bflo(w.x); x[r][1] = bfhi(w.x); x[r][2] = bflo(w.y); x[r][3] = bfhi(w.y); x[r][4] = bflo(w.z); x[r][5] = bfhi(w.z); x[r][6] = bflo(w.w); x[r][7] = bfhi(w.w); }
#pragma unroll
            for (int r = 0; r < 4; ++r) sm[r] = ((x[r][0] + x[r][1]) + (x[r][2] + x[r][3])) + ((x[r][4] + x[r][5]) + (x[r][6] + x[r][7]));
#pragma unroll
            for (int o = 1; o < 64; o <<= 1) {
#pragma unroll
                for (int r = 0; r < 4; ++r) sm[r] += __shfl_xor(sm[r], o);
            }
            float vr[4];
#pragma unroll
            for (int r = 0; r < 4; ++r) { const float mean = sm[r] * (1.f / 512.f); sm[r] = mean; float a = 0.f;
#pragma unroll
                for (int j = 0; j < 8; ++j) { const float d = x[r][j] - mean; a += d * d; }
                vr[r] = a; }
#pragma unroll
            for (int o = 1; o < 64; o <<= 1) {
#pragma unroll
                for (int r = 0; r < 4; ++r) vr[r] += __shfl_xor(vr[r], o);
            }
            if (lane == 0) {
#pragma unroll
                for (int r = 0; r < 4; ++r) { const int row = 16 * wave + 4 * r4 + r; st[2 * row] = sm[r]; st[2 * row + 1] = 1.0f / sqrtf(vr[r] * (1.f / 512.f) + EPS); }
            }
        }
        __syncthreads();
#pragma unroll 1
        for (int g = 0; g < 4; ++g) {
#pragma unroll
            for (int i = 0; i < 4; ++i) {
                const int piece = i * NTHR + tid, row = piece >> 4, ch = piece & 15;
                const u32x4 w = *(const u32x4*)(p.VB + (m0 + row) * 512 + g * 128 + ch * 8);
                const float mean = st[2 * row], rstd = st[2 * row + 1];
                const f32x4 ga = *(const f32x4*)(p.ln_g + g * 128 + ch * 8), gb = *(const f32x4*)(p.ln_g + g * 128 + ch * 8 + 4);
                const f32x4 ba = *(const f32x4*)(p.ln_b + g * 128 + ch * 8), bb = *(const f32x4*)(p.ln_b + g * 128 + ch * 8 + 4);
                u32x4 o;
                o.x = pk2((bflo(w.x) - mean) * rstd * ga[0] + ba[0], (bfhi(w.x) - mean) * rstd * ga[1] + ba[1]);
                o.y = pk2((bflo(w.y) - mean) * rstd * ga[2] + ba[2], (bfhi(w.y) - mean) * rstd * ga[3] + ba[3]);
                o.z = pk2((bflo(w.z) - mean) * rstd * gb[0] + bb[0], (bfhi(w.z) - mean) * rstd * gb[1] + bb[1]);
                o.w = pk2((bflo(w.w) - mean) * rstd * gb[2] + bb[2], (bfhi(w.w) - mean) * rstd * gb[3] + bb[3]);
                *(LAS u32x4*)(vt + off_b(row, ch)) = o;
            }
            const size_t orow = (m0 + 16 * wave + ic) * 512 + g * 128 + 4 * g4;
            u32x2 uv[8];
#pragma unroll
            for (int et = 0; et < 8; ++et) uv[et] = *(const u32x2*)(p.UB + orow + 16 * et);
            const float bs = p.b_sp[g * 128 + 16 * wave + ic];
            const int nks = ((16 * wave + 15) >> 5) + 1;
            bf16x8 wb[4];
#pragma unroll
            for (int ks = 0; ks < 4; ++ks) wb[ks] = *(const bf16x8*)(p.WSB + ((size_t)g * 128 + 16 * wave + ic) * 128 + 32 * ks + 8 * g4);
            __syncthreads();
            f32x4 acc[8];
#pragma unroll
            for (int et = 0; et < 8; ++et) acc[et] = (f32x4){0.f, 0.f, 0.f, 0.f};
#pragma unroll
            for (int ks = 0; ks < 4; ++ks) {
                if (ks < nks) {
                    bf16x4 ta[8][2];
#pragma unroll
                    for (int et = 0; et < 8; ++et) {
                        const unsigned r0 = 32 * ks + 8 * g4 + q4, ch = 2 * et + (p4 >> 1);
                        ta[et][0] = tr16(vt + off_b(r0, ch) + 8 * (p4 & 1)); ta[et][1] = tr16(vt + off_b(r0 + 4, ch) + 8 * (p4 & 1));
                    }
#pragma unroll
                    for (int et = 0; et < 8; ++et) acc[et] = __builtin_amdgcn_mfma_f32_16x16x32_bf16(cat4(ta[et][0], ta[et][1]), wb[ks], acc[et], 0, 0, 0);
                }
            }
#pragma unroll
            for (int et = 0; et < 8; ++et) {
                u32x2 w;
                w.x = pk2(bflo(uv[et].x) * (acc[et][0] + bs), bfhi(uv[et].x) * (acc[et][1] + bs));
                w.y = pk2(bflo(uv[et].y) * (acc[et][2] + bs), bfhi(uv[et].y) * (acc[et][3] + bs));
                *(u32x2*)(p.US + orow + 16 * et) = w;
            }
            __syncthreads();
        }
    }
}

__device__ __forceinline__ float dot16(const f32x4 (&hv)[4], const LAS float* wr, int lane) {
    float s = 0.f;
#pragma unroll
    for (int j = 0; j < 4; ++j) { const f32x4 w = ((const LAS f32x4*)wr)[lane + 64 * j]; s += (hv[j].x * w.x + hv[j].y * w.y) + (hv[j].z * w.z + hv[j].w * w.w); }
    return s;
}
__device__ __forceinline__ void ph_router(const P& p, LAS unsigned char* lds, const int wv) {
    const int tid = opaque_tid(wv), lane = tid & 63, wave = __builtin_amdgcn_readfirstlane(tid >> 6);
    LAS float* WL = (LAS float*)lds;
    LAS unsigned* cnt = (LAS unsigned*)(lds + 147456);
    const float* X1 = p.out;
    for (int i = tid; i < 36 * 256; i += NTHR) ((LAS f32x4*)WL)[i] = ((const f32x4*)p.WrT)[i];
    __syncthreads();
    for (int c = blockIdx.x; c < M / 128; c += gridDim.x) {
        if (tid < 32) cnt[tid] = 0u;
        __syncthreads();
#pragma unroll 1
        for (int it = 0; it < 8; ++it) {
            const int m = c * 128 + wave * 16 + it * 2;
            f32x4 hv[2][4];
#pragma unroll
            for (int rr = 0; rr < 2; ++rr) {
                const f32x4* xr = (const f32x4*)(X1 + (size_t)(m + rr) * D) + lane;
#pragma unroll
                for (int j = 0; j < 4; ++j) hv[rr][j] = xr[64 * j];
            }
#pragma unroll
            for (int rr = 0; rr < 2; ++rr) {
                float s = 0.f;
#pragma unroll
                for (int j = 0; j < 4; ++j) s += (hv[rr][j].x * hv[rr][j].x + hv[rr][j].y * hv[rr][j].y) + (hv[rr][j].z * hv[rr][j].z + hv[rr][j].w * hv[rr][j].w);
                const float rinv = 1.0f / sqrtf(wave_sum(s) * (1.f / D) + EPS);
                unsigned long long* o8 = (unsigned long long*)(p.H2B + (size_t)(m + rr) * D) + lane;
#pragma unroll
                for (int j = 0; j < 4; ++j) { const f32x4 g = ((const f32x4*)p.n2g)[lane + 64 * j]; hv[rr][j] = hv[rr][j] * rinv * g;
                    o8[64 * j] = (unsigned long long)pk2(hv[rr][j].x, hv[rr][j].y) | ((unsigned long long)pk2(hv[rr][j].z, hv[rr][j].w) << 32); }
            }
            float gl[2][4];
#pragma unroll
            for (int cc = 0; cc < 4; ++cc) {
#pragma unroll
                for (int rr = 0; rr < 2; ++rr) gl[rr][cc] = dot16(hv[rr], WL + cc * 1024, lane);
                asm volatile("" ::: "memory");
            }
#pragma unroll
            for (int rr = 0; rr < 2; ++rr)
#pragma unroll
                for (int cc = 0; cc < 4; ++cc) gl[rr][cc] = wave_sum(gl[rr][cc]) + p.rg_b[cc];
            int gi[2]; float gwt[2];
#pragma unroll
            for (int rr = 0; rr < 2; ++rr) {
                int g = 0; float gm = gl[rr][0];
#pragma unroll
                for (int i = 1; i < 4; ++i) if (gl[rr][i] > gm) { gm = gl[rr][i]; g = i; }
                float gs = 0.f;
#pragma unroll
                for (int i = 0; i < 4; ++i) gs += __expf(gl[rr][i] - gm);
                gi[rr] = __builtin_amdgcn_readfirstlane(g); gwt[rr] = 1.f / gs;
            }
            float el[2][8];
#pragma unroll
            for (int cc = 0; cc < 8; ++cc) {
#pragma unroll
                for (int rr = 0; rr < 2; ++rr) el[rr][cc] = dot16(hv[rr], WL + (4 + gi[rr] * 8 + cc) * 1024, lane);
                asm volatile("" ::: "memory");
            }
#pragma unroll
            for (int rr = 0; rr < 2; ++rr)
#pragma unroll
                for (int cc = 0; cc < 8; ++cc) el[rr][cc] = wave_sum(el[rr][cc]) + p.re_b[gi[rr] * 8 + cc];
#pragma unroll
            for (int rr = 0; rr < 2; ++rr) {
                int i1 = 0; float m1 = el[rr][0];
#pragma unroll
                for (int j = 1; j < 8; ++j) if (el[rr][j] > m1) { m1 = el[rr][j]; i1 = j; }
                int i2 = 0; float m2 = -INFINITY;
#pragma unroll
                for (int j = 0; j < 8; ++j) if (j != i1 && el[rr][j] > m2) { m2 = el[rr][j]; i2 = j; }
                const float e2r = __expf(m2 - m1), e1 = 1.f / (1.f + e2r), e2 = e2r * e1;
                if (lane == 0) {
                    const int ea = gi[rr] * 8 + i1, eb = gi[rr] * 8 + i2;
                    p.EID[2 * (m + rr)] = ea; p.EID[2 * (m + rr) + 1] = eb;
                    p.EW[2 * (m + rr)] = gwt[rr] * e1; p.EW[2 * (m + rr) + 1] = gwt[rr] * e2;
                    __hip_atomic_fetch_add(cnt + ea, 1u, __ATOMIC_RELAXED, __HIP_MEMORY_SCOPE_WORKGROUP);
                    __hip_atomic_fetch_add(cnt + eb, 1u, __ATOMIC_RELAXED, __HIP_MEMORY_SCOPE_WORKGROUP);
                }
            }
        }
        __syncthreads();
        if (tid < 32) p.BLKCNT[c * 32 + tid] = (int)cnt[tid];
        __syncthreads();
    }
}

__device__ __forceinline__ void ph_scan(const P& p, LAS unsigned char* lds, const int wv) {}
__device__ __forceinline__ void ph_scatter(const P& p, LAS unsigned char* lds, const int wv) {
    const int tid = opaque_tid(wv);
    LAS int* s = (LAS int*)lds;
    LAS int* se = s + 2048;
    const int e = tid & 31, part = tid >> 5;
    int loc[16]; int sum = 0;
#pragma unroll
    for (int i = 0; i < 16; ++i) { loc[i] = p.BLKCNT[(part * 16 + i) * 32 + e]; sum += loc[i]; }
    s[128 + part * 32 + e] = sum;
    __syncthreads();
    if (tid < 32) { int t = 0; for (int k = 0; k < 16; ++k) { const int v = s[128 + k * 32 + tid]; s[128 + k * 32 + tid] = t; t += v; } s[tid] = t; }
    __syncthreads();
    if (tid == 0) { int off = 0; for (int k = 0; k < 32; ++k) { s[32 + k] = off; off += (s[k] + 255) >> 8; } s[64] = off; }
    __syncthreads();
    if (blockIdx.x == 0) {
        const int ntiles = s[64];
        if (tid < 32) { p.MOEI[tid] = s[32 + tid] * 256; p.MOEI[32 + tid] = s[32 + tid]; }
        if (tid == 0) { p.MOEI[64] = ntiles; p.MOEI[65] = ntiles * 2; p.MOEI[66] = ntiles * 4; }
        for (int rt = tid; rt < ntiles; rt += NTHR) {
            int ex = 0;
            for (int k = 0; k < 32; ++k) { const int tb = s[32 + k], nt = (s[k] + 255) >> 8; if (rt >= tb && rt < tb + nt) ex = k; }
            p.GU[4 * rt + 0] = rt; p.GU[4 * rt + 1] = ex * 2; p.GU[4 * rt + 2] = rt; p.GU[4 * rt + 3] = ex * 2 + 1;
#pragma unroll
            for (int j = 0; j < 4; ++j) { p.DN[8 * rt + 2 * j] = rt; p.DN[8 * rt + 2 * j + 1] = ex * 4 + j; }
        }
        for (int k = 0; k < 32; ++k) {
            const int lo = s[32 + k] * 256 + s[k], hi = (s[32 + k] + ((s[k] + 255) >> 8)) * 256;
            for (int i = lo + tid; i < hi; i += NTHR) p.PTOK[i] = -1;
        }
    }
    for (int c = blockIdx.x; c < M / 128; c += gridDim.x) {
        if (part == (c >> 4)) {
            int run = s[32 + e] * 256 + s[128 + part * 32 + e];
#pragma unroll
            for (int i = 0; i < 16; ++i) run += (i < (c & 15)) ? loc[i] : 0;
            s[1024 + e] = run;
        }
        int ex = 0;
        if (tid < 256) { ex = p.EID[c * 256 + tid]; se[tid] = ex; }
        __syncthreads();
        if (tid < 256) {
            int rank = 0;
            for (int t = 0; t < tid; ++t) rank += (se[t] == ex) ? 1 : 0;
            p.PTOK[s[1024 + ex] + rank] = c * 256 + tid;
        }
        __syncthreads();
    }
}

template <bool DRY> __device__ __forceinline__ void ph_final(const P& p, const int wv) {
    const int tid = opaque_tid(wv), lane = tid & 63, wave = tid >> 6;
    const int gw = blockIdx.x * NWAVES + wave, NGW = gridDim.x * NWAVES;
    for (int m4 = gw; m4 < M / 4; m4 += NGW) {
        f32x4 v[4][4]; float s[4];
#pragma unroll
        for (int rr = 0; rr < 4; ++rr) {
            const int m = 4 * m4 + rr;
            const f32x4* xr = (const f32x4*)(p.out + (size_t)m * D) + lane;
            const u32x2* y0 = (const u32x2*)(p.YS + (size_t)m * D) + lane; const u32x2* y1 = (const u32x2*)(p.YS + ((size_t)M + m) * D) + lane;
            s[rr] = 0.f;
#pragma unroll
            for (int j = 0; j < 4; ++j) {
                v[rr][j] = xr[64 * j]; const u32x2 a = y0[64 * j], b = y1[64 * j];
                v[rr][j].x += bflo(a.x) + bflo(b.x); v[rr][j].y += bfhi(a.x) + bfhi(b.x); v[rr][j].z += bflo(a.y) + bflo(b.y); v[rr][j].w += bfhi(a.y) + bfhi(b.y);
                s[rr] += (v[rr][j].x * v[rr][j].x + v[rr][j].y * v[rr][j].y) + (v[rr][j].z * v[rr][j].z + v[rr][j].w * v[rr][j].w);
            }
        }
#pragma unroll
        for (int rr = 0; rr < 4; ++rr) {
            const float rinv = 1.0f / sqrtf(wave_sum(s[rr]) * (1.f / D) + EPS);
            f32x4* xr = (f32x4*)((DRY ? (float*)p.GBB : p.out) + (size_t)(4 * m4 + rr) * D) + lane;
#pragma unroll
            for (int j = 0; j < 4; ++j) { const f32x4 g = ((const f32x4*)p.fg)[lane + 64 * j]; xr[64 * j] = v[rr][j] * rinv * g; }
        }
    }
}

#ifndef GEMM_SP2
#define GEMM_SP2 true
#endif
__device__ __forceinline__ void ph_gemm_in(const P& p, LAS unsigned char* lds, const int wv) {
    pg8::Gemm g{p.HB, p.WinT, M, NIN, 1024}; pg8::StaticOrder S; S.init(M, NIN, gridDim.x, (int)blockIdx.x);
    EpiIn E{p.QL, p.QI, p.KI, p.UB, p.VB, p.GAB, p.GBB, p.CKVR, p.WI};
    pg8::gemm_phase<EpiIn, pg8::StaticOrder, true, GEMM_SP2>(lds, g, S, E, wv);
    {
        const int G = gridDim.x, nwg = (M / 256) * (NIN / 256), nextra = nwg % G;
        const int c = blockIdx.x, nshort = nextra == 0 ? G : G - nextra;
        if (nextra == 0 || c >= nextra) {
            const int tid = opaque_tid(wv), lane = tid & 63, wave = __builtin_amdgcn_readfirstlane(tid >> 6);
            __syncthreads();
            prep_gateup(p, lds, (nextra == 0 ? c : c - nextra) * NWAVES + wave, nshort * NWAVES, wave, lane);
        }
    }
}
__device__ __forceinline__ void ph_gemm_yb(const P& p, LAS unsigned char* lds, const int wv) {
    pg8::Gemm g{p.US, p.WpbT, M, 1024, 512}; pg8::StaticOrder S; S.init(M, 1024, gridDim.x, (int)blockIdx.x);
    EpiMB E{p.GBB, p.MB};
    pg8::gemm_phase<EpiMB, pg8::StaticOrder, true, GEMM_SP2>(lds, g, S, E, wv);
}
__device__ __forceinline__ void ph_gemm_ya(const P& p, LAS unsigned char* lds, const int wv) {
    pg8::Gemm g{p.OL, p.WovT, M, 1024, 1024}; pg8::StaticOrder S; S.init(M, 1024, gridDim.x, (int)blockIdx.x);
    EpiMG E{p.GAB, p.MB, p.MG};
    pg8::gemm_phase<EpiMG, pg8::StaticOrder, true, GEMM_SP2>(lds, g, S, E, wv);
}
__device__ __forceinline__ void ph_gemm_out(const P& p, LAS unsigned char* lds, const int wv) {
    pg8::Gemm g{p.MG, p.WoutT, M, 1024, 1024}; pg8::StaticOrder S; S.init(M, 1024, gridDim.x, (int)blockIdx.x);
    EpiX1 E{p.x, p.out};
    pg8::gemm_phase<EpiX1, pg8::StaticOrder, true, GEMM_SP2>(lds, g, S, E, wv);
}
__device__ __forceinline__ void ph_gemm_gu(const P& p, LAS unsigned char* lds, const int wv) {
    pg8::Gemm g{p.H2B, p.WguT, NPOS, 32 * 512, 1024}; TableGatherOrder S{p.GU, p.MOEI + 65, p.PTOK, (int)gridDim.x, (int)blockIdx.x};
    EpiHE E{p.HE};
    pg8::gemm_phase<EpiHE, TableGatherOrder, true, true>(lds, g, S, E, wv);
}
__device__ __forceinline__ void ph_gemm_dn(const P& p, LAS unsigned char* lds, const int wv) {
    pg8::Gemm g{p.HE, p.WdT, NPOS, 32 * 1024, 256}; TableOrder S{p.DN, p.MOEI + 66, (int)gridDim.x, (int)blockIdx.x};
    EpiDown E{p.PTOK, p.EW, p.YS};
    pg8::gemm_phase<EpiDown, TableOrder, true, GEMM_SP2>(lds, g, S, E, wv);
}

constexpr int NPHASE = 15;
template <int PH> __device__ __forceinline__ void run_phase(const P& p, LAS unsigned char* lds, const int wv) {
    if constexpr (PH == 0) ph_prep(p, lds, wv);
    if constexpr (PH == 1) ph_gemm_in(p, lds, wv);
    if constexpr (PH == 2) ph_ckvnorm(p, wv);
    if constexpr (PH == 3) ph_index7(p, lds, wv);
    if constexpr (PH == 4) ph_attn(p, lds, wv);
    if constexpr (PH == 5) ph_gmlp(p, lds, wv);
    if constexpr (PH == 6) ph_gemm_yb(p, lds, wv);
    if constexpr (PH == 7) ph_gemm_ya(p, lds, wv);
    if constexpr (PH == 8) ph_gemm_out(p, lds, wv);
    if constexpr (PH == 9) ph_router(p, lds, wv);
    if constexpr (PH == 10) ph_scan(p, lds, wv);
    if constexpr (PH == 11) ph_scatter(p, lds, wv);
    if constexpr (PH == 12) ph_gemm_gu(p, lds, wv);
    if constexpr (PH == 13) ph_gemm_dn(p, lds, wv);
    if constexpr (PH == 14) ph_final<false>(p, wv);
}
template <int PH> __global__ void __launch_bounds__(NTHR, 2) k_phase(P p) {
    extern __shared__ __attribute__((aligned(16))) unsigned char lds_raw[];
    run_phase<PH>(p, (LAS unsigned char*)lds_raw, __builtin_amdgcn_readfirstlane(threadIdx.x >> 6));
}

constexpr int MISC_OFF = LDS_BYTES - 256;
__global__ void __launch_bounds__(NTHR, 2) k_mega(P p) {
    extern __shared__ __attribute__((aligned(16))) unsigned char lds_raw[];
    LAS unsigned char* lds = (LAS unsigned char*)lds_raw;
    volatile LAS unsigned* MISC = (volatile LAS unsigned*)(lds + MISC_OFF);
    int wv = __builtin_amdgcn_readfirstlane(threadIdx.x >> 6); asm volatile("" : "+s"(wv));
    if (threadIdx.x < 64) MISC[threadIdx.x] = 0u;
    __syncthreads();
    XcdBarrier bar = xcd_barrier_post(p.ctl + CW_BAR, MISC, wv);
    run_phase<0>(p, lds, wv);
#if defined(DUP0)
    __syncthreads(); run_phase<0>(p, lds, wv);
#endif
    xcd_barrier(bar);
    run_phase<1>(p, lds, wv);
#if defined(DUP1)
    __syncthreads(); run_phase<1>(p, lds, wv);
#endif
    xcd_barrier(bar);
    run_phase<2>(p, lds, wv);
#if defined(DUP2)
    run_phase<2>(p, lds, wv);
#endif
    run_phase<3>(p, lds, wv);
#if defined(DUP3)
    __syncthreads(); run_phase<3>(p, lds, wv);
#endif
    xcd_barrier(bar);
    run_phase<4>(p, lds, wv);  __syncthreads();
#if defined(DUP4)
    run_phase<4>(p, lds, wv);  __syncthreads();
#endif
    run_phase<5>(p, lds, wv);
#if defined(DUP5)
    __syncthreads(); run_phase<5>(p, lds, wv);
#endif
    xcd_barrier(bar);
    run_phase<6>(p, lds, wv);
    run_phase<7>(p, lds, wv);  xcd_barrier(bar);
    run_phase<8>(p, lds, wv);
#if defined(DUP678)
    __syncthreads(); run_phase<6>(p, lds, wv); run_phase<7>(p, lds, wv); xcd_barrier(bar); run_phase<8>(p, lds, wv);
#endif
    xcd_barrier(bar);
    run_phase<9>(p, lds, wv);
#if defined(DUP9)
    __syncthreads(); run_phase<9>(p, lds, wv);
#endif
    xcd_barrier(bar);
    run_phase<11>(p, lds, wv);
#if defined(DUP11)
    __syncthreads(); run_phase<11>(p, lds, wv);
#endif
    xcd_barrier(bar);
    run_phase<12>(p, lds, wv);
#if defined(DUP12)
    __syncthreads(); run_phase<12>(p, lds, wv);
#endif
    xcd_barrier(bar);
    run_phase<13>(p, lds, wv);
#if defined(DUP13)
    __syncthreads(); run_phase<13>(p, lds, wv);
#endif
    xcd_barrier(bar);
#if defined(XBAR10)
    for (int i = 0; i < 10; ++i) xcd_barrier(bar);
#endif
#if defined(DUP14)
    ph_final<true>(p, wv); __syncthreads();
#endif
    run_phase<14>(p, lds, wv);
}

extern "C" void kernel_launch(void* const* d_in, const int* in_sizes, int n_in, void* d_out, int out_size, void* d_ws, size_t ws_size, hipStream_t stream) {
    static int grid = 0; static bool first = true;
    if (grid == 0) {
        if (n_in != 23 || in_sizes[0] != M * D || out_size != M * D || ws_size < WS_END) { fprintf(stderr, "kernel_launch: unexpected shapes (n_in %d, in0 %d, out %d, ws %zu)\n", n_in, n_in > 0 ? in_sizes[0] : -1, out_size, ws_size); grid = -1; return; }
        int dev = 0, cus = 0;
        if (hipGetDevice(&dev) != hipSuccess || hipDeviceGetAttribute(&cus, hipDeviceAttributeMultiprocessorCount, dev) != hipSuccess) { grid = -1; return; }
        grid = cus;
    }
    if (grid < 0) return;
    unsigned char* ws = (unsigned char*)d_ws;
    (void)hipMemsetAsync(ws + WS_CTL, 0, CTL_ZERO_BYTES, stream);
    P p{};
    const float* const* in = (const float* const*)d_in;
    p.x = in[0]; p.w_in = in[1]; p.kv_g = in[2]; p.w_uk = in[3]; p.w_uv = in[4]; p.rel_bias = in[5]; p.ln_g = in[6]; p.ln_b = in[7]; p.w_sp = in[8]; p.b_sp = in[9];
    p.w_pa = in[10]; p.w_pb = in[11]; p.w_out = in[12]; p.n1g = in[13]; p.n2g = in[14]; p.rg_w = in[15]; p.rg_b = in[16]; p.re_w = in[17]; p.re_b = in[18];
    p.w_gate = in[19]; p.w_up = in[20]; p.w_down = in[21]; p.fg = in[22];
    p.out = (float*)d_out; p.ctl = (unsigned*)(ws + WS_CTL);
    p.WinT = (bf16_t*)(ws + WS_WIN); p.WoutT = (bf16_t*)(ws + WS_WOUT); p.WpbT = (bf16_t*)(ws + WS_WPB); p.WovT = (bf16_t*)(ws + WS_WOV); p.WSB = (bf16_t*)(ws + WS_WSB);
    p.WguT = (bf16_t*)(ws + WS_WGU); p.WdT = (bf16_t*)(ws + WS_WD); p.WrT = (float*)(ws + WS_WRT);
    p.HB = (bf16_t*)(ws + WS_A); p.OL = (bf16_t*)(ws + WS_A); p.H2B = (bf16_t*)(ws + WS_A);
    p.QL = (bf16_t*)(ws + WS_B); p.MB = (bf16_t*)(ws + WS_B); p.H2S = (bf16_t*)(ws + WS_B); p.YS = (bf16_t*)(ws + WS_B);
    p.GAB = (bf16_t*)(ws + WS_GA); p.GBB = (bf16_t*)(ws + WS_GB);
    p.UB = (bf16_t*)(ws + WS_C); p.VB = (bf16_t*)(ws + WS_C + 32 * MiB); p.MG = (bf16_t*)(ws + WS_C); p.HE = (bf16_t*)(ws + WS_C);
    p.QI = (bf16_t*)(ws + WS_DQ); p.US = (bf16_t*)(ws + WS_DQ);
    p.CKVR = (float*)(ws + WS_CKVR); p.CKVB = (bf16_t*)(ws + WS_CKVB); p.KI = (bf16_t*)(ws + WS_KI); p.WI = (float*)(ws + WS_WI); p.SEL = (unsigned short*)(ws + WS_SEL);
    p.EID = (int*)(ws + WS_MOE); p.EW = (float*)(ws + WS_MOE + 262144); p.PTOK = (int*)(ws + WS_MOE + 524288); p.MOEI = (int*)(ws + WS_MOE + 1048576);
    p.GU = (int*)(ws + WS_MOE + 1048576 + 4096); p.BLKCNT = (int*)(ws + WS_MOE + 1048576 + 65536); p.IDXROW = (float*)(ws + WS_A); p.CB = (int*)(ws + WS_MOE + 1048576 + 131072); p.DN = (int*)(ws + WS_MOE + 1048576 + 4096 + 8192);
    if (first) { (void)hipFuncSetAttribute((const void*)k_mega, hipFuncAttributeMaxDynamicSharedMemorySize, LDS_BYTES); first = false; }
    hipLaunchKernelGGL(k_mega, dim3(grid), dim3(NTHR), LDS_BYTES, stream, p);
}
```

```cpp
#include <hip/hip_runtime.h>
#include <cstdio>
#include <cstdint>
__device__ __forceinline__ int opaque_tid(const int wv) { int l; asm volatile("v_mbcnt_lo_u32_b32 %0, -1, 0\n\tv_mbcnt_hi_u32_b32 %0, -1, %0" : "=v"(l)); return (wv << 6) + l; }
#define LAS __attribute__((address_space(3)))
namespace pg8 {
#define PG8_LAS __attribute__((address_space(3)))
typedef unsigned short bf16_t;
typedef short bf16x8 __attribute__((ext_vector_type(8)));
typedef float f32x4 __attribute__((ext_vector_type(4)));
typedef unsigned u32x4 __attribute__((ext_vector_type(4)));
constexpr int BM = 256, BK = 64, HALF = 128, HTB = HALF * BK * 2  , STAGE_BYTES = 8 * HTB, NXCD = 8, WGM = 8;

__host__ __device__ __forceinline__ int lds_byte(int r, int c) { const int st = (r >> 4) * 2 + (c >> 5), rr = r & 15, cc = c & 31, ob = rr * 64 + cc * 2; return st * 1024 + (ob ^ (((ob >> 9) & 1) << 5)); }
__host__ __device__ __forceinline__ void stage_rc(int b, int& R, int& C) { const int st = b / 1024, sb = b % 1024, swz = sb ^ (((sb >> 9) & 1) << 5); R = (st >> 1) * 16 + swz / 64; C = (st & 1) * 32 + (swz % 64) / 2; }
__host__ __device__ __forceinline__ int perm32(int rho) { const int n = rho >> 4, i = rho & 15; return 8 * (i >> 2) + 4 * n + (i & 3); }

struct Unit { int pm, pn; };
struct Gemm { const bf16_t* A; const bf16_t* Bt; int M, N, K; };

struct StaticOrder {
    static constexpr bool GATHER = false;
    int nM, nN, nwg, G, c;
    __host__ __device__ void init(int M, int N, int G_, int c_) { nM = M / BM; nN = N / BM; nwg = nM * nN; G = G_; c = c_; }
    __host__ __device__ bool next(int i, Unit& u) const {
        const long L = (long)i * G + c; if (L >= nwg) return false;
        int wgid = (int)L; { const int q = nwg / NXCD, r = nwg % NXCD, xcd = wgid % NXCD, off = wgid / NXCD; wgid = (xcd < r ? xcd * (q + 1) : r * (q + 1) + (xcd - r) * q) + off; }
        const int nig = WGM * nN, gid = wgid / nig, fm = gid * WGM, gsz = (nM - fm) < WGM ? (nM - fm) : WGM;
        u.pm = fm + ((wgid % nig) % gsz); u.pn = (wgid % nig) / gsz; return true;
    }
    __device__ __forceinline__ int arow(int r) const { return r; }
    __device__ __forceinline__ void a_ready(const Unit&) const {}
    __device__ __forceinline__ void done(const Unit&) const {}
};

__device__ __forceinline__ unsigned cvt_pk_bf16(float lo, float hi) { unsigned r; asm volatile("v_cvt_pk_bf16_f32 %0, %1, %2" : "=v"(r) : "v"(lo), "v"(hi)); return r; }
typedef float f32x2 __attribute__((ext_vector_type(2)));
template <class Epi, class Sched, bool ALIGN_EPI = false, bool SP2 = false>
__device__ __forceinline__ void gemm_phase(PG8_LAS unsigned char* lds, const Gemm g, const Sched& S, const Epi& E, const int wv) {
    const int tid = opaque_tid(wv), wid = __builtin_amdgcn_readfirstlane(tid >> 6), lane = tid & 63, wr = wid >> 2, wc = wid & 3, fr = lane & 15, fq = lane >> 4;
    const int K = g.K, nt = K / BK;
    unsigned voffA[2], voffB[2];
#pragma unroll
    for (int i = 0; i < 2; ++i) { int R, C; stage_rc(tid * 16 + i * 8192, R, C); const int Rb = Epi::PERM ? ((R & ~31) + perm32(R & 31)) : R;
        voffA[i] = (unsigned)(R * K + C) * 2u; voffB[i] = (unsigned)(Rb * K + C) * 2u; }
    static_assert(!Sched::GATHER || SP2, "gathered A rows: SP2 loop only");
    unsigned gcur[2][2], gnxt[2][2]; int gR[2], gC[2];
    if constexpr (Sched::GATHER) {
#pragma unroll
        for (int i = 0; i < 2; ++i) { stage_rc(tid * 16 + i * 8192, gR[i], gC[i]); }
    }
#define PG8_GOFF(dst, u_) do { _Pragma("unroll") for (int h_ = 0; h_ < 2; ++h_) _Pragma("unroll") for (int i_ = 0; i_ < 2; ++i_) \
        dst[h_][i_] = ((unsigned)S.arow((u_).pm * BM + h_ * HALF + gR[i_]) * (unsigned)K + (unsigned)gC[i_]) * 2u; } while (0)
    const size_t kstep = (size_t)(BK * 2);
    const size_t hstep = (size_t)HALF * K * 2;
    const size_t tstep = 2 * hstep;
    const unsigned ldsw = (unsigned)wid * 1024u;
    const int aoff = lds_byte(wr * 64 + fr, fq * 8), boff = lds_byte(wc * 32 + fr, fq * 8);
#define PG8_SA(b, h) (((b) * 2 + (h)) * HTB)
#define PG8_SB(b, h) ((4 + (b) * 2 + (h)) * HTB)
#define PG8_STAGE(bufoff, gbase, voff) do { _Pragma("unroll") for (int _i = 0; _i < 2; ++_i) \
        __builtin_amdgcn_global_load_lds((const unsigned*)((const char*)(gbase) + (voff)[_i]), (PG8_LAS unsigned*)(lds + (bufoff) + ldsw + _i * 8192), 16, 0, 0); } while (0)
#define PG8_LDA(dst, b, h) do { _Pragma("unroll") for (int m = 0; m < 4; ++m) _Pragma("unroll") for (int k = 0; k < 2; ++k) dst[m][k] = *(const PG8_LAS bf16x8*)(lds + PG8_SA(b, h) + aoff + m * 2048 + k * 1024); } while (0)
#define PG8_LDB(dst, b, h) do { _Pragma("unroll") for (int n = 0; n < 2; ++n) _Pragma("unroll") for (int k = 0; k < 2; ++k) dst[n][k] = *(const PG8_LAS bf16x8*)(lds + PG8_SB(b, h) + boff + n * 2048 + k * 1024); } while (0)
#define PG8_MMA(ai, bj, At, Bt) do { __builtin_amdgcn_s_setprio(1); _Pragma("unroll") for (int m = 0; m < 4; ++m) _Pragma("unroll") for (int n = 0; n < 2; ++n) _Pragma("unroll") for (int k = 0; k < 2; ++k) \
        acc[ai][bj][m][n] = __builtin_amdgcn_mfma_f32_16x16x32_bf16(Bt[n][k], At[m][k], acc[ai][bj][m][n], 0, 0, 0); __builtin_amdgcn_s_setprio(0); } while (0)
#define PG8_WAIT_V(n) asm volatile("s_waitcnt vmcnt(" #n ")" ::: "memory")
#define PG8_WAIT_L(n) asm volatile("s_waitcnt lgkmcnt(" #n ")" ::: "memory")
#define PG8_BAR __builtin_amdgcn_s_barrier()
#define PG8_SCHED __builtin_amdgcn_sched_barrier(0)
    Unit cur, nxt; int ui = 0;
    if (!S.next(0, cur)) return;
    f32x4 acc[2][2][4][2];
#pragma unroll
    for (int a = 0; a < 2; ++a)
#pragma unroll
        for (int b = 0; b < 2; ++b)
#pragma unroll
            for (int m = 0; m < 4; ++m)
#pragma unroll
                for (int n = 0; n < 2; ++n) acc[a][b][m][n] = (f32x4){0.f, 0.f, 0.f, 0.f};
    bf16x8 At[4][2], B0[2][2], B1[2][2];
    const char* cA = Sched::GATHER ? (const char*)g.A : (const char*)g.A + (size_t)cur.pm * tstep; const char* cB = (const char*)g.Bt + (size_t)cur.pn * tstep;
    S.a_ready(cur);
    if constexpr (Sched::GATHER) { PG8_GOFF(gcur, cur); }
#define PG8_STAGE_A(bufoff, base_, h_, koff_, GO_) do { if constexpr (Sched::GATHER) { PG8_STAGE(bufoff, (const char*)g.A + (koff_), GO_[h_]); } else { PG8_STAGE(bufoff, (base_) + (h_) * hstep + (koff_), voffA); } } while (0)
    if constexpr (SP2) {
        PG8_STAGE(PG8_SB(0, 0), cB, voffB); PG8_STAGE(PG8_SB(0, 1), cB + hstep, voffB); PG8_STAGE_A(PG8_SA(0, 0), cA, 0, 0, gcur); PG8_STAGE_A(PG8_SA(0, 1), cA, 1, 0, gcur);
        if (wr == 1) PG8_BAR;
        PG8_WAIT_V(2); PG8_BAR;
        PG8_STAGE(PG8_SB(1, 0), cB + kstep, voffB); PG8_STAGE_A(PG8_SA(1, 0), cA, 0, kstep, gcur); PG8_STAGE(PG8_SB(1, 1), cB + hstep + kstep, voffB);
        PG8_WAIT_V(6); PG8_BAR;
    } else {
        PG8_STAGE(PG8_SB(0, 0), cB, voffB); PG8_STAGE(PG8_SA(0, 0), cA, voffA); PG8_STAGE(PG8_SB(0, 1), cB + hstep, voffB); PG8_STAGE(PG8_SA(0, 1), cA + hstep, voffA);
        if (wr == 1) PG8_BAR;
        PG8_WAIT_V(4); PG8_BAR;
        PG8_STAGE(PG8_SB(1, 0), cB + kstep, voffB); PG8_STAGE(PG8_SA(1, 0), cA + kstep, voffA); PG8_STAGE(PG8_SB(1, 1), cB + hstep + kstep, voffB);
        PG8_WAIT_V(6); PG8_BAR;
    }
    for (;;) {
        const bool has_next = S.next(ui + 1, nxt);
        const char* nA = Sched::GATHER ? cA : (has_next ? (const char*)g.A + (size_t)nxt.pm * tstep : cA); const char* nB = has_next ? (const char*)g.Bt + (size_t)nxt.pn * tstep : cB;
        if constexpr (Sched::GATHER) { if (has_next) { PG8_GOFF(gnxt, nxt); } else { _Pragma("unroll") for (int h_ = 0; h_ < 2; ++h_) _Pragma("unroll") for (int i_ = 0; i_ < 2; ++i_) gnxt[h_][i_] = gcur[h_][i_]; } }
        for (int t = 0; t < nt; t += 2) {
            const bool last = (t == nt - 2);
            const char* a1 = cA + (size_t)(t + 1) * kstep;
            const char* a2 = last ? nA : cA + (size_t)(t + 2) * kstep; const char* b2 = last ? nB : cB + (size_t)(t + 2) * kstep;
            const char* a3 = a2 + kstep; const char* b3 = b2 + kstep;
            unsigned g2[2][2];
            if constexpr (Sched::GATHER) { _Pragma("unroll") for (int h_ = 0; h_ < 2; ++h_) _Pragma("unroll") for (int i_ = 0; i_ < 2; ++i_) g2[h_][i_] = last ? gnxt[h_][i_] : gcur[h_][i_]; }
            const size_t k1 = (size_t)(t + 1) * kstep, k2 = last ? (size_t)0 : (size_t)(t + 2) * kstep, k3 = k2 + kstep;
            if (last && has_next) S.a_ready(nxt);
            if constexpr (SP2) {
            PG8_LDB(B0, 0, 0); PG8_LDB(B1, 0, 1); PG8_SCHED; PG8_LDA(At, 0, 0); if constexpr (Sched::GATHER) { PG8_STAGE(PG8_SA(1, 1), (const char*)g.A + k1, gcur[1]); } else { PG8_STAGE(PG8_SA(1, 1), a1 + hstep, voffA); }
            PG8_WAIT_V(8); PG8_WAIT_L(0); PG8_BAR; PG8_MMA(0, 0, At, B0); PG8_MMA(0, 1, At, B1); PG8_BAR; PG8_SCHED;
            PG8_LDA(At, 0, 1); PG8_STAGE(PG8_SB(0, 0), b2, voffB); PG8_STAGE(PG8_SB(0, 1), b2 + hstep, voffB); if constexpr (Sched::GATHER) { PG8_STAGE(PG8_SA(0, 0), (const char*)g.A + k2, g2[0]); } else { PG8_STAGE(PG8_SA(0, 0), a2, voffA); }
            PG8_WAIT_V(8); PG8_WAIT_L(0); PG8_BAR; PG8_MMA(1, 0, At, B0); PG8_MMA(1, 1, At, B1); PG8_BAR; PG8_SCHED;
            PG8_LDB(B0, 1, 0); PG8_LDB(B1, 1, 1); PG8_SCHED; PG8_LDA(At, 1, 0); if constexpr (Sched::GATHER) { PG8_STAGE(PG8_SA(0, 1), (const char*)g.A + k2, g2[1]); } else { PG8_STAGE(PG8_SA(0, 1), a2 + hstep, voffA); }
            PG8_WAIT_V(8); PG8_WAIT_L(0); PG8_BAR; PG8_MMA(0, 0, At, B0); PG8_MMA(0, 1, At, B1); PG8_BAR; PG8_SCHED;
            PG8_LDA(At, 1, 1); PG8_STAGE(PG8_SB(1, 0), b3, voffB); PG8_STAGE(PG8_SB(1, 1), b3 + hstep, voffB); if constexpr (Sched::GATHER) { PG8_STAGE(PG8_SA(1, 0), (const char*)g.A + k3, g2[0]); } else { PG8_STAGE(PG8_SA(1, 0), a3, voffA); }
            PG8_WAIT_V(8); PG8_WAIT_L(0); PG8_BAR; PG8_MMA(1, 0, At, B0); PG8_MMA(1, 1, At, B1); PG8_BAR; PG8_SCHED;
            } else {
            PG8_LDB(B0, 0, 0); PG8_SCHED; PG8_LDA(At, 0, 0); PG8_STAGE(PG8_SA(1, 1), a1 + hstep, voffA);
            PG8_WAIT_L(8); PG8_BAR; PG8_WAIT_L(0); PG8_MMA(0, 0, At, B0); PG8_BAR; PG8_SCHED;
            PG8_LDB(B1, 0, 1); PG8_STAGE(PG8_SB(0, 0), b2, voffB);
            PG8_BAR; PG8_WAIT_L(0); PG8_MMA(0, 1, At, B1); PG8_BAR;
            PG8_LDA(At, 0, 1); PG8_STAGE(PG8_SA(0, 0), a2, voffA);
            PG8_BAR; PG8_WAIT_L(0); PG8_MMA(1, 0, At, B0); PG8_BAR; PG8_SCHED;
            PG8_STAGE(PG8_SB(0, 1), b2 + hstep, voffB);
            PG8_WAIT_V(6); PG8_BAR; PG8_MMA(1, 1, At, B1); PG8_BAR;
            PG8_LDB(B0, 1, 0); PG8_SCHED; PG8_LDA(At, 1, 0); PG8_STAGE(PG8_SA(0, 1), a2 + hstep, voffA);
            PG8_WAIT_L(8); PG8_BAR; PG8_WAIT_L(0); PG8_MMA(0, 0, At, B0); PG8_BAR; PG8_SCHED;
            PG8_LDB(B1, 1, 1); PG8_STAGE(PG8_SB(1, 0), b3, voffB);
            PG8_BAR; PG8_WAIT_L(0); PG8_MMA(0, 1, At, B1); PG8_BAR;
            PG8_LDA(At, 1, 1); PG8_STAGE(PG8_SA(1, 0), a3, voffA);
            PG8_BAR; PG8_WAIT_L(0); PG8_MMA(1, 0, At, B0); PG8_BAR; PG8_SCHED;
            PG8_STAGE(PG8_SB(1, 1), b3 + hstep, voffB);
            PG8_WAIT_V(6); PG8_BAR; PG8_MMA(1, 1, At, B1); PG8_BAR;
            }
        }
        if constexpr (ALIGN_EPI) { if (wr == 0) PG8_BAR; }
        if constexpr (!Epi::AFTER_DRAIN) {
            const int tz = opaque_tid(wv), wz = __builtin_amdgcn_readfirstlane(tz >> 6), lz = tz & 63;
            E(acc, cur, wz >> 2, wz & 3, lz & 15, lz >> 4); S.done(cur); }
        if (!has_next) break;
#pragma unroll
        for (int a = 0; a < 2; ++a)
#pragma unroll
            for (int b = 0; b < 2; ++b)
#pragma unroll
                for (int m = 0; m < 4; ++m)
#pragma unroll
                    for (int n = 0; n < 2; ++n) acc[a][b][m][n] = (f32x4){0.f, 0.f, 0.f, 0.f};
        cur = nxt; cA = nA; cB = nB; ++ui;
        if constexpr (Sched::GATHER) { _Pragma("unroll") for (int h_ = 0; h_ < 2; ++h_) _Pragma("unroll") for (int i_ = 0; i_ < 2; ++i_) gcur[h_][i_] = gnxt[h_][i_]; }
        if constexpr (ALIGN_EPI) { if (wr == 1) PG8_BAR; }
    }
    PG8_WAIT_V(0);
    if constexpr (!ALIGN_EPI) { if (wr == 0) PG8_BAR; }
    PG8_BAR;
    if constexpr (Epi::AFTER_DRAIN) { E.fused(acc, cur, wr, wc, fr, fq, lds, wid, lane); S.done(cur); }
#undef PG8_SA
#undef PG8_SB
#undef PG8_STAGE
#undef PG8_STAGE_A
#undef PG8_GOFF
#undef PG8_LDA
#undef PG8_LDB
#undef PG8_MMA
#undef PG8_WAIT_V
#undef PG8_WAIT_L
#undef PG8_BAR
#undef PG8_SCHED
}
}
#define XB_TMO      128
#define XB_XCNT(j)  (256  + 64 * (j))
#define XB_XSUB(j)  (1280 + 64 * (j))
#define XB_XGEN(j)  (2304 + 64 * (j))
#define XB_TOP      3328
#define XB_TOPGEN   3392
#define XCD_BAR_WORDS 3456
#define XB_SPIN_CAP (1u << 18)

__device__ __forceinline__ unsigned xb_ld(unsigned* p)              { return __hip_atomic_load(p, __ATOMIC_RELAXED, __HIP_MEMORY_SCOPE_AGENT); }
__device__ __forceinline__ unsigned xb_add(unsigned* p, unsigned v) { return __hip_atomic_fetch_add(p, v, __ATOMIC_RELAXED, __HIP_MEMORY_SCOPE_AGENT); }
__device__ __forceinline__ unsigned xb_xcc_id() { return (unsigned)__builtin_amdgcn_s_getreg((3 << 11) | 20) & 0xFu; }
#define XB_SPIN(cond, bar) do { unsigned _sp = 0; while (cond) { __builtin_amdgcn_s_sleep(1); \
    if ((++_sp & 255u) == 0u) { if (xb_ld(&(bar)[XB_TMO])) break; if (_sp > XB_SPIN_CAP) { atomicAdd(&(bar)[XB_TMO], 1u); break; } } } } while (0)

struct XcdBarrier {
    unsigned* bar; unsigned x; int wv;
    volatile LAS unsigned* st;
};

__device__ __forceinline__ XcdBarrier xcd_barrier_post(unsigned* bar, volatile LAS unsigned* st, int wv) {
    XcdBarrier b; b.bar = bar; b.x = xb_xcc_id(); b.st = st; b.wv = wv;
    if (opaque_tid(wv) == 0) (void)xb_add(&bar[XB_XCNT(b.x)], 1u);
    return b;
}
__device__ __forceinline__ void xcd_barrier_complete(unsigned* bar, unsigned x, unsigned& nloc, unsigned& nx) {
    const unsigned G = gridDim.x * gridDim.y * gridDim.z;
    unsigned sum, cnt, mine, sp = 0u;
    for (;;) {
        sum = 0u; cnt = 0u; mine = 0u;
#pragma unroll
        for (unsigned j = 0; j < 16; ++j) { const unsigned c = xb_ld(&bar[XB_XCNT(j)]); sum += c; cnt += (c > 0u) ? 1u : 0u; mine = (j == x) ? c : mine; }
        if (sum == G) break;
        __builtin_amdgcn_s_sleep(1);
        if ((++sp & 255u) == 0u) { if (xb_ld(&bar[XB_TMO])) break; if (sp > XB_SPIN_CAP) { atomicAdd(&bar[XB_TMO], 1u); break; } }
    }
    nloc = mine > 0u ? mine : 1u; nx = cnt > 0u ? cnt : 1u;
}

__device__ __forceinline__ void xcd_barrier(const XcdBarrier& b) {
    asm volatile("s_waitcnt vmcnt(0)" ::: "memory");
    __syncthreads();
    if (opaque_tid(b.wv) == 0) {
        unsigned* bar = b.bar;
        __builtin_amdgcn_s_waitcnt(0);
        unsigned nloc = b.st[0], nx = b.st[1];
        if (nloc == 0u) { xcd_barrier_complete(bar, b.x, nloc, nx); b.st[0] = nloc; b.st[1] = nx; }
        const unsigned old = xb_add(&bar[XB_XSUB(b.x)], 1u);
        const unsigned gen = old / nloc;
        if (old + 1u == (gen + 1u) * nloc) {
            __builtin_amdgcn_fence(__ATOMIC_RELEASE, "agent");
            asm volatile("s_waitcnt vmcnt(0)" ::: "memory");
            const unsigned og = xb_add(&bar[XB_TOP], 1u);
            const unsigned tg = og / nx;
            if (og + 1u == (tg + 1u) * nx) xb_add(&bar[XB_TOPGEN], 1u);
            else XB_SPIN(xb_ld(&bar[XB_TOPGEN]) == tg, bar);
            __builtin_amdgcn_fence(__ATOMIC_ACQUIRE, "agent");
            xb_add(&bar[XB_XGEN(b.x)], 1u);
            asm volatile("s_waitcnt vmcnt(0)" ::: "memory");
        } else {
            XB_SPIN(xb_ld(&bar[XB_XGEN(b.x)]) == gen, bar);
            __builtin_amdgcn_fence(__ATOMIC_ACQUIRE, "agent");
            asm volatile("s_waitcnt vmcnt(0)" ::: "memory");
        }
    }
    __syncthreads();
}

typedef unsigned short bf16_t;
typedef short bf16x8 __attribute__((ext_vector_type(8)));
typedef short bf16x4 __attribute__((ext_vector_type(4)));
typedef float f32x4 __attribute__((ext_vector_type(4)));
typedef float f32x2 __attribute__((ext_vector_type(2)));
typedef float f32x16 __attribute__((ext_vector_type(16)));
typedef unsigned u32x4 __attribute__((ext_vector_type(4)));
typedef unsigned u32x2 __attribute__((ext_vector_type(2)));

constexpr int NB = 8, T = 4096, D = 1024, M = NB * T;
constexpr int INC = 4296;
constexpr int NIN = 19 * 256;
constexpr float EPS = 1e-6f;
constexpr int NPOS = 73728;
constexpr int NWAVES = 8, NTHR = 512;
constexpr int LDS_BYTES = 163840;

constexpr size_t MiB = 1u << 20;
constexpr size_t WS_CTL = 0, CTL_ZERO_BYTES = 65536;
constexpr size_t WS_WIN = 1 * MiB, WS_WOUT = 11 * MiB, WS_WPB = 13 * MiB, WS_WOV = 14 * MiB, WS_WSB = 16 * MiB, WS_WRT = 16 * MiB + 262144, WS_WGU = 17 * MiB, WS_WD = 49 * MiB;
constexpr size_t WS_A = 65 * MiB;
constexpr size_t WS_B = 129 * MiB;
constexpr size_t WS_GA = 193 * MiB, WS_GB = 257 * MiB;
constexpr size_t WS_C = 321 * MiB;
constexpr size_t WS_DQ = 385 * MiB;
constexpr size_t WS_CKVR = 417 * MiB, WS_CKVB = 433 * MiB, WS_KI = 441 * MiB, WS_WI = 445 * MiB, WS_SEL = 446 * MiB;
constexpr size_t WS_MOE = 462 * MiB;
constexpr size_t WS_END = 464 * MiB;

constexpr int CW_BAR = 4096;
constexpr int CW_CNT = 8192, CW_CUR = 8256;

struct P {
    const float *x, *w_in, *kv_g, *w_uk, *w_uv, *rel_bias, *ln_g, *ln_b, *w_sp, *b_sp, *w_pa, *w_pb, *w_out, *n1g, *n2g, *rg_w, *rg_b, *re_w, *re_b, *w_gate, *w_up, *w_down, *fg;
    float* out;
    unsigned* ctl;
    bf16_t *WinT, *WoutT, *WpbT, *WovT, *WSB, *WguT, *WdT;
    float* WrT;
    bf16_t *HB, *QL, *QI, *CKVB, *KI, *UB, *VB, *GAB, *GBB, *OL, *US, *MB, *MG, *H2B, *H2S, *HE, *YS;
    float *CKVR, *WI, *EW, *IDXROW, *RINV2;
    unsigned short* SEL;
    int *EID, *PTOK, *MOEI, *GU, *DN, *BLKCNT, *CB;
};

__device__ __forceinline__ unsigned f2bf(float f) { unsigned u = __builtin_bit_cast(unsigned, f); return (u + 0x7fffu + ((u >> 16) & 1u)) >> 16; }
__device__ __forceinline__ unsigned pk2(float lo, float hi) { return f2bf(lo) | (f2bf(hi) << 16); }
__device__ __forceinline__ float bflo(unsigned w) { return __builtin_bit_cast(float, w << 16); }
__device__ __forceinline__ float bfhi(unsigned w) { return __builtin_bit_cast(float, w & 0xffff0000u); }
__device__ __forceinline__ float bf2f(unsigned short b) { return __builtin_bit_cast(float, (unsigned)b << 16); }
__device__ __forceinline__ float wave_sum(float v) {
#pragma unroll
    for (int o = 1; o < 64; o <<= 1) v += __shfl_xor(v, o);
    return v;
}
#define LDS_WAIT() asm volatile("s_waitcnt lgkmcnt(0)" ::: "memory")
__device__ __forceinline__ float sigm(float x) { return __builtin_amdgcn_rcpf(1.f + __builtin_amdgcn_exp2f(-1.4426950409f * x)); }
__device__ __forceinline__ float gelu_t(float x) { const float x2 = x * x; return x * __builtin_amdgcn_rcpf(1.f + __builtin_amdgcn_exp2f(x * (-2.3022082f - 0.1029432f * x2))); }
__device__ __forceinline__ unsigned off_b(unsigned row, unsigned ch) { return 256u * row + 16u * (ch ^ (((row & 3) << 2) | ((row >> 2) & 3))); }
__device__ __forceinline__ bf16x4 tr_read(unsigned lds_addr) { bf16x4 r; asm volatile("ds_read_b64_tr_b16 %0, %1\n\ts_waitcnt lgkmcnt(0)" : "=&v"(r) : "v"(lds_addr) : "memory"); return r; }
__device__ __forceinline__ bf16x8 cat4(bf16x4 a, bf16x4 b) { bf16x8 r; r[0] = a[0]; r[1] = a[1]; r[2] = a[2]; r[3] = a[3]; r[4] = b[0]; r[5] = b[1]; r[6] = b[2]; r[7] = b[3]; return r; }
__device__ __forceinline__ unsigned lds_addr_of(LAS unsigned char* p) { return (unsigned)(unsigned long long)p; }

__device__ __forceinline__ void st8bf(bf16_t* p, const pg8::f32x4& a, const pg8::f32x4& b) {
    u32x4 w; w.x = pg8::cvt_pk_bf16(a[0], a[1]); w.y = pg8::cvt_pk_bf16(a[2], a[3]); w.z = pg8::cvt_pk_bf16(b[0], b[1]); w.w = pg8::cvt_pk_bf16(b[2], b[3]);
    *(u32x4*)p = w;
}
__device__ __forceinline__ void ld8bf(const bf16_t* p, pg8::f32x4& a, pg8::f32x4& b) {
    const u32x4 w = *(const u32x4*)p;
    a[0] = bflo(w.x); a[1] = bfhi(w.x); a[2] = bflo(w.y); a[3] = bfhi(w.y); b[0] = bflo(w.z); b[1] = bfhi(w.z); b[2] = bflo(w.w); b[3] = bfhi(w.w);
}

struct EpiIn {
    static constexpr bool PERM = true, AFTER_DRAIN = false;
    bf16_t *QL, *QI, *KI, *UB, *VB, *GAB, *GBB; float *CKVR, *WI;
    __device__ __forceinline__ void operator()(const pg8::f32x4 (&acc)[2][2][4][2], const pg8::Unit& u, int wr, int wc, int fr, int fq) const {
        const int row0 = u.pm * 256 + wr * 64 + fr, pn = u.pn, c8 = wc * 32 + 8 * fq;
        int mode; bf16_t* dst; int ld;
        if (pn < 4)       { mode = 0; dst = QL + pn * 256; ld = 1024; }
        else if (pn < 6)  { mode = 0; dst = QI + (pn - 4) * 256; ld = 512; }
        else if (pn == 6) { mode = 3; dst = KI; ld = 64; }
        else if (pn < 9)  { mode = 1; dst = UB + (pn - 7) * 256; ld = 512; }
        else if (pn < 11) { mode = 1; dst = VB + (pn - 9) * 256; ld = 512; }
        else if (pn < 15) { mode = 2; dst = GAB + (pn - 11) * 256; ld = 1024; }
        else              { mode = 2; dst = GBB + (pn - 15) * 256; ld = 1024; }
#pragma unroll
        for (int ai = 0; ai < 2; ++ai)
#pragma unroll
            for (int m = 0; m < 4; ++m) {
                const size_t row = (size_t)(row0 + ai * 128 + m * 16);
#pragma unroll
                for (int bj = 0; bj < 2; ++bj) {
                    pg8::f32x4 v0 = acc[ai][bj][m][0], v1 = acc[ai][bj][m][1];
                    if (mode == 3) {
                        if (bj == 0) { float* c = CKVR + row * 128 + c8; *(pg8::f32x4*)c = v0; *(pg8::f32x4*)(c + 4) = v1; }
                        else if (c8 < 64) st8bf(KI + row * 64 + c8, v0, v1);
                        else if (c8 == 64) { float* c = WI + row * 8; *(pg8::f32x4*)c = v0 * 0.044194174f; *(pg8::f32x4*)(c + 4) = v1 * 0.044194174f; }
                    } else {
                        if (mode == 1) {
#pragma unroll
                            for (int j = 0; j < 4; ++j) { v0[j] = gelu_t(v0[j]); v1[j] = gelu_t(v1[j]); }
                        } else if (mode == 2) {
#pragma unroll
                            for (int j = 0; j < 4; ++j) { v0[j] = sigm(v0[j]); v1[j] = sigm(v1[j]); }
                        }
                        st8bf(dst + row * ld + bj * 128 + c8, v0, v1);
                    }
                }
            }
    }
};

struct EpiMB {
    static constexpr bool PERM = true, AFTER_DRAIN = false;
    const bf16_t* G; bf16_t* O;
    __device__ __forceinline__ void operator()(const pg8::f32x4 (&acc)[2][2][4][2], const pg8::Unit& u, int wr, int wc, int fr, int fq) const {
        const int row0 = u.pm * 256 + wr * 64 + fr, col0 = u.pn * 256 + wc * 32 + 8 * fq;
#pragma unroll
        for (int ai = 0; ai < 2; ++ai)
#pragma unroll
            for (int m = 0; m < 4; ++m)
#pragma unroll
                for (int bj = 0; bj < 2; ++bj) {
                    const size_t o = (size_t)(row0 + ai * 128 + m * 16) * 1024 + col0 + bj * 128;
                    pg8::f32x4 g0, g1; ld8bf(G + o, g0, g1);
                    st8bf(O + o, acc[ai][bj][m][0] * g0, acc[ai][bj][m][1] * g1);
                }
    }
};
struct EpiMG {
    static constexpr bool PERM = true, AFTER_DRAIN = false;
    const bf16_t *G, *MBp; bf16_t* O;
    __device__ __forceinline__ void operator()(const pg8::f32x4 (&acc)[2][2][4][2], const pg8::Unit& u, int wr, int wc, int fr, int fq) const {
        const int row0 = u.pm * 256 + wr * 64 + fr, col0 = u.pn * 256 + wc * 32 + 8 * fq;
#pragma unroll
        for (int ai = 0; ai < 2; ++ai)
#pragma unroll
            for (int m = 0; m < 4; ++m)
#pragma unroll
                for (int bj = 0; bj < 2; ++bj) {
                    const size_t o = (size_t)(row0 + ai * 128 + m * 16) * 1024 + col0 + bj * 128;
                    pg8::f32x4 g0, g1, b0, b1; ld8bf(G + o, g0, g1); ld8bf(MBp + o, b0, b1);
                    st8bf(O + o, acc[ai][bj][m][0] * g0 + b0, acc[ai][bj][m][1] * g1 + b1);
                }
    }
};
struct EpiX1 {
    static constexpr bool PERM = true, AFTER_DRAIN = false;
    const float* X; float* O;
    __device__ __forceinline__ void operator()(const pg8::f32x4 (&acc)[2][2][4][2], const pg8::Unit& u, int wr, int wc, int fr, int fq) const {
        const int row0 = u.pm * 256 + wr * 64 + fr, col0 = u.pn * 256 + wc * 32 + 8 * fq;
#pragma unroll
        for (int ai = 0; ai < 2; ++ai)
#pragma unroll
            for (int m = 0; m < 4; ++m)
#pragma unroll
                for (int bj = 0; bj < 2; ++bj) {
                    const size_t o = (size_t)(row0 + ai * 128 + m * 16) * 1024 + col0 + bj * 128;
                    const pg8::f32x4 x0 = *(const pg8::f32x4*)(X + o), x1 = *(const pg8::f32x4*)(X + o + 4);
                    *(pg8::f32x4*)(O + o) = x0 + acc[ai][bj][m][0]; *(pg8::f32x4*)(O + o + 4) = x1 + acc[ai][bj][m][1];
                }
    }
};
struct EpiHE {
    static constexpr bool PERM = true, AFTER_DRAIN = false;
    bf16_t* HE; const int* PTOK; const float* RINV2;
    __device__ __forceinline__ void operator()(const pg8::f32x4 (&acc)[2][2][4][2], const pg8::Unit& u, int wr, int wc, int fr, int fq) const {
        const int row0 = u.pm * 256 + wr * 64 + fr, col0 = (u.pn & 1) * 128 + wc * 32 + 8 * fq;
#pragma unroll
        for (int ai = 0; ai < 2; ++ai) {
            int ts[4]; float ri[4];
#pragma unroll
            for (int m = 0; m < 4; ++m) ts[m] = PTOK[row0 + ai * 128 + m * 16];
#pragma unroll
            for (int m = 0; m < 4; ++m) ri[m] = RINV2[ts[m] < 0 ? 0 : (ts[m] >> 1)];
#pragma unroll
            for (int m = 0; m < 4; ++m) {
                const float r = ts[m] < 0 ? 0.f : ri[m];
                pg8::f32x4 h0, h1;
#pragma unroll
                for (int j = 0; j < 4; ++j) {
                    const float g0 = r * acc[ai][0][m][0][j], g1 = r * acc[ai][0][m][1][j];
                    h0[j] = g0 * sigm(g0) * (r * acc[ai][1][m][0][j]); h1[j] = g1 * sigm(g1) * (r * acc[ai][1][m][1][j]);
                }
                st8bf(HE + (size_t)(row0 + ai * 128 + m * 16) * 256 + col0, h0, h1);
            }
        }
    }
};
struct EpiDown {
    static constexpr bool PERM = true, AFTER_DRAIN = false;
    const int* PTOK; const float* EW; bf16_t* YS;
    __device__ __forceinline__ void operator()(const pg8::f32x4 (&acc)[2][2][4][2], const pg8::Unit& u, int wr, int wc, int fr, int fq) const {
        const int row0 = u.pm * 256 + wr * 64 + fr, col0 = (u.pn & 3) * 256 + wc * 32 + 8 * fq;
#pragma unroll
        for (int ai = 0; ai < 2; ++ai) {
            int ts[4]; float w[4];
#pragma unroll
            for (int m = 0; m < 4; ++m) ts[m] = PTOK[row0 + ai * 128 + m * 16];
#pragma unroll
            for (int m = 0; m < 4; ++m) w[m] = EW[ts[m] < 0 ? 0 : ts[m]];
#pragma unroll
            for (int m = 0; m < 4; ++m) {
                const int t = ts[m];
                if (t >= 0) {
                    bf16_t* d = YS + ((size_t)(t & 1) * M + (size_t)(t >> 1)) * 1024 + col0;
#pragma unroll
                    for (int bj = 0; bj < 2; ++bj) st8bf(d + bj * 128, acc[ai][bj][m][0] * w[m], acc[ai][bj][m][1] * w[m]);
                }
            }
        }
    }
};
constexpr int LDS_TAB_OFF = 155648;
__device__ __forceinline__ void table_prefetch(LAS unsigned char* lds, const int* tab, const int* nunits, int G, int c, int tid) {
    LAS int* lt = (LAS int*)(lds + LDS_TAB_OFF);
    if (tid < 16) { const int idx = (tid >> 1) * G + c; const int n = __builtin_nontemporal_load(nunits); lt[tid] = idx < n ? tab[2 * idx + (tid & 1)] : -1; }
    __syncthreads();
}
struct TableOrder {
    static constexpr bool GATHER = false;
    const int* tab; const int* nunits; int G, c; const LAS int* lt;
    __device__ __forceinline__ int arow(int r) const { return r; }
    __device__ __forceinline__ bool next(int i, pg8::Unit& u) const {
        if (i < 8) { const int a = lt[2 * i]; if (a < 0) return false; u.pm = a; u.pn = lt[2 * i + 1]; return true; }
        const int idx = i * G + c; const int n = __builtin_nontemporal_load(nunits);
        if (idx >= n) return false;
        u.pm = tab[2 * idx]; u.pn = tab[2 * idx + 1]; return true;
    }
    __device__ __forceinline__ void a_ready(const pg8::Unit&) const {}
    __device__ __forceinline__ void done(const pg8::Unit&) const {}
};

struct TableGatherOrder {
    static constexpr bool GATHER = true;
    const int* tab; const int* nunits; const int* ptok; int G, c; const LAS int* lt;
    __device__ __forceinline__ bool next(int i, pg8::Unit& u) const {
        if (i < 8) { const int a = lt[2 * i]; if (a < 0) return false; u.pm = a; u.pn = lt[2 * i + 1]; return true; }
        const int idx = i * G + c; const int n = __builtin_nontemporal_load(nunits);
        if (idx >= n) return false;
        u.pm = tab[2 * idx]; u.pn = tab[2 * idx + 1]; return true;
    }
    __device__ __forceinline__ int arow(int r) const { const int ts = ptok[r]; return ts < 0 ? 0 : (ts >> 1); }
    __device__ __forceinline__ void a_ready(const pg8::Unit&) const {}
    __device__ __forceinline__ void done(const pg8::Unit&) const {}
};

__device__ __forceinline__ void tr_item(const float* src, int ld, int K, int NC, bf16_t* dst, LAS float* scr, int item, int lane) {
    const int nblk = NC / 32, kb = item / nblk, nb = item % nblk, k0 = 64 * kb, n0 = 32 * nb;
    f32x4 tv[8];
    const int tr = lane >> 3, tc = (lane & 7) * 4;
    if ((((size_t)src) & 15) == 0 && (ld & 3) == 0) {
#pragma unroll
        for (int i = 0; i < 8; ++i) tv[i] = *(const f32x4*)(src + (size_t)(k0 + 8 * i + tr) * ld + n0 + tc);
    } else {
#pragma unroll
        for (int i = 0; i < 8; ++i) { const float* q = src + (size_t)(k0 + 8 * i + tr) * ld + n0 + tc; tv[i] = (f32x4){q[0], q[1], q[2], q[3]}; }
    }
#pragma unroll
    for (int i = 0; i < 8; ++i) { LAS float* d = scr + (8 * i + tr) * 33 + tc; d[0] = tv[i].x; d[1] = tv[i].y; d[2] = tv[i].z; d[3] = tv[i].w; }
    LDS_WAIT();
    const int c = lane & 7;
#pragma unroll
    for (int j = 0; j < 4; ++j) { const int n = (lane >> 3) + 8 * j; const LAS float* s = scr + (8 * c) * 33 + n;
        u32x4 o; o.x = pk2(s[0 * 33], s[1 * 33]); o.y = pk2(s[2 * 33], s[3 * 33]); o.z = pk2(s[4 * 33], s[5 * 33]); o.w = pk2(s[6 * 33], s[7 * 33]);
        *(u32x4*)(dst + (size_t)(n0 + n) * K + k0 + 8 * c) = o; }
    LDS_WAIT();
}

__device__ __forceinline__ void prep_gateup(const P& p, LAS unsigned char* lds, int w_idx, int nw, int wave, int lane) {
    LAS float* scr = (LAS float*)(lds + wave * 16384);
    for (int it = w_idx; it < 8192; it += nw) {
        const int sub = it & 63, q = it >> 6, gu = q & 1, j = (q >> 1) & 1, e = q >> 2;
        const float* src = (gu ? p.w_up : p.w_gate) + (size_t)e * 262144 + 128 * j;
        tr_item(src, 256, 1024, 128, p.WguT + ((size_t)e * 512 + j * 256 + gu * 128) * 1024, scr, sub, lane);
    }
}

__device__ __forceinline__ void ph_prep(const P& p, LAS unsigned char* lds, const int wv) {
    const int tid = opaque_tid(wv), lane = tid & 63, wave = __builtin_amdgcn_readfirstlane(tid >> 6);
    LAS float* scr = (LAS float*)(lds + wave * 16384);
    const int gw = blockIdx.x * NWAVES + wave, NGW = gridDim.x * NWAVES;
    const int gt = blockIdx.x * NTHR + tid, NGT = gridDim.x * NTHR;
    {
        const int c0s[7] = {640, 512, 1152, 1224, 1736, 2248, 3272};
        const int ncs[7] = {512, 128, 64, 512, 512, 1024, 1024};
        const int r0s[7] = {1024, 1536, 1664, 1792, 2304, 2816, 3840};
#pragma unroll
        for (int s = 0; s < 7; ++s) {
            const int nit = 16 * (ncs[s] / 32);
            for (int it = gw; it < nit; it += NGW) tr_item(p.w_in + c0s[s], INC, 1024, ncs[s], p.WinT + (size_t)r0s[s] * 1024, scr, it, lane);
        }
    }
    for (int i = gt; i < 64 * 1024; i += NGT) { const int j = i >> 10, k = i & 1023; p.WinT[(size_t)(1728 + j) * 1024 + k] = j < 8 ? (bf16_t)f2bf(p.w_in[(size_t)k * INC + 1216 + j]) : (bf16_t)0; }
    for (int it = gw; it < 512; it += NGW) tr_item(p.w_out, 1024, 1024, 1024, p.WoutT, scr, it, lane);
    for (int it = gw; it < 256; it += NGW) tr_item(p.w_pb, 1024, 512, 1024, p.WpbT, scr, it, lane);
    for (int it = gw; it < 4096; it += NGW) { const int sub = it & 127, e = it >> 7; tr_item(p.w_down + (size_t)e * 262144, 1024, 256, 1024, p.WdT + (size_t)e * 262144, scr, sub, lane); }
    for (int it = gw; it < 1024; it += NGW) {
        const int h = it >> 7, kt = (it >> 2) & 31, rt = it & 3, i = lane & 31, hf = lane >> 5;
        const f32x4* ap = (const f32x4*)(p.w_in + (size_t)(kt * 32 + i) * INC + h * 64 + 32 * hf);
        const f32x4* bp = (const f32x4*)(p.w_uk + (size_t)((rt * 32 + i) * 8 + h) * 64 + 32 * hf);
        f32x4 av[8], bv[8];
#pragma unroll
        for (int j = 0; j < 8; ++j) { av[j] = ap[j]; bv[j] = bp[j]; }
        f32x16 acc;
#pragma unroll
        for (int j = 0; j < 16; ++j) acc[j] = 0.f;
#pragma unroll
        for (int j = 0; j < 8; ++j)
#pragma unroll
            for (int e = 0; e < 4; ++e) acc = __builtin_amdgcn_mfma_f32_32x32x2f32(av[j][e], bv[j][e], acc, 0, 0, 0);
#pragma unroll
        for (int g4 = 0; g4 < 4; ++g4) {
            constexpr float QS = 0.125f * 1.4426950409f;
            u32x2 w; w.x = pk2(QS * acc[4 * g4], QS * acc[4 * g4 + 1]); w.y = pk2(QS * acc[4 * g4 + 2], QS * acc[4 * g4 + 3]);
            *(u32x2*)(p.WinT + (size_t)(h * 128 + rt * 32 + i) * 1024 + kt * 32 + 8 * g4 + 4 * hf) = w;
        }
    }
    for (int it = gw; it < 1024; it += NGW) {
        const int h = it >> 7, nt = (it >> 2) & 31, rt = it & 3, i = lane & 31, hf = lane >> 5;
        const f32x4* ap = (const f32x4*)(p.w_uv + (size_t)((rt * 32 + i) * 8 + h) * 64 + 32 * hf);
        const float* bp = p.w_pa + (size_t)(h * 64 + 32 * hf) * 1024 + nt * 32 + i;
        f32x4 av[8]; float bv[32];
#pragma unroll
        for (int j = 0; j < 8; ++j) av[j] = ap[j];
#pragma unroll
        for (int j = 0; j < 32; ++j) bv[j] = bp[(size_t)j * 1024];
        f32x16 acc;
#pragma unroll
        for (int j = 0; j < 16; ++j) acc[j] = 0.f;
#pragma unroll
        for (int j = 0; j < 8; ++j)
#pragma unroll
            for (int e = 0; e < 4; ++e) acc = __builtin_amdgcn_mfma_f32_32x32x2f32(av[j][e], bv[4 * j + e], acc, 0, 0, 0);
#pragma unroll
        for (int g4 = 0; g4 < 4; ++g4) {
            u32x2 w; w.x = pk2(acc[4 * g4], acc[4 * g4 + 1]); w.y = pk2(acc[4 * g4 + 2], acc[4 * g4 + 3]);
            *(u32x2*)(p.WovT + (size_t)(nt * 32 + i) * 1024 + h * 128 + rt * 32 + 8 * g4 + 4 * hf) = w;
        }
    }
    for (int i = gt; i < 4 * 128 * 128; i += NGT) { const int jj = i & 127, ii = (i >> 7) & 127; p.WSB[i] = jj <= ii ? (bf16_t)f2bf(p.w_sp[i]) : (bf16_t)0; }
    for (int i = gt; i < 36 * 1024; i += NGT) { const int c = i >> 10, k = i & 1023; p.WrT[i] = c < 4 ? p.rg_w[k * 4 + c] : p.re_w[k * 32 + (c - 4)]; }
    for (int m4 = gw; m4 < M / 4; m4 += NGW) {
        f32x4 v[4][4]; float ss[4];
#pragma unroll
        for (int r = 0; r < 4; ++r) { const f32x4* xr = (const f32x4*)(p.x + (size_t)(4 * m4 + r) * D) + lane;
#pragma unroll
            for (int j = 0; j < 4; ++j) v[r][j] = xr[64 * j]; }
#pragma unroll
        for (int r = 0; r < 4; ++r) { ss[r] = 0.f;
#pragma unroll
            for (int j = 0; j < 4; ++j) ss[r] += (v[r][j].x * v[r][j].x + v[r][j].y * v[r][j].y) + (v[r][j].z * v[r][j].z + v[r][j].w * v[r][j].w); }
#pragma unroll
        for (int o = 1; o < 64; o <<= 1) {
#pragma unroll
            for (int r = 0; r < 4; ++r) ss[r] += __shfl_xor(ss[r], o);
        }
#pragma unroll
        for (int r = 0; r < 4; ++r) {
            const float rinv = 1.0f / sqrtf(ss[r] * (1.f / D) + EPS);
            unsigned long long* o8 = (unsigned long long*)(p.HB + (size_t)(4 * m4 + r) * D) + lane;
#pragma unroll
            for (int j = 0; j < 4; ++j) { const f32x4 g = ((const f32x4*)p.n1g)[lane + 64 * j]; const f32x4 o = v[r][j] * rinv * g;
                o8[64 * j] = (unsigned long long)pk2(o.x, o.y) | ((unsigned long long)pk2(o.z, o.w) << 32); }
        }
    }
}

__device__ __forceinline__ void ph_ckvnorm(const P& p, const int wv) {
    const int tid = opaque_tid(wv), lane = tid & 63, wave = tid >> 6;
    const int gw = blockIdx.x * NWAVES + wave, NGW = gridDim.x * NWAVES;
    const float g0 = p.kv_g[2 * lane], g1 = p.kv_g[2 * lane + 1];
    for (int m4 = gw; m4 < M / 4; m4 += NGW) {
        float2 v[4]; float ss[4];
#pragma unroll
        for (int r = 0; r < 4; ++r) v[r] = ((const float2*)(p.CKVR + (size_t)(4 * m4 + r) * 128))[lane];
#pragma unroll
        for (int r = 0; r < 4; ++r) ss[r] = v[r].x * v[r].x + v[r].y * v[r].y;
#pragma unroll
        for (int o = 1; o < 64; o <<= 1) {
#pragma unroll
            for (int r = 0; r < 4; ++r) ss[r] += __shfl_xor(ss[r], o);
        }
#pragma unroll
        for (int r = 0; r < 4; ++r) { const float rinv = 1.0f / sqrtf(ss[r] * (1.f / 128.f) + EPS);
            ((unsigned*)(p.CKVB + (size_t)(4 * m4 + r) * 128))[lane] = pk2(v[r].x * rinv * g0, v[r].y * rinv * g1); }
    }
}

__device__ __forceinline__ bf16x4 tr16(const LAS unsigned char* a) { return __builtin_amdgcn_ds_read_tr16_b64_v4i16((LAS bf16x4*)a); }
__device__ __forceinline__ void ph_attn(const P& p, LAS unsigned char* lds, const int wv) {
    const int tid = opaque_tid(wv), lane = tid & 63, wave = __builtin_amdgcn_readfirstlane(tid >> 6);
    LAS unsigned char* buf = lds + wave * 16384;
    LAS unsigned char* selL = lds + 131072 + wave * 2048;
    LAS unsigned char* selT = selL + 1024;
    LAS float* bias = (LAS float*)(lds + 147456);
    LAS float* cst = (LAS float*)(lds + 147456 + 4096);
    for (int i = tid; i < 1024; i += NTHR) {
        const int d = i >> 3; int bk = d;
        if (d >= 16) { const float nf = (float)d; bk = 16 + (int)(logf(nf / 16.f) / 2.0794415f * 16.f); if (bk > 31) bk = 31; }
        bias[i] = 1.4426950409f * p.rel_bias[bk * 8 + (i & 7)];
    }
    if (wave == 0) {
        float gm = fmaxf(fabsf(p.kv_g[lane]), fabsf(p.kv_g[lane + 64]));
        float bm = fmaxf(fmaxf(fabsf(p.rel_bias[lane]), fabsf(p.rel_bias[lane + 64])), fmaxf(fabsf(p.rel_bias[lane + 128]), fabsf(p.rel_bias[lane + 192])));
#pragma unroll
        for (int o = 1; o < 64; o <<= 1) { gm = fmaxf(gm, __shfl_xor(gm, o)); bm = fmaxf(bm, __shfl_xor(bm, o)); }
        if (lane == 0) { cst[0] = 11.3137085f * gm * 1.01f; cst[1] = 1.4426950409f * bm; }
    }
    __syncthreads();
    const int g = lane >> 4, hcol = lane & 15, q4 = hcol >> 2, p4 = lane & 3;
    const float cmax = cst[0], bmaxl = cst[1];
    const int G = gridDim.x, bx = blockIdx.x, vcu = (G % 8 == 0) ? (bx % 8) * (G / 8) + bx / 8 : bx;
#define ATT_QF_LOAD(dst, mm) do { _Pragma("unroll") for (int s = 0; s < 4; ++s) { bf16x8 z; _Pragma("unroll") for (int j = 0; j < 8; ++j) z[j] = 0; \
        dst[s] = hcol < 8 ? *(const bf16x8*)(p.QL + (size_t)(mm) * 1024 + hcol * 128 + 32 * s + 8 * g) : z; } } while (0)
#define ATT_DMA_CHUNK(img_, selt_, c_) do { const u32x4 k8 = *(const LAS u32x4*)((selt_) + 64 * (c_) + 16 * g);        \
        const unsigned kk8[8] = {k8.x & 0xffffu, k8.x >> 16, k8.y & 0xffffu, k8.y >> 16, k8.z & 0xffffu, k8.z >> 16, k8.w & 0xffffu, k8.w >> 16}; \
        _Pragma("unroll") for (int i = 0; i < 8; ++i) { \
        const unsigned sch = (unsigned)hcol ^ (((unsigned)g << 2) | (unsigned)(i & 3)); \
        __builtin_amdgcn_global_load_lds((const unsigned*)(ckb + (size_t)kk8[i] * 256u + sch * 16u), (LAS unsigned*)((img_) + i * 1024), 16, 0, 0); } } while (0)
#define ATT_SEL_WRITE(par_, sv_) do { *(LAS u32x2*)(selL + (par_) * 512 + lane * 8) = (sv_); \
        LAS unsigned short* tq = (LAS unsigned short*)(selT + (par_) * 512) + (lane >> 3) * 32 + (lane & 7); \
        tq[0] = (unsigned short)((sv_).x & 0xffffu); tq[8] = (unsigned short)((sv_).x >> 16); tq[16] = (unsigned short)((sv_).y & 0xffffu); tq[24] = (unsigned short)((sv_).y >> 16); } while (0)
    for (int qc = vcu; qc < M / 128; qc += G) {
        const int m0 = qc * 128 + wave * 16;
        const size_t mb = (size_t)(m0 >> 12) * T;
        const unsigned char* ckb = (const unsigned char*)(p.CKVB + mb * 128);
        u32x2 sv = *(const u32x2*)(p.SEL + (size_t)m0 * 256 + 4 * lane);
        bf16x8 qf[4], qfn[4];
        ATT_QF_LOAD(qfn, m0);
        ATT_SEL_WRITE(0, sv);
        LDS_WAIT();
        ATT_DMA_CHUNK(buf, selT, 0);
        sv = *(const u32x2*)(p.SEL + (size_t)(m0 + 1) * 256 + 4 * lane);
        f32x4 o[8]; float lsum = 0.f, mhl = 0.f;
#pragma unroll
        for (int rt = 0; rt < 8; ++rt) o[rt] = (f32x4){0.f, 0.f, 0.f, 0.f};
#define ATT_BODY(gc_, B_) do { const int gc = (gc_); \
            const int qi = gc >> 3, c = gc & 7, m = m0 + qi; \
            const int t = m & (T - 1); \
            const LAS unsigned char* selc = selL + (qi & 1) * 512; \
            const LAS unsigned char* img = buf + (B_) * 8192; \
            if (gc + 1 < 128) { const int nqi = (gc + 1) >> 3, nc = (gc + 1) & 7; ATT_DMA_CHUNK(buf + ((B_) ^ 1) * 8192, selT + (nqi & 1) * 512, nc); \
                __builtin_amdgcn_sched_barrier(0); asm volatile("s_waitcnt vmcnt(8)" ::: "memory"); } \
            else { __builtin_amdgcn_sched_barrier(0); asm volatile("s_waitcnt vmcnt(0)" ::: "memory"); } \
            __builtin_amdgcn_sched_barrier(0); \
            if (c == 0) { \
                _Pragma("unroll") for (int s = 0; s < 4; ++s) qf[s] = qfn[s]; \
                float ss = 0.f; \
                _Pragma("unroll") for (int s = 0; s < 4; ++s) _Pragma("unroll") for (int j = 0; j < 8; ++j) { const float v = bf2f((unsigned short)qf[s][j]); ss += v * v; } \
                ss += __shfl_xor(ss, 16); ss += __shfl_xor(ss, 32); \
                mhl = sqrtf(ss) * cmax + bmaxl; \
                if (qi < 15) ATT_QF_LOAD(qfn, m + 1); \
            } \
            if (c == 3 && qi < 15) { \
                ATT_SEL_WRITE((qi + 1) & 1, sv); \
                if (qi < 14) sv = *(const u32x2*)(p.SEL + (size_t)(m + 2) * 256 + 4 * lane); \
            } \
              \
            bf16x8 af[2][4]; u32x2 kk[2]; \
            _Pragma("unroll") for (int tau = 0; tau < 2; ++tau) { kk[tau] = *(const LAS u32x2*)(selc + 2 * (32 * c + 16 * tau + 4 * g)); \
                _Pragma("unroll") for (int s = 0; s < 4; ++s) af[tau][s] = *(const LAS bf16x8*)(img + off_b(16 * tau + hcol, 4 * s + g)); } \
            float bv[2][4]; \
            _Pragma("unroll") for (int tau = 0; tau < 2; ++tau) { \
                const int keys[4] = {(int)(kk[tau].x & 0xffffu), (int)(kk[tau].x >> 16), (int)(kk[tau].y & 0xffffu), (int)(kk[tau].y >> 16)}; \
                _Pragma("unroll") for (int r = 0; r < 4; ++r) { const int dist = t - keys[r]; const int dcl = dist > 127 ? 127 : dist; bv[tau][r] = bias[dcl * 8 + (hcol & 7)]; } \
            } \
            __builtin_amdgcn_sched_barrier(0); \
            f32x4 acc[2]; \
            _Pragma("unroll") for (int tau = 0; tau < 2; ++tau) { \
                acc[tau] = (f32x4){0.f, 0.f, 0.f, 0.f}; \
                _Pragma("unroll") for (int s = 0; s < 4; ++s) acc[tau] = __builtin_amdgcn_mfma_f32_16x16x32_bf16(af[tau][s], qf[s], acc[tau], 0, 0, 0); \
            } \
            bf16x4 ta[8][2]; \
            _Pragma("unroll") for (int rt = 0; rt < 8; ++rt) { \
                const unsigned row0 = 4 * g + q4, ch = 2 * rt + (p4 >> 1); \
                ta[rt][0] = tr16(img + off_b(row0, ch) + 8 * (p4 & 1)); ta[rt][1] = tr16(img + off_b(row0 + 16, ch) + 8 * (p4 & 1)); \
            } \
            __builtin_amdgcn_sched_barrier(0); \
            float pr[2][4]; \
            _Pragma("unroll") for (int tau = 0; tau < 2; ++tau) _Pragma("unroll") for (int r = 0; r < 4; ++r) pr[tau][r] = __builtin_amdgcn_exp2f(acc[tau][r] + bv[tau][r] - mhl); \
            if (t < 255) {                                           \
                _Pragma("unroll") for (int tau = 0; tau < 2; ++tau) _Pragma("unroll") for (int r = 0; r < 4; ++r) if (32 * c + 16 * tau + 4 * g + r > t) pr[tau][r] = 0.f; \
            } \
            lsum += ((pr[0][0] + pr[0][1]) + (pr[0][2] + pr[0][3])) + ((pr[1][0] + pr[1][1]) + (pr[1][2] + pr[1][3])); \
            u32x4 pw; pw.x = pg8::cvt_pk_bf16(pr[0][0], pr[0][1]); pw.y = pg8::cvt_pk_bf16(pr[0][2], pr[0][3]); pw.z = pg8::cvt_pk_bf16(pr[1][0], pr[1][1]); pw.w = pg8::cvt_pk_bf16(pr[1][2], pr[1][3]); \
            const bf16x8 pf = __builtin_bit_cast(bf16x8, pw); \
            _Pragma("unroll") for (int rt = 0; rt < 8; ++rt) o[rt] = __builtin_amdgcn_mfma_f32_16x16x32_bf16(cat4(ta[rt][0], ta[rt][1]), pf, o[rt], 0, 0, 0); \
            if (c == 7) { \
                lsum += __shfl_xor(lsum, 16); lsum += __shfl_xor(lsum, 32); \
                const float inv = __builtin_amdgcn_rcpf(lsum); \
                if (hcol < 8) { \
                    _Pragma("unroll") for (int rt = 0; rt < 8; ++rt) { \
                        u32x2 w; w.x = pg8::cvt_pk_bf16(o[rt][0] * inv, o[rt][1] * inv); w.y = pg8::cvt_pk_bf16(o[rt][2] * inv, o[rt][3] * inv); \
                        *(u32x2*)(p.OL + (size_t)m * 1024 + hcol * 128 + 16 * rt + 4 * g) = w; \
                    } \
                } \
                _Pragma("unroll") for (int rt = 0; rt < 8; ++rt) o[rt] = (f32x4){0.f, 0.f, 0.f, 0.f}; \
                lsum = 0.f; \
            } } while (0)
#pragma unroll 1
        for (int g2 = 0; g2 < 128; g2 += 2) {
            ATT_BODY(g2, 0);
            ATT_BODY(g2 + 1, 1);
        }
#undef ATT_BODY
        asm volatile("s_waitcnt vmcnt(0)" ::: "memory");
    }
#undef ATT_DMA_CHUNK
#undef ATT_SEL_WRITE
#undef ATT_QF_LOAD
}

__device__ __forceinline__ unsigned q16of(float x) { return (unsigned)(int)__builtin_fminf(__builtin_fmaxf((x + 8.0f) * 4096.0f, 0.0f), 65535.0f); }

__device__ __forceinline__ void select_row7(const LAS unsigned short* row, int n, LAS unsigned* hist, LAS unsigned* h2, unsigned short* out, int lane) {
    if (n <= 256) {
#pragma unroll
        for (int i = 0; i < 4; ++i) { const int k = lane + 64 * i; out[k] = (unsigned short)(k < n ? k : 0); }
#pragma unroll
        for (int i = 0; i < 8; ++i) hist[lane + 64 * i] = 0u;
        return;
    }
    const unsigned long long lt = (1ull << lane) - 1ull;
    unsigned b1, above;
    {
        const u32x4 w0 = *(const LAS u32x4*)(hist + 8 * lane), w1 = *(const LAS u32x4*)(hist + 8 * lane + 4);
        unsigned c[16];
        c[0] = w0.x & 0xffffu; c[1] = w0.x >> 16; c[2] = w0.y & 0xffffu; c[3] = w0.y >> 16; c[4] = w0.z & 0xffffu; c[5] = w0.z >> 16; c[6] = w0.w & 0xffffu; c[7] = w0.w >> 16;
        c[8] = w1.x & 0xffffu; c[9] = w1.x >> 16; c[10] = w1.y & 0xffffu; c[11] = w1.y >> 16; c[12] = w1.z & 0xffffu; c[13] = w1.z >> 16; c[14] = w1.w & 0xffffu; c[15] = w1.w >> 16;
        unsigned s = 0;
#pragma unroll
        for (int j = 0; j < 16; ++j) s += c[j];
        unsigned incl = s;
#pragma unroll
        for (int o = 1; o < 64; o <<= 1) { const unsigned t = __shfl_down(incl, o); if (lane + o < 64) incl += t; }
        const unsigned excl = incl - s;
        const bool mine = (excl < 256u) && (incl >= 256u);
        unsigned bin = 0, ab = 0, run = excl; bool found = false;
#pragma unroll
        for (int j = 15; j >= 0; --j) { if (!found && run + c[j] >= 256u) { bin = 16 * lane + j; ab = run; found = true; } if (!found) run += c[j]; }
        const unsigned long long bm = __ballot(mine);
        const int src = bm ? (int)__builtin_ctzll(bm) : 0;
        b1 = __shfl(bin, src); above = __shfl(ab, src);
    }
    LDS_WAIT();
    int need = 256 - (int)above;
    LAS unsigned short* cand = (LAS unsigned short*)hist;
    const int nblk = (n + 255) >> 8;
    const unsigned thr = b1 << 6;
    int C = 0;
    u32x2 vn = *(const LAS u32x2*)(row + 4 * lane);
    for (int blk = 0; blk < nblk; ++blk) {
        const u32x2 v = vn;
        if (blk + 1 < nblk) vn = *(const LAS u32x2*)(row + (blk + 1) * 256 + 4 * lane);
        const unsigned q[4] = {v.x & 0xffffu, v.x >> 16, v.y & 0xffffu, v.y >> 16};
        bool ge[4]; unsigned long long bl[4];
#pragma unroll
        for (int e = 0; e < 4; ++e) { ge[e] = (blk * 256 + 4 * lane + e < n) && (q[e] >= thr); bl[e] = __ballot(ge[e]); }
        const int below = __builtin_popcountll(bl[0] & lt) + __builtin_popcountll(bl[1] & lt) + __builtin_popcountll(bl[2] & lt) + __builtin_popcountll(bl[3] & lt);
        int pos = C + below;
#pragma unroll
        for (int e = 0; e < 4; ++e) { if (ge[e]) { if (pos < 768) cand[pos] = (unsigned short)(blk * 256 + 4 * lane + e); ++pos; } }
        C += __builtin_popcountll(bl[0]) + __builtin_popcountll(bl[1]) + __builtin_popcountll(bl[2]) + __builtin_popcountll(bl[3]);
    }
    LDS_WAIT();
    LAS unsigned short* outL = cand + 768;
    if (C <= 512) {
        int ci[8]; unsigned cq[8]; bool ceq[8];
#pragma unroll
        for (int k = 0; k < 8; ++k) { const int j = lane + 64 * k; ci[k] = j < C ? (int)cand[j] : -1; }
#pragma unroll
        for (int k = 0; k < 8; ++k) { cq[k] = ci[k] >= 0 ? (unsigned)row[ci[k]] : 0u; ceq[k] = ci[k] >= 0 && (cq[k] >> 6) == b1; }
        h2[lane] = 0u;
        LDS_WAIT();
#pragma unroll
        for (int k = 0; k < 8; ++k) if (ceq[k]) __hip_atomic_fetch_add(h2 + (cq[k] & 63u), 1u, __ATOMIC_RELAXED, __HIP_MEMORY_SCOPE_WORKGROUP);
        LDS_WAIT();
        const unsigned cme = h2[lane];
        unsigned incl = cme;
#pragma unroll
        for (int o = 1; o < 64; o <<= 1) { const unsigned t = __shfl_down(incl, o); if (lane + o < 64) incl += t; }
        const unsigned excl = incl - cme;
        const bool mine = (excl < (unsigned)need) && (incl >= (unsigned)need);
        const unsigned long long bm = __ballot(mine);
        const int src = bm ? (int)__builtin_ctzll(bm) : 0;
        const unsigned Tl = (unsigned)src;
        need -= (int)__shfl(excl, src);
        const unsigned Tq = (b1 << 6) | Tl;
        int eq_seen = 0, cnt = 0;
#pragma unroll
        for (int k = 0; k < 8; ++k) {
            const bool valid = ci[k] >= 0, eqk = valid && cq[k] == Tq;
            const unsigned long long beq = __ballot(eqk);
            const int eq_rank = eq_seen + __builtin_popcountll(beq & lt);
            const bool take = valid && (cq[k] > Tq || (eqk && eq_rank < need));
            const unsigned long long bt = __ballot(take);
            const int pos = cnt + __builtin_popcountll(bt & lt);
            if (take && pos < 256) outL[pos] = (unsigned short)ci[k];
            cnt += __builtin_popcountll(bt); eq_seen += __builtin_popcountll(beq);
        }
    } else {
        unsigned lo = 0u, hi = 65535u;
        while (lo < hi) {
            const unsigned mid = (lo + hi + 1u) >> 1;
            int cge = 0;
            for (int i = lane; i < n; i += 64) cge += ((unsigned)row[i] >= mid) ? 1 : 0;
#pragma unroll
            for (int o = 1; o < 64; o <<= 1) cge += __shfl_xor(cge, o);
            if (cge >= 256) lo = mid; else hi = mid - 1u;
        }
        const unsigned Tq = lo;
        int cgt = 0;
        for (int i = lane; i < n; i += 64) cgt += ((unsigned)row[i] > Tq) ? 1 : 0;
#pragma unroll
        for (int o = 1; o < 64; o <<= 1) cgt += __shfl_xor(cgt, o);
        const int needq = 256 - cgt;
        int cnt = 0, eq_seen = 0;
        for (int i0 = 0; i0 < n; i0 += 64) {
            const int i = i0 + lane; const bool valid = i < n;
            const unsigned qv = valid ? (unsigned)row[i] : 0u;
            const bool eqk = valid && qv == Tq;
            const unsigned long long beq = __ballot(eqk);
            const int eq_rank = eq_seen + __builtin_popcountll(beq & lt);
            const bool take = valid && (qv > Tq || (eqk && eq_rank < needq));
            const unsigned long long bt = __ballot(take);
            const int pos = cnt + __builtin_popcountll(bt & lt);
            if (take && pos < 256) outL[pos] = (unsigned short)i;
            cnt += __builtin_popcountll(bt); eq_seen += __builtin_popcountll(beq);
        }
    }
    LDS_WAIT();
    *(u32x2*)(out + 4 * lane) = *(const LAS u32x2*)(outL + 4 * lane);
    LDS_WAIT();
#pragma unroll
    for (int i = 0; i < 8; ++i) hist[lane + 64 * i] = 0u;
}

template <int STRIP> __device__ __forceinline__ void ph_index7_t(const P& p, LAS unsigned char* lds, const int wv) {
    LAS unsigned short* Irow = (LAS unsigned short*)lds;
    LAS unsigned* hist = (LAS unsigned*)(lds + 65536);
    LAS unsigned* h2 = (LAS unsigned*)(lds + 81920);
    const int tid = opaque_tid(wv), lane = tid & 63, wave = __builtin_amdgcn_readfirstlane(tid >> 6);
    LAS unsigned char* KSw = lds + 92160 + wave * 8192;
    const int hh = lane >> 5, n = lane & 31;
    const int rho = lane & 31, qlA = 2 * ((rho >> 2) & 1) + (rho >> 4), hdA = (rho & 3) + 4 * ((rho >> 3) & 1);
    const int srow = lane >> 3, sch = lane & 7;
#pragma unroll
    for (int i = 0; i < 8; ++i) hist[tid + NTHR * i] = 0u;
    bf16x8 A[2][4]; float wq[2][16]; u32x4 RA[4], RB[4];
#define IDX7_LOAD(R_, mb_, kt_) do { const bf16_t* kp_ = p.KI + ((mb_) + (size_t)(kt_) * 32 + srow) * 64 + sch * 8; \
        _Pragma("unroll") for (int i = 0; i < 4; ++i) R_[i] = *(const u32x4*)(kp_ + (size_t)i * 8 * 64); } while (0)
#define IDX7_LOAD_UNIT(u_) do { const int b_ = (u_) & 7, t0_ = (511 - ((u_) >> 3)) * 8; const size_t mb_ = (size_t)b_ * T; const int nkt_ = (t0_ + 8 + 31) >> 5; \
        _Pragma("unroll") for (int mt = 0; mt < 2; ++mt) { const bf16_t* src = p.QI + (mb_ + t0_ + mt * 4 + qlA) * 512 + hdA * 64 + 8 * hh; \
            _Pragma("unroll") for (int s = 0; s < 4; ++s) A[mt][s] = *(const bf16x8*)(src + 16 * s); \
            _Pragma("unroll") for (int c = 0; c < 2; ++c) { const float* wp = p.WI + (mb_ + t0_ + mt * 4 + 2 * hh + c) * 8; const f32x4 w0 = *(const f32x4*)wp, w1 = *(const f32x4*)(wp + 4); \
                _Pragma("unroll") for (int j = 0; j < 4; ++j) { wq[mt][c * 8 + j] = w0[j]; wq[mt][c * 8 + 4 + j] = w1[j]; } } } \
        if (wave < nkt_) IDX7_LOAD(RA, mb_, wave); if (wave + NWAVES < nkt_) IDX7_LOAD(RB, mb_, wave + NWAVES); } while (0)
    if ((int)blockIdx.x < 4096) IDX7_LOAD_UNIT((int)blockIdx.x);
    __syncthreads();
    for (int u = blockIdx.x; u < 4096; u += gridDim.x) {
        const int b = u & 7, tb = 511 - (u >> 3), t0 = tb * 8; const size_t mb = (size_t)b * T;
        const int nkt = (t0 + 8 + 31) >> 5;
#pragma unroll
        for (int mt = 0; mt < 2; ++mt) {
#pragma unroll
            for (int s = 0; s < 4; ++s) asm volatile("" :: "v"(A[mt][s]));
#pragma unroll
            for (int j = 0; j < 16; ++j) asm volatile("" :: "v"(wq[mt][j]));
        }
#define IDX7_BODY(kt_, R_, bf_) do { const int kt = (kt_); if (kt < nkt) { \
            LAS unsigned char* img = KSw + (bf_) * 4096; \
            _Pragma("unroll") for (int i = 0; i < 4; ++i) { const int row = 8 * i + srow; *(LAS u32x4*)(img + row * 128 + 16 * (sch ^ (row & 7))) = R_[i]; } \
            if (kt + 2 * NWAVES < nkt) IDX7_LOAD(R_, mb, kt + 2 * NWAVES); \
            bf16x8 Bf[4]; \
            _Pragma("unroll") for (int s = 0; s < 4; ++s) Bf[s] = *(const LAS bf16x8*)(img + n * 128 + 16 * ((2 * s + hh) ^ (n & 7))); \
            const int key = kt * 32 + n; \
            _Pragma("unroll") for (int mt = 0; mt < 2; ++mt) { \
                f32x16 acc; \
                _Pragma("unroll") for (int j = 0; j < 16; ++j) acc[j] = 0.f; \
                _Pragma("unroll") for (int s = 0; s < 4; ++s) acc = __builtin_amdgcn_mfma_f32_32x32x16_bf16(A[mt][s], Bf[s], acc, 0, 0, 0); \
                _Pragma("unroll") for (int c = 0; c < 2; ++c) { \
                    float v = 0.f; \
                    _Pragma("unroll") for (int h = 0; h < 8; ++h) { const float af = acc[c * 8 + h]; const int ai = __float_as_int(af); v = __builtin_fmaf(wq[mt][c * 8 + h], __int_as_float(ai > 0 ? ai : 0), v); } \
                    const int r = mt * 4 + 2 * hh + c; const unsigned q = q16of(v); \
                    Irow[r * 4096 + key] = (unsigned short)q; \
                    if (key <= t0 + r) { const unsigned bin = q >> 6; __hip_atomic_fetch_add(hist + r * 512 + (bin >> 1), 1u << ((bin & 1u) * 16u), __ATOMIC_RELAXED, __HIP_MEMORY_SCOPE_WORKGROUP); } \
                } \
            } } } while (0)
#pragma unroll 1
        for (int k0 = wave; k0 < nkt; k0 += 2 * NWAVES) {
            IDX7_BODY(k0, RA, 0);
            IDX7_BODY(k0 + NWAVES, RB, 1);
        }
#undef IDX7_BODY
        if (u + (int)gridDim.x < 4096) IDX7_LOAD_UNIT(u + (int)gridDim.x);
        LDS_WAIT(); __builtin_amdgcn_s_barrier();
        if (STRIP != 1) select_row7(Irow + wave * 4096, t0 + wave + 1, hist + wave * 512, h2 + wave * 320, p.SEL + (mb + t0 + wave) * 256, lane);
        else { _Pragma("unroll") for (int i = 0; i < 8; ++i) hist[wave * 512 + lane + 64 * i] = 0u; }
        LDS_WAIT(); __builtin_amdgcn_s_barrier();
    }
#undef IDX7_LOAD
#undef IDX7_LOAD_UNIT
}

__device__ __forceinline__ void ph_index7(const P& p, LAS unsigned char* lds, const int wv) { ph_index7_t<0>(p, lds, wv); }

__device__ __forceinline__ void ph_gmlp(const P& p, LAS unsigned char* lds, const int wv) {
    const int tid = opaque_tid(wv), lane = tid & 63, wave = __builtin_amdgcn_readfirstlane(tid >> 6);
    LAS unsigned char* vt = lds;
    LAS float* st = (LAS float*)(lds + 32768);
    const int g4 = lane >> 4, q4 = (lane & 15) >> 2, p4 = lane & 3, ic = lane & 15;
    for (int u = blockIdx.x; u < 256; u += gridDim.x) {
        const size_t m0 = (size_t)u * 128;
#pragma unroll 1
        for (int r4 = 0; r4 < 4; ++r4) {
            float x[4][8], sm[4];
#pragma unroll
            for (int r = 0; r < 4; ++r) { const u32x4 w = *(const u32x4*)(p.VB + (m0 + 16 * wave + 4 * r4 + r) * 512 + lane * 8);
                x[r][0] = bflo(w.x); x[r][1] = bfhi(w.x); x[r][2] = bflo(w.y); x[r][3] = bfhi(w.y); x[r][4] = bflo(w.z); x[r][5] = bfhi(w.z); x[r][6] = bflo(w.w); x[r][7] = bfhi(w.w); }
#pragma unroll
            for (int r = 0; r < 4; ++r) sm[r] = ((x[r][0] + x[r][1]) + (x[r][2] + x[r][3])) + ((x[r][4] + x[r][5]) + (x[r][6] + x[r][7]));
#pragma unroll
            for (int o = 1; o < 64; o <<= 1) {
#pragma unroll
                for (int r = 0; r < 4; ++r) sm[r] += __shfl_xor(sm[r], o);
            }
            float vr[4];
#pragma unroll
            for (int r = 0; r < 4; ++r) { const float mean = sm[r] * (1.f / 512.f); sm[r] = mean; float a = 0.f;
#pragma unroll
                for (int j = 0; j < 8; ++j) { const float d = x[r][j] - mean; a += d * d; }
                vr[r] = a; }
#pragma unroll
            for (int o = 1; o < 64; o <<= 1) {
#pragma unroll
                for (int r = 0; r < 4; ++r) vr[r] += __shfl_xor(vr[r], o);
            }
            if (lane == 0) {
#pragma unroll
                for (int r = 0; r < 4; ++r) { const int row = 16 * wave + 4 * r4 + r; st[2 * row] = sm[r]; st[2 * row + 1] = 1.0f / sqrtf(vr[r] * (1.f / 512.f) + EPS); }
            }
        }
        __syncthreads();
#pragma unroll 1
        for (int g = 0; g < 4; ++g) {
#pragma unroll
            for (int i = 0; i < 4; ++i) {
                const int piece = i * NTHR + tid, row = piece >> 4, ch = piece & 15;
                const u32x4 w = *(const u32x4*)(p.VB + (m0 + row) * 512 + g * 128 + ch * 8);
                const float mean = st[2 * row], rstd = st[2 * row + 1];
                const f32x4 ga = *(const f32x4*)(p.ln_g + g * 128 + ch * 8), gb = *(const f32x4*)(p.ln_g + g * 128 + ch * 8 + 4);
                const f32x4 ba = *(const f32x4*)(p.ln_b + g * 128 + ch * 8), bb = *(const f32x4*)(p.ln_b + g * 128 + ch * 8 + 4);
                u32x4 o;
                o.x = pk2((bflo(w.x) - mean) * rstd * ga[0] + ba[0], (bfhi(w.x) - mean) * rstd * ga[1] + ba[1]);
                o.y = pk2((bflo(w.y) - mean) * rstd * ga[2] + ba[2], (bfhi(w.y) - mean) * rstd * ga[3] + ba[3]);
                o.z = pk2((bflo(w.z) - mean) * rstd * gb[0] + bb[0], (bfhi(w.z) - mean) * rstd * gb[1] + bb[1]);
                o.w = pk2((bflo(w.w) - mean) * rstd * gb[2] + bb[2], (bfhi(w.w) - mean) * rstd * gb[3] + bb[3]);
                *(LAS u32x4*)(vt + off_b(row, ch)) = o;
            }
            const size_t orow = (m0 + 16 * wave + ic) * 512 + g * 128 + 4 * g4;
            u32x2 uv[8];
#pragma unroll
            for (int et = 0; et < 8; ++et) uv[et] = *(const u32x2*)(p.UB + orow + 16 * et);
            const float bs = p.b_sp[g * 128 + 16 * wave + ic];
            const int nks = ((16 * wave + 15) >> 5) + 1;
            bf16x8 wb[4];
#pragma unroll
            for (int ks = 0; ks < 4; ++ks) wb[ks] = *(const bf16x8*)(p.WSB + ((size_t)g * 128 + 16 * wave + ic) * 128 + 32 * ks + 8 * g4);
            __syncthreads();
            f32x4 acc[8];
#pragma unroll
            for (int et = 0; et < 8; ++et) acc[et] = (f32x4){0.f, 0.f, 0.f, 0.f};
#pragma unroll
            for (int ks = 0; ks < 4; ++ks) {
                if (ks < nks) {
                    bf16x4 ta[8][2];
#pragma unroll
                    for (int et = 0; et < 8; ++et) {
                        const unsigned r0 = 32 * ks + 8 * g4 + q4, ch = 2 * et + (p4 >> 1);
                        ta[et][0] = tr16(vt + off_b(r0, ch) + 8 * (p4 & 1)); ta[et][1] = tr16(vt + off_b(r0 + 4, ch) + 8 * (p4 & 1));
                    }
#pragma unroll
                    for (int et = 0; et < 8; ++et) acc[et] = __builtin_amdgcn_mfma_f32_16x16x32_bf16(cat4(ta[et][0], ta[et][1]), wb[ks], acc[et], 0, 0, 0);
                }
            }
#pragma unroll
            for (int et = 0; et < 8; ++et) {
                u32x2 w;
                w.x = pk2(bflo(uv[et].x) * (acc[et][0] + bs), bfhi(uv[et].x) * (acc[et][1] + bs));
                w.y = pk2(bflo(uv[et].y) * (acc[et][2] + bs), bfhi(uv[et].y) * (acc[et][3] + bs));
                *(u32x2*)(p.US + orow + 16 * et) = w;
            }
            __syncthreads();
        }
    }
}

__device__ __forceinline__ void split2(float a, float b, unsigned& h, unsigned& l) {
    const unsigned ha = f2bf(a), hb = f2bf(b);
    h = ha | (hb << 16); l = pk2(a - __uint_as_float(ha << 16), b - __uint_as_float(hb << 16));
}
__device__ __forceinline__ void split_bf16(const f32x4 a, const f32x4 b, bf16x8& hi, bf16x8& lo) {
    unsigned h0, h1, h2, h3, l0, l1, l2, l3;
    split2(a.x, a.y, h0, l0); split2(a.z, a.w, h1, l1); split2(b.x, b.y, h2, l2); split2(b.z, b.w, h3, l3);
    const u32x4 h = {h0, h1, h2, h3}, l = {l0, l1, l2, l3};
    hi = __builtin_bit_cast(bf16x8, h); lo = __builtin_bit_cast(bf16x8, l);
}
template <int STRIP> __device__ __forceinline__ void ph_router_t(const P& p, LAS unsigned char* lds, const int wv) {
    const int tid = opaque_tid(wv), lane = tid & 63, wave = __builtin_amdgcn_readfirstlane(tid >> 6);
    LAS float* LG = (LAS float*)lds;
    LAS float* SS = (LAS float*)(lds + 26624);
    LAS unsigned* cnt = (LAS unsigned*)(lds + 26624 + 512);
    const int g = lane >> 4, ic = lane & 15;
    const float* X1 = p.out;
    bf16x8 bh[4][3], bl[4][3];
#pragma unroll
    for (int ks = 0; ks < 4; ++ks) {
        const int k0 = 128 * wave + 32 * ks + 8 * g;
#pragma unroll
        for (int nt = 0; nt < 3; ++nt) {
            const int col = 16 * nt + ic; const int cc = col < 36 ? col : 0;
            f32x4 a = *(const f32x4*)(p.WrT + (size_t)cc * 1024 + k0), b = *(const f32x4*)(p.WrT + (size_t)cc * 1024 + k0 + 4);
            if (col >= 36) { a = (f32x4){0.f, 0.f, 0.f, 0.f}; b = a; }
            split_bf16(a, b, bh[ks][nt], bl[ks][nt]);
        }
        if (ks & 1) asm volatile("" ::: "memory");
    }
    for (int c = blockIdx.x; c < M / 128; c += gridDim.x) {
        for (int i = tid; i < 128 * 52 + 128 + 32; i += NTHR) ((LAS float*)lds)[i] = 0.f;
        __syncthreads();
        f32x4 xa[4], xb[4], na[4], nb[4];
#define RT_LOAD(XA_, XB_, rt_) do { const float* xr = X1 + (size_t)(c * 128 + 16 * (rt_) + ic) * D + 128 * wave + 8 * g; \
            _Pragma("unroll") for (int ks = 0; ks < 4; ++ks) { XA_[ks] = *(const f32x4*)(xr + 32 * ks); XB_[ks] = *(const f32x4*)(xr + 32 * ks + 4); } } while (0)
        RT_LOAD(na, nb, 0);
#pragma unroll 1
        for (int rt = 0; rt < 8; ++rt) {
#pragma unroll
            for (int ks = 0; ks < 4; ++ks) { xa[ks] = na[ks]; xb[ks] = nb[ks]; }
            if (rt < 7) RT_LOAD(na, nb, rt + 1);
            __builtin_amdgcn_sched_barrier(0);
            f32x4 acc[3];
#pragma unroll
            for (int nt = 0; nt < 3; ++nt) acc[nt] = (f32x4){0.f, 0.f, 0.f, 0.f};
            float ssq = 0.f;
            bf16_t* hr = p.H2B + (size_t)(c * 128 + 16 * rt + ic) * D + 128 * wave + 8 * g;
#pragma unroll
            for (int ks = 0; ks < 4; ++ks) {
                ssq += (xa[ks].x * xa[ks].x + xa[ks].y * xa[ks].y) + (xa[ks].z * xa[ks].z + xa[ks].w * xa[ks].w) + (xb[ks].x * xb[ks].x + xb[ks].y * xb[ks].y) + (xb[ks].z * xb[ks].z + xb[ks].w * xb[ks].w);
                const f32x4 ga = *(const f32x4*)(p.n2g + 128 * wave + 32 * ks + 8 * g), gb = *(const f32x4*)(p.n2g + 128 * wave + 32 * ks + 8 * g + 4);
                bf16x8 ah, al;
                split_bf16(xa[ks] * ga, xb[ks] * gb, ah, al);
                *(bf16x8*)(hr + 32 * ks) = ah;
                if (STRIP != 1) {
#pragma unroll
                for (int nt = 0; nt < 3; ++nt) {
                    acc[nt] = __builtin_amdgcn_mfma_f32_16x16x32_bf16(ah, bh[ks][nt], acc[nt], 0, 0, 0);
                    acc[nt] = __builtin_amdgcn_mfma_f32_16x16x32_bf16(al, bh[ks][nt], acc[nt], 0, 0, 0);
                    acc[nt] = __builtin_amdgcn_mfma_f32_16x16x32_bf16(ah, bl[ks][nt], acc[nt], 0, 0, 0);
                }
                }
            }
            ssq += __shfl_xor(ssq, 16); ssq += __shfl_xor(ssq, 32);
            LAS float* PT = (LAS float*)(lds + 32768) + ((rt & 1) * 8 + wave) * (16 * 52);
            if (STRIP == 0) {
#pragma unroll
            for (int nt = 0; nt < 3; ++nt)
#pragma unroll
                for (int r = 0; r < 4; ++r) PT[(4 * g + r) * 52 + 16 * nt + ic] = acc[nt][r];
            if (g == 0) PT[ic * 52 + 48] = ssq;
            }
            LDS_WAIT(); __builtin_amdgcn_s_barrier();
            if (STRIP == 0) {
            for (int e = tid; e < 16 * 52; e += NTHR) {
                const LAS float* q = (const LAS float*)(lds + 32768) + (rt & 1) * 8 * (16 * 52) + e;
                float s = 0.f;
#pragma unroll
                for (int w = 0; w < 8; ++w) s += q[w * (16 * 52)];
                LG[16 * rt * 52 + e] = s;
            }
            }
        }
#undef RT_LOAD
        __syncthreads();
        if (tid < 128) {
            const int m = c * 128 + tid;
            const LAS float* lg = LG + tid * 52;
            const float rinv = 1.0f / sqrtf(lg[48] * (1.f / D) + EPS);
            float gl[4];
#pragma unroll
            for (int i = 0; i < 4; ++i) gl[i] = rinv * lg[i] + p.rg_b[i];
            int gi = 0; float gm = gl[0];
#pragma unroll
            for (int i = 1; i < 4; ++i) if (gl[i] > gm) { gm = gl[i]; gi = i; }
            float gs = 0.f;
#pragma unroll
            for (int i = 0; i < 4; ++i) gs += __expf(gl[i] - gm);
            const float gwt = 1.f / gs;
            float el[8];
#pragma unroll
            for (int j = 0; j < 8; ++j) el[j] = rinv * lg[4 + gi * 8 + j] + p.re_b[gi * 8 + j];
            int i1 = 0; float m1 = el[0];
#pragma unroll
            for (int j = 1; j < 8; ++j) if (el[j] > m1) { m1 = el[j]; i1 = j; }
            int i2 = 0; float m2 = -INFINITY;
#pragma unroll
            for (int j = 0; j < 8; ++j) if (j != i1 && el[j] > m2) { m2 = el[j]; i2 = j; }
            const float e2r = __expf(m2 - m1), e1 = 1.f / (1.f + e2r), e2 = e2r * e1;
            const int ea = gi * 8 + i1, eb = gi * 8 + i2;
            p.EID[2 * m] = ea; p.EID[2 * m + 1] = eb;
            p.EW[2 * m] = gwt * e1; p.EW[2 * m + 1] = gwt * e2;
            p.RINV2[m] = rinv;
            __hip_atomic_fetch_add(cnt + ea, 1u, __ATOMIC_RELAXED, __HIP_MEMORY_SCOPE_WORKGROUP);
            __hip_atomic_fetch_add(cnt + eb, 1u, __ATOMIC_RELAXED, __HIP_MEMORY_SCOPE_WORKGROUP);
        }
        __syncthreads();
        if (tid < 32) p.BLKCNT[c * 32 + tid] = (int)cnt[tid];
        __syncthreads();
    }
}

__device__ __forceinline__ void ph_router(const P& p, LAS unsigned char* lds, const int wv) { ph_router_t<0>(p, lds, wv); }

__device__ __forceinline__ void ph_scan(const P& p, LAS unsigned char* lds, const int wv) {}
__device__ __forceinline__ void ph_scatter(const P& p, LAS unsigned char* lds, const int wv) {
    const int tid = opaque_tid(wv);
    LAS int* s = (LAS int*)lds;
    LAS int* se = s + 2048;
    const int e = tid & 31, part = tid >> 5;
    int loc[16]; int sum = 0;
#pragma unroll
    for (int i = 0; i < 16; ++i) { loc[i] = p.BLKCNT[(part * 16 + i) * 32 + e]; sum += loc[i]; }
    s[128 + part * 32 + e] = sum;
    __syncthreads();
    if (tid < 32) { int t = 0; for (int k = 0; k < 16; ++k) { const int v = s[128 + k * 32 + tid]; s[128 + k * 32 + tid] = t; t += v; } s[tid] = t; }
    __syncthreads();
    if (tid == 0) { int off = 0; for (int k = 0; k < 32; ++k) { s[32 + k] = off; off += (s[k] + 255) >> 8; } s[64] = off; }
    __syncthreads();
    if (blockIdx.x == 0) {
        const int ntiles = s[64];
        if (tid < 32) { p.MOEI[tid] = s[32 + tid] * 256; p.MOEI[32 + tid] = s[32 + tid]; }
        if (tid == 0) { p.MOEI[64] = ntiles; p.MOEI[65] = ntiles * 2; p.MOEI[66] = ntiles * 4; }
        for (int rt = tid; rt < ntiles; rt += NTHR) {
            int ex = 0;
            for (int k = 0; k < 32; ++k) { const int tb = s[32 + k], nt = (s[k] + 255) >> 8; if (rt >= tb && rt < tb + nt) ex = k; }
            p.GU[4 * rt + 0] = rt; p.GU[4 * rt + 1] = ex * 2; p.GU[4 * rt + 2] = rt; p.GU[4 * rt + 3] = ex * 2 + 1;
#pragma unroll
            for (int j = 0; j < 4; ++j) { p.DN[8 * rt + 2 * j] = rt; p.DN[8 * rt + 2 * j + 1] = ex * 4 + j; }
        }
        for (int k = 0; k < 32; ++k) {
            const int lo = s[32 + k] * 256 + s[k], hi = (s[32 + k] + ((s[k] + 255) >> 8)) * 256;
            for (int i = lo + tid; i < hi; i += NTHR) p.PTOK[i] = -1;
        }
    }
    for (int c = blockIdx.x; c < M / 128; c += gridDim.x) {
        if (part == (c >> 4)) {
            int run = s[32 + e] * 256 + s[128 + part * 32 + e];
#pragma unroll
            for (int i = 0; i < 16; ++i) run += (i < (c & 15)) ? loc[i] : 0;
            s[1024 + e] = run;
        }
        int ex = 0;
        if (tid < 256) { ex = p.EID[c * 256 + tid]; se[tid] = ex; }
        __syncthreads();
        if (tid < 256) {
            int rank = 0;
            for (int t = 0; t < tid; ++t) rank += (se[t] == ex) ? 1 : 0;
            p.PTOK[s[1024 + ex] + rank] = c * 256 + tid;
        }
        __syncthreads();
    }
}

template <bool DRY> __device__ __forceinline__ void ph_final(const P& p, const int wv) {
    const int tid = opaque_tid(wv), lane = tid & 63, wave = tid >> 6;
    const int gw = blockIdx.x * NWAVES + wave, NGW = gridDim.x * NWAVES;
    for (int m4 = gw; m4 < M / 4; m4 += NGW) {
        f32x4 v[4][4]; float s[4];
#pragma unroll
        for (int rr = 0; rr < 4; ++rr) {
            const int m = 4 * m4 + rr;
            const f32x4* xr = (const f32x4*)(p.out + (size_t)m * D) + lane;
            const u32x2* y0 = (const u32x2*)(p.YS + (size_t)m * D) + lane; const u32x2* y1 = (const u32x2*)(p.YS + ((size_t)M + m) * D) + lane;
            s[rr] = 0.f;
#pragma unroll
            for (int j = 0; j < 4; ++j) {
                v[rr][j] = xr[64 * j]; const u32x2 a = y0[64 * j], b = y1[64 * j];
                v[rr][j].x += bflo(a.x) + bflo(b.x); v[rr][j].y += bfhi(a.x) + bfhi(b.x); v[rr][j].z += bflo(a.y) + bflo(b.y); v[rr][j].w += bfhi(a.y) + bfhi(b.y);
                s[rr] += (v[rr][j].x * v[rr][j].x + v[rr][j].y * v[rr][j].y) + (v[rr][j].z * v[rr][j].z + v[rr][j].w * v[rr][j].w);
            }
        }
#pragma unroll
        for (int rr = 0; rr < 4; ++rr) {
            const float rinv = 1.0f / sqrtf(wave_sum(s[rr]) * (1.f / D) + EPS);
            f32x4* xr = (f32x4*)((DRY ? (float*)p.GBB : p.out) + (size_t)(4 * m4 + rr) * D) + lane;
#pragma unroll
            for (int j = 0; j < 4; ++j) { const f32x4 g = ((const f32x4*)p.fg)[lane + 64 * j]; xr[64 * j] = v[rr][j] * rinv * g; }
        }
    }
}

#ifndef GEMM_SP2
#define GEMM_SP2 true
#endif
__device__ __forceinline__ void ph_gemm_in(const P& p, LAS unsigned char* lds, const int wv) {
    pg8::Gemm g{p.HB, p.WinT, M, NIN, 1024}; pg8::StaticOrder S; S.init(M, NIN, gridDim.x, (int)blockIdx.x);
    EpiIn E{p.QL, p.QI, p.KI, p.UB, p.VB, p.GAB, p.GBB, p.CKVR, p.WI};
    pg8::gemm_phase<EpiIn, pg8::StaticOrder, true, GEMM_SP2>(lds, g, S, E, wv);
    {
        const int G = gridDim.x, nwg = (M / 256) * (NIN / 256), nextra = nwg % G;
        const int c = blockIdx.x, nshort = nextra == 0 ? G : G - nextra;
        if (nextra == 0 || c >= nextra) {
            const int tid = opaque_tid(wv), lane = tid & 63, wave = __builtin_amdgcn_readfirstlane(tid >> 6);
            __syncthreads();
            prep_gateup(p, lds, (nextra == 0 ? c : c - nextra) * NWAVES + wave, nshort * NWAVES, wave, lane);
        }
    }
}
__device__ __forceinline__ void ph_gemm_yb(const P& p, LAS unsigned char* lds, const int wv) {
    pg8::Gemm g{p.US, p.WpbT, M, 1024, 512}; pg8::StaticOrder S; S.init(M, 1024, gridDim.x, (int)blockIdx.x);
    EpiMB E{p.GBB, p.MB};
    pg8::gemm_phase<EpiMB, pg8::StaticOrder, true, GEMM_SP2>(lds, g, S, E, wv);
}
__device__ __forceinline__ void ph_gemm_ya(const P& p, LAS unsigned char* lds, const int wv) {
    pg8::Gemm g{p.OL, p.WovT, M, 1024, 1024}; pg8::StaticOrder S; S.init(M, 1024, gridDim.x, (int)blockIdx.x);
    EpiMG E{p.GAB, p.MB, p.MG};
    pg8::gemm_phase<EpiMG, pg8::StaticOrder, true, GEMM_SP2>(lds, g, S, E, wv);
}
__device__ __forceinline__ void ph_gemm_out(const P& p, LAS unsigned char* lds, const int wv) {
    pg8::Gemm g{p.MG, p.WoutT, M, 1024, 1024}; pg8::StaticOrder S; S.init(M, 1024, gridDim.x, (int)blockIdx.x);
    EpiX1 E{p.x, p.out};
    pg8::gemm_phase<EpiX1, pg8::StaticOrder, true, GEMM_SP2>(lds, g, S, E, wv);
}
__device__ __forceinline__ void ph_gemm_gu(const P& p, LAS unsigned char* lds, const int wv) {
    table_prefetch(lds, p.GU, p.MOEI + 65, (int)gridDim.x, (int)blockIdx.x, opaque_tid(wv));
    pg8::Gemm g{p.H2B, p.WguT, NPOS, 32 * 512, 1024}; TableGatherOrder S{p.GU, p.MOEI + 65, p.PTOK, (int)gridDim.x, (int)blockIdx.x, (const LAS int*)(lds + LDS_TAB_OFF)};
    EpiHE E{p.HE, p.PTOK, p.RINV2};
    pg8::gemm_phase<EpiHE, TableGatherOrder, true, true>(lds, g, S, E, wv);
}
__device__ __forceinline__ void ph_gemm_dn(const P& p, LAS unsigned char* lds, const int wv) {
    table_prefetch(lds, p.DN, p.MOEI + 66, (int)gridDim.x, (int)blockIdx.x, opaque_tid(wv));
    pg8::Gemm g{p.HE, p.WdT, NPOS, 32 * 1024, 256}; TableOrder S{p.DN, p.MOEI + 66, (int)gridDim.x, (int)blockIdx.x, (const LAS int*)(lds + LDS_TAB_OFF)};
    EpiDown E{p.PTOK, p.EW, p.YS};
    pg8::gemm_phase<EpiDown, TableOrder, true, GEMM_SP2>(lds, g, S, E, wv);
}
constexpr int NPHASE = 15;
template <int PH> __device__ __forceinline__ void run_phase(const P& p, LAS unsigned char* lds, const int wv) {
    if constexpr (PH == 0) ph_prep(p, lds, wv);
    if constexpr (PH == 1) ph_gemm_in(p, lds, wv);
    if constexpr (PH == 2) ph_ckvnorm(p, wv);
    if constexpr (PH == 3) ph_index7(p, lds, wv);
    if constexpr (PH == 4) ph_attn(p, lds, wv);
    if constexpr (PH == 5) ph_gmlp(p, lds, wv);
    if constexpr (PH == 6) ph_gemm_yb(p, lds, wv);
    if constexpr (PH == 7) ph_gemm_ya(p, lds, wv);
    if constexpr (PH == 8) ph_gemm_out(p, lds, wv);
    if constexpr (PH == 9) ph_router(p, lds, wv);
    if constexpr (PH == 10) ph_scan(p, lds, wv);
    if constexpr (PH == 11) ph_scatter(p, lds, wv);
    if constexpr (PH == 12) ph_gemm_gu(p, lds, wv);
    if constexpr (PH == 13) ph_gemm_dn(p, lds, wv);
    if constexpr (PH == 14) ph_final<false>(p, wv);
}
template <int PH> __global__ void __launch_bounds__(NTHR, 2) k_phase(P p) {
    extern __shared__ __attribute__((aligned(16))) unsigned char lds_raw[];
    run_phase<PH>(p, (LAS unsigned char*)lds_raw, __builtin_amdgcn_readfirstlane(threadIdx.x >> 6));
}

constexpr int MISC_OFF = LDS_BYTES - 256;
__global__ void __launch_bounds__(NTHR, 2) k_mega(P p) {
    extern __shared__ __attribute__((aligned(16))) unsigned char lds_raw[];
    LAS unsigned char* lds = (LAS unsigned char*)lds_raw;
    volatile LAS unsigned* MISC = (volatile LAS unsigned*)(lds + MISC_OFF);
    int wv = __builtin_amdgcn_readfirstlane(threadIdx.x >> 6); asm volatile("" : "+s"(wv));
    if (threadIdx.x < 64) MISC[threadIdx.x] = 0u;
    __syncthreads();
    XcdBarrier bar = xcd_barrier_post(p.ctl + CW_BAR, MISC, wv);
    run_phase<0>(p, lds, wv);
#if defined(DUP0)
    __syncthreads(); run_phase<0>(p, lds, wv);
#endif
    xcd_barrier(bar);
    run_phase<1>(p, lds, wv);
#if defined(DUP1)
    __syncthreads(); run_phase<1>(p, lds, wv);
#endif
    xcd_barrier(bar);
    run_phase<2>(p, lds, wv);
#if defined(DUP2)
    run_phase<2>(p, lds, wv);
#endif
#if defined(PRE3)
    ph_index7_t<PRE3>(p, lds, wv); __syncthreads();
#endif
    run_phase<3>(p, lds, wv);
#if defined(DUP3)
    __syncthreads(); run_phase<3>(p, lds, wv);
#endif
    xcd_barrier(bar);
    run_phase<4>(p, lds, wv);  __syncthreads();
#if defined(DUP4)
    run_phase<4>(p, lds, wv);  __syncthreads();
#endif
    run_phase<5>(p, lds, wv);
#if defined(DUP5)
    __syncthreads(); run_phase<5>(p, lds, wv);
#endif
    xcd_barrier(bar);
    run_phase<6>(p, lds, wv);
    run_phase<7>(p, lds, wv);  xcd_barrier(bar);
    run_phase<8>(p, lds, wv);
#if defined(DUP678)
    __syncthreads(); run_phase<6>(p, lds, wv); run_phase<7>(p, lds, wv); xcd_barrier(bar); run_phase<8>(p, lds, wv);
#endif
    xcd_barrier(bar);
#if defined(PRE9)
    ph_router_t<PRE9>(p, lds, wv); __syncthreads();
#endif
    run_phase<9>(p, lds, wv);
#if defined(DUP9)
    __syncthreads(); run_phase<9>(p, lds, wv);
#endif

    xcd_barrier(bar);
    run_phase<11>(p, lds, wv);
#if defined(DUP11)
    __syncthreads(); run_phase<11>(p, lds, wv);
#endif
    xcd_barrier(bar);
    run_phase<12>(p, lds, wv);
#if defined(DUP12)
    __syncthreads(); run_phase<12>(p, lds, wv);
#endif
    xcd_barrier(bar);
    run_phase<13>(p, lds, wv);
#if defined(DUP13)
    __syncthreads(); run_phase<13>(p, lds, wv);
#endif
    xcd_barrier(bar);
#if defined(XBAR10)
    for (int i = 0; i < 10; ++i) xcd_barrier(bar);
#endif
#if defined(DUP14)
    ph_final<true>(p, wv); __syncthreads();
#endif
    run_phase<14>(p, lds, wv);
}

extern "C" void kernel_launch(void* const* d_in, const int* in_sizes, int n_in, void* d_out, int out_size, void* d_ws, size_t ws_size, hipStream_t stream) {
    static int grid = 0; static bool first = true;
    if (grid == 0) {
        if (n_in != 23 || in_sizes[0] != M * D || out_size != M * D || ws_size < WS_END) { fprintf(stderr, "kernel_launch: unexpected shapes (n_in %d, in0 %d, out %d, ws %zu)\n", n_in, n_in > 0 ? in_sizes[0] : -1, out_size, ws_size); grid = -1; return; }
        int dev = 0, cus = 0;
        if (hipGetDevice(&dev) != hipSuccess || hipDeviceGetAttribute(&cus, hipDeviceAttributeMultiprocessorCount, dev) != hipSuccess) { grid = -1; return; }
        grid = cus;
    }
    if (grid < 0) return;
    unsigned char* ws = (unsigned char*)d_ws;
    (void)hipMemsetAsync(ws + WS_CTL, 0, CTL_ZERO_BYTES, stream);
    P p{};
    const float* const* in = (const float* const*)d_in;
    p.x = in[0]; p.w_in = in[1]; p.kv_g = in[2]; p.w_uk = in[3]; p.w_uv = in[4]; p.rel_bias = in[5]; p.ln_g = in[6]; p.ln_b = in[7]; p.w_sp = in[8]; p.b_sp = in[9];
    p.w_pa = in[10]; p.w_pb = in[11]; p.w_out = in[12]; p.n1g = in[13]; p.n2g = in[14]; p.rg_w = in[15]; p.rg_b = in[16]; p.re_w = in[17]; p.re_b = in[18];
    p.w_gate = in[19]; p.w_up = in[20]; p.w_down = in[21]; p.fg = in[22];
    p.out = (float*)d_out; p.ctl = (unsigned*)(ws + WS_CTL);
    p.WinT = (bf16_t*)(ws + WS_WIN); p.WoutT = (bf16_t*)(ws + WS_WOUT); p.WpbT = (bf16_t*)(ws + WS_WPB); p.WovT = (bf16_t*)(ws + WS_WOV); p.WSB = (bf16_t*)(ws + WS_WSB);
    p.WguT = (bf16_t*)(ws + WS_WGU); p.WdT = (bf16_t*)(ws + WS_WD); p.WrT = (float*)(ws + WS_WRT);
    p.HB = (bf16_t*)(ws + WS_A); p.OL = (bf16_t*)(ws + WS_A); p.H2B = (bf16_t*)(ws + WS_A);
    p.QL = (bf16_t*)(ws + WS_B); p.MB = (bf16_t*)(ws + WS_B); p.H2S = (bf16_t*)(ws + WS_B); p.YS = (bf16_t*)(ws + WS_B);
    p.GAB = (bf16_t*)(ws + WS_GA); p.GBB = (bf16_t*)(ws + WS_GB);
    p.UB = (bf16_t*)(ws + WS_C); p.VB = (bf16_t*)(ws + WS_C + 32 * MiB); p.MG = (bf16_t*)(ws + WS_C); p.HE = (bf16_t*)(ws + WS_C);
    p.QI = (bf16_t*)(ws + WS_DQ); p.US = (bf16_t*)(ws + WS_DQ);
    p.CKVR = (float*)(ws + WS_CKVR); p.CKVB = (bf16_t*)(ws + WS_CKVB); p.KI = (bf16_t*)(ws + WS_KI); p.WI = (float*)(ws + WS_WI); p.SEL = (unsigned short*)(ws + WS_SEL);
    p.EID = (int*)(ws + WS_MOE); p.EW = (float*)(ws + WS_MOE + 262144); p.PTOK = (int*)(ws + WS_MOE + 524288); p.MOEI = (int*)(ws + WS_MOE + 1048576);
    p.GU = (int*)(ws + WS_MOE + 1048576 + 4096); p.BLKCNT = (int*)(ws + WS_MOE + 1048576 + 65536); p.IDXROW = (float*)(ws + WS_A); p.RINV2 = (float*)(ws + WS_MOE + 1048576 + 262144); p.CB = (int*)(ws + WS_MOE + 1048576 + 131072); p.DN = (int*)(ws + WS_MOE + 1048576 + 4096 + 8192);
    if (first) { (void)hipFuncSetAttribute((const void*)k_mega, hipFuncAttributeMaxDynamicSharedMemorySize, LDS_BYTES); first = false; }
    hipLaunchKernelGGL(k_mega, dim3(grid), dim3(NTHR), LDS_BYTES, stream, p);
}
```

```cpp
#include <hip/hip_runtime.h>
#include <cstdio>
#include <cstdint>
__device__ __forceinline__ int opaque_tid(const int wv) { int l; asm volatile("v_mbcnt_lo_u32_b32 %0, -1, 0\n\tv_mbcnt_hi_u32_b32 %0, -1, %0" : "=v"(l)); return (wv << 6) + l; }
#define LAS __attribute__((address_space(3)))
namespace pg8 {
#define PG8_LAS __attribute__((address_space(3)))
typedef unsigned short bf16_t;
typedef short bf16x8 __attribute__((ext_vector_type(8)));
typedef float f32x4 __attribute__((ext_vector_type(4)));
typedef unsigned u32x4 __attribute__((ext_vector_type(4)));
constexpr int BM = 256, BK = 64, HALF = 128, HTB = HALF * BK * 2  , STAGE_BYTES = 8 * HTB, NXCD = 8, WGM = 8;

__host__ __device__ __forceinline__ int lds_byte(int r, int c) { const int st = (r >> 4) * 2 + (c >> 5), rr = r & 15, cc = c & 31, ob = rr * 64 + cc * 2; return st * 1024 + (ob ^ (((ob >> 9) & 1) << 5)); }
__host__ __device__ __forceinline__ void stage_rc(int b, int& R, int& C) { const int st = b / 1024, sb = b % 1024, swz = sb ^ (((sb >> 9) & 1) << 5); R = (st >> 1) * 16 + swz / 64; C = (st & 1) * 32 + (swz % 64) / 2; }
__host__ __device__ __forceinline__ int perm32(int rho) { const int n = rho >> 4, i = rho & 15; return 8 * (i >> 2) + 4 * n + (i & 3); }

struct Unit { int pm, pn; };
struct Gemm { const bf16_t* A; const bf16_t* Bt; int M, N, K; };

struct StaticOrder {
    static constexpr bool GATHER = false;
    int nM, nN, nwg, G, c;
    __host__ __device__ void init(int M, int N, int G_, int c_) { nM = M / BM; nN = N / BM; nwg = nM * nN; G = G_; c = c_; }
    __host__ __device__ bool next(int i, Unit& u) const {
        const long L = (long)i * G + c; if (L >= nwg) return false;
        int wgid = (int)L; { const int q = nwg / NXCD, r = nwg % NXCD, xcd = wgid % NXCD, off = wgid / NXCD; wgid = (xcd < r ? xcd * (q + 1) : r * (q + 1) + (xcd - r) * q) + off; }
        const int nig = WGM * nN, gid = wgid / nig, fm = gid * WGM, gsz = (nM - fm) < WGM ? (nM - fm) : WGM;
        u.pm = fm + ((wgid % nig) % gsz); u.pn = (wgid % nig) / gsz; return true;
    }
    __device__ __forceinline__ int arow(int r) const { return r; }
    __device__ __forceinline__ void a_ready(const Unit&) const {}
    __device__ __forceinline__ void done(const Unit&) const {}
};

__device__ __forceinline__ unsigned cvt_pk_bf16(float lo, float hi) { unsigned r; asm volatile("v_cvt_pk_bf16_f32 %0, %1, %2" : "=v"(r) : "v"(lo), "v"(hi)); return r; }
typedef float f32x2 __attribute__((ext_vector_type(2)));
template <class Epi, class Sched, bool ALIGN_EPI = false, bool SP2 = false>
__device__ __forceinline__ void gemm_phase(PG8_LAS unsigned char* lds, const Gemm g, const Sched& S, const Epi& E, const int wv) {
    const int tid = opaque_tid(wv), wid = __builtin_amdgcn_readfirstlane(tid >> 6), lane = tid & 63, wr = wid >> 2, wc = wid & 3, fr = lane & 15, fq = lane >> 4;
    const int K = g.K, nt = K / BK;
    unsigned voffA[2], voffB[2];
#pragma unroll
    for (int i = 0; i < 2; ++i) { int R, C; stage_rc(tid * 16 + i * 8192, R, C); const int Rb = Epi::PERM ? ((R & ~31) + perm32(R & 31)) : R;
        voffA[i] = (unsigned)(R * K + C) * 2u; voffB[i] = (unsigned)(Rb * K + C) * 2u; }
    static_assert(!Sched::GATHER || SP2, "gathered A rows: SP2 loop only");
    unsigned gcur[2][2], gnxt[2][2]; int gR[2], gC[2];
    if constexpr (Sched::GATHER) {
#pragma unroll
        for (int i = 0; i < 2; ++i) { stage_rc(tid * 16 + i * 8192, gR[i], gC[i]); }
    }
#define PG8_GOFF(dst, u_) do { _Pragma("unroll") for (int h_ = 0; h_ < 2; ++h_) _Pragma("unroll") for (int i_ = 0; i_ < 2; ++i_) \
        dst[h_][i_] = ((unsigned)S.arow((u_).pm * BM + h_ * HALF + gR[i_]) * (unsigned)K + (unsigned)gC[i_]) * 2u; } while (0)
    const size_t kstep = (size_t)(BK * 2);
    const size_t hstep = (size_t)HALF * K * 2;
    const size_t tstep = 2 * hstep;
    const unsigned ldsw = (unsigned)wid * 1024u;
    const int aoff = lds_byte(wr * 64 + fr, fq * 8), boff = lds_byte(wc * 32 + fr, fq * 8);
#define PG8_SA(b, h) (((b) * 2 + (h)) * HTB)
#define PG8_SB(b, h) ((4 + (b) * 2 + (h)) * HTB)
#define PG8_STAGE(bufoff, gbase, voff) do { _Pragma("unroll") for (int _i = 0; _i < 2; ++_i) \
        __builtin_amdgcn_global_load_lds((const unsigned*)((const char*)(gbase) + (voff)[_i]), (PG8_LAS unsigned*)(lds + (bufoff) + ldsw + _i * 8192), 16, 0, 0); } while (0)
#define PG8_LDA(dst, b, h) do { _Pragma("unroll") for (int m = 0; m < 4; ++m) _Pragma("unroll") for (int k = 0; k < 2; ++k) dst[m][k] = *(const PG8_LAS bf16x8*)(lds + PG8_SA(b, h) + aoff + m * 2048 + k * 1024); } while (0)
#define PG8_LDB(dst, b, h) do { _Pragma("unroll") for (int n = 0; n < 2; ++n) _Pragma("unroll") for (int k = 0; k < 2; ++k) dst[n][k] = *(const PG8_LAS bf16x8*)(lds + PG8_SB(b, h) + boff + n * 2048 + k * 1024); } while (0)
#define PG8_MMA(ai, bj, At, Bt) do { __builtin_amdgcn_s_setprio(1); _Pragma("unroll") for (int m = 0; m < 4; ++m) _Pragma("unroll") for (int n = 0; n < 2; ++n) _Pragma("unroll") for (int k = 0; k < 2; ++k) \
        acc[ai][bj][m][n] = __builtin_amdgcn_mfma_f32_16x16x32_bf16(Bt[n][k], At[m][k], acc[ai][bj][m][n], 0, 0, 0); __builtin_amdgcn_s_setprio(0); } while (0)
#define PG8_WAIT_V(n) asm volatile("s_waitcnt vmcnt(" #n ")" ::: "memory")
#define PG8_WAIT_L(n) asm volatile("s_waitcnt lgkmcnt(" #n ")" ::: "memory")
#define PG8_BAR __builtin_amdgcn_s_barrier()
#define PG8_SCHED __builtin_amdgcn_sched_barrier(0)
    Unit cur, nxt; int ui = 0;
    if (!S.next(0, cur)) return;
    f32x4 acc[2][2][4][2];
#pragma unroll
    for (int a = 0; a < 2; ++a)
#pragma unroll
        for (int b = 0; b < 2; ++b)
#pragma unroll
            for (int m = 0; m < 4; ++m)
#pragma unroll
                for (int n = 0; n < 2; ++n) acc[a][b][m][n] = (f32x4){0.f, 0.f, 0.f, 0.f};
    bf16x8 At[4][2], B0[2][2], B1[2][2];
    const char* cA = Sched::GATHER ? (const char*)g.A : (const char*)g.A + (size_t)cur.pm * tstep; const char* cB = (const char*)g.Bt + (size_t)cur.pn * tstep;
    S.a_ready(cur);
    if constexpr (Sched::GATHER) { PG8_GOFF(gcur, cur); }
#define PG8_STAGE_A(bufoff, base_, h_, koff_, GO_) do { if constexpr (Sched::GATHER) { PG8_STAGE(bufoff, (const char*)g.A + (koff_), GO_[h_]); } else { PG8_STAGE(bufoff, (base_) + (h_) * hstep + (koff_), voffA); } } while (0)
    if constexpr (SP2) {
        PG8_STAGE(PG8_SB(0, 0), cB, voffB); PG8_STAGE(PG8_SB(0, 1), cB + hstep, voffB); PG8_STAGE_A(PG8_SA(0, 0), cA, 0, 0, gcur); PG8_STAGE_A(PG8_SA(0, 1), cA, 1, 0, gcur);
        if (wr == 1) PG8_BAR;
        PG8_WAIT_V(2); PG8_BAR;
        PG8_STAGE(PG8_SB(1, 0), cB + kstep, voffB); PG8_STAGE_A(PG8_SA(1, 0), cA, 0, kstep, gcur); PG8_STAGE(PG8_SB(1, 1), cB + hstep + kstep, voffB);
        PG8_WAIT_V(6); PG8_BAR;
    } else {
        PG8_STAGE(PG8_SB(0, 0), cB, voffB); PG8_STAGE(PG8_SA(0, 0), cA, voffA); PG8_STAGE(PG8_SB(0, 1), cB + hstep, voffB); PG8_STAGE(PG8_SA(0, 1), cA + hstep, voffA);
        if (wr == 1) PG8_BAR;
        PG8_WAIT_V(4); PG8_BAR;
        PG8_STAGE(PG8_SB(1, 0), cB + kstep, voffB); PG8_STAGE(PG8_SA(1, 0), cA + kstep, voffA); PG8_STAGE(PG8_SB(1, 1), cB + hstep + kstep, voffB);
        PG8_WAIT_V(6); PG8_BAR;
    }
    for (;;) {
        const bool has_next = S.next(ui + 1, nxt);
        const char* nA = Sched::GATHER ? cA : (has_next ? (const char*)g.A + (size_t)nxt.pm * tstep : cA); const char* nB = has_next ? (const char*)g.Bt + (size_t)nxt.pn * tstep : cB;
        if constexpr (Sched::GATHER) { if (has_next) { PG8_GOFF(gnxt, nxt); } else { _Pragma("unroll") for (int h_ = 0; h_ < 2; ++h_) _Pragma("unroll") for (int i_ = 0; i_ < 2; ++i_) gnxt[h_][i_] = gcur[h_][i_]; } }
        for (int t = 0; t < nt; t += 2) {
            const bool last = (t == nt - 2);
            const char* a1 = cA + (size_t)(t + 1) * kstep;
            const char* a2 = last ? nA : cA + (size_t)(t + 2) * kstep; const char* b2 = last ? nB : cB + (size_t)(t + 2) * kstep;
            const char* a3 = a2 + kstep; const char* b3 = b2 + kstep;
            unsigned g2[2][2];
            if constexpr (Sched::GATHER) { _Pragma("unroll") for (int h_ = 0; h_ < 2; ++h_) _Pragma("unroll") for (int i_ = 0; i_ < 2; ++i_) g2[h_][i_] = last ? gnxt[h_][i_] : gcur[h_][i_]; }
            const size_t k1 = (size_t)(t + 1) * kstep, k2 = last ? (size_t)0 : (size_t)(t + 2) * kstep, k3 = k2 + kstep;
            if (last && has_next) S.a_ready(nxt);
            if constexpr (SP2) {
            PG8_LDB(B0, 0, 0); PG8_LDB(B1, 0, 1); PG8_SCHED; PG8_LDA(At, 0, 0); if constexpr (Sched::GATHER) { PG8_STAGE(PG8_SA(1, 1), (const char*)g.A + k1, gcur[1]); } else { PG8_STAGE(PG8_SA(1, 1), a1 + hstep, voffA); }
            PG8_WAIT_V(8); PG8_WAIT_L(0); PG8_BAR; PG8_MMA(0, 0, At, B0); PG8_MMA(0, 1, At, B1); PG8_BAR; PG8_SCHED;
            PG8_LDA(At, 0, 1); PG8_STAGE(PG8_SB(0, 0), b2, voffB); PG8_STAGE(PG8_SB(0, 1), b2 + hstep, voffB); if constexpr (Sched::GATHER) { PG8_STAGE(PG8_SA(0, 0), (const char*)g.A + k2, g2[0]); } else { PG8_STAGE(PG8_SA(0, 0), a2, voffA); }
            PG8_WAIT_V(8); PG8_WAIT_L(0); PG8_BAR; PG8_MMA(1, 0, At, B0); PG8_MMA(1, 1, At, B1); PG8_BAR; PG8_SCHED;
            PG8_LDB(B0, 1, 0); PG8_LDB(B1, 1, 1); PG8_SCHED; PG8_LDA(At, 1, 0); if constexpr (Sched::GATHER) { PG8_STAGE(PG8_SA(0, 1), (const char*)g.A + k2, g2[1]); } else { PG8_STAGE(PG8_SA(0, 1), a2 + hstep, voffA); }
            PG8_WAIT_V(8); PG8_WAIT_L(0); PG8_BAR; PG8_MMA(0, 0, At, B0); PG8_MMA(0, 1, At, B1); PG8_BAR; PG8_SCHED;
            PG8_LDA(At, 1, 1); PG8_STAGE(PG8_SB(1, 0), b3, voffB); PG8_STAGE(PG8_SB(1, 1), b3 + hstep, voffB); if constexpr (Sched::GATHER) { PG8_STAGE(PG8_SA(1, 0), (const char*)g.A + k3, g2[0]); } else { PG8_STAGE(PG8_SA(1, 0), a3, voffA); }
            PG8_WAIT_V(8); PG8_WAIT_L(0); PG8_BAR; PG8_MMA(1, 0, At, B0); PG8_MMA(1, 1, At, B1); PG8_BAR; PG8_SCHED;
            } else {
            PG8_LDB(B0, 0, 0); PG8_SCHED; PG8_LDA(At, 0, 0); PG8_STAGE(PG8_SA(1, 1), a1 + hstep, voffA);
            PG8_WAIT_L(8); PG8_BAR; PG8_WAIT_L(0); PG8_MMA(0, 0, At, B0); PG8_BAR; PG8_SCHED;
            PG8_LDB(B1, 0, 1); PG8_STAGE(PG8_SB(0, 0), b2, voffB);
            PG8_BAR; PG8_WAIT_L(0); PG8_MMA(0, 1, At, B1); PG8_BAR;
            PG8_LDA(At, 0, 1); PG8_STAGE(PG8_SA(0, 0), a2, voffA);
            PG8_BAR; PG8_WAIT_L(0); PG8_MMA(1, 0, At, B0); PG8_BAR; PG8_SCHED;
            PG8_STAGE(PG8_SB(0, 1), b2 + hstep, voffB);
            PG8_WAIT_V(6); PG8_BAR; PG8_MMA(1, 1, At, B1); PG8_BAR;
            PG8_LDB(B0, 1, 0); PG8_SCHED; PG8_LDA(At, 1, 0); PG8_STAGE(PG8_SA(0, 1), a2 + hstep, voffA);
            PG8_WAIT_L(8); PG8_BAR; PG8_WAIT_L(0); PG8_MMA(0, 0, At, B0); PG8_BAR; PG8_SCHED;
            PG8_LDB(B1, 1, 1); PG8_STAGE(PG8_SB(1, 0), b3, voffB);
            PG8_BAR; PG8_WAIT_L(0); PG8_MMA(0, 1, At, B1); PG8_BAR;
            PG8_LDA(At, 1, 1); PG8_STAGE(PG8_SA(1, 0), a3, voffA);
            PG8_BAR; PG8_WAIT_L(0); PG8_MMA(1, 0, At, B0); PG8_BAR; PG8_SCHED;
            PG8_STAGE(PG8_SB(1, 1), b3 + hstep, voffB);
            PG8_WAIT_V(6); PG8_BAR; PG8_MMA(1, 1, At, B1); PG8_BAR;
            }
        }
        if constexpr (ALIGN_EPI) { if (wr == 0) PG8_BAR; }
        if constexpr (!Epi::AFTER_DRAIN) {
            const int tz = opaque_tid(wv), wz = __builtin_amdgcn_readfirstlane(tz >> 6), lz = tz & 63;
            E(acc, cur, wz >> 2, wz & 3, lz & 15, lz >> 4); S.done(cur); }
        if (!has_next) break;
#pragma unroll
        for (int a = 0; a < 2; ++a)
#pragma unroll
            for (int b = 0; b < 2; ++b)
#pragma unroll
                for (int m = 0; m < 4; ++m)
#pragma unroll
                    for (int n = 0; n < 2; ++n) acc[a][b][m][n] = (f32x4){0.f, 0.f, 0.f, 0.f};
        cur = nxt; cA = nA; cB = nB; ++ui;
        if constexpr (Sched::GATHER) { _Pragma("unroll") for (int h_ = 0; h_ < 2; ++h_) _Pragma("unroll") for (int i_ = 0; i_ < 2; ++i_) gcur[h_][i_] = gnxt[h_][i_]; }
        if constexpr (ALIGN_EPI) { if (wr == 1) PG8_BAR; }
    }
    PG8_WAIT_V(0);
    if constexpr (!ALIGN_EPI) { if (wr == 0) PG8_BAR; }
    PG8_BAR;
    if constexpr (Epi::AFTER_DRAIN) { E.fused(acc, cur, wr, wc, fr, fq, lds, wid, lane); S.done(cur); }
#undef PG8_SA
#undef PG8_SB
#undef PG8_STAGE
#undef PG8_STAGE_A
#undef PG8_GOFF
#undef PG8_LDA
#undef PG8_LDB
#undef PG8_MMA
#undef PG8_WAIT_V
#undef PG8_WAIT_L
#undef PG8_BAR
#undef PG8_SCHED
}
}
#define XB_TMO      128
#define XB_XCNT(j)  (256  + 64 * (j))
#define XB_XSUB(j)  (1280 + 64 * (j))
#define XB_XGEN(j)  (2304 + 64 * (j))
#define XB_TOP      3328
#define XB_TOPGEN   3392
#define XCD_BAR_WORDS 3456
#define XB_SPIN_CAP (1u << 18)

__device__ __forceinline__ unsigned xb_ld(unsigned* p)              { return __hip_atomic_load(p, __ATOMIC_RELAXED, __HIP_MEMORY_SCOPE_AGENT); }
__device__ __forceinline__ unsigned xb_add(unsigned* p, unsigned v) { return __hip_atomic_fetch_add(p, v, __ATOMIC_RELAXED, __HIP_MEMORY_SCOPE_AGENT); }
__device__ __forceinline__ unsigned xb_xcc_id() { return (unsigned)__builtin_amdgcn_s_getreg((3 << 11) | 20) & 0xFu; }
#define XB_SPIN(cond, bar) do { unsigned _sp = 0; while (cond) { __builtin_amdgcn_s_sleep(1); \
    if ((++_sp & 255u) == 0u) { if (xb_ld(&(bar)[XB_TMO])) break; if (_sp > XB_SPIN_CAP) { atomicAdd(&(bar)[XB_TMO], 1u); break; } } } } while (0)

struct XcdBarrier {
    unsigned* bar; unsigned x; int wv;
    volatile LAS unsigned* st;
};

__device__ __forceinline__ XcdBarrier xcd_barrier_post(unsigned* bar, volatile LAS unsigned* st, int wv) {
    XcdBarrier b; b.bar = bar; b.x = xb_xcc_id(); b.st = st; b.wv = wv;
    if (opaque_tid(wv) == 0) (void)xb_add(&bar[XB_XCNT(b.x)], 1u);
    return b;
}
__device__ __forceinline__ void xcd_barrier_complete(unsigned* bar, unsigned x, unsigned& nloc, unsigned& nx) {
    const unsigned G = gridDim.x * gridDim.y * gridDim.z;
    unsigned sum, cnt, mine, sp = 0u;
    for (;;) {
        sum = 0u; cnt = 0u; mine = 0u;
#pragma unroll
        for (unsigned j = 0; j < 16; ++j) { const unsigned c = xb_ld(&bar[XB_XCNT(j)]); sum += c; cnt += (c > 0u) ? 1u : 0u; mine = (j == x) ? c : mine; }
        if (sum == G) break;
        __builtin_amdgcn_s_sleep(1);
        if ((++sp & 255u) == 0u) { if (xb_ld(&bar[XB_TMO])) break; if (sp > XB_SPIN_CAP) { atomicAdd(&bar[XB_TMO], 1u); break; } }
    }
    nloc = mine > 0u ? mine : 1u; nx = cnt > 0u ? cnt : 1u;
}

__device__ __forceinline__ void xcd_barrier(const XcdBarrier& b) {
    asm volatile("s_waitcnt vmcnt(0)" ::: "memory");
    __syncthreads();
    if (opaque_tid(b.wv) == 0) {
        unsigned* bar = b.bar;
        __builtin_amdgcn_s_waitcnt(0);
        unsigned nloc = b.st[0], nx = b.st[1];
        if (nloc == 0u) { xcd_barrier_complete(bar, b.x, nloc, nx); b.st[0] = nloc; b.st[1] = nx; }
        const unsigned old = xb_add(&bar[XB_XSUB(b.x)], 1u);
        const unsigned gen = old / nloc;
        if (old + 1u == (gen + 1u) * nloc) {
            __builtin_amdgcn_fence(__ATOMIC_RELEASE, "agent");
            asm volatile("s_waitcnt vmcnt(0)" ::: "memory");
            const unsigned og = xb_add(&bar[XB_TOP], 1u);
            const unsigned tg = og / nx;
            if (og + 1u == (tg + 1u) * nx) xb_add(&bar[XB_TOPGEN], 1u);
            else XB_SPIN(xb_ld(&bar[XB_TOPGEN]) == tg, bar);
            __builtin_amdgcn_fence(__ATOMIC_ACQUIRE, "agent");
            xb_add(&bar[XB_XGEN(b.x)], 1u);
            asm volatile("s_waitcnt vmcnt(0)" ::: "memory");
        } else {
            XB_SPIN(xb_ld(&bar[XB_XGEN(b.x)]) == gen, bar);
            __builtin_amdgcn_fence(__ATOMIC_ACQUIRE, "agent");
            asm volatile("s_waitcnt vmcnt(0)" ::: "memory");
        }
    }
    __syncthreads();
}

typedef unsigned short bf16_t;
typedef short bf16x8 __attribute__((ext_vector_type(8)));
typedef short bf16x4 __attribute__((ext_vector_type(4)));
typedef float f32x4 __attribute__((ext_vector_type(4)));
typedef float f32x2 __attribute__((ext_vector_type(2)));
typedef float f32x16 __attribute__((ext_vector_type(16)));
typedef unsigned u32x4 __attribute__((ext_vector_type(4)));
typedef unsigned u32x2 __attribute__((ext_vector_type(2)));

constexpr int NB = 8, T = 4096, D = 1024, M = NB * T;
constexpr int INC = 4296;
constexpr int NIN = 19 * 256;
constexpr float EPS = 1e-6f;
constexpr int NPOS = 73728;
constexpr int NWAVES = 8, NTHR = 512;
constexpr int LDS_BYTES = 163840;

constexpr size_t MiB = 1u << 20;
constexpr size_t WS_CTL = 0, CTL_ZERO_BYTES = 65536;
constexpr size_t WS_WIN = 1 * MiB, WS_WOUT = 11 * MiB, WS_WPB = 13 * MiB, WS_WOV = 14 * MiB, WS_WSB = 16 * MiB, WS_WRT = 16 * MiB + 262144, WS_WGU = 17 * MiB, WS_WD = 49 * MiB;
constexpr size_t WS_A = 65 * MiB;
constexpr size_t WS_B = 129 * MiB;
constexpr size_t WS_GA = 193 * MiB, WS_GB = 257 * MiB;
constexpr size_t WS_C = 321 * MiB;
constexpr size_t WS_DQ = 385 * MiB;
constexpr size_t WS_CKVR = 417 * MiB, WS_CKVB = 433 * MiB, WS_KI = 441 * MiB, WS_WI = 445 * MiB, WS_SEL = 446 * MiB;
constexpr size_t WS_MOE = 462 * MiB;
constexpr size_t WS_END = 464 * MiB;

constexpr int CW_BAR = 4096;
constexpr int CW_CNT = 8192, CW_CUR = 8256;

struct P {
    const float *x, *w_in, *kv_g, *w_uk, *w_uv, *rel_bias, *ln_g, *ln_b, *w_sp, *b_sp, *w_pa, *w_pb, *w_out, *n1g, *n2g, *rg_w, *rg_b, *re_w, *re_b, *w_gate, *w_up, *w_down, *fg;
    float* out;
    unsigned* ctl;
    bf16_t *WinT, *WoutT, *WpbT, *WovT, *WSB, *WguT, *WdT;
    float* WrT;
    bf16_t *HB, *QL, *QI, *CKVB, *KI, *UB, *VB, *GAB, *GBB, *OL, *US, *MB, *MG, *H2B, *H2S, *HE, *YS;
    float *CKVR, *WI, *EW, *IDXROW, *RINV2;
    unsigned short* SEL;
    int *EID, *PTOK, *MOEI, *GU, *DN, *BLKCNT, *CB;
};

__device__ __forceinline__ unsigned f2bf(float f) { unsigned u = __builtin_bit_cast(unsigned, f); return (u + 0x7fffu + ((u >> 16) & 1u)) >> 16; }
__device__ __forceinline__ unsigned pk2(float lo, float hi) { return f2bf(lo) | (f2bf(hi) << 16); }
__device__ __forceinline__ float bflo(unsigned w) { return __builtin_bit_cast(float, w << 16); }
__device__ __forceinline__ float bfhi(unsigned w) { return __builtin_bit_cast(float, w & 0xffff0000u); }
__device__ __forceinline__ float bf2f(unsigned short b) { return __builtin_bit_cast(float, (unsigned)b << 16); }
__device__ __forceinline__ float wave_sum(float v) {
#pragma unroll
    for (int o = 1; o < 64; o <<= 1) v += __shfl_xor(v, o);
    return v;
}
#define LDS_WAIT() asm volatile("s_waitcnt lgkmcnt(0)" ::: "memory")
__device__ __forceinline__ float sigm(float x) { return __builtin_amdgcn_rcpf(1.f + __builtin_amdgcn_exp2f(-1.4426950409f * x)); }
__device__ __forceinline__ float gelu_t(float x) { const float x2 = x * x; return x * __builtin_amdgcn_rcpf(1.f + __builtin_amdgcn_exp2f(x * (-2.3022082f - 0.1029432f * x2))); }
__device__ __forceinline__ unsigned off_b(unsigned row, unsigned ch) { return 256u * row + 16u * (ch ^ (((row & 3) << 2) | ((row >> 2) & 3))); }
__device__ __forceinline__ bf16x4 tr_read(unsigned lds_addr) { bf16x4 r; asm volatile("ds_read_b64_tr_b16 %0, %1\n\ts_waitcnt lgkmcnt(0)" : "=&v"(r) : "v"(lds_addr) : "memory"); return r; }
__device__ __forceinline__ bf16x8 cat4(bf16x4 a, bf16x4 b) { bf16x8 r; r[0] = a[0]; r[1] = a[1]; r[2] = a[2]; r[3] = a[3]; r[4] = b[0]; r[5] = b[1]; r[6] = b[2]; r[7] = b[3]; return r; }
__device__ __forceinline__ unsigned lds_addr_of(LAS unsigned char* p) { return (unsigned)(unsigned long long)p; }

__device__ __forceinline__ void st8bf(bf16_t* p, const pg8::f32x4& a, const pg8::f32x4& b) {
    u32x4 w; w.x = pg8::cvt_pk_bf16(a[0], a[1]); w.y = pg8::cvt_pk_bf16(a[2], a[3]); w.z = pg8::cvt_pk_bf16(b[0], b[1]); w.w = pg8::cvt_pk_bf16(b[2], b[3]);
    *(u32x4*)p = w;
}
__device__ __forceinline__ void ld8bf(const bf16_t* p, pg8::f32x4& a, pg8::f32x4& b) {
    const u32x4 w = *(const u32x4*)p;
    a[0] = bflo(w.x); a[1] = bfhi(w.x); a[2] = bflo(w.y); a[3] = bfhi(w.y); b[0] = bflo(w.z); b[1] = bfhi(w.z); b[2] = bflo(w.w); b[3] = bfhi(w.w);
}

__device__ __forceinline__ void st8q(unsigned char* p, const pg8::f32x4& a, const pg8::f32x4& b) {
    float v[8];
#pragma unroll
    for (int j = 0; j < 4; ++j) { v[j] = fminf(fmaxf(a[j] * 16.f, -440.f), 440.f); v[4 + j] = fminf(fmaxf(b[j] * 16.f, -440.f), 440.f); }
    u32x2 h, l;
    h.x = (unsigned)__builtin_amdgcn_cvt_pk_fp8_f32(v[0], v[1], 0, false); h.x = (unsigned)__builtin_amdgcn_cvt_pk_fp8_f32(v[2], v[3], (int)h.x, true);
    h.y = (unsigned)__builtin_amdgcn_cvt_pk_fp8_f32(v[4], v[5], 0, false); h.y = (unsigned)__builtin_amdgcn_cvt_pk_fp8_f32(v[6], v[7], (int)h.y, true);
    const f32x2 b0 = __builtin_amdgcn_cvt_pk_f32_fp8((int)h.x, false), b1 = __builtin_amdgcn_cvt_pk_f32_fp8((int)h.x, true);
    const f32x2 b2 = __builtin_amdgcn_cvt_pk_f32_fp8((int)h.y, false), b3 = __builtin_amdgcn_cvt_pk_f32_fp8((int)h.y, true);
    l.x = (unsigned)__builtin_amdgcn_cvt_pk_fp8_f32(v[0] - b0[0], v[1] - b0[1], 0, false); l.x = (unsigned)__builtin_amdgcn_cvt_pk_fp8_f32(v[2] - b1[0], v[3] - b1[1], (int)l.x, true);
    l.y = (unsigned)__builtin_amdgcn_cvt_pk_fp8_f32(v[4] - b2[0], v[5] - b2[1], 0, false); l.y = (unsigned)__builtin_amdgcn_cvt_pk_fp8_f32(v[6] - b3[0], v[7] - b3[1], (int)l.y, true);
    *(u32x2*)p = h; *(u32x2*)(p + 128) = l;
}
struct EpiIn {
    static constexpr bool PERM = true, AFTER_DRAIN = false;
    bf16_t *QL, *QI, *KI, *UB, *VB, *GAB, *GBB; float *CKVR, *WI;
    __device__ __forceinline__ void operator()(const pg8::f32x4 (&acc)[2][2][4][2], const pg8::Unit& u, int wr, int wc, int fr, int fq) const {
        const int row0 = u.pm * 256 + wr * 64 + fr, pn = u.pn, c8 = wc * 32 + 8 * fq;
        int mode; bf16_t* dst; int ld;
        if (pn < 4)       { mode = 0; dst = QL + pn * 256; ld = 1024; }
        else if (pn < 6)  { mode = 0; dst = QI + (pn - 4) * 256; ld = 512; }
        else if (pn == 6) { mode = 3; dst = KI; ld = 64; }
        else if (pn < 9)  { mode = 1; dst = UB + (pn - 7) * 256; ld = 512; }
        else if (pn < 11) { mode = 1; dst = VB + (pn - 9) * 256; ld = 512; }
        else if (pn < 15) { mode = 2; dst = GAB + (pn - 11) * 256; ld = 1024; }
        else              { mode = 2; dst = GBB + (pn - 15) * 256; ld = 1024; }
#pragma unroll
        for (int ai = 0; ai < 2; ++ai)
#pragma unroll
            for (int m = 0; m < 4; ++m) {
                const size_t row = (size_t)(row0 + ai * 128 + m * 16);
#pragma unroll
                for (int bj = 0; bj < 2; ++bj) {
                    pg8::f32x4 v0 = acc[ai][bj][m][0], v1 = acc[ai][bj][m][1];
                    if (mode == 3) {
                        if (bj == 0) { float* c = CKVR + row * 128 + c8; *(pg8::f32x4*)c = v0; *(pg8::f32x4*)(c + 4) = v1; }
                        else if (c8 < 64) st8bf(KI + row * 64 + c8, v0, v1);
                        else if (c8 == 64) { float* c = WI + row * 8; *(pg8::f32x4*)c = v0 * 0.044194174f; *(pg8::f32x4*)(c + 4) = v1 * 0.044194174f; }
                    } else {
                        if (mode == 1) {
#pragma unroll
                            for (int j = 0; j < 4; ++j) { v0[j] = gelu_t(v0[j]); v1[j] = gelu_t(v1[j]); }
                        } else if (mode == 2) {
#pragma unroll
                            for (int j = 0; j < 4; ++j) { v0[j] = sigm(v0[j]); v1[j] = sigm(v1[j]); }
                        }
                        if (pn < 4) st8q((unsigned char*)QL + row * 2048 + (pn * 2 + bj) * 256 + c8, v0, v1);
                        else st8bf(dst + row * ld + bj * 128 + c8, v0, v1);
                    }
                }
            }
    }
};

struct EpiMB {
    static constexpr bool PERM = true, AFTER_DRAIN = false;
    const bf16_t* G; bf16_t* O;
    __device__ __forceinline__ void operator()(const pg8::f32x4 (&acc)[2][2][4][2], const pg8::Unit& u, int wr, int wc, int fr, int fq) const {
        const int row0 = u.pm * 256 + wr * 64 + fr, col0 = u.pn * 256 + wc * 32 + 8 * fq;
#pragma unroll
        for (int ai = 0; ai < 2; ++ai)
#pragma unroll
            for (int m = 0; m < 4; ++m)
#pragma unroll
                for (int bj = 0; bj < 2; ++bj) {
                    const size_t o = (size_t)(row0 + ai * 128 + m * 16) * 1024 + col0 + bj * 128;
                    pg8::f32x4 g0, g1; ld8bf(G + o, g0, g1);
                    st8bf(O + o, acc[ai][bj][m][0] * g0, acc[ai][bj][m][1] * g1);
                }
    }
};
struct EpiMG {
    static constexpr bool PERM = true, AFTER_DRAIN = false;
    const bf16_t *G, *MBp; bf16_t* O;
    __device__ __forceinline__ void operator()(const pg8::f32x4 (&acc)[2][2][4][2], const pg8::Unit& u, int wr, int wc, int fr, int fq) const {
        const int row0 = u.pm * 256 + wr * 64 + fr, col0 = u.pn * 256 + wc * 32 + 8 * fq;
#pragma unroll
        for (int ai = 0; ai < 2; ++ai)
#pragma unroll
            for (int m = 0; m < 4; ++m)
#pragma unroll
                for (int bj = 0; bj < 2; ++bj) {
                    const size_t o = (size_t)(row0 + ai * 128 + m * 16) * 1024 + col0 + bj * 128;
                    pg8::f32x4 g0, g1, b0, b1; ld8bf(G + o, g0, g1); ld8bf(MBp + o, b0, b1);
                    st8bf(O + o, acc[ai][bj][m][0] * g0 + b0, acc[ai][bj][m][1] * g1 + b1);
                }
    }
};
struct EpiX1 {
    static constexpr bool PERM = true, AFTER_DRAIN = false;
    const float* X; float* O;
    __device__ __forceinline__ void operator()(const pg8::f32x4 (&acc)[2][2][4][2], const pg8::Unit& u, int wr, int wc, int fr, int fq) const {
        const int row0 = u.pm * 256 + wr * 64 + fr, col0 = u.pn * 256 + wc * 32 + 8 * fq;
#pragma unroll
        for (int ai = 0; ai < 2; ++ai)
#pragma unroll
            for (int m = 0; m < 4; ++m)
#pragma unroll
                for (int bj = 0; bj < 2; ++bj) {
                    const size_t o = (size_t)(row0 + ai * 128 + m * 16) * 1024 + col0 + bj * 128;
                    const pg8::f32x4 x0 = *(const pg8::f32x4*)(X + o), x1 = *(const pg8::f32x4*)(X + o + 4);
                    *(pg8::f32x4*)(O + o) = x0 + acc[ai][bj][m][0]; *(pg8::f32x4*)(O + o + 4) = x1 + acc[ai][bj][m][1];
                }
    }
};
struct EpiHE {
    static constexpr bool PERM = true, AFTER_DRAIN = false;
    bf16_t* HE; const int* PTOK; const float* RINV2;
    __device__ __forceinline__ void operator()(const pg8::f32x4 (&acc)[2][2][4][2], const pg8::Unit& u, int wr, int wc, int fr, int fq) const {
        const int row0 = u.pm * 256 + wr * 64 + fr, col0 = (u.pn & 1) * 128 + wc * 32 + 8 * fq;
#pragma unroll
        for (int ai = 0; ai < 2; ++ai) {
            int ts[4]; float ri[4];
#pragma unroll
            for (int m = 0; m < 4; ++m) ts[m] = PTOK[row0 + ai * 128 + m * 16];
#pragma unroll
            for (int m = 0; m < 4; ++m) ri[m] = RINV2[ts[m] < 0 ? 0 : (ts[m] >> 1)];
#pragma unroll
            for (int m = 0; m < 4; ++m) {
                const float r = ts[m] < 0 ? 0.f : ri[m];
                pg8::f32x4 h0, h1;
#pragma unroll
                for (int j = 0; j < 4; ++j) {
                    const float g0 = r * acc[ai][0][m][0][j], g1 = r * acc[ai][0][m][1][j];
                    h0[j] = g0 * sigm(g0) * (r * acc[ai][1][m][0][j]); h1[j] = g1 * sigm(g1) * (r * acc[ai][1][m][1][j]);
                }
                st8bf(HE + (size_t)(row0 + ai * 128 + m * 16) * 256 + col0, h0, h1);
            }
        }
    }
};
struct EpiDown {
    static constexpr bool PERM = true, AFTER_DRAIN = false;
    const int* PTOK; const float* EW; bf16_t* YS;
    __device__ __forceinline__ void operator()(const pg8::f32x4 (&acc)[2][2][4][2], const pg8::Unit& u, int wr, int wc, int fr, int fq) const {
        const int row0 = u.pm * 256 + wr * 64 + fr, col0 = (u.pn & 3) * 256 + wc * 32 + 8 * fq;
#pragma unroll
        for (int ai = 0; ai < 2; ++ai) {
            int ts[4]; float w[4];
#pragma unroll
            for (int m = 0; m < 4; ++m) ts[m] = PTOK[row0 + ai * 128 + m * 16];
#pragma unroll
            for (int m = 0; m < 4; ++m) w[m] = EW[ts[m] < 0 ? 0 : ts[m]];
#pragma unroll
            for (int m = 0; m < 4; ++m) {
                const int t = ts[m];
                if (t >= 0) {
                    bf16_t* d = YS + ((size_t)(t & 1) * M + (size_t)(t >> 1)) * 1024 + col0;
#pragma unroll
                    for (int bj = 0; bj < 2; ++bj) st8bf(d + bj * 128, acc[ai][bj][m][0] * w[m], acc[ai][bj][m][1] * w[m]);
                }
            }
        }
    }
};
constexpr int LDS_TAB_OFF = 155648;
__device__ __forceinline__ void table_prefetch(LAS unsigned char* lds, const int* tab, const int* nunits, int G, int c, int tid) {
    LAS int* lt = (LAS int*)(lds + LDS_TAB_OFF);
    if (tid < 16) { const int idx = (tid >> 1) * G + c; const int n = __builtin_nontemporal_load(nunits); lt[tid] = idx < n ? tab[2 * idx + (tid & 1)] : -1; }
    __syncthreads();
}
struct TableOrder {
    static constexpr bool GATHER = false;
    const int* tab; const int* nunits; int G, c; const LAS int* lt;
    __device__ __forceinline__ int arow(int r) const { return r; }
    __device__ __forceinline__ bool next(int i, pg8::Unit& u) const {
        if (i < 8) { const int a = lt[2 * i]; if (a < 0) return false; u.pm = a; u.pn = lt[2 * i + 1]; return true; }
        const int idx = i * G + c; const int n = __builtin_nontemporal_load(nunits);
        if (idx >= n) return false;
        u.pm = tab[2 * idx]; u.pn = tab[2 * idx + 1]; return true;
    }
    __device__ __forceinline__ void a_ready(const pg8::Unit&) const {}
    __device__ __forceinline__ void done(const pg8::Unit&) const {}
};

struct TableGatherOrder {
    static constexpr bool GATHER = true;
    const int* tab; const int* nunits; const int* ptok; int G, c; const LAS int* lt;
    __device__ __forceinline__ bool next(int i, pg8::Unit& u) const {
        if (i < 8) { const int a = lt[2 * i]; if (a < 0) return false; u.pm = a; u.pn = lt[2 * i + 1]; return true; }
        const int idx = i * G + c; const int n = __builtin_nontemporal_load(nunits);
        if (idx >= n) return false;
        u.pm = tab[2 * idx]; u.pn = tab[2 * idx + 1]; return true;
    }
    __device__ __forceinline__ int arow(int r) const { const int ts = ptok[r]; return ts < 0 ? 0 : (ts >> 1); }
    __device__ __forceinline__ void a_ready(const pg8::Unit&) const {}
    __device__ __forceinline__ void done(const pg8::Unit&) const {}
};

__device__ __forceinline__ void tr_item(const float* src, int ld, int K, int NC, bf16_t* dst, LAS float* scr, int item, int lane) {
    const int nblk = NC / 32, kb = item / nblk, nb = item % nblk, k0 = 64 * kb, n0 = 32 * nb;
    f32x4 tv[8];
    const int tr = lane >> 3, tc = (lane & 7) * 4;
    if ((((size_t)src) & 15) == 0 && (ld & 3) == 0) {
#pragma unroll
        for (int i = 0; i < 8; ++i) tv[i] = *(const f32x4*)(src + (size_t)(k0 + 8 * i + tr) * ld + n0 + tc);
    } else {
#pragma unroll
        for (int i = 0; i < 8; ++i) { const float* q = src + (size_t)(k0 + 8 * i + tr) * ld + n0 + tc; tv[i] = (f32x4){q[0], q[1], q[2], q[3]}; }
    }
#pragma unroll
    for (int i = 0; i < 8; ++i) { LAS float* d = scr + (8 * i + tr) * 33 + tc; d[0] = tv[i].x; d[1] = tv[i].y; d[2] = tv[i].z; d[3] = tv[i].w; }
    LDS_WAIT();
    const int c = lane & 7;
#pragma unroll
    for (int j = 0; j < 4; ++j) { const int n = (lane >> 3) + 8 * j; const LAS float* s = scr + (8 * c) * 33 + n;
        u32x4 o; o.x = pk2(s[0 * 33], s[1 * 33]); o.y = pk2(s[2 * 33], s[3 * 33]); o.z = pk2(s[4 * 33], s[5 * 33]); o.w = pk2(s[6 * 33], s[7 * 33]);
        *(u32x4*)(dst + (size_t)(n0 + n) * K + k0 + 8 * c) = o; }
    LDS_WAIT();
}

__device__ __forceinline__ void prep_gateup(const P& p, LAS unsigned char* lds, int w_idx, int nw, int wave, int lane) {
    LAS float* scr = (LAS float*)(lds + wave * 16384);
    for (int it = w_idx; it < 8192; it += nw) {
        const int sub = it & 63, q = it >> 6, gu = q & 1, j = (q >> 1) & 1, e = q >> 2;
        const float* src = (gu ? p.w_up : p.w_gate) + (size_t)e * 262144 + 128 * j;
        tr_item(src, 256, 1024, 128, p.WguT + ((size_t)e * 512 + j * 256 + gu * 128) * 1024, scr, sub, lane);
    }
}

__device__ __forceinline__ void ph_prep(const P& p, LAS unsigned char* lds, const int wv) {
    const int tid = opaque_tid(wv), lane = tid & 63, wave = __builtin_amdgcn_readfirstlane(tid >> 6);
    LAS float* scr = (LAS float*)(lds + wave * 16384);
    const int gw = blockIdx.x * NWAVES + wave, NGW = gridDim.x * NWAVES;
    const int gt = blockIdx.x * NTHR + tid, NGT = gridDim.x * NTHR;
    {
        const int c0s[7] = {640, 512, 1152, 1224, 1736, 2248, 3272};
        const int ncs[7] = {512, 128, 64, 512, 512, 1024, 1024};
        const int r0s[7] = {1024, 1536, 1664, 1792, 2304, 2816, 3840};
#pragma unroll
        for (int s = 0; s < 7; ++s) {
            const int nit = 16 * (ncs[s] / 32);
            for (int it = gw; it < nit; it += NGW) tr_item(p.w_in + c0s[s], INC, 1024, ncs[s], p.WinT + (size_t)r0s[s] * 1024, scr, it, lane);
        }
    }
    for (int i = gt; i < 64 * 1024; i += NGT) { const int j = i >> 10, k = i & 1023; p.WinT[(size_t)(1728 + j) * 1024 + k] = j < 8 ? (bf16_t)f2bf(p.w_in[(size_t)k * INC + 1216 + j]) : (bf16_t)0; }
    for (int it = gw; it < 512; it += NGW) tr_item(p.w_out, 1024, 1024, 1024, p.WoutT, scr, it, lane);
    for (int it = gw; it < 256; it += NGW) tr_item(p.w_pb, 1024, 512, 1024, p.WpbT, scr, it, lane);
    for (int it = gw; it < 4096; it += NGW) { const int sub = it & 127, e = it >> 7; tr_item(p.w_down + (size_t)e * 262144, 1024, 256, 1024, p.WdT + (size_t)e * 262144, scr, sub, lane); }
    for (int it = gw; it < 1024; it += NGW) {
        const int h = it >> 7, kt = (it >> 2) & 31, rt = it & 3, i = lane & 31, hf = lane >> 5;
        const f32x4* ap = (const f32x4*)(p.w_in + (size_t)(kt * 32 + i) * INC + h * 64 + 32 * hf);
        const f32x4* bp = (const f32x4*)(p.w_uk + (size_t)((rt * 32 + i) * 8 + h) * 64 + 32 * hf);
        f32x4 av[8], bv[8];
#pragma unroll
        for (int j = 0; j < 8; ++j) { av[j] = ap[j]; bv[j] = bp[j]; }
        f32x16 acc;
#pragma unroll
        for (int j = 0; j < 16; ++j) acc[j] = 0.f;
#pragma unroll
        for (int j = 0; j < 8; ++j)
#pragma unroll
            for (int e = 0; e < 4; ++e) acc = __builtin_amdgcn_mfma_f32_32x32x2f32(av[j][e], bv[j][e], acc, 0, 0, 0);
#pragma unroll
        for (int g4 = 0; g4 < 4; ++g4) {
            constexpr float QS = 0.125f * 1.4426950409f;
            u32x2 w; w.x = pk2(QS * acc[4 * g4], QS * acc[4 * g4 + 1]); w.y = pk2(QS * acc[4 * g4 + 2], QS * acc[4 * g4 + 3]);
            *(u32x2*)(p.WinT + (size_t)(h * 128 + rt * 32 + i) * 1024 + kt * 32 + 8 * g4 + 4 * hf) = w;
        }
    }
    for (int it = gw; it < 1024; it += NGW) {
        const int h = it >> 7, nt = (it >> 2) & 31, rt = it & 3, i = lane & 31, hf = lane >> 5;
        const f32x4* ap = (const f32x4*)(p.w_uv + (size_t)((rt * 32 + i) * 8 + h) * 64 + 32 * hf);
        const float* bp = p.w_pa + (size_t)(h * 64 + 32 * hf) * 1024 + nt * 32 + i;
        f32x4 av[8]; float bv[32];
#pragma unroll
        for (int j = 0; j < 8; ++j) av[j] = ap[j];
#pragma unroll
        for (int j = 0; j < 32; ++j) bv[j] = bp[(size_t)j * 1024];
        f32x16 acc;
#pragma unroll
        for (int j = 0; j < 16; ++j) acc[j] = 0.f;
#pragma unroll
        for (int j = 0; j < 8; ++j)
#pragma unroll
            for (int e = 0; e < 4; ++e) acc = __builtin_amdgcn_mfma_f32_32x32x2f32(av[j][e], bv[4 * j + e], acc, 0, 0, 0);
#pragma unroll
        for (int g4 = 0; g4 < 4; ++g4) {
            u32x2 w; w.x = pk2(acc[4 * g4], acc[4 * g4 + 1]); w.y = pk2(acc[4 * g4 + 2], acc[4 * g4 + 3]);
            *(u32x2*)(p.WovT + (size_t)(nt * 32 + i) * 1024 + h * 128 + rt * 32 + 8 * g4 + 4 * hf) = w;
        }
    }
    for (int i = gt; i < 4 * 128 * 128; i += NGT) { const int jj = i & 127, ii = (i >> 7) & 127; p.WSB[i] = jj <= ii ? (bf16_t)f2bf(p.w_sp[i]) : (bf16_t)0; }
    for (int i = gt; i < 36 * 1024; i += NGT) { const int c = i >> 10, k = i & 1023; p.WrT[i] = c < 4 ? p.rg_w[k * 4 + c] : p.re_w[k * 32 + (c - 4)]; }
    for (int m4 = gw; m4 < M / 4; m4 += NGW) {
        f32x4 v[4][4]; float ss[4];
#pragma unroll
        for (int r = 0; r < 4; ++r) { const f32x4* xr = (const f32x4*)(p.x + (size_t)(4 * m4 + r) * D) + lane;
#pragma unroll
            for (int j = 0; j < 4; ++j) v[r][j] = xr[64 * j]; }
#pragma unroll
        for (int r = 0; r < 4; ++r) { ss[r] = 0.f;
#pragma unroll
            for (int j = 0; j < 4; ++j) ss[r] += (v[r][j].x * v[r][j].x + v[r][j].y * v[r][j].y) + (v[r][j].z * v[r][j].z + v[r][j].w * v[r][j].w); }
#pragma unroll
        for (int o = 1; o < 64; o <<= 1) {
#pragma unroll
            for (int r = 0; r < 4; ++r) ss[r] += __shfl_xor(ss[r], o);
        }
#pragma unroll
        for (int r = 0; r < 4; ++r) {
            const float rinv = 1.0f / sqrtf(ss[r] * (1.f / D) + EPS);
            unsigned long long* o8 = (unsigned long long*)(p.HB + (size_t)(4 * m4 + r) * D) + lane;
#pragma unroll
            for (int j = 0; j < 4; ++j) { const f32x4 g = ((const f32x4*)p.n1g)[lane + 64 * j]; const f32x4 o = v[r][j] * rinv * g;
                o8[64 * j] = (unsigned long long)pk2(o.x, o.y) | ((unsigned long long)pk2(o.z, o.w) << 32); }
        }
    }
}

__device__ __forceinline__ void ph_ckvnorm(const P& p, const int wv) {
    const int tid = opaque_tid(wv), lane = tid & 63, wave = tid >> 6;
    const int gw = blockIdx.x * NWAVES + wave, NGW = gridDim.x * NWAVES;
    const float g0 = p.kv_g[2 * lane], g1 = p.kv_g[2 * lane + 1];
    for (int m4 = gw; m4 < M / 4; m4 += NGW) {
        float2 v[4]; float ss[4];
#pragma unroll
        for (int r = 0; r < 4; ++r) v[r] = ((const float2*)(p.CKVR + (size_t)(4 * m4 + r) * 128))[lane];
#pragma unroll
        for (int r = 0; r < 4; ++r) ss[r] = v[r].x * v[r].x + v[r].y * v[r].y;
#pragma unroll
        for (int o = 1; o < 64; o <<= 1) {
#pragma unroll
            for (int r = 0; r < 4; ++r) ss[r] += __shfl_xor(ss[r], o);
        }
#pragma unroll
        for (int r = 0; r < 4; ++r) { const float rinv = 1.0f / sqrtf(ss[r] * (1.f / 128.f) + EPS);
            const float c0 = fminf(fmaxf(v[r].x * rinv * g0, -440.f), 440.f), c1 = fminf(fmaxf(v[r].y * rinv * g1, -440.f), 440.f);
            ((unsigned short*)((unsigned char*)p.CKVB + (size_t)(4 * m4 + r) * 128))[lane] = (unsigned short)__builtin_amdgcn_cvt_pk_fp8_f32(c0, c1, 0, false); }
    }
}

typedef int i32x8 __attribute__((ext_vector_type(8)));
__device__ __forceinline__ bf16x4 tr16(const LAS unsigned char* a) { return __builtin_amdgcn_ds_read_tr16_b64_v4i16((LAS bf16x4*)a); }
__device__ __forceinline__ unsigned att_f(unsigned row) { return ((row >> 1) & 3u) | ((((row >> 2) ^ (row >> 4)) & 1u) << 2); }
__device__ __forceinline__ float xmax16(float x) {
    auto a = __builtin_amdgcn_permlane16_swap(__float_as_uint(x), __float_as_uint(x), false, false);
    const float y = fmaxf(__uint_as_float(a[0]), __uint_as_float(a[1]));
    auto b = __builtin_amdgcn_permlane32_swap(__float_as_uint(y), __float_as_uint(y), false, false);
    return fmaxf(__uint_as_float(b[0]), __uint_as_float(b[1]));
}
__device__ __forceinline__ void ph_attn(const P& p, LAS unsigned char* lds, const int wv) {
    const int tid = opaque_tid(wv), lane = tid & 63, wave = __builtin_amdgcn_readfirstlane(tid >> 6);
    LAS unsigned char* buf = lds + wave * 16384;
    LAS unsigned char* selL = lds + 131072 + wave * 3072;
    LAS unsigned char* selT = selL + 1024;
    LAS unsigned char* bias = lds + 155648;
    for (int i = tid; i < 1024; i += NTHR) {
        const int d = i >> 3; int bk = d;
        if (d >= 16) { const float nf = (float)d; bk = 16 + (int)(logf(nf / 16.f) / 2.0794415f * 16.f); if (bk > 31) bk = 31; }
        ((LAS float*)bias)[i] = 1.4426950409f * p.rel_bias[bk * 8 + (i & 7)];
    }
    __syncthreads();
    const int g = lane >> 4, hcol = lane & 15, r8 = lane >> 3, pc = lane & 7;
    const int G = gridDim.x, bx = blockIdx.x, vcu = (G % 8 == 0) ? (bx % 8) * (G / 8) + bx / 8 : bx;
    const unsigned so0 = 16u * ((unsigned)pc ^ att_f((unsigned)r8)), so1 = so0 ^ 64u;
    unsigned qka[2][2], tra[8];
#pragma unroll
    for (int tau = 0; tau < 2; ++tau)
#pragma unroll
        for (int r = 0; r < 2; ++r) { const unsigned row = hcol + 16 * tau; qka[tau][r] = (unsigned)(size_t)buf + row * 128u + 16u * ((2u * g + r) ^ att_f(row)); }
    {   const unsigned q = (lane & 15) >> 1, row = q < 4 ? 4 * g + q : 16 + 4 * g + (q - 4);
#pragma unroll
        for (int rt = 0; rt < 8; ++rt) tra[rt] = (unsigned)(size_t)buf + row * 128u + 16u * ((unsigned)rt ^ att_f(row)) + 8u * (lane & 1);
    }
    const unsigned biasl = (unsigned)(size_t)bias + 4u * (hcol & 7);
    const long ones8 = 0x3838383838383838L;
#define ATT_Q_LOAD(dh, dl, mm) do { const i32x8 z = {0, 0, 0, 0, 0, 0, 0, 0}; \
        const unsigned char* qp = (const unsigned char*)p.QL + (size_t)(mm) * 2048 + (hcol & 7) * 256 + 32 * g; \
        dh = hcol < 8 ? *(const i32x8*)qp : z; dl = hcol < 8 ? *(const i32x8*)(qp + 128) : z; } while (0)
#define ATT_DMA_CHUNK(img_, selt_, c_) do { const u32x4 k4 = *(const LAS u32x4*)((selt_) + 128 * (c_) + 16 * r8);        \
        __builtin_amdgcn_global_load_lds((const unsigned*)(ckb + (k4.x + so0)), (LAS unsigned*)(img_), 16, 0, 0); \
        __builtin_amdgcn_global_load_lds((const unsigned*)(ckb + (k4.y + so0)), (LAS unsigned*)((img_) + 1024), 16, 0, 0); \
        __builtin_amdgcn_global_load_lds((const unsigned*)(ckb + (k4.z + so1)), (LAS unsigned*)((img_) + 2048), 16, 0, 0); \
        __builtin_amdgcn_global_load_lds((const unsigned*)(ckb + (k4.w + so1)), (LAS unsigned*)((img_) + 3072), 16, 0, 0); } while (0)
#define ATT_SEL_WRITE(par_, sv_, tq_) do { \
        const int k0 = (int)((sv_).x & 0xffffu), k1 = (int)((sv_).x >> 16), k2 = (int)((sv_).y & 0xffffu), k3 = (int)((sv_).y >> 16); \
        const int d0 = min((tq_) - k0, 127), d1 = min((tq_) - k1, 127), d2 = min((tq_) - k2, 127), d3 = min((tq_) - k3, 127); \
        u32x2 dw; dw.x = (unsigned)(d0 * 32) | ((unsigned)(d1 * 32) << 16); dw.y = (unsigned)(d2 * 32) | ((unsigned)(d3 * 32) << 16); \
        *(LAS u32x2*)(selL + (par_) * 512 + lane * 8) = dw; \
        LAS unsigned* tq = (LAS unsigned*)(selT + (par_) * 1024) + (lane >> 3) * 32 + (4 * (lane & 1)) * 4 + ((lane & 7) >> 1); \
        tq[0] = (unsigned)k0 * 128u; tq[4] = (unsigned)k1 * 128u; tq[8] = (unsigned)k2 * 128u; tq[12] = (unsigned)k3 * 128u; } while (0)
    for (int qc = vcu; qc < M / 128; qc += G) {
        const int m0 = qc * 128 + wave * 16;
        const size_t mb = (size_t)(m0 >> 12) * T;
        const unsigned char* ckb = (const unsigned char*)p.CKVB + mb * 128;
        u32x2 sv = *(const u32x2*)(p.SEL + (size_t)m0 * 256 + 4 * lane);
        i32x8 qh, ql, qhn, qln;
        ATT_Q_LOAD(qhn, qln, m0);
        ATT_SEL_WRITE(0, sv, m0 & (T - 1));
        LDS_WAIT();
        ATT_DMA_CHUNK(buf, selT, 0);
        ATT_DMA_CHUNK(buf + 4096, selT, 1);
        ATT_DMA_CHUNK(buf + 8192, selT, 2);
        sv = *(const u32x2*)(p.SEL + (size_t)(m0 + 1) * 256 + 4 * lane);
        f32x4 o[8], ls; float mref = -1e30f;
#pragma unroll
        for (int rt = 0; rt < 8; ++rt) o[rt] = (f32x4){0.f, 0.f, 0.f, 0.f};
        ls = (f32x4){0.f, 0.f, 0.f, 0.f};
#define ATT_BODY(c_) do { \
            const int m = m0 + qi, t = m & (T - 1); \
            const LAS unsigned char* selc = selL + (qi & 1) * 512; \
            if ((c_) < 5) { ATT_DMA_CHUNK(buf + (((c_) + 3) & 3) * 4096, selT + (qi & 1) * 1024, (c_) + 3); \
                __builtin_amdgcn_sched_barrier(0); asm volatile("s_waitcnt vmcnt(12)" ::: "memory"); } \
            else if (qi < 15) { ATT_DMA_CHUNK(buf + (((c_) + 3) & 3) * 4096, selT + ((qi + 1) & 1) * 1024, (c_) - 5); \
                __builtin_amdgcn_sched_barrier(0); asm volatile("s_waitcnt vmcnt(12)" ::: "memory"); } \
            else { __builtin_amdgcn_sched_barrier(0); asm volatile("s_waitcnt vmcnt(0)" ::: "memory"); } \
            __builtin_amdgcn_sched_barrier(0); \
            if ((c_) == 0) { qh = qhn; ql = qln; if (qi < 15) ATT_Q_LOAD(qhn, qln, m + 1); } \
            if ((c_) == 3 && qi < 15) { \
                ATT_SEL_WRITE((qi + 1) & 1, sv, (m + 1) & (T - 1)); \
                if (qi < 14) sv = *(const u32x2*)(p.SEL + (size_t)(m + 2) * 256 + 4 * lane); \
            } \
              \
            i32x8 af[2]; u32x2 kk[2]; \
            _Pragma("unroll") for (int tau = 0; tau < 2; ++tau) { kk[tau] = *(const LAS u32x2*)(selc + 2 * (32 * (c_) + 16 * tau + 4 * g)); \
                const u32x4 a0 = *(const LAS u32x4*)(size_t)(qka[tau][0] + ((c_) & 3) * 4096), a1 = *(const LAS u32x4*)(size_t)(qka[tau][1] + ((c_) & 3) * 4096); \
                af[tau] = (i32x8){(int)a0.x, (int)a0.y, (int)a0.z, (int)a0.w, (int)a1.x, (int)a1.y, (int)a1.z, (int)a1.w}; } \
            float bv[2][4]; \
            _Pragma("unroll") for (int tau = 0; tau < 2; ++tau) { \
                bv[tau][0] = *(const LAS float*)(size_t)(biasl + (kk[tau].x & 0xffffu)); bv[tau][1] = *(const LAS float*)(size_t)(biasl + (kk[tau].x >> 16)); \
                bv[tau][2] = *(const LAS float*)(size_t)(biasl + (kk[tau].y & 0xffffu)); bv[tau][3] = *(const LAS float*)(size_t)(biasl + (kk[tau].y >> 16)); } \
            __builtin_amdgcn_sched_barrier(0); \
            f32x4 acc[2]; \
            _Pragma("unroll") for (int tau = 0; tau < 2; ++tau) { \
                acc[tau] = __builtin_amdgcn_mfma_scale_f32_16x16x128_f8f6f4(af[tau], qh, (f32x4){0.f, 0.f, 0.f, 0.f}, 0, 0, 0, 0, 0, 0); \
                acc[tau] = __builtin_amdgcn_mfma_scale_f32_16x16x128_f8f6f4(af[tau], ql, acc[tau], 0, 0, 0, 0, 0, 0); \
            } \
              \
            long ta[8]; \
            _Pragma("unroll") for (int rt = 0; rt < 8; ++rt) { \
                if (((c_) & 3) == 0) asm volatile("ds_read_b64_tr_b8 %0, %1" : "=v"(ta[rt]) : "v"(tra[rt])); \
                else if (((c_) & 3) == 1) asm volatile("ds_read_b64_tr_b8 %0, %1 offset:4096" : "=v"(ta[rt]) : "v"(tra[rt])); \
                else if (((c_) & 3) == 2) asm volatile("ds_read_b64_tr_b8 %0, %1 offset:8192" : "=v"(ta[rt]) : "v"(tra[rt])); \
                else asm volatile("ds_read_b64_tr_b8 %0, %1 offset:12288" : "=v"(ta[rt]) : "v"(tra[rt])); \
            } \
            __builtin_amdgcn_sched_barrier(0); \
            float sc[2][4]; \
            _Pragma("unroll") for (int tau = 0; tau < 2; ++tau) _Pragma("unroll") for (int r = 0; r < 4; ++r) sc[tau][r] = fmaf(acc[tau][r], 0.0625f, bv[tau][r]); \
            if (t < 255) {                                           \
                _Pragma("unroll") for (int tau = 0; tau < 2; ++tau) _Pragma("unroll") for (int r = 0; r < 4; ++r) if (32 * (c_) + 16 * tau + 4 * g + r > t) sc[tau][r] = -1e30f; \
            } \
            const float mx = xmax16(fmaxf(fmaxf(fmaxf(sc[0][0], sc[0][1]), fmaxf(sc[0][2], sc[0][3])), fmaxf(fmaxf(sc[1][0], sc[1][1]), fmaxf(sc[1][2], sc[1][3])))); \
            if ((c_) == 0) mref = mx; \
            else if (__builtin_amdgcn_ballot_w64(mx > mref + 3.0f) != 0) {                         \
                const float mn = fmaxf(mref, mx), rs = __builtin_amdgcn_exp2f(mref - mn); mref = mn; \
                _Pragma("unroll") for (int rt = 0; rt < 8; ++rt) o[rt] *= rs; \
                ls *= rs; \
            } \
            const float mo = mref - 5.0f; \
            float pr[2][4]; \
            _Pragma("unroll") for (int tau = 0; tau < 2; ++tau) _Pragma("unroll") for (int r = 0; r < 4; ++r) pr[tau][r] = __builtin_amdgcn_exp2f(sc[tau][r] - mo); \
            u32x2 pw; \
            pw.x = (unsigned)__builtin_amdgcn_cvt_pk_fp8_f32(pr[0][0], pr[0][1], 0, false); pw.x = (unsigned)__builtin_amdgcn_cvt_pk_fp8_f32(pr[0][2], pr[0][3], (int)pw.x, true); \
            pw.y = (unsigned)__builtin_amdgcn_cvt_pk_fp8_f32(pr[1][0], pr[1][1], 0, false); pw.y = (unsigned)__builtin_amdgcn_cvt_pk_fp8_f32(pr[1][2], pr[1][3], (int)pw.y, true); \
            const long pf = __builtin_bit_cast(long, pw); \
            asm volatile("s_waitcnt lgkmcnt(0)" : "+v"(ta[0]), "+v"(ta[1]), "+v"(ta[2]), "+v"(ta[3]), "+v"(ta[4]), "+v"(ta[5]), "+v"(ta[6]), "+v"(ta[7])); \
            _Pragma("unroll") for (int rt = 0; rt < 8; ++rt) o[rt] = __builtin_amdgcn_mfma_f32_16x16x32_fp8_fp8(ta[rt], pf, o[rt], 0, 0, 0); \
            ls = __builtin_amdgcn_mfma_f32_16x16x32_fp8_fp8(ones8, pf, ls, 0, 0, 0); \
            if ((c_) == 7) { \
                const float inv = __builtin_amdgcn_rcpf(ls[0]); \
                if (hcol < 8) { \
                    _Pragma("unroll") for (int rt = 0; rt < 8; ++rt) { \
                        u32x2 w; w.x = pg8::cvt_pk_bf16(o[rt][0] * inv, o[rt][1] * inv); w.y = pg8::cvt_pk_bf16(o[rt][2] * inv, o[rt][3] * inv); \
                        *(u32x2*)(p.OL + (size_t)m * 1024 + hcol * 128 + 16 * rt + 4 * g) = w; \
                    } \
                } \
                _Pragma("unroll") for (int rt = 0; rt < 8; ++rt) o[rt] = (f32x4){0.f, 0.f, 0.f, 0.f}; \
                ls = (f32x4){0.f, 0.f, 0.f, 0.f}; \
            } } while (0)
#pragma unroll 1
        for (int qi = 0; qi < 16; ++qi) {
            ATT_BODY(0); ATT_BODY(1); ATT_BODY(2); ATT_BODY(3); ATT_BODY(4); ATT_BODY(5); ATT_BODY(6); ATT_BODY(7);
        }
#undef ATT_BODY
        asm volatile("s_waitcnt vmcnt(0)" ::: "memory");
    }
#undef ATT_DMA_CHUNK
#undef ATT_SEL_WRITE
#undef ATT_Q_LOAD
}

__device__ __forceinline__ unsigned q16of(float x) { return (unsigned)(int)__builtin_fminf(__builtin_fmaxf((x + 8.0f) * 4096.0f, 0.0f), 65535.0f); }

__device__ __forceinline__ void select_row7(const LAS unsigned short* row, int n, LAS unsigned* hist, LAS unsigned* h2, unsigned short* out, int lane) {
    if (n <= 256) {
#pragma unroll
        for (int i = 0; i < 4; ++i) { const int k = lane + 64 * i; out[k] = (unsigned short)(k < n ? k : 0); }
#pragma unroll
        for (int i = 0; i < 8; ++i) hist[lane + 64 * i] = 0u;
        return;
    }
    const unsigned long long lt = (1ull << lane) - 1ull;
    unsigned b1, above;
    {
        const u32x4 w0 = *(const LAS u32x4*)(hist + 8 * lane), w1 = *(const LAS u32x4*)(hist + 8 * lane + 4);
        unsigned c[16];
        c[0] = w0.x & 0xffffu; c[1] = w0.x >> 16; c[2] = w0.y & 0xffffu; c[3] = w0.y >> 16; c[4] = w0.z & 0xffffu; c[5] = w0.z >> 16; c[6] = w0.w & 0xffffu; c[7] = w0.w >> 16;
        c[8] = w1.x & 0xffffu; c[9] = w1.x >> 16; c[10] = w1.y & 0xffffu; c[11] = w1.y >> 16; c[12] = w1.z & 0xffffu; c[13] = w1.z >> 16; c[14] = w1.w & 0xffffu; c[15] = w1.w >> 16;
        unsigned s = 0;
#pragma unroll
        for (int j = 0; j < 16; ++j) s += c[j];
        unsigned incl = s;
#pragma unroll
        for (int o = 1; o < 64; o <<= 1) { const unsigned t = __shfl_down(incl, o); if (lane + o < 64) incl += t; }
        const unsigned excl = incl - s;
        const bool mine = (excl < 256u) && (incl >= 256u);
        unsigned bin = 0, ab = 0, run = excl; bool found = false;
#pragma unroll
        for (int j = 15; j >= 0; --j) { if (!found && run + c[j] >= 256u) { bin = 16 * lane + j; ab = run; found = true; } if (!found) run += c[j]; }
        const unsigned long long bm = __ballot(mine);
        const int src = bm ? (int)__builtin_ctzll(bm) : 0;
        b1 = __shfl(bin, src); above = __shfl(ab, src);
    }
    LDS_WAIT();
    int need = 256 - (int)above;
    LAS unsigned short* cand = (LAS unsigned short*)hist;
    const int nblk = (n + 255) >> 8;
    const unsigned thr = b1 << 6;
    int C = 0;
    u32x2 vn = *(const LAS u32x2*)(row + 4 * lane);
    for (int blk = 0; blk < nblk; ++blk) {
        const u32x2 v = vn;
        if (blk + 1 < nblk) vn = *(const LAS u32x2*)(row + (blk + 1) * 256 + 4 * lane);
        const unsigned q[4] = {v.x & 0xffffu, v.x >> 16, v.y & 0xffffu, v.y >> 16};
        bool ge[4]; unsigned long long bl[4];
#pragma unroll
        for (int e = 0; e < 4; ++e) { ge[e] = (blk * 256 + 4 * lane + e < n) && (q[e] >= thr); bl[e] = __ballot(ge[e]); }
        const int below = __builtin_popcountll(bl[0] & lt) + __builtin_popcountll(bl[1] & lt) + __builtin_popcountll(bl[2] & lt) + __builtin_popcountll(bl[3] & lt);
        int pos = C + below;
#pragma unroll
        for (int e = 0; e < 4; ++e) { if (ge[e]) { if (pos < 768) cand[pos] = (unsigned short)(blk * 256 + 4 * lane + e); ++pos; } }
        C += __builtin_popcountll(bl[0]) + __builtin_popcountll(bl[1]) + __builtin_popcountll(bl[2]) + __builtin_popcountll(bl[3]);
    }
    LDS_WAIT();
    LAS unsigned short* outL = cand + 768;
    if (C <= 512) {
        int ci[8]; unsigned cq[8]; bool ceq[8];
#pragma unroll
        for (int k = 0; k < 8; ++k) { const int j = lane + 64 * k; ci[k] = j < C ? (int)cand[j] : -1; }
#pragma unroll
        for (int k = 0; k < 8; ++k) { cq[k] = ci[k] >= 0 ? (unsigned)row[ci[k]] : 0u; ceq[k] = ci[k] >= 0 && (cq[k] >> 6) == b1; }
        h2[lane] = 0u;
        LDS_WAIT();
#pragma unroll
        for (int k = 0; k < 8; ++k) if (ceq[k]) __hip_atomic_fetch_add(h2 + (cq[k] & 63u), 1u, __ATOMIC_RELAXED, __HIP_MEMORY_SCOPE_WORKGROUP);
        LDS_WAIT();
        const unsigned cme = h2[lane];
        unsigned incl = cme;
#pragma unroll
        for (int o = 1; o < 64; o <<= 1) { const unsigned t = __shfl_down(incl, o); if (lane + o < 64) incl += t; }
        const unsigned excl = incl - cme;
        const bool mine = (excl < (unsigned)need) && (incl >= (unsigned)need);
        const unsigned long long bm = __ballot(mine);
        const int src = bm ? (int)__builtin_ctzll(bm) : 0;
        const unsigned Tl = (unsigned)src;
        need -= (int)__shfl(excl, src);
        const unsigned Tq = (b1 << 6) | Tl;
        int eq_seen = 0, cnt = 0;
#pragma unroll
        for (int k = 0; k < 8; ++k) {
            const bool valid = ci[k] >= 0, eqk = valid && cq[k] == Tq;
            const unsigned long long beq = __ballot(eqk);
            const int eq_rank = eq_seen + __builtin_popcountll(beq & lt);
            const bool take = valid && (cq[k] > Tq || (eqk && eq_rank < need));
            const unsigned long long bt = __ballot(take);
            const int pos = cnt + __builtin_popcountll(bt & lt);
            if (take && pos < 256) outL[pos] = (unsigned short)ci[k];
            cnt += __builtin_popcountll(bt); eq_seen += __builtin_popcountll(beq);
        }
    } else {
        unsigned lo = 0u, hi = 65535u;
        while (lo < hi) {
            const unsigned mid = (lo + hi + 1u) >> 1;
            int cge = 0;
            for (int i = lane; i < n; i += 64) cge += ((unsigned)row[i] >= mid) ? 1 : 0;
#pragma unroll
            for (int o = 1; o < 64; o <<= 1) cge += __shfl_xor(cge, o);
            if (cge >= 256) lo = mid; else hi = mid - 1u;
        }
        const unsigned Tq = lo;
        int cgt = 0;
        for (int i = lane; i < n; i += 64) cgt += ((unsigned)row[i] > Tq) ? 1 : 0;
#pragma unroll
        for (int o = 1; o < 64; o <<= 1) cgt += __shfl_xor(cgt, o);
        const int needq = 256 - cgt;
        int cnt = 0, eq_seen = 0;
        for (int i0 = 0; i0 < n; i0 += 64) {
            const int i = i0 + lane; const bool valid = i < n;
            const unsigned qv = valid ? (unsigned)row[i] : 0u;
            const bool eqk = valid && qv == Tq;
            const unsigned long long beq = __ballot(eqk);
            const int eq_rank = eq_seen + __builtin_popcountll(beq & lt);
            const bool take = valid && (qv > Tq || (eqk && eq_rank < needq));
            const unsigned long long bt = __ballot(take);
            const int pos = cnt + __builtin_popcountll(bt & lt);
            if (take && pos < 256) outL[pos] = (unsigned short)i;
            cnt += __builtin_popcountll(bt); eq_seen += __builtin_popcountll(beq);
        }
    }
    LDS_WAIT();
    *(u32x2*)(out + 4 * lane) = *(const LAS u32x2*)(outL + 4 * lane);
    LDS_WAIT();
#pragma unroll
    for (int i = 0; i < 8; ++i) hist[lane + 64 * i] = 0u;
}

template <int STRIP> __device__ __forceinline__ void ph_index7_t(const P& p, LAS unsigned char* lds, const int wv) {
    LAS unsigned short* Irow = (LAS unsigned short*)lds;
    LAS unsigned* hist = (LAS unsigned*)(lds + 65536);
    LAS unsigned* h2 = (LAS unsigned*)(lds + 81920);
    const int tid = opaque_tid(wv), lane = tid & 63, wave = __builtin_amdgcn_readfirstlane(tid >> 6);
    LAS unsigned char* KSw = lds + 92160 + wave * 8192;
    const int hh = lane >> 5, n = lane & 31;
    const int rho = lane & 31, qlA = 2 * ((rho >> 2) & 1) + (rho >> 4), hdA = (rho & 3) + 4 * ((rho >> 3) & 1);
    const int srow = lane >> 3, sch = lane & 7;
#pragma unroll
    for (int i = 0; i < 8; ++i) hist[tid + NTHR * i] = 0u;
    bf16x8 A[2][4]; float wq[2][16]; u32x4 RA[4], RB[4];
#define IDX7_LOAD(R_, mb_, kt_) do { const bf16_t* kp_ = p.KI + ((mb_) + (size_t)(kt_) * 32 + srow) * 64 + sch * 8; \
        _Pragma("unroll") for (int i = 0; i < 4; ++i) R_[i] = *(const u32x4*)(kp_ + (size_t)i * 8 * 64); } while (0)
#define IDX7_LOAD_UNIT(u_) do { const int b_ = (u_) & 7, t0_ = (511 - ((u_) >> 3)) * 8; const size_t mb_ = (size_t)b_ * T; const int nkt_ = (t0_ + 8 + 31) >> 5; \
        _Pragma("unroll") for (int mt = 0; mt < 2; ++mt) { const bf16_t* src = p.QI + (mb_ + t0_ + mt * 4 + qlA) * 512 + hdA * 64 + 8 * hh; \
            _Pragma("unroll") for (int s = 0; s < 4; ++s) A[mt][s] = *(const bf16x8*)(src + 16 * s); \
            _Pragma("unroll") for (int c = 0; c < 2; ++c) { const float* wp = p.WI + (mb_ + t0_ + mt * 4 + 2 * hh + c) * 8; const f32x4 w0 = *(const f32x4*)wp, w1 = *(const f32x4*)(wp + 4); \
                _Pragma("unroll") for (int j = 0; j < 4; ++j) { wq[mt][c * 8 + j] = w0[j]; wq[mt][c * 8 + 4 + j] = w1[j]; } } } \
        if (wave < nkt_) IDX7_LOAD(RA, mb_, wave); if (wave + NWAVES < nkt_) IDX7_LOAD(RB, mb_, wave + NWAVES); } while (0)
    if ((int)blockIdx.x < 4096) IDX7_LOAD_UNIT((int)blockIdx.x);
    __syncthreads();
    for (int u = blockIdx.x; u < 4096; u += gridDim.x) {
        const int b = u & 7, tb = 511 - (u >> 3), t0 = tb * 8; const size_t mb = (size_t)b * T;
        const int nkt = (t0 + 8 + 31) >> 5;
#pragma unroll
        for (int mt = 0; mt < 2; ++mt) {
#pragma unroll
            for (int s = 0; s < 4; ++s) asm volatile("" :: "v"(A[mt][s]));
#pragma unroll
            for (int j = 0; j < 16; ++j) asm volatile("" :: "v"(wq[mt][j]));
        }
#define IDX7_BODY(kt_, R_, bf_) do { const int kt = (kt_); if (kt < nkt) { \
            LAS unsigned char* img = KSw + (bf_) * 4096; \
            _Pragma("unroll") for (int i = 0; i < 4; ++i) { const int row = 8 * i + srow; *(LAS u32x4*)(img + row * 128 + 16 * (sch ^ (row & 7))) = R_[i]; } \
            if (kt + 2 * NWAVES < nkt) IDX7_LOAD(R_, mb, kt + 2 * NWAVES); \
            bf16x8 Bf[4]; \
            _Pragma("unroll") for (int s = 0; s < 4; ++s) Bf[s] = *(const LAS bf16x8*)(img + n * 128 + 16 * ((2 * s + hh) ^ (n & 7))); \
            const int key = kt * 32 + n; \
            _Pragma("unroll") for (int mt = 0; mt < 2; ++mt) { \
                f32x16 acc; \
                _Pragma("unroll") for (int j = 0; j < 16; ++j) acc[j] = 0.f; \
                _Pragma("unroll") for (int s = 0; s < 4; ++s) acc = __builtin_amdgcn_mfma_f32_32x32x16_bf16(A[mt][s], Bf[s], acc, 0, 0, 0); \
                _Pragma("unroll") for (int c = 0; c < 2; ++c) { \
                    float v = 0.f; \
                    _Pragma("unroll") for (int h = 0; h < 8; ++h) { const float af = acc[c * 8 + h]; const int ai = __float_as_int(af); v = __builtin_fmaf(wq[mt][c * 8 + h], __int_as_float(ai > 0 ? ai : 0), v); } \
                    const int r = mt * 4 + 2 * hh + c; const unsigned q = q16of(v); \
                    Irow[r * 4096 + key] = (unsigned short)q; \
                    if (key <= t0 + r) { const unsigned bin = q >> 6; __hip_atomic_fetch_add(hist + r * 512 + (bin >> 1), 1u << ((bin & 1u) * 16u), __ATOMIC_RELAXED, __HIP_MEMORY_SCOPE_WORKGROUP); } \
                } \
            } } } while (0)
#pragma unroll 1
        for (int k0 = wave; k0 < nkt; k0 += 2 * NWAVES) {
            IDX7_BODY(k0, RA, 0);
            IDX7_BODY(k0 + NWAVES, RB, 1);
        }
#undef IDX7_BODY
        if (u + (int)gridDim.x < 4096) IDX7_LOAD_UNIT(u + (int)gridDim.x);
        LDS_WAIT(); __builtin_amdgcn_s_barrier();
        if (STRIP != 1) select_row7(Irow + wave * 4096, t0 + wave + 1, hist + wave * 512, h2 + wave * 320, p.SEL + (mb + t0 + wave) * 256, lane);
        else { _Pragma("unroll") for (int i = 0; i < 8; ++i) hist[wave * 512 + lane + 64 * i] = 0u; }
        LDS_WAIT(); __builtin_amdgcn_s_barrier();
    }
#undef IDX7_LOAD
#undef IDX7_LOAD_UNIT
}

__device__ __forceinline__ void ph_index7(const P& p, LAS unsigned char* lds, const int wv) { ph_index7_t<0>(p, lds, wv); }

__device__ __forceinline__ void ph_gmlp(const P& p, LAS unsigned char* lds, const int wv) {
    const int tid = opaque_tid(wv), lane = tid & 63, wave = __builtin_amdgcn_readfirstlane(tid >> 6);
    LAS unsigned char* vt = lds;
    LAS float* st = (LAS float*)(lds + 32768);
    const int g4 = lane >> 4, q4 = (lane & 15) >> 2, p4 = lane & 3, ic = lane & 15;
    for (int u = blockIdx.x; u < 256; u += gridDim.x) {
        const size_t m0 = (size_t)u * 128;
#pragma unroll 1
        for (int r4 = 0; r4 < 4; ++r4) {
            float x[4][8], sm[4];
#pragma unroll
            for (int r = 0; r < 4; ++r) { const u32x4 w = *(const u32x4*)(p.VB + (m0 + 16 * wave + 4 * r4 + r) * 512 + lane * 8);
                x[r][0] = bflo(w.x); x[r][1] = bfhi(w.x); x[r][2] = bflo(w.y); x[r][3] = bfhi(w.y); x[r][4] = bflo(w.z); x[r][5] = bfhi(w.z); x[r][6] = bflo(w.w); x[r][7] = bfhi(w.w); }
#pragma unroll
            for (int r = 0; r < 4; ++r) sm[r] = ((x[r][0] + x[r][1]) + (x[r][2] + x[r][3])) + ((x[r][4] + x[r][5]) + (x[r][6] + x[r][7]));
#pragma unroll
            for (int o = 1; o < 64; o <<= 1) {
#pragma unroll
                for (int r = 0; r < 4; ++r) sm[r] += __shfl_xor(sm[r], o);
            }
            float vr[4];
#pragma unroll
            for (int r = 0; r < 4; ++r) { const float mean = sm[r] * (1.f / 512.f); sm[r] = mean; float a = 0.f;
#pragma unroll
                for (int j = 0; j < 8; ++j) { const float d = x[r][j] - mean; a += d * d; }
                vr[r] = a; }
#pragma unroll
            for (int o = 1; o < 64; o <<= 1) {
#pragma unroll
                for (int r = 0; r < 4; ++r) vr[r] += __shfl_xor(vr[r], o);
            }
            if (lane == 0) {
#pragma unroll
                for (int r = 0; r < 4; ++r) { const int row = 16 * wave + 4 * r4 + r; st[2 * row] = sm[r]; st[2 * row + 1] = 1.0f / sqrtf(vr[r] * (1.f / 512.f) + EPS); }
            }
        }
        __syncthreads();
#pragma unroll 1
        for (int g = 0; g < 4; ++g) {
#pragma unroll
            for (int i = 0; i < 4; ++i) {
                const int piece = i * NTHR + tid, row = piece >> 4, ch = piece & 15;
                const u32x4 w = *(const u32x4*)(p.VB + (m0 + row) * 512 + g * 128 + ch * 8);
                const float mean = st[2 * row], rstd = st[2 * row + 1];
                const f32x4 ga = *(const f32x4*)(p.ln_g + g * 128 + ch * 8), gb = *(const f32x4*)(p.ln_g + g * 128 + ch * 8 + 4);
                const f32x4 ba = *(const f32x4*)(p.ln_b + g * 128 + ch * 8), bb = *(const f32x4*)(p.ln_b + g * 128 + ch * 8 + 4);
                u32x4 o;
                o.x = pk2((bflo(w.x) - mean) * rstd * ga[0] + ba[0], (bfhi(w.x) - mean) * rstd * ga[1] + ba[1]);
                o.y = pk2((bflo(w.y) - mean) * rstd * ga[2] + ba[2], (bfhi(w.y) - mean) * rstd * ga[3] + ba[3]);
                o.z = pk2((bflo(w.z) - mean) * rstd * gb[0] + bb[0], (bfhi(w.z) - mean) * rstd * gb[1] + bb[1]);
                o.w = pk2((bflo(w.w) - mean) * rstd * gb[2] + bb[2], (bfhi(w.w) - mean) * rstd * gb[3] + bb[3]);
                *(LAS u32x4*)(vt + off_b(row, ch)) = o;
            }
            const size_t orow = (m0 + 16 * wave + ic) * 512 + g * 128 + 4 * g4;
            u32x2 uv[8];
#pragma unroll
            for (int et = 0; et < 8; ++et) uv[et] = *(const u32x2*)(p.UB + orow + 16 * et);
            const float bs = p.b_sp[g * 128 + 16 * wave + ic];
            const int nks = ((16 * wave + 15) >> 5) + 1;
            bf16x8 wb[4];
#pragma unroll
            for (int ks = 0; ks < 4; ++ks) wb[ks] = *(const bf16x8*)(p.WSB + ((size_t)g * 128 + 16 * wave + ic) * 128 + 32 * ks + 8 * g4);
            __syncthreads();
            f32x4 acc[8];
#pragma unroll
            for (int et = 0; et < 8; ++et) acc[et] = (f32x4){0.f, 0.f, 0.f, 0.f};
#pragma unroll
            for (int ks = 0; ks < 4; ++ks) {
                if (ks < nks) {
                    bf16x4 ta[8][2];
#pragma unroll
                    for (int et = 0; et < 8; ++et) {
                        const unsigned r0 = 32 * ks + 8 * g4 + q4, ch = 2 * et + (p4 >> 1);
                        ta[et][0] = tr16(vt + off_b(r0, ch) + 8 * (p4 & 1)); ta[et][1] = tr16(vt + off_b(r0 + 4, ch) + 8 * (p4 & 1));
                    }
#pragma unroll
                    for (int et = 0; et < 8; ++et) acc[et] = __builtin_amdgcn_mfma_f32_16x16x32_bf16(cat4(ta[et][0], ta[et][1]), wb[ks], acc[et], 0, 0, 0);
                }
            }
#pragma unroll
            for (int et = 0; et < 8; ++et) {
                u32x2 w;
                w.x = pk2(bflo(uv[et].x) * (acc[et][0] + bs), bfhi(uv[et].x) * (acc[et][1] + bs));
                w.y = pk2(bflo(uv[et].y) * (acc[et][2] + bs), bfhi(uv[et].y) * (acc[et][3] + bs));
                *(u32x2*)(p.US + orow + 16 * et) = w;
            }
            __syncthreads();
        }
    }
}

__device__ __forceinline__ void split2(float a, float b, unsigned& h, unsigned& l) {
    const unsigned ha = f2bf(a), hb = f2bf(b);
    h = ha | (hb << 16); l = pk2(a - __uint_as_float(ha << 16), b - __uint_as_float(hb << 16));
}
__device__ __forceinline__ void split_bf16(const f32x4 a, const f32x4 b, bf16x8& hi, bf16x8& lo) {
    unsigned h0, h1, h2, h3, l0, l1, l2, l3;
    split2(a.x, a.y, h0, l0); split2(a.z, a.w, h1, l1); split2(b.x, b.y, h2, l2); split2(b.z, b.w, h3, l3);
    const u32x4 h = {h0, h1, h2, h3}, l = {l0, l1, l2, l3};
    hi = __builtin_bit_cast(bf16x8, h); lo = __builtin_bit_cast(bf16x8, l);
}
template <int STRIP> __device__ __forceinline__ void ph_router_t(const P& p, LAS unsigned char* lds, const int wv) {
    const int tid = opaque_tid(wv), lane = tid & 63, wave = __builtin_amdgcn_readfirstlane(tid >> 6);
    LAS float* LG = (LAS float*)lds;
    LAS float* SS = (LAS float*)(lds + 26624);
    LAS unsigned* cnt = (LAS unsigned*)(lds + 26624 + 512);
    const int g = lane >> 4, ic = lane & 15;
    const float* X1 = p.out;
    bf16x8 bh[4][3], bl[4][3];
#pragma unroll
    for (int ks = 0; ks < 4; ++ks) {
        const int k0 = 128 * wave + 32 * ks + 8 * g;
#pragma unroll
        for (int nt = 0; nt < 3; ++nt) {
            const int col = 16 * nt + ic; const int cc = col < 36 ? col : 0;
            f32x4 a = *(const f32x4*)(p.WrT + (size_t)cc * 1024 + k0), b = *(const f32x4*)(p.WrT + (size_t)cc * 1024 + k0 + 4);
            if (col >= 36) { a = (f32x4){0.f, 0.f, 0.f, 0.f}; b = a; }
            split_bf16(a, b, bh[ks][nt], bl[ks][nt]);
        }
        if (ks & 1) asm volatile("" ::: "memory");
    }
    for (int c = blockIdx.x; c < M / 128; c += gridDim.x) {
        for (int i = tid; i < 128 * 52 + 128 + 32; i += NTHR) ((LAS float*)lds)[i] = 0.f;
        __syncthreads();
        f32x4 xa[4], xb[4], na[4], nb[4];
#define RT_LOAD(XA_, XB_, rt_) do { const float* xr = X1 + (size_t)(c * 128 + 16 * (rt_) + ic) * D + 128 * wave + 8 * g; \
            _Pragma("unroll") for (int ks = 0; ks < 4; ++ks) { XA_[ks] = *(const f32x4*)(xr + 32 * ks); XB_[ks] = *(const f32x4*)(xr + 32 * ks + 4); } } while (0)
        RT_LOAD(na, nb, 0);
#pragma unroll 1
        for (int rt = 0; rt < 8; ++rt) {
#pragma unroll
            for (int ks = 0; ks < 4; ++ks) { xa[ks] = na[ks]; xb[ks] = nb[ks]; }
            if (rt < 7) RT_LOAD(na, nb, rt + 1);
            __builtin_amdgcn_sched_barrier(0);
            f32x4 acc[3];
#pragma unroll
            for (int nt = 0; nt < 3; ++nt) acc[nt] = (f32x4){0.f, 0.f, 0.f, 0.f};
            float ssq = 0.f;
            bf16_t* hr = p.H2B + (size_t)(c * 128 + 16 * rt + ic) * D + 128 * wave + 8 * g;
#pragma unroll
            for (int ks = 0; ks < 4; ++ks) {
                ssq += (xa[ks].x * xa[ks].x + xa[ks].y * xa[ks].y) + (xa[ks].z * xa[ks].z + xa[ks].w * xa[ks].w) + (xb[ks].x * xb[ks].x + xb[ks].y * xb[ks].y) + (xb[ks].z * xb[ks].z + xb[ks].w * xb[ks].w);
                const f32x4 ga = *(const f32x4*)(p.n2g + 128 * wave + 32 * ks + 8 * g), gb = *(const f32x4*)(p.n2g + 128 * wave + 32 * ks + 8 * g + 4);
                bf16x8 ah, al;
                split_bf16(xa[ks] * ga, xb[ks] * gb, ah, al);
                *(bf16x8*)(hr + 32 * ks) = ah;
                if (STRIP != 1) {
#pragma unroll
                for (int nt = 0; nt < 3; ++nt) {
                    acc[nt] = __builtin_amdgcn_mfma_f32_16x16x32_bf16(ah, bh[ks][nt], acc[nt], 0, 0, 0);
                    acc[nt] = __builtin_amdgcn_mfma_f32_16x16x32_bf16(al, bh[ks][nt], acc[nt], 0, 0, 0);
                    acc[nt] = __builtin_amdgcn_mfma_f32_16x16x32_bf16(ah, bl[ks][nt], acc[nt], 0, 0, 0);
                }
                }
            }
            ssq += __shfl_xor(ssq, 16); ssq += __shfl_xor(ssq, 32);
            LAS float* PT = (LAS float*)(lds + 32768) + ((rt & 1) * 8 + wave) * (16 * 52);
            if (STRIP == 0) {
#pragma unroll
            for (int nt = 0; nt < 3; ++nt)
#pragma unroll
                for (int r = 0; r < 4; ++r) PT[(4 * g + r) * 52 + 16 * nt + ic] = acc[nt][r];
            if (g == 0) PT[ic * 52 + 48] = ssq;
            }
            LDS_WAIT(); __builtin_amdgcn_s_barrier();
            if (STRIP == 0) {
            for (int e = tid; e < 16 * 52; e += NTHR) {
                const LAS float* q = (const LAS float*)(lds + 32768) + (rt & 1) * 8 * (16 * 52) + e;
                float s = 0.f;
#pragma unroll
                for (int w = 0; w < 8; ++w) s += q[w * (16 * 52)];
                LG[16 * rt * 52 + e] = s;
            }
            }
        }
#undef RT_LOAD
        __syncthreads();
        if (tid < 128) {
            const int m = c * 128 + tid;
            const LAS float* lg = LG + tid * 52;
            const float rinv = 1.0f / sqrtf(lg[48] * (1.f / D) + EPS);
            float gl[4];
#pragma unroll
            for (int i = 0; i < 4; ++i) gl[i] = rinv * lg[i] + p.rg_b[i];
            int gi = 0; float gm = gl[0];
#pragma unroll
            for (int i = 1; i < 4; ++i) if (gl[i] > gm) { gm = gl[i]; gi = i; }
            float gs = 0.f;
#pragma unroll
            for (int i = 0; i < 4; ++i) gs += __expf(gl[i] - gm);
            const float gwt = 1.f / gs;
            float el[8];
#pragma unroll
            for (int j = 0; j < 8; ++j) el[j] = rinv * lg[4 + gi * 8 + j] + p.re_b[gi * 8 + j];
            int i1 = 0; float m1 = el[0];
#pragma unroll
            for (int j = 1; j < 8; ++j) if (el[j] > m1) { m1 = el[j]; i1 = j; }
            int i2 = 0; float m2 = -INFINITY;
#pragma unroll
            for (int j = 0; j < 8; ++j) if (j != i1 && el[j] > m2) { m2 = el[j]; i2 = j; }
            const float e2r = __expf(m2 - m1), e1 = 1.f / (1.f + e2r), e2 = e2r * e1;
            const int ea = gi * 8 + i1, eb = gi * 8 + i2;
            p.EID[2 * m] = ea; p.EID[2 * m + 1] = eb;
            p.EW[2 * m] = gwt * e1; p.EW[2 * m + 1] = gwt * e2;
            p.RINV2[m] = rinv;
            __hip_atomic_fetch_add(cnt + ea, 1u, __ATOMIC_RELAXED, __HIP_MEMORY_SCOPE_WORKGROUP);
            __hip_atomic_fetch_add(cnt + eb, 1u, __ATOMIC_RELAXED, __HIP_MEMORY_SCOPE_WORKGROUP);
        }
        __syncthreads();
        if (tid < 32) p.BLKCNT[c * 32 + tid] = (int)cnt[tid];
        __syncthreads();
    }
}

__device__ __forceinline__ void ph_router(const P& p, LAS unsigned char* lds, const int wv) { ph_router_t<0>(p, lds, wv); }

__device__ __forceinline__ void ph_scan(const P& p, LAS unsigned char* lds, const int wv) {}
__device__ __forceinline__ void ph_scatter(const P& p, LAS unsigned char* lds, const int wv) {
    const int tid = opaque_tid(wv);
    LAS int* s = (LAS int*)lds;
    LAS int* se = s + 2048;
    const int e = tid & 31, part = tid >> 5;
    int loc[16]; int sum = 0;
#pragma unroll
    for (int i = 0; i < 16; ++i) { loc[i] = p.BLKCNT[(part * 16 + i) * 32 + e]; sum += loc[i]; }
    s[128 + part * 32 + e] = sum;
    __syncthreads();
    if (tid < 32) { int t = 0; for (int k = 0; k < 16; ++k) { const int v = s[128 + k * 32 + tid]; s[128 + k * 32 + tid] = t; t += v; } s[tid] = t; }
    __syncthreads();
    if (tid == 0) { int off = 0; for (int k = 0; k < 32; ++k) { s[32 + k] = off; off += (s[k] + 255) >> 8; } s[64] = off; }
    __syncthreads();
    if (blockIdx.x == 0) {
        const int ntiles = s[64];
        if (tid < 32) { p.MOEI[tid] = s[32 + tid] * 256; p.MOEI[32 + tid] = s[32 + tid]; }
        if (tid == 0) { p.MOEI[64] = ntiles; p.MOEI[65] = ntiles * 2; p.MOEI[66] = ntiles * 4; }
        for (int rt = tid; rt < ntiles; rt += NTHR) {
            int ex = 0;
            for (int k = 0; k < 32; ++k) { const int tb = s[32 + k], nt = (s[k] + 255) >> 8; if (rt >= tb && rt < tb + nt) ex = k; }
            p.GU[4 * rt + 0] = rt; p.GU[4 * rt + 1] = ex * 2; p.GU[4 * rt + 2] = rt; p.GU[4 * rt + 3] = ex * 2 + 1;
#pragma unroll
            for (int j = 0; j < 4; ++j) { p.DN[8 * rt + 2 * j] = rt; p.DN[8 * rt + 2 * j + 1] = ex * 4 + j; }
        }
        for (int k = 0; k < 32; ++k) {
            const int lo = s[32 + k] * 256 + s[k], hi = (s[32 + k] + ((s[k] + 255) >> 8)) * 256;
            for (int i = lo + tid; i < hi; i += NTHR) p.PTOK[i] = -1;
        }
    }
    for (int c = blockIdx.x; c < M / 128; c += gridDim.x) {
        if (part == (c >> 4)) {
            int run = s[32 + e] * 256 + s[128 + part * 32 + e];
#pragma unroll
            for (int i = 0; i < 16; ++i) run += (i < (c & 15)) ? loc[i] : 0;
            s[1024 + e] = run;
        }
        int ex = 0;
        if (tid < 256) { ex = p.EID[c * 256 + tid]; se[tid] = ex; }
        __syncthreads();
        if (tid < 256) {
            int rank = 0;
            for (int t = 0; t < tid; ++t) rank += (se[t] == ex) ? 1 : 0;
            p.PTOK[s[1024 + ex] + rank] = c * 256 + tid;
        }
        __syncthreads();
    }
}

template <bool DRY> __device__ __forceinline__ void ph_final(const P& p, const int wv) {
    const int tid = opaque_tid(wv), lane = tid & 63, wave = tid >> 6;
    const int gw = blockIdx.x * NWAVES + wave, NGW = gridDim.x * NWAVES;
    for (int m4 = gw; m4 < M / 4; m4 += NGW) {
        f32x4 v[4][4]; float s[4];
#pragma unroll
        for (int rr = 0; rr < 4; ++rr) {
            const int m = 4 * m4 + rr;
            const f32x4* xr = (const f32x4*)(p.out + (size_t)m * D) + lane;
            const u32x2* y0 = (const u32x2*)(p.YS + (size_t)m * D) + lane; const u32x2* y1 = (const u32x2*)(p.YS + ((size_t)M + m) * D) + lane;
            s[rr] = 0.f;
#pragma unroll
            for (int j = 0; j < 4; ++j) {
                v[rr][j] = xr[64 * j]; const u32x2 a = y0[64 * j], b = y1[64 * j];
                v[rr][j].x += bflo(a.x) + bflo(b.x); v[rr][j].y += bfhi(a.x) + bfhi(b.x); v[rr][j].z += bflo(a.y) + bflo(b.y); v[rr][j].w += bfhi(a.y) + bfhi(b.y);
                s[rr] += (v[rr][j].x * v[rr][j].x + v[rr][j].y * v[rr][j].y) + (v[rr][j].z * v[rr][j].z + v[rr][j].w * v[rr][j].w);
            }
        }
#pragma unroll
        for (int rr = 0; rr < 4; ++rr) {
            const float rinv = 1.0f / sqrtf(wave_sum(s[rr]) * (1.f / D) + EPS);
            f32x4* xr = (f32x4*)((DRY ? (float*)p.GBB : p.out) + (size_t)(4 * m4 + rr) * D) + lane;
#pragma unroll
            for (int j = 0; j < 4; ++j) { const f32x4 g = ((const f32x4*)p.fg)[lane + 64 * j]; xr[64 * j] = v[rr][j] * rinv * g; }
        }
    }
}

#ifndef GEMM_SP2
#define GEMM_SP2 true
#endif
__device__ __forceinline__ void ph_gemm_in(const P& p, LAS unsigned char* lds, const int wv) {
    pg8::Gemm g{p.HB, p.WinT, M, NIN, 1024}; pg8::StaticOrder S; S.init(M, NIN, gridDim.x, (int)blockIdx.x);
    EpiIn E{p.QL, p.QI, p.KI, p.UB, p.VB, p.GAB, p.GBB, p.CKVR, p.WI};
    pg8::gemm_phase<EpiIn, pg8::StaticOrder, true, GEMM_SP2>(lds, g, S, E, wv);
    {
        const int G = gridDim.x, nwg = (M / 256) * (NIN / 256), nextra = nwg % G;
        const int c = blockIdx.x, nshort = nextra == 0 ? G : G - nextra;
        if (nextra == 0 || c >= nextra) {
            const int tid = opaque_tid(wv), lane = tid & 63, wave = __builtin_amdgcn_readfirstlane(tid >> 6);
            __syncthreads();
            prep_gateup(p, lds, (nextra == 0 ? c : c - nextra) * NWAVES + wave, nshort * NWAVES, wave, lane);
        }
    }
}
__device__ __forceinline__ void ph_gemm_yb(const P& p, LAS unsigned char* lds, const int wv) {
    pg8::Gemm g{p.US, p.WpbT, M, 1024, 512}; pg8::StaticOrder S; S.init(M, 1024, gridDim.x, (int)blockIdx.x);
    EpiMB E{p.GBB, p.MB};
    pg8::gemm_phase<EpiMB, pg8::StaticOrder, true, GEMM_SP2>(lds, g, S, E, wv);
}
__device__ __forceinline__ void ph_gemm_ya(const P& p, LAS unsigned char* lds, const int wv) {
    pg8::Gemm g{p.OL, p.WovT, M, 1024, 1024}; pg8::StaticOrder S; S.init(M, 1024, gridDim.x, (int)blockIdx.x);
    EpiMG E{p.GAB, p.MB, p.MG};
    pg8::gemm_phase<EpiMG, pg8::StaticOrder, true, GEMM_SP2>(lds, g, S, E, wv);
}
__device__ __forceinline__ void ph_gemm_out(const P& p, LAS unsigned char* lds, const int wv) {
    pg8::Gemm g{p.MG, p.WoutT, M, 1024, 1024}; pg8::StaticOrder S; S.init(M, 1024, gridDim.x, (int)blockIdx.x);
    EpiX1 E{p.x, p.out};
    pg8::gemm_phase<EpiX1, pg8::StaticOrder, true, GEMM_SP2>(lds, g, S, E, wv);
}
__device__ __forceinline__ void ph_gemm_gu(const P& p, LAS unsigned char* lds, const int wv) {
    table_prefetch(lds, p.GU, p.MOEI + 65, (int)gridDim.x, (int)blockIdx.x, opaque_tid(wv));
    pg8::Gemm g{p.H2B, p.WguT, NPOS, 32 * 512, 1024}; TableGatherOrder S{p.GU, p.MOEI + 65, p.PTOK, (int)gridDim.x, (int)blockIdx.x, (const LAS int*)(lds + LDS_TAB_OFF)};
    EpiHE E{p.HE, p.PTOK, p.RINV2};
    pg8::gemm_phase<EpiHE, TableGatherOrder, true, true>(lds, g, S, E, wv);
}
__device__ __forceinline__ void ph_gemm_dn(const P& p, LAS unsigned char* lds, const int wv) {
    table_prefetch(lds, p.DN, p.MOEI + 66, (int)gridDim.x, (int)blockIdx.x, opaque_tid(wv));
    pg8::Gemm g{p.HE, p.WdT, NPOS, 32 * 1024, 256}; TableOrder S{p.DN, p.MOEI + 66, (int)gridDim.x, (int)blockIdx.x, (const LAS int*)(lds + LDS_TAB_OFF)};
    EpiDown E{p.PTOK, p.EW, p.YS};
    pg8::gemm_phase<EpiDown, TableOrder, true, GEMM_SP2>(lds, g, S, E, wv);
}
constexpr int NPHASE = 15;
template <int PH> __device__ __forceinline__ void run_phase(const P& p, LAS unsigned char* lds, const int wv) {
    if constexpr (PH == 0) ph_prep(p, lds, wv);
    if constexpr (PH == 1) ph_gemm_in(p, lds, wv);
    if constexpr (PH == 2) ph_ckvnorm(p, wv);
    if constexpr (PH == 3) ph_index7(p, lds, wv);
    if constexpr (PH == 4) ph_attn(p, lds, wv);
    if constexpr (PH == 5) ph_gmlp(p, lds, wv);
    if constexpr (PH == 6) ph_gemm_yb(p, lds, wv);
    if constexpr (PH == 7) ph_gemm_ya(p, lds, wv);
    if constexpr (PH == 8) ph_gemm_out(p, lds, wv);
    if constexpr (PH == 9) ph_router(p, lds, wv);
    if constexpr (PH == 10) ph_scan(p, lds, wv);
    if constexpr (PH == 11) ph_scatter(p, lds, wv);
    if constexpr (PH == 12) ph_gemm_gu(p, lds, wv);
    if constexpr (PH == 13) ph_gemm_dn(p, lds, wv);
    if constexpr (PH == 14) ph_final<false>(p, wv);
}
template <int PH> __global__ void __launch_bounds__(NTHR, 2) k_phase(P p) {
    extern __shared__ __attribute__((aligned(16))) unsigned char lds_raw[];
    run_phase<PH>(p, (LAS unsigned char*)lds_raw, __builtin_amdgcn_readfirstlane(threadIdx.x >> 6));
}

constexpr int MISC_OFF = LDS_BYTES - 256;
__global__ void __launch_bounds__(NTHR, 2) k_mega(P p) {
    extern __shared__ __attribute__((aligned(16))) unsigned char lds_raw[];
    LAS unsigned char* lds = (LAS unsigned char*)lds_raw;
    volatile LAS unsigned* MISC = (volatile LAS unsigned*)(lds + MISC_OFF);
    int wv = __builtin_amdgcn_readfirstlane(threadIdx.x >> 6); asm volatile("" : "+s"(wv));
    if (threadIdx.x < 64) MISC[threadIdx.x] = 0u;
    __syncthreads();
    XcdBarrier bar = xcd_barrier_post(p.ctl + CW_BAR, MISC, wv);
    run_phase<0>(p, lds, wv);
#if defined(DUP0)
    __syncthreads(); run_phase<0>(p, lds, wv);
#endif
    xcd_barrier(bar);
    run_phase<1>(p, lds, wv);
#if defined(DUP1)
    __syncthreads(); run_phase<1>(p, lds, wv);
#endif
    xcd_barrier(bar);
    run_phase<2>(p, lds, wv);
#if defined(DUP2)
    run_phase<2>(p, lds, wv);
#endif
#if defined(PRE3)
    ph_index7_t<PRE3>(p, lds, wv); __syncthreads();
#endif
    run_phase<3>(p, lds, wv);
#if defined(DUP3)
    __syncthreads(); run_phase<3>(p, lds, wv);
#endif
    xcd_barrier(bar);
    run_phase<4>(p, lds, wv);  __syncthreads();
#if defined(DUP4)
    run_phase<4>(p, lds, wv);  __syncthreads();
#endif
    run_phase<5>(p, lds, wv);
#if defined(DUP5)
    __syncthreads(); run_phase<5>(p, lds, wv);
#endif
    xcd_barrier(bar);
    run_phase<6>(p, lds, wv);
    run_phase<7>(p, lds, wv);  xcd_barrier(bar);
    run_phase<8>(p, lds, wv);
#if defined(DUP678)
    __syncthreads(); run_phase<6>(p, lds, wv); run_phase<7>(p, lds, wv); xcd_barrier(bar); run_phase<8>(p, lds, wv);
#endif
    xcd_barrier(bar);
#if defined(PRE9)
    ph_router_t<PRE9>(p, lds, wv); __syncthreads();
#endif
    run_phase<9>(p, lds, wv);
#if defined(DUP9)
    __syncthreads(); run_phase<9>(p, lds, wv);
#endif

    xcd_barrier(bar);
    run_phase<11>(p, lds, wv);
#if defined(DUP11)
    __syncthreads(); run_phase<11>(p, lds, wv);
#endif
    xcd_barrier(bar);
    run_phase<12>(p, lds, wv);
#if defined(DUP12)
    __syncthreads(); run_phase<12>(p, lds, wv);
#endif
    xcd_barrier(bar);
    run_phase<13>(p, lds, wv);
#if defined(DUP13)
    __syncthreads(); run_phase<13>(p, lds, wv);
#endif
    xcd_barrier(bar);
#if defined(XBAR10)
    for (int i = 0; i < 10; ++i) xcd_barrier(bar);
#endif
#if defined(DUP14)
    ph_final<true>(p, wv); __syncthreads();
#endif
    run_phase<14>(p, lds, wv);
}

extern "C" void kernel_launch(void* const* d_in, const int* in_sizes, int n_in, void* d_out, int out_size, void* d_ws, size_t ws_size, hipStream_t stream) {
    static int grid = 0; static bool first = true;
    if (grid == 0) {
        if (n_in != 23 || in_sizes[0] != M * D || out_size != M * D || ws_size < WS_END) { fprintf(stderr, "kernel_launch: unexpected shapes (n_in %d, in0 %d, out %d, ws %zu)\n", n_in, n_in > 0 ? in_sizes[0] : -1, out_size, ws_size); grid = -1; return; }
        int dev = 0, cus = 0;
        if (hipGetDevice(&dev) != hipSuccess || hipDeviceGetAttribute(&cus, hipDeviceAttributeMultiprocessorCount, dev) != hipSuccess) { grid = -1; return; }
        grid = cus;
    }
    if (grid < 0) return;
    unsigned char* ws = (unsigned char*)d_ws;
    (void)hipMemsetAsync(ws + WS_CTL, 0, CTL_ZERO_BYTES, stream);
    P p{};
    const float* const* in = (const float* const*)d_in;
    p.x = in[0]; p.w_in = in[1]; p.kv_g = in[2]; p.w_uk = in[3]; p.w_uv = in[4]; p.rel_bias = in[5]; p.ln_g = in[6]; p.ln_b = in[7]; p.w_sp = in[8]; p.b_sp = in[9];
    p.w_pa = in[10]; p.w_pb = in[11]; p.w_out = in[12]; p.n1g = in[13]; p.n2g = in[14]; p.rg_w = in[15]; p.rg_b = in[16]; p.re_w = in[17]; p.re_b = in[18];
    p.w_gate = in[19]; p.w_up = in[20]; p.w_down = in[21]; p.fg = in[22];
    p.out = (float*)d_out; p.ctl = (unsigned*)(ws + WS_CTL);
    p.WinT = (bf16_t*)(ws + WS_WIN); p.WoutT = (bf16_t*)(ws + WS_WOUT); p.WpbT = (bf16_t*)(ws + WS_WPB); p.WovT = (bf16_t*)(ws + WS_WOV); p.WSB = (bf16_t*)(ws + WS_WSB);
    p.WguT = (bf16_t*)(ws + WS_WGU); p.WdT = (bf16_t*)(ws + WS_WD); p.WrT = (float*)(ws + WS_WRT);
    p.HB = (bf16_t*)(ws + WS_A); p.OL = (bf16_t*)(ws + WS_A); p.H2B = (bf16_t*)(ws + WS_A);
    p.QL = (bf16_t*)(ws + WS_B); p.MB = (bf16_t*)(ws + WS_B); p.H2S = (bf16_t*)(ws + WS_B); p.YS = (bf16_t*)(ws + WS_B);
    p.GAB = (bf16_t*)(ws + WS_GA); p.GBB = (bf16_t*)(ws + WS_GB);
    p.UB = (bf16_t*)(ws + WS_C); p.VB = (bf16_t*)(ws + WS_C + 32 * MiB); p.MG = (bf16_t*)(ws + WS_C); p.HE = (bf16_t*)(ws + WS_C);
    p.QI = (bf16_t*)(ws + WS_DQ); p.US = (bf16_t*)(ws + WS_DQ);
    p.CKVR = (float*)(ws + WS_CKVR); p.CKVB = (bf16_t*)(ws + WS_CKVB); p.KI = (bf16_t*)(ws + WS_KI); p.WI = (float*)(ws + WS_WI); p.SEL = (unsigned short*)(ws + WS_SEL);
    p.EID = (int*)(ws + WS_MOE); p.EW = (float*)(ws + WS_MOE + 262144); p.PTOK = (int*)(ws + WS_MOE + 524288); p.MOEI = (int*)(ws + WS_MOE + 1048576);
    p.GU = (int*)(ws + WS_MOE + 1048576 + 4096); p.BLKCNT = (int*)(ws + WS_MOE + 1048576 + 65536); p.IDXROW = (float*)(ws + WS_A); p.RINV2 = (float*)(ws + WS_MOE + 1048576 + 262144); p.CB = (int*)(ws + WS_MOE + 1048576 + 131072); p.DN = (int*)(ws + WS_MOE + 1048576 + 4096 + 8192);
    if (first) { (void)hipFuncSetAttribute((const void*)k_mega, hipFuncAttributeMaxDynamicSharedMemorySize, LDS_BYTES); first = false; }
    hipLaunchKernelGGL(k_mega, dim3(grid), dim3(NTHR), LDS_BYTES, stream, p);
}
```

```cpp
#include <hip/hip_runtime.h>
#include <cstdio>
#include <cstdint>
__device__ __forceinline__ int opaque_tid(const int wv) { int l; asm volatile("v_mbcnt_lo_u32_b32 %0, -1, 0\n\tv_mbcnt_hi_u32_b32 %0, -1, %0" : "=v"(l)); return (wv << 6) + l; }
#define LAS __attribute__((address_space(3)))
namespace pg8 {
#define PG8_LAS __attribute__((address_space(3)))
typedef unsigned short bf16_t;
typedef short bf16x8 __attribute__((ext_vector_type(8)));
typedef float f32x4 __attribute__((ext_vector_type(4)));
typedef unsigned u32x4 __attribute__((ext_vector_type(4)));
constexpr int BM = 256, BK = 64, HALF = 128, HTB = HALF * BK * 2  , STAGE_BYTES = 8 * HTB, NXCD = 8, WGM = 8;

__host__ __device__ __forceinline__ int lds_byte(int r, int c) { const int st = (r >> 4) * 2 + (c >> 5), rr = r & 15, cc = c & 31, ob = rr * 64 + cc * 2; return st * 1024 + (ob ^ (((ob >> 9) & 1) << 5)); }
__host__ __device__ __forceinline__ void stage_rc(int b, int& R, int& C) { const int st = b / 1024, sb = b % 1024, swz = sb ^ (((sb >> 9) & 1) << 5); R = (st >> 1) * 16 + swz / 64; C = (st & 1) * 32 + (swz % 64) / 2; }
__host__ __device__ __forceinline__ int perm32(int rho) { const int n = rho >> 4, i = rho & 15; return 8 * (i >> 2) + 4 * n + (i & 3); }

struct Unit { int pm, pn; };
struct Gemm { const bf16_t* A; const bf16_t* Bt; int M, N, K; };

struct StaticOrder {
    static constexpr bool GATHER = false;
    int nM, nN, nwg, G, c;
    __host__ __device__ void init(int M, int N, int G_, int c_) { nM = M / BM; nN = N / BM; nwg = nM * nN; G = G_; c = c_; }
    __host__ __device__ bool next(int i, Unit& u) const {
        const long L = (long)i * G + c; if (L >= nwg) return false;
        int wgid = (int)L; { const int q = nwg / NXCD, r = nwg % NXCD, xcd = wgid % NXCD, off = wgid / NXCD; wgid = (xcd < r ? xcd * (q + 1) : r * (q + 1) + (xcd - r) * q) + off; }
        const int nig = WGM * nN, gid = wgid / nig, fm = gid * WGM, gsz = (nM - fm) < WGM ? (nM - fm) : WGM;
        u.pm = fm + ((wgid % nig) % gsz); u.pn = (wgid % nig) / gsz; return true;
    }
    __device__ __forceinline__ int arow(int r) const { return r; }
    __device__ __forceinline__ void a_ready(const Unit&) const {}
    __device__ __forceinline__ void done(const Unit&) const {}
};

__device__ __forceinline__ unsigned cvt_pk_bf16(float lo, float hi) { unsigned r; asm volatile("v_cvt_pk_bf16_f32 %0, %1, %2" : "=v"(r) : "v"(lo), "v"(hi)); return r; }
typedef float f32x2 __attribute__((ext_vector_type(2)));
template <class Epi, class Sched, bool ALIGN_EPI = false, bool SP2 = false>
__device__ __forceinline__ void gemm_phase(PG8_LAS unsigned char* lds, const Gemm g, const Sched& S, const Epi& E, const int wv) {
    const int tid = opaque_tid(wv), wid = __builtin_amdgcn_readfirstlane(tid >> 6), lane = tid & 63, wr = wid >> 2, wc = wid & 3, fr = lane & 15, fq = lane >> 4;
    const int K = g.K, nt = K / BK;
    unsigned voffA[2], voffB[2];
#pragma unroll
    for (int i = 0; i < 2; ++i) { int R, C; stage_rc(tid * 16 + i * 8192, R, C); const int Rb = Epi::PERM ? ((R & ~31) + perm32(R & 31)) : R;
        voffA[i] = (unsigned)(R * K + C) * 2u; voffB[i] = (unsigned)(Rb * K + C) * 2u; }
    static_assert(!Sched::GATHER || SP2, "gathered A rows: SP2 loop only");
    unsigned gcur[2][2], gnxt[2][2]; int gR[2], gC[2];
    if constexpr (Sched::GATHER) {
#pragma unroll
        for (int i = 0; i < 2; ++i) { stage_rc(tid * 16 + i * 8192, gR[i], gC[i]); }
    }
#define PG8_GOFF(dst, u_) do { _Pragma("unroll") for (int h_ = 0; h_ < 2; ++h_) _Pragma("unroll") for (int i_ = 0; i_ < 2; ++i_) \
        dst[h_][i_] = ((unsigned)S.arow((u_).pm * BM + h_ * HALF + gR[i_]) * (unsigned)K + (unsigned)gC[i_]) * 2u; } while (0)
    const size_t kstep = (size_t)(BK * 2);
    const size_t hstep = (size_t)HALF * K * 2;
    const size_t tstep = 2 * hstep;
    const unsigned ldsw = (unsigned)wid * 1024u;
    const int aoff = lds_byte(wr * 64 + fr, fq * 8), boff = lds_byte(wc * 32 + fr, fq * 8);
#define PG8_SA(b, h) (((b) * 2 + (h)) * HTB)
#define PG8_SB(b, h) ((4 + (b) * 2 + (h)) * HTB)
#define PG8_STAGE(bufoff, gbase, voff) do { _Pragma("unroll") for (int _i = 0; _i < 2; ++_i) \
        __builtin_amdgcn_global_load_lds((const unsigned*)((const char*)(gbase) + (voff)[_i]), (PG8_LAS unsigned*)(lds + (bufoff) + ldsw + _i * 8192), 16, 0, 0); } while (0)
#define PG8_LDA(dst, b, h) do { _Pragma("unroll") for (int m = 0; m < 4; ++m) _Pragma("unroll") for (int k = 0; k < 2; ++k) dst[m][k] = *(const PG8_LAS bf16x8*)(lds + PG8_SA(b, h) + aoff + m * 2048 + k * 1024); } while (0)
#define PG8_LDB(dst, b, h) do { _Pragma("unroll") for (int n = 0; n < 2; ++n) _Pragma("unroll") for (int k = 0; k < 2; ++k) dst[n][k] = *(const PG8_LAS bf16x8*)(lds + PG8_SB(b, h) + boff + n * 2048 + k * 1024); } while (0)
#define PG8_MMA(ai, bj, At, Bt) do { __builtin_amdgcn_s_setprio(1); _Pragma("unroll") for (int m = 0; m < 4; ++m) _Pragma("unroll") for (int n = 0; n < 2; ++n) _Pragma("unroll") for (int k = 0; k < 2; ++k) \
        acc[ai][bj][m][n] = __builtin_amdgcn_mfma_f32_16x16x32_bf16(Bt[n][k], At[m][k], acc[ai][bj][m][n], 0, 0, 0); __builtin_amdgcn_s_setprio(0); } while (0)
#define PG8_WAIT_V(n) asm volatile("s_waitcnt vmcnt(" #n ")" ::: "memory")
#define PG8_WAIT_L(n) asm volatile("s_waitcnt lgkmcnt(" #n ")" ::: "memory")
#define PG8_BAR __builtin_amdgcn_s_barrier()
#define PG8_SCHED __builtin_amdgcn_sched_barrier(0)
    Unit cur, nxt; int ui = 0;
    if (!S.next(0, cur)) return;
    f32x4 acc[2][2][4][2];
#pragma unroll
    for (int a = 0; a < 2; ++a)
#pragma unroll
        for (int b = 0; b < 2; ++b)
#pragma unroll
            for (int m = 0; m < 4; ++m)
#pragma unroll
                for (int n = 0; n < 2; ++n) acc[a][b][m][n] = (f32x4){0.f, 0.f, 0.f, 0.f};
    bf16x8 At[4][2], B0[2][2], B1[2][2];
    const char* cA = Sched::GATHER ? (const char*)g.A : (const char*)g.A + (size_t)cur.pm * tstep; const char* cB = (const char*)g.Bt + (size_t)cur.pn * tstep;
    S.a_ready(cur);
    if constexpr (Sched::GATHER) { PG8_GOFF(gcur, cur); }
#define PG8_STAGE_A(bufoff, base_, h_, koff_, GO_) do { if constexpr (Sched::GATHER) { PG8_STAGE(bufoff, (const char*)g.A + (koff_), GO_[h_]); } else { PG8_STAGE(bufoff, (base_) + (h_) * hstep + (koff_), voffA); } } while (0)
    if constexpr (SP2) {
        PG8_STAGE(PG8_SB(0, 0), cB, voffB); PG8_STAGE(PG8_SB(0, 1), cB + hstep, voffB); PG8_STAGE_A(PG8_SA(0, 0), cA, 0, 0, gcur); PG8_STAGE_A(PG8_SA(0, 1), cA, 1, 0, gcur);
        if (wr == 1) PG8_BAR;
        PG8_WAIT_V(2); PG8_BAR;
        PG8_STAGE(PG8_SB(1, 0), cB + kstep, voffB); PG8_STAGE_A(PG8_SA(1, 0), cA, 0, kstep, gcur); PG8_STAGE(PG8_SB(1, 1), cB + hstep + kstep, voffB);
        PG8_WAIT_V(6); PG8_BAR;
    } else {
        PG8_STAGE(PG8_SB(0, 0), cB, voffB); PG8_STAGE(PG8_SA(0, 0), cA, voffA); PG8_STAGE(PG8_SB(0, 1), cB + hstep, voffB); PG8_STAGE(PG8_SA(0, 1), cA + hstep, voffA);
        if (wr == 1) PG8_BAR;
        PG8_WAIT_V(4); PG8_BAR;
        PG8_STAGE(PG8_SB(1, 0), cB + kstep, voffB); PG8_STAGE(PG8_SA(1, 0), cA + kstep, voffA); PG8_STAGE(PG8_SB(1, 1), cB + hstep + kstep, voffB);
        PG8_WAIT_V(6); PG8_BAR;
    }
    for (;;) {
        const bool has_next = S.next(ui + 1, nxt);
        const char* nA = Sched::GATHER ? cA : (has_next ? (const char*)g.A + (size_t)nxt.pm * tstep : cA); const char* nB = has_next ? (const char*)g.Bt + (size_t)nxt.pn * tstep : cB;
        if constexpr (Sched::GATHER) { if (has_next) { PG8_GOFF(gnxt, nxt); } else { _Pragma("unroll") for (int h_ = 0; h_ < 2; ++h_) _Pragma("unroll") for (int i_ = 0; i_ < 2; ++i_) gnxt[h_][i_] = gcur[h_][i_]; } }
        for (int t = 0; t < nt; t += 2) {
            const bool last = (t == nt - 2);
            const char* a1 = cA + (size_t)(t + 1) * kstep;
            const char* a2 = last ? nA : cA + (size_t)(t + 2) * kstep; const char* b2 = last ? nB : cB + (size_t)(t + 2) * kstep;
            const char* a3 = a2 + kstep; const char* b3 = b2 + kstep;
            unsigned g2[2][2];
            if constexpr (Sched::GATHER) { _Pragma("unroll") for (int h_ = 0; h_ < 2; ++h_) _Pragma("unroll") for (int i_ = 0; i_ < 2; ++i_) g2[h_][i_] = last ? gnxt[h_][i_] : gcur[h_][i_]; }
            const size_t k1 = (size_t)(t + 1) * kstep, k2 = last ? (size_t)0 : (size_t)(t + 2) * kstep, k3 = k2 + kstep;
            if (last && has_next) S.a_ready(nxt);
            if constexpr (SP2) {
            PG8_LDB(B0, 0, 0); PG8_LDB(B1, 0, 1); PG8_SCHED; PG8_LDA(At, 0, 0); if constexpr (Sched::GATHER) { PG8_STAGE(PG8_SA(1, 1), (const char*)g.A + k1, gcur[1]); } else { PG8_STAGE(PG8_SA(1, 1), a1 + hstep, voffA); }
            PG8_WAIT_V(8); PG8_WAIT_L(0); PG8_BAR; PG8_MMA(0, 0, At, B0); PG8_MMA(0, 1, At, B1); PG8_BAR; PG8_SCHED;
            PG8_LDA(At, 0, 1); PG8_STAGE(PG8_SB(0, 0), b2, voffB); PG8_STAGE(PG8_SB(0, 1), b2 + hstep, voffB); if constexpr (Sched::GATHER) { PG8_STAGE(PG8_SA(0, 0), (const char*)g.A + k2, g2[0]); } else { PG8_STAGE(PG8_SA(0, 0), a2, voffA); }
            PG8_WAIT_V(8); PG8_WAIT_L(0); PG8_BAR; PG8_MMA(1, 0, At, B0); PG8_MMA(1, 1, At, B1); PG8_BAR; PG8_SCHED;
            PG8_LDB(B0, 1, 0); PG8_LDB(B1, 1, 1); PG8_SCHED; PG8_LDA(At, 1, 0); if constexpr (Sched::GATHER) { PG8_STAGE(PG8_SA(0, 1), (const char*)g.A + k2, g2[1]); } else { PG8_STAGE(PG8_SA(0, 1), a2 + hstep, voffA); }
            PG8_WAIT_V(8); PG8_WAIT_L(0); PG8_BAR; PG8_MMA(0, 0, At, B0); PG8_MMA(0, 1, At, B1); PG8_BAR; PG8_SCHED;
            PG8_LDA(At, 1, 1); PG8_STAGE(PG8_SB(1, 0), b3, voffB); PG8_STAGE(PG8_SB(1, 1), b3 + hstep, voffB); if constexpr (Sched::GATHER) { PG8_STAGE(PG8_SA(1, 0), (const char*)g.A + k3, g2[0]); } else { PG8_STAGE(PG8_SA(1, 0), a3, voffA); }
            PG8_WAIT_V(8); PG8_WAIT_L(0); PG8_BAR; PG8_MMA(1, 0, At, B0); PG8_MMA(1, 1, At, B1); PG8_BAR; PG8_SCHED;
            } else {
            PG8_LDB(B0, 0, 0); PG8_SCHED; PG8_LDA(At, 0, 0); PG8_STAGE(PG8_SA(1, 1), a1 + hstep, voffA);
            PG8_WAIT_L(8); PG8_BAR; PG8_WAIT_L(0); PG8_MMA(0, 0, At, B0); PG8_BAR; PG8_SCHED;
            PG8_LDB(B1, 0, 1); PG8_STAGE(PG8_SB(0, 0), b2, voffB);
            PG8_BAR; PG8_WAIT_L(0); PG8_MMA(0, 1, At, B1); PG8_BAR;
            PG8_LDA(At, 0, 1); PG8_STAGE(PG8_SA(0, 0), a2, voffA);
            PG8_BAR; PG8_WAIT_L(0); PG8_MMA(1, 0, At, B0); PG8_BAR; PG8_SCHED;
            PG8_STAGE(PG8_SB(0, 1), b2 + hstep, voffB);
            PG8_WAIT_V(6); PG8_BAR; PG8_MMA(1, 1, At, B1); PG8_BAR;
            PG8_LDB(B0, 1, 0); PG8_SCHED; PG8_LDA(At, 1, 0); PG8_STAGE(PG8_SA(0, 1), a2 + hstep, voffA);
            PG8_WAIT_L(8); PG8_BAR; PG8_WAIT_L(0); PG8_MMA(0, 0, At, B0); PG8_BAR; PG8_SCHED;
            PG8_LDB(B1, 1, 1); PG8_STAGE(PG8_SB(1, 0), b3, voffB);
            PG8_BAR; PG8_WAIT_L(0); PG8_MMA(0, 1, At, B1); PG8_BAR;
            PG8_LDA(At, 1, 1); PG8_STAGE(PG8_SA(1, 0), a3, voffA);
            PG8_BAR; PG8_WAIT_L(0); PG8_MMA(1, 0, At, B0); PG8_BAR; PG8_SCHED;
            PG8_STAGE(PG8_SB(1, 1), b3 + hstep, voffB);
            PG8_WAIT_V(6); PG8_BAR; PG8_MMA(1, 1, At, B1); PG8_BAR;
            }
        }
        if constexpr (ALIGN_EPI) { if (wr == 0) PG8_BAR; }
        if constexpr (!Epi::AFTER_DRAIN) {
            const int tz = opaque_tid(wv), wz = __builtin_amdgcn_readfirstlane(tz >> 6), lz = tz & 63;
            E(acc, cur, wz >> 2, wz & 3, lz & 15, lz >> 4); S.done(cur); }
        if (!has_next) break;
#pragma unroll
        for (int a = 0; a < 2; ++a)
#pragma unroll
            for (int b = 0; b < 2; ++b)
#pragma unroll
                for (int m = 0; m < 4; ++m)
#pragma unroll
                    for (int n = 0; n < 2; ++n) acc[a][b][m][n] = (f32x4){0.f, 0.f, 0.f, 0.f};
        cur = nxt; cA = nA; cB = nB; ++ui;
        if constexpr (Sched::GATHER) { _Pragma("unroll") for (int h_ = 0; h_ < 2; ++h_) _Pragma("unroll") for (int i_ = 0; i_ < 2; ++i_) gcur[h_][i_] = gnxt[h_][i_]; }
        if constexpr (ALIGN_EPI) { if (wr == 1) PG8_BAR; }
    }
    PG8_WAIT_V(0);
    if constexpr (!ALIGN_EPI) { if (wr == 0) PG8_BAR; }
    PG8_BAR;
    if constexpr (Epi::AFTER_DRAIN) { E.fused(acc, cur, wr, wc, fr, fq, lds, wid, lane); S.done(cur); }
#undef PG8_SA
#undef PG8_SB
#undef PG8_STAGE
#undef PG8_STAGE_A
#undef PG8_GOFF
#undef PG8_LDA
#undef PG8_LDB
#undef PG8_MMA
#undef PG8_WAIT_V
#undef PG8_WAIT_L
#undef PG8_BAR
#undef PG8_SCHED
}
}
#define XB_TMO      128
#define XB_XCNT(j)  (256  + 64 * (j))
#define XB_XSUB(j)  (1280 + 64 * (j))
#define XB_XGEN(j)  (2304 + 64 * (j))
#define XB_TOP      3328
#define XB_TOPGEN   3392
#define XCD_BAR_WORDS 3456
#define XB_SPIN_CAP (1u << 18)

__device__ __forceinline__ unsigned xb_ld(unsigned* p)              { return __hip_atomic_load(p, __ATOMIC_RELAXED, __HIP_MEMORY_SCOPE_AGENT); }
__device__ __forceinline__ unsigned xb_add(unsigned* p, unsigned v) { return __hip_atomic_fetch_add(p, v, __ATOMIC_RELAXED, __HIP_MEMORY_SCOPE_AGENT); }
__device__ __forceinline__ unsigned xb_xcc_id() { return (unsigned)__builtin_amdgcn_s_getreg((3 << 11) | 20) & 0xFu; }
#define XB_SPIN(cond, bar) do { unsigned _sp = 0; while (cond) { __builtin_amdgcn_s_sleep(1); \
    if ((++_sp & 255u) == 0u) { if (xb_ld(&(bar)[XB_TMO])) break; if (_sp > XB_SPIN_CAP) { atomicAdd(&(bar)[XB_TMO], 1u); break; } } } } while (0)

struct XcdBarrier {
    unsigned* bar; unsigned x; int wv;
    volatile LAS unsigned* st;
};

__device__ __forceinline__ XcdBarrier xcd_barrier_post(unsigned* bar, volatile LAS unsigned* st, int wv) {
    XcdBarrier b; b.bar = bar; b.x = xb_xcc_id(); b.st = st; b.wv = wv;
    if (opaque_tid(wv) == 0) (void)xb_add(&bar[XB_XCNT(b.x)], 1u);
    return b;
}
__device__ __forceinline__ void xcd_barrier_complete(unsigned* bar, unsigned x, unsigned& nloc, unsigned& nx) {
    const unsigned G = gridDim.x * gridDim.y * gridDim.z;
    unsigned sum, cnt, mine, sp = 0u;
    for (;;) {
        sum = 0u; cnt = 0u; mine = 0u;
#pragma unroll
        for (unsigned j = 0; j < 16; ++j) { const unsigned c = xb_ld(&bar[XB_XCNT(j)]); sum += c; cnt += (c > 0u) ? 1u : 0u; mine = (j == x) ? c : mine; }
        if (sum == G) break;
        __builtin_amdgcn_s_sleep(1);
        if ((++sp & 255u) == 0u) { if (xb_ld(&bar[XB_TMO])) break; if (sp > XB_SPIN_CAP) { atomicAdd(&bar[XB_TMO], 1u); break; } }
    }
    nloc = mine > 0u ? mine : 1u; nx = cnt > 0u ? cnt : 1u;
}

__device__ __forceinline__ void xcd_barrier(const XcdBarrier& b) {
    asm volatile("s_waitcnt vmcnt(0)" ::: "memory");
    __syncthreads();
    if (opaque_tid(b.wv) == 0) {
        unsigned* bar = b.bar;
        __builtin_amdgcn_s_waitcnt(0);
        unsigned nloc = b.st[0], nx = b.st[1];
        if (nloc == 0u) { xcd_barrier_complete(bar, b.x, nloc, nx); b.st[0] = nloc; b.st[1] = nx; }
        const unsigned old = xb_add(&bar[XB_XSUB(b.x)], 1u);
        const unsigned gen = old / nloc;
        if (old + 1u == (gen + 1u) * nloc) {
            __builtin_amdgcn_fence(__ATOMIC_RELEASE, "agent");
            asm volatile("s_waitcnt vmcnt(0)" ::: "memory");
            const unsigned og = xb_add(&bar[XB_TOP], 1u);
            const unsigned tg = og / nx;
            if (og + 1u == (tg + 1u) * nx) xb_add(&bar[XB_TOPGEN], 1u);
            else XB_SPIN(xb_ld(&bar[XB_TOPGEN]) == tg, bar);
            __builtin_amdgcn_fence(__ATOMIC_ACQUIRE, "agent");
            xb_add(&bar[XB_XGEN(b.x)], 1u);
            asm volatile("s_waitcnt vmcnt(0)" ::: "memory");
        } else {
            XB_SPIN(xb_ld(&bar[XB_XGEN(b.x)]) == gen, bar);
            __builtin_amdgcn_fence(__ATOMIC_ACQUIRE, "agent");
            asm volatile("s_waitcnt vmcnt(0)" ::: "memory");
        }
    }
    __syncthreads();
}

typedef unsigned short bf16_t;
typedef short bf16x8 __attribute__((ext_vector_type(8)));
typedef short bf16x4 __attribute__((ext_vector_type(4)));
typedef float f32x4 __attribute__((ext_vector_type(4)));
typedef float f32x2 __attribute__((ext_vector_type(2)));
typedef float f32x16 __attribute__((ext_vector_type(16)));
typedef unsigned u32x4 __attribute__((ext_vector_type(4)));
typedef unsigned u32x2 __attribute__((ext_vector_type(2)));

constexpr int NB = 8, T = 4096, D = 1024, M = NB * T;
constexpr int INC = 4296;
constexpr int NIN = 19 * 256;
constexpr float EPS = 1e-6f;
constexpr int NPOS = 73728;
constexpr int NWAVES = 8, NTHR = 512;
constexpr int LDS_BYTES = 163840;

constexpr size_t MiB = 1u << 20;
constexpr size_t WS_CTL = 0, CTL_ZERO_BYTES = 65536;
constexpr size_t WS_WIN = 1 * MiB, WS_WOUT = 11 * MiB, WS_WPB = 13 * MiB, WS_WOV = 14 * MiB, WS_WSB = 16 * MiB, WS_WRT = 16 * MiB + 262144, WS_WGU = 17 * MiB, WS_WD = 49 * MiB;
constexpr size_t WS_A = 65 * MiB;
constexpr size_t WS_B = 129 * MiB;
constexpr size_t WS_GA = 193 * MiB, WS_GB = 257 * MiB;
constexpr size_t WS_C = 321 * MiB;
constexpr size_t WS_DQ = 385 * MiB;
constexpr size_t WS_CKVR = 417 * MiB, WS_CKVB = 433 * MiB, WS_KI = 441 * MiB, WS_WI = 445 * MiB, WS_SEL = 446 * MiB;
constexpr size_t WS_MOE = 462 * MiB;
constexpr size_t WS_END = 464 * MiB;

constexpr int CW_BAR = 4096;
constexpr int CW_CNT = 8192, CW_CUR = 8256;

struct P {
    const float *x, *w_in, *kv_g, *w_uk, *w_uv, *rel_bias, *ln_g, *ln_b, *w_sp, *b_sp, *w_pa, *w_pb, *w_out, *n1g, *n2g, *rg_w, *rg_b, *re_w, *re_b, *w_gate, *w_up, *w_down, *fg;
    float* out;
    unsigned* ctl;
    bf16_t *WinT, *WoutT, *WpbT, *WovT, *WSB, *WguT, *WdT;
    float* WrT;
    bf16_t *HB, *QL, *QI, *CKVB, *KI, *UB, *VB, *GAB, *GBB, *OL, *US, *MB, *MG, *H2B, *H2S, *HE, *YS;
    float *CKVR, *WI, *EW, *IDXROW, *RINV2;
    unsigned short* SEL;
    int *EID, *PTOK, *MOEI, *GU, *DN, *BLKCNT, *CB;
};

__device__ __forceinline__ unsigned f2bf(float f) { unsigned u = __builtin_bit_cast(unsigned, f); return (u + 0x7fffu + ((u >> 16) & 1u)) >> 16; }
__device__ __forceinline__ unsigned pk2(float lo, float hi) { return f2bf(lo) | (f2bf(hi) << 16); }
__device__ __forceinline__ float bflo(unsigned w) { return __builtin_bit_cast(float, w << 16); }
__device__ __forceinline__ float bfhi(unsigned w) { return __builtin_bit_cast(float, w & 0xffff0000u); }
__device__ __forceinline__ float bf2f(unsigned short b) { return __builtin_bit_cast(float, (unsigned)b << 16); }
__device__ __forceinline__ float wave_sum(float v) {
#pragma unroll
    for (int o = 1; o < 64; o <<= 1) v += __shfl_xor(v, o);
    return v;
}
#define LDS_WAIT() asm volatile("s_waitcnt lgkmcnt(0)" ::: "memory")
__device__ __forceinline__ float sigm(float x) { return __builtin_amdgcn_rcpf(1.f + __builtin_amdgcn_exp2f(-1.4426950409f * x)); }
__device__ __forceinline__ float gelu_t(float x) { const float x2 = x * x; return x * __builtin_amdgcn_rcpf(1.f + __builtin_amdgcn_exp2f(x * (-2.3022082f - 0.1029432f * x2))); }
__device__ __forceinline__ unsigned off_b(unsigned row, unsigned ch) { return 256u * row + 16u * (ch ^ (((row & 3) << 2) | ((row >> 2) & 3))); }
__device__ __forceinline__ bf16x4 tr_read(unsigned lds_addr) { bf16x4 r; asm volatile("ds_read_b64_tr_b16 %0, %1\n\ts_waitcnt lgkmcnt(0)" : "=&v"(r) : "v"(lds_addr) : "memory"); return r; }
__device__ __forceinline__ bf16x8 cat4(bf16x4 a, bf16x4 b) { bf16x8 r; r[0] = a[0]; r[1] = a[1]; r[2] = a[2]; r[3] = a[3]; r[4] = b[0]; r[5] = b[1]; r[6] = b[2]; r[7] = b[3]; return r; }
__device__ __forceinline__ unsigned lds_addr_of(LAS unsigned char* p) { return (unsigned)(unsigned long long)p; }

__device__ __forceinline__ void st8bf(bf16_t* p, const pg8::f32x4& a, const pg8::f32x4& b) {
    u32x4 w; w.x = pg8::cvt_pk_bf16(a[0], a[1]); w.y = pg8::cvt_pk_bf16(a[2], a[3]); w.z = pg8::cvt_pk_bf16(b[0], b[1]); w.w = pg8::cvt_pk_bf16(b[2], b[3]);
    *(u32x4*)p = w;
}
__device__ __forceinline__ void ld8bf(const bf16_t* p, pg8::f32x4& a, pg8::f32x4& b) {
    const u32x4 w = *(const u32x4*)p;
    a[0] = bflo(w.x); a[1] = bfhi(w.x); a[2] = bflo(w.y); a[3] = bfhi(w.y); b[0] = bflo(w.z); b[1] = bfhi(w.z); b[2] = bflo(w.w); b[3] = bfhi(w.w);
}

__device__ __forceinline__ void st8q(unsigned char* p, const pg8::f32x4& a, const pg8::f32x4& b) {
    float v[8];
#pragma unroll
    for (int j = 0; j < 4; ++j) { v[j] = fminf(fmaxf(a[j] * 16.f, -440.f), 440.f); v[4 + j] = fminf(fmaxf(b[j] * 16.f, -440.f), 440.f); }
    u32x2 h, l;
    h.x = (unsigned)__builtin_amdgcn_cvt_pk_fp8_f32(v[0], v[1], 0, false); h.x = (unsigned)__builtin_amdgcn_cvt_pk_fp8_f32(v[2], v[3], (int)h.x, true);
    h.y = (unsigned)__builtin_amdgcn_cvt_pk_fp8_f32(v[4], v[5], 0, false); h.y = (unsigned)__builtin_amdgcn_cvt_pk_fp8_f32(v[6], v[7], (int)h.y, true);
    const f32x2 b0 = __builtin_amdgcn_cvt_pk_f32_fp8((int)h.x, false), b1 = __builtin_amdgcn_cvt_pk_f32_fp8((int)h.x, true);
    const f32x2 b2 = __builtin_amdgcn_cvt_pk_f32_fp8((int)h.y, false), b3 = __builtin_amdgcn_cvt_pk_f32_fp8((int)h.y, true);
    l.x = (unsigned)__builtin_amdgcn_cvt_pk_fp8_f32(v[0] - b0[0], v[1] - b0[1], 0, false); l.x = (unsigned)__builtin_amdgcn_cvt_pk_fp8_f32(v[2] - b1[0], v[3] - b1[1], (int)l.x, true);
    l.y = (unsigned)__builtin_amdgcn_cvt_pk_fp8_f32(v[4] - b2[0], v[5] - b2[1], 0, false); l.y = (unsigned)__builtin_amdgcn_cvt_pk_fp8_f32(v[6] - b3[0], v[7] - b3[1], (int)l.y, true);
    *(u32x2*)p = h; *(u32x2*)(p + 128) = l;
}
struct EpiIn {
    static constexpr bool PERM = true, AFTER_DRAIN = false;
    bf16_t *QL, *QI, *KI, *UB, *VB, *GAB, *GBB; float *CKVR, *WI;
    __device__ __forceinline__ void operator()(const pg8::f32x4 (&acc)[2][2][4][2], const pg8::Unit& u, int wr, int wc, int fr, int fq) const {
        const int row0 = u.pm * 256 + wr * 64 + fr, pn = u.pn, c8 = wc * 32 + 8 * fq;
        int mode; bf16_t* dst; int ld;
        if (pn < 4)       { mode = 0; dst = QL + pn * 256; ld = 1024; }
        else if (pn < 6)  { mode = 0; dst = QI + (pn - 4) * 256; ld = 512; }
        else if (pn == 6) { mode = 3; dst = KI; ld = 64; }
        else if (pn < 9)  { mode = 1; dst = UB + (pn - 7) * 256; ld = 512; }
        else if (pn < 11) { mode = 1; dst = VB + (pn - 9) * 256; ld = 512; }
        else if (pn < 15) { mode = 2; dst = GAB + (pn - 11) * 256; ld = 1024; }
        else              { mode = 2; dst = GBB + (pn - 15) * 256; ld = 1024; }
#pragma unroll
        for (int ai = 0; ai < 2; ++ai)
#pragma unroll
            for (int m = 0; m < 4; ++m) {
                const size_t row = (size_t)(row0 + ai * 128 + m * 16);
#pragma unroll
                for (int bj = 0; bj < 2; ++bj) {
                    pg8::f32x4 v0 = acc[ai][bj][m][0], v1 = acc[ai][bj][m][1];
                    if (mode == 3) {
                        if (bj == 0) { float* c = CKVR + row * 128 + c8; *(pg8::f32x4*)c = v0; *(pg8::f32x4*)(c + 4) = v1; }
                        else if (c8 < 64) st8bf(KI + row * 64 + c8, v0, v1);
                        else if (c8 == 64) { float* c = WI + row * 8; *(pg8::f32x4*)c = v0 * 0.044194174f; *(pg8::f32x4*)(c + 4) = v1 * 0.044194174f; }
                    } else {
                        if (mode == 1) {
#pragma unroll
                            for (int j = 0; j < 4; ++j) { v0[j] = gelu_t(v0[j]); v1[j] = gelu_t(v1[j]); }
                        } else if (mode == 2) {
#pragma unroll
                            for (int j = 0; j < 4; ++j) { v0[j] = sigm(v0[j]); v1[j] = sigm(v1[j]); }
                        }
                        if (pn < 4) st8q((unsigned char*)QL + row * 2048 + (pn * 2 + bj) * 256 + c8, v0, v1);
                        else st8bf(dst + row * ld + bj * 128 + c8, v0, v1);
                    }
                }
            }
    }
};

struct EpiMB {
    static constexpr bool PERM = true, AFTER_DRAIN = false;
    const bf16_t* G; bf16_t* O;
    __device__ __forceinline__ void operator()(const pg8::f32x4 (&acc)[2][2][4][2], const pg8::Unit& u, int wr, int wc, int fr, int fq) const {
        const int row0 = u.pm * 256 + wr * 64 + fr, col0 = u.pn * 256 + wc * 32 + 8 * fq;
#pragma unroll
        for (int ai = 0; ai < 2; ++ai)
#pragma unroll
            for (int m = 0; m < 4; ++m)
#pragma unroll
                for (int bj = 0; bj < 2; ++bj) {
                    const size_t o = (size_t)(row0 + ai * 128 + m * 16) * 1024 + col0 + bj * 128;
                    pg8::f32x4 g0, g1; ld8bf(G + o, g0, g1);
                    st8bf(O + o, acc[ai][bj][m][0] * g0, acc[ai][bj][m][1] * g1);
                }
    }
};
struct EpiMG {
    static constexpr bool PERM = true, AFTER_DRAIN = false;
    const bf16_t *G, *MBp; bf16_t* O;
    __device__ __forceinline__ void operator()(const pg8::f32x4 (&acc)[2][2][4][2], const pg8::Unit& u, int wr, int wc, int fr, int fq) const {
        const int row0 = u.pm * 256 + wr * 64 + fr, col0 = u.pn * 256 + wc * 32 + 8 * fq;
#pragma unroll
        for (int ai = 0; ai < 2; ++ai)
#pragma unroll
            for (int m = 0; m < 4; ++m)
#pragma unroll
                for (int bj = 0; bj < 2; ++bj) {
                    const size_t o = (size_t)(row0 + ai * 128 + m * 16) * 1024 + col0 + bj * 128;
                    pg8::f32x4 g0, g1, b0, b1; ld8bf(G + o, g0, g1); ld8bf(MBp + o, b0, b1);
                    st8bf(O + o, acc[ai][bj][m][0] * g0 + b0, acc[ai][bj][m][1] * g1 + b1);
                }
    }
};
struct EpiX1 {
    static constexpr bool PERM = true, AFTER_DRAIN = false;
    const float* X; float* O;
    __device__ __forceinline__ void operator()(const pg8::f32x4 (&acc)[2][2][4][2], const pg8::Unit& u, int wr, int wc, int fr, int fq) const {
        const int row0 = u.pm * 256 + wr * 64 + fr, col0 = u.pn * 256 + wc * 32 + 8 * fq;
#pragma unroll
        for (int ai = 0; ai < 2; ++ai)
#pragma unroll
            for (int m = 0; m < 4; ++m)
#pragma unroll
                for (int bj = 0; bj < 2; ++bj) {
                    const size_t o = (size_t)(row0 + ai * 128 + m * 16) * 1024 + col0 + bj * 128;
                    const pg8::f32x4 x0 = *(const pg8::f32x4*)(X + o), x1 = *(const pg8::f32x4*)(X + o + 4);
                    *(pg8::f32x4*)(O + o) = x0 + acc[ai][bj][m][0]; *(pg8::f32x4*)(O + o + 4) = x1 + acc[ai][bj][m][1];
                }
    }
};
struct EpiHE {
    static constexpr bool PERM = true, AFTER_DRAIN = false;
    bf16_t* HE; const int* PTOK; const float* RINV2;
    __device__ __forceinline__ void operator()(const pg8::f32x4 (&acc)[2][2][4][2], const pg8::Unit& u, int wr, int wc, int fr, int fq) const {
        const int row0 = u.pm * 256 + wr * 64 + fr, col0 = (u.pn & 1) * 128 + wc * 32 + 8 * fq;
#pragma unroll
        for (int ai = 0; ai < 2; ++ai) {
            int ts[4]; float ri[4];
#pragma unroll
            for (int m = 0; m < 4; ++m) ts[m] = PTOK[row0 + ai * 128 + m * 16];
#pragma unroll
            for (int m = 0; m < 4; ++m) ri[m] = RINV2[ts[m] < 0 ? 0 : (ts[m] >> 1)];
#pragma unroll
            for (int m = 0; m < 4; ++m) {
                const float r = ts[m] < 0 ? 0.f : ri[m];
                pg8::f32x4 h0, h1;
#pragma unroll
                for (int j = 0; j < 4; ++j) {
                    const float g0 = r * acc[ai][0][m][0][j], g1 = r * acc[ai][0][m][1][j];
                    h0[j] = g0 * sigm(g0) * (r * acc[ai][1][m][0][j]); h1[j] = g1 * sigm(g1) * (r * acc[ai][1][m][1][j]);
                }
                st8bf(HE + (size_t)(row0 + ai * 128 + m * 16) * 256 + col0, h0, h1);
            }
        }
    }
};
struct EpiDown {
    static constexpr bool PERM = true, AFTER_DRAIN = false;
    const int* PTOK; const float* EW; bf16_t* YS;
    __device__ __forceinline__ void operator()(const pg8::f32x4 (&acc)[2][2][4][2], const pg8::Unit& u, int wr, int wc, int fr, int fq) const {
        const int row0 = u.pm * 256 + wr * 64 + fr, col0 = (u.pn & 3) * 256 + wc * 32 + 8 * fq;
#pragma unroll
        for (int ai = 0; ai < 2; ++ai) {
            int ts[4]; float w[4];
#pragma unroll
            for (int m = 0; m < 4; ++m) ts[m] = PTOK[row0 + ai * 128 + m * 16];
#pragma unroll
            for (int m = 0; m < 4; ++m) w[m] = EW[ts[m] < 0 ? 0 : ts[m]];
#pragma unroll
            for (int m = 0; m < 4; ++m) {
                const int t = ts[m];
                if (t >= 0) {
                    bf16_t* d = YS + ((size_t)(t & 1) * M + (size_t)(t >> 1)) * 1024 + col0;
#pragma unroll
                    for (int bj = 0; bj < 2; ++bj) st8bf(d + bj * 128, acc[ai][bj][m][0] * w[m], acc[ai][bj][m][1] * w[m]);
                }
            }
        }
    }
};
constexpr int LDS_TAB_OFF = 155648;
__device__ __forceinline__ void table_prefetch(LAS unsigned char* lds, const int* tab, const int* nunits, int G, int c, int tid) {
    LAS int* lt = (LAS int*)(lds + LDS_TAB_OFF);
    if (tid < 16) { const int idx = (tid >> 1) * G + c; const int n = __builtin_nontemporal_load(nunits); lt[tid] = idx < n ? tab[2 * idx + (tid & 1)] : -1; }
    __syncthreads();
}
struct TableOrder {
    static constexpr bool GATHER = false;
    const int* tab; const int* nunits; int G, c; const LAS int* lt;
    __device__ __forceinline__ int arow(int r) const { return r; }
    __device__ __forceinline__ bool next(int i, pg8::Unit& u) const {
        if (i < 8) { const int a = lt[2 * i]; if (a < 0) return false; u.pm = a; u.pn = lt[2 * i + 1]; return true; }
        const int idx = i * G + c; const int n = __builtin_nontemporal_load(nunits);
        if (idx >= n) return false;
        u.pm = tab[2 * idx]; u.pn = tab[2 * idx + 1]; return true;
    }
    __device__ __forceinline__ void a_ready(const pg8::Unit&) const {}
    __device__ __forceinline__ void done(const pg8::Unit&) const {}
};

struct TableGatherOrder {
    static constexpr bool GATHER = true;
    const int* tab; const int* nunits; const int* ptok; int G, c; const LAS int* lt;
    __device__ __forceinline__ bool next(int i, pg8::Unit& u) const {
        if (i < 8) { const int a = lt[2 * i]; if (a < 0) return false; u.pm = a; u.pn = lt[2 * i + 1]; return true; }
        const int idx = i * G + c; const int n = __builtin_nontemporal_load(nunits);
        if (idx >= n) return false;
        u.pm = tab[2 * idx]; u.pn = tab[2 * idx + 1]; return true;
    }
    __device__ __forceinline__ int arow(int r) const { const int ts = ptok[r]; return ts < 0 ? 0 : (ts >> 1); }
    __device__ __forceinline__ void a_ready(const pg8::Unit&) const {}
    __device__ __forceinline__ void done(const pg8::Unit&) const {}
};

__device__ __forceinline__ void tr_item(const float* src, int ld, int K, int NC, bf16_t* dst, LAS float* scr, int item, int lane) {
    const int nblk = NC / 32, kb = item / nblk, nb = item % nblk, k0 = 64 * kb, n0 = 32 * nb;
    f32x4 tv[8];
    const int tr = lane >> 3, tc = (lane & 7) * 4;
    if ((((size_t)src) & 15) == 0 && (ld & 3) == 0) {
#pragma unroll
        for (int i = 0; i < 8; ++i) tv[i] = *(const f32x4*)(src + (size_t)(k0 + 8 * i + tr) * ld + n0 + tc);
    } else {
#pragma unroll
        for (int i = 0; i < 8; ++i) { const float* q = src + (size_t)(k0 + 8 * i + tr) * ld + n0 + tc; tv[i] = (f32x4){q[0], q[1], q[2], q[3]}; }
    }
#pragma unroll
    for (int i = 0; i < 8; ++i) { LAS float* d = scr + (8 * i + tr) * 33 + tc; d[0] = tv[i].x; d[1] = tv[i].y; d[2] = tv[i].z; d[3] = tv[i].w; }
    LDS_WAIT();
    const int c = lane & 7;
#pragma unroll
    for (int j = 0; j < 4; ++j) { const int n = (lane >> 3) + 8 * j; const LAS float* s = scr + (8 * c) * 33 + n;
        u32x4 o; o.x = pk2(s[0 * 33], s[1 * 33]); o.y = pk2(s[2 * 33], s[3 * 33]); o.z = pk2(s[4 * 33], s[5 * 33]); o.w = pk2(s[6 * 33], s[7 * 33]);
        *(u32x4*)(dst + (size_t)(n0 + n) * K + k0 + 8 * c) = o; }
    LDS_WAIT();
}

__device__ __forceinline__ void prep_gateup(const P& p, LAS unsigned char* lds, int w_idx, int nw, int wave, int lane) {
    LAS float* scr = (LAS float*)(lds + wave * 16384);
    for (int it = w_idx; it < 8192; it += nw) {
        const int sub = it & 63, q = it >> 6, gu = q & 1, j = (q >> 1) & 1, e = q >> 2;
        const float* src = (gu ? p.w_up : p.w_gate) + (size_t)e * 262144 + 128 * j;
        tr_item(src, 256, 1024, 128, p.WguT + ((size_t)e * 512 + j * 256 + gu * 128) * 1024, scr, sub, lane);
    }
}

__device__ __forceinline__ void ph_prep(const P& p, LAS unsigned char* lds, const int wv) {
    const int tid = opaque_tid(wv), lane = tid & 63, wave = __builtin_amdgcn_readfirstlane(tid >> 6);
    LAS float* scr = (LAS float*)(lds + wave * 16384);
    const int gw = blockIdx.x * NWAVES + wave, NGW = gridDim.x * NWAVES;
    const int gt = blockIdx.x * NTHR + tid, NGT = gridDim.x * NTHR;
    {
        const int c0s[7] = {640, 512, 1152, 1224, 1736, 2248, 3272};
        const int ncs[7] = {512, 128, 64, 512, 512, 1024, 1024};
        const int r0s[7] = {1024, 1536, 1664, 1792, 2304, 2816, 3840};
#pragma unroll
        for (int s = 0; s < 7; ++s) {
            const int nit = 16 * (ncs[s] / 32);
            for (int it = gw; it < nit; it += NGW) tr_item(p.w_in + c0s[s], INC, 1024, ncs[s], p.WinT + (size_t)r0s[s] * 1024, scr, it, lane);
        }
    }
    for (int i = gt; i < 64 * 1024; i += NGT) { const int j = i >> 10, k = i & 1023; p.WinT[(size_t)(1728 + j) * 1024 + k] = j < 8 ? (bf16_t)f2bf(p.w_in[(size_t)k * INC + 1216 + j]) : (bf16_t)0; }
    for (int it = gw; it < 512; it += NGW) tr_item(p.w_out, 1024, 1024, 1024, p.WoutT, scr, it, lane);
    for (int it = gw; it < 256; it += NGW) tr_item(p.w_pb, 1024, 512, 1024, p.WpbT, scr, it, lane);
    for (int it = gw; it < 4096; it += NGW) { const int sub = it & 127, e = it >> 7; tr_item(p.w_down + (size_t)e * 262144, 1024, 256, 1024, p.WdT + (size_t)e * 262144, scr, sub, lane); }
    for (int it = gw; it < 1024; it += NGW) {
        const int h = it >> 7, kt = (it >> 2) & 31, rt = it & 3, i = lane & 31, hf = lane >> 5;
        const f32x4* ap = (const f32x4*)(p.w_in + (size_t)(kt * 32 + i) * INC + h * 64 + 32 * hf);
        const f32x4* bp = (const f32x4*)(p.w_uk + (size_t)((rt * 32 + i) * 8 + h) * 64 + 32 * hf);
        f32x4 av[8], bv[8];
#pragma unroll
        for (int j = 0; j < 8; ++j) { av[j] = ap[j]; bv[j] = bp[j]; }
        f32x16 acc;
#pragma unroll
        for (int j = 0; j < 16; ++j) acc[j] = 0.f;
#pragma unroll
        for (int j = 0; j < 8; ++j)
#pragma unroll
            for (int e = 0; e < 4; ++e) acc = __builtin_amdgcn_mfma_f32_32x32x2f32(av[j][e], bv[j][e], acc, 0, 0, 0);
#pragma unroll
        for (int g4 = 0; g4 < 4; ++g4) {
            constexpr float QS = 0.125f * 1.4426950409f;
            u32x2 w; w.x = pk2(QS * acc[4 * g4], QS * acc[4 * g4 + 1]); w.y = pk2(QS * acc[4 * g4 + 2], QS * acc[4 * g4 + 3]);
            *(u32x2*)(p.WinT + (size_t)(h * 128 + rt * 32 + i) * 1024 + kt * 32 + 8 * g4 + 4 * hf) = w;
        }
    }
    for (int it = gw; it < 1024; it += NGW) {
        const int h = it >> 7, nt = (it >> 2) & 31, rt = it & 3, i = lane & 31, hf = lane >> 5;
        const f32x4* ap = (const f32x4*)(p.w_uv + (size_t)((rt * 32 + i) * 8 + h) * 64 + 32 * hf);
        const float* bp = p.w_pa + (size_t)(h * 64 + 32 * hf) * 1024 + nt * 32 + i;
        f32x4 av[8]; float bv[32];
#pragma unroll
        for (int j = 0; j < 8; ++j) av[j] = ap[j];
#pragma unroll
        for (int j = 0; j < 32; ++j) bv[j] = bp[(size_t)j * 1024];
        f32x16 acc;
#pragma unroll
        for (int j = 0; j < 16; ++j) acc[j] = 0.f;
#pragma unroll
        for (int j = 0; j < 8; ++j)
#pragma unroll
            for (int e = 0; e < 4; ++e) acc = __builtin_amdgcn_mfma_f32_32x32x2f32(av[j][e], bv[4 * j + e], acc, 0, 0, 0);
#pragma unroll
        for (int g4 = 0; g4 < 4; ++g4) {
            u32x2 w; w.x = pk2(acc[4 * g4], acc[4 * g4 + 1]); w.y = pk2(acc[4 * g4 + 2], acc[4 * g4 + 3]);
            *(u32x2*)(p.WovT + (size_t)(nt * 32 + i) * 1024 + h * 128 + rt * 32 + 8 * g4 + 4 * hf) = w;
        }
    }
    for (int i = gt; i < 4 * 128 * 128; i += NGT) { const int jj = i & 127, ii = (i >> 7) & 127; p.WSB[i] = jj <= ii ? (bf16_t)f2bf(p.w_sp[i]) : (bf16_t)0; }
    for (int i = gt; i < 36 * 1024; i += NGT) { const int c = i >> 10, k = i & 1023; p.WrT[i] = c < 4 ? p.rg_w[k * 4 + c] : p.re_w[k * 32 + (c - 4)]; }
    for (int m4 = gw; m4 < M / 4; m4 += NGW) {
        f32x4 v[4][4]; float ss[4];
#pragma unroll
        for (int r = 0; r < 4; ++r) { const f32x4* xr = (const f32x4*)(p.x + (size_t)(4 * m4 + r) * D) + lane;
#pragma unroll
            for (int j = 0; j < 4; ++j) v[r][j] = xr[64 * j]; }
#pragma unroll
        for (int r = 0; r < 4; ++r) { ss[r] = 0.f;
#pragma unroll
            for (int j = 0; j < 4; ++j) ss[r] += (v[r][j].x * v[r][j].x + v[r][j].y * v[r][j].y) + (v[r][j].z * v[r][j].z + v[r][j].w * v[r][j].w); }
#pragma unroll
        for (int o = 1; o < 64; o <<= 1) {
#pragma unroll
            for (int r = 0; r < 4; ++r) ss[r] += __shfl_xor(ss[r], o);
        }
#pragma unroll
        for (int r = 0; r < 4; ++r) {
            const float rinv = 1.0f / sqrtf(ss[r] * (1.f / D) + EPS);
            unsigned long long* o8 = (unsigned long long*)(p.HB + (size_t)(4 * m4 + r) * D) + lane;
#pragma unroll
            for (int j = 0; j < 4; ++j) { const f32x4 g = ((const f32x4*)p.n1g)[lane + 64 * j]; const f32x4 o = v[r][j] * rinv * g;
                o8[64 * j] = (unsigned long long)pk2(o.x, o.y) | ((unsigned long long)pk2(o.z, o.w) << 32); }
        }
    }
}

__device__ __forceinline__ void ph_ckvnorm(const P& p, const int wv) {
    const int tid = opaque_tid(wv), lane = tid & 63, wave = tid >> 6;
    const int gw = blockIdx.x * NWAVES + wave, NGW = gridDim.x * NWAVES;
    const float g0 = p.kv_g[2 * lane], g1 = p.kv_g[2 * lane + 1];
    for (int m4 = gw; m4 < M / 4; m4 += NGW) {
        float2 v[4]; float ss[4];
#pragma unroll
        for (int r = 0; r < 4; ++r) v[r] = ((const float2*)(p.CKVR + (size_t)(4 * m4 + r) * 128))[lane];
#pragma unroll
        for (int r = 0; r < 4; ++r) ss[r] = v[r].x * v[r].x + v[r].y * v[r].y;
#pragma unroll
        for (int o = 1; o < 64; o <<= 1) {
#pragma unroll
            for (int r = 0; r < 4; ++r) ss[r] += __shfl_xor(ss[r], o);
        }
#pragma unroll
        for (int r = 0; r < 4; ++r) { const float rinv = 1.0f / sqrtf(ss[r] * (1.f / 128.f) + EPS);
            const float c0 = fminf(fmaxf(v[r].x * rinv * g0, -440.f), 440.f), c1 = fminf(fmaxf(v[r].y * rinv * g1, -440.f), 440.f);
            ((unsigned short*)((unsigned char*)p.CKVB + (size_t)(4 * m4 + r) * 128))[lane] = (unsigned short)__builtin_amdgcn_cvt_pk_fp8_f32(c0, c1, 0, false); }
    }
}

typedef int i32x8 __attribute__((ext_vector_type(8)));
#ifndef ATT_SKEW
#define ATT_SKEW 10
#endif
__device__ __forceinline__ bf16x4 tr16(const LAS unsigned char* a) { return __builtin_amdgcn_ds_read_tr16_b64_v4i16((LAS bf16x4*)a); }
__device__ __forceinline__ unsigned att_f(unsigned row) { return ((row >> 1) & 3u) | ((((row >> 2) ^ (row >> 4)) & 1u) << 2); }
__device__ __forceinline__ float vmax3(float a, float b, float c) { float r; asm("v_max3_f32 %0, %1, %2, %3" : "=v"(r) : "v"(a), "v"(b), "v"(c)); return r; }
__device__ __forceinline__ float vmax2(float a, float b) { float r; asm("v_max_f32 %0, %1, %2" : "=v"(r) : "v"(a), "v"(b)); return r; }
__device__ __forceinline__ float ror8(float x) { return __int_as_float(__builtin_amdgcn_update_dpp(0, __float_as_int(x), 0x128, 0xf, 0xf, false)); }
__device__ __forceinline__ float xmax16(float x) {
    auto a = __builtin_amdgcn_permlane16_swap(__float_as_uint(x), __float_as_uint(x), false, false);
    const float y = vmax2(__uint_as_float(a[0]), __uint_as_float(a[1]));
    auto b = __builtin_amdgcn_permlane32_swap(__float_as_uint(y), __float_as_uint(y), false, false);
    return vmax2(__uint_as_float(b[0]), __uint_as_float(b[1]));
}
template <int STRIP>
__device__ __forceinline__ void ph_attn_t(const P& p, LAS unsigned char* lds, const int wv) {
    const int tid = opaque_tid(wv), lane = tid & 63, wave = __builtin_amdgcn_readfirstlane(tid >> 6);
    LAS unsigned char* buf = lds + wave * 16384;
    LAS unsigned char* selL = lds + 131072 + wave * 3072;
    LAS unsigned char* selT = selL + 1024;
    LAS unsigned char* bias = lds + 155648;
    for (int i = tid; i < 1024; i += NTHR) {
        const int d = i >> 3; int bk = d;
        if (d >= 16) { const float nf = (float)d; bk = 16 + (int)(logf(nf / 16.f) / 2.0794415f * 16.f); if (bk > 31) bk = 31; }
        ((LAS float*)bias)[i] = 1.4426950409f * p.rel_bias[bk * 8 + (i & 7)];
    }
    __syncthreads();
    const int g = lane >> 4, hcol = lane & 15, r8 = lane >> 3, pc = lane & 7;
    const int G = gridDim.x, bx = blockIdx.x, vcu = (G % 8 == 0) ? (bx % 8) * (G / 8) + bx / 8 : bx;
    const unsigned so0 = 16u * ((unsigned)pc ^ att_f((unsigned)r8)), so1 = so0 ^ 64u;
    unsigned qka[2][2], tra[8];
#pragma unroll
    for (int tau = 0; tau < 2; ++tau)
#pragma unroll
        for (int r = 0; r < 2; ++r) { const unsigned row = hcol + 16 * tau; qka[tau][r] = (unsigned)(size_t)buf + row * 128u + 16u * ((2u * g + r) ^ att_f(row)); }
    {   const unsigned q = (lane & 15) >> 1, row = q < 4 ? 4 * g + q : 16 + 4 * g + (q - 4);
#pragma unroll
        for (int rt = 0; rt < 8; ++rt) tra[rt] = (unsigned)(size_t)buf + row * 128u + 16u * ((unsigned)rt ^ att_f(row)) + 8u * (lane & 1);
    }
    const unsigned biasl = (unsigned)(size_t)bias + 4u * (hcol & 7);
    const unsigned qoff = (unsigned)((hcol & 7) * 256 + 32 * g + (hcol >> 3) * 128), svoff = 8u * (unsigned)lane;
    const long ones8 = 0x3838383838383838L;
#define ATT_Q_LOAD(mm) do { const unsigned char* qb = (const unsigned char*)p.QL + (size_t)(mm) * 2048;            \
        asm volatile("global_load_dwordx4 %0, %1, %2" : "=v"(qn0) : "v"(qoff), "s"(qb)); asm volatile("global_load_dwordx4 %0, %1, %2 offset:16" : "=v"(qn1) : "v"(qoff), "s"(qb)); } while (0)
#define ATT_SV_LOAD(mm) do { const unsigned short* sb = p.SEL + (size_t)(mm) * 256; asm volatile("global_load_dwordx2 %0, %1, %2" : "=v"(sv) : "v"(svoff), "s"(sb)); } while (0)
#define ATT_DMA_CHUNK(img_, selt_, c_) do { const u32x4 k4 = *(const LAS u32x4*)((selt_) + 128 * (c_) + 16 * r8);        \
        __builtin_amdgcn_global_load_lds((const unsigned*)(ckb + (k4.x + so0)), (LAS unsigned*)(img_), 16, 0, 0); \
        __builtin_amdgcn_global_load_lds((const unsigned*)(ckb + (k4.y + so0)), (LAS unsigned*)((img_) + 1024), 16, 0, 0); \
        __builtin_amdgcn_global_load_lds((const unsigned*)(ckb + (k4.z + so1)), (LAS unsigned*)((img_) + 2048), 16, 0, 0); \
        __builtin_amdgcn_global_load_lds((const unsigned*)(ckb + (k4.w + so1)), (LAS unsigned*)((img_) + 3072), 16, 0, 0); } while (0)
#define ATT_SEL_WRITE(par_, sv_, tq_) do { \
        const int k0 = (int)((sv_).x & 0xffffu), k1 = (int)((sv_).x >> 16), k2 = (int)((sv_).y & 0xffffu), k3 = (int)((sv_).y >> 16); \
        const int d0 = min((tq_) - k0, 127), d1 = min((tq_) - k1, 127), d2 = min((tq_) - k2, 127), d3 = min((tq_) - k3, 127); \
        u32x2 dw; dw.x = (unsigned)(d0 * 32) | ((unsigned)(d1 * 32) << 16); dw.y = (unsigned)(d2 * 32) | ((unsigned)(d3 * 32) << 16); \
        *(LAS u32x2*)(selL + (par_) * 512 + lane * 8) = dw; \
        LAS unsigned* tq = (LAS unsigned*)(selT + (par_) * 1024) + (lane >> 3) * 32 + (4 * (lane & 1)) * 4 + ((lane & 7) >> 1); \
        tq[0] = (unsigned)k0 * 128u; tq[4] = (unsigned)k1 * 128u; tq[8] = (unsigned)k2 * 128u; tq[12] = (unsigned)k3 * 128u; } while (0)
    for (int qc = vcu; qc < M / 128; qc += G) {
        const int m0 = qc * 128 + wave * 16;
        const size_t mb = (size_t)(m0 >> 12) * T;
        const unsigned char* ckb = (const unsigned char*)p.CKVB + mb * 128;
        u32x2 sv; u32x4 qn0, qn1; i32x8 qh;
        ATT_SV_LOAD(m0);
        ATT_Q_LOAD(m0);
        asm volatile("s_waitcnt vmcnt(0)" ::: "memory");
        asm volatile("" : "+v"(qn0), "+v"(qn1), "+v"(sv));
        ATT_SEL_WRITE(0, sv, m0 & (T - 1));
        LDS_WAIT();
        ATT_DMA_CHUNK(buf, selT, 0);
        ATT_DMA_CHUNK(buf + 4096, selT, 1);
        __builtin_amdgcn_sched_barrier(0);
        ATT_SV_LOAD(m0 + 1);
        f32x4 o[8], ls; float mref = -1e30f;
#pragma unroll
        for (int rt = 0; rt < 8; ++rt) o[rt] = (f32x4){0.f, 0.f, 0.f, 0.f};
        ls = (f32x4){0.f, 0.f, 0.f, 0.f};
#define ATT_BODY(cp_) do { \
            const int m = m0 + qi, t = m & (T - 1); \
            const LAS unsigned char* selc = selL + (qi & 1) * 512; \
            if ((cp_) == 0) qh = (i32x8){(int)qn0.x, (int)qn0.y, (int)qn0.z, (int)qn0.w, (int)qn1.x, (int)qn1.y, (int)qn1.z, (int)qn1.w}; \
            if (STRIP >= 2) { } \
            else if ((cp_) < 3) { ATT_DMA_CHUNK(buf + (((cp_) + 1) & 1) * 8192, selT + (qi & 1) * 1024, 2 * (cp_) + 2); ATT_DMA_CHUNK(buf + (((cp_) + 1) & 1) * 8192 + 4096, selT + (qi & 1) * 1024, 2 * (cp_) + 3); \
                __builtin_amdgcn_sched_barrier(0); \
                if ((cp_) == 0) { if (qi == 0) asm volatile("s_waitcnt vmcnt(8)" ::: "memory"); else asm volatile("s_waitcnt vmcnt(16)" ::: "memory"); } \
                else if ((cp_) == 1) { if (qi < 15) asm volatile("s_waitcnt vmcnt(10)" ::: "memory"); else asm volatile("s_waitcnt vmcnt(8)" ::: "memory"); } \
                else { if (qi < 14) asm volatile("s_waitcnt vmcnt(9)" ::: "memory"); else asm volatile("s_waitcnt vmcnt(8)" ::: "memory"); } } \
            else if (qi < 15) { ATT_DMA_CHUNK(buf, selT + ((qi + 1) & 1) * 1024, 0); ATT_DMA_CHUNK(buf + 4096, selT + ((qi + 1) & 1) * 1024, 1); \
                __builtin_amdgcn_sched_barrier(0); asm volatile("s_waitcnt vmcnt(8)" ::: "memory"); } \
            else { __builtin_amdgcn_sched_barrier(0); asm volatile("s_waitcnt vmcnt(0)" ::: "memory"); } \
            __builtin_amdgcn_sched_barrier(0); \
              \
              \
            if ((cp_) == 2 && qi < 15) asm volatile("" : "+v"(qn0), "+v"(qn1)); \
            if ((cp_) == 3 && qi < 14) asm volatile("" : "+v"(sv)); \
            if (STRIP == 1) break; \
              \
            i32x8 af[2][2]; u32x2 kk[2][2]; \
            _Pragma("unroll") for (int h = 0; h < 2; ++h) _Pragma("unroll") for (int tau = 0; tau < 2; ++tau) { \
                kk[h][tau] = *(const LAS u32x2*)(selc + 2 * (64 * (cp_) + 32 * h + 16 * tau + 4 * g)); \
                const u32x4 a0 = *(const LAS u32x4*)(size_t)(qka[tau][0] + ((cp_) & 1) * 8192 + h * 4096), a1 = *(const LAS u32x4*)(size_t)(qka[tau][1] + ((cp_) & 1) * 8192 + h * 4096); \
                af[h][tau] = (i32x8){(int)a0.x, (int)a0.y, (int)a0.z, (int)a0.w, (int)a1.x, (int)a1.y, (int)a1.z, (int)a1.w}; } \
              \
            long ta[2][8]; \
            if (STRIP == 4) { _Pragma("unroll") for (int rt = 0; rt < 8; ++rt) { ta[0][rt] = 0; ta[1][rt] = 0; } } else \
            _Pragma("unroll") for (int rt = 0; rt < 8; ++rt) { \
                if (((cp_) & 1) == 0) { asm volatile("ds_read_b64_tr_b8 %0, %1" : "=v"(ta[0][rt]) : "v"(tra[rt])); asm volatile("ds_read_b64_tr_b8 %0, %1 offset:4096" : "=v"(ta[1][rt]) : "v"(tra[rt])); } \
                else { asm volatile("ds_read_b64_tr_b8 %0, %1 offset:8192" : "=v"(ta[0][rt]) : "v"(tra[rt])); asm volatile("ds_read_b64_tr_b8 %0, %1 offset:12288" : "=v"(ta[1][rt]) : "v"(tra[rt])); } \
            } \
            float bv[2][2][4]; \
            if (STRIP == 3) { _Pragma("unroll") for (int h = 0; h < 2; ++h) _Pragma("unroll") for (int tau = 0; tau < 2; ++tau) { bv[h][tau][0] = __uint_as_float(kk[h][tau].x); bv[h][tau][1] = __uint_as_float(kk[h][tau].y); bv[h][tau][2] = 1.f; bv[h][tau][3] = 2.f; } } else \
            _Pragma("unroll") for (int h = 0; h < 2; ++h) _Pragma("unroll") for (int tau = 0; tau < 2; ++tau) { \
                bv[h][tau][0] = *(const LAS float*)(size_t)(biasl + (kk[h][tau].x & 0xffffu)); bv[h][tau][1] = *(const LAS float*)(size_t)(biasl + (kk[h][tau].x >> 16)); \
                bv[h][tau][2] = *(const LAS float*)(size_t)(biasl + (kk[h][tau].y & 0xffffu)); bv[h][tau][3] = *(const LAS float*)(size_t)(biasl + (kk[h][tau].y >> 16)); } \
            if ((cp_) == 0 && qi < 15) ATT_Q_LOAD(m + 1); \
            if ((cp_) == 1 && qi < 15) { \
                ATT_SEL_WRITE((qi + 1) & 1, sv, (m + 1) & (T - 1)); \
                if (qi < 14) ATT_SV_LOAD(m + 2); \
            } \
            __builtin_amdgcn_sched_barrier(0); \
            f32x4 acc[2][2]; \
            if (STRIP == 6) { _Pragma("unroll") for (int h = 0; h < 2; ++h) _Pragma("unroll") for (int tau = 0; tau < 2; ++tau) acc[h][tau] = (f32x4){__int_as_float(af[h][tau][0]), __int_as_float(af[h][tau][1]), __int_as_float(af[h][tau][4]), __int_as_float(af[h][tau][5])}; } else { \
            _Pragma("unroll") for (int h = 0; h < 2; ++h) _Pragma("unroll") for (int tau = 0; tau < 2; ++tau) \
                acc[h][tau] = __builtin_amdgcn_mfma_scale_f32_16x16x128_f8f6f4(af[h][tau], qh, (f32x4){0.f, 0.f, 0.f, 0.f}, 0, 0, 0, 0, 0, 0); } \
            float sc[2][2][4]; \
            _Pragma("unroll") for (int h = 0; h < 2; ++h) _Pragma("unroll") for (int tau = 0; tau < 2; ++tau) _Pragma("unroll") for (int r = 0; r < 4; ++r) \
                sc[h][tau][r] = fmaf(acc[h][tau][r] + ror8(acc[h][tau][r]), 0.0625f, bv[h][tau][r]);        \
            if (t < 255) {                                           \
                _Pragma("unroll") for (int h = 0; h < 2; ++h) _Pragma("unroll") for (int tau = 0; tau < 2; ++tau) _Pragma("unroll") for (int r = 0; r < 4; ++r) \
                    if (64 * (cp_) + 32 * h + 16 * tau + 4 * g + r > t) sc[h][tau][r] = -1e30f; \
            } \
            const float mxa = vmax3(vmax3(sc[0][0][0], sc[0][0][1], sc[0][0][2]), vmax3(sc[0][0][3], sc[0][1][0], sc[0][1][1]), vmax3(sc[0][1][2], sc[0][1][3], sc[1][0][0])); \
            const float mxb = vmax3(vmax3(sc[1][0][1], sc[1][0][2], sc[1][0][3]), vmax3(sc[1][1][0], sc[1][1][1], sc[1][1][2]), sc[1][1][3]); \
            const float mx = xmax16(vmax2(mxa, mxb)); \
            if ((cp_) == 0) mref = mx; \
            else if (__builtin_amdgcn_ballot_w64(mx > mref + 3.0f) != 0) {                         \
                const float mn = vmax2(mref, mx), rs = __builtin_amdgcn_exp2f(mref - mn); mref = mn; \
                _Pragma("unroll") for (int rt = 0; rt < 8; ++rt) o[rt] *= rs; \
                ls *= rs; \
            } \
            const float mo = mref - 5.0f; \
            long pf[2]; \
            _Pragma("unroll") for (int h = 0; h < 2; ++h) { float pr[2][4]; \
                _Pragma("unroll") for (int tau = 0; tau < 2; ++tau) _Pragma("unroll") for (int r = 0; r < 4; ++r) pr[tau][r] = STRIP == 5 ? sc[h][tau][r] : __builtin_amdgcn_exp2f(sc[h][tau][r] - mo); \
                u32x2 pw; \
                pw.x = (unsigned)__builtin_amdgcn_cvt_pk_fp8_f32(pr[0][0], pr[0][1], 0, false); pw.x = (unsigned)__builtin_amdgcn_cvt_pk_fp8_f32(pr[0][2], pr[0][3], (int)pw.x, true); \
                pw.y = (unsigned)__builtin_amdgcn_cvt_pk_fp8_f32(pr[1][0], pr[1][1], 0, false); pw.y = (unsigned)__builtin_amdgcn_cvt_pk_fp8_f32(pr[1][2], pr[1][3], (int)pw.y, true); \
                pf[h] = __builtin_bit_cast(long, pw); } \
            asm volatile("s_waitcnt lgkmcnt(0)" : "+v"(ta[0][0]), "+v"(ta[0][1]), "+v"(ta[0][2]), "+v"(ta[0][3]), "+v"(ta[0][4]), "+v"(ta[0][5]), "+v"(ta[0][6]), "+v"(ta[0][7])); \
            asm volatile("" : "+v"(ta[1][0]), "+v"(ta[1][1]), "+v"(ta[1][2]), "+v"(ta[1][3]), "+v"(ta[1][4]), "+v"(ta[1][5]), "+v"(ta[1][6]), "+v"(ta[1][7])); \
            if (STRIP == 4) { o[0][0] += __uint_as_float((unsigned)pf[0]); o[1][0] += __uint_as_float((unsigned)pf[1]); } else \
            _Pragma("unroll") for (int h = 0; h < 2; ++h) { \
                _Pragma("unroll") for (int rt = 0; rt < 8; ++rt) o[rt] = __builtin_amdgcn_mfma_f32_16x16x32_fp8_fp8(ta[h][rt], pf[h], o[rt], 0, 0, 0); \
                ls = __builtin_amdgcn_mfma_f32_16x16x32_fp8_fp8(ones8, pf[h], ls, 0, 0, 0); } \
            if ((cp_) == 3) { \
                const float inv = __builtin_amdgcn_rcpf(ls[0]); \
                if (hcol < 8) { \
                    _Pragma("unroll") for (int rt = 0; rt < 8; ++rt) { \
                        u32x2 w; w.x = pg8::cvt_pk_bf16(o[rt][0] * inv, o[rt][1] * inv); w.y = pg8::cvt_pk_bf16(o[rt][2] * inv, o[rt][3] * inv); \
                        *(u32x2*)(p.OL + (size_t)m * 1024 + hcol * 128 + 16 * rt + 4 * g) = w; \
                    } \
                } \
                _Pragma("unroll") for (int rt = 0; rt < 8; ++rt) o[rt] = (f32x4){0.f, 0.f, 0.f, 0.f}; \
                ls = (f32x4){0.f, 0.f, 0.f, 0.f}; \
            } } while (0)
        if (wave >= 4) { __builtin_amdgcn_s_sleep(ATT_SKEW); }
#pragma unroll 1
        for (int qi = 0; qi < 16; ++qi) {
            ATT_BODY(0); ATT_BODY(1); ATT_BODY(2); ATT_BODY(3);
        }
#undef ATT_BODY
        asm volatile("s_waitcnt vmcnt(0)" ::: "memory");
    }
#undef ATT_DMA_CHUNK
#undef ATT_SEL_WRITE
#undef ATT_Q_LOAD
}

__device__ __forceinline__ unsigned q16of(float x) { return (unsigned)(int)__builtin_fminf(__builtin_fmaxf((x + 8.0f) * 4096.0f, 0.0f), 65535.0f); }

__device__ __forceinline__ void select_row7(const LAS unsigned short* row, int n, LAS unsigned* hist, LAS unsigned* h2, unsigned short* out, int lane) {
    if (n <= 256) {
#pragma unroll
        for (int i = 0; i < 4; ++i) { const int k = lane + 64 * i; out[k] = (unsigned short)(k < n ? k : 0); }
#pragma unroll
        for (int i = 0; i < 8; ++i) hist[lane + 64 * i] = 0u;
        return;
    }
    const unsigned long long lt = (1ull << lane) - 1ull;
    unsigned b1, above;
    {
        const u32x4 w0 = *(const LAS u32x4*)(hist + 8 * lane), w1 = *(const LAS u32x4*)(hist + 8 * lane + 4);
        unsigned c[16];
        c[0] = w0.x & 0xffffu; c[1] = w0.x >> 16; c[2] = w0.y & 0xffffu; c[3] = w0.y >> 16; c[4] = w0.z & 0xffffu; c[5] = w0.z >> 16; c[6] = w0.w & 0xffffu; c[7] = w0.w >> 16;
        c[8] = w1.x & 0xffffu; c[9] = w1.x >> 16; c[10] = w1.y & 0xffffu; c[11] = w1.y >> 16; c[12] = w1.z & 0xffffu; c[13] = w1.z >> 16; c[14] = w1.w & 0xffffu; c[15] = w1.w >> 16;
        unsigned s = 0;
#pragma unroll
        for (int j = 0; j < 16; ++j) s += c[j];
        unsigned incl = s;
#pragma unroll
        for (int o = 1; o < 64; o <<= 1) { const unsigned t = __shfl_down(incl, o); if (lane + o < 64) incl += t; }
        const unsigned excl = incl - s;
        const bool mine = (excl < 256u) && (incl >= 256u);
        unsigned bin = 0, ab = 0, run = excl; bool found = false;
#pragma unroll
        for (int j = 15; j >= 0; --j) { if (!found && run + c[j] >= 256u) { bin = 16 * lane + j; ab = run; found = true; } if (!found) run += c[j]; }
        const unsigned long long bm = __ballot(mine);
        const int src = bm ? (int)__builtin_ctzll(bm) : 0;
        b1 = __shfl(bin, src); above = __shfl(ab, src);
    }
    LDS_WAIT();
    int need = 256 - (int)above;
    LAS unsigned short* cand = (LAS unsigned short*)hist;
    const int nblk = (n + 255) >> 8;
    const unsigned thr = b1 << 6;
    int C = 0;
    u32x2 vn = *(const LAS u32x2*)(row + 4 * lane);
    for (int blk = 0; blk < nblk; ++blk) {
        const u32x2 v = vn;
        if (blk + 1 < nblk) vn = *(const LAS u32x2*)(row + (blk + 1) * 256 + 4 * lane);
        const unsigned q[4] = {v.x & 0xffffu, v.x >> 16, v.y & 0xffffu, v.y >> 16};
        bool ge[4]; unsigned long long bl[4];
#pragma unroll
        for (int e = 0; e < 4; ++e) { ge[e] = (blk * 256 + 4 * lane + e < n) && (q[e] >= thr); bl[e] = __ballot(ge[e]); }
        const int below = __builtin_popcountll(bl[0] & lt) + __builtin_popcountll(bl[1] & lt) + __builtin_popcountll(bl[2] & lt) + __builtin_popcountll(bl[3] & lt);
        int pos = C + below;
#pragma unroll
        for (int e = 0; e < 4; ++e) { if (ge[e]) { if (pos < 768) cand[pos] = (unsigned short)(blk * 256 + 4 * lane + e); ++pos; } }
        C += __builtin_popcountll(bl[0]) + __builtin_popcountll(bl[1]) + __builtin_popcountll(bl[2]) + __builtin_popcountll(bl[3]);
    }
    LDS_WAIT();
    LAS unsigned short* outL = cand + 768;
    if (C <= 512) {
        int ci[8]; unsigned cq[8]; bool ceq[8];
#pragma unroll
        for (int k = 0; k < 8; ++k) { const int j = lane + 64 * k; ci[k] = j < C ? (int)cand[j] : -1; }
#pragma unroll
        for (int k = 0; k < 8; ++k) { cq[k] = ci[k] >= 0 ? (unsigned)row[ci[k]] : 0u; ceq[k] = ci[k] >= 0 && (cq[k] >> 6) == b1; }
        h2[lane] = 0u;
        LDS_WAIT();
#pragma unroll
        for (int k = 0; k < 8; ++k) if (ceq[k]) __hip_atomic_fetch_add(h2 + (cq[k] & 63u), 1u, __ATOMIC_RELAXED, __HIP_MEMORY_SCOPE_WORKGROUP);
        LDS_WAIT();
        const unsigned cme = h2[lane];
        unsigned incl = cme;
#pragma unroll
        for (int o = 1; o < 64; o <<= 1) { const unsigned t = __shfl_down(incl, o); if (lane + o < 64) incl += t; }
        const unsigned excl = incl - cme;
        const bool mine = (excl < (unsigned)need) && (incl >= (unsigned)need);
        const unsigned long long bm = __ballot(mine);
        const int src = bm ? (int)__builtin_ctzll(bm) : 0;
        const unsigned Tl = (unsigned)src;
        need -= (int)__shfl(excl, src);
        const unsigned Tq = (b1 << 6) | Tl;
        int eq_seen = 0, cnt = 0;
#pragma unroll
        for (int k = 0; k < 8; ++k) {
            const bool valid = ci[k] >= 0, eqk = valid && cq[k] == Tq;
            const unsigned long long beq = __ballot(eqk);
            const int eq_rank = eq_seen + __builtin_popcountll(beq & lt);
            const bool take = valid && (cq[k] > Tq || (eqk && eq_rank < need));
            const unsigned long long bt = __ballot(take);
            const int pos = cnt + __builtin_popcountll(bt & lt);
            if (take && pos < 256) outL[pos] = (unsigned short)ci[k];
            cnt += __builtin_popcountll(bt); eq_seen += __builtin_popcountll(beq);
        }
    } else {
        unsigned lo = 0u, hi = 65535u;
        while (lo < hi) {
            const unsigned mid = (lo + hi + 1u) >> 1;
            int cge = 0;
            for (int i = lane; i < n; i += 64) cge += ((unsigned)row[i] >= mid) ? 1 : 0;
#pragma unroll
            for (int o = 1; o < 64; o <<= 1) cge += __shfl_xor(cge, o);
            if (cge >= 256) lo = mid; else hi = mid - 1u;
        }
        const unsigned Tq = lo;
        int cgt = 0;
        for (int i = lane; i < n; i += 64) cgt += ((unsigned)row[i] > Tq) ? 1 : 0;
#pragma unroll
        for (int o = 1; o < 64; o <<= 1) cgt += __shfl_xor(cgt, o);
        const int needq = 256 - cgt;
        int cnt = 0, eq_seen = 0;
        for (int i0 = 0; i0 < n; i0 += 64) {
            const int i = i0 + lane; const bool valid = i < n;
            const unsigned qv = valid ? (unsigned)row[i] : 0u;
            const bool eqk = valid && qv == Tq;
            const unsigned long long beq = __ballot(eqk);
            const int eq_rank = eq_seen + __builtin_popcountll(beq & lt);
            const bool take = valid && (qv > Tq || (eqk && eq_rank < needq));
            const unsigned long long bt = __ballot(take);
            const int pos = cnt + __builtin_popcountll(bt & lt);
            if (take && pos < 256) outL[pos] = (unsigned short)i;
            cnt += __builtin_popcountll(bt); eq_seen += __builtin_popcountll(beq);
        }
    }
    LDS_WAIT();
    *(u32x2*)(out + 4 * lane) = *(const LAS u32x2*)(outL + 4 * lane);
    LDS_WAIT();
#pragma unroll
    for (int i = 0; i < 8; ++i) hist[lane + 64 * i] = 0u;
}

template <int STRIP> __device__ __forceinline__ void ph_index7_t(const P& p, LAS unsigned char* lds, const int wv) {
    LAS unsigned short* Irow = (LAS unsigned short*)lds;
    LAS unsigned* hist = (LAS unsigned*)(lds + 65536);
    LAS unsigned* h2 = (LAS unsigned*)(lds + 81920);
    const int tid = opaque_tid(wv), lane = tid & 63, wave = __builtin_amdgcn_readfirstlane(tid >> 6);
    LAS unsigned char* KSw = lds + 92160 + wave * 8192;
    const int hh = lane >> 5, n = lane & 31;
    const int rho = lane & 31, qlA = 2 * ((rho >> 2) & 1) + (rho >> 4), hdA = (rho & 3) + 4 * ((rho >> 3) & 1);
    const int srow = lane >> 3, sch = lane & 7;
#pragma unroll
    for (int i = 0; i < 8; ++i) hist[tid + NTHR * i] = 0u;
    bf16x8 A[2][4]; float wq[2][16]; u32x4 RA[4], RB[4];
#define IDX7_LOAD(R_, mb_, kt_) do { const bf16_t* kp_ = p.KI + ((mb_) + (size_t)(kt_) * 32 + srow) * 64 + sch * 8; \
        _Pragma("unroll") for (int i = 0; i < 4; ++i) R_[i] = *(const u32x4*)(kp_ + (size_t)i * 8 * 64); } while (0)
#define IDX7_LOAD_UNIT(u_) do { const int b_ = (u_) & 7, t0_ = (511 - ((u_) >> 3)) * 8; const size_t mb_ = (size_t)b_ * T; const int nkt_ = (t0_ + 8 + 31) >> 5; \
        _Pragma("unroll") for (int mt = 0; mt < 2; ++mt) { const bf16_t* src = p.QI + (mb_ + t0_ + mt * 4 + qlA) * 512 + hdA * 64 + 8 * hh; \
            _Pragma("unroll") for (int s = 0; s < 4; ++s) A[mt][s] = *(const bf16x8*)(src + 16 * s); \
            _Pragma("unroll") for (int c = 0; c < 2; ++c) { const float* wp = p.WI + (mb_ + t0_ + mt * 4 + 2 * hh + c) * 8; const f32x4 w0 = *(const f32x4*)wp, w1 = *(const f32x4*)(wp + 4); \
                _Pragma("unroll") for (int j = 0; j < 4; ++j) { wq[mt][c * 8 + j] = w0[j]; wq[mt][c * 8 + 4 + j] = w1[j]; } } } \
        if (wave < nkt_) IDX7_LOAD(RA, mb_, wave); if (wave + NWAVES < nkt_) IDX7_LOAD(RB, mb_, wave + NWAVES); } while (0)
    if ((int)blockIdx.x < 4096) IDX7_LOAD_UNIT((int)blockIdx.x);
    __syncthreads();
    for (int u = blockIdx.x; u < 4096; u += gridDim.x) {
        const int b = u & 7, tb = 511 - (u >> 3), t0 = tb * 8; const size_t mb = (size_t)b * T;
        const int nkt = (t0 + 8 + 31) >> 5;
#pragma unroll
        for (int mt = 0; mt < 2; ++mt) {
#pragma unroll
            for (int s = 0; s < 4; ++s) asm volatile("" :: "v"(A[mt][s]));
#pragma unroll
            for (int j = 0; j < 16; ++j) asm volatile("" :: "v"(wq[mt][j]));
        }
#define IDX7_BODY(kt_, R_, bf_) do { const int kt = (kt_); if (kt < nkt) { \
            LAS unsigned char* img = KSw + (bf_) * 4096; \
            _Pragma("unroll") for (int i = 0; i < 4; ++i) { const int row = 8 * i + srow; *(LAS u32x4*)(img + row * 128 + 16 * (sch ^ (row & 7))) = R_[i]; } \
            if (kt + 2 * NWAVES < nkt) IDX7_LOAD(R_, mb, kt + 2 * NWAVES); \
            bf16x8 Bf[4]; \
            _Pragma("unroll") for (int s = 0; s < 4; ++s) Bf[s] = *(const LAS bf16x8*)(img + n * 128 + 16 * ((2 * s + hh) ^ (n & 7))); \
            const int key = kt * 32 + n; \
            _Pragma("unroll") for (int mt = 0; mt < 2; ++mt) { \
                f32x16 acc; \
                _Pragma("unroll") for (int j = 0; j < 16; ++j) acc[j] = 0.f; \
                _Pragma("unroll") for (int s = 0; s < 4; ++s) acc = __builtin_amdgcn_mfma_f32_32x32x16_bf16(A[mt][s], Bf[s], acc, 0, 0, 0); \
                _Pragma("unroll") for (int c = 0; c < 2; ++c) { \
                    float v = 0.f; \
                    _Pragma("unroll") for (int h = 0; h < 8; ++h) { const float af = acc[c * 8 + h]; const int ai = __float_as_int(af); v = __builtin_fmaf(wq[mt][c * 8 + h], __int_as_float(ai > 0 ? ai : 0), v); } \
                    const int r = mt * 4 + 2 * hh + c; const unsigned q = q16of(v); \
                    Irow[r * 4096 + key] = (unsigned short)q; \
                    if (key <= t0 + r) { const unsigned bin = q >> 6; __hip_atomic_fetch_add(hist + r * 512 + (bin >> 1), 1u << ((bin & 1u) * 16u), __ATOMIC_RELAXED, __HIP_MEMORY_SCOPE_WORKGROUP); } \
                } \
            } } } while (0)
#pragma unroll 1
        for (int k0 = wave; k0 < nkt; k0 += 2 * NWAVES) {
            IDX7_BODY(k0, RA, 0);
            IDX7_BODY(k0 + NWAVES, RB, 1);
        }
#undef IDX7_BODY
        if (u + (int)gridDim.x < 4096) IDX7_LOAD_UNIT(u + (int)gridDim.x);
        LDS_WAIT(); __builtin_amdgcn_s_barrier();
        if (STRIP != 1) select_row7(Irow + wave * 4096, t0 + wave + 1, hist + wave * 512, h2 + wave * 320, p.SEL + (mb + t0 + wave) * 256, lane);
        else { _Pragma("unroll") for (int i = 0; i < 8; ++i) hist[wave * 512 + lane + 64 * i] = 0u; }
        LDS_WAIT(); __builtin_amdgcn_s_barrier();
    }
#undef IDX7_LOAD
#undef IDX7_LOAD_UNIT
}

__device__ __forceinline__ void ph_index7(const P& p, LAS unsigned char* lds, const int wv) { ph_index7_t<0>(p, lds, wv); }

__device__ __forceinline__ void ph_gmlp(const P& p, LAS unsigned char* lds, const int wv) {
    const int tid = opaque_tid(wv), lane = tid & 63, wave = __builtin_amdgcn_readfirstlane(tid >> 6);
    LAS unsigned char* vt = lds;
    LAS float* st = (LAS float*)(lds + 32768);
    const int g4 = lane >> 4, q4 = (lane & 15) >> 2, p4 = lane & 3, ic = lane & 15;
    for (int u = blockIdx.x; u < 256; u += gridDim.x) {
        const size_t m0 = (size_t)u * 128;
#pragma unroll 1
        for (int r4 = 0; r4 < 4; ++r4) {
            float x[4][8], sm[4];
#pragma unroll
            for (int r = 0; r < 4; ++r) { const u32x4 w = *(const u32x4*)(p.VB + (m0 + 16 * wave + 4 * r4 + r) * 512 + lane * 8);
                x[r][0] = bflo(w.x); x[r][1] = bfhi(w.x); x[r][2] = bflo(w.y); x[r][3] = bfhi(w.y); x[r][4] = bflo(w.z); x[r][5] = bfhi(w.z); x[r][6] = bflo(w.w); x[r][7] = bfhi(w.w); }
#pragma unroll
            for (int r = 0; r < 4; ++r) sm[r] = ((x[r][0] + x[r][1]) + (x[r][2] + x[r][3])) + ((x[r][4] + x[r][5]) + (x[r][6] + x[r][7]));
#pragma unroll
            for (int o = 1; o < 64; o <<= 1) {
#pragma unroll
                for (int r = 0; r < 4; ++r) sm[r] += __shfl_xor(sm[r], o);
            }
            float vr[4];
#pragma unroll
            for (int r = 0; r < 4; ++r) { const float mean = sm[r] * (1.f / 512.f); sm[r] = mean; float a = 0.f;
#pragma unroll
                for (int j = 0; j < 8; ++j) { const float d = x[r][j] - mean; a += d * d; }
                vr[r] = a; }
#pragma unroll
            for (int o = 1; o < 64; o <<= 1) {
#pragma unroll
                for (int r = 0; r < 4; ++r) vr[r] += __shfl_xor(vr[r], o);
            }
            if (lane == 0) {
#pragma unroll
                for (int r = 0; r < 4; ++r) { const int row = 16 * wave + 4 * r4 + r; st[2 * row] = sm[r]; st[2 * row + 1] = 1.0f / sqrtf(vr[r] * (1.f / 512.f) + EPS); }
            }
        }
        __syncthreads();
#pragma unroll 1
        for (int g = 0; g < 4; ++g) {
#pragma unroll
            for (int i = 0; i < 4; ++i) {
                const int piece = i * NTHR + tid, row = piece >> 4, ch = piece & 15;
                const u32x4 w = *(const u32x4*)(p.VB + (m0 + row) * 512 + g * 128 + ch * 8);
                const float mean = st[2 * row], rstd = st[2 * row + 1];
                const f32x4 ga = *(const f32x4*)(p.ln_g + g * 128 + ch * 8), gb = *(const f32x4*)(p.ln_g + g * 128 + ch * 8 + 4);
                const f32x4 ba = *(const f32x4*)(p.ln_b + g * 128 + ch * 8), bb = *(const f32x4*)(p.ln_b + g * 128 + ch * 8 + 4);
                u32x4 o;
                o.x = pk2((bflo(w.x) - mean) * rstd * ga[0] + ba[0], (bfhi(w.x) - mean) * rstd * ga[1] + ba[1]);
                o.y = pk2((bflo(w.y) - mean) * rstd * ga[2] + ba[2], (bfhi(w.y) - mean) * rstd * ga[3] + ba[3]);
                o.z = pk2((bflo(w.z) - mean) * rstd * gb[0] + bb[0], (bfhi(w.z) - mean) * rstd * gb[1] + bb[1]);
                o.w = pk2((bflo(w.w) - mean) * rstd * gb[2] + bb[2], (bfhi(w.w) - mean) * rstd * gb[3] + bb[3]);
                *(LAS u32x4*)(vt + off_b(row, ch)) = o;
            }
            const size_t orow = (m0 + 16 * wave + ic) * 512 + g * 128 + 4 * g4;
            u32x2 uv[8];
#pragma unroll
            for (int et = 0; et < 8; ++et) uv[et] = *(const u32x2*)(p.UB + orow + 16 * et);
            const float bs = p.b_sp[g * 128 + 16 * wave + ic];
            const int nks = ((16 * wave + 15) >> 5) + 1;
            bf16x8 wb[4];
#pragma unroll
            for (int ks = 0; ks < 4; ++ks) wb[ks] = *(const bf16x8*)(p.WSB + ((size_t)g * 128 + 16 * wave + ic) * 128 + 32 * ks + 8 * g4);
            __syncthreads();
            f32x4 acc[8];
#pragma unroll
            for (int et = 0; et < 8; ++et) acc[et] = (f32x4){0.f, 0.f, 0.f, 0.f};
#pragma unroll
            for (int ks = 0; ks < 4; ++ks) {
                if (ks < nks) {
                    bf16x4 ta[8][2];
#pragma unroll
                    for (int et = 0; et < 8; ++et) {
                        const unsigned r0 = 32 * ks + 8 * g4 + q4, ch = 2 * et + (p4 >> 1);
                        ta[et][0] = tr16(vt + off_b(r0, ch) + 8 * (p4 & 1)); ta[et][1] = tr16(vt + off_b(r0 + 4, ch) + 8 * (p4 & 1));
                    }
#pragma unroll
                    for (int et = 0; et < 8; ++et) acc[et] = __builtin_amdgcn_mfma_f32_16x16x32_bf16(cat4(ta[et][0], ta[et][1]), wb[ks], acc[et], 0, 0, 0);
                }
            }
#pragma unroll
            for (int et = 0; et < 8; ++et) {
                u32x2 w;
                w.x = pk2(bflo(uv[et].x) * (acc[et][0] + bs), bfhi(uv[et].x) * (acc[et][1] + bs));
                w.y = pk2(bflo(uv[et].y) * (acc[et][2] + bs), bfhi(uv[et].y) * (acc[et][3] + bs));
                *(u32x2*)(p.US + orow + 16 * et) = w;
            }
            __syncthreads();
        }
    }
}

__device__ __forceinline__ void split2(float a, float b, unsigned& h, unsigned& l) {
    const unsigned ha = f2bf(a), hb = f2bf(b);
    h = ha | (hb << 16); l = pk2(a - __uint_as_float(ha << 16), b - __uint_as_float(hb << 16));
}
__device__ __forceinline__ void split_bf16(const f32x4 a, const f32x4 b, bf16x8& hi, bf16x8& lo) {
    unsigned h0, h1, h2, h3, l0, l1, l2, l3;
    split2(a.x, a.y, h0, l0); split2(a.z, a.w, h1, l1); split2(b.x, b.y, h2, l2); split2(b.z, b.w, h3, l3);
    const u32x4 h = {h0, h1, h2, h3}, l = {l0, l1, l2, l3};
    hi = __builtin_bit_cast(bf16x8, h); lo = __builtin_bit_cast(bf16x8, l);
}
template <int STRIP> __device__ __forceinline__ void ph_router_t(const P& p, LAS unsigned char* lds, const int wv) {
    const int tid = opaque_tid(wv), lane = tid & 63, wave = __builtin_amdgcn_readfirstlane(tid >> 6);
    LAS float* LG = (LAS float*)lds;
    LAS float* SS = (LAS float*)(lds + 26624);
    LAS unsigned* cnt = (LAS unsigned*)(lds + 26624 + 512);
    const int g = lane >> 4, ic = lane & 15;
    const float* X1 = p.out;
    bf16x8 bh[4][3], bl[4][3];
#pragma unroll
    for (int ks = 0; ks < 4; ++ks) {
        const int k0 = 128 * wave + 32 * ks + 8 * g;
#pragma unroll
        for (int nt = 0; nt < 3; ++nt) {
            const int col = 16 * nt + ic; const int cc = col < 36 ? col : 0;
            f32x4 a = *(const f32x4*)(p.WrT + (size_t)cc * 1024 + k0), b = *(const f32x4*)(p.WrT + (size_t)cc * 1024 + k0 + 4);
            if (col >= 36) { a = (f32x4){0.f, 0.f, 0.f, 0.f}; b = a; }
            split_bf16(a, b, bh[ks][nt], bl[ks][nt]);
        }
        if (ks & 1) asm volatile("" ::: "memory");
    }
    for (int c = blockIdx.x; c < M / 128; c += gridDim.x) {
        for (int i = tid; i < 128 * 52 + 128 + 32; i += NTHR) ((LAS float*)lds)[i] = 0.f;
        __syncthreads();
        f32x4 xa[4], xb[4], na[4], nb[4];
#define RT_LOAD(XA_, XB_, rt_) do { const float* xr = X1 + (size_t)(c * 128 + 16 * (rt_) + ic) * D + 128 * wave + 8 * g; \
            _Pragma("unroll") for (int ks = 0; ks < 4; ++ks) { XA_[ks] = *(const f32x4*)(xr + 32 * ks); XB_[ks] = *(const f32x4*)(xr + 32 * ks + 4); } } while (0)
        RT_LOAD(na, nb, 0);
#pragma unroll 1
        for (int rt = 0; rt < 8; ++rt) {
#pragma unroll
            for (int ks = 0; ks < 4; ++ks) { xa[ks] = na[ks]; xb[ks] = nb[ks]; }
            if (rt < 7) RT_LOAD(na, nb, rt + 1);
            __builtin_amdgcn_sched_barrier(0);
            f32x4 acc[3];
#pragma unroll
            for (int nt = 0; nt < 3; ++nt) acc[nt] = (f32x4){0.f, 0.f, 0.f, 0.f};
            float ssq = 0.f;
            bf16_t* hr = p.H2B + (size_t)(c * 128 + 16 * rt + ic) * D + 128 * wave + 8 * g;
#pragma unroll
            for (int ks = 0; ks < 4; ++ks) {
                ssq += (xa[ks].x * xa[ks].x + xa[ks].y * xa[ks].y) + (xa[ks].z * xa[ks].z + xa[ks].w * xa[ks].w) + (xb[ks].x * xb[ks].x + xb[ks].y * xb[ks].y) + (xb[ks].z * xb[ks].z + xb[ks].w * xb[ks].w);
                const f32x4 ga = *(const f32x4*)(p.n2g + 128 * wave + 32 * ks + 8 * g), gb = *(const f32x4*)(p.n2g + 128 * wave + 32 * ks + 8 * g + 4);
                bf16x8 ah, al;
                split_bf16(xa[ks] * ga, xb[ks] * gb, ah, al);
                *(bf16x8*)(hr + 32 * ks) = ah;
                if (STRIP != 1) {
#pragma unroll
                for (int nt = 0; nt < 3; ++nt) {
                    acc[nt] = __builtin_amdgcn_mfma_f32_16x16x32_bf16(ah, bh[ks][nt], acc[nt], 0, 0, 0);
                    acc[nt] = __builtin_amdgcn_mfma_f32_16x16x32_bf16(al, bh[ks][nt], acc[nt], 0, 0, 0);
                    acc[nt] = __builtin_amdgcn_mfma_f32_16x16x32_bf16(ah, bl[ks][nt], acc[nt], 0, 0, 0);
                }
                }
            }
            ssq += __shfl_xor(ssq, 16); ssq += __shfl_xor(ssq, 32);
            LAS float* PT = (LAS float*)(lds + 32768) + ((rt & 1) * 8 + wave) * (16 * 52);
            if (STRIP == 0) {
#pragma unroll
            for (int nt = 0; nt < 3; ++nt)
#pragma unroll
                for (int r = 0; r < 4; ++r) PT[(4 * g + r) * 52 + 16 * nt + ic] = acc[nt][r];
            if (g == 0) PT[ic * 52 + 48] = ssq;
            }
            LDS_WAIT(); __builtin_amdgcn_s_barrier();
            if (STRIP == 0) {
            for (int e = tid; e < 16 * 52; e += NTHR) {
                const LAS float* q = (const LAS float*)(lds + 32768) + (rt & 1) * 8 * (16 * 52) + e;
                float s = 0.f;
#pragma unroll
                for (int w = 0; w < 8; ++w) s += q[w * (16 * 52)];
                LG[16 * rt * 52 + e] = s;
            }
            }
        }
#undef RT_LOAD
        __syncthreads();
        if (tid < 128) {
            const int m = c * 128 + tid;
            const LAS float* lg = LG + tid * 52;
            const float rinv = 1.0f / sqrtf(lg[48] * (1.f / D) + EPS);
            float gl[4];
#pragma unroll
            for (int i = 0; i < 4; ++i) gl[i] = rinv * lg[i] + p.rg_b[i];
            int gi = 0; float gm = gl[0];
#pragma unroll
            for (int i = 1; i < 4; ++i) if (gl[i] > gm) { gm = gl[i]; gi = i; }
            float gs = 0.f;
#pragma unroll
            for (int i = 0; i < 4; ++i) gs += __expf(gl[i] - gm);
            const float gwt = 1.f / gs;
            float el[8];
#pragma unroll
            for (int j = 0; j < 8; ++j) el[j] = rinv * lg[4 + gi * 8 + j] + p.re_b[gi * 8 + j];
            int i1 = 0; float m1 = el[0];
#pragma unroll
            for (int j = 1; j < 8; ++j) if (el[j] > m1) { m1 = el[j]; i1 = j; }
            int i2 = 0; float m2 = -INFINITY;
#pragma unroll
            for (int j = 0; j < 8; ++j) if (j != i1 && el[j] > m2) { m2 = el[j]; i2 = j; }
            const float e2r = __expf(m2 - m1), e1 = 1.f / (1.f + e2r), e2 = e2r * e1;
            const int ea = gi * 8 + i1, eb = gi * 8 + i2;
            p.EID[2 * m] = ea; p.EID[2 * m + 1] = eb;
            p.EW[2 * m] = gwt * e1; p.EW[2 * m + 1] = gwt * e2;
            p.RINV2[m] = rinv;
            __hip_atomic_fetch_add(cnt + ea, 1u, __ATOMIC_RELAXED, __HIP_MEMORY_SCOPE_WORKGROUP);
            __hip_atomic_fetch_add(cnt + eb, 1u, __ATOMIC_RELAXED, __HIP_MEMORY_SCOPE_WORKGROUP);
        }
        __syncthreads();
        if (tid < 32) p.BLKCNT[c * 32 + tid] = (int)cnt[tid];
        __syncthreads();
    }
}

__device__ __forceinline__ void ph_router(const P& p, LAS unsigned char* lds, const int wv) { ph_router_t<0>(p, lds, wv); }

__device__ __forceinline__ void ph_scan(const P& p, LAS unsigned char* lds, const int wv) {}
__device__ __forceinline__ void ph_scatter(const P& p, LAS unsigned char* lds, const int wv) {
    const int tid = opaque_tid(wv);
    LAS int* s = (LAS int*)lds;
    LAS int* se = s + 2048;
    const int e = tid & 31, part = tid >> 5;
    int loc[16]; int sum = 0;
#pragma unroll
    for (int i = 0; i < 16; ++i) { loc[i] = p.BLKCNT[(part * 16 + i) * 32 + e]; sum += loc[i]; }
    s[128 + part * 32 + e] = sum;
    __syncthreads();
    if (tid < 32) { int t = 0; for (int k = 0; k < 16; ++k) { const int v = s[128 + k * 32 + tid]; s[128 + k * 32 + tid] = t; t += v; } s[tid] = t; }
    __syncthreads();
    if (tid == 0) { int off = 0; for (int k = 0; k < 32; ++k) { s[32 + k] = off; off += (s[k] + 255) >> 8; } s[64] = off; }
    __syncthreads();
    if (blockIdx.x == 0) {
        const int ntiles = s[64];
        if (tid < 32) { p.MOEI[tid] = s[32 + tid] * 256; p.MOEI[32 + tid] = s[32 + tid]; }
        if (tid == 0) { p.MOEI[64] = ntiles; p.MOEI[65] = ntiles * 2; p.MOEI[66] = ntiles * 4; }
        for (int rt = tid; rt < ntiles; rt += NTHR) {
            int ex = 0;
            for (int k = 0; k < 32; ++k) { const int tb = s[32 + k], nt = (s[k] + 255) >> 8; if (rt >= tb && rt < tb + nt) ex = k; }
            p.GU[4 * rt + 0] = rt; p.GU[4 * rt + 1] = ex * 2; p.GU[4 * rt + 2] = rt; p.GU[4 * rt + 3] = ex * 2 + 1;
#pragma unroll
            for (int j = 0; j < 4; ++j) { p.DN[8 * rt + 2 * j] = rt; p.DN[8 * rt + 2 * j + 1] = ex * 4 + j; }
        }
        for (int k = 0; k < 32; ++k) {
            const int lo = s[32 + k] * 256 + s[k], hi = (s[32 + k] + ((s[k] + 255) >> 8)) * 256;
            for (int i = lo + tid; i < hi; i += NTHR) p.PTOK[i] = -1;
        }
    }
    for (int c = blockIdx.x; c < M / 128; c += gridDim.x) {
        if (part == (c >> 4)) {
            int run = s[32 + e] * 256 + s[128 + part * 32 + e];
#pragma unroll
            for (int i = 0; i < 16; ++i) run += (i < (c & 15)) ? loc[i] : 0;
            s[1024 + e] = run;
        }
        int ex = 0;
        if (tid < 256) { ex = p.EID[c * 256 + tid]; se[tid] = ex; }
        __syncthreads();
        if (tid < 256) {
            int rank = 0;
            for (int t = 0; t < tid; ++t) rank += (se[t] == ex) ? 1 : 0;
            p.PTOK[s[1024 + ex] + rank] = c * 256 + tid;
        }
        __syncthreads();
    }
}

template <bool DRY> __device__ __forceinline__ void ph_final(const P& p, const int wv) {
    const int tid = opaque_tid(wv), lane = tid & 63, wave = tid >> 6;
    const int gw = blockIdx.x * NWAVES + wave, NGW = gridDim.x * NWAVES;
    for (int m4 = gw; m4 < M / 4; m4 += NGW) {
        f32x4 v[4][4]; float s[4];
#pragma unroll
        for (int rr = 0; rr < 4; ++rr) {
            const int m = 4 * m4 + rr;
            const f32x4* xr = (const f32x4*)(p.out + (size_t)m * D) + lane;
            const u32x2* y0 = (const u32x2*)(p.YS + (size_t)m * D) + lane; const u32x2* y1 = (const u32x2*)(p.YS + ((size_t)M + m) * D) + lane;
            s[rr] = 0.f;
#pragma unroll
            for (int j = 0; j < 4; ++j) {
                v[rr][j] = xr[64 * j]; const u32x2 a = y0[64 * j], b = y1[64 * j];
                v[rr][j].x += bflo(a.x) + bflo(b.x); v[rr][j].y += bfhi(a.x) + bfhi(b.x); v[rr][j].z += bflo(a.y) + bflo(b.y); v[rr][j].w += bfhi(a.y) + bfhi(b.y);
                s[rr] += (v[rr][j].x * v[rr][j].x + v[rr][j].y * v[rr][j].y) + (v[rr][j].z * v[rr][j].z + v[rr][j].w * v[rr][j].w);
            }
        }
#pragma unroll
        for (int rr = 0; rr < 4; ++rr) {
            const float rinv = 1.0f / sqrtf(wave_sum(s[rr]) * (1.f / D) + EPS);
            f32x4* xr = (f32x4*)((DRY ? (float*)p.GBB : p.out) + (size_t)(4 * m4 + rr) * D) + lane;
#pragma unroll
            for (int j = 0; j < 4; ++j) { const f32x4 g = ((const f32x4*)p.fg)[lane + 64 * j]; xr[64 * j] = v[rr][j] * rinv * g; }
        }
    }
}

#ifndef GEMM_SP2
#define GEMM_SP2 true
#endif
__device__ __forceinline__ void ph_gemm_in(const P& p, LAS unsigned char* lds, const int wv) {
    pg8::Gemm g{p.HB, p.WinT, M, NIN, 1024}; pg8::StaticOrder S; S.init(M, NIN, gridDim.x, (int)blockIdx.x);
    EpiIn E{p.QL, p.QI, p.KI, p.UB, p.VB, p.GAB, p.GBB, p.CKVR, p.WI};
    pg8::gemm_phase<EpiIn, pg8::StaticOrder, true, GEMM_SP2>(lds, g, S, E, wv);
    {
        const int G = gridDim.x, nwg = (M / 256) * (NIN / 256), nextra = nwg % G;
        const int c = blockIdx.x, nshort = nextra == 0 ? G : G - nextra;
        if (nextra == 0 || c >= nextra) {
            const int tid = opaque_tid(wv), lane = tid & 63, wave = __builtin_amdgcn_readfirstlane(tid >> 6);
            __syncthreads();
            prep_gateup(p, lds, (nextra == 0 ? c : c - nextra) * NWAVES + wave, nshort * NWAVES, wave, lane);
        }
    }
}
__device__ __forceinline__ void ph_gemm_yb(const P& p, LAS unsigned char* lds, const int wv) {
    pg8::Gemm g{p.US, p.WpbT, M, 1024, 512}; pg8::StaticOrder S; S.init(M, 1024, gridDim.x, (int)blockIdx.x);
    EpiMB E{p.GBB, p.MB};
    pg8::gemm_phase<EpiMB, pg8::StaticOrder, true, GEMM_SP2>(lds, g, S, E, wv);
}
__device__ __forceinline__ void ph_gemm_ya(const P& p, LAS unsigned char* lds, const int wv) {
    pg8::Gemm g{p.OL, p.WovT, M, 1024, 1024}; pg8::StaticOrder S; S.init(M, 1024, gridDim.x, (int)blockIdx.x);
    EpiMG E{p.GAB, p.MB, p.MG};
    pg8::gemm_phase<EpiMG, pg8::StaticOrder, true, GEMM_SP2>(lds, g, S, E, wv);
}
__device__ __forceinline__ void ph_gemm_out(const P& p, LAS unsigned char* lds, const int wv) {
    pg8::Gemm g{p.MG, p.WoutT, M, 1024, 1024}; pg8::StaticOrder S; S.init(M, 1024, gridDim.x, (int)blockIdx.x);
    EpiX1 E{p.x, p.out};
    pg8::gemm_phase<EpiX1, pg8::StaticOrder, true, GEMM_SP2>(lds, g, S, E, wv);
}
__device__ __forceinline__ void ph_gemm_gu(const P& p, LAS unsigned char* lds, const int wv) {
    table_prefetch(lds, p.GU, p.MOEI + 65, (int)gridDim.x, (int)blockIdx.x, opaque_tid(wv));
    pg8::Gemm g{p.H2B, p.WguT, NPOS, 32 * 512, 1024}; TableGatherOrder S{p.GU, p.MOEI + 65, p.PTOK, (int)gridDim.x, (int)blockIdx.x, (const LAS int*)(lds + LDS_TAB_OFF)};
    EpiHE E{p.HE, p.PTOK, p.RINV2};
    pg8::gemm_phase<EpiHE, TableGatherOrder, true, true>(lds, g, S, E, wv);
}
__device__ __forceinline__ void ph_gemm_dn(const P& p, LAS unsigned char* lds, const int wv) {
    table_prefetch(lds, p.DN, p.MOEI + 66, (int)gridDim.x, (int)blockIdx.x, opaque_tid(wv));
    pg8::Gemm g{p.HE, p.WdT, NPOS, 32 * 1024, 256}; TableOrder S{p.DN, p.MOEI + 66, (int)gridDim.x, (int)blockIdx.x, (const LAS int*)(lds + LDS_TAB_OFF)};
    EpiDown E{p.PTOK, p.EW, p.YS};
    pg8::gemm_phase<EpiDown, TableOrder, true, GEMM_SP2>(lds, g, S, E, wv);
}
constexpr int NPHASE = 15;
template <int PH> __device__ __forceinline__ void run_phase(const P& p, LAS unsigned char* lds, const int wv) {
    if constexpr (PH == 0) ph_prep(p, lds, wv);
    if constexpr (PH == 1) ph_gemm_in(p, lds, wv);
    if constexpr (PH == 2) ph_ckvnorm(p, wv);
    if constexpr (PH == 3) ph_index7(p, lds, wv);
    if constexpr (PH == 4) ph_attn_t<0>(p, lds, wv);
    if constexpr (PH == 5) ph_gmlp(p, lds, wv);
    if constexpr (PH == 6) ph_gemm_yb(p, lds, wv);
    if constexpr (PH == 7) ph_gemm_ya(p, lds, wv);
    if constexpr (PH == 8) ph_gemm_out(p, lds, wv);
    if constexpr (PH == 9) ph_router(p, lds, wv);
    if constexpr (PH == 10) ph_scan(p, lds, wv);
    if constexpr (PH == 11) ph_scatter(p, lds, wv);
    if constexpr (PH == 12) ph_gemm_gu(p, lds, wv);
    if constexpr (PH == 13) ph_gemm_dn(p, lds, wv);
    if constexpr (PH == 14) ph_final<false>(p, wv);
}
template <int PH> __global__ void __launch_bounds__(NTHR, 2) k_phase(P p) {
    extern __shared__ __attribute__((aligned(16))) unsigned char lds_raw[];
    run_phase<PH>(p, (LAS unsigned char*)lds_raw, __builtin_amdgcn_readfirstlane(threadIdx.x >> 6));
}

constexpr int MISC_OFF = LDS_BYTES - 256;
__global__ void __launch_bounds__(NTHR, 2) k_mega(P p) {
    extern __shared__ __attribute__((aligned(16))) unsigned char lds_raw[];
    LAS unsigned char* lds = (LAS unsigned char*)lds_raw;
    volatile LAS unsigned* MISC = (volatile LAS unsigned*)(lds + MISC_OFF);
    int wv = __builtin_amdgcn_readfirstlane(threadIdx.x >> 6); asm volatile("" : "+s"(wv));
    if (threadIdx.x < 64) MISC[threadIdx.x] = 0u;
    __syncthreads();
    XcdBarrier bar = xcd_barrier_post(p.ctl + CW_BAR, MISC, wv);
    run_phase<0>(p, lds, wv);
#if defined(DUP0)
    __syncthreads(); run_phase<0>(p, lds, wv);
#endif
    xcd_barrier(bar);
    run_phase<1>(p, lds, wv);
#if defined(DUP1)
    __syncthreads(); run_phase<1>(p, lds, wv);
#endif
    xcd_barrier(bar);
    run_phase<2>(p, lds, wv);
#if defined(DUP2)
    run_phase<2>(p, lds, wv);
#endif
#if defined(PRE3)
    ph_index7_t<PRE3>(p, lds, wv); __syncthreads();
#endif
    run_phase<3>(p, lds, wv);
#if defined(DUP3)
    __syncthreads(); run_phase<3>(p, lds, wv);
#endif
    xcd_barrier(bar);
#if defined(PRE4)
    ph_attn_t<PRE4>(p, lds, wv); __syncthreads();
#endif
    run_phase<4>(p, lds, wv);  __syncthreads();
#if defined(DUP4)
    run_phase<4>(p, lds, wv);  __syncthreads();
#endif
    run_phase<5>(p, lds, wv);
#if defined(DUP5)
    __syncthreads(); run_phase<5>(p, lds, wv);
#endif
    xcd_barrier(bar);
    run_phase<6>(p, lds, wv);
    run_phase<7>(p, lds, wv);  xcd_barrier(bar);
    run_phase<8>(p, lds, wv);
#if defined(DUP678)
    __syncthreads(); run_phase<6>(p, lds, wv); run_phase<7>(p, lds, wv); xcd_barrier(bar); run_phase<8>(p, lds, wv);
#endif
    xcd_barrier(bar);
#if defined(PRE9)
    ph_router_t<PRE9>(p, lds, wv); __syncthreads();
#endif
    run_phase<9>(p, lds, wv);
#if defined(DUP9)
    __syncthreads(); run_phase<9>(p, lds, wv);
#endif

    xcd_barrier(bar);
    run_phase<11>(p, lds, wv);
#if defined(DUP11)
    __syncthreads(); run_phase<11>(p, lds, wv);
#endif
    xcd_barrier(bar);
    run_phase<12>(p, lds, wv);
#if defined(DUP12)
    __syncthreads(); run_phase<12>(p, lds, wv);
#endif
    xcd_barrier(bar);
    run_phase<13>(p, lds, wv);
#if defined(DUP13)
    __syncthreads(); run_phase<13>(p, lds, wv);
#endif
    xcd_barrier(bar);
#if defined(XBAR10)
    for (int i = 0; i < 10; ++i) xcd_barrier(bar);
#endif
#if defined(DUP14)
    ph_final<true>(p, wv); __syncthreads();
#endif
    run_phase<14>(p, lds, wv);
}

extern "C" void kernel_launch(void* const* d_in, const int* in_sizes, int n_in, void* d_out, int out_size, void* d_ws, size_t ws_size, hipStream_t stream) {
    static int grid = 0; static bool first = true;
    if (grid == 0) {
        if (n_in != 23 || in_sizes[0] != M * D || out_size != M * D || ws_size < WS_END) { fprintf(stderr, "kernel_launch: unexpected shapes (n_in %d, in0 %d, out %d, ws %zu)\n", n_in, n_in > 0 ? in_sizes[0] : -1, out_size, ws_size); grid = -1; return; }
        int dev = 0, cus = 0;
        if (hipGetDevice(&dev) != hipSuccess || hipDeviceGetAttribute(&cus, hipDeviceAttributeMultiprocessorCount, dev) != hipSuccess) { grid = -1; return; }
        grid = cus;
    }
    if (grid < 0) return;
    unsigned char* ws = (unsigned char*)d_ws;
    (void)hipMemsetAsync(ws + WS_CTL, 0, CTL_ZERO_BYTES, stream);
    P p{};
    const float* const* in = (const float* const*)d_in;
    p.x = in[0]; p.w_in = in[1]; p.kv_g = in[2]; p.w_uk = in[3]; p.w_uv = in[4]; p.rel_bias = in[5]; p.ln_g = in[6]; p.ln_b = in[7]; p.w_sp = in[8]; p.b_sp = in[9];
    p.w_pa = in[10]; p.w_pb = in[11]; p.w_out = in[12]; p.n1g = in[13]; p.n2g = in[14]; p.rg_w = in[15]; p.rg_b = in[16]; p.re_w = in[17]; p.re_b = in[18];
    p.w_gate = in[19]; p.w_up = in[20]; p.w_down = in[21]; p.fg = in[22];
    p.out = (float*)d_out; p.ctl = (unsigned*)(ws + WS_CTL);
    p.WinT = (bf16_t*)(ws + WS_WIN); p.WoutT = (bf16_t*)(ws + WS_WOUT); p.WpbT = (bf16_t*)(ws + WS_WPB); p.WovT = (bf16_t*)(ws + WS_WOV); p.WSB = (bf16_t*)(ws + WS_WSB);
    p.WguT = (bf16_t*)(ws + WS_WGU); p.WdT = (bf16_t*)(ws + WS_WD); p.WrT = (float*)(ws + WS_WRT);
    p.HB = (bf16_t*)(ws + WS_A); p.OL = (bf16_t*)(ws + WS_A); p.H2B = (bf16_t*)(ws + WS_A);
    p.QL = (bf16_t*)(ws + WS_B); p.MB = (bf16_t*)(ws + WS_B); p.H2S = (bf16_t*)(ws + WS_B); p.YS = (bf16_t*)(ws + WS_B);
    p.GAB = (bf16_t*)(ws + WS_GA); p.GBB = (bf16_t*)(ws + WS_GB);
    p.UB = (bf16_t*)(ws + WS_C); p.VB = (bf16_t*)(ws + WS_C + 32 * MiB); p.MG = (bf16_t*)(ws + WS_C); p.HE = (bf16_t*)(ws + WS_C);
    p.QI = (bf16_t*)(ws + WS_DQ); p.US = (bf16_t*)(ws + WS_DQ);
    p.CKVR = (float*)(ws + WS_CKVR); p.CKVB = (bf16_t*)(ws + WS_CKVB); p.KI = (bf16_t*)(ws + WS_KI); p.WI = (float*)(ws + WS_WI); p.SEL = (unsigned short*)(ws + WS_SEL);
    p.EID = (int*)(ws + WS_MOE); p.EW = (float*)(ws + WS_MOE + 262144); p.PTOK = (int*)(ws + WS_MOE + 524288); p.MOEI = (int*)(ws + WS_MOE + 1048576);
    p.GU = (int*)(ws + WS_MOE + 1048576 + 4096); p.BLKCNT = (int*)(ws + WS_MOE + 1048576 + 65536); p.IDXROW = (float*)(ws + WS_A); p.RINV2 = (float*)(ws + WS_MOE + 1048576 + 262144); p.CB = (int*)(ws + WS_MOE + 1048576 + 131072); p.DN = (int*)(ws + WS_MOE + 1048576 + 4096 + 8192);
    if (first) { (void)hipFuncSetAttribute((const void*)k_mega, hipFuncAttributeMaxDynamicSharedMemorySize, LDS_BYTES); first = false; }
    hipLaunchKernelGGL(k_mega, dim3(grid), dim3(NTHR), LDS_BYTES, stream, p);
}
```

```cpp
#include <hip/hip_runtime.h>
#include <cstdio>
#include <cstdint>
__device__ __forceinline__ int opaque_tid(const int wv) { int l; asm volatile("v_mbcnt_lo_u32_b32 %0, -1, 0\n\tv_mbcnt_hi_u32_b32 %0, -1, %0" : "=v"(l)); return (wv << 6) + l; }
#define LAS __attribute__((address_space(3)))
namespace pg8 {
#define PG8_LAS __attribute__((address_space(3)))
typedef unsigned short bf16_t;
typedef short bf16x8 __attribute__((ext_vector_type(8)));
typedef float f32x4 __attribute__((ext_vector_type(4)));
typedef unsigned u32x4 __attribute__((ext_vector_type(4)));
constexpr int BM = 256, BK = 64, HALF = 128, HTB = HALF * BK * 2  , STAGE_BYTES = 8 * HTB, NXCD = 8, WGM = 8;

__host__ __device__ __forceinline__ int lds_byte(int r, int c) { const int st = (r >> 4) * 2 + (c >> 5), rr = r & 15, cc = c & 31, ob = rr * 64 + cc * 2; return st * 1024 + (ob ^ (((ob >> 9) & 1) << 5)); }
__host__ __device__ __forceinline__ void stage_rc(int b, int& R, int& C) { const int st = b / 1024, sb = b % 1024, swz = sb ^ (((sb >> 9) & 1) << 5); R = (st >> 1) * 16 + swz / 64; C = (st & 1) * 32 + (swz % 64) / 2; }
__host__ __device__ __forceinline__ int perm32(int rho) { const int n = rho >> 4, i = rho & 15; return 8 * (i >> 2) + 4 * n + (i & 3); }

struct Unit { int pm, pn; };
struct Gemm { const bf16_t* A; const bf16_t* Bt; int M, N, K; };

struct StaticOrder {
    static constexpr bool GATHER = false;
    int nM, nN, nwg, G, c;
    __host__ __device__ void init(int M, int N, int G_, int c_) { nM = M / BM; nN = N / BM; nwg = nM * nN; G = G_; c = c_; }
    __host__ __device__ bool next(int i, Unit& u) const {
        const long L = (long)i * G + c; if (L >= nwg) return false;
        int wgid = (int)L; { const int q = nwg / NXCD, r = nwg % NXCD, xcd = wgid % NXCD, off = wgid / NXCD; wgid = (xcd < r ? xcd * (q + 1) : r * (q + 1) + (xcd - r) * q) + off; }
        const int nig = WGM * nN, gid = wgid / nig, fm = gid * WGM, gsz = (nM - fm) < WGM ? (nM - fm) : WGM;
        u.pm = fm + ((wgid % nig) % gsz); u.pn = (wgid % nig) / gsz; return true;
    }
    __device__ __forceinline__ int arow(int r) const { return r; }
    __device__ __forceinline__ void a_ready(const Unit&) const {}
    __device__ __forceinline__ void done(const Unit&) const {}
};

__device__ __forceinline__ unsigned cvt_pk_bf16(float lo, float hi) { unsigned r; asm volatile("v_cvt_pk_bf16_f32 %0, %1, %2" : "=v"(r) : "v"(lo), "v"(hi)); return r; }
typedef float f32x2 __attribute__((ext_vector_type(2)));
template <class Epi, class Sched, bool ALIGN_EPI = false, bool SP2 = false>
__device__ __forceinline__ void gemm_phase(PG8_LAS unsigned char* lds, const Gemm g, const Sched& S, const Epi& E, const int wv) {
    const int tid = opaque_tid(wv), wid = __builtin_amdgcn_readfirstlane(tid >> 6), lane = tid & 63, wr = wid >> 2, wc = wid & 3, fr = lane & 15, fq = lane >> 4;
    const int K = g.K, nt = K / BK;
    unsigned voffA[2], voffB[2];
#pragma unroll
    for (int i = 0; i < 2; ++i) { int R, C; stage_rc(tid * 16 + i * 8192, R, C); const int Rb = Epi::PERM ? ((R & ~31) + perm32(R & 31)) : R;
        voffA[i] = (unsigned)(R * K + C) * 2u; voffB[i] = (unsigned)(Rb * K + C) * 2u; }
    static_assert(!Sched::GATHER || SP2, "gathered A rows: SP2 loop only");
    unsigned gcur[2][2], gnxt[2][2]; int gR[2], gC[2];
    if constexpr (Sched::GATHER) {
#pragma unroll
        for (int i = 0; i < 2; ++i) { stage_rc(tid * 16 + i * 8192, gR[i], gC[i]); }
    }
#define PG8_GOFF(dst, u_) do { _Pragma("unroll") for (int h_ = 0; h_ < 2; ++h_) _Pragma("unroll") for (int i_ = 0; i_ < 2; ++i_) \
        dst[h_][i_] = ((unsigned)S.arow((u_).pm * BM + h_ * HALF + gR[i_]) * (unsigned)K + (unsigned)gC[i_]) * 2u; } while (0)
    const size_t kstep = (size_t)(BK * 2);
    const size_t hstep = (size_t)HALF * K * 2;
    const size_t tstep = 2 * hstep;
    const unsigned ldsw = (unsigned)wid * 1024u;
    const int aoff = lds_byte(wr * 64 + fr, fq * 8), boff = lds_byte(wc * 32 + fr, fq * 8);
#define PG8_SA(b, h) (((b) * 2 + (h)) * HTB)
#define PG8_SB(b, h) ((4 + (b) * 2 + (h)) * HTB)
#define PG8_STAGE(bufoff, gbase, voff) do { _Pragma("unroll") for (int _i = 0; _i < 2; ++_i) \
        __builtin_amdgcn_global_load_lds((const unsigned*)((const char*)(gbase) + (voff)[_i]), (PG8_LAS unsigned*)(lds + (bufoff) + ldsw + _i * 8192), 16, 0, 0); } while (0)
#define PG8_LDA(dst, b, h) do { _Pragma("unroll") for (int m = 0; m < 4; ++m) _Pragma("unroll") for (int k = 0; k < 2; ++k) dst[m][k] = *(const PG8_LAS bf16x8*)(lds + PG8_SA(b, h) + aoff + m * 2048 + k * 1024); } while (0)
#define PG8_LDB(dst, b, h) do { _Pragma("unroll") for (int n = 0; n < 2; ++n) _Pragma("unroll") for (int k = 0; k < 2; ++k) dst[n][k] = *(const PG8_LAS bf16x8*)(lds + PG8_SB(b, h) + boff + n * 2048 + k * 1024); } while (0)
#define PG8_MMA(ai, bj, At, Bt) do { __builtin_amdgcn_s_setprio(1); _Pragma("unroll") for (int m = 0; m < 4; ++m) _Pragma("unroll") for (int n = 0; n < 2; ++n) _Pragma("unroll") for (int k = 0; k < 2; ++k) \
        acc[ai][bj][m][n] = __builtin_amdgcn_mfma_f32_16x16x32_bf16(Bt[n][k], At[m][k], acc[ai][bj][m][n], 0, 0, 0); __builtin_amdgcn_s_setprio(0); } while (0)
#define PG8_WAIT_V(n) asm volatile("s_waitcnt vmcnt(" #n ")" ::: "memory")
#define PG8_WAIT_L(n) asm volatile("s_waitcnt lgkmcnt(" #n ")" ::: "memory")
#define PG8_BAR __builtin_amdgcn_s_barrier()
#define PG8_SCHED __builtin_amdgcn_sched_barrier(0)
    Unit cur, nxt; int ui = 0;
    if (!S.next(0, cur)) return;
    f32x4 acc[2][2][4][2];
#pragma unroll
    for (int a = 0; a < 2; ++a)
#pragma unroll
        for (int b = 0; b < 2; ++b)
#pragma unroll
            for (int m = 0; m < 4; ++m)
#pragma unroll
                for (int n = 0; n < 2; ++n) acc[a][b][m][n] = (f32x4){0.f, 0.f, 0.f, 0.f};
    bf16x8 At[4][2], B0[2][2], B1[2][2];
    const char* cA = Sched::GATHER ? (const char*)g.A : (const char*)g.A + (size_t)cur.pm * tstep; const char* cB = (const char*)g.Bt + (size_t)cur.pn * tstep;
    S.a_ready(cur);
    if constexpr (Sched::GATHER) { PG8_GOFF(gcur, cur); }
#define PG8_STAGE_A(bufoff, base_, h_, koff_, GO_) do { if constexpr (Sched::GATHER) { PG8_STAGE(bufoff, (const char*)g.A + (koff_), GO_[h_]); } else { PG8_STAGE(bufoff, (base_) + (h_) * hstep + (koff_), voffA); } } while (0)
    if constexpr (SP2) {
        PG8_STAGE(PG8_SB(0, 0), cB, voffB); PG8_STAGE(PG8_SB(0, 1), cB + hstep, voffB); PG8_STAGE_A(PG8_SA(0, 0), cA, 0, 0, gcur); PG8_STAGE_A(PG8_SA(0, 1), cA, 1, 0, gcur);
        if (wr == 1) PG8_BAR;
        PG8_WAIT_V(2); PG8_BAR;
        PG8_STAGE(PG8_SB(1, 0), cB + kstep, voffB); PG8_STAGE_A(PG8_SA(1, 0), cA, 0, kstep, gcur); PG8_STAGE(PG8_SB(1, 1), cB + hstep + kstep, voffB);
        PG8_WAIT_V(6); PG8_BAR;
    } else {
        PG8_STAGE(PG8_SB(0, 0), cB, voffB); PG8_STAGE(PG8_SA(0, 0), cA, voffA); PG8_STAGE(PG8_SB(0, 1), cB + hstep, voffB); PG8_STAGE(PG8_SA(0, 1), cA + hstep, voffA);
        if (wr == 1) PG8_BAR;
        PG8_WAIT_V(4); PG8_BAR;
        PG8_STAGE(PG8_SB(1, 0), cB + kstep, voffB); PG8_STAGE(PG8_SA(1, 0), cA + kstep, voffA); PG8_STAGE(PG8_SB(1, 1), cB + hstep + kstep, voffB);
        PG8_WAIT_V(6); PG8_BAR;
    }
    for (;;) {
        const bool has_next = S.next(ui + 1, nxt);
        const char* nA = Sched::GATHER ? cA : (has_next ? (const char*)g.A + (size_t)nxt.pm * tstep : cA); const char* nB = has_next ? (const char*)g.Bt + (size_t)nxt.pn * tstep : cB;
        if constexpr (Sched::GATHER) { if (has_next) { PG8_GOFF(gnxt, nxt); } else { _Pragma("unroll") for (int h_ = 0; h_ < 2; ++h_) _Pragma("unroll") for (int i_ = 0; i_ < 2; ++i_) gnxt[h_][i_] = gcur[h_][i_]; } }
        for (int t = 0; t < nt; t += 2) {
            const bool last = (t == nt - 2);
            const char* a1 = cA + (size_t)(t + 1) * kstep;
            const char* a2 = last ? nA : cA + (size_t)(t + 2) * kstep; const char* b2 = last ? nB : cB + (size_t)(t + 2) * kstep;
            const char* a3 = a2 + kstep; const char* b3 = b2 + kstep;
            unsigned g2[2][2];
            if constexpr (Sched::GATHER) { _Pragma("unroll") for (int h_ = 0; h_ < 2; ++h_) _Pragma("unroll") for (int i_ = 0; i_ < 2; ++i_) g2[h_][i_] = last ? gnxt[h_][i_] : gcur[h_][i_]; }
            const size_t k1 = (size_t)(t + 1) * kstep, k2 = last ? (size_t)0 : (size_t)(t + 2) * kstep, k3 = k2 + kstep;
            if (last && has_next) S.a_ready(nxt);
            if constexpr (SP2) {
            PG8_LDB(B0, 0, 0); PG8_LDB(B1, 0, 1); PG8_SCHED; PG8_LDA(At, 0, 0); if constexpr (Sched::GATHER) { PG8_STAGE(PG8_SA(1, 1), (const char*)g.A + k1, gcur[1]); } else { PG8_STAGE(PG8_SA(1, 1), a1 + hstep, voffA); }
            PG8_WAIT_V(8); PG8_WAIT_L(0); PG8_BAR; PG8_MMA(0, 0, At, B0); PG8_MMA(0, 1, At, B1); PG8_BAR; PG8_SCHED;
            PG8_LDA(At, 0, 1); PG8_STAGE(PG8_SB(0, 0), b2, voffB); PG8_STAGE(PG8_SB(0, 1), b2 + hstep, voffB); if constexpr (Sched::GATHER) { PG8_STAGE(PG8_SA(0, 0), (const char*)g.A + k2, g2[0]); } else { PG8_STAGE(PG8_SA(0, 0), a2, voffA); }
            PG8_WAIT_V(8); PG8_WAIT_L(0); PG8_BAR; PG8_MMA(1, 0, At, B0); PG8_MMA(1, 1, At, B1); PG8_BAR; PG8_SCHED;
            PG8_LDB(B0, 1, 0); PG8_LDB(B1, 1, 1); PG8_SCHED; PG8_LDA(At, 1, 0); if constexpr (Sched::GATHER) { PG8_STAGE(PG8_SA(0, 1), (const char*)g.A + k2, g2[1]); } else { PG8_STAGE(PG8_SA(0, 1), a2 + hstep, voffA); }
            PG8_WAIT_V(8); PG8_WAIT_L(0); PG8_BAR; PG8_MMA(0, 0, At, B0); PG8_MMA(0, 1, At, B1); PG8_BAR; PG8_SCHED;
            PG8_LDA(At, 1, 1); PG8_STAGE(PG8_SB(1, 0), b3, voffB); PG8_STAGE(PG8_SB(1, 1), b3 + hstep, voffB); if constexpr (Sched::GATHER) { PG8_STAGE(PG8_SA(1, 0), (const char*)g.A + k3, g2[0]); } else { PG8_STAGE(PG8_SA(1, 0), a3, voffA); }
            PG8_WAIT_V(8); PG8_WAIT_L(0); PG8_BAR; PG8_MMA(1, 0, At, B0); PG8_MMA(1, 1, At, B1); PG8_BAR; PG8_SCHED;
            } else {
            PG8_LDB(B0, 0, 0); PG8_SCHED; PG8_LDA(At, 0, 0); PG8_STAGE(PG8_SA(1, 1), a1 + hstep, voffA);
            PG8_WAIT_L(8); PG8_BAR; PG8_WAIT_L(0); PG8_MMA(0, 0, At, B0); PG8_BAR; PG8_SCHED;
            PG8_LDB(B1, 0, 1); PG8_STAGE(PG8_SB(0, 0), b2, voffB);
            PG8_BAR; PG8_WAIT_L(0); PG8_MMA(0, 1, At, B1); PG8_BAR;
            PG8_LDA(At, 0, 1); PG8_STAGE(PG8_SA(0, 0), a2, voffA);
            PG8_BAR; PG8_WAIT_L(0); PG8_MMA(1, 0, At, B0); PG8_BAR; PG8_SCHED;
            PG8_STAGE(PG8_SB(0, 1), b2 + hstep, voffB);
            PG8_WAIT_V(6); PG8_BAR; PG8_MMA(1, 1, At, B1); PG8_BAR;
            PG8_LDB(B0, 1, 0); PG8_SCHED; PG8_LDA(At, 1, 0); PG8_STAGE(PG8_SA(0, 1), a2 + hstep, voffA);
            PG8_WAIT_L(8); PG8_BAR; PG8_WAIT_L(0); PG8_MMA(0, 0, At, B0); PG8_BAR; PG8_SCHED;
            PG8_LDB(B1, 1, 1); PG8_STAGE(PG8_SB(1, 0), b3, voffB);
            PG8_BAR; PG8_WAIT_L(0); PG8_MMA(0, 1, At, B1); PG8_BAR;
            PG8_LDA(At, 1, 1); PG8_STAGE(PG8_SA(1, 0), a3, voffA);
            PG8_BAR; PG8_WAIT_L(0); PG8_MMA(1, 0, At, B0); PG8_BAR; PG8_SCHED;
            PG8_STAGE(PG8_SB(1, 1), b3 + hstep, voffB);
            PG8_WAIT_V(6); PG8_BAR; PG8_MMA(1, 1, At, B1); PG8_BAR;
            }
        }
        if constexpr (ALIGN_EPI) { if (wr == 0) PG8_BAR; }
        if constexpr (!Epi::AFTER_DRAIN) {
            const int tz = opaque_tid(wv), wz = __builtin_amdgcn_readfirstlane(tz >> 6), lz = tz & 63;
            E(acc, cur, wz >> 2, wz & 3, lz & 15, lz >> 4); S.done(cur); }
        if (!has_next) break;
#pragma unroll
        for (int a = 0; a < 2; ++a)
#pragma unroll
            for (int b = 0; b < 2; ++b)
#pragma unroll
                for (int m = 0; m < 4; ++m)
#pragma unroll
                    for (int n = 0; n < 2; ++n) acc[a][b][m][n] = (f32x4){0.f, 0.f, 0.f, 0.f};
        cur = nxt; cA = nA; cB = nB; ++ui;
        if constexpr (Sched::GATHER) { _Pragma("unroll") for (int h_ = 0; h_ < 2; ++h_) _Pragma("unroll") for (int i_ = 0; i_ < 2; ++i_) gcur[h_][i_] = gnxt[h_][i_]; }
        if constexpr (ALIGN_EPI) { if (wr == 1) PG8_BAR; }
    }
    PG8_WAIT_V(0);
    if constexpr (!ALIGN_EPI) { if (wr == 0) PG8_BAR; }
    PG8_BAR;
    if constexpr (Epi::AFTER_DRAIN) { E.fused(acc, cur, wr, wc, fr, fq, lds, wid, lane); S.done(cur); }
#undef PG8_SA
#undef PG8_SB
#undef PG8_STAGE
#undef PG8_STAGE_A
#undef PG8_GOFF
#undef PG8_LDA
#undef PG8_LDB
#undef PG8_MMA
#undef PG8_WAIT_V
#undef PG8_WAIT_L
#undef PG8_BAR
#undef PG8_SCHED
}
}
#define XB_TMO      128
#define XB_XCNT(j)  (256  + 64 * (j))
#define XB_XSUB(j)  (1280 + 64 * (j))
#define XB_XGEN(j)  (2304 + 64 * (j))
#define XB_TOP      3328
#define XB_TOPGEN   3392
#define XCD_BAR_WORDS 3456
#define XB_SPIN_CAP (1u << 18)

__device__ __forceinline__ unsigned xb_ld(unsigned* p)              { return __hip_atomic_load(p, __ATOMIC_RELAXED, __HIP_MEMORY_SCOPE_AGENT); }
__device__ __forceinline__ unsigned xb_add(unsigned* p, unsigned v) { return __hip_atomic_fetch_add(p, v, __ATOMIC_RELAXED, __HIP_MEMORY_SCOPE_AGENT); }
__device__ __forceinline__ unsigned xb_xcc_id() { return (unsigned)__builtin_amdgcn_s_getreg((3 << 11) | 20) & 0xFu; }
#define XB_SPIN(cond, bar) do { unsigned _sp = 0; while (cond) { __builtin_amdgcn_s_sleep(1); \
    if ((++_sp & 255u) == 0u) { if (xb_ld(&(bar)[XB_TMO])) break; if (_sp > XB_SPIN_CAP) { atomicAdd(&(bar)[XB_TMO], 1u); break; } } } } while (0)

struct XcdBarrier {
    unsigned* bar; unsigned x; int wv;
    volatile LAS unsigned* st;
};

__device__ __forceinline__ XcdBarrier xcd_barrier_post(unsigned* bar, volatile LAS unsigned* st, int wv) {
    XcdBarrier b; b.bar = bar; b.x = xb_xcc_id(); b.st = st; b.wv = wv;
    if (opaque_tid(wv) == 0) (void)xb_add(&bar[XB_XCNT(b.x)], 1u);
    return b;
}
__device__ __forceinline__ void xcd_barrier_complete(unsigned* bar, unsigned x, unsigned& nloc, unsigned& nx) {
    const unsigned G = gridDim.x * gridDim.y * gridDim.z;
    unsigned sum, cnt, mine, sp = 0u;
    for (;;) {
        sum = 0u; cnt = 0u; mine = 0u;
#pragma unroll
        for (unsigned j = 0; j < 16; ++j) { const unsigned c = xb_ld(&bar[XB_XCNT(j)]); sum += c; cnt += (c > 0u) ? 1u : 0u; mine = (j == x) ? c : mine; }
        if (sum == G) break;
        __builtin_amdgcn_s_sleep(1);
        if ((++sp & 255u) == 0u) { if (xb_ld(&bar[XB_TMO])) break; if (sp > XB_SPIN_CAP) { atomicAdd(&bar[XB_TMO], 1u); break; } }
    }
    nloc = mine > 0u ? mine : 1u; nx = cnt > 0u ? cnt : 1u;
}

__device__ __forceinline__ void xcd_barrier(const XcdBarrier& b) {
    asm volatile("s_waitcnt vmcnt(0)" ::: "memory");
    __syncthreads();
    if (opaque_tid(b.wv) == 0) {
        unsigned* bar = b.bar;
        __builtin_amdgcn_s_waitcnt(0);
        unsigned nloc = b.st[0], nx = b.st[1];
        if (nloc == 0u) { xcd_barrier_complete(bar, b.x, nloc, nx); b.st[0] = nloc; b.st[1] = nx; }
        const unsigned old = xb_add(&bar[XB_XSUB(b.x)], 1u);
        const unsigned gen = old / nloc;
        if (old + 1u == (gen + 1u) * nloc) {
            __builtin_amdgcn_fence(__ATOMIC_RELEASE, "agent");
            asm volatile("s_waitcnt vmcnt(0)" ::: "memory");
            const unsigned og = xb_add(&bar[XB_TOP], 1u);
            const unsigned tg = og / nx;
            if (og + 1u == (tg + 1u) * nx) xb_add(&bar[XB_TOPGEN], 1u);
            else XB_SPIN(xb_ld(&bar[XB_TOPGEN]) == tg, bar);
            __builtin_amdgcn_fence(__ATOMIC_ACQUIRE, "agent");
            xb_add(&bar[XB_XGEN(b.x)], 1u);
            asm volatile("s_waitcnt vmcnt(0)" ::: "memory");
        } else {
            XB_SPIN(xb_ld(&bar[XB_XGEN(b.x)]) == gen, bar);
            __builtin_amdgcn_fence(__ATOMIC_ACQUIRE, "agent");
            asm volatile("s_waitcnt vmcnt(0)" ::: "memory");
        }
    }
    __syncthreads();
}

typedef unsigned short bf16_t;
typedef short bf16x8 __attribute__((ext_vector_type(8)));
typedef short bf16x4 __attribute__((ext_vector_type(4)));
typedef float f32x4 __attribute__((ext_vector_type(4)));
typedef float f32x2 __attribute__((ext_vector_type(2)));
typedef float f32x16 __attribute__((ext_vector_type(16)));
typedef unsigned u32x4 __attribute__((ext_vector_type(4)));
typedef unsigned u32x2 __attribute__((ext_vector_type(2)));

constexpr int NB = 8, T = 4096, D = 1024, M = NB * T;
constexpr int INC = 4296;
constexpr int NIN = 19 * 256;
constexpr float EPS = 1e-6f;
constexpr int NPOS = 73728;
constexpr int NWAVES = 8, NTHR = 512;
constexpr int LDS_BYTES = 163840;

constexpr size_t MiB = 1u << 20;
constexpr size_t WS_CTL = 0, CTL_ZERO_BYTES = 65536;
constexpr size_t WS_WIN = 1 * MiB, WS_WOUT = 11 * MiB, WS_WPB = 13 * MiB, WS_WOV = 14 * MiB, WS_WSB = 16 * MiB, WS_WRT = 16 * MiB + 262144, WS_WGU = 17 * MiB, WS_WD = 49 * MiB;
constexpr size_t WS_A = 65 * MiB;
constexpr size_t WS_B = 129 * MiB;
constexpr size_t WS_GA = 193 * MiB, WS_GB = 257 * MiB;
constexpr size_t WS_C = 321 * MiB;
constexpr size_t WS_DQ = 385 * MiB;
constexpr size_t WS_CKVR = 417 * MiB, WS_CKVB = 433 * MiB, WS_KI = 441 * MiB, WS_WI = 445 * MiB, WS_SEL = 446 * MiB;
constexpr size_t WS_MOE = 462 * MiB;
constexpr size_t WS_END = 464 * MiB;

constexpr int CW_BAR = 4096;
constexpr int CW_CNT = 8192, CW_CUR = 8256;

struct P {
    const float *x, *w_in, *kv_g, *w_uk, *w_uv, *rel_bias, *ln_g, *ln_b, *w_sp, *b_sp, *w_pa, *w_pb, *w_out, *n1g, *n2g, *rg_w, *rg_b, *re_w, *re_b, *w_gate, *w_up, *w_down, *fg;
    float* out;
    unsigned* ctl;
    bf16_t *WinT, *WoutT, *WpbT, *WovT, *WSB, *WguT, *WdT;
    float* WrT;
    bf16_t *HB, *QL, *QI, *CKVB, *KI, *UB, *VB, *GAB, *GBB, *OL, *US, *MB, *MG, *H2B, *H2S, *HE, *YS;
    float *CKVR, *WI, *EW, *IDXROW, *RINV2;
    unsigned short* SEL;
    int *EID, *PTOK, *MOEI, *GU, *DN, *BLKCNT, *CB;
};

__device__ __forceinline__ unsigned f2bf(float f) { unsigned u = __builtin_bit_cast(unsigned, f); return (u + 0x7fffu + ((u >> 16) & 1u)) >> 16; }
__device__ __forceinline__ unsigned pk2(float lo, float hi) { return f2bf(lo) | (f2bf(hi) << 16); }
__device__ __forceinline__ float bflo(unsigned w) { return __builtin_bit_cast(float, w << 16); }
__device__ __forceinline__ float bfhi(unsigned w) { return __builtin_bit_cast(float, w & 0xffff0000u); }
__device__ __forceinline__ float bf2f(unsigned short b) { return __builtin_bit_cast(float, (unsigned)b << 16); }
__device__ __forceinline__ float wave_sum(float v) {
#pragma unroll
    for (int o = 1; o < 64; o <<= 1) v += __shfl_xor(v, o);
    return v;
}
#define LDS_WAIT() asm volatile("s_waitcnt lgkmcnt(0)" ::: "memory")
__device__ __forceinline__ float sigm(float x) { return __builtin_amdgcn_rcpf(1.f + __builtin_amdgcn_exp2f(-1.4426950409f * x)); }
__device__ __forceinline__ float gelu_t(float x) { const float x2 = x * x; return x * __builtin_amdgcn_rcpf(1.f + __builtin_amdgcn_exp2f(x * (-2.3022082f - 0.1029432f * x2))); }
__device__ __forceinline__ unsigned off_b(unsigned row, unsigned ch) { return 256u * row + 16u * (ch ^ (((row & 3) << 2) | ((row >> 2) & 3))); }
__device__ __forceinline__ bf16x4 tr_read(unsigned lds_addr) { bf16x4 r; asm volatile("ds_read_b64_tr_b16 %0, %1\n\ts_waitcnt lgkmcnt(0)" : "=&v"(r) : "v"(lds_addr) : "memory"); return r; }
__device__ __forceinline__ bf16x8 cat4(bf16x4 a, bf16x4 b) { bf16x8 r; r[0] = a[0]; r[1] = a[1]; r[2] = a[2]; r[3] = a[3]; r[4] = b[0]; r[5] = b[1]; r[6] = b[2]; r[7] = b[3]; return r; }
__device__ __forceinline__ unsigned lds_addr_of(LAS unsigned char* p) { return (unsigned)(unsigned long long)p; }

__device__ __forceinline__ void st8bf(bf16_t* p, const pg8::f32x4& a, const pg8::f32x4& b) {
    u32x4 w; w.x = pg8::cvt_pk_bf16(a[0], a[1]); w.y = pg8::cvt_pk_bf16(a[2], a[3]); w.z = pg8::cvt_pk_bf16(b[0], b[1]); w.w = pg8::cvt_pk_bf16(b[2], b[3]);
    *(u32x4*)p = w;
}
__device__ __forceinline__ void ld8bf(const bf16_t* p, pg8::f32x4& a, pg8::f32x4& b) {
    const u32x4 w = *(const u32x4*)p;
    a[0] = bflo(w.x); a[1] = bfhi(w.x); a[2] = bflo(w.y); a[3] = bfhi(w.y); b[0] = bflo(w.z); b[1] = bfhi(w.z); b[2] = bflo(w.w); b[3] = bfhi(w.w);
}

__device__ __forceinline__ void st8q(unsigned char* p, const pg8::f32x4& a, const pg8::f32x4& b) {
    float v[8];
#pragma unroll
    for (int j = 0; j < 4; ++j) { v[j] = fminf(fmaxf(a[j] * 16.f, -440.f), 440.f); v[4 + j] = fminf(fmaxf(b[j] * 16.f, -440.f), 440.f); }
    u32x2 h, l;
    h.x = (unsigned)__builtin_amdgcn_cvt_pk_fp8_f32(v[0], v[1], 0, false); h.x = (unsigned)__builtin_amdgcn_cvt_pk_fp8_f32(v[2], v[3], (int)h.x, true);
    h.y = (unsigned)__builtin_amdgcn_cvt_pk_fp8_f32(v[4], v[5], 0, false); h.y = (unsigned)__builtin_amdgcn_cvt_pk_fp8_f32(v[6], v[7], (int)h.y, true);
    const f32x2 b0 = __builtin_amdgcn_cvt_pk_f32_fp8((int)h.x, false), b1 = __builtin_amdgcn_cvt_pk_f32_fp8((int)h.x, true);
    const f32x2 b2 = __builtin_amdgcn_cvt_pk_f32_fp8((int)h.y, false), b3 = __builtin_amdgcn_cvt_pk_f32_fp8((int)h.y, true);
    l.x = (unsigned)__builtin_amdgcn_cvt_pk_fp8_f32(v[0] - b0[0], v[1] - b0[1], 0, false); l.x = (unsigned)__builtin_amdgcn_cvt_pk_fp8_f32(v[2] - b1[0], v[3] - b1[1], (int)l.x, true);
    l.y = (unsigned)__builtin_amdgcn_cvt_pk_fp8_f32(v[4] - b2[0], v[5] - b2[1], 0, false); l.y = (unsigned)__builtin_amdgcn_cvt_pk_fp8_f32(v[6] - b3[0], v[7] - b3[1], (int)l.y, true);
    *(u32x2*)p = h; *(u32x2*)(p + 128) = l;
}
struct EpiIn {
    static constexpr bool PERM = true, AFTER_DRAIN = false;
    bf16_t *QL, *QI, *KI, *UB, *VB, *GAB, *GBB; float *CKVR, *WI;
    __device__ __forceinline__ void operator()(const pg8::f32x4 (&acc)[2][2][4][2], const pg8::Unit& u, int wr, int wc, int fr, int fq) const {
        const int row0 = u.pm * 256 + wr * 64 + fr, pn = u.pn, c8 = wc * 32 + 8 * fq;
        int mode; bf16_t* dst; int ld;
        if (pn < 4)       { mode = 0; dst = QL + pn * 256; ld = 1024; }
        else if (pn < 6)  { mode = 0; dst = QI + (pn - 4) * 256; ld = 512; }
        else if (pn == 6) { mode = 3; dst = KI; ld = 64; }
        else if (pn < 9)  { mode = 1; dst = UB + (pn - 7) * 256; ld = 512; }
        else if (pn < 11) { mode = 1; dst = VB + (pn - 9) * 256; ld = 512; }
        else if (pn < 15) { mode = 2; dst = GAB + (pn - 11) * 256; ld = 1024; }
        else              { mode = 2; dst = GBB + (pn - 15) * 256; ld = 1024; }
#pragma unroll
        for (int ai = 0; ai < 2; ++ai)
#pragma unroll
            for (int m = 0; m < 4; ++m) {
                const size_t row = (size_t)(row0 + ai * 128 + m * 16);
#pragma unroll
                for (int bj = 0; bj < 2; ++bj) {
                    pg8::f32x4 v0 = acc[ai][bj][m][0], v1 = acc[ai][bj][m][1];
                    if (mode == 3) {
                        if (bj == 0) { float* c = CKVR + row * 128 + c8; *(pg8::f32x4*)c = v0; *(pg8::f32x4*)(c + 4) = v1; }
                        else if (c8 < 64) st8bf(KI + row * 64 + c8, v0, v1);
                        else if (c8 == 64) { float* c = WI + row * 8; *(pg8::f32x4*)c = v0 * 0.044194174f; *(pg8::f32x4*)(c + 4) = v1 * 0.044194174f; }
                    } else {
                        if (mode == 1) {
#pragma unroll
                            for (int j = 0; j < 4; ++j) { v0[j] = gelu_t(v0[j]); v1[j] = gelu_t(v1[j]); }
                        } else if (mode == 2) {
#pragma unroll
                            for (int j = 0; j < 4; ++j) { v0[j] = sigm(v0[j]); v1[j] = sigm(v1[j]); }
                        }
                        if (pn < 4) st8q((unsigned char*)QL + row * 2048 + (pn * 2 + bj) * 256 + c8, v0, v1);
                        else st8bf(dst + row * ld + bj * 128 + c8, v0, v1);
                    }
                }
            }
    }
};

struct EpiMB {
    static constexpr bool PERM = true, AFTER_DRAIN = false;
    const bf16_t* G; bf16_t* O;
    __device__ __forceinline__ void operator()(const pg8::f32x4 (&acc)[2][2][4][2], const pg8::Unit& u, int wr, int wc, int fr, int fq) const {
        const int row0 = u.pm * 256 + wr * 64 + fr, col0 = u.pn * 256 + wc * 32 + 8 * fq;
#pragma unroll
        for (int ai = 0; ai < 2; ++ai)
#pragma unroll
            for (int m = 0; m < 4; ++m)
#pragma unroll
                for (int bj = 0; bj < 2; ++bj) {
                    const size_t o = (size_t)(row0 + ai * 128 + m * 16) * 1024 + col0 + bj * 128;
                    pg8::f32x4 g0, g1; ld8bf(G + o, g0, g1);
                    st8bf(O + o, acc[ai][bj][m][0] * g0, acc[ai][bj][m][1] * g1);
                }
    }
};
struct EpiMG {
    static constexpr bool PERM = true, AFTER_DRAIN = false;
    const bf16_t *G, *MBp; bf16_t* O;
    __device__ __forceinline__ void operator()(const pg8::f32x4 (&acc)[2][2][4][2], const pg8::Unit& u, int wr, int wc, int fr, int fq) const {
        const int row0 = u.pm * 256 + wr * 64 + fr, col0 = u.pn * 256 + wc * 32 + 8 * fq;
#pragma unroll
        for (int ai = 0; ai < 2; ++ai)
#pragma unroll
            for (int m = 0; m < 4; ++m)
#pragma unroll
                for (int bj = 0; bj < 2; ++bj) {
                    const size_t o = (size_t)(row0 + ai * 128 + m * 16) * 1024 + col0 + bj * 128;
                    pg8::f32x4 g0, g1, b0, b1; ld8bf(G + o, g0, g1); ld8bf(MBp + o, b0, b1);
                    st8bf(O + o, acc[ai][bj][m][0] * g0 + b0, acc[ai][bj][m][1] * g1 + b1);
                }
    }
};
struct EpiX1 {
    static constexpr bool PERM = true, AFTER_DRAIN = false;
    const float* X; float* O;
    __device__ __forceinline__ void operator()(const pg8::f32x4 (&acc)[2][2][4][2], const pg8::Unit& u, int wr, int wc, int fr, int fq) const {
        const int row0 = u.pm * 256 + wr * 64 + fr, col0 = u.pn * 256 + wc * 32 + 8 * fq;
#pragma unroll
        for (int ai = 0; ai < 2; ++ai)
#pragma unroll
            for (int m = 0; m < 4; ++m)
#pragma unroll
                for (int bj = 0; bj < 2; ++bj) {
                    const size_t o = (size_t)(row0 + ai * 128 + m * 16) * 1024 + col0 + bj * 128;
                    const pg8::f32x4 x0 = *(const pg8::f32x4*)(X + o), x1 = *(const pg8::f32x4*)(X + o + 4);
                    *(pg8::f32x4*)(O + o) = x0 + acc[ai][bj][m][0]; *(pg8::f32x4*)(O + o + 4) = x1 + acc[ai][bj][m][1];
                }
    }
};
struct EpiHE {
    static constexpr bool PERM = true, AFTER_DRAIN = false;
    bf16_t* HE; const int* PTOK; const float* RINV2;
    __device__ __forceinline__ void operator()(const pg8::f32x4 (&acc)[2][2][4][2], const pg8::Unit& u, int wr, int wc, int fr, int fq) const {
        const int row0 = u.pm * 256 + wr * 64 + fr, col0 = (u.pn & 1) * 128 + wc * 32 + 8 * fq;
#pragma unroll
        for (int ai = 0; ai < 2; ++ai) {
            int ts[4]; float ri[4];
#pragma unroll
            for (int m = 0; m < 4; ++m) ts[m] = PTOK[row0 + ai * 128 + m * 16];
#pragma unroll
            for (int m = 0; m < 4; ++m) ri[m] = RINV2[ts[m] < 0 ? 0 : (ts[m] >> 1)];
#pragma unroll
            for (int m = 0; m < 4; ++m) {
                const float r = ts[m] < 0 ? 0.f : ri[m];
                pg8::f32x4 h0, h1;
#pragma unroll
                for (int j = 0; j < 4; ++j) {
                    const float g0 = r * acc[ai][0][m][0][j], g1 = r * acc[ai][0][m][1][j];
                    h0[j] = g0 * sigm(g0) * (r * acc[ai][1][m][0][j]); h1[j] = g1 * sigm(g1) * (r * acc[ai][1][m][1][j]);
                }
                st8bf(HE + (size_t)(row0 + ai * 128 + m * 16) * 256 + col0, h0, h1);
            }
        }
    }
};
struct EpiDown {
    static constexpr bool PERM = true, AFTER_DRAIN = false;
    const int* PTOK; const float* EW; bf16_t* YS;
    __device__ __forceinline__ void operator()(const pg8::f32x4 (&acc)[2][2][4][2], const pg8::Unit& u, int wr, int wc, int fr, int fq) const {
        const int row0 = u.pm * 256 + wr * 64 + fr, col0 = (u.pn & 3) * 256 + wc * 32 + 8 * fq;
#pragma unroll
        for (int ai = 0; ai < 2; ++ai) {
            int ts[4]; float w[4];
#pragma unroll
            for (int m = 0; m < 4; ++m) ts[m] = PTOK[row0 + ai * 128 + m * 16];
#pragma unroll
            for (int m = 0; m < 4; ++m) w[m] = EW[ts[m] < 0 ? 0 : ts[m]];
#pragma unroll
            for (int m = 0; m < 4; ++m) {
                const int t = ts[m];
                if (t >= 0) {
                    bf16_t* d = YS + ((size_t)(t & 1) * M + (size_t)(t >> 1)) * 1024 + col0;
#pragma unroll
                    for (int bj = 0; bj < 2; ++bj) st8bf(d + bj * 128, acc[ai][bj][m][0] * w[m], acc[ai][bj][m][1] * w[m]);
                }
            }
        }
    }
};
constexpr int LDS_TAB_OFF = 155648;
__device__ __forceinline__ void table_prefetch(LAS unsigned char* lds, const int* tab, const int* nunits, int G, int c, int tid) {
    LAS int* lt = (LAS int*)(lds + LDS_TAB_OFF);
    if (tid < 16) { const int idx = (tid >> 1) * G + c; const int n = __builtin_nontemporal_load(nunits); lt[tid] = idx < n ? tab[2 * idx + (tid & 1)] : -1; }
    __syncthreads();
}
struct TableOrder {
    static constexpr bool GATHER = false;
    const int* tab; const int* nunits; int G, c; const LAS int* lt;
    __device__ __forceinline__ int arow(int r) const { return r; }
    __device__ __forceinline__ bool next(int i, pg8::Unit& u) const {
        if (i < 8) { const int a = lt[2 * i]; if (a < 0) return false; u.pm = a; u.pn = lt[2 * i + 1]; return true; }
        const int idx = i * G + c; const int n = __builtin_nontemporal_load(nunits);
        if (idx >= n) return false;
        u.pm = tab[2 * idx]; u.pn = tab[2 * idx + 1]; return true;
    }
    __device__ __forceinline__ void a_ready(const pg8::Unit&) const {}
    __device__ __forceinline__ void done(const pg8::Unit&) const {}
};

struct TableGatherOrder {
    static constexpr bool GATHER = true;
    const int* tab; const int* nunits; const int* ptok; int G, c; const LAS int* lt;
    __device__ __forceinline__ bool next(int i, pg8::Unit& u) const {
        if (i < 8) { const int a = lt[2 * i]; if (a < 0) return false; u.pm = a; u.pn = lt[2 * i + 1]; return true; }
        const int idx = i * G + c; const int n = __builtin_nontemporal_load(nunits);
        if (idx >= n) return false;
        u.pm = tab[2 * idx]; u.pn = tab[2 * idx + 1]; return true;
    }
    __device__ __forceinline__ int arow(int r) const { const int ts = ptok[r]; return ts < 0 ? 0 : (ts >> 1); }
    __device__ __forceinline__ void a_ready(const pg8::Unit&) const {}
    __device__ __forceinline__ void done(const pg8::Unit&) const {}
};

__device__ __forceinline__ void tr_item(const float* src, int ld, int K, int NC, bf16_t* dst, LAS float* scr, int item, int lane) {
    const int nblk = NC / 32, kb = item / nblk, nb = item % nblk, k0 = 64 * kb, n0 = 32 * nb;
    f32x4 tv[8];
    const int tr = lane >> 3, tc = (lane & 7) * 4;
    if ((((size_t)src) & 15) == 0 && (ld & 3) == 0) {
#pragma unroll
        for (int i = 0; i < 8; ++i) tv[i] = *(const f32x4*)(src + (size_t)(k0 + 8 * i + tr) * ld + n0 + tc);
    } else {
#pragma unroll
        for (int i = 0; i < 8; ++i) { const float* q = src + (size_t)(k0 + 8 * i + tr) * ld + n0 + tc; tv[i] = (f32x4){q[0], q[1], q[2], q[3]}; }
    }
#pragma unroll
    for (int i = 0; i < 8; ++i) { LAS float* d = scr + (8 * i + tr) * 33 + tc; d[0] = tv[i].x; d[1] = tv[i].y; d[2] = tv[i].z; d[3] = tv[i].w; }
    LDS_WAIT();
    const int c = lane & 7;
#pragma unroll
    for (int j = 0; j < 4; ++j) { const int n = (lane >> 3) + 8 * j; const LAS float* s = scr + (8 * c) * 33 + n;
        u32x4 o; o.x = pk2(s[0 * 33], s[1 * 33]); o.y = pk2(s[2 * 33], s[3 * 33]); o.z = pk2(s[4 * 33], s[5 * 33]); o.w = pk2(s[6 * 33], s[7 * 33]);
        *(u32x4*)(dst + (size_t)(n0 + n) * K + k0 + 8 * c) = o; }
    LDS_WAIT();
}

__device__ __forceinline__ void prep_gateup(const P& p, LAS unsigned char* lds, int w_idx, int nw, int wave, int lane) {
    LAS float* scr = (LAS float*)(lds + wave * 16384);
    for (int it = w_idx; it < 8192; it += nw) {
        const int sub = it & 63, q = it >> 6, gu = q & 1, j = (q >> 1) & 1, e = q >> 2;
        const float* src = (gu ? p.w_up : p.w_gate) + (size_t)e * 262144 + 128 * j;
        tr_item(src, 256, 1024, 128, p.WguT + ((size_t)e * 512 + j * 256 + gu * 128) * 1024, scr, sub, lane);
    }
}

__device__ __forceinline__ void ph_prep(const P& p, LAS unsigned char* lds, const int wv) {
    const int tid = opaque_tid(wv), lane = tid & 63, wave = __builtin_amdgcn_readfirstlane(tid >> 6);
    LAS float* scr = (LAS float*)(lds + wave * 16384);
    const int gw = blockIdx.x * NWAVES + wave, NGW = gridDim.x * NWAVES;
    const int gt = blockIdx.x * NTHR + tid, NGT = gridDim.x * NTHR;
    {
        const int c0s[7] = {640, 512, 1152, 1224, 1736, 2248, 3272};
        const int ncs[7] = {512, 128, 64, 512, 512, 1024, 1024};
        const int r0s[7] = {1024, 1536, 1664, 1792, 2304, 2816, 3840};
#pragma unroll
        for (int s = 0; s < 7; ++s) {
            const int nit = 16 * (ncs[s] / 32);
            for (int it = gw; it < nit; it += NGW) tr_item(p.w_in + c0s[s], INC, 1024, ncs[s], p.WinT + (size_t)r0s[s] * 1024, scr, it, lane);
        }
    }
    for (int i = gt; i < 64 * 1024; i += NGT) { const int j = i >> 10, k = i & 1023; p.WinT[(size_t)(1728 + j) * 1024 + k] = j < 8 ? (bf16_t)f2bf(p.w_in[(size_t)k * INC + 1216 + j]) : (bf16_t)0; }
    for (int it = gw; it < 512; it += NGW) tr_item(p.w_out, 1024, 1024, 1024, p.WoutT, scr, it, lane);
    for (int it = gw; it < 256; it += NGW) tr_item(p.w_pb, 1024, 512, 1024, p.WpbT, scr, it, lane);
    for (int it = gw; it < 4096; it += NGW) { const int sub = it & 127, e = it >> 7; tr_item(p.w_down + (size_t)e * 262144, 1024, 256, 1024, p.WdT + (size_t)e * 262144, scr, sub, lane); }
    for (int it = gw; it < 1024; it += NGW) {
        const int h = it >> 7, kt = (it >> 2) & 31, rt = it & 3, i = lane & 31, hf = lane >> 5;
        const f32x4* ap = (const f32x4*)(p.w_in + (size_t)(kt * 32 + i) * INC + h * 64 + 32 * hf);
        const f32x4* bp = (const f32x4*)(p.w_uk + (size_t)((rt * 32 + i) * 8 + h) * 64 + 32 * hf);
        f32x4 av[8], bv[8];
#pragma unroll
        for (int j = 0; j < 8; ++j) { av[j] = ap[j]; bv[j] = bp[j]; }
        f32x16 acc;
#pragma unroll
        for (int j = 0; j < 16; ++j) acc[j] = 0.f;
#pragma unroll
        for (int j = 0; j < 8; ++j)
#pragma unroll
            for (int e = 0; e < 4; ++e) acc = __builtin_amdgcn_mfma_f32_32x32x2f32(av[j][e], bv[j][e], acc, 0, 0, 0);
#pragma unroll
        for (int g4 = 0; g4 < 4; ++g4) {
            constexpr float QS = 0.125f * 1.4426950409f;
            u32x2 w; w.x = pk2(QS * acc[4 * g4], QS * acc[4 * g4 + 1]); w.y = pk2(QS * acc[4 * g4 + 2], QS * acc[4 * g4 + 3]);
            *(u32x2*)(p.WinT + (size_t)(h * 128 + rt * 32 + i) * 1024 + kt * 32 + 8 * g4 + 4 * hf) = w;
        }
    }
    for (int it = gw; it < 1024; it += NGW) {
        const int h = it >> 7, nt = (it >> 2) & 31, rt = it & 3, i = lane & 31, hf = lane >> 5;
        const f32x4* ap = (const f32x4*)(p.w_uv + (size_t)((rt * 32 + i) * 8 + h) * 64 + 32 * hf);
        const float* bp = p.w_pa + (size_t)(h * 64 + 32 * hf) * 1024 + nt * 32 + i;
        f32x4 av[8]; float bv[32];
#pragma unroll
        for (int j = 0; j < 8; ++j) av[j] = ap[j];
#pragma unroll
        for (int j = 0; j < 32; ++j) bv[j] = bp[(size_t)j * 1024];
        f32x16 acc;
#pragma unroll
        for (int j = 0; j < 16; ++j) acc[j] = 0.f;
#pragma unroll
        for (int j = 0; j < 8; ++j)
#pragma unroll
            for (int e = 0; e < 4; ++e) acc = __builtin_amdgcn_mfma_f32_32x32x2f32(av[j][e], bv[4 * j + e], acc, 0, 0, 0);
#pragma unroll
        for (int g4 = 0; g4 < 4; ++g4) {
            u32x2 w; w.x = pk2(acc[4 * g4], acc[4 * g4 + 1]); w.y = pk2(acc[4 * g4 + 2], acc[4 * g4 + 3]);
            *(u32x2*)(p.WovT + (size_t)(nt * 32 + i) * 1024 + h * 128 + rt * 32 + 8 * g4 + 4 * hf) = w;
        }
    }
    for (int i = gt; i < 4 * 128 * 128; i += NGT) { const int jj = i & 127, ii = (i >> 7) & 127; p.WSB[i] = jj <= ii ? (bf16_t)f2bf(p.w_sp[i]) : (bf16_t)0; }
    for (int i = gt; i < 36 * 1024; i += NGT) { const int c = i >> 10, k = i & 1023; p.WrT[i] = c < 4 ? p.rg_w[k * 4 + c] : p.re_w[k * 32 + (c - 4)]; }
    for (int m4 = gw; m4 < M / 4; m4 += NGW) {
        f32x4 v[4][4]; float ss[4];
#pragma unroll
        for (int r = 0; r < 4; ++r) { const f32x4* xr = (const f32x4*)(p.x + (size_t)(4 * m4 + r) * D) + lane;
#pragma unroll
            for (int j = 0; j < 4; ++j) v[r][j] = xr[64 * j]; }
#pragma unroll
        for (int r = 0; r < 4; ++r) { ss[r] = 0.f;
#pragma unroll
            for (int j = 0; j < 4; ++j) ss[r] += (v[r][j].x * v[r][j].x + v[r][j].y * v[r][j].y) + (v[r][j].z * v[r][j].z + v[r][j].w * v[r][j].w); }
#pragma unroll
        for (int o = 1; o < 64; o <<= 1) {
#pragma unroll
            for (int r = 0; r < 4; ++r) ss[r] += __shfl_xor(ss[r], o);
        }
#pragma unroll
        for (int r = 0; r < 4; ++r) {
            const float rinv = 1.0f / sqrtf(ss[r] * (1.f / D) + EPS);
            unsigned long long* o8 = (unsigned long long*)(p.HB + (size_t)(4 * m4 + r) * D) + lane;
#pragma unroll
            for (int j = 0; j < 4; ++j) { const f32x4 g = ((const f32x4*)p.n1g)[lane + 64 * j]; const f32x4 o = v[r][j] * rinv * g;
                o8[64 * j] = (unsigned long long)pk2(o.x, o.y) | ((unsigned long long)pk2(o.z, o.w) << 32); }
        }
    }
}

__device__ __forceinline__ void ph_ckvnorm(const P& p, const int wv) {
    const int tid = opaque_tid(wv), lane = tid & 63, wave = tid >> 6;
    const int gw = blockIdx.x * NWAVES + wave, NGW = gridDim.x * NWAVES;
    const float g0 = p.kv_g[2 * lane], g1 = p.kv_g[2 * lane + 1];
    for (int m4 = gw; m4 < M / 4; m4 += NGW) {
        float2 v[4]; float ss[4];
#pragma unroll
        for (int r = 0; r < 4; ++r) v[r] = ((const float2*)(p.CKVR + (size_t)(4 * m4 + r) * 128))[lane];
#pragma unroll
        for (int r = 0; r < 4; ++r) ss[r] = v[r].x * v[r].x + v[r].y * v[r].y;
#pragma unroll
        for (int o = 1; o < 64; o <<= 1) {
#pragma unroll
            for (int r = 0; r < 4; ++r) ss[r] += __shfl_xor(ss[r], o);
        }
#pragma unroll
        for (int r = 0; r < 4; ++r) { const float rinv = 1.0f / sqrtf(ss[r] * (1.f / 128.f) + EPS);
            const float c0 = fminf(fmaxf(v[r].x * rinv * g0, -440.f), 440.f), c1 = fminf(fmaxf(v[r].y * rinv * g1, -440.f), 440.f);
            ((unsigned short*)((unsigned char*)p.CKVB + (size_t)(4 * m4 + r) * 128))[lane] = (unsigned short)__builtin_amdgcn_cvt_pk_fp8_f32(c0, c1, 0, false); }
    }
}

typedef int i32x8 __attribute__((ext_vector_type(8)));
#ifndef ATT_SKEW
#define ATT_SKEW 10
#endif
__device__ __forceinline__ bf16x4 tr16(const LAS unsigned char* a) { return __builtin_amdgcn_ds_read_tr16_b64_v4i16((LAS bf16x4*)a); }
__device__ __forceinline__ unsigned att_f(unsigned row) { return ((row >> 1) & 3u) | ((((row >> 2) ^ (row >> 4)) & 1u) << 2); }
__device__ __forceinline__ float vmax3(float a, float b, float c) { float r; asm("v_max3_f32 %0, %1, %2, %3" : "=v"(r) : "v"(a), "v"(b), "v"(c)); return r; }
__device__ __forceinline__ float vmax2(float a, float b) { float r; asm("v_max_f32 %0, %1, %2" : "=v"(r) : "v"(a), "v"(b)); return r; }
__device__ __forceinline__ float ror8(float x) { return __int_as_float(__builtin_amdgcn_update_dpp(0, __float_as_int(x), 0x128, 0xf, 0xf, false)); }
__device__ __forceinline__ float xmax16(float x) {
    auto a = __builtin_amdgcn_permlane16_swap(__float_as_uint(x), __float_as_uint(x), false, false);
    const float y = vmax2(__uint_as_float(a[0]), __uint_as_float(a[1]));
    auto b = __builtin_amdgcn_permlane32_swap(__float_as_uint(y), __float_as_uint(y), false, false);
    return vmax2(__uint_as_float(b[0]), __uint_as_float(b[1]));
}
template <int STRIP>
__device__ __forceinline__ void ph_attn_t(const P& p, LAS unsigned char* lds, const int wv) {
    const int tid = opaque_tid(wv), lane = tid & 63, wave = __builtin_amdgcn_readfirstlane(tid >> 6);
    LAS unsigned char* buf = lds + wave * 16384;
    LAS unsigned char* selL = lds + 131072 + wave * 3072;
    LAS unsigned char* selT = selL + 1024;
    LAS unsigned char* bias = lds + 155648;
    for (int i = tid; i < 1024; i += NTHR) {
        const int d = i >> 3; int bk = d;
        if (d >= 16) { const float nf = (float)d; bk = 16 + (int)(logf(nf / 16.f) / 2.0794415f * 16.f); if (bk > 31) bk = 31; }
        ((LAS float*)bias)[i] = 1.4426950409f * p.rel_bias[bk * 8 + (i & 7)];
    }
    __syncthreads();
    const int g = lane >> 4, hcol = lane & 15, r8 = lane >> 3, pc = lane & 7;
    const int G = gridDim.x, bx = blockIdx.x, vcu = (G % 8 == 0) ? (bx % 8) * (G / 8) + bx / 8 : bx;
    const unsigned so0 = 16u * ((unsigned)pc ^ att_f((unsigned)r8)), so1 = so0 ^ 64u;
    unsigned qka[2][2], tra[8];
#pragma unroll
    for (int tau = 0; tau < 2; ++tau)
#pragma unroll
        for (int r = 0; r < 2; ++r) { const unsigned row = hcol + 16 * tau; qka[tau][r] = (unsigned)(size_t)buf + row * 128u + 16u * ((2u * g + r) ^ att_f(row)); }
    {   const unsigned q = (lane & 15) >> 1, row = q < 4 ? 4 * g + q : 16 + 4 * g + (q - 4);
#pragma unroll
        for (int rt = 0; rt < 8; ++rt) tra[rt] = (unsigned)(size_t)buf + row * 128u + 16u * ((unsigned)rt ^ att_f(row)) + 8u * (lane & 1);
    }
    const unsigned biasl = (unsigned)(size_t)bias + 4u * (hcol & 7);
    const unsigned qoff = (unsigned)((hcol & 7) * 256 + 32 * g + (hcol >> 3) * 128), svoff = 8u * (unsigned)lane;
    const long ones8 = 0x3838383838383838L;
#define ATT_Q_LOAD(mm) do { const unsigned char* qb = (const unsigned char*)p.QL + (size_t)(mm) * 2048;            \
        asm volatile("global_load_dwordx4 %0, %1, %2" : "=v"(qn0) : "v"(qoff), "s"(qb)); asm volatile("global_load_dwordx4 %0, %1, %2 offset:16" : "=v"(qn1) : "v"(qoff), "s"(qb)); } while (0)
#define ATT_SV_LOAD(mm) do { const unsigned short* sb = p.SEL + (size_t)(mm) * 256; asm volatile("global_load_dwordx2 %0, %1, %2" : "=v"(sv) : "v"(svoff), "s"(sb)); } while (0)
#define ATT_DMA_CHUNK(img_, selt_, c_) do { const u32x4 k4 = *(const LAS u32x4*)((selt_) + 128 * (c_) + 16 * r8);        \
        __builtin_amdgcn_global_load_lds((const unsigned*)(ckb + (k4.x + so0)), (LAS unsigned*)(img_), 16, 0, 0); \
        __builtin_amdgcn_global_load_lds((const unsigned*)(ckb + (k4.y + so0)), (LAS unsigned*)((img_) + 1024), 16, 0, 0); \
        __builtin_amdgcn_global_load_lds((const unsigned*)(ckb + (k4.z + so1)), (LAS unsigned*)((img_) + 2048), 16, 0, 0); \
        __builtin_amdgcn_global_load_lds((const unsigned*)(ckb + (k4.w + so1)), (LAS unsigned*)((img_) + 3072), 16, 0, 0); } while (0)
#define ATT_SEL_WRITE(par_, sv_, tq_) do { \
        const int k0 = (int)((sv_).x & 0xffffu), k1 = (int)((sv_).x >> 16), k2 = (int)((sv_).y & 0xffffu), k3 = (int)((sv_).y >> 16); \
        const int d0 = min((tq_) - k0, 127), d1 = min((tq_) - k1, 127), d2 = min((tq_) - k2, 127), d3 = min((tq_) - k3, 127); \
        u32x2 dw; dw.x = (unsigned)(d0 * 32) | ((unsigned)(d1 * 32) << 16); dw.y = (unsigned)(d2 * 32) | ((unsigned)(d3 * 32) << 16); \
        *(LAS u32x2*)(selL + (par_) * 512 + lane * 8) = dw; \
        LAS unsigned* tq = (LAS unsigned*)(selT + (par_) * 1024) + (lane >> 3) * 32 + (4 * (lane & 1)) * 4 + ((lane & 7) >> 1); \
        tq[0] = (unsigned)k0 * 128u; tq[4] = (unsigned)k1 * 128u; tq[8] = (unsigned)k2 * 128u; tq[12] = (unsigned)k3 * 128u; } while (0)
    for (int qc = vcu; qc < M / 128; qc += G) {
        const int m0 = qc * 128 + wave * 16;
        const size_t mb = (size_t)(m0 >> 12) * T;
        const unsigned char* ckb = (const unsigned char*)p.CKVB + mb * 128;
        u32x2 sv; u32x4 qn0, qn1; i32x8 qh;
        ATT_SV_LOAD(m0);
        ATT_Q_LOAD(m0);
        asm volatile("s_waitcnt vmcnt(0)" ::: "memory");
        asm volatile("" : "+v"(qn0), "+v"(qn1), "+v"(sv));
        ATT_SEL_WRITE(0, sv, m0 & (T - 1));
        LDS_WAIT();
        ATT_DMA_CHUNK(buf, selT, 0);
        ATT_DMA_CHUNK(buf + 4096, selT, 1);
        __builtin_amdgcn_sched_barrier(0);
        ATT_SV_LOAD(m0 + 1);
        f32x4 o[8], ls; float mref = -1e30f;
#pragma unroll
        for (int rt = 0; rt < 8; ++rt) o[rt] = (f32x4){0.f, 0.f, 0.f, 0.f};
        ls = (f32x4){0.f, 0.f, 0.f, 0.f};
#define ATT_BODY(cp_) do { \
            const int m = m0 + qi, t = m & (T - 1); \
            const LAS unsigned char* selc = selL + (qi & 1) * 512; \
            if ((cp_) == 0) qh = (i32x8){(int)qn0.x, (int)qn0.y, (int)qn0.z, (int)qn0.w, (int)qn1.x, (int)qn1.y, (int)qn1.z, (int)qn1.w}; \
            if (STRIP >= 2) { } \
            else if ((cp_) < 3) { ATT_DMA_CHUNK(buf + (((cp_) + 1) & 1) * 8192, selT + (qi & 1) * 1024, 2 * (cp_) + 2); ATT_DMA_CHUNK(buf + (((cp_) + 1) & 1) * 8192 + 4096, selT + (qi & 1) * 1024, 2 * (cp_) + 3); \
                __builtin_amdgcn_sched_barrier(0); \
                if ((cp_) == 0) { if (qi == 0) asm volatile("s_waitcnt vmcnt(8)" ::: "memory"); else asm volatile("s_waitcnt vmcnt(16)" ::: "memory"); } \
                else if ((cp_) == 1) { if (qi < 15) asm volatile("s_waitcnt vmcnt(10)" ::: "memory"); else asm volatile("s_waitcnt vmcnt(8)" ::: "memory"); } \
                else { if (qi < 14) asm volatile("s_waitcnt vmcnt(9)" ::: "memory"); else asm volatile("s_waitcnt vmcnt(8)" ::: "memory"); } } \
            else if (qi < 15) { ATT_DMA_CHUNK(buf, selT + ((qi + 1) & 1) * 1024, 0); ATT_DMA_CHUNK(buf + 4096, selT + ((qi + 1) & 1) * 1024, 1); \
                __builtin_amdgcn_sched_barrier(0); asm volatile("s_waitcnt vmcnt(8)" ::: "memory"); } \
            else { __builtin_amdgcn_sched_barrier(0); asm volatile("s_waitcnt vmcnt(0)" ::: "memory"); } \
            __builtin_amdgcn_sched_barrier(0); \
              \
              \
            if ((cp_) == 2 && qi < 15) asm volatile("" : "+v"(qn0), "+v"(qn1)); \
            if ((cp_) == 3 && qi < 14) asm volatile("" : "+v"(sv)); \
            if (STRIP == 1) break; \
              \
            i32x8 af[2][2]; u32x2 kk[2][2]; \
            _Pragma("unroll") for (int h = 0; h < 2; ++h) _Pragma("unroll") for (int tau = 0; tau < 2; ++tau) { \
                kk[h][tau] = *(const LAS u32x2*)(selc + 2 * (64 * (cp_) + 32 * h + 16 * tau + 4 * g)); \
                const u32x4 a0 = *(const LAS u32x4*)(size_t)(qka[tau][0] + ((cp_) & 1) * 8192 + h * 4096), a1 = *(const LAS u32x4*)(size_t)(qka[tau][1] + ((cp_) & 1) * 8192 + h * 4096); \
                af[h][tau] = (i32x8){(int)a0.x, (int)a0.y, (int)a0.z, (int)a0.w, (int)a1.x, (int)a1.y, (int)a1.z, (int)a1.w}; } \
              \
            long ta[2][8]; \
            if (STRIP == 4) { _Pragma("unroll") for (int rt = 0; rt < 8; ++rt) { ta[0][rt] = 0; ta[1][rt] = 0; } } else \
            _Pragma("unroll") for (int rt = 0; rt < 8; ++rt) { \
                if (((cp_) & 1) == 0) { asm volatile("ds_read_b64_tr_b8 %0, %1" : "=v"(ta[0][rt]) : "v"(tra[rt])); asm volatile("ds_read_b64_tr_b8 %0, %1 offset:4096" : "=v"(ta[1][rt]) : "v"(tra[rt])); } \
                else { asm volatile("ds_read_b64_tr_b8 %0, %1 offset:8192" : "=v"(ta[0][rt]) : "v"(tra[rt])); asm volatile("ds_read_b64_tr_b8 %0, %1 offset:12288" : "=v"(ta[1][rt]) : "v"(tra[rt])); } \
            } \
            float bv[2][2][4]; \
            if (STRIP == 3) { _Pragma("unroll") for (int h = 0; h < 2; ++h) _Pragma("unroll") for (int tau = 0; tau < 2; ++tau) { bv[h][tau][0] = __uint_as_float(kk[h][tau].x); bv[h][tau][1] = __uint_as_float(kk[h][tau].y); bv[h][tau][2] = 1.f; bv[h][tau][3] = 2.f; } } else \
            _Pragma("unroll") for (int h = 0; h < 2; ++h) _Pragma("unroll") for (int tau = 0; tau < 2; ++tau) { \
                bv[h][tau][0] = *(const LAS float*)(size_t)(biasl + (kk[h][tau].x & 0xffffu)); bv[h][tau][1] = *(const LAS float*)(size_t)(biasl + (kk[h][tau].x >> 16)); \
                bv[h][tau][2] = *(const LAS float*)(size_t)(biasl + (kk[h][tau].y & 0xffffu)); bv[h][tau][3] = *(const LAS float*)(size_t)(biasl + (kk[h][tau].y >> 16)); } \
            if ((cp_) == 0 && qi < 15) ATT_Q_LOAD(m + 1); \
            if ((cp_) == 1 && qi < 15) { \
                ATT_SEL_WRITE((qi + 1) & 1, sv, (m + 1) & (T - 1)); \
                if (qi < 14) ATT_SV_LOAD(m + 2); \
            } \
            __builtin_amdgcn_sched_barrier(0); \
            f32x4 acc[2][2]; \
            if (STRIP == 6) { _Pragma("unroll") for (int h = 0; h < 2; ++h) _Pragma("unroll") for (int tau = 0; tau < 2; ++tau) acc[h][tau] = (f32x4){__int_as_float(af[h][tau][0]), __int_as_float(af[h][tau][1]), __int_as_float(af[h][tau][4]), __int_as_float(af[h][tau][5])}; } else { \
            _Pragma("unroll") for (int h = 0; h < 2; ++h) _Pragma("unroll") for (int tau = 0; tau < 2; ++tau) \
                acc[h][tau] = __builtin_amdgcn_mfma_scale_f32_16x16x128_f8f6f4(af[h][tau], qh, (f32x4){0.f, 0.f, 0.f, 0.f}, 0, 0, 0, 0, 0, 0); } \
            float sc[2][2][4]; \
            _Pragma("unroll") for (int h = 0; h < 2; ++h) _Pragma("unroll") for (int tau = 0; tau < 2; ++tau) _Pragma("unroll") for (int r = 0; r < 4; ++r) \
                sc[h][tau][r] = fmaf(acc[h][tau][r] + ror8(acc[h][tau][r]), 0.0625f, bv[h][tau][r]);        \
            if (t < 255) {                                           \
                _Pragma("unroll") for (int h = 0; h < 2; ++h) _Pragma("unroll") for (int tau = 0; tau < 2; ++tau) _Pragma("unroll") for (int r = 0; r < 4; ++r) \
                    if (64 * (cp_) + 32 * h + 16 * tau + 4 * g + r > t) sc[h][tau][r] = -1e30f; \
            } \
            const float mxa = vmax3(vmax3(sc[0][0][0], sc[0][0][1], sc[0][0][2]), vmax3(sc[0][0][3], sc[0][1][0], sc[0][1][1]), vmax3(sc[0][1][2], sc[0][1][3], sc[1][0][0])); \
            const float mxb = vmax3(vmax3(sc[1][0][1], sc[1][0][2], sc[1][0][3]), vmax3(sc[1][1][0], sc[1][1][1], sc[1][1][2]), sc[1][1][3]); \
            const float mx = xmax16(vmax2(mxa, mxb)); \
            if ((cp_) == 0) mref = mx; \
            else if (__builtin_amdgcn_ballot_w64(mx > mref + 3.0f) != 0) {                         \
                const float mn = vmax2(mref, mx), rs = __builtin_amdgcn_exp2f(mref - mn); mref = mn; \
                _Pragma("unroll") for (int rt = 0; rt < 8; ++rt) o[rt] *= rs; \
                ls *= rs; \
            } \
            const float mo = mref - 5.0f; \
            long pf[2]; \
            _Pragma("unroll") for (int h = 0; h < 2; ++h) { float pr[2][4]; \
                _Pragma("unroll") for (int tau = 0; tau < 2; ++tau) _Pragma("unroll") for (int r = 0; r < 4; ++r) pr[tau][r] = STRIP == 5 ? sc[h][tau][r] : __builtin_amdgcn_exp2f(sc[h][tau][r] - mo); \
                u32x2 pw; \
                pw.x = (unsigned)__builtin_amdgcn_cvt_pk_fp8_f32(pr[0][0], pr[0][1], 0, false); pw.x = (unsigned)__builtin_amdgcn_cvt_pk_fp8_f32(pr[0][2], pr[0][3], (int)pw.x, true); \
                pw.y = (unsigned)__builtin_amdgcn_cvt_pk_fp8_f32(pr[1][0], pr[1][1], 0, false); pw.y = (unsigned)__builtin_amdgcn_cvt_pk_fp8_f32(pr[1][2], pr[1][3], (int)pw.y, true); \
                pf[h] = __builtin_bit_cast(long, pw); } \
            asm volatile("s_waitcnt lgkmcnt(0)" : "+v"(ta[0][0]), "+v"(ta[0][1]), "+v"(ta[0][2]), "+v"(ta[0][3]), "+v"(ta[0][4]), "+v"(ta[0][5]), "+v"(ta[0][6]), "+v"(ta[0][7])); \
            asm volatile("" : "+v"(ta[1][0]), "+v"(ta[1][1]), "+v"(ta[1][2]), "+v"(ta[1][3]), "+v"(ta[1][4]), "+v"(ta[1][5]), "+v"(ta[1][6]), "+v"(ta[1][7])); \
            if (STRIP == 4) { o[0][0] += __uint_as_float((unsigned)pf[0]); o[1][0] += __uint_as_float((unsigned)pf[1]); } else \
            _Pragma("unroll") for (int h = 0; h < 2; ++h) { \
                _Pragma("unroll") for (int rt = 0; rt < 8; ++rt) o[rt] = __builtin_amdgcn_mfma_f32_16x16x32_fp8_fp8(ta[h][rt], pf[h], o[rt], 0, 0, 0); \
                ls = __builtin_amdgcn_mfma_f32_16x16x32_fp8_fp8(ones8, pf[h], ls, 0, 0, 0); } \
            if ((cp_) == 3) { \
                const float inv = __builtin_amdgcn_rcpf(ls[0]); \
                if (hcol < 8) { \
                    _Pragma("unroll") for (int rt = 0; rt < 8; ++rt) { \
                        u32x2 w; w.x = pg8::cvt_pk_bf16(o[rt][0] * inv, o[rt][1] * inv); w.y = pg8::cvt_pk_bf16(o[rt][2] * inv, o[rt][3] * inv); \
                        *(u32x2*)(p.OL + (size_t)m * 1024 + hcol * 128 + 16 * rt + 4 * g) = w; \
                    } \
                } \
                _Pragma("unroll") for (int rt = 0; rt < 8; ++rt) o[rt] = (f32x4){0.f, 0.f, 0.f, 0.f}; \
                ls = (f32x4){0.f, 0.f, 0.f, 0.f}; \
            } } while (0)
        if (wave >= 4) { __builtin_amdgcn_s_sleep(ATT_SKEW); }
#pragma unroll 1
        for (int qi = 0; qi < 16; ++qi) {
            ATT_BODY(0); ATT_BODY(1); ATT_BODY(2); ATT_BODY(3);
        }
#undef ATT_BODY
        asm volatile("s_waitcnt vmcnt(0)" ::: "memory");
    }
#undef ATT_DMA_CHUNK
#undef ATT_SEL_WRITE
#undef ATT_Q_LOAD
}

__device__ __forceinline__ unsigned q16of(float x) { return (unsigned)(int)__builtin_fminf(__builtin_fmaxf((x + 8.0f) * 4096.0f, 0.0f), 65535.0f); }

__device__ __forceinline__ unsigned wave_incl_scan(unsigned x) {
    x += (unsigned)__builtin_amdgcn_update_dpp(0, (int)x, 0x111, 0xf, 0xf, false);
    x += (unsigned)__builtin_amdgcn_update_dpp(0, (int)x, 0x112, 0xf, 0xf, false);
    x += (unsigned)__builtin_amdgcn_update_dpp(0, (int)x, 0x114, 0xf, 0xf, false);
    x += (unsigned)__builtin_amdgcn_update_dpp(0, (int)x, 0x118, 0xf, 0xf, false);
    x += (unsigned)__builtin_amdgcn_update_dpp(0, (int)x, 0x142, 0xa, 0xf, false);
    x += (unsigned)__builtin_amdgcn_update_dpp(0, (int)x, 0x143, 0xc, 0xf, false);
    return x;
}
__device__ __forceinline__ void select_row7(const LAS unsigned short* row, int n, LAS unsigned* hist, LAS unsigned* h2, unsigned short* out, int lane) {
    if (n <= 256) {
#pragma unroll
        for (int i = 0; i < 4; ++i) { const int k = lane + 64 * i; out[k] = (unsigned short)(k < n ? k : 0); }
#pragma unroll
        for (int i = 0; i < 8; ++i) hist[lane + 64 * i] = 0u;
        return;
    }
    const unsigned long long lt = (1ull << lane) - 1ull;
    unsigned b1, above;
    {
        const int rl = 63 - lane;
        const u32x4 w0 = *(const LAS u32x4*)(hist + 8 * rl), w1 = *(const LAS u32x4*)(hist + 8 * rl + 4);
        unsigned c[16];
        c[0] = w0.x & 0xffffu; c[1] = w0.x >> 16; c[2] = w0.y & 0xffffu; c[3] = w0.y >> 16; c[4] = w0.z & 0xffffu; c[5] = w0.z >> 16; c[6] = w0.w & 0xffffu; c[7] = w0.w >> 16;
        c[8] = w1.x & 0xffffu; c[9] = w1.x >> 16; c[10] = w1.y & 0xffffu; c[11] = w1.y >> 16; c[12] = w1.z & 0xffffu; c[13] = w1.z >> 16; c[14] = w1.w & 0xffffu; c[15] = w1.w >> 16;
        unsigned s = 0;
#pragma unroll
        for (int j = 0; j < 16; ++j) s += c[j];
        const unsigned incl = wave_incl_scan(s), excl = incl - s;
        const bool mine = (excl < 256u) && (incl >= 256u);
        unsigned bin = 0, ab = 0, run = excl, found = 0u;
#pragma unroll
        for (int j = 15; j >= 0; --j) { const unsigned r2 = run + c[j]; const unsigned hit = (found == 0u && r2 >= 256u) ? 1u : 0u;
            bin = hit ? (unsigned)(16 * rl + j) : bin; ab = hit ? run : ab; found |= hit; run = r2; }
        const unsigned long long bm = __ballot(mine);
        const int src = __builtin_amdgcn_readfirstlane(bm ? (int)__builtin_ctzll(bm) : 0);
        b1 = (unsigned)__builtin_amdgcn_readlane((int)bin, src); above = (unsigned)__builtin_amdgcn_readlane((int)ab, src);
    }
    LDS_WAIT();
    int need = 256 - (int)above;
    LAS unsigned short* cand = (LAS unsigned short*)hist;
    const int nblk = (n + 255) >> 8;
    const unsigned thr = b1 << 6;
    int C = 0;
    u32x2 vn = *(const LAS u32x2*)(row + 4 * lane);
    for (int blk = 0; blk < nblk; ++blk) {
        const u32x2 v = vn;
        if (blk + 1 < nblk) vn = *(const LAS u32x2*)(row + (blk + 1) * 256 + 4 * lane);
        const unsigned q[4] = {v.x & 0xffffu, v.x >> 16, v.y & 0xffffu, v.y >> 16};
        bool ge[4]; unsigned long long bl[4];
#pragma unroll
        for (int e = 0; e < 4; ++e) { ge[e] = (blk * 256 + 4 * lane + e < n) && (q[e] >= thr); bl[e] = __ballot(ge[e]); }
        const int below = __builtin_popcountll(bl[0] & lt) + __builtin_popcountll(bl[1] & lt) + __builtin_popcountll(bl[2] & lt) + __builtin_popcountll(bl[3] & lt);
        int pos = C + below;
#pragma unroll
        for (int e = 0; e < 4; ++e) { if (ge[e]) { if (pos < 768) cand[pos] = (unsigned short)(blk * 256 + 4 * lane + e); ++pos; } }
        C += __builtin_popcountll(bl[0]) + __builtin_popcountll(bl[1]) + __builtin_popcountll(bl[2]) + __builtin_popcountll(bl[3]);
    }
    LDS_WAIT();
    LAS unsigned short* outL = cand + 768;
    if (C <= 512) {
        int ci[8]; unsigned cq[8]; bool ceq[8];
#pragma unroll
        for (int k = 0; k < 8; ++k) { const int j = lane + 64 * k; ci[k] = j < C ? (int)cand[j] : -1; }
#pragma unroll
        for (int k = 0; k < 8; ++k) { cq[k] = ci[k] >= 0 ? (unsigned)row[ci[k]] : 0u; ceq[k] = ci[k] >= 0 && (cq[k] >> 6) == b1; }
        h2[lane] = 0u;
        LDS_WAIT();
#pragma unroll
        for (int k = 0; k < 8; ++k) if (ceq[k]) __hip_atomic_fetch_add(h2 + (cq[k] & 63u), 1u, __ATOMIC_RELAXED, __HIP_MEMORY_SCOPE_WORKGROUP);
        LDS_WAIT();
        const unsigned cme = h2[63 - lane];
        const unsigned incl = wave_incl_scan(cme), excl = incl - cme;
        const bool mine = (excl < (unsigned)need) && (incl >= (unsigned)need);
        const unsigned long long bm = __ballot(mine);
        const int src = __builtin_amdgcn_readfirstlane(bm ? (int)__builtin_ctzll(bm) : 0);
        const unsigned Tl = (unsigned)(63 - src);
        need -= __builtin_amdgcn_readlane((int)excl, src);
        const unsigned Tq = (b1 << 6) | Tl;
        int eq_seen = 0, cnt = 0;
#pragma unroll
        for (int k = 0; k < 8; ++k) {
            const bool valid = ci[k] >= 0, eqk = valid && cq[k] == Tq;
            const unsigned long long beq = __ballot(eqk);
            const int eq_rank = eq_seen + __builtin_popcountll(beq & lt);
            const bool take = valid && (cq[k] > Tq || (eqk && eq_rank < need));
            const unsigned long long bt = __ballot(take);
            const int pos = cnt + __builtin_popcountll(bt & lt);
            if (take && pos < 256) outL[pos] = (unsigned short)ci[k];
            cnt += __builtin_popcountll(bt); eq_seen += __builtin_popcountll(beq);
        }
    } else {
        unsigned lo = 0u, hi = 65535u;
        while (lo < hi) {
            const unsigned mid = (lo + hi + 1u) >> 1;
            int cge = 0;
            for (int i = lane; i < n; i += 64) cge += ((unsigned)row[i] >= mid) ? 1 : 0;
#pragma unroll
            for (int o = 1; o < 64; o <<= 1) cge += __shfl_xor(cge, o);
            if (cge >= 256) lo = mid; else hi = mid - 1u;
        }
        const unsigned Tq = lo;
        int cgt = 0;
        for (int i = lane; i < n; i += 64) cgt += ((unsigned)row[i] > Tq) ? 1 : 0;
#pragma unroll
        for (int o = 1; o < 64; o <<= 1) cgt += __shfl_xor(cgt, o);
        const int needq = 256 - cgt;
        int cnt = 0, eq_seen = 0;
        for (int i0 = 0; i0 < n; i0 += 64) {
            const int i = i0 + lane; const bool valid = i < n;
            const unsigned qv = valid ? (unsigned)row[i] : 0u;
            const bool eqk = valid && qv == Tq;
            const unsigned long long beq = __ballot(eqk);
            const int eq_rank = eq_seen + __builtin_popcountll(beq & lt);
            const bool take = valid && (qv > Tq || (eqk && eq_rank < needq));
            const unsigned long long bt = __ballot(take);
            const int pos = cnt + __builtin_popcountll(bt & lt);
            if (take && pos < 256) outL[pos] = (unsigned short)i;
            cnt += __builtin_popcountll(bt); eq_seen += __builtin_popcountll(beq);
        }
    }
    LDS_WAIT();
    *(u32x2*)(out + 4 * lane) = *(const LAS u32x2*)(outL + 4 * lane);
    LDS_WAIT();
#pragma unroll
    for (int i = 0; i < 8; ++i) hist[lane + 64 * i] = 0u;
}

template <int STRIP> __device__ __forceinline__ void ph_index7_t(const P& p, LAS unsigned char* lds, const int wv) {
    LAS unsigned short* Irow = (LAS unsigned short*)lds;
    LAS unsigned* hist = (LAS unsigned*)(lds + 65536);
    LAS unsigned* h2 = (LAS unsigned*)(lds + 81920);
    const int tid = opaque_tid(wv), lane = tid & 63, wave = __builtin_amdgcn_readfirstlane(tid >> 6);
    LAS unsigned char* KSw = lds + 92160 + wave * 8192;
    const int hh = lane >> 5, n = lane & 31;
    const int rho = lane & 31, qlA = 2 * ((rho >> 2) & 1) + (rho >> 4), hdA = (rho & 3) + 4 * ((rho >> 3) & 1);
    const int srow = lane >> 3, sch = lane & 7;
#pragma unroll
    for (int i = 0; i < 8; ++i) hist[tid + NTHR * i] = 0u;
    bf16x8 A[2][4]; float wq[2][16]; u32x4 RA[4], RB[4];
#define IDX7_LOAD(R_, mb_, kt_) do { const bf16_t* kp_ = p.KI + ((mb_) + (size_t)(kt_) * 32 + srow) * 64 + sch * 8; \
        _Pragma("unroll") for (int i = 0; i < 4; ++i) R_[i] = *(const u32x4*)(kp_ + (size_t)i * 8 * 64); } while (0)
#define IDX7_LOAD_UNIT(u_) do { const int b_ = (u_) & 7, t0_ = (511 - ((u_) >> 3)) * 8; const size_t mb_ = (size_t)b_ * T; const int nkt_ = (t0_ + 8 + 31) >> 5; \
        _Pragma("unroll") for (int mt = 0; mt < 2; ++mt) { const bf16_t* src = p.QI + (mb_ + t0_ + mt * 4 + qlA) * 512 + hdA * 64 + 8 * hh; \
            _Pragma("unroll") for (int s = 0; s < 4; ++s) A[mt][s] = *(const bf16x8*)(src + 16 * s); \
            _Pragma("unroll") for (int c = 0; c < 2; ++c) { const float* wp = p.WI + (mb_ + t0_ + mt * 4 + 2 * hh + c) * 8; const f32x4 w0 = *(const f32x4*)wp, w1 = *(const f32x4*)(wp + 4); \
                _Pragma("unroll") for (int j = 0; j < 4; ++j) { wq[mt][c * 8 + j] = w0[j]; wq[mt][c * 8 + 4 + j] = w1[j]; } } } \
        if (wave < nkt_) IDX7_LOAD(RA, mb_, wave); if (wave + NWAVES < nkt_) IDX7_LOAD(RB, mb_, wave + NWAVES); } while (0)
    if ((int)blockIdx.x < 4096) IDX7_LOAD_UNIT((int)blockIdx.x);
    __syncthreads();
    for (int u = blockIdx.x; u < 4096; u += gridDim.x) {
        const int b = u & 7, tb = 511 - (u >> 3), t0 = tb * 8; const size_t mb = (size_t)b * T;
        const int nkt = (t0 + 8 + 31) >> 5;
#pragma unroll
        for (int mt = 0; mt < 2; ++mt) {
#pragma unroll
            for (int s = 0; s < 4; ++s) asm volatile("" :: "v"(A[mt][s]));
#pragma unroll
            for (int j = 0; j < 16; ++j) asm volatile("" :: "v"(wq[mt][j]));
        }
#define IDX7_BODY(kt_, R_, bf_) do { const int kt = (kt_); if (kt < nkt) { \
            LAS unsigned char* img = KSw + (bf_) * 4096; \
            _Pragma("unroll") for (int i = 0; i < 4; ++i) { const int row = 8 * i + srow; *(LAS u32x4*)(img + row * 128 + 16 * (sch ^ (row & 7))) = R_[i]; } \
            if (kt + 2 * NWAVES < nkt) IDX7_LOAD(R_, mb, kt + 2 * NWAVES); \
            bf16x8 Bf[4]; \
            _Pragma("unroll") for (int s = 0; s < 4; ++s) Bf[s] = *(const LAS bf16x8*)(img + n * 128 + 16 * ((2 * s + hh) ^ (n & 7))); \
            const int key = kt * 32 + n; \
            _Pragma("unroll") for (int mt = 0; mt < 2; ++mt) { \
                f32x16 acc; \
                _Pragma("unroll") for (int j = 0; j < 16; ++j) acc[j] = 0.f; \
                _Pragma("unroll") for (int s = 0; s < 4; ++s) acc = __builtin_amdgcn_mfma_f32_32x32x16_bf16(A[mt][s], Bf[s], acc, 0, 0, 0); \
                _Pragma("unroll") for (int c = 0; c < 2; ++c) { \
                    float v = 0.f; \
                    _Pragma("unroll") for (int h = 0; h < 8; ++h) { const float af = acc[c * 8 + h]; const int ai = __float_as_int(af); v = __builtin_fmaf(wq[mt][c * 8 + h], __int_as_float(ai > 0 ? ai : 0), v); } \
                    const int r = mt * 4 + 2 * hh + c; const unsigned q = q16of(v); \
                    Irow[r * 4096 + key] = (unsigned short)q; \
                    if (key <= t0 + r) { const unsigned bin = q >> 6; __hip_atomic_fetch_add(hist + r * 512 + (bin >> 1), 1u << ((bin & 1u) * 16u), __ATOMIC_RELAXED, __HIP_MEMORY_SCOPE_WORKGROUP); } \
                } \
            } } } while (0)
#pragma unroll 1
        for (int k0 = wave; k0 < nkt; k0 += 2 * NWAVES) {
            IDX7_BODY(k0, RA, 0);
            IDX7_BODY(k0 + NWAVES, RB, 1);
        }
#undef IDX7_BODY
        if (u + (int)gridDim.x < 4096) IDX7_LOAD_UNIT(u + (int)gridDim.x);
        LDS_WAIT(); __builtin_amdgcn_s_barrier();
        if (STRIP != 1) select_row7(Irow + wave * 4096, t0 + wave + 1, hist + wave * 512, h2 + wave * 320, p.SEL + (mb + t0 + wave) * 256, lane);
        else { _Pragma("unroll") for (int i = 0; i < 8; ++i) hist[wave * 512 + lane + 64 * i] = 0u; }
        LDS_WAIT(); __builtin_amdgcn_s_barrier();
    }
#undef IDX7_LOAD
#undef IDX7_LOAD_UNIT
}

__device__ __forceinline__ void ph_index7(const P& p, LAS unsigned char* lds, const int wv) { ph_index7_t<0>(p, lds, wv); }

__device__ __forceinline__ void ph_gmlp(const P& p, LAS unsigned char* lds, const int wv) {
    const int tid = opaque_tid(wv), lane = tid & 63, wave = __builtin_amdgcn_readfirstlane(tid >> 6);
    LAS unsigned char* vt = lds;
    LAS float* st = (LAS float*)(lds + 32768);
    const int g4 = lane >> 4, q4 = (lane & 15) >> 2, p4 = lane & 3, ic = lane & 15;
    for (int u = blockIdx.x; u < 256; u += gridDim.x) {
        const size_t m0 = (size_t)u * 128;
#pragma unroll 1
        for (int r4 = 0; r4 < 4; ++r4) {
            float x[4][8], sm[4];
#pragma unroll
            for (int r = 0; r < 4; ++r) { const u32x4 w = *(const u32x4*)(p.VB + (m0 + 16 * wave + 4 * r4 + r) * 512 + lane * 8);
                x[r][0] = bflo(w.x); x[r][1] = bfhi(w.x); x[r][2] = bflo(w.y); x[r][3] = bfhi(w.y); x[r][4] = bflo(w.z); x[r][5] = bfhi(w.z); x[r][6] = bflo(w.w); x[r][7] = bfhi(w.w); }
#pragma unroll
            for (int r = 0; r < 4; ++r) sm[r] = ((x[r][0] + x[r][1]) + (x[r][2] + x[r][3])) + ((x[r][4] + x[r][5]) + (x[r][6] + x[r][7]));
#pragma unroll
            for (int o = 1; o < 64; o <<= 1) {
#pragma unroll
                for (int r = 0; r < 4; ++r) sm[r] += __shfl_xor(sm[r], o);
            }
            float vr[4];
#pragma unroll
            for (int r = 0; r < 4; ++r) { const float mean = sm[r] * (1.f / 512.f); sm[r] = mean; float a = 0.f;
#pragma unroll
                for (int j = 0; j < 8; ++j) { const float d = x[r][j] - mean; a += d * d; }
                vr[r] = a; }
#pragma unroll
            for (int o = 1; o < 64; o <<= 1) {
#pragma unroll
                for (int r = 0; r < 4; ++r) vr[r] += __shfl_xor(vr[r], o);
            }
            if (lane == 0) {
#pragma unroll
                for (int r = 0; r < 4; ++r) { const int row = 16 * wave + 4 * r4 + r; st[2 * row] = sm[r]; st[2 * row + 1] = 1.0f / sqrtf(vr[r] * (1.f / 512.f) + EPS); }
            }
        }
        __syncthreads();
#pragma unroll 1
        for (int g = 0; g < 4; ++g) {
#pragma unroll
            for (int i = 0; i < 4; ++i) {
                const int piece = i * NTHR + tid, row = piece >> 4, ch = piece & 15;
                const u32x4 w = *(const u32x4*)(p.VB + (m0 + row) * 512 + g * 128 + ch * 8);
                const float mean = st[2 * row], rstd = st[2 * row + 1];
                const f32x4 ga = *(const f32x4*)(p.ln_g + g * 128 + ch * 8), gb = *(const f32x4*)(p.ln_g + g * 128 + ch * 8 + 4);
                const f32x4 ba = *(const f32x4*)(p.ln_b + g * 128 + ch * 8), bb = *(const f32x4*)(p.ln_b + g * 128 + ch * 8 + 4);
                u32x4 o;
                o.x = pk2((bflo(w.x) - mean) * rstd * ga[0] + ba[0], (bfhi(w.x) - mean) * rstd * ga[1] + ba[1]);
                o.y = pk2((bflo(w.y) - mean) * rstd * ga[2] + ba[2], (bfhi(w.y) - mean) * rstd * ga[3] + ba[3]);
                o.z = pk2((bflo(w.z) - mean) * rstd * gb[0] + bb[0], (bfhi(w.z) - mean) * rstd * gb[1] + bb[1]);
                o.w = pk2((bflo(w.w) - mean) * rstd * gb[2] + bb[2], (bfhi(w.w) - mean) * rstd * gb[3] + bb[3]);
                *(LAS u32x4*)(vt + off_b(row, ch)) = o;
            }
            const size_t orow = (m0 + 16 * wave + ic) * 512 + g * 128 + 4 * g4;
            u32x2 uv[8];
#pragma unroll
            for (int et = 0; et < 8; ++et) uv[et] = *(const u32x2*)(p.UB + orow + 16 * et);
            const float bs = p.b_sp[g * 128 + 16 * wave + ic];
            const int nks = ((16 * wave + 15) >> 5) + 1;
            bf16x8 wb[4];
#pragma unroll
            for (int ks = 0; ks < 4; ++ks) wb[ks] = *(const bf16x8*)(p.WSB + ((size_t)g * 128 + 16 * wave + ic) * 128 + 32 * ks + 8 * g4);
            __syncthreads();
            f32x4 acc[8];
#pragma unroll
            for (int et = 0; et < 8; ++et) acc[et] = (f32x4){0.f, 0.f, 0.f, 0.f};
#pragma unroll
            for (int ks = 0; ks < 4; ++ks) {
                if (ks < nks) {
                    bf16x4 ta[8][2];
#pragma unroll
                    for (int et = 0; et < 8; ++et) {
                        const unsigned r0 = 32 * ks + 8 * g4 + q4, ch = 2 * et + (p4 >> 1);
                        ta[et][0] = tr16(vt + off_b(r0, ch) + 8 * (p4 & 1)); ta[et][1] = tr16(vt + off_b(r0 + 4, ch) + 8 * (p4 & 1));
                    }
#pragma unroll
                    for (int et = 0; et < 8; ++et) acc[et] = __builtin_amdgcn_mfma_f32_16x16x32_bf16(cat4(ta[et][0], ta[et][1]), wb[ks], acc[et], 0, 0, 0);
                }
            }
#pragma unroll
            for (int et = 0; et < 8; ++et) {
                u32x2 w;
                w.x = pk2(bflo(uv[et].x) * (acc[et][0] + bs), bfhi(uv[et].x) * (acc[et][1] + bs));
                w.y = pk2(bflo(uv[et].y) * (acc[et][2] + bs), bfhi(uv[et].y) * (acc[et][3] + bs));
                *(u32x2*)(p.US + orow + 16 * et) = w;
            }
            __syncthreads();
        }
    }
}

__device__ __forceinline__ void split2(float a, float b, unsigned& h, unsigned& l) {
    const unsigned ha = f2bf(a), hb = f2bf(b);
    h = ha | (hb << 16); l = pk2(a - __uint_as_float(ha << 16), b - __uint_as_float(hb << 16));
}
__device__ __forceinline__ void split_bf16(const f32x4 a, const f32x4 b, bf16x8& hi, bf16x8& lo) {
    unsigned h0, h1, h2, h3, l0, l1, l2, l3;
    split2(a.x, a.y, h0, l0); split2(a.z, a.w, h1, l1); split2(b.x, b.y, h2, l2); split2(b.z, b.w, h3, l3);
    const u32x4 h = {h0, h1, h2, h3}, l = {l0, l1, l2, l3};
    hi = __builtin_bit_cast(bf16x8, h); lo = __builtin_bit_cast(bf16x8, l);
}
template <int STRIP> __device__ __forceinline__ void ph_router_t(const P& p, LAS unsigned char* lds, const int wv) {
    const int tid = opaque_tid(wv), lane = tid & 63, wave = __builtin_amdgcn_readfirstlane(tid >> 6);
    LAS float* LG = (LAS float*)lds;
    LAS float* SS = (LAS float*)(lds + 26624);
    LAS unsigned* cnt = (LAS unsigned*)(lds + 26624 + 512);
    const int g = lane >> 4, ic = lane & 15;
    const float* X1 = p.out;
    bf16x8 bh[4][3], bl[4][3];
#pragma unroll
    for (int ks = 0; ks < 4; ++ks) {
        const int k0 = 128 * wave + 32 * ks + 8 * g;
#pragma unroll
        for (int nt = 0; nt < 3; ++nt) {
            const int col = 16 * nt + ic; const int cc = col < 36 ? col : 0;
            f32x4 a = *(const f32x4*)(p.WrT + (size_t)cc * 1024 + k0), b = *(const f32x4*)(p.WrT + (size_t)cc * 1024 + k0 + 4);
            if (col >= 36) { a = (f32x4){0.f, 0.f, 0.f, 0.f}; b = a; }
            split_bf16(a, b, bh[ks][nt], bl[ks][nt]);
        }
        if (ks & 1) asm volatile("" ::: "memory");
    }
    for (int c = blockIdx.x; c < M / 128; c += gridDim.x) {
        for (int i = tid; i < 128 * 52 + 128 + 32; i += NTHR) ((LAS float*)lds)[i] = 0.f;
        __syncthreads();
        f32x4 xa[4], xb[4], na[4], nb[4];
#define RT_LOAD(XA_, XB_, rt_) do { const float* xr = X1 + (size_t)(c * 128 + 16 * (rt_) + ic) * D + 128 * wave + 8 * g; \
            _Pragma("unroll") for (int ks = 0; ks < 4; ++ks) { XA_[ks] = *(const f32x4*)(xr + 32 * ks); XB_[ks] = *(const f32x4*)(xr + 32 * ks + 4); } } while (0)
        RT_LOAD(na, nb, 0);
#pragma unroll 1
        for (int rt = 0; rt < 8; ++rt) {
#pragma unroll
            for (int ks = 0; ks < 4; ++ks) { xa[ks] = na[ks]; xb[ks] = nb[ks]; }
            if (rt < 7) RT_LOAD(na, nb, rt + 1);
            __builtin_amdgcn_sched_barrier(0);
            f32x4 acc[3];
#pragma unroll
            for (int nt = 0; nt < 3; ++nt) acc[nt] = (f32x4){0.f, 0.f, 0.f, 0.f};
            float ssq = 0.f;
            bf16_t* hr = p.H2B + (size_t)(c * 128 + 16 * rt + ic) * D + 128 * wave + 8 * g;
#pragma unroll
            for (int ks = 0; ks < 4; ++ks) {
                ssq += (xa[ks].x * xa[ks].x + xa[ks].y * xa[ks].y) + (xa[ks].z * xa[ks].z + xa[ks].w * xa[ks].w) + (xb[ks].x * xb[ks].x + xb[ks].y * xb[ks].y) + (xb[ks].z * xb[ks].z + xb[ks].w * xb[ks].w);
                const f32x4 ga = *(const f32x4*)(p.n2g + 128 * wave + 32 * ks + 8 * g), gb = *(const f32x4*)(p.n2g + 128 * wave + 32 * ks + 8 * g + 4);
                bf16x8 ah, al;
                split_bf16(xa[ks] * ga, xb[ks] * gb, ah, al);
                *(bf16x8*)(hr + 32 * ks) = ah;
                if (STRIP != 1) {
#pragma unroll
                for (int nt = 0; nt < 3; ++nt) {
                    acc[nt] = __builtin_amdgcn_mfma_f32_16x16x32_bf16(ah, bh[ks][nt], acc[nt], 0, 0, 0);
                    acc[nt] = __builtin_amdgcn_mfma_f32_16x16x32_bf16(al, bh[ks][nt], acc[nt], 0, 0, 0);
                    acc[nt] = __builtin_amdgcn_mfma_f32_16x16x32_bf16(ah, bl[ks][nt], acc[nt], 0, 0, 0);
                }
                }
            }
            ssq += __shfl_xor(ssq, 16); ssq += __shfl_xor(ssq, 32);
            LAS float* PT = (LAS float*)(lds + 32768) + ((rt & 1) * 8 + wave) * (16 * 52);
            if (STRIP == 0) {
#pragma unroll
            for (int nt = 0; nt < 3; ++nt)
#pragma unroll
                for (int r = 0; r < 4; ++r) PT[(4 * g + r) * 52 + 16 * nt + ic] = acc[nt][r];
            if (g == 0) PT[ic * 52 + 48] = ssq;
            }
            LDS_WAIT(); __builtin_amdgcn_s_barrier();
            if (STRIP == 0) {
            for (int e = tid; e < 16 * 52; e += NTHR) {
                const LAS float* q = (const LAS float*)(lds + 32768) + (rt & 1) * 8 * (16 * 52) + e;
                float s = 0.f;
#pragma unroll
                for (int w = 0; w < 8; ++w) s += q[w * (16 * 52)];
                LG[16 * rt * 52 + e] = s;
            }
            }
        }
#undef RT_LOAD
        __syncthreads();
        if (tid < 128) {
            const int m = c * 128 + tid;
            const LAS float* lg = LG + tid * 52;
            const float rinv = 1.0f / sqrtf(lg[48] * (1.f / D) + EPS);
            float gl[4];
#pragma unroll
            for (int i = 0; i < 4; ++i) gl[i] = rinv * lg[i] + p.rg_b[i];
            int gi = 0; float gm = gl[0];
#pragma unroll
            for (int i = 1; i < 4; ++i) if (gl[i] > gm) { gm = gl[i]; gi = i; }
            float gs = 0.f;
#pragma unroll
            for (int i = 0; i < 4; ++i) gs += __expf(gl[i] - gm);
            const float gwt = 1.f / gs;
            float el[8];
#pragma unroll
            for (int j = 0; j < 8; ++j) el[j] = rinv * lg[4 + gi * 8 + j] + p.re_b[gi * 8 + j];
            int i1 = 0; float m1 = el[0];
#pragma unroll
            for (int j = 1; j < 8; ++j) if (el[j] > m1) { m1 = el[j]; i1 = j; }
            int i2 = 0; float m2 = -INFINITY;
#pragma unroll
            for (int j = 0; j < 8; ++j) if (j != i1 && el[j] > m2) { m2 = el[j]; i2 = j; }
            const float e2r = __expf(m2 - m1), e1 = 1.f / (1.f + e2r), e2 = e2r * e1;
            const int ea = gi * 8 + i1, eb = gi * 8 + i2;
            p.EID[2 * m] = ea; p.EID[2 * m + 1] = eb;
            p.EW[2 * m] = gwt * e1; p.EW[2 * m + 1] = gwt * e2;
            p.RINV2[m] = rinv;
            __hip_atomic_fetch_add(cnt + ea, 1u, __ATOMIC_RELAXED, __HIP_MEMORY_SCOPE_WORKGROUP);
            __hip_atomic_fetch_add(cnt + eb, 1u, __ATOMIC_RELAXED, __HIP_MEMORY_SCOPE_WORKGROUP);
        }
        __syncthreads();
        if (tid < 32) p.BLKCNT[c * 32 + tid] = (int)cnt[tid];
        __syncthreads();
    }
}

__device__ __forceinline__ void ph_router(const P& p, LAS unsigned char* lds, const int wv) { ph_router_t<0>(p, lds, wv); }

__device__ __forceinline__ void ph_scan(const P& p, LAS unsigned char* lds, const int wv) {}
__device__ __forceinline__ void ph_scatter(const P& p, LAS unsigned char* lds, const int wv) {
    const int tid = opaque_tid(wv);
    LAS int* s = (LAS int*)lds;
    LAS int* se = s + 2048;
    const int e = tid & 31, part = tid >> 5;
    int loc[16]; int sum = 0;
#pragma unroll
    for (int i = 0; i < 16; ++i) { loc[i] = p.BLKCNT[(part * 16 + i) * 32 + e]; sum += loc[i]; }
    s[128 + part * 32 + e] = sum;
    __syncthreads();
    if (tid < 32) { int t = 0; for (int k = 0; k < 16; ++k) { const int v = s[128 + k * 32 + tid]; s[128 + k * 32 + tid] = t; t += v; } s[tid] = t; }
    __syncthreads();
    if (tid == 0) { int off = 0; for (int k = 0; k < 32; ++k) { s[32 + k] = off; off += (s[k] + 255) >> 8; } s[64] = off; }
    __syncthreads();
    if (blockIdx.x == 0) {
        const int ntiles = s[64];
        if (tid < 32) { p.MOEI[tid] = s[32 + tid] * 256; p.MOEI[32 + tid] = s[32 + tid]; }
        if (tid == 0) { p.MOEI[64] = ntiles; p.MOEI[65] = ntiles * 2; p.MOEI[66] = ntiles * 4; }
        for (int rt = tid; rt < ntiles; rt += NTHR) {
            int ex = 0;
            for (int k = 0; k < 32; ++k) { const int tb = s[32 + k], nt = (s[k] + 255) >> 8; if (rt >= tb && rt < tb + nt) ex = k; }
            p.GU[4 * rt + 0] = rt; p.GU[4 * rt + 1] = ex * 2; p.GU[4 * rt + 2] = rt; p.GU[4 * rt + 3] = ex * 2 + 1;
#pragma unroll
            for (int j = 0; j < 4; ++j) { p.DN[8 * rt + 2 * j] = rt; p.DN[8 * rt + 2 * j + 1] = ex * 4 + j; }
        }
        for (int k = 0; k < 32; ++k) {
            const int lo = s[32 + k] * 256 + s[k], hi = (s[32 + k] + ((s[k] + 255) >> 8)) * 256;
            for (int i = lo + tid; i < hi; i += NTHR) p.PTOK[i] = -1;
        }
    }
    for (int c = blockIdx.x; c < M / 128; c += gridDim.x) {
        if (part == (c >> 4)) {
            int run = s[32 + e] * 256 + s[128 + part * 32 + e];
#pragma unroll
            for (int i = 0; i < 16; ++i) run += (i < (c & 15)) ? loc[i] : 0;
            s[1024 + e] = run;
        }
        int ex = 0;
        if (tid < 256) { ex = p.EID[c * 256 + tid]; se[tid] = ex; }
        __syncthreads();
        if (tid < 256) {
            int rank = 0;
            for (int t = 0; t < tid; ++t) rank += (se[t] == ex) ? 1 : 0;
            p.PTOK[s[1024 + ex] + rank] = c * 256 + tid;
        }
        __syncthreads();
    }
}

template <bool DRY> __device__ __forceinline__ void ph_final(const P& p, const int wv) {
    const int tid = opaque_tid(wv), lane = tid & 63, wave = tid >> 6;
    const int gw = blockIdx.x * NWAVES + wave, NGW = gridDim.x * NWAVES;
    for (int m4 = gw; m4 < M / 4; m4 += NGW) {
        f32x4 v[4][4]; float s[4];
#pragma unroll
        for (int rr = 0; rr < 4; ++rr) {
            const int m = 4 * m4 + rr;
            const f32x4* xr = (const f32x4*)(p.out + (size_t)m * D) + lane;
            const u32x2* y0 = (const u32x2*)(p.YS + (size_t)m * D) + lane; const u32x2* y1 = (const u32x2*)(p.YS + ((size_t)M + m) * D) + lane;
            s[rr] = 0.f;
#pragma unroll
            for (int j = 0; j < 4; ++j) {
                v[rr][j] = xr[64 * j]; const u32x2 a = y0[64 * j], b = y1[64 * j];
                v[rr][j].x += bflo(a.x) + bflo(b.x); v[rr][j].y += bfhi(a.x) + bfhi(b.x); v[rr][j].z += bflo(a.y) + bflo(b.y); v[rr][j].w += bfhi(a.y) + bfhi(b.y);
                s[rr] += (v[rr][j].x * v[rr][j].x + v[rr][j].y * v[rr][j].y) + (v[rr][j].z * v[rr][j].z + v[rr][j].w * v[rr][j].w);
            }
        }
#pragma unroll
        for (int rr = 0; rr < 4; ++rr) {
            const float rinv = 1.0f / sqrtf(wave_sum(s[rr]) * (1.f / D) + EPS);
            f32x4* xr = (f32x4*)((DRY ? (float*)p.GBB : p.out) + (size_t)(4 * m4 + rr) * D) + lane;
#pragma unroll
            for (int j = 0; j < 4; ++j) { const f32x4 g = ((const f32x4*)p.fg)[lane + 64 * j]; xr[64 * j] = v[rr][j] * rinv * g; }
        }
    }
}

#ifndef GEMM_SP2
#define GEMM_SP2 true
#endif
__device__ __forceinline__ void ph_gemm_in(const P& p, LAS unsigned char* lds, const int wv) {
    pg8::Gemm g{p.HB, p.WinT, M, NIN, 1024}; pg8::StaticOrder S; S.init(M, NIN, gridDim.x, (int)blockIdx.x);
    EpiIn E{p.QL, p.QI, p.KI, p.UB, p.VB, p.GAB, p.GBB, p.CKVR, p.WI};
    pg8::gemm_phase<EpiIn, pg8::StaticOrder, true, GEMM_SP2>(lds, g, S, E, wv);
    {
        const int G = gridDim.x, nwg = (M / 256) * (NIN / 256), nextra = nwg % G;
        const int c = blockIdx.x, nshort = nextra == 0 ? G : G - nextra;
        if (nextra == 0 || c >= nextra) {
            const int tid = opaque_tid(wv), lane = tid & 63, wave = __builtin_amdgcn_readfirstlane(tid >> 6);
            __syncthreads();
            prep_gateup(p, lds, (nextra == 0 ? c : c - nextra) * NWAVES + wave, nshort * NWAVES, wave, lane);
        }
    }
}
__device__ __forceinline__ void ph_gemm_yb(const P& p, LAS unsigned char* lds, const int wv) {
    pg8::Gemm g{p.US, p.WpbT, M, 1024, 512}; pg8::StaticOrder S; S.init(M, 1024, gridDim.x, (int)blockIdx.x);
    EpiMB E{p.GBB, p.MB};
    pg8::gemm_phase<EpiMB, pg8::StaticOrder, true, GEMM_SP2>(lds, g, S, E, wv);
}
__device__ __forceinline__ void ph_gemm_ya(const P& p, LAS unsigned char* lds, const int wv) {
    pg8::Gemm g{p.OL, p.WovT, M, 1024, 1024}; pg8::StaticOrder S; S.init(M, 1024, gridDim.x, (int)blockIdx.x);
    EpiMG E{p.GAB, p.MB, p.MG};
    pg8::gemm_phase<EpiMG, pg8::StaticOrder, true, GEMM_SP2>(lds, g, S, E, wv);
}
__device__ __forceinline__ void ph_gemm_out(const P& p, LAS unsigned char* lds, const int wv) {
    pg8::Gemm g{p.MG, p.WoutT, M, 1024, 1024}; pg8::StaticOrder S; S.init(M, 1024, gridDim.x, (int)blockIdx.x);
    EpiX1 E{p.x, p.out};
    pg8::gemm_phase<EpiX1, pg8::StaticOrder, true, GEMM_SP2>(lds, g, S, E, wv);
}
__device__ __forceinline__ void ph_gemm_gu(const P& p, LAS unsigned char* lds, const int wv) {
    table_prefetch(lds, p.GU, p.MOEI + 65, (int)gridDim.x, (int)blockIdx.x, opaque_tid(wv));
    pg8::Gemm g{p.H2B, p.WguT, NPOS, 32 * 512, 1024}; TableGatherOrder S{p.GU, p.MOEI + 65, p.PTOK, (int)gridDim.x, (int)blockIdx.x, (const LAS int*)(lds + LDS_TAB_OFF)};
    EpiHE E{p.HE, p.PTOK, p.RINV2};
    pg8::gemm_phase<EpiHE, TableGatherOrder, true, true>(lds, g, S, E, wv);
}
__device__ __forceinline__ void ph_gemm_dn(const P& p, LAS unsigned char* lds, const int wv) {
    table_prefetch(lds, p.DN, p.MOEI + 66, (int)gridDim.x, (int)blockIdx.x, opaque_tid(wv));
    pg8::Gemm g{p.HE, p.WdT, NPOS, 32 * 1024, 256}; TableOrder S{p.DN, p.MOEI + 66, (int)gridDim.x, (int)blockIdx.x, (const LAS int*)(lds + LDS_TAB_OFF)};
    EpiDown E{p.PTOK, p.EW, p.YS};
    pg8::gemm_phase<EpiDown, TableOrder, true, GEMM_SP2>(lds, g, S, E, wv);
}
constexpr int NPHASE = 15;
template <int PH> __device__ __forceinline__ void run_phase(const P& p, LAS unsigned char* lds, const int wv) {
    if constexpr (PH == 0) ph_prep(p, lds, wv);
    if constexpr (PH == 1) ph_gemm_in(p, lds, wv);
    if constexpr (PH == 2) ph_ckvnorm(p, wv);
    if constexpr (PH == 3) ph_index7(p, lds, wv);
    if constexpr (PH == 4) ph_attn_t<0>(p, lds, wv);
    if constexpr (PH == 5) ph_gmlp(p, lds, wv);
    if constexpr (PH == 6) ph_gemm_yb(p, lds, wv);
    if constexpr (PH == 7) ph_gemm_ya(p, lds, wv);
    if constexpr (PH == 8) ph_gemm_out(p, lds, wv);
    if constexpr (PH == 9) ph_router(p, lds, wv);
    if constexpr (PH == 10) ph_scan(p, lds, wv);
    if constexpr (PH == 11) ph_scatter(p, lds, wv);
    if constexpr (PH == 12) ph_gemm_gu(p, lds, wv);
    if constexpr (PH == 13) ph_gemm_dn(p, lds, wv);
    if constexpr (PH == 14) ph_final<false>(p, wv);
}
template <int PH> __global__ void __launch_bounds__(NTHR, 2) k_phase(P p) {
    extern __shared__ __attribute__((aligned(16))) unsigned char lds_raw[];
    run_phase<PH>(p, (LAS unsigned char*)lds_raw, __builtin_amdgcn_readfirstlane(threadIdx.x >> 6));
}

constexpr int MISC_OFF = LDS_BYTES - 256;
__global__ void __launch_bounds__(NTHR, 2) k_mega(P p) {
    extern __shared__ __attribute__((aligned(16))) unsigned char lds_raw[];
    LAS unsigned char* lds = (LAS unsigned char*)lds_raw;
    volatile LAS unsigned* MISC = (volatile LAS unsigned*)(lds + MISC_OFF);
    int wv = __builtin_amdgcn_readfirstlane(threadIdx.x >> 6); asm volatile("" : "+s"(wv));
    if (threadIdx.x < 64) MISC[threadIdx.x] = 0u;
    __syncthreads();
    XcdBarrier bar = xcd_barrier_post(p.ctl + CW_BAR, MISC, wv);
    run_phase<0>(p, lds, wv);
#if defined(DUP0)
    __syncthreads(); run_phase<0>(p, lds, wv);
#endif
    xcd_barrier(bar);
    run_phase<1>(p, lds, wv);
#if defined(DUP1)
    __syncthreads(); run_phase<1>(p, lds, wv);
#endif
    xcd_barrier(bar);
    run_phase<2>(p, lds, wv);
#if defined(DUP2)
    run_phase<2>(p, lds, wv);
#endif
#if defined(PRE3)
    ph_index7_t<PRE3>(p, lds, wv); __syncthreads();
#endif
    run_phase<3>(p, lds, wv);
#if defined(DUP3)
    __syncthreads(); run_phase<3>(p, lds, wv);
#endif
    xcd_barrier(bar);
#if defined(PRE4)
    ph_attn_t<PRE4>(p, lds, wv); __syncthreads();
#endif
    run_phase<4>(p, lds, wv);  __syncthreads();
#if defined(DUP4)
    run_phase<4>(p, lds, wv);  __syncthreads();
#endif
    run_phase<5>(p, lds, wv);
#if defined(DUP5)
    __syncthreads(); run_phase<5>(p, lds, wv);
#endif
    xcd_barrier(bar);
    run_phase<6>(p, lds, wv);
    run_phase<7>(p, lds, wv);  xcd_barrier(bar);
    run_phase<8>(p, lds, wv);
#if defined(DUP678)
    __syncthreads(); run_phase<6>(p, lds, wv); run_phase<7>(p, lds, wv); xcd_barrier(bar); run_phase<8>(p, lds, wv);
#endif
    xcd_barrier(bar);
#if defined(PRE9)
    ph_router_t<PRE9>(p, lds, wv); __syncthreads();
#endif
    run_phase<9>(p, lds, wv);
#if defined(DUP9)
    __syncthreads(); run_phase<9>(p, lds, wv);
#endif

    xcd_barrier(bar);
    run_phase<11>(p, lds, wv);
#if defined(DUP11)
    __syncthreads(); run_phase<11>(p, lds, wv);
#endif
    xcd_barrier(bar);
    run_phase<12>(p, lds, wv);
#if defined(DUP12)
    __syncthreads(); run_phase<12>(p, lds, wv);
#endif
    xcd_barrier(bar);
    run_phase<13>(p, lds, wv);
#if defined(DUP13)
    __syncthreads(); run_phase<13>(p, lds, wv);
#endif
    xcd_barrier(bar);
#if defined(XBAR10)
    for (int i = 0; i < 10; ++i) xcd_barrier(bar);
#endif
#if defined(DUP14)
    ph_final<true>(p, wv); __syncthreads();
#endif
    run_phase<14>(p, lds, wv);
}

extern "C" void kernel_launch(void* const* d_in, const int* in_sizes, int n_in, void* d_out, int out_size, void* d_ws, size_t ws_size, hipStream_t stream) {
    static int grid = 0; static bool first = true;
    if (grid == 0) {
        if (n_in != 23 || in_sizes[0] != M * D || out_size != M * D || ws_size < WS_END) { fprintf(stderr, "kernel_launch: unexpected shapes (n_in %d, in0 %d, out %d, ws %zu)\n", n_in, n_in > 0 ? in_sizes[0] : -1, out_size, ws_size); grid = -1; return; }
        int dev = 0, cus = 0;
        if (hipGetDevice(&dev) != hipSuccess || hipDeviceGetAttribute(&cus, hipDeviceAttributeMultiprocessorCount, dev) != hipSuccess) { grid = -1; return; }
        grid = cus;
    }
    if (grid < 0) return;
    unsigned char* ws = (unsigned char*)d_ws;
    (void)hipMemsetAsync(ws + WS_CTL, 0, CTL_ZERO_BYTES, stream);
    P p{};
    const float* const* in = (const float* const*)d_in;
    p.x = in[0]; p.w_in = in[1]; p.kv_g = in[2]; p.w_uk = in[3]; p.w_uv = in[4]; p.rel_bias = in[5]; p.ln_g = in[6]; p.ln_b = in[7]; p.w_sp = in[8]; p.b_sp = in[9];
    p.w_pa = in[10]; p.w_pb = in[11]; p.w_out = in[12]; p.n1g = in[13]; p.n2g = in[14]; p.rg_w = in[15]; p.rg_b = in[16]; p.re_w = in[17]; p.re_b = in[18];
    p.w_gate = in[19]; p.w_up = in[20]; p.w_down = in[21]; p.fg = in[22];
    p.out = (float*)d_out; p.ctl = (unsigned*)(ws + WS_CTL);
    p.WinT = (bf16_t*)(ws + WS_WIN); p.WoutT = (bf16_t*)(ws + WS_WOUT); p.WpbT = (bf16_t*)(ws + WS_WPB); p.WovT = (bf16_t*)(ws + WS_WOV); p.WSB = (bf16_t*)(ws + WS_WSB);
    p.WguT = (bf16_t*)(ws + WS_WGU); p.WdT = (bf16_t*)(ws + WS_WD); p.WrT = (float*)(ws + WS_WRT);
    p.HB = (bf16_t*)(ws + WS_A); p.OL = (bf16_t*)(ws + WS_A); p.H2B = (bf16_t*)(ws + WS_A);
    p.QL = (bf16_t*)(ws + WS_B); p.MB = (bf16_t*)(ws + WS_B); p.H2S = (bf16_t*)(ws + WS_B); p.YS = (bf16_t*)(ws + WS_B);
    p.GAB = (bf16_t*)(ws + WS_GA); p.GBB = (bf16_t*)(ws + WS_GB);
    p.UB = (bf16_t*)(ws + WS_C); p.VB = (bf16_t*)(ws + WS_C + 32 * MiB); p.MG = (bf16_t*)(ws + WS_C); p.HE = (bf16_t*)(ws + WS_C);
    p.QI = (bf16_t*)(ws + WS_DQ); p.US = (bf16_t*)(ws + WS_DQ);
    p.CKVR = (float*)(ws + WS_CKVR); p.CKVB = (bf16_t*)(ws + WS_CKVB); p.KI = (bf16_t*)(ws + WS_KI); p.WI = (float*)(ws + WS_WI); p.SEL = (unsigned short*)(ws + WS_SEL);
    p.EID = (int*)(ws + WS_MOE); p.EW = (float*)(ws + WS_MOE + 262144); p.PTOK = (int*)(ws + WS_MOE + 524288); p.MOEI = (int*)(ws + WS_MOE + 1048576);
    p.GU = (int*)(ws + WS_MOE + 1048576 + 4096); p.BLKCNT = (int*)(ws + WS_MOE + 1048576 + 65536); p.IDXROW = (float*)(ws + WS_A); p.RINV2 = (float*)(ws + WS_MOE + 1048576 + 262144); p.CB = (int*)(ws + WS_MOE + 1048576 + 131072); p.DN = (int*)(ws + WS_MOE + 1048576 + 4096 + 8192);
    if (first) { (void)hipFuncSetAttribute((const void*)k_mega, hipFuncAttributeMaxDynamicSharedMemorySize, LDS_BYTES); first = false; }
    hipLaunchKernelGGL(k_mega, dim3(grid), dim3(NTHR), LDS_BYTES, stream, p);
}
```

```cpp
#include <hip/hip_runtime.h>
#include <cstdio>
#include <cstdint>
__device__ __forceinline__ int opaque_tid(const int wv) { int l; asm volatile("v_mbcnt_lo_u32_b32 %0, -1, 0\n\tv_mbcnt_hi_u32_b32 %0, -1, %0" : "=v"(l)); return (wv << 6) + l; }
#define LAS __attribute__((address_space(3)))
namespace pg8 {
#define PG8_LAS __attribute__((address_space(3)))
typedef unsigned short bf16_t;
typedef short bf16x8 __attribute__((ext_vector_type(8)));
typedef float f32x4 __attribute__((ext_vector_type(4)));
typedef unsigned u32x4 __attribute__((ext_vector_type(4)));
constexpr int BM = 256, BK = 64, HALF = 128, HTB = HALF * BK * 2  , STAGE_BYTES = 8 * HTB, NXCD = 8, WGM = 8;

__host__ __device__ __forceinline__ int lds_byte(int r, int c) { const int st = (r >> 4) * 2 + (c >> 5), rr = r & 15, cc = c & 31, ob = rr * 64 + cc * 2; return st * 1024 + (ob ^ (((ob >> 9) & 1) << 5)); }
__host__ __device__ __forceinline__ void stage_rc(int b, int& R, int& C) { const int st = b / 1024, sb = b % 1024, swz = sb ^ (((sb >> 9) & 1) << 5); R = (st >> 1) * 16 + swz / 64; C = (st & 1) * 32 + (swz % 64) / 2; }
__host__ __device__ __forceinline__ int perm32(int rho) { const int n = rho >> 4, i = rho & 15; return 8 * (i >> 2) + 4 * n + (i & 3); }

struct Unit { int pm, pn; };
struct Gemm { const bf16_t* A; const bf16_t* Bt; int M, N, K; };

struct StaticOrder {
    static constexpr bool GATHER = false;
    int nM, nN, nwg, G, c;
    __host__ __device__ void init(int M, int N, int G_, int c_) { nM = M / BM; nN = N / BM; nwg = nM * nN; G = G_; c = c_; }
    __host__ __device__ bool next(int i, Unit& u) const {
        const long L = (long)i * G + c; if (L >= nwg) return false;
        int wgid = (int)L; { const int q = nwg / NXCD, r = nwg % NXCD, xcd = wgid % NXCD, off = wgid / NXCD; wgid = (xcd < r ? xcd * (q + 1) : r * (q + 1) + (xcd - r) * q) + off; }
        const int nig = WGM * nN, gid = wgid / nig, fm = gid * WGM, gsz = (nM - fm) < WGM ? (nM - fm) : WGM;
        u.pm = fm + ((wgid % nig) % gsz); u.pn = (wgid % nig) / gsz; return true;
    }
    __device__ __forceinline__ int arow(int r) const { return r; }
    __device__ __forceinline__ void a_ready(const Unit&) const {}
    __device__ __forceinline__ void done(const Unit&) const {}
};

__device__ __forceinline__ unsigned cvt_pk_bf16(float lo, float hi) { unsigned r; asm volatile("v_cvt_pk_bf16_f32 %0, %1, %2" : "=v"(r) : "v"(lo), "v"(hi)); return r; }
typedef float f32x2 __attribute__((ext_vector_type(2)));
template <class Epi, class Sched, bool ALIGN_EPI = false, bool SP2 = false>
__device__ __forceinline__ void gemm_phase(PG8_LAS unsigned char* lds, const Gemm g, const Sched& S, const Epi& E, const int wv) {
    const int tid = opaque_tid(wv), wid = __builtin_amdgcn_readfirstlane(tid >> 6), lane = tid & 63, wr = wid >> 2, wc = wid & 3, fr = lane & 15, fq = lane >> 4;
    const int K = g.K, nt = K / BK;
    unsigned voffA[2], voffB[2];
#pragma unroll
    for (int i = 0; i < 2; ++i) { int R, C; stage_rc(tid * 16 + i * 8192, R, C); const int Rb = Epi::PERM ? ((R & ~31) + perm32(R & 31)) : R;
        voffA[i] = (unsigned)(R * K + C) * 2u; voffB[i] = (unsigned)(Rb * K + C) * 2u; }
    static_assert(!Sched::GATHER || SP2, "gathered A rows: SP2 loop only");
    unsigned gcur[2][2], gnxt[2][2]; int gR[2], gC[2];
    if constexpr (Sched::GATHER) {
#pragma unroll
        for (int i = 0; i < 2; ++i) { stage_rc(tid * 16 + i * 8192, gR[i], gC[i]); }
    }
#define PG8_GOFF(dst, u_) do { _Pragma("unroll") for (int h_ = 0; h_ < 2; ++h_) _Pragma("unroll") for (int i_ = 0; i_ < 2; ++i_) \
        dst[h_][i_] = ((unsigned)S.arow((u_).pm * BM + h_ * HALF + gR[i_]) * (unsigned)K + (unsigned)gC[i_]) * 2u; } while (0)
    const size_t kstep = (size_t)(BK * 2);
    const size_t hstep = (size_t)HALF * K * 2;
    const size_t tstep = 2 * hstep;
    const unsigned ldsw = (unsigned)wid * 1024u;
    const int aoff = lds_byte(wr * 64 + fr, fq * 8), boff = lds_byte(wc * 32 + fr, fq * 8);
#define PG8_SA(b, h) (((b) * 2 + (h)) * HTB)
#define PG8_SB(b, h) ((4 + (b) * 2 + (h)) * HTB)
#define PG8_STAGE(bufoff, gbase, voff) do { _Pragma("unroll") for (int _i = 0; _i < 2; ++_i) \
        __builtin_amdgcn_global_load_lds((const unsigned*)((const char*)(gbase) + (voff)[_i]), (PG8_LAS unsigned*)(lds + (bufoff) + ldsw + _i * 8192), 16, 0, 0); } while (0)
#define PG8_LDA(dst, b, h) do { _Pragma("unroll") for (int m = 0; m < 4; ++m) _Pragma("unroll") for (int k = 0; k < 2; ++k) dst[m][k] = *(const PG8_LAS bf16x8*)(lds + PG8_SA(b, h) + aoff + m * 2048 + k * 1024); } while (0)
#define PG8_LDB(dst, b, h) do { _Pragma("unroll") for (int n = 0; n < 2; ++n) _Pragma("unroll") for (int k = 0; k < 2; ++k) dst[n][k] = *(const PG8_LAS bf16x8*)(lds + PG8_SB(b, h) + boff + n * 2048 + k * 1024); } while (0)
#define PG8_MMA(ai, bj, At, Bt) do { __builtin_amdgcn_s_setprio(1); _Pragma("unroll") for (int m = 0; m < 4; ++m) _Pragma("unroll") for (int n = 0; n < 2; ++n) _Pragma("unroll") for (int k = 0; k < 2; ++k) \
        acc[ai][bj][m][n] = __builtin_amdgcn_mfma_f32_16x16x32_bf16(Bt[n][k], At[m][k], acc[ai][bj][m][n], 0, 0, 0); __builtin_amdgcn_s_setprio(0); } while (0)
#define PG8_WAIT_V(n) asm volatile("s_waitcnt vmcnt(" #n ")" ::: "memory")
#define PG8_WAIT_L(n) asm volatile("s_waitcnt lgkmcnt(" #n ")" ::: "memory")
#define PG8_BAR __builtin_amdgcn_s_barrier()
#define PG8_SCHED __builtin_amdgcn_sched_barrier(0)
    Unit cur, nxt; int ui = 0;
    if (!S.next(0, cur)) return;
    f32x4 acc[2][2][4][2];
#pragma unroll
    for (int a = 0; a < 2; ++a)
#pragma unroll
        for (int b = 0; b < 2; ++b)
#pragma unroll
            for (int m = 0; m < 4; ++m)
#pragma unroll
                for (int n = 0; n < 2; ++n) acc[a][b][m][n] = (f32x4){0.f, 0.f, 0.f, 0.f};
    bf16x8 At[4][2], B0[2][2], B1[2][2];
    const char* cA = Sched::GATHER ? (const char*)g.A : (const char*)g.A + (size_t)cur.pm * tstep; const char* cB = (const char*)g.Bt + (size_t)cur.pn * tstep;
    S.a_ready(cur);
    if constexpr (Sched::GATHER) { PG8_GOFF(gcur, cur); }
#define PG8_STAGE_A(bufoff, base_, h_, koff_, GO_) do { if constexpr (Sched::GATHER) { PG8_STAGE(bufoff, (const char*)g.A + (koff_), GO_[h_]); } else { PG8_STAGE(bufoff, (base_) + (h_) * hstep + (koff_), voffA); } } while (0)
    if constexpr (SP2) {
        PG8_STAGE(PG8_SB(0, 0), cB, voffB); PG8_STAGE(PG8_SB(0, 1), cB + hstep, voffB); PG8_STAGE_A(PG8_SA(0, 0), cA, 0, 0, gcur); PG8_STAGE_A(PG8_SA(0, 1), cA, 1, 0, gcur);
        if (wr == 1) PG8_BAR;
        PG8_WAIT_V(2); PG8_BAR;
        PG8_STAGE(PG8_SB(1, 0), cB + kstep, voffB); PG8_STAGE_A(PG8_SA(1, 0), cA, 0, kstep, gcur); PG8_STAGE(PG8_SB(1, 1), cB + hstep + kstep, voffB);
        PG8_WAIT_V(6); PG8_BAR;
    } else {
        PG8_STAGE(PG8_SB(0, 0), cB, voffB); PG8_STAGE(PG8_SA(0, 0), cA, voffA); PG8_STAGE(PG8_SB(0, 1), cB + hstep, voffB); PG8_STAGE(PG8_SA(0, 1), cA + hstep, voffA);
        if (wr == 1) PG8_BAR;
        PG8_WAIT_V(4); PG8_BAR;
        PG8_STAGE(PG8_SB(1, 0), cB + kstep, voffB); PG8_STAGE(PG8_SA(1, 0), cA + kstep, voffA); PG8_STAGE(PG8_SB(1, 1), cB + hstep + kstep, voffB);
        PG8_WAIT_V(6); PG8_BAR;
    }
    for (;;) {
        const bool has_next = S.next(ui + 1, nxt);
        const char* nA = Sched::GATHER ? cA : (has_next ? (const char*)g.A + (size_t)nxt.pm * tstep : cA); const char* nB = has_next ? (const char*)g.Bt + (size_t)nxt.pn * tstep : cB;
        if constexpr (Sched::GATHER) { if (has_next) { PG8_GOFF(gnxt, nxt); } else { _Pragma("unroll") for (int h_ = 0; h_ < 2; ++h_) _Pragma("unroll") for (int i_ = 0; i_ < 2; ++i_) gnxt[h_][i_] = gcur[h_][i_]; } }
        for (int t = 0; t < nt; t += 2) {
            const bool last = (t == nt - 2);
            const char* a1 = cA + (size_t)(t + 1) * kstep;
            const char* a2 = last ? nA : cA + (size_t)(t + 2) * kstep; const char* b2 = last ? nB : cB + (size_t)(t + 2) * kstep;
            const char* a3 = a2 + kstep; const char* b3 = b2 + kstep;
            unsigned g2[2][2];
            if constexpr (Sched::GATHER) { _Pragma("unroll") for (int h_ = 0; h_ < 2; ++h_) _Pragma("unroll") for (int i_ = 0; i_ < 2; ++i_) g2[h_][i_] = last ? gnxt[h_][i_] : gcur[h_][i_]; }
            const size_t k1 = (size_t)(t + 1) * kstep, k2 = last ? (size_t)0 : (size_t)(t + 2) * kstep, k3 = k2 + kstep;
            if (last && has_next) S.a_ready(nxt);
            if constexpr (SP2) {
            PG8_LDB(B0, 0, 0); PG8_LDB(B1, 0, 1); PG8_SCHED; PG8_LDA(At, 0, 0); if constexpr (Sched::GATHER) { PG8_STAGE(PG8_SA(1, 1), (const char*)g.A + k1, gcur[1]); } else { PG8_STAGE(PG8_SA(1, 1), a1 + hstep, voffA); }
            PG8_WAIT_V(8); PG8_WAIT_L(0); PG8_BAR; PG8_MMA(0, 0, At, B0); PG8_MMA(0, 1, At, B1); PG8_BAR; PG8_SCHED;
            PG8_LDA(At, 0, 1); PG8_STAGE(PG8_SB(0, 0), b2, voffB); PG8_STAGE(PG8_SB(0, 1), b2 + hstep, voffB); if constexpr (Sched::GATHER) { PG8_STAGE(PG8_SA(0, 0), (const char*)g.A + k2, g2[0]); } else { PG8_STAGE(PG8_SA(0, 0), a2, voffA); }
            PG8_WAIT_V(8); PG8_WAIT_L(0); PG8_BAR; PG8_MMA(1, 0, At, B0); PG8_MMA(1, 1, At, B1); PG8_BAR; PG8_SCHED;
            PG8_LDB(B0, 1, 0); PG8_LDB(B1, 1, 1); PG8_SCHED; PG8_LDA(At, 1, 0); if constexpr (Sched::GATHER) { PG8_STAGE(PG8_SA(0, 1), (const char*)g.A + k2, g2[1]); } else { PG8_STAGE(PG8_SA(0, 1), a2 + hstep, voffA); }
            PG8_WAIT_V(8); PG8_WAIT_L(0); PG8_BAR; PG8_MMA(0, 0, At, B0); PG8_MMA(0, 1, At, B1); PG8_BAR; PG8_SCHED;
            PG8_LDA(At, 1, 1); PG8_STAGE(PG8_SB(1, 0), b3, voffB); PG8_STAGE(PG8_SB(1, 1), b3 + hstep, voffB); if constexpr (Sched::GATHER) { PG8_STAGE(PG8_SA(1, 0), (const char*)g.A + k3, g2[0]); } else { PG8_STAGE(PG8_SA(1, 0), a3, voffA); }
            PG8_WAIT_V(8); PG8_WAIT_L(0); PG8_BAR; PG8_MMA(1, 0, At, B0); PG8_MMA(1, 1, At, B1); PG8_BAR; PG8_SCHED;
            } else {
            PG8_LDB(B0, 0, 0); PG8_SCHED; PG8_LDA(At, 0, 0); PG8_STAGE(PG8_SA(1, 1), a1 + hstep, voffA);
            PG8_WAIT_L(8); PG8_BAR; PG8_WAIT_L(0); PG8_MMA(0, 0, At, B0); PG8_BAR; PG8_SCHED;
            PG8_LDB(B1, 0, 1); PG8_STAGE(PG8_SB(0, 0), b2, voffB);
            PG8_BAR; PG8_WAIT_L(0); PG8_MMA(0, 1, At, B1); PG8_BAR;
            PG8_LDA(At, 0, 1); PG8_STAGE(PG8_SA(0, 0), a2, voffA);
            PG8_BAR; PG8_WAIT_L(0); PG8_MMA(1, 0, At, B0); PG8_BAR; PG8_SCHED;
            PG8_STAGE(PG8_SB(0, 1), b2 + hstep, voffB);
            PG8_WAIT_V(6); PG8_BAR; PG8_MMA(1, 1, At, B1); PG8_BAR;
            PG8_LDB(B0, 1, 0); PG8_SCHED; PG8_LDA(At, 1, 0); PG8_STAGE(PG8_SA(0, 1), a2 + hstep, voffA);
            PG8_WAIT_L(8); PG8_BAR; PG8_WAIT_L(0); PG8_MMA(0, 0, At, B0); PG8_BAR; PG8_SCHED;
            PG8_LDB(B1, 1, 1); PG8_STAGE(PG8_SB(1, 0), b3, voffB);
            PG8_BAR; PG8_WAIT_L(0); PG8_MMA(0, 1, At, B1); PG8_BAR;
            PG8_LDA(At, 1, 1); PG8_STAGE(PG8_SA(1, 0), a3, voffA);
            PG8_BAR; PG8_WAIT_L(0); PG8_MMA(1, 0, At, B0); PG8_BAR; PG8_SCHED;
            PG8_STAGE(PG8_SB(1, 1), b3 + hstep, voffB);
            PG8_WAIT_V(6); PG8_BAR; PG8_MMA(1, 1, At, B1); PG8_BAR;
            }
        }
        if constexpr (ALIGN_EPI) { if (wr == 0) PG8_BAR; }
        if constexpr (!Epi::AFTER_DRAIN) {
            const int tz = opaque_tid(wv), wz = __builtin_amdgcn_readfirstlane(tz >> 6), lz = tz & 63;
            E(acc, cur, wz >> 2, wz & 3, lz & 15, lz >> 4); S.done(cur); }
        if (!has_next) break;
#pragma unroll
        for (int a = 0; a < 2; ++a)
#pragma unroll
            for (int b = 0; b < 2; ++b)
#pragma unroll
                for (int m = 0; m < 4; ++m)
#pragma unroll
                    for (int n = 0; n < 2; ++n) acc[a][b][m][n] = (f32x4){0.f, 0.f, 0.f, 0.f};
        cur = nxt; cA = nA; cB = nB; ++ui;
        if constexpr (Sched::GATHER) { _Pragma("unroll") for (int h_ = 0; h_ < 2; ++h_) _Pragma("unroll") for (int i_ = 0; i_ < 2; ++i_) gcur[h_][i_] = gnxt[h_][i_]; }
        if constexpr (ALIGN_EPI) { if (wr == 1) PG8_BAR; }
    }
    PG8_WAIT_V(0);
    if constexpr (!ALIGN_EPI) { if (wr == 0) PG8_BAR; }
    PG8_BAR;
    if constexpr (Epi::AFTER_DRAIN) { E.fused(acc, cur, wr, wc, fr, fq, lds, wid, lane); S.done(cur); }
#undef PG8_SA
#undef PG8_SB
#undef PG8_STAGE
#undef PG8_STAGE_A
#undef PG8_GOFF
#undef PG8_LDA
#undef PG8_LDB
#undef PG8_MMA
#undef PG8_WAIT_V
#undef PG8_WAIT_L
#undef PG8_BAR
#undef PG8_SCHED
}
}
#define XB_TMO      128
#define XB_XCNT(j)  (256  + 64 * (j))
#define XB_XSUB(j)  (1280 + 64 * (j))
#define XB_XGEN(j)  (2304 + 64 * (j))
#define XB_TOP      3328
#define XB_TOPGEN   3392
#define XCD_BAR_WORDS 3456
#define XB_SPIN_CAP (1u << 18)

__device__ __forceinline__ unsigned xb_ld(unsigned* p)              { return __hip_atomic_load(p, __ATOMIC_RELAXED, __HIP_MEMORY_SCOPE_AGENT); }
__device__ __forceinline__ unsigned xb_add(unsigned* p, unsigned v) { return __hip_atomic_fetch_add(p, v, __ATOMIC_RELAXED, __HIP_MEMORY_SCOPE_AGENT); }
__device__ __forceinline__ unsigned xb_xcc_id() { return (unsigned)__builtin_amdgcn_s_getreg((3 << 11) | 20) & 0xFu; }
#define XB_SPIN(cond, bar) do { unsigned _sp = 0; while (cond) { __builtin_amdgcn_s_sleep(1); \
    if ((++_sp & 255u) == 0u) { if (xb_ld(&(bar)[XB_TMO])) break; if (_sp > XB_SPIN_CAP) { atomicAdd(&(bar)[XB_TMO], 1u); break; } } } } while (0)

struct XcdBarrier {
    unsigned* bar; unsigned x; int wv;
    volatile LAS unsigned* st;
};

__device__ __forceinline__ XcdBarrier xcd_barrier_post(unsigned* bar, volatile LAS unsigned* st, int wv) {
    XcdBarrier b; b.bar = bar; b.x = xb_xcc_id(); b.st = st; b.wv = wv;
    if (opaque_tid(wv) == 0) (void)xb_add(&bar[XB_XCNT(b.x)], 1u);
    return b;
}
__device__ __forceinline__ void xcd_barrier_complete(unsigned* bar, unsigned x, unsigned& nloc, unsigned& nx) {
    const unsigned G = gridDim.x * gridDim.y * gridDim.z;
    unsigned sum, cnt, mine, sp = 0u;
    for (;;) {
        sum = 0u; cnt = 0u; mine = 0u;
#pragma unroll
        for (unsigned j = 0; j < 16; ++j) { const unsigned c = xb_ld(&bar[XB_XCNT(j)]); sum += c; cnt += (c > 0u) ? 1u : 0u; mine = (j == x) ? c : mine; }
        if (sum == G) break;
        __builtin_amdgcn_s_sleep(1);
        if ((++sp & 255u) == 0u) { if (xb_ld(&bar[XB_TMO])) break; if (sp > XB_SPIN_CAP) { atomicAdd(&bar[XB_TMO], 1u); break; } }
    }
    nloc = mine > 0u ? mine : 1u; nx = cnt > 0u ? cnt : 1u;
}

__device__ __forceinline__ void xcd_barrier(const XcdBarrier& b) {
    asm volatile("s_waitcnt vmcnt(0)" ::: "memory");
    __syncthreads();
    if (opaque_tid(b.wv) == 0) {
        unsigned* bar = b.bar;
        __builtin_amdgcn_s_waitcnt(0);
        unsigned nloc = b.st[0], nx = b.st[1];
        if (nloc == 0u) { xcd_barrier_complete(bar, b.x, nloc, nx); b.st[0] = nloc; b.st[1] = nx; }
        const unsigned old = xb_add(&bar[XB_XSUB(b.x)], 1u);
        const unsigned gen = old / nloc;
        if (old + 1u == (gen + 1u) * nloc) {
            __builtin_amdgcn_fence(__ATOMIC_RELEASE, "agent");
            asm volatile("s_waitcnt vmcnt(0)" ::: "memory");
            const unsigned og = xb_add(&bar[XB_TOP], 1u);
            const unsigned tg = og / nx;
            if (og + 1u == (tg + 1u) * nx) xb_add(&bar[XB_TOPGEN], 1u);
            else XB_SPIN(xb_ld(&bar[XB_TOPGEN]) == tg, bar);
            __builtin_amdgcn_fence(__ATOMIC_ACQUIRE, "agent");
            xb_add(&bar[XB_XGEN(b.x)], 1u);
            asm volatile("s_waitcnt vmcnt(0)" ::: "memory");
        } else {
            XB_SPIN(xb_ld(&bar[XB_XGEN(b.x)]) == gen, bar);
            __builtin_amdgcn_fence(__ATOMIC_ACQUIRE, "agent");
            asm volatile("s_waitcnt vmcnt(0)" ::: "memory");
        }
    }
    __syncthreads();
}

typedef unsigned short bf16_t;
typedef short bf16x8 __attribute__((ext_vector_type(8)));
typedef short bf16x4 __attribute__((ext_vector_type(4)));
typedef float f32x4 __attribute__((ext_vector_type(4)));
typedef float f32x2 __attribute__((ext_vector_type(2)));
typedef float f32x16 __attribute__((ext_vector_type(16)));
typedef unsigned u32x4 __attribute__((ext_vector_type(4)));
typedef unsigned u32x2 __attribute__((ext_vector_type(2)));

constexpr int NB = 8, T = 4096, D = 1024, M = NB * T;
constexpr int INC = 4296;
constexpr int NIN = 19 * 256;
constexpr float EPS = 1e-6f;
constexpr int NPOS = 73728;
constexpr int NWAVES = 8, NTHR = 512;
constexpr int LDS_BYTES = 163840;

constexpr size_t MiB = 1u << 20;
constexpr size_t WS_CTL = 0, CTL_ZERO_BYTES = 65536;
constexpr size_t WS_WIN = 1 * MiB, WS_WOUT = 11 * MiB, WS_WPB = 13 * MiB, WS_WOV = 14 * MiB, WS_WSB = 16 * MiB, WS_WRT = 16 * MiB + 262144, WS_WGU = 17 * MiB, WS_WD = 49 * MiB;
constexpr size_t WS_A = 65 * MiB;
constexpr size_t WS_B = 129 * MiB;
constexpr size_t WS_GA = 193 * MiB, WS_GB = 257 * MiB;
constexpr size_t WS_C = 321 * MiB;
constexpr size_t WS_DQ = 385 * MiB;
constexpr size_t WS_CKVR = 417 * MiB, WS_CKVB = 433 * MiB, WS_KI = 441 * MiB, WS_WI = 445 * MiB, WS_SEL = 446 * MiB;
constexpr size_t WS_MOE = 462 * MiB;
constexpr size_t WS_END = 464 * MiB;

constexpr int CW_BAR = 4096;
constexpr int CW_CNT = 8192, CW_CUR = 8256;

struct P {
    const float *x, *w_in, *kv_g, *w_uk, *w_uv, *rel_bias, *ln_g, *ln_b, *w_sp, *b_sp, *w_pa, *w_pb, *w_out, *n1g, *n2g, *rg_w, *rg_b, *re_w, *re_b, *w_gate, *w_up, *w_down, *fg;
    float* out;
    unsigned* ctl;
    bf16_t *WinT, *WoutT, *WpbT, *WovT, *WSB, *WguT, *WdT;
    float* WrT;
    bf16_t *HB, *QL, *QI, *CKVB, *KI, *UB, *VB, *GAB, *GBB, *OL, *US, *MB, *MG, *H2B, *H2S, *HE, *YS;
    float *CKVR, *WI, *EW, *IDXROW, *RINV2;
    unsigned short* SEL;
    int *EID, *PTOK, *MOEI, *GU, *DN, *BLKCNT, *CB;
};

__device__ __forceinline__ unsigned f2bf(float f) { unsigned u = __builtin_bit_cast(unsigned, f); return (u + 0x7fffu + ((u >> 16) & 1u)) >> 16; }
__device__ __forceinline__ unsigned pk2(float lo, float hi) { return f2bf(lo) | (f2bf(hi) << 16); }
__device__ __forceinline__ float bflo(unsigned w) { return __builtin_bit_cast(float, w << 16); }
__device__ __forceinline__ float bfhi(unsigned w) { return __builtin_bit_cast(float, w & 0xffff0000u); }
__device__ __forceinline__ float bf2f(unsigned short b) { return __builtin_bit_cast(float, (unsigned)b << 16); }
__device__ __forceinline__ float wave_sum(float v) {
#pragma unroll
    for (int o = 1; o < 64; o <<= 1) v += __shfl_xor(v, o);
    return v;
}
#define LDS_WAIT() asm volatile("s_waitcnt lgkmcnt(0)" ::: "memory")
__device__ __forceinline__ float sigm(float x) { return __builtin_amdgcn_rcpf(1.f + __builtin_amdgcn_exp2f(-1.4426950409f * x)); }
__device__ __forceinline__ float gelu_t(float x) { const float x2 = x * x; return x * __builtin_amdgcn_rcpf(1.f + __builtin_amdgcn_exp2f(x * (-2.3022082f - 0.1029432f * x2))); }
__device__ __forceinline__ unsigned off_b(unsigned row, unsigned ch) { return 256u * row + 16u * (ch ^ (((row & 3) << 2) | ((row >> 2) & 3))); }
__device__ __forceinline__ bf16x4 tr_read(unsigned lds_addr) { bf16x4 r; asm volatile("ds_read_b64_tr_b16 %0, %1\n\ts_waitcnt lgkmcnt(0)" : "=&v"(r) : "v"(lds_addr) : "memory"); return r; }
__device__ __forceinline__ bf16x8 cat4(bf16x4 a, bf16x4 b) { bf16x8 r; r[0] = a[0]; r[1] = a[1]; r[2] = a[2]; r[3] = a[3]; r[4] = b[0]; r[5] = b[1]; r[6] = b[2]; r[7] = b[3]; return r; }
__device__ __forceinline__ unsigned lds_addr_of(LAS unsigned char* p) { return (unsigned)(unsigned long long)p; }

__device__ __forceinline__ void st8bf(bf16_t* p, const pg8::f32x4& a, const pg8::f32x4& b) {
    u32x4 w; w.x = pg8::cvt_pk_bf16(a[0], a[1]); w.y = pg8::cvt_pk_bf16(a[2], a[3]); w.z = pg8::cvt_pk_bf16(b[0], b[1]); w.w = pg8::cvt_pk_bf16(b[2], b[3]);
    *(u32x4*)p = w;
}
__device__ __forceinline__ void ld8bf(const bf16_t* p, pg8::f32x4& a, pg8::f32x4& b) {
    const u32x4 w = *(const u32x4*)p;
    a[0] = bflo(w.x); a[1] = bfhi(w.x); a[2] = bflo(w.y); a[3] = bfhi(w.y); b[0] = bflo(w.z); b[1] = bfhi(w.z); b[2] = bflo(w.w); b[3] = bfhi(w.w);
}

__device__ __forceinline__ void st8f8(unsigned char* p, const pg8::f32x4& a, const pg8::f32x4& b) {
    float v[8];
#pragma unroll
    for (int j = 0; j < 4; ++j) { v[j] = fminf(fmaxf(a[j], -440.f), 440.f); v[4 + j] = fminf(fmaxf(b[j], -440.f), 440.f); }
    u32x2 h;
    h.x = (unsigned)__builtin_amdgcn_cvt_pk_fp8_f32(v[0], v[1], 0, false); h.x = (unsigned)__builtin_amdgcn_cvt_pk_fp8_f32(v[2], v[3], (int)h.x, true);
    h.y = (unsigned)__builtin_amdgcn_cvt_pk_fp8_f32(v[4], v[5], 0, false); h.y = (unsigned)__builtin_amdgcn_cvt_pk_fp8_f32(v[6], v[7], (int)h.y, true);
    *(u32x2*)p = h;
}
__device__ __forceinline__ void st8q(unsigned char* p, const pg8::f32x4& a, const pg8::f32x4& b, const float scale, const int looff) {
    float v[8];
#pragma unroll
    for (int j = 0; j < 4; ++j) { v[j] = fminf(fmaxf(a[j] * scale, -440.f), 440.f); v[4 + j] = fminf(fmaxf(b[j] * scale, -440.f), 440.f); }
    u32x2 h, l;
    h.x = (unsigned)__builtin_amdgcn_cvt_pk_fp8_f32(v[0], v[1], 0, false); h.x = (unsigned)__builtin_amdgcn_cvt_pk_fp8_f32(v[2], v[3], (int)h.x, true);
    h.y = (unsigned)__builtin_amdgcn_cvt_pk_fp8_f32(v[4], v[5], 0, false); h.y = (unsigned)__builtin_amdgcn_cvt_pk_fp8_f32(v[6], v[7], (int)h.y, true);
    const f32x2 b0 = __builtin_amdgcn_cvt_pk_f32_fp8((int)h.x, false), b1 = __builtin_amdgcn_cvt_pk_f32_fp8((int)h.x, true);
    const f32x2 b2 = __builtin_amdgcn_cvt_pk_f32_fp8((int)h.y, false), b3 = __builtin_amdgcn_cvt_pk_f32_fp8((int)h.y, true);
    l.x = (unsigned)__builtin_amdgcn_cvt_pk_fp8_f32(v[0] - b0[0], v[1] - b0[1], 0, false); l.x = (unsigned)__builtin_amdgcn_cvt_pk_fp8_f32(v[2] - b1[0], v[3] - b1[1], (int)l.x, true);
    l.y = (unsigned)__builtin_amdgcn_cvt_pk_fp8_f32(v[4] - b2[0], v[5] - b2[1], 0, false); l.y = (unsigned)__builtin_amdgcn_cvt_pk_fp8_f32(v[6] - b3[0], v[7] - b3[1], (int)l.y, true);
    *(u32x2*)p = h; *(u32x2*)(p + looff) = l;
}
struct EpiIn {
    static constexpr bool PERM = true, AFTER_DRAIN = false;
    bf16_t *QL, *QI, *KI, *UB, *VB, *GAB, *GBB; float *CKVR, *WI;
    __device__ __forceinline__ void operator()(const pg8::f32x4 (&acc)[2][2][4][2], const pg8::Unit& u, int wr, int wc, int fr, int fq) const {
        const int row0 = u.pm * 256 + wr * 64 + fr, pn = u.pn, c8 = wc * 32 + 8 * fq;
        int mode; bf16_t* dst; int ld;
        if (pn < 4)       { mode = 0; dst = QL + pn * 256; ld = 1024; }
        else if (pn < 6)  { mode = 0; dst = QI + (pn - 4) * 256; ld = 512; }
        else if (pn == 6) { mode = 3; dst = KI; ld = 64; }
        else if (pn < 9)  { mode = 1; dst = UB + (pn - 7) * 256; ld = 512; }
        else if (pn < 11) { mode = 1; dst = VB + (pn - 9) * 256; ld = 512; }
        else if (pn < 15) { mode = 2; dst = GAB + (pn - 11) * 256; ld = 1024; }
        else              { mode = 2; dst = GBB + (pn - 15) * 256; ld = 1024; }
#pragma unroll
        for (int ai = 0; ai < 2; ++ai)
#pragma unroll
            for (int m = 0; m < 4; ++m) {
                const size_t row = (size_t)(row0 + ai * 128 + m * 16);
#pragma unroll
                for (int bj = 0; bj < 2; ++bj) {
                    pg8::f32x4 v0 = acc[ai][bj][m][0], v1 = acc[ai][bj][m][1];
                    if (mode == 3) {
                        if (bj == 0) { float* c = CKVR + row * 128 + c8; *(pg8::f32x4*)c = v0; *(pg8::f32x4*)(c + 4) = v1; }
                        else if (c8 < 64) st8f8((unsigned char*)KI + row * 64 + c8, v0, v1);
                        else if (c8 == 64) { float* c = WI + row * 8; *(pg8::f32x4*)c = v0 * 0.044194174f; *(pg8::f32x4*)(c + 4) = v1 * 0.044194174f; }
                    } else {
                        if (mode == 1) {
#pragma unroll
                            for (int j = 0; j < 4; ++j) { v0[j] = gelu_t(v0[j]); v1[j] = gelu_t(v1[j]); }
                        } else if (mode == 2) {
#pragma unroll
                            for (int j = 0; j < 4; ++j) { v0[j] = sigm(v0[j]); v1[j] = sigm(v1[j]); }
                        }
                        if (pn < 4) st8q((unsigned char*)QL + row * 2048 + (pn * 2 + bj) * 256 + c8, v0, v1, 16.f, 128);
                        else if (pn < 6) { const int col = (pn - 4) * 256 + bj * 128 + c8; st8q((unsigned char*)QI + row * 1024 + (col >> 6) * 128 + (col & 63), v0, v1, 1.f, 64); }
                        else st8bf(dst + row * ld + bj * 128 + c8, v0, v1);
                    }
                }
            }
    }
};

struct EpiMB {
    static constexpr bool PERM = true, AFTER_DRAIN = false;
    const bf16_t* G; bf16_t* O;
    __device__ __forceinline__ void operator()(const pg8::f32x4 (&acc)[2][2][4][2], const pg8::Unit& u, int wr, int wc, int fr, int fq) const {
        const int row0 = u.pm * 256 + wr * 64 + fr, col0 = u.pn * 256 + wc * 32 + 8 * fq;
#pragma unroll
        for (int ai = 0; ai < 2; ++ai)
#pragma unroll
            for (int m = 0; m < 4; ++m)
#pragma unroll
                for (int bj = 0; bj < 2; ++bj) {
                    const size_t o = (size_t)(row0 + ai * 128 + m * 16) * 1024 + col0 + bj * 128;
                    pg8::f32x4 g0, g1; ld8bf(G + o, g0, g1);
                    st8bf(O + o, acc[ai][bj][m][0] * g0, acc[ai][bj][m][1] * g1);
                }
    }
};
struct EpiMG {
    static constexpr bool PERM = true, AFTER_DRAIN = false;
    const bf16_t *G, *MBp; bf16_t* O;
    __device__ __forceinline__ void operator()(const pg8::f32x4 (&acc)[2][2][4][2], const pg8::Unit& u, int wr, int wc, int fr, int fq) const {
        const int row0 = u.pm * 256 + wr * 64 + fr, col0 = u.pn * 256 + wc * 32 + 8 * fq;
#pragma unroll
        for (int ai = 0; ai < 2; ++ai)
#pragma unroll
            for (int m = 0; m < 4; ++m)
#pragma unroll
                for (int bj = 0; bj < 2; ++bj) {
                    const size_t o = (size_t)(row0 + ai * 128 + m * 16) * 1024 + col0 + bj * 128;
                    pg8::f32x4 g0, g1, b0, b1; ld8bf(G + o, g0, g1); ld8bf(MBp + o, b0, b1);
                    st8bf(O + o, acc[ai][bj][m][0] * g0 + b0, acc[ai][bj][m][1] * g1 + b1);
                }
    }
};
struct EpiX1 {
    static constexpr bool PERM = true, AFTER_DRAIN = false;
    const float* X; float* O;
    __device__ __forceinline__ void operator()(const pg8::f32x4 (&acc)[2][2][4][2], const pg8::Unit& u, int wr, int wc, int fr, int fq) const {
        const int row0 = u.pm * 256 + wr * 64 + fr, col0 = u.pn * 256 + wc * 32 + 8 * fq;
#pragma unroll
        for (int ai = 0; ai < 2; ++ai)
#pragma unroll
            for (int m = 0; m < 4; ++m)
#pragma unroll
                for (int bj = 0; bj < 2; ++bj) {
                    const size_t o = (size_t)(row0 + ai * 128 + m * 16) * 1024 + col0 + bj * 128;
                    const pg8::f32x4 x0 = *(const pg8::f32x4*)(X + o), x1 = *(const pg8::f32x4*)(X + o + 4);
                    *(pg8::f32x4*)(O + o) = x0 + acc[ai][bj][m][0]; *(pg8::f32x4*)(O + o + 4) = x1 + acc[ai][bj][m][1];
                }
    }
};
struct EpiHE {
    static constexpr bool PERM = true, AFTER_DRAIN = false;
    bf16_t* HE; const int* PTOK; const float* RINV2;
    __device__ __forceinline__ void operator()(const pg8::f32x4 (&acc)[2][2][4][2], const pg8::Unit& u, int wr, int wc, int fr, int fq) const {
        const int row0 = u.pm * 256 + wr * 64 + fr, col0 = (u.pn & 1) * 128 + wc * 32 + 8 * fq;
#pragma unroll
        for (int ai = 0; ai < 2; ++ai) {
            int ts[4]; float ri[4];
#pragma unroll
            for (int m = 0; m < 4; ++m) ts[m] = PTOK[row0 + ai * 128 + m * 16];
#pragma unroll
            for (int m = 0; m < 4; ++m) ri[m] = RINV2[ts[m] < 0 ? 0 : (ts[m] >> 1)];
#pragma unroll
            for (int m = 0; m < 4; ++m) {
                const float r = ts[m] < 0 ? 0.f : ri[m];
                pg8::f32x4 h0, h1;
#pragma unroll
                for (int j = 0; j < 4; ++j) {
                    const float g0 = r * acc[ai][0][m][0][j], g1 = r * acc[ai][0][m][1][j];
                    h0[j] = g0 * sigm(g0) * (r * acc[ai][1][m][0][j]); h1[j] = g1 * sigm(g1) * (r * acc[ai][1][m][1][j]);
                }
                st8bf(HE + (size_t)(row0 + ai * 128 + m * 16) * 256 + col0, h0, h1);
            }
        }
    }
};
struct EpiDown {
    static constexpr bool PERM = true, AFTER_DRAIN = false;
    const int* PTOK; const float* EW; bf16_t* YS;
    __device__ __forceinline__ void operator()(const pg8::f32x4 (&acc)[2][2][4][2], const pg8::Unit& u, int wr, int wc, int fr, int fq) const {
        const int row0 = u.pm * 256 + wr * 64 + fr, col0 = (u.pn & 3) * 256 + wc * 32 + 8 * fq;
#pragma unroll
        for (int ai = 0; ai < 2; ++ai) {
            int ts[4]; float w[4];
#pragma unroll
            for (int m = 0; m < 4; ++m) ts[m] = PTOK[row0 + ai * 128 + m * 16];
#pragma unroll
            for (int m = 0; m < 4; ++m) w[m] = EW[ts[m] < 0 ? 0 : ts[m]];
#pragma unroll
            for (int m = 0; m < 4; ++m) {
                const int t = ts[m];
                if (t >= 0) {
                    bf16_t* d = YS + ((size_t)(t & 1) * M + (size_t)(t >> 1)) * 1024 + col0;
#pragma unroll
                    for (int bj = 0; bj < 2; ++bj) st8bf(d + bj * 128, acc[ai][bj][m][0] * w[m], acc[ai][bj][m][1] * w[m]);
                }
            }
        }
    }
};
constexpr int LDS_TAB_OFF = 155648;
__device__ __forceinline__ void table_prefetch(LAS unsigned char* lds, const int* tab, const int* nunits, int G, int c, int tid) {
    LAS int* lt = (LAS int*)(lds + LDS_TAB_OFF);
    if (tid < 16) { const int idx = (tid >> 1) * G + c; const int n = __builtin_nontemporal_load(nunits); lt[tid] = idx < n ? tab[2 * idx + (tid & 1)] : -1; }
    __syncthreads();
}
struct TableOrder {
    static constexpr bool GATHER = false;
    const int* tab; const int* nunits; int G, c; const LAS int* lt;
    __device__ __forceinline__ int arow(int r) const { return r; }
    __device__ __forceinline__ bool next(int i, pg8::Unit& u) const {
        if (i < 8) { const int a = lt[2 * i]; if (a < 0) return false; u.pm = a; u.pn = lt[2 * i + 1]; return true; }
        const int idx = i * G + c; const int n = __builtin_nontemporal_load(nunits);
        if (idx >= n) return false;
        u.pm = tab[2 * idx]; u.pn = tab[2 * idx + 1]; return true;
    }
    __device__ __forceinline__ void a_ready(const pg8::Unit&) const {}
    __device__ __forceinline__ void done(const pg8::Unit&) const {}
};

struct TableGatherOrder {
    static constexpr bool GATHER = true;
    const int* tab; const int* nunits; const int* ptok; int G, c; const LAS int* lt;
    __device__ __forceinline__ bool next(int i, pg8::Unit& u) const {
        if (i < 8) { const int a = lt[2 * i]; if (a < 0) return false; u.pm = a; u.pn = lt[2 * i + 1]; return true; }
        const int idx = i * G + c; const int n = __builtin_nontemporal_load(nunits);
        if (idx >= n) return false;
        u.pm = tab[2 * idx]; u.pn = tab[2 * idx + 1]; return true;
    }
    __device__ __forceinline__ int arow(int r) const { const int ts = ptok[r]; return ts < 0 ? 0 : (ts >> 1); }
    __device__ __forceinline__ void a_ready(const pg8::Unit&) const {}
    __device__ __forceinline__ void done(const pg8::Unit&) const {}
};

__device__ __forceinline__ void tr_item(const float* src, int ld, int K, int NC, bf16_t* dst, LAS float* scr, int item, int lane) {
    const int nblk = NC / 32, kb = item / nblk, nb = item % nblk, k0 = 64 * kb, n0 = 32 * nb;
    f32x4 tv[8];
    const int tr = lane >> 3, tc = (lane & 7) * 4;
    if ((((size_t)src) & 15) == 0 && (ld & 3) == 0) {
#pragma unroll
        for (int i = 0; i < 8; ++i) tv[i] = *(const f32x4*)(src + (size_t)(k0 + 8 * i + tr) * ld + n0 + tc);
    } else {
#pragma unroll
        for (int i = 0; i < 8; ++i) { const float* q = src + (size_t)(k0 + 8 * i + tr) * ld + n0 + tc; tv[i] = (f32x4){q[0], q[1], q[2], q[3]}; }
    }
#pragma unroll
    for (int i = 0; i < 8; ++i) { LAS float* d = scr + (8 * i + tr) * 33 + tc; d[0] = tv[i].x; d[1] = tv[i].y; d[2] = tv[i].z; d[3] = tv[i].w; }
    LDS_WAIT();
    const int c = lane & 7;
#pragma unroll
    for (int j = 0; j < 4; ++j) { const int n = (lane >> 3) + 8 * j; const LAS float* s = scr + (8 * c) * 33 + n;
        u32x4 o; o.x = pk2(s[0 * 33], s[1 * 33]); o.y = pk2(s[2 * 33], s[3 * 33]); o.z = pk2(s[4 * 33], s[5 * 33]); o.w = pk2(s[6 * 33], s[7 * 33]);
        *(u32x4*)(dst + (size_t)(n0 + n) * K + k0 + 8 * c) = o; }
    LDS_WAIT();
}

__device__ __forceinline__ void prep_gateup(const P& p, LAS unsigned char* lds, int w_idx, int nw, int wave, int lane) {
    LAS float* scr = (LAS float*)(lds + wave * 16384);
    for (int it = w_idx; it < 8192; it += nw) {
        const int sub = it & 63, q = it >> 6, gu = q & 1, j = (q >> 1) & 1, e = q >> 2;
        const float* src = (gu ? p.w_up : p.w_gate) + (size_t)e * 262144 + 128 * j;
        tr_item(src, 256, 1024, 128, p.WguT + ((size_t)e * 512 + j * 256 + gu * 128) * 1024, scr, sub, lane);
    }
}

__device__ __forceinline__ void ph_prep(const P& p, LAS unsigned char* lds, const int wv) {
    const int tid = opaque_tid(wv), lane = tid & 63, wave = __builtin_amdgcn_readfirstlane(tid >> 6);
    LAS float* scr = (LAS float*)(lds + wave * 16384);
    const int gw = blockIdx.x * NWAVES + wave, NGW = gridDim.x * NWAVES;
    const int gt = blockIdx.x * NTHR + tid, NGT = gridDim.x * NTHR;
    for (int i = gt; i < 64 * 1024; i += NGT) { const int j = i >> 10, k = i & 1023; p.WinT[(size_t)(1728 + j) * 1024 + k] = j < 8 ? (bf16_t)f2bf(p.w_in[(size_t)k * INC + 1216 + j]) : (bf16_t)0; }
    for (int i = gt; i < 4 * 128 * 128; i += NGT) { const int jj = i & 127, ii = (i >> 7) & 127; p.WSB[i] = jj <= ii ? (bf16_t)f2bf(p.w_sp[i]) : (bf16_t)0; }
    for (int i = gt; i < 36 * 1024; i += NGT) { const int c = i >> 10, k = i & 1023; p.WrT[i] = c < 4 ? p.rg_w[k * 4 + c] : p.re_w[k * 32 + (c - 4)]; }
    for (int idx = gw; idx < 16992; idx += NGW) {
        if (idx < 1024) {
            const int it = idx;
            const int h = it >> 7, kt = (it >> 2) & 31, rt = it & 3, i = lane & 31, hf = lane >> 5;
            const f32x4* ap = (const f32x4*)(p.w_in + (size_t)(kt * 32 + i) * INC + h * 64 + 32 * hf);
            const f32x4* bp = (const f32x4*)(p.w_uk + (size_t)((rt * 32 + i) * 8 + h) * 64 + 32 * hf);
            f32x4 av[8], bv[8];
#pragma unroll
            for (int j = 0; j < 8; ++j) { av[j] = ap[j]; bv[j] = bp[j]; }
            f32x16 acc;
#pragma unroll
            for (int j = 0; j < 16; ++j) acc[j] = 0.f;
#pragma unroll
            for (int j = 0; j < 8; ++j)
#pragma unroll
                for (int e = 0; e < 4; ++e) acc = __builtin_amdgcn_mfma_f32_32x32x2f32(av[j][e], bv[j][e], acc, 0, 0, 0);
#pragma unroll
            for (int g4 = 0; g4 < 4; ++g4) {
                constexpr float QS = 0.125f * 1.4426950409f;
                u32x2 w; w.x = pk2(QS * acc[4 * g4], QS * acc[4 * g4 + 1]); w.y = pk2(QS * acc[4 * g4 + 2], QS * acc[4 * g4 + 3]);
                *(u32x2*)(p.WinT + (size_t)(h * 128 + rt * 32 + i) * 1024 + kt * 32 + 8 * g4 + 4 * hf) = w;
            }
        } else if (idx < 2048) {
            const int it = idx - 1024;
            const int h = it >> 7, nt = (it >> 2) & 31, rt = it & 3, i = lane & 31, hf = lane >> 5;
            const f32x4* ap = (const f32x4*)(p.w_uv + (size_t)((rt * 32 + i) * 8 + h) * 64 + 32 * hf);
            const float* bp = p.w_pa + (size_t)(h * 64 + 32 * hf) * 1024 + nt * 32 + i;
            f32x4 av[8]; float bv[32];
#pragma unroll
            for (int j = 0; j < 8; ++j) av[j] = ap[j];
#pragma unroll
            for (int j = 0; j < 32; ++j) bv[j] = bp[(size_t)j * 1024];
            f32x16 acc;
#pragma unroll
            for (int j = 0; j < 16; ++j) acc[j] = 0.f;
#pragma unroll
            for (int j = 0; j < 8; ++j)
#pragma unroll
                for (int e = 0; e < 4; ++e) acc = __builtin_amdgcn_mfma_f32_32x32x2f32(av[j][e], bv[4 * j + e], acc, 0, 0, 0);
#pragma unroll
            for (int g4 = 0; g4 < 4; ++g4) {
                u32x2 w; w.x = pk2(acc[4 * g4], acc[4 * g4 + 1]); w.y = pk2(acc[4 * g4 + 2], acc[4 * g4 + 3]);
                *(u32x2*)(p.WovT + (size_t)(nt * 32 + i) * 1024 + h * 128 + rt * 32 + 8 * g4 + 4 * hf) = w;
            }
        } else if (idx < 3936) {
            int it = idx - 2048;
            const int c0s[7] = {640, 512, 1152, 1224, 1736, 2248, 3272};
            const int ncs[7] = {512, 128, 64, 512, 512, 1024, 1024};
            const int r0s[7] = {1024, 1536, 1664, 1792, 2304, 2816, 3840};
            int c0 = 0, nc = 32, r0 = 0; bool got = false;
#pragma unroll
            for (int sg = 0; sg < 7; ++sg) { const int nit = 16 * (ncs[sg] / 32); if (!got) { if (it < nit) { c0 = c0s[sg]; nc = ncs[sg]; r0 = r0s[sg]; got = true; } else it -= nit; } }
            tr_item(p.w_in + c0, INC, 1024, nc, p.WinT + (size_t)r0 * 1024, scr, it, lane);
        } else if (idx < 4448) {
            tr_item(p.w_out, 1024, 1024, 1024, p.WoutT, scr, idx - 3936, lane);
        } else if (idx < 4704) {
            tr_item(p.w_pb, 1024, 512, 1024, p.WpbT, scr, idx - 4448, lane);
        } else if (idx < 8800) {
            const int it = idx - 4704, sub = it & 127, e = it >> 7;
            tr_item(p.w_down + (size_t)e * 262144, 1024, 256, 1024, p.WdT + (size_t)e * 262144, scr, sub, lane);
        } else {
            const int m4 = idx - 8800;
            f32x4 v[4][4]; float ss[4];
#pragma unroll
            for (int r = 0; r < 4; ++r) { const f32x4* xr = (const f32x4*)(p.x + (size_t)(4 * m4 + r) * D) + lane;
#pragma unroll
                for (int j = 0; j < 4; ++j) v[r][j] = xr[64 * j]; }
#pragma unroll
            for (int r = 0; r < 4; ++r) { ss[r] = 0.f;
#pragma unroll
                for (int j = 0; j < 4; ++j) ss[r] += (v[r][j].x * v[r][j].x + v[r][j].y * v[r][j].y) + (v[r][j].z * v[r][j].z + v[r][j].w * v[r][j].w); }
#pragma unroll
            for (int o = 1; o < 64; o <<= 1) {
#pragma unroll
                for (int r = 0; r < 4; ++r) ss[r] += __shfl_xor(ss[r], o);
            }
#pragma unroll
            for (int r = 0; r < 4; ++r) {
                const float rinv = 1.0f / sqrtf(ss[r] * (1.f / D) + EPS);
                unsigned long long* o8 = (unsigned long long*)(p.HB + (size_t)(4 * m4 + r) * D) + lane;
#pragma unroll
                for (int j = 0; j < 4; ++j) { const f32x4 g = ((const f32x4*)p.n1g)[lane + 64 * j]; const f32x4 o = v[r][j] * rinv * g;
                    o8[64 * j] = (unsigned long long)pk2(o.x, o.y) | ((unsigned long long)pk2(o.z, o.w) << 32); }
            }
        }
    }
}

__device__ __forceinline__ void ph_ckvnorm(const P& p, const int wv) {
    const int tid = opaque_tid(wv), lane = tid & 63, wave = tid >> 6;
    const int gw = blockIdx.x * NWAVES + wave, NGW = gridDim.x * NWAVES;
    const float g0 = p.kv_g[2 * lane], g1 = p.kv_g[2 * lane + 1];
    for (int m4 = gw; m4 < M / 4; m4 += NGW) {
        float2 v[4]; float ss[4];
#pragma unroll
        for (int r = 0; r < 4; ++r) v[r] = ((const float2*)(p.CKVR + (size_t)(4 * m4 + r) * 128))[lane];
#pragma unroll
        for (int r = 0; r < 4; ++r) ss[r] = v[r].x * v[r].x + v[r].y * v[r].y;
#pragma unroll
        for (int o = 1; o < 64; o <<= 1) {
#pragma unroll
            for (int r = 0; r < 4; ++r) ss[r] += __shfl_xor(ss[r], o);
        }
#pragma unroll
        for (int r = 0; r < 4; ++r) { const float rinv = 1.0f / sqrtf(ss[r] * (1.f / 128.f) + EPS);
            const float c0 = fminf(fmaxf(v[r].x * rinv * g0, -440.f), 440.f), c1 = fminf(fmaxf(v[r].y * rinv * g1, -440.f), 440.f);
            ((unsigned short*)((unsigned char*)p.CKVB + (size_t)(4 * m4 + r) * 128))[lane] = (unsigned short)__builtin_amdgcn_cvt_pk_fp8_f32(c0, c1, 0, false); }
    }
}

typedef int i32x8 __attribute__((ext_vector_type(8)));
#ifndef ATT_SKEW
#define ATT_SKEW 10
#endif
__device__ __forceinline__ bf16x4 tr16(const LAS unsigned char* a) { return __builtin_amdgcn_ds_read_tr16_b64_v4i16((LAS bf16x4*)a); }
__device__ __forceinline__ unsigned att_f(unsigned row) { return ((row >> 1) & 3u) | ((((row >> 2) ^ (row >> 4)) & 1u) << 2); }
__device__ __forceinline__ float vmax3(float a, float b, float c) { float r; asm("v_max3_f32 %0, %1, %2, %3" : "=v"(r) : "v"(a), "v"(b), "v"(c)); return r; }
__device__ __forceinline__ float vmax2(float a, float b) { float r; asm("v_max_f32 %0, %1, %2" : "=v"(r) : "v"(a), "v"(b)); return r; }
__device__ __forceinline__ float ror8(float x) { return __int_as_float(__builtin_amdgcn_update_dpp(0, __float_as_int(x), 0x128, 0xf, 0xf, false)); }
__device__ __forceinline__ float xmax16(float x) {
    auto a = __builtin_amdgcn_permlane16_swap(__float_as_uint(x), __float_as_uint(x), false, false);
    const float y = vmax2(__uint_as_float(a[0]), __uint_as_float(a[1]));
    auto b = __builtin_amdgcn_permlane32_swap(__float_as_uint(y), __float_as_uint(y), false, false);
    return vmax2(__uint_as_float(b[0]), __uint_as_float(b[1]));
}
template <int STRIP>
__device__ __forceinline__ void ph_attn_t(const P& p, LAS unsigned char* lds, const int wv) {
    const int tid = opaque_tid(wv), lane = tid & 63, wave = __builtin_amdgcn_readfirstlane(tid >> 6);
    LAS unsigned char* buf = lds + wave * 16384;
    LAS unsigned char* selL = lds + 131072 + wave * 3072;
    LAS unsigned char* selT = selL + 1024;
    LAS unsigned char* bias = lds + 155648;
    for (int i = tid; i < 1024; i += NTHR) {
        const int d = i >> 3; int bk = d;
        if (d >= 16) { const float nf = (float)d; bk = 16 + (int)(logf(nf / 16.f) / 2.0794415f * 16.f); if (bk > 31) bk = 31; }
        ((LAS float*)bias)[i] = 1.4426950409f * p.rel_bias[bk * 8 + (i & 7)];
    }
    __syncthreads();
    const int g = lane >> 4, hcol = lane & 15, r8 = lane >> 3, pc = lane & 7;
    const int G = gridDim.x, bx = blockIdx.x, vcu = (G % 8 == 0) ? (bx % 8) * (G / 8) + bx / 8 : bx;
    const unsigned so0 = 16u * ((unsigned)pc ^ att_f((unsigned)r8)), so1 = so0 ^ 64u;
    unsigned qka[2][2], tra[8];
#pragma unroll
    for (int tau = 0; tau < 2; ++tau)
#pragma unroll
        for (int r = 0; r < 2; ++r) { const unsigned row = hcol + 16 * tau; qka[tau][r] = (unsigned)(size_t)buf + row * 128u + 16u * ((2u * g + r) ^ att_f(row)); }
    {   const unsigned q = (lane & 15) >> 1, row = q < 4 ? 4 * g + q : 16 + 4 * g + (q - 4);
#pragma unroll
        for (int rt = 0; rt < 8; ++rt) tra[rt] = (unsigned)(size_t)buf + row * 128u + 16u * ((unsigned)rt ^ att_f(row)) + 8u * (lane & 1);
    }
    const unsigned biasl = (unsigned)(size_t)bias + 4u * (hcol & 7);
    const int hs = hcol >> 3;
    const unsigned qoff = (unsigned)((hcol & 7) * 256 + 32 * g + (hcol >> 3) * 128), svoff = 8u * (unsigned)lane;
    const long ones8 = 0x3838383838383838L;
#define ATT_Q_LOAD(mm) do { const unsigned char* qb = (const unsigned char*)p.QL + (size_t)(mm) * 2048;            \
        asm volatile("global_load_dwordx4 %0, %1, %2" : "=v"(qn0) : "v"(qoff), "s"(qb)); asm volatile("global_load_dwordx4 %0, %1, %2 offset:16" : "=v"(qn1) : "v"(qoff), "s"(qb)); } while (0)
#define ATT_SV_LOAD(mm) do { const unsigned short* sb = p.SEL + (size_t)(mm) * 256; asm volatile("global_load_dwordx2 %0, %1, %2" : "=v"(sv) : "v"(svoff), "s"(sb)); } while (0)
#define ATT_DMA_CHUNK(img_, selt_, c_) do { const u32x4 k4 = *(const LAS u32x4*)((selt_) + 128 * (c_) + 16 * r8);        \
        __builtin_amdgcn_global_load_lds((const unsigned*)(ckb + (k4.x + so0)), (LAS unsigned*)(img_), 16, 0, 0); \
        __builtin_amdgcn_global_load_lds((const unsigned*)(ckb + (k4.y + so0)), (LAS unsigned*)((img_) + 1024), 16, 0, 0); \
        __builtin_amdgcn_global_load_lds((const unsigned*)(ckb + (k4.z + so1)), (LAS unsigned*)((img_) + 2048), 16, 0, 0); \
        __builtin_amdgcn_global_load_lds((const unsigned*)(ckb + (k4.w + so1)), (LAS unsigned*)((img_) + 3072), 16, 0, 0); } while (0)
#define ATT_SEL_WRITE(par_, sv_, tq_) do { \
        const int k0 = (int)((sv_).x & 0xffffu), k1 = (int)((sv_).x >> 16), k2 = (int)((sv_).y & 0xffffu), k3 = (int)((sv_).y >> 16); \
        const int d0 = min((tq_) - k0, 127), d1 = min((tq_) - k1, 127), d2 = min((tq_) - k2, 127), d3 = min((tq_) - k3, 127); \
        u32x2 dw; dw.x = (unsigned)(d0 * 32) | ((unsigned)(d1 * 32) << 16); dw.y = (unsigned)(d2 * 32) | ((unsigned)(d3 * 32) << 16); \
        *(LAS u32x2*)(selL + (par_) * 512 + lane * 8) = dw; \
        LAS unsigned* tq = (LAS unsigned*)(selT + (par_) * 1024) + (lane >> 3) * 32 + (4 * (lane & 1)) * 4 + ((lane & 7) >> 1); \
        tq[0] = (unsigned)k0 * 128u; tq[4] = (unsigned)k1 * 128u; tq[8] = (unsigned)k2 * 128u; tq[12] = (unsigned)k3 * 128u; } while (0)
    for (int qc = vcu; qc < M / 128; qc += G) {
        const int m0 = qc * 128 + wave * 16;
        const size_t mb = (size_t)(m0 >> 12) * T;
        const unsigned char* ckb = (const unsigned char*)p.CKVB + mb * 128;
        u32x2 sv; u32x4 qn0, qn1; i32x8 qh;
        ATT_SV_LOAD(m0);
        ATT_Q_LOAD(m0);
        asm volatile("s_waitcnt vmcnt(0)" ::: "memory");
        asm volatile("" : "+v"(qn0), "+v"(qn1), "+v"(sv));
        ATT_SEL_WRITE(0, sv, m0 & (T - 1));
        LDS_WAIT();
        ATT_DMA_CHUNK(buf, selT, 0);
        ATT_DMA_CHUNK(buf + 4096, selT, 1);
        __builtin_amdgcn_sched_barrier(0);
        ATT_SV_LOAD(m0 + 1);
        f32x4 o[8], ls; float mref = -1e30f;
#pragma unroll
        for (int rt = 0; rt < 8; ++rt) o[rt] = (f32x4){0.f, 0.f, 0.f, 0.f};
        ls = (f32x4){0.f, 0.f, 0.f, 0.f};
#define ATT_BODY(cp_) do { \
            const int m = m0 + qi, t = m & (T - 1); \
            const LAS unsigned char* selc = selL + (qi & 1) * 512; \
            if ((cp_) == 0) qh = (i32x8){(int)qn0.x, (int)qn0.y, (int)qn0.z, (int)qn0.w, (int)qn1.x, (int)qn1.y, (int)qn1.z, (int)qn1.w}; \
            if (STRIP >= 2) { } \
            else if ((cp_) < 3) { ATT_DMA_CHUNK(buf + (((cp_) + 1) & 1) * 8192, selT + (qi & 1) * 1024, 2 * (cp_) + 2); ATT_DMA_CHUNK(buf + (((cp_) + 1) & 1) * 8192 + 4096, selT + (qi & 1) * 1024, 2 * (cp_) + 3); \
                __builtin_amdgcn_sched_barrier(0); \
                if ((cp_) == 0) { if (qi == 0) asm volatile("s_waitcnt vmcnt(8)" ::: "memory"); else asm volatile("s_waitcnt vmcnt(16)" ::: "memory"); } \
                else if ((cp_) == 1) { if (qi < 15) asm volatile("s_waitcnt vmcnt(10)" ::: "memory"); else asm volatile("s_waitcnt vmcnt(8)" ::: "memory"); } \
                else { if (qi < 14) asm volatile("s_waitcnt vmcnt(9)" ::: "memory"); else asm volatile("s_waitcnt vmcnt(8)" ::: "memory"); } } \
            else if (qi < 15) { ATT_DMA_CHUNK(buf, selT + ((qi + 1) & 1) * 1024, 0); ATT_DMA_CHUNK(buf + 4096, selT + ((qi + 1) & 1) * 1024, 1); \
                __builtin_amdgcn_sched_barrier(0); asm volatile("s_waitcnt vmcnt(8)" ::: "memory"); } \
            else { __builtin_amdgcn_sched_barrier(0); asm volatile("s_waitcnt vmcnt(0)" ::: "memory"); } \
            __builtin_amdgcn_sched_barrier(0); \
              \
              \
            if ((cp_) == 2 && qi < 15) asm volatile("" : "+v"(qn0), "+v"(qn1)); \
            if ((cp_) == 3 && qi < 14) asm volatile("" : "+v"(sv)); \
            if (STRIP == 1) break; \
              \
              \
            i32x8 af[2][2]; u32x2 kk[2]; \
            _Pragma("unroll") for (int tau = 0; tau < 2; ++tau) kk[tau] = *(const LAS u32x2*)(selc + 2 * (64 * (cp_) + 32 * hs + 16 * tau + 4 * g)); \
            _Pragma("unroll") for (int h = 0; h < 2; ++h) _Pragma("unroll") for (int tau = 0; tau < 2; ++tau) { \
                const u32x4 a0 = *(const LAS u32x4*)(size_t)(qka[tau][0] + ((cp_) & 1) * 8192 + h * 4096), a1 = *(const LAS u32x4*)(size_t)(qka[tau][1] + ((cp_) & 1) * 8192 + h * 4096); \
                af[h][tau] = (i32x8){(int)a0.x, (int)a0.y, (int)a0.z, (int)a0.w, (int)a1.x, (int)a1.y, (int)a1.z, (int)a1.w}; } \
              \
            long ta[2][8]; \
            _Pragma("unroll") for (int rt = 0; rt < 8; ++rt) { \
                if (((cp_) & 1) == 0) { asm volatile("ds_read_b64_tr_b8 %0, %1" : "=v"(ta[0][rt]) : "v"(tra[rt])); asm volatile("ds_read_b64_tr_b8 %0, %1 offset:4096" : "=v"(ta[1][rt]) : "v"(tra[rt])); } \
                else { asm volatile("ds_read_b64_tr_b8 %0, %1 offset:8192" : "=v"(ta[0][rt]) : "v"(tra[rt])); asm volatile("ds_read_b64_tr_b8 %0, %1 offset:12288" : "=v"(ta[1][rt]) : "v"(tra[rt])); } \
            } \
            float bv[2][4]; \
            _Pragma("unroll") for (int tau = 0; tau < 2; ++tau) { \
                bv[tau][0] = *(const LAS float*)(size_t)(biasl + (kk[tau].x & 0xffffu)); bv[tau][1] = *(const LAS float*)(size_t)(biasl + (kk[tau].x >> 16)); \
                bv[tau][2] = *(const LAS float*)(size_t)(biasl + (kk[tau].y & 0xffffu)); bv[tau][3] = *(const LAS float*)(size_t)(biasl + (kk[tau].y >> 16)); } \
            if ((cp_) == 0 && qi < 15) ATT_Q_LOAD(m + 1); \
            if ((cp_) == 1 && qi < 15) { \
                ATT_SEL_WRITE((qi + 1) & 1, sv, (m + 1) & (T - 1)); \
                if (qi < 14) ATT_SV_LOAD(m + 2); \
            } \
            __builtin_amdgcn_sched_barrier(0); \
            f32x4 acc[2][2]; \
            _Pragma("unroll") for (int h = 0; h < 2; ++h) _Pragma("unroll") for (int tau = 0; tau < 2; ++tau) \
                acc[h][tau] = __builtin_amdgcn_mfma_scale_f32_16x16x128_f8f6f4(af[h][tau], qh, (f32x4){0.f, 0.f, 0.f, 0.f}, 0, 0, 0, 0, 0, 0); \
              \
              \
            float sr[2][4]; \
            asm volatile("s_nop 15\n\ts_nop 3" :: "v"(acc[0][0]), "v"(acc[0][1]), "v"(acc[1][0]), "v"(acc[1][1])); \
            _Pragma("unroll") for (int tau = 0; tau < 2; ++tau) _Pragma("unroll") for (int r = 0; r < 4; ++r) { float d; \
                const float x1 = acc[1][tau][r], x0 = acc[0][tau][r]; \
                asm volatile("v_add_f32_dpp %0, %1, %1 row_ror:8 row_mask:0xf bank_mask:0xc" : "=v"(d) : "v"(x1)); \
                asm volatile("v_add_f32_dpp %0, %1, %1 row_ror:8 row_mask:0xf bank_mask:0x3" : "+v"(d) : "v"(x0)); \
                sr[tau][r] = d; } \
            float sc[2][4]; \
            _Pragma("unroll") for (int tau = 0; tau < 2; ++tau) _Pragma("unroll") for (int r = 0; r < 4; ++r) sc[tau][r] = fmaf(sr[tau][r], 0.0625f, bv[tau][r]); \
            if (t < 255) {                                           \
                _Pragma("unroll") for (int tau = 0; tau < 2; ++tau) _Pragma("unroll") for (int r = 0; r < 4; ++r) \
                    if (64 * (cp_) + 32 * hs + 16 * tau + 4 * g + r > t) sc[tau][r] = -1e30f; \
            } \
            const float mxh = vmax3(vmax3(sc[0][0], sc[0][1], sc[0][2]), vmax3(sc[0][3], sc[1][0], sc[1][1]), vmax2(sc[1][2], sc[1][3])); \
            const float mx = xmax16(vmax2(mxh, ror8(mxh))); \
            if ((cp_) == 0) mref = mx; \
            else if (__builtin_amdgcn_ballot_w64(mx > mref + 3.0f) != 0) {                         \
                const float mn = vmax2(mref, mx), rs = __builtin_amdgcn_exp2f(mref - mn); mref = mn; \
                _Pragma("unroll") for (int rt = 0; rt < 8; ++rt) o[rt] *= rs; \
                ls *= rs; \
            } \
            const float mo = mref - 5.0f; \
            long pf[2]; \
            { float pr[2][4]; \
                _Pragma("unroll") for (int tau = 0; tau < 2; ++tau) _Pragma("unroll") for (int r = 0; r < 4; ++r) pr[tau][r] = __builtin_amdgcn_exp2f(sc[tau][r] - mo); \
                u32x2 pw, px; \
                pw.x = (unsigned)__builtin_amdgcn_cvt_pk_fp8_f32(pr[0][0], pr[0][1], 0, false); pw.x = (unsigned)__builtin_amdgcn_cvt_pk_fp8_f32(pr[0][2], pr[0][3], (int)pw.x, true); \
                pw.y = (unsigned)__builtin_amdgcn_cvt_pk_fp8_f32(pr[1][0], pr[1][1], 0, false); pw.y = (unsigned)__builtin_amdgcn_cvt_pk_fp8_f32(pr[1][2], pr[1][3], (int)pw.y, true); \
                px.x = (unsigned)__builtin_amdgcn_update_dpp(0, (int)pw.x, 0x128, 0xf, 0xf, false); px.y = (unsigned)__builtin_amdgcn_update_dpp(0, (int)pw.y, 0x128, 0xf, 0xf, false); \
                pf[0] = __builtin_bit_cast(long, pw); pf[1] = __builtin_bit_cast(long, px); }        \
            asm volatile("s_waitcnt lgkmcnt(0)" : "+v"(ta[0][0]), "+v"(ta[0][1]), "+v"(ta[0][2]), "+v"(ta[0][3]), "+v"(ta[0][4]), "+v"(ta[0][5]), "+v"(ta[0][6]), "+v"(ta[0][7])); \
            asm volatile("" : "+v"(ta[1][0]), "+v"(ta[1][1]), "+v"(ta[1][2]), "+v"(ta[1][3]), "+v"(ta[1][4]), "+v"(ta[1][5]), "+v"(ta[1][6]), "+v"(ta[1][7])); \
            _Pragma("unroll") for (int h = 0; h < 2; ++h) { \
                _Pragma("unroll") for (int rt = 0; rt < 8; ++rt) o[rt] = __builtin_amdgcn_mfma_f32_16x16x32_fp8_fp8(ta[h][rt], pf[h], o[rt], 0, 0, 0); \
                ls = __builtin_amdgcn_mfma_f32_16x16x32_fp8_fp8(ones8, pf[h], ls, 0, 0, 0); } \
            if ((cp_) == 3) { \
                const float inv = __builtin_amdgcn_rcpf(ls[0]); \
                if (hcol < 8) { \
                    _Pragma("unroll") for (int rt = 0; rt < 8; ++rt) { \
                        u32x2 w; w.x = pg8::cvt_pk_bf16(o[rt][0] * inv, o[rt][1] * inv); w.y = pg8::cvt_pk_bf16(o[rt][2] * inv, o[rt][3] * inv); \
                        *(u32x2*)(p.OL + (size_t)m * 1024 + hcol * 128 + 16 * rt + 4 * g) = w; \
                    } \
                } \
                _Pragma("unroll") for (int rt = 0; rt < 8; ++rt) o[rt] = (f32x4){0.f, 0.f, 0.f, 0.f}; \
                ls = (f32x4){0.f, 0.f, 0.f, 0.f}; \
            } } while (0)
        if (wave >= 4) { __builtin_amdgcn_s_sleep(ATT_SKEW); }
#pragma unroll 1
        for (int qi = 0; qi < 16; ++qi) {
            ATT_BODY(0); ATT_BODY(1); ATT_BODY(2); ATT_BODY(3);
        }
#undef ATT_BODY
        asm volatile("s_waitcnt vmcnt(0)" ::: "memory");
    }
#undef ATT_DMA_CHUNK
#undef ATT_SEL_WRITE
#undef ATT_Q_LOAD
}

__device__ __forceinline__ unsigned q16of(float x) { return (unsigned)(int)__builtin_fminf(__builtin_fmaxf((x + 8.0f) * 4096.0f, 0.0f), 65535.0f); }

__device__ __forceinline__ unsigned wave_incl_scan(unsigned x) {
    x += (unsigned)__builtin_amdgcn_update_dpp(0, (int)x, 0x111, 0xf, 0xf, false);
    x += (unsigned)__builtin_amdgcn_update_dpp(0, (int)x, 0x112, 0xf, 0xf, false);
    x += (unsigned)__builtin_amdgcn_update_dpp(0, (int)x, 0x114, 0xf, 0xf, false);
    x += (unsigned)__builtin_amdgcn_update_dpp(0, (int)x, 0x118, 0xf, 0xf, false);
    x += (unsigned)__builtin_amdgcn_update_dpp(0, (int)x, 0x142, 0xa, 0xf, false);
    x += (unsigned)__builtin_amdgcn_update_dpp(0, (int)x, 0x143, 0xc, 0xf, false);
    return x;
}
__device__ __forceinline__ void select_row7(const LAS unsigned short* row, int n, LAS unsigned* hist, LAS unsigned* h2, unsigned short* out, int lane) {
    if (n <= 256) {
#pragma unroll
        for (int i = 0; i < 4; ++i) { const int k = lane + 64 * i; out[k] = (unsigned short)(k < n ? k : 0); }
#pragma unroll
        for (int i = 0; i < 8; ++i) hist[lane + 64 * i] = 0u;
        return;
    }
    const unsigned long long lt = (1ull << lane) - 1ull;
    unsigned b1, above;
    {
        const int rl = 63 - lane;
        const u32x4 w0 = *(const LAS u32x4*)(hist + 8 * rl), w1 = *(const LAS u32x4*)(hist + 8 * rl + 4);
        unsigned c[16];
        c[0] = w0.x & 0xffffu; c[1] = w0.x >> 16; c[2] = w0.y & 0xffffu; c[3] = w0.y >> 16; c[4] = w0.z & 0xffffu; c[5] = w0.z >> 16; c[6] = w0.w & 0xffffu; c[7] = w0.w >> 16;
        c[8] = w1.x & 0xffffu; c[9] = w1.x >> 16; c[10] = w1.y & 0xffffu; c[11] = w1.y >> 16; c[12] = w1.z & 0xffffu; c[13] = w1.z >> 16; c[14] = w1.w & 0xffffu; c[15] = w1.w >> 16;
        unsigned s = 0;
#pragma unroll
        for (int j = 0; j < 16; ++j) s += c[j];
        const unsigned incl = wave_incl_scan(s), excl = incl - s;
        const bool mine = (excl < 256u) && (incl >= 256u);
        unsigned bin = 0, ab = 0, run = excl, found = 0u;
#pragma unroll
        for (int j = 15; j >= 0; --j) { const unsigned r2 = run + c[j]; const unsigned hit = (found == 0u && r2 >= 256u) ? 1u : 0u;
            bin = hit ? (unsigned)(16 * rl + j) : bin; ab = hit ? run : ab; found |= hit; run = r2; }
        const unsigned long long bm = __ballot(mine);
        const int src = __builtin_amdgcn_readfirstlane(bm ? (int)__builtin_ctzll(bm) : 0);
        b1 = (unsigned)__builtin_amdgcn_readlane((int)bin, src); above = (unsigned)__builtin_amdgcn_readlane((int)ab, src);
    }
    LDS_WAIT();
    int need = 256 - (int)above;
    LAS unsigned short* cand = (LAS unsigned short*)hist;
    const int nblk = (n + 255) >> 8;
    const unsigned thr = b1 << 6;
    int C = 0;
    u32x2 vn = *(const LAS u32x2*)(row + 4 * lane);
    for (int blk = 0; blk < nblk; ++blk) {
        const u32x2 v = vn;
        if (blk + 1 < nblk) vn = *(const LAS u32x2*)(row + (blk + 1) * 256 + 4 * lane);
        const unsigned q[4] = {v.x & 0xffffu, v.x >> 16, v.y & 0xffffu, v.y >> 16};
        bool ge[4]; unsigned long long bl[4];
#pragma unroll
        for (int e = 0; e < 4; ++e) { ge[e] = (blk * 256 + 4 * lane + e < n) && (q[e] >= thr); bl[e] = __ballot(ge[e]); }
        const int below = __builtin_popcountll(bl[0] & lt) + __builtin_popcountll(bl[1] & lt) + __builtin_popcountll(bl[2] & lt) + __builtin_popcountll(bl[3] & lt);
        int pos = C + below;
#pragma unroll
        for (int e = 0; e < 4; ++e) { if (ge[e]) { if (pos < 768) cand[pos] = (unsigned short)(blk * 256 + 4 * lane + e); ++pos; } }
        C += __builtin_popcountll(bl[0]) + __builtin_popcountll(bl[1]) + __builtin_popcountll(bl[2]) + __builtin_popcountll(bl[3]);
    }
    LDS_WAIT();
    LAS unsigned short* outL = cand + 768;
    if (C <= 512) {
        int ci[8]; unsigned cq[8]; bool ceq[8];
#pragma unroll
        for (int k = 0; k < 8; ++k) { const int j = lane + 64 * k; ci[k] = j < C ? (int)cand[j] : -1; }
#pragma unroll
        for (int k = 0; k < 8; ++k) { cq[k] = ci[k] >= 0 ? (unsigned)row[ci[k]] : 0u; ceq[k] = ci[k] >= 0 && (cq[k] >> 6) == b1; }
        h2[lane] = 0u;
        LDS_WAIT();
#pragma unroll
        for (int k = 0; k < 8; ++k) if (ceq[k]) __hip_atomic_fetch_add(h2 + (cq[k] & 63u), 1u, __ATOMIC_RELAXED, __HIP_MEMORY_SCOPE_WORKGROUP);
        LDS_WAIT();
        const unsigned cme = h2[63 - lane];
        const unsigned incl = wave_incl_scan(cme), excl = incl - cme;
        const bool mine = (excl < (unsigned)need) && (incl >= (unsigned)need);
        const unsigned long long bm = __ballot(mine);
        const int src = __builtin_amdgcn_readfirstlane(bm ? (int)__builtin_ctzll(bm) : 0);
        const unsigned Tl = (unsigned)(63 - src);
        need -= __builtin_amdgcn_readlane((int)excl, src);
        const unsigned Tq = (b1 << 6) | Tl;
        int eq_seen = 0, cnt = 0;
#pragma unroll
        for (int k = 0; k < 8; ++k) {
            const bool valid = ci[k] >= 0, eqk = valid && cq[k] == Tq;
            const unsigned long long beq = __ballot(eqk);
            const int eq_rank = eq_seen + __builtin_popcountll(beq & lt);
            const bool take = valid && (cq[k] > Tq || (eqk && eq_rank < need));
            const unsigned long long bt = __ballot(take);
            const int pos = cnt + __builtin_popcountll(bt & lt);
            if (take && pos < 256) outL[pos] = (unsigned short)ci[k];
            cnt += __builtin_popcountll(bt); eq_seen += __builtin_popcountll(beq);
        }
    } else {
        unsigned lo = 0u, hi = 65535u;
        while (lo < hi) {
            const unsigned mid = (lo + hi + 1u) >> 1;
            int cge = 0;
            for (int i = lane; i < n; i += 64) cge += ((unsigned)row[i] >= mid) ? 1 : 0;
#pragma unroll
            for (int o = 1; o < 64; o <<= 1) cge += __shfl_xor(cge, o);
            if (cge >= 256) lo = mid; else hi = mid - 1u;
        }
        const unsigned Tq = lo;
        int cgt = 0;
        for (int i = lane; i < n; i += 64) cgt += ((unsigned)row[i] > Tq) ? 1 : 0;
#pragma unroll
        for (int o = 1; o < 64; o <<= 1) cgt += __shfl_xor(cgt, o);
        const int needq = 256 - cgt;
        int cnt = 0, eq_seen = 0;
        for (int i0 = 0; i0 < n; i0 += 64) {
            const int i = i0 + lane; const bool valid = i < n;
            const unsigned qv = valid ? (unsigned)row[i] : 0u;
            const bool eqk = valid && qv == Tq;
            const unsigned long long beq = __ballot(eqk);
            const int eq_rank = eq_seen + __builtin_popcountll(beq & lt);
            const bool take = valid && (qv > Tq || (eqk && eq_rank < needq));
            const unsigned long long bt = __ballot(take);
            const int pos = cnt + __builtin_popcountll(bt & lt);
            if (take && pos < 256) outL[pos] = (unsigned short)i;
            cnt += __builtin_popcountll(bt); eq_seen += __builtin_popcountll(beq);
        }
    }
    LDS_WAIT();
    *(u32x2*)(out + 4 * lane) = *(const LAS u32x2*)(outL + 4 * lane);
    LDS_WAIT();
#pragma unroll
    for (int i = 0; i < 8; ++i) hist[lane + 64 * i] = 0u;
}

template <int STRIP> __device__ __forceinline__ void ph_index7_t(const P& p, LAS unsigned char* lds, const int wv) {
    LAS unsigned short* Irow = (LAS unsigned short*)lds;
    LAS unsigned* hist = (LAS unsigned*)(lds + 65536);
    LAS unsigned* h2 = (LAS unsigned*)(lds + 81920);
    const int tid = opaque_tid(wv), lane = tid & 63, wave = __builtin_amdgcn_readfirstlane(tid >> 6);
    const int hh = lane >> 5, n = lane & 31;
    const int rho = lane & 31, qlA = 2 * ((rho >> 2) & 1) + (rho >> 4), hdA = (rho & 3) + 4 * ((rho >> 3) & 1);
    const unsigned boff = (unsigned)(n * 64 + 16 * hh);
#pragma unroll
    for (int i = 0; i < 8; ++i) hist[tid + NTHR * i] = 0u;
    i32x8 Ah[2], Al[2]; float wq[2][16]; u32x4 R0a, R0b, R1a, R1b, R2a, R2b, R3a, R3b;
#define IDX8_LOAD(Ra_, Rb_, mb_, kt_) do { const unsigned char* kb_ = (const unsigned char*)p.KI + ((mb_) + (size_t)(kt_) * 32) * 64; \
        asm volatile("global_load_dwordx4 %0, %1, %2" : "=v"(Ra_) : "v"(boff), "s"(kb_)); asm volatile("global_load_dwordx4 %0, %1, %2 offset:32" : "=v"(Rb_) : "v"(boff), "s"(kb_)); } while (0)
#define IDX8_LOAD_UNIT(u_) do { const int b_ = (u_) & 7, t0_ = (511 - ((u_) >> 3)) * 8; const size_t mb_ = (size_t)b_ * T; const int nkt_ = (t0_ + 8 + 31) >> 5; \
        _Pragma("unroll") for (int mt = 0; mt < 2; ++mt) { const unsigned char* src = (const unsigned char*)p.QI + (mb_ + t0_ + mt * 4 + qlA) * 1024 + hdA * 128 + 16 * hh; \
            const u32x4 h0 = *(const u32x4*)src, h1 = *(const u32x4*)(src + 32), l0 = *(const u32x4*)(src + 64), l1 = *(const u32x4*)(src + 96); \
            Ah[mt] = (i32x8){(int)h0.x, (int)h0.y, (int)h0.z, (int)h0.w, (int)h1.x, (int)h1.y, (int)h1.z, (int)h1.w}; \
            Al[mt] = (i32x8){(int)l0.x, (int)l0.y, (int)l0.z, (int)l0.w, (int)l1.x, (int)l1.y, (int)l1.z, (int)l1.w}; \
            _Pragma("unroll") for (int c = 0; c < 2; ++c) { const float* wp = p.WI + (mb_ + t0_ + mt * 4 + 2 * hh + c) * 8; const f32x4 w0 = *(const f32x4*)wp, w1 = *(const f32x4*)(wp + 4); \
                _Pragma("unroll") for (int j = 0; j < 4; ++j) { wq[mt][c * 8 + j] = w0[j]; wq[mt][c * 8 + 4 + j] = w1[j]; } } } \
        __builtin_amdgcn_sched_barrier(0); \
        IDX8_LOAD(R0a, R0b, mb_, min(wave, nkt_ - 1)); IDX8_LOAD(R1a, R1b, mb_, min(wave + NWAVES, nkt_ - 1));            \
        IDX8_LOAD(R2a, R2b, mb_, min(wave + 2 * NWAVES, nkt_ - 1)); IDX8_LOAD(R3a, R3b, mb_, min(wave + 3 * NWAVES, nkt_ - 1)); } while (0)
    if ((int)blockIdx.x < 4096) IDX8_LOAD_UNIT((int)blockIdx.x);
    __syncthreads();
    for (int u = blockIdx.x; u < 4096; u += gridDim.x) {
        const int b = u & 7, tb = 511 - (u >> 3), t0 = tb * 8; const size_t mb = (size_t)b * T;
        const int nkt = (t0 + 8 + 31) >> 5;
#pragma unroll
        for (int mt = 0; mt < 2; ++mt) {
            asm volatile("" :: "v"(Ah[mt]), "v"(Al[mt]));
#pragma unroll
            for (int j = 0; j < 16; ++j) asm volatile("" :: "v"(wq[mt][j]));
        }
#define IDX8_BODY(s_, kt_, Ra_, Rb_) do { const int kt = (kt_); if (kt < nkt) { \
            const int rem = (nkt - 1 - kt) >> 3;                    \
            const int yt = (k0 == wave && last <= 3) ? 3 - (s_) : (rem < 3 ? rem : 3);        \
            if (yt >= 3) asm volatile("s_waitcnt vmcnt(6)" ::: "memory"); else if (yt == 2) asm volatile("s_waitcnt vmcnt(4)" ::: "memory"); \
            else if (yt == 1) asm volatile("s_waitcnt vmcnt(2)" ::: "memory"); else asm volatile("s_waitcnt vmcnt(0)" ::: "memory"); \
            asm volatile("" : "+v"(Ra_), "+v"(Rb_)); \
            const i32x8 Bf = (i32x8){(int)Ra_.x, (int)Ra_.y, (int)Ra_.z, (int)Ra_.w, (int)Rb_.x, (int)Rb_.y, (int)Rb_.z, (int)Rb_.w}; \
            f32x16 acc[2]; \
            _Pragma("unroll") for (int mt = 0; mt < 2; ++mt) { \
                _Pragma("unroll") for (int j = 0; j < 16; ++j) acc[mt][j] = 0.f; \
                acc[mt] = __builtin_amdgcn_mfma_scale_f32_32x32x64_f8f6f4(Ah[mt], Bf, acc[mt], 0, 0, 0, 0, 0, 0); \
                acc[mt] = __builtin_amdgcn_mfma_scale_f32_32x32x64_f8f6f4(Al[mt], Bf, acc[mt], 0, 0, 0, 0, 0, 0); } \
            __builtin_amdgcn_sched_barrier(0); \
            if (kt + 4 * NWAVES < nkt) IDX8_LOAD(Ra_, Rb_, mb, kt + 4 * NWAVES); \
            __builtin_amdgcn_sched_barrier(0); \
            const int key = kt * 32 + n; \
            _Pragma("unroll") for (int mt = 0; mt < 2; ++mt) { \
                _Pragma("unroll") for (int c = 0; c < 2; ++c) { \
                    float v = 0.f; \
                    _Pragma("unroll") for (int h = 0; h < 8; ++h) { const float af = acc[mt][c * 8 + h]; const int ai = __float_as_int(af); v = __builtin_fmaf(wq[mt][c * 8 + h], __int_as_float(ai > 0 ? ai : 0), v); } \
                    const int r = mt * 4 + 2 * hh + c; const unsigned q = q16of(v); \
                    Irow[r * 4096 + key] = (unsigned short)q; \
                    if (key <= t0 + r) { const unsigned bin = q >> 6; __hip_atomic_fetch_add(hist + r * 512 + (bin >> 1), 1u << ((bin & 1u) * 16u), __ATOMIC_RELAXED, __HIP_MEMORY_SCOPE_WORKGROUP); } \
                } \
            } } } while (0)
        const int last = (nkt - 1 - wave) >> 3;
#pragma unroll 1
        for (int k0 = wave; k0 < nkt; k0 += 4 * NWAVES) {
            IDX8_BODY(0, k0, R0a, R0b);
            IDX8_BODY(1, k0 + NWAVES, R1a, R1b);
            IDX8_BODY(2, k0 + 2 * NWAVES, R2a, R2b);
            IDX8_BODY(3, k0 + 3 * NWAVES, R3a, R3b);
        }
#undef IDX8_BODY
        if (u + (int)gridDim.x < 4096) IDX8_LOAD_UNIT(u + (int)gridDim.x);
        LDS_WAIT(); __builtin_amdgcn_s_barrier();
        if (STRIP != 1) select_row7(Irow + wave * 4096, t0 + wave + 1, hist + wave * 512, h2 + wave * 320, p.SEL + (mb + t0 + wave) * 256, lane);
        else { _Pragma("unroll") for (int i = 0; i < 8; ++i) hist[wave * 512 + lane + 64 * i] = 0u; }
        LDS_WAIT(); __builtin_amdgcn_s_barrier();
    }
#undef IDX8_LOAD
#undef IDX8_LOAD_UNIT
}

__device__ __forceinline__ void ph_index7(const P& p, LAS unsigned char* lds, const int wv) { ph_index7_t<0>(p, lds, wv); }

__device__ __forceinline__ void ph_gmlp(const P& p, LAS unsigned char* lds, const int wv) {
    const int tid = opaque_tid(wv), lane = tid & 63, wave = __builtin_amdgcn_readfirstlane(tid >> 6);
    LAS unsigned char* vt = lds;
    LAS float* st = (LAS float*)(lds + 32768);
    const int g4 = lane >> 4, q4 = (lane & 15) >> 2, p4 = lane & 3, ic = lane & 15;
    for (int u = blockIdx.x; u < 256; u += gridDim.x) {
        const size_t m0 = (size_t)u * 128;
#pragma unroll 1
        for (int r4 = 0; r4 < 4; ++r4) {
            float x[4][8], sm[4];
#pragma unroll
            for (int r = 0; r < 4; ++r) { const u32x4 w = *(const u32x4*)(p.VB + (m0 + 16 * wave + 4 * r4 + r) * 512 + lane * 8);
                x[r][0] = bflo(w.x); x[r][1] = bfhi(w.x); x[r][2] = bflo(w.y); x[r][3] = bfhi(w.y); x[r][4] = bflo(w.z); x[r][5] = bfhi(w.z); x[r][6] = bflo(w.w); x[r][7] = bfhi(w.w); }
#pragma unroll
            for (int r = 0; r < 4; ++r) sm[r] = ((x[r][0] + x[r][1]) + (x[r][2] + x[r][3])) + ((x[r][4] + x[r][5]) + (x[r][6] + x[r][7]));
#pragma unroll
            for (int o = 1; o < 64; o <<= 1) {
#pragma unroll
                for (int r = 0; r < 4; ++r) sm[r] += __shfl_xor(sm[r], o);
            }
            float vr[4];
#pragma unroll
            for (int r = 0; r < 4; ++r) { const float mean = sm[r] * (1.f / 512.f); sm[r] = mean; float a = 0.f;
#pragma unroll
                for (int j = 0; j < 8; ++j) { const float d = x[r][j] - mean; a += d * d; }
                vr[r] = a; }
#pragma unroll
            for (int o = 1; o < 64; o <<= 1) {
#pragma unroll
                for (int r = 0; r < 4; ++r) vr[r] += __shfl_xor(vr[r], o);
            }
            if (lane == 0) {
#pragma unroll
                for (int r = 0; r < 4; ++r) { const int row = 16 * wave + 4 * r4 + r; st[2 * row] = sm[r]; st[2 * row + 1] = 1.0f / sqrtf(vr[r] * (1.f / 512.f) + EPS); }
            }
        }
        __syncthreads();
#pragma unroll 1
        for (int g = 0; g < 4; ++g) {
#pragma unroll
            for (int i = 0; i < 4; ++i) {
                const int piece = i * NTHR + tid, row = piece >> 4, ch = piece & 15;
                const u32x4 w = *(const u32x4*)(p.VB + (m0 + row) * 512 + g * 128 + ch * 8);
                const float mean = st[2 * row], rstd = st[2 * row + 1];
                const f32x4 ga = *(const f32x4*)(p.ln_g + g * 128 + ch * 8), gb = *(const f32x4*)(p.ln_g + g * 128 + ch * 8 + 4);
                const f32x4 ba = *(const f32x4*)(p.ln_b + g * 128 + ch * 8), bb = *(const f32x4*)(p.ln_b + g * 128 + ch * 8 + 4);
                u32x4 o;
                o.x = pk2((bflo(w.x) - mean) * rstd * ga[0] + ba[0], (bfhi(w.x) - mean) * rstd * ga[1] + ba[1]);
                o.y = pk2((bflo(w.y) - mean) * rstd * ga[2] + ba[2], (bfhi(w.y) - mean) * rstd * ga[3] + ba[3]);
                o.z = pk2((bflo(w.z) - mean) * rstd * gb[0] + bb[0], (bfhi(w.z) - mean) * rstd * gb[1] + bb[1]);
                o.w = pk2((bflo(w.w) - mean) * rstd * gb[2] + bb[2], (bfhi(w.w) - mean) * rstd * gb[3] + bb[3]);
                *(LAS u32x4*)(vt + off_b(row, ch)) = o;
            }
            const size_t orow = (m0 + 16 * wave + ic) * 512 + g * 128 + 4 * g4;
            u32x2 uv[8];
#pragma unroll
            for (int et = 0; et < 8; ++et) uv[et] = *(const u32x2*)(p.UB + orow + 16 * et);
            const float bs = p.b_sp[g * 128 + 16 * wave + ic];
            const int nks = ((16 * wave + 15) >> 5) + 1;
            bf16x8 wb[4];
#pragma unroll
            for (int ks = 0; ks < 4; ++ks) wb[ks] = *(const bf16x8*)(p.WSB + ((size_t)g * 128 + 16 * wave + ic) * 128 + 32 * ks + 8 * g4);
            __syncthreads();
            f32x4 acc[8];
#pragma unroll
            for (int et = 0; et < 8; ++et) acc[et] = (f32x4){0.f, 0.f, 0.f, 0.f};
#pragma unroll
            for (int ks = 0; ks < 4; ++ks) {
                if (ks < nks) {
                    bf16x4 ta[8][2];
#pragma unroll
                    for (int et = 0; et < 8; ++et) {
                        const unsigned r0 = 32 * ks + 8 * g4 + q4, ch = 2 * et + (p4 >> 1);
                        ta[et][0] = tr16(vt + off_b(r0, ch) + 8 * (p4 & 1)); ta[et][1] = tr16(vt + off_b(r0 + 4, ch) + 8 * (p4 & 1));
                    }
#pragma unroll
                    for (int et = 0; et < 8; ++et) acc[et] = __builtin_amdgcn_mfma_f32_16x16x32_bf16(cat4(ta[et][0], ta[et][1]), wb[ks], acc[et], 0, 0, 0);
                }
            }
#pragma unroll
            for (int et = 0; et < 8; ++et) {
                u32x2 w;
                w.x = pk2(bflo(uv[et].x) * (acc[et][0] + bs), bfhi(uv[et].x) * (acc[et][1] + bs));
                w.y = pk2(bflo(uv[et].y) * (acc[et][2] + bs), bfhi(uv[et].y) * (acc[et][3] + bs));
                *(u32x2*)(p.US + orow + 16 * et) = w;
            }
            __syncthreads();
        }
    }
}

__device__ __forceinline__ void split2(float a, float b, unsigned& h, unsigned& l) {
    const unsigned ha = f2bf(a), hb = f2bf(b);
    h = ha | (hb << 16); l = pk2(a - __uint_as_float(ha << 16), b - __uint_as_float(hb << 16));
}
__device__ __forceinline__ void split_bf16(const f32x4 a, const f32x4 b, bf16x8& hi, bf16x8& lo) {
    unsigned h0, h1, h2, h3, l0, l1, l2, l3;
    split2(a.x, a.y, h0, l0); split2(a.z, a.w, h1, l1); split2(b.x, b.y, h2, l2); split2(b.z, b.w, h3, l3);
    const u32x4 h = {h0, h1, h2, h3}, l = {l0, l1, l2, l3};
    hi = __builtin_bit_cast(bf16x8, h); lo = __builtin_bit_cast(bf16x8, l);
}
template <int STRIP> __device__ __forceinline__ void ph_router_t(const P& p, LAS unsigned char* lds, const int wv) {
    const int tid = opaque_tid(wv), lane = tid & 63, wave = __builtin_amdgcn_readfirstlane(tid >> 6);
    LAS float* LG = (LAS float*)lds;
    LAS float* SS = (LAS float*)(lds + 26624);
    LAS unsigned* cnt = (LAS unsigned*)(lds + 26624 + 512);
    const int g = lane >> 4, ic = lane & 15;
    const float* X1 = p.out;
    bf16x8 bh[4][3], bl[4][3];
#pragma unroll
    for (int ks = 0; ks < 4; ++ks) {
        const int k0 = 128 * wave + 32 * ks + 8 * g;
#pragma unroll
        for (int nt = 0; nt < 3; ++nt) {
            const int col = 16 * nt + ic; const int cc = col < 36 ? col : 0;
            f32x4 a = *(const f32x4*)(p.WrT + (size_t)cc * 1024 + k0), b = *(const f32x4*)(p.WrT + (size_t)cc * 1024 + k0 + 4);
            if (col >= 36) { a = (f32x4){0.f, 0.f, 0.f, 0.f}; b = a; }
            split_bf16(a, b, bh[ks][nt], bl[ks][nt]);
        }
        if (ks & 1) asm volatile("" ::: "memory");
    }
    for (int c = blockIdx.x; c < M / 128; c += gridDim.x) {
        for (int i = tid; i < 128 * 52 + 128 + 32; i += NTHR) ((LAS float*)lds)[i] = 0.f;
        __syncthreads();
        f32x4 xa[4], xb[4], na[4], nb[4];
#define RT_LOAD(XA_, XB_, rt_) do { const float* xr = X1 + (size_t)(c * 128 + 16 * (rt_) + ic) * D + 128 * wave + 8 * g; \
            _Pragma("unroll") for (int ks = 0; ks < 4; ++ks) { XA_[ks] = *(const f32x4*)(xr + 32 * ks); XB_[ks] = *(const f32x4*)(xr + 32 * ks + 4); } } while (0)
        RT_LOAD(na, nb, 0);
#pragma unroll 1
        for (int rt = 0; rt < 8; ++rt) {
#pragma unroll
            for (int ks = 0; ks < 4; ++ks) { xa[ks] = na[ks]; xb[ks] = nb[ks]; }
            if (rt < 7) RT_LOAD(na, nb, rt + 1);
            __builtin_amdgcn_sched_barrier(0);
            f32x4 acc[3];
#pragma unroll
            for (int nt = 0; nt < 3; ++nt) acc[nt] = (f32x4){0.f, 0.f, 0.f, 0.f};
            float ssq = 0.f;
            bf16_t* hr = p.H2B + (size_t)(c * 128 + 16 * rt + ic) * D + 128 * wave + 8 * g;
#pragma unroll
            for (int ks = 0; ks < 4; ++ks) {
                ssq += (xa[ks].x * xa[ks].x + xa[ks].y * xa[ks].y) + (xa[ks].z * xa[ks].z + xa[ks].w * xa[ks].w) + (xb[ks].x * xb[ks].x + xb[ks].y * xb[ks].y) + (xb[ks].z * xb[ks].z + xb[ks].w * xb[ks].w);
                const f32x4 ga = *(const f32x4*)(p.n2g + 128 * wave + 32 * ks + 8 * g), gb = *(const f32x4*)(p.n2g + 128 * wave + 32 * ks + 8 * g + 4);
                bf16x8 ah, al;
                split_bf16(xa[ks] * ga, xb[ks] * gb, ah, al);
                *(bf16x8*)(hr + 32 * ks) = ah;
                if (STRIP != 1) {
#pragma unroll
                for (int nt = 0; nt < 3; ++nt) {
                    acc[nt] = __builtin_amdgcn_mfma_f32_16x16x32_bf16(ah, bh[ks][nt], acc[nt], 0, 0, 0);
                    acc[nt] = __builtin_amdgcn_mfma_f32_16x16x32_bf16(al, bh[ks][nt], acc[nt], 0, 0, 0);
                    acc[nt] = __builtin_amdgcn_mfma_f32_16x16x32_bf16(ah, bl[ks][nt], acc[nt], 0, 0, 0);
                }
                }
            }
            ssq += __shfl_xor(ssq, 16); ssq += __shfl_xor(ssq, 32);
            LAS float* PT = (LAS float*)(lds + 32768) + ((rt & 1) * 8 + wave) * (16 * 52);
            if (STRIP == 0) {
#pragma unroll
            for (int nt = 0; nt < 3; ++nt)
#pragma unroll
                for (int r = 0; r < 4; ++r) PT[(4 * g + r) * 52 + 16 * nt + ic] = acc[nt][r];
            if (g == 0) PT[ic * 52 + 48] = ssq;
            }
            LDS_WAIT(); __builtin_amdgcn_s_barrier();
            if (STRIP == 0) {
            for (int e = tid; e < 16 * 52; e += NTHR) {
                const LAS float* q = (const LAS float*)(lds + 32768) + (rt & 1) * 8 * (16 * 52) + e;
                float s = 0.f;
#pragma unroll
                for (int w = 0; w < 8; ++w) s += q[w * (16 * 52)];
                LG[16 * rt * 52 + e] = s;
            }
            }
        }
#undef RT_LOAD
        __syncthreads();
        if (tid < 128) {
            const int m = c * 128 + tid;
            const LAS float* lg = LG + tid * 52;
            const float rinv = 1.0f / sqrtf(lg[48] * (1.f / D) + EPS);
            float gl[4];
#pragma unroll
            for (int i = 0; i < 4; ++i) gl[i] = rinv * lg[i] + p.rg_b[i];
            int gi = 0; float gm = gl[0];
#pragma unroll
            for (int i = 1; i < 4; ++i) if (gl[i] > gm) { gm = gl[i]; gi = i; }
            float gs = 0.f;
#pragma unroll
            for (int i = 0; i < 4; ++i) gs += __expf(gl[i] - gm);
            const float gwt = 1.f / gs;
            float el[8];
#pragma unroll
            for (int j = 0; j < 8; ++j) el[j] = rinv * lg[4 + gi * 8 + j] + p.re_b[gi * 8 + j];
            int i1 = 0; float m1 = el[0];
#pragma unroll
            for (int j = 1; j < 8; ++j) if (el[j] > m1) { m1 = el[j]; i1 = j; }
            int i2 = 0; float m2 = -INFINITY;
#pragma unroll
            for (int j = 0; j < 8; ++j) if (j != i1 && el[j] > m2) { m2 = el[j]; i2 = j; }
            const float e2r = __expf(m2 - m1), e1 = 1.f / (1.f + e2r), e2 = e2r * e1;
            const int ea = gi * 8 + i1, eb = gi * 8 + i2;
            p.EID[2 * m] = ea; p.EID[2 * m + 1] = eb;
            p.EW[2 * m] = gwt * e1; p.EW[2 * m + 1] = gwt * e2;
            p.RINV2[m] = rinv;
            __hip_atomic_fetch_add(cnt + ea, 1u, __ATOMIC_RELAXED, __HIP_MEMORY_SCOPE_WORKGROUP);
            __hip_atomic_fetch_add(cnt + eb, 1u, __ATOMIC_RELAXED, __HIP_MEMORY_SCOPE_WORKGROUP);
        }
        __syncthreads();
        if (tid < 32) p.BLKCNT[c * 32 + tid] = (int)cnt[tid];
        __syncthreads();
    }
}

__device__ __forceinline__ void ph_router(const P& p, LAS unsigned char* lds, const int wv) { ph_router_t<0>(p, lds, wv); }

__device__ __forceinline__ void ph_scan(const P& p, LAS unsigned char* lds, const int wv) {}
__device__ __forceinline__ void ph_scatter(const P& p, LAS unsigned char* lds, const int wv) {
    const int tid = opaque_tid(wv);
    LAS int* s = (LAS int*)lds;
    LAS int* se = s + 2048;
    const int e = tid & 31, part = tid >> 5;
    int loc[16]; int sum = 0;
#pragma unroll
    for (int i = 0; i < 16; ++i) { loc[i] = p.BLKCNT[(part * 16 + i) * 32 + e]; sum += loc[i]; }
    s[128 + part * 32 + e] = sum;
    __syncthreads();
    if (tid < 32) { int t = 0; for (int k = 0; k < 16; ++k) { const int v = s[128 + k * 32 + tid]; s[128 + k * 32 + tid] = t; t += v; } s[tid] = t; }
    __syncthreads();
    if (tid == 0) { int off = 0; for (int k = 0; k < 32; ++k) { s[32 + k] = off; off += (s[k] + 255) >> 8; } s[64] = off; }
    __syncthreads();
    if (blockIdx.x == 0) {
        const int ntiles = s[64];
        if (tid < 32) { p.MOEI[tid] = s[32 + tid] * 256; p.MOEI[32 + tid] = s[32 + tid]; }
        if (tid == 0) { p.MOEI[64] = ntiles; p.MOEI[65] = ntiles * 2; p.MOEI[66] = ntiles * 4; }
        for (int rt = tid; rt < ntiles; rt += NTHR) {
            int ex = 0;
            for (int k = 0; k < 32; ++k) { const int tb = s[32 + k], nt = (s[k] + 255) >> 8; if (rt >= tb && rt < tb + nt) ex = k; }
            p.GU[4 * rt + 0] = rt; p.GU[4 * rt + 1] = ex * 2; p.GU[4 * rt + 2] = rt; p.GU[4 * rt + 3] = ex * 2 + 1;
#pragma unroll
            for (int j = 0; j < 4; ++j) { p.DN[8 * rt + 2 * j] = rt; p.DN[8 * rt + 2 * j + 1] = ex * 4 + j; }
        }
        for (int k = 0; k < 32; ++k) {
            const int lo = s[32 + k] * 256 + s[k], hi = (s[32 + k] + ((s[k] + 255) >> 8)) * 256;
            for (int i = lo + tid; i < hi; i += NTHR) p.PTOK[i] = -1;
        }
    }
    for (int c = blockIdx.x; c < M / 128; c += gridDim.x) {
        if (part == (c >> 4)) {
            int run = s[32 + e] * 256 + s[128 + part * 32 + e];
#pragma unroll
            for (int i = 0; i < 16; ++i) run += (i < (c & 15)) ? loc[i] : 0;
            s[1024 + e] = run;
        }
        int ex = 0;
        if (tid < 256) { ex = p.EID[c * 256 + tid]; se[tid] = ex; }
        __syncthreads();
        if (tid < 256) {
            int rank = 0;
            for (int t = 0; t < tid; ++t) rank += (se[t] == ex) ? 1 : 0;
            p.PTOK[s[1024 + ex] + rank] = c * 256 + tid;
        }
        __syncthreads();
    }
}

template <bool DRY> __device__ __forceinline__ void ph_final(const P& p, const int wv) {
    const int tid = opaque_tid(wv), lane = tid & 63, wave = tid >> 6;
    const int gw = blockIdx.x * NWAVES + wave, NGW = gridDim.x * NWAVES;
    for (int m4 = gw; m4 < M / 4; m4 += NGW) {
        f32x4 v[4][4]; float s[4];
#pragma unroll
        for (int rr = 0; rr < 4; ++rr) {
            const int m = 4 * m4 + rr;
            const f32x4* xr = (const f32x4*)(p.out + (size_t)m * D) + lane;
            const u32x2* y0 = (const u32x2*)(p.YS + (size_t)m * D) + lane; const u32x2* y1 = (const u32x2*)(p.YS + ((size_t)M + m) * D) + lane;
            s[rr] = 0.f;
#pragma unroll
            for (int j = 0; j < 4; ++j) {
                v[rr][j] = xr[64 * j]; const u32x2 a = y0[64 * j], b = y1[64 * j];
                v[rr][j].x += bflo(a.x) + bflo(b.x); v[rr][j].y += bfhi(a.x) + bfhi(b.x); v[rr][j].z += bflo(a.y) + bflo(b.y); v[rr][j].w += bfhi(a.y) + bfhi(b.y);
                s[rr] += (v[rr][j].x * v[rr][j].x + v[rr][j].y * v[rr][j].y) + (v[rr][j].z * v[rr][j].z + v[rr][j].w * v[rr][j].w);
            }
        }
#pragma unroll
        for (int rr = 0; rr < 4; ++rr) {
            const float rinv = 1.0f / sqrtf(wave_sum(s[rr]) * (1.f / D) + EPS);
            f32x4* xr = (f32x4*)((DRY ? (float*)p.GBB : p.out) + (size_t)(4 * m4 + rr) * D) + lane;
#pragma unroll
            for (int j = 0; j < 4; ++j) { const f32x4 g = ((const f32x4*)p.fg)[lane + 64 * j]; xr[64 * j] = v[rr][j] * rinv * g; }
        }
    }
}

#ifndef GEMM_SP2
#define GEMM_SP2 true
#endif
__device__ __forceinline__ void ph_gemm_in(const P& p, LAS unsigned char* lds, const int wv) {
    pg8::Gemm g{p.HB, p.WinT, M, NIN, 1024}; pg8::StaticOrder S; S.init(M, NIN, gridDim.x, (int)blockIdx.x);
    EpiIn E{p.QL, p.QI, p.KI, p.UB, p.VB, p.GAB, p.GBB, p.CKVR, p.WI};
    pg8::gemm_phase<EpiIn, pg8::StaticOrder, true, GEMM_SP2>(lds, g, S, E, wv);
    {
        const int G = gridDim.x, nwg = (M / 256) * (NIN / 256), nextra = nwg % G;
        const int c = blockIdx.x, nshort = nextra == 0 ? G : G - nextra;
        if (nextra == 0 || c >= nextra) {
            const int tid = opaque_tid(wv), lane = tid & 63, wave = __builtin_amdgcn_readfirstlane(tid >> 6);
            __syncthreads();
            prep_gateup(p, lds, (nextra == 0 ? c : c - nextra) * NWAVES + wave, nshort * NWAVES, wave, lane);
        }
    }
}
__device__ __forceinline__ void ph_gemm_yb(const P& p, LAS unsigned char* lds, const int wv) {
    pg8::Gemm g{p.US, p.WpbT, M, 1024, 512}; pg8::StaticOrder S; S.init(M, 1024, gridDim.x, (int)blockIdx.x);
    EpiMB E{p.GBB, p.MB};
    pg8::gemm_phase<EpiMB, pg8::StaticOrder, true, GEMM_SP2>(lds, g, S, E, wv);
}
__device__ __forceinline__ void ph_gemm_ya(const P& p, LAS unsigned char* lds, const int wv) {
    pg8::Gemm g{p.OL, p.WovT, M, 1024, 1024}; pg8::StaticOrder S; S.init(M, 1024, gridDim.x, (int)blockIdx.x);
    EpiMG E{p.GAB, p.MB, p.MG};
    pg8::gemm_phase<EpiMG, pg8::StaticOrder, true, GEMM_SP2>(lds, g, S, E, wv);
}
__device__ __forceinline__ void ph_gemm_out(const P& p, LAS unsigned char* lds, const int wv) {
    pg8::Gemm g{p.MG, p.WoutT, M, 1024, 1024}; pg8::StaticOrder S; S.init(M, 1024, gridDim.x, (int)blockIdx.x);
    EpiX1 E{p.x, p.out};
    pg8::gemm_phase<EpiX1, pg8::StaticOrder, true, GEMM_SP2>(lds, g, S, E, wv);
}
__device__ __forceinline__ void ph_gemm_gu(const P& p, LAS unsigned char* lds, const int wv) {
    table_prefetch(lds, p.GU, p.MOEI + 65, (int)gridDim.x, (int)blockIdx.x, opaque_tid(wv));
    pg8::Gemm g{p.H2B, p.WguT, NPOS, 32 * 512, 1024}; TableGatherOrder S{p.GU, p.MOEI + 65, p.PTOK, (int)gridDim.x, (int)blockIdx.x, (const LAS int*)(lds + LDS_TAB_OFF)};
    EpiHE E{p.HE, p.PTOK, p.RINV2};
    pg8::gemm_phase<EpiHE, TableGatherOrder, true, true>(lds, g, S, E, wv);
}
__device__ __forceinline__ void ph_gemm_dn(const P& p, LAS unsigned char* lds, const int wv) {
    table_prefetch(lds, p.DN, p.MOEI + 66, (int)gridDim.x, (int)blockIdx.x, opaque_tid(wv));
    pg8::Gemm g{p.HE, p.WdT, NPOS, 32 * 1024, 256}; TableOrder S{p.DN, p.MOEI + 66, (int)gridDim.x, (int)blockIdx.x, (const LAS int*)(lds + LDS_TAB_OFF)};
    EpiDown E{p.PTOK, p.EW, p.YS};
    pg8::gemm_phase<EpiDown, TableOrder, true, GEMM_SP2>(lds, g, S, E, wv);
}
constexpr int NPHASE = 15;
template <int PH> __device__ __forceinline__ void run_phase(const P& p, LAS unsigned char* lds, const int wv) {
    if constexpr (PH == 0) ph_prep(p, lds, wv);
    if constexpr (PH == 1) ph_gemm_in(p, lds, wv);
    if constexpr (PH == 2) ph_ckvnorm(p, wv);
    if constexpr (PH == 3) ph_index7(p, lds, wv);
    if constexpr (PH == 4) ph_attn_t<0>(p, lds, wv);
    if constexpr (PH == 5) ph_gmlp(p, lds, wv);
    if constexpr (PH == 6) ph_gemm_yb(p, lds, wv);
    if constexpr (PH == 7) ph_gemm_ya(p, lds, wv);
    if constexpr (PH == 8) ph_gemm_out(p, lds, wv);
    if constexpr (PH == 9) ph_router(p, lds, wv);
    if constexpr (PH == 10) ph_scan(p, lds, wv);
    if constexpr (PH == 11) ph_scatter(p, lds, wv);
    if constexpr (PH == 12) ph_gemm_gu(p, lds, wv);
    if constexpr (PH == 13) ph_gemm_dn(p, lds, wv);
    if constexpr (PH == 14) ph_final<false>(p, wv);
}
template <int PH> __global__ void __launch_bounds__(NTHR, 2) k_phase(P p) {
    extern __shared__ __attribute__((aligned(16))) unsigned char lds_raw[];
    run_phase<PH>(p, (LAS unsigned char*)lds_raw, __builtin_amdgcn_readfirstlane(threadIdx.x >> 6));
}

constexpr int MISC_OFF = LDS_BYTES - 256;
__global__ void __launch_bounds__(NTHR, 2) k_mega(P p) {
    extern __shared__ __attribute__((aligned(16))) unsigned char lds_raw[];
    LAS unsigned char* lds = (LAS unsigned char*)lds_raw;
    volatile LAS unsigned* MISC = (volatile LAS unsigned*)(lds + MISC_OFF);
    int wv = __builtin_amdgcn_readfirstlane(threadIdx.x >> 6); asm volatile("" : "+s"(wv));
    if (threadIdx.x < 64) MISC[threadIdx.x] = 0u;
    __syncthreads();
    XcdBarrier bar = xcd_barrier_post(p.ctl + CW_BAR, MISC, wv);
    run_phase<0>(p, lds, wv);
#if defined(DUP0)
    __syncthreads(); run_phase<0>(p, lds, wv);
#endif
    xcd_barrier(bar);
    run_phase<1>(p, lds, wv);
#if defined(DUP1)
    __syncthreads(); run_phase<1>(p, lds, wv);
#endif
    xcd_barrier(bar);
    run_phase<2>(p, lds, wv);
#if defined(DUP2)
    run_phase<2>(p, lds, wv);
#endif
#if defined(PRE3)
    ph_index7_t<PRE3>(p, lds, wv); __syncthreads();
#endif
    run_phase<3>(p, lds, wv);
#if defined(DUP3)
    __syncthreads(); run_phase<3>(p, lds, wv);
#endif
    xcd_barrier(bar);
#if defined(PRE4)
    ph_attn_t<PRE4>(p, lds, wv); __syncthreads();
#endif
    run_phase<4>(p, lds, wv);  __syncthreads();
#if defined(DUP4)
    run_phase<4>(p, lds, wv);  __syncthreads();
#endif
    run_phase<5>(p, lds, wv);
#if defined(DUP5)
    __syncthreads(); run_phase<5>(p, lds, wv);
#endif
    xcd_barrier(bar);
    run_phase<6>(p, lds, wv);
    run_phase<7>(p, lds, wv);  xcd_barrier(bar);
    run_phase<8>(p, lds, wv);
#if defined(DUP678)
    __syncthreads(); run_phase<6>(p, lds, wv); run_phase<7>(p, lds, wv); xcd_barrier(bar); run_phase<8>(p, lds, wv);
#endif
    xcd_barrier(bar);
#if defined(PRE9)
    ph_router_t<PRE9>(p, lds, wv); __syncthreads();
#endif
    run_phase<9>(p, lds, wv);
#if defined(DUP9)
    __syncthreads(); run_phase<9>(p, lds, wv);
#endif

    xcd_barrier(bar);
    run_phase<11>(p, lds, wv);
#if defined(DUP11)
    __syncthreads(); run_phase<11>(p, lds, wv);
#endif
    xcd_barrier(bar);
    run_phase<12>(p, lds, wv);
#if defined(DUP12)
    __syncthreads(); run_phase<12>(p, lds, wv);
#endif
    xcd_barrier(bar);
    run_phase<13>(p, lds, wv);
#if defined(DUP13)
    __syncthreads(); run_phase<13>(p, lds, wv);
#endif
    xcd_barrier(bar);
#if defined(XBAR10)
    for (int i = 0; i < 10; ++i) xcd_barrier(bar);
#endif
#if defined(DUP14)
    ph_final<true>(p, wv); __syncthreads();
#endif
    run_phase<14>(p, lds, wv);
}

extern "C" void kernel_launch(void* const* d_in, const int* in_sizes, int n_in, void* d_out, int out_size, void* d_ws, size_t ws_size, hipStream_t stream) {
    static int grid = 0; static bool first = true;
    if (grid == 0) {
        if (n_in != 23 || in_sizes[0] != M * D || out_size != M * D || ws_size < WS_END) { fprintf(stderr, "kernel_launch: unexpected shapes (n_in %d, in0 %d, out %d, ws %zu)\n", n_in, n_in > 0 ? in_sizes[0] : -1, out_size, ws_size); grid = -1; return; }
        int dev = 0, cus = 0;
        if (hipGetDevice(&dev) != hipSuccess || hipDeviceGetAttribute(&cus, hipDeviceAttributeMultiprocessorCount, dev) != hipSuccess) { grid = -1; return; }
        grid = cus;
    }
    if (grid < 0) return;
    unsigned char* ws = (unsigned char*)d_ws;
    (void)hipMemsetAsync(ws + WS_CTL, 0, CTL_ZERO_BYTES, stream);
    P p{};
    const float* const* in = (const float* const*)d_in;
    p.x = in[0]; p.w_in = in[1]; p.kv_g = in[2]; p.w_uk = in[3]; p.w_uv = in[4]; p.rel_bias = in[5]; p.ln_g = in[6]; p.ln_b = in[7]; p.w_sp = in[8]; p.b_sp = in[9];
    p.w_pa = in[10]; p.w_pb = in[11]; p.w_out = in[12]; p.n1g = in[13]; p.n2g = in[14]; p.rg_w = in[15]; p.rg_b = in[16]; p.re_w = in[17]; p.re_b = in[18];
    p.w_gate = in[19]; p.w_up = in[20]; p.w_down = in[21]; p.fg = in[22];
    p.out = (float*)d_out; p.ctl = (unsigned*)(ws + WS_CTL);
    p.WinT = (bf16_t*)(ws + WS_WIN); p.WoutT = (bf16_t*)(ws + WS_WOUT); p.WpbT = (bf16_t*)(ws + WS_WPB); p.WovT = (bf16_t*)(ws + WS_WOV); p.WSB = (bf16_t*)(ws + WS_WSB);
    p.WguT = (bf16_t*)(ws + WS_WGU); p.WdT = (bf16_t*)(ws + WS_WD); p.WrT = (float*)(ws + WS_WRT);
    p.HB = (bf16_t*)(ws + WS_A); p.OL = (bf16_t*)(ws + WS_A); p.H2B = (bf16_t*)(ws + WS_A);
    p.QL = (bf16_t*)(ws + WS_B); p.MB = (bf16_t*)(ws + WS_B); p.H2S = (bf16_t*)(ws + WS_B); p.YS = (bf16_t*)(ws + WS_B);
    p.GAB = (bf16_t*)(ws + WS_GA); p.GBB = (bf16_t*)(ws + WS_GB);
    p.UB = (bf16_t*)(ws + WS_C); p.VB = (bf16_t*)(ws + WS_C + 32 * MiB); p.MG = (bf16_t*)(ws + WS_C); p.HE = (bf16_t*)(ws + WS_C);
    p.QI = (bf16_t*)(ws + WS_DQ); p.US = (bf16_t*)(ws + WS_DQ);
    p.CKVR = (float*)(ws + WS_CKVR); p.CKVB = (bf16_t*)(ws + WS_CKVB); p.KI = (bf16_t*)(ws + WS_KI); p.WI = (float*)(ws + WS_WI); p.SEL = (unsigned short*)(ws + WS_SEL);
    p.EID = (int*)(ws + WS_MOE); p.EW = (float*)(ws + WS_MOE + 262144); p.PTOK = (int*)(ws + WS_MOE + 524288); p.MOEI = (int*)(ws + WS_MOE + 1048576);
    p.GU = (int*)(ws + WS_MOE + 1048576 + 4096); p.BLKCNT = (int*)(ws + WS_MOE + 1048576 + 65536); p.IDXROW = (float*)(ws + WS_A); p.RINV2 = (float*)(ws + WS_MOE + 1048576 + 262144); p.CB = (int*)(ws + WS_MOE + 1048576 + 131072); p.DN = (int*)(ws + WS_MOE + 1048576 + 4096 + 8192);
    if (first) { (void)hipFuncSetAttribute((const void*)k_mega, hipFuncAttributeMaxDynamicSharedMemorySize, LDS_BYTES); first = false; }
    hipLaunchKernelGGL(k_mega, dim3(grid), dim3(NTHR), LDS_BYTES, stream, p);
}
```

```cpp
#include <hip/hip_runtime.h>
#include <cstdio>
#include <cstdint>
__device__ __forceinline__ int opaque_tid(const int wv) { int l; asm volatile("v_mbcnt_lo_u32_b32 %0, -1, 0\n\tv_mbcnt_hi_u32_b32 %0, -1, %0" : "=v"(l)); return (wv << 6) + l; }
#define LAS __attribute__((address_space(3)))
namespace pg8 {
#define PG8_LAS __attribute__((address_space(3)))
typedef unsigned short bf16_t;
typedef short bf16x8 __attribute__((ext_vector_type(8)));
typedef float f32x4 __attribute__((ext_vector_type(4)));
typedef unsigned u32x4 __attribute__((ext_vector_type(4)));
constexpr int BM = 256, BK = 64, HALF = 128, HTB = HALF * BK * 2  , STAGE_BYTES = 8 * HTB, NXCD = 8, WGM = 8;

__host__ __device__ __forceinline__ int lds_byte(int r, int c) { const int st = (r >> 4) * 2 + (c >> 5), rr = r & 15, cc = c & 31, ob = rr * 64 + cc * 2; return st * 1024 + (ob ^ (((ob >> 9) & 1) << 5)); }
__host__ __device__ __forceinline__ void stage_rc(int b, int& R, int& C) { const int st = b / 1024, sb = b % 1024, swz = sb ^ (((sb >> 9) & 1) << 5); R = (st >> 1) * 16 + swz / 64; C = (st & 1) * 32 + (swz % 64) / 2; }
__host__ __device__ __forceinline__ int perm32(int rho) { const int n = rho >> 4, i = rho & 15; return 8 * (i >> 2) + 4 * n + (i & 3); }

struct Unit { int pm, pn; };
struct Gemm { const bf16_t* A; const bf16_t* Bt; int M, N, K; };

struct StaticOrder {
    static constexpr bool GATHER = false;
    int nM, nN, nwg, G, c;
    __host__ __device__ void init(int M, int N, int G_, int c_) { nM = M / BM; nN = N / BM; nwg = nM * nN; G = G_; c = c_; }
    __host__ __device__ bool next(int i, Unit& u) const {
        const long L = (long)i * G + c; if (L >= nwg) return false;
        int wgid = (int)L; { const int q = nwg / NXCD, r = nwg % NXCD, xcd = wgid % NXCD, off = wgid / NXCD; wgid = (xcd < r ? xcd * (q + 1) : r * (q + 1) + (xcd - r) * q) + off; }
        const int nig = WGM * nN, gid = wgid / nig, fm = gid * WGM, gsz = (nM - fm) < WGM ? (nM - fm) : WGM;
        u.pm = fm + ((wgid % nig) % gsz); u.pn = (wgid % nig) / gsz; return true;
    }
    __device__ __forceinline__ int arow(int r) const { return r; }
    __device__ __forceinline__ void a_ready(const Unit&) const {}
    __device__ __forceinline__ void done(const Unit&) const {}
};

__device__ __forceinline__ unsigned cvt_pk_bf16(float lo, float hi) { unsigned r; asm volatile("v_cvt_pk_bf16_f32 %0, %1, %2" : "=v"(r) : "v"(lo), "v"(hi)); return r; }
typedef float f32x2 __attribute__((ext_vector_type(2)));
template <class Epi, class Sched, bool ALIGN_EPI = false, bool SP2 = false>
__device__ __forceinline__ void gemm_phase(PG8_LAS unsigned char* lds, const Gemm g, const Sched& S, const Epi& E, const int wv) {
    const int tid = opaque_tid(wv), wid = __builtin_amdgcn_readfirstlane(tid >> 6), lane = tid & 63, wr = wid >> 2, wc = wid & 3, fr = lane & 15, fq = lane >> 4;
    const int K = g.K, nt = K / BK;
    unsigned voffA[2], voffB[2];
#pragma unroll
    for (int i = 0; i < 2; ++i) { int R, C; stage_rc(tid * 16 + i * 8192, R, C); const int Rb = Epi::PERM ? ((R & ~31) + perm32(R & 31)) : R;
        voffA[i] = (unsigned)(R * K + C) * 2u; voffB[i] = (unsigned)(Rb * K + C) * 2u; }
    static_assert(!Sched::GATHER || SP2, "gathered A rows: SP2 loop only");
    unsigned gcur[2][2], gnxt[2][2]; int gR[2], gC[2];
    if constexpr (Sched::GATHER) {
#pragma unroll
        for (int i = 0; i < 2; ++i) { stage_rc(tid * 16 + i * 8192, gR[i], gC[i]); }
    }
#define PG8_GOFF(dst, u_) do { _Pragma("unroll") for (int h_ = 0; h_ < 2; ++h_) _Pragma("unroll") for (int i_ = 0; i_ < 2; ++i_) \
        dst[h_][i_] = ((unsigned)S.arow((u_).pm * BM + h_ * HALF + gR[i_]) * (unsigned)K + (unsigned)gC[i_]) * 2u; } while (0)
    const size_t kstep = (size_t)(BK * 2);
    const size_t hstep = (size_t)HALF * K * 2;
    const size_t tstep = 2 * hstep;
    const unsigned ldsw = (unsigned)wid * 1024u;
    const int aoff = lds_byte(wr * 64 + fr, fq * 8), boff = lds_byte(wc * 32 + fr, fq * 8);
#define PG8_SA(b, h) (((b) * 2 + (h)) * HTB)
#define PG8_SB(b, h) ((4 + (b) * 2 + (h)) * HTB)
#define PG8_STAGE(bufoff, gbase, voff) do { _Pragma("unroll") for (int _i = 0; _i < 2; ++_i) { unsigned vo_ = (voff)[_i]; asm volatile("" : "+v"(vo_)); \
        __builtin_amdgcn_global_load_lds((const unsigned*)((const char*)(gbase) + vo_), (PG8_LAS unsigned*)(lds + (bufoff) + ldsw + _i * 8192), 16, 0, 0); } } while (0)
#define PG8_LDA(dst, b, h) do { _Pragma("unroll") for (int m = 0; m < 4; ++m) _Pragma("unroll") for (int k = 0; k < 2; ++k) dst[m][k] = *(const PG8_LAS bf16x8*)(lds + PG8_SA(b, h) + aoff + m * 2048 + k * 1024); } while (0)
#define PG8_LDB(dst, b, h) do { _Pragma("unroll") for (int n = 0; n < 2; ++n) _Pragma("unroll") for (int k = 0; k < 2; ++k) dst[n][k] = *(const PG8_LAS bf16x8*)(lds + PG8_SB(b, h) + boff + n * 2048 + k * 1024); } while (0)
#define PG8_MMA(ai, bj, At, Bt) do { __builtin_amdgcn_s_setprio(1); _Pragma("unroll") for (int m = 0; m < 4; ++m) _Pragma("unroll") for (int n = 0; n < 2; ++n) _Pragma("unroll") for (int k = 0; k < 2; ++k) \
        acc[ai][bj][m][n] = __builtin_amdgcn_mfma_f32_16x16x32_bf16(Bt[n][k], At[m][k], acc[ai][bj][m][n], 0, 0, 0); __builtin_amdgcn_s_setprio(0); } while (0)
#define PG8_WAIT_V(n) asm volatile("s_waitcnt vmcnt(" #n ")" ::: "memory")
#define PG8_WAIT_L(n) asm volatile("s_waitcnt lgkmcnt(" #n ")" ::: "memory")
#define PG8_BAR __builtin_amdgcn_s_barrier()
#define PG8_SCHED __builtin_amdgcn_sched_barrier(0)
    Unit cur, nxt; int ui = 0;
    if (!S.next(0, cur)) return;
    f32x4 acc[2][2][4][2];
#pragma unroll
    for (int a = 0; a < 2; ++a)
#pragma unroll
        for (int b = 0; b < 2; ++b)
#pragma unroll
            for (int m = 0; m < 4; ++m)
#pragma unroll
                for (int n = 0; n < 2; ++n) acc[a][b][m][n] = (f32x4){0.f, 0.f, 0.f, 0.f};
    bf16x8 At[4][2], B0[2][2], B1[2][2];
    const char* cA = Sched::GATHER ? (const char*)g.A : (const char*)g.A + (size_t)cur.pm * tstep; const char* cB = (const char*)g.Bt + (size_t)cur.pn * tstep;
    S.a_ready(cur);
    if constexpr (Sched::GATHER) { PG8_GOFF(gcur, cur); }
#define PG8_STAGE_A(bufoff, base_, h_, koff_, GO_) do { if constexpr (Sched::GATHER) { PG8_STAGE(bufoff, (const char*)g.A + (koff_), GO_[h_]); } else { PG8_STAGE(bufoff, (base_) + (h_) * hstep + (koff_), voffA); } } while (0)
    if constexpr (SP2) {
        PG8_STAGE(PG8_SB(0, 0), cB, voffB); PG8_STAGE(PG8_SB(0, 1), cB + hstep, voffB); PG8_STAGE_A(PG8_SA(0, 0), cA, 0, 0, gcur); PG8_STAGE_A(PG8_SA(0, 1), cA, 1, 0, gcur);
        if (wr == 1) PG8_BAR;
        PG8_WAIT_V(2); PG8_BAR;
        PG8_STAGE(PG8_SB(1, 0), cB + kstep, voffB); PG8_STAGE_A(PG8_SA(1, 0), cA, 0, kstep, gcur); PG8_STAGE(PG8_SB(1, 1), cB + hstep + kstep, voffB);
        PG8_WAIT_V(6); PG8_BAR;
    } else {
        PG8_STAGE(PG8_SB(0, 0), cB, voffB); PG8_STAGE(PG8_SA(0, 0), cA, voffA); PG8_STAGE(PG8_SB(0, 1), cB + hstep, voffB); PG8_STAGE(PG8_SA(0, 1), cA + hstep, voffA);
        if (wr == 1) PG8_BAR;
        PG8_WAIT_V(4); PG8_BAR;
        PG8_STAGE(PG8_SB(1, 0), cB + kstep, voffB); PG8_STAGE(PG8_SA(1, 0), cA + kstep, voffA); PG8_STAGE(PG8_SB(1, 1), cB + hstep + kstep, voffB);
        PG8_WAIT_V(6); PG8_BAR;
    }
    for (;;) {
        const bool has_next = S.next(ui + 1, nxt);
        const char* nA = Sched::GATHER ? cA : (has_next ? (const char*)g.A + (size_t)nxt.pm * tstep : cA); const char* nB = has_next ? (const char*)g.Bt + (size_t)nxt.pn * tstep : cB;
        if constexpr (Sched::GATHER) { if (has_next) { PG8_GOFF(gnxt, nxt); } else { _Pragma("unroll") for (int h_ = 0; h_ < 2; ++h_) _Pragma("unroll") for (int i_ = 0; i_ < 2; ++i_) gnxt[h_][i_] = gcur[h_][i_]; } }
        for (int t = 0; t < nt; t += 2) {
            const bool last = (t == nt - 2);
            const char* a1 = cA + (size_t)(t + 1) * kstep;
            const char* a2 = last ? nA : cA + (size_t)(t + 2) * kstep; const char* b2 = last ? nB : cB + (size_t)(t + 2) * kstep;
            const char* a3 = a2 + kstep; const char* b3 = b2 + kstep;
            unsigned g2[2][2];
            if constexpr (Sched::GATHER) { _Pragma("unroll") for (int h_ = 0; h_ < 2; ++h_) _Pragma("unroll") for (int i_ = 0; i_ < 2; ++i_) g2[h_][i_] = last ? gnxt[h_][i_] : gcur[h_][i_]; }
            const size_t k1 = (size_t)(t + 1) * kstep, k2 = last ? (size_t)0 : (size_t)(t + 2) * kstep, k3 = k2 + kstep;
            if (last && has_next) S.a_ready(nxt);
            if constexpr (SP2) {
            PG8_LDB(B0, 0, 0); PG8_LDB(B1, 0, 1); PG8_SCHED; PG8_LDA(At, 0, 0); if constexpr (Sched::GATHER) { PG8_STAGE(PG8_SA(1, 1), (const char*)g.A + k1, gcur[1]); } else { PG8_STAGE(PG8_SA(1, 1), a1 + hstep, voffA); }
            PG8_WAIT_V(8); PG8_WAIT_L(0); PG8_BAR; PG8_MMA(0, 0, At, B0); PG8_MMA(0, 1, At, B1); PG8_BAR; PG8_SCHED;
            PG8_LDA(At, 0, 1); PG8_STAGE(PG8_SB(0, 0), b2, voffB); PG8_STAGE(PG8_SB(0, 1), b2 + hstep, voffB); if constexpr (Sched::GATHER) { PG8_STAGE(PG8_SA(0, 0), (const char*)g.A + k2, g2[0]); } else { PG8_STAGE(PG8_SA(0, 0), a2, voffA); }
            PG8_WAIT_V(8); PG8_WAIT_L(0); PG8_BAR; PG8_MMA(1, 0, At, B0); PG8_MMA(1, 1, At, B1); PG8_BAR; PG8_SCHED;
            PG8_LDB(B0, 1, 0); PG8_LDB(B1, 1, 1); PG8_SCHED; PG8_LDA(At, 1, 0); if constexpr (Sched::GATHER) { PG8_STAGE(PG8_SA(0, 1), (const char*)g.A + k2, g2[1]); } else { PG8_STAGE(PG8_SA(0, 1), a2 + hstep, voffA); }
            PG8_WAIT_V(8); PG8_WAIT_L(0); PG8_BAR; PG8_MMA(0, 0, At, B0); PG8_MMA(0, 1, At, B1); PG8_BAR; PG8_SCHED;
            PG8_LDA(At, 1, 1); PG8_STAGE(PG8_SB(1, 0), b3, voffB); PG8_STAGE(PG8_SB(1, 1), b3 + hstep, voffB); if constexpr (Sched::GATHER) { PG8_STAGE(PG8_SA(1, 0), (const char*)g.A + k3, g2[0]); } else { PG8_STAGE(PG8_SA(1, 0), a3, voffA); }
            PG8_WAIT_V(8); PG8_WAIT_L(0); PG8_BAR; PG8_MMA(1, 0, At, B0); PG8_MMA(1, 1, At, B1); PG8_BAR; PG8_SCHED;
            } else {
            PG8_LDB(B0, 0, 0); PG8_SCHED; PG8_LDA(At, 0, 0); PG8_STAGE(PG8_SA(1, 1), a1 + hstep, voffA);
            PG8_WAIT_L(8); PG8_BAR; PG8_WAIT_L(0); PG8_MMA(0, 0, At, B0); PG8_BAR; PG8_SCHED;
            PG8_LDB(B1, 0, 1); PG8_STAGE(PG8_SB(0, 0), b2, voffB);
            PG8_BAR; PG8_WAIT_L(0); PG8_MMA(0, 1, At, B1); PG8_BAR;
            PG8_LDA(At, 0, 1); PG8_STAGE(PG8_SA(0, 0), a2, voffA);
            PG8_BAR; PG8_WAIT_L(0); PG8_MMA(1, 0, At, B0); PG8_BAR; PG8_SCHED;
            PG8_STAGE(PG8_SB(0, 1), b2 + hstep, voffB);
            PG8_WAIT_V(6); PG8_BAR; PG8_MMA(1, 1, At, B1); PG8_BAR;
            PG8_LDB(B0, 1, 0); PG8_SCHED; PG8_LDA(At, 1, 0); PG8_STAGE(PG8_SA(0, 1), a2 + hstep, voffA);
            PG8_WAIT_L(8); PG8_BAR; PG8_WAIT_L(0); PG8_MMA(0, 0, At, B0); PG8_BAR; PG8_SCHED;
            PG8_LDB(B1, 1, 1); PG8_STAGE(PG8_SB(1, 0), b3, voffB);
            PG8_BAR; PG8_WAIT_L(0); PG8_MMA(0, 1, At, B1); PG8_BAR;
            PG8_LDA(At, 1, 1); PG8_STAGE(PG8_SA(1, 0), a3, voffA);
            PG8_BAR; PG8_WAIT_L(0); PG8_MMA(1, 0, At, B0); PG8_BAR; PG8_SCHED;
            PG8_STAGE(PG8_SB(1, 1), b3 + hstep, voffB);
            PG8_WAIT_V(6); PG8_BAR; PG8_MMA(1, 1, At, B1); PG8_BAR;
            }
        }
        if constexpr (ALIGN_EPI) { if (wr == 0) PG8_BAR; }
        if constexpr (!Epi::AFTER_DRAIN) {
            const int tz = opaque_tid(wv), wz = __builtin_amdgcn_readfirstlane(tz >> 6), lz = tz & 63;
            E(acc, cur, wz >> 2, wz & 3, lz & 15, lz >> 4); S.done(cur); }
        if (!has_next) break;
#pragma unroll
        for (int a = 0; a < 2; ++a)
#pragma unroll
            for (int b = 0; b < 2; ++b)
#pragma unroll
                for (int m = 0; m < 4; ++m)
#pragma unroll
                    for (int n = 0; n < 2; ++n) acc[a][b][m][n] = (f32x4){0.f, 0.f, 0.f, 0.f};
        cur = nxt; cA = nA; cB = nB; ++ui;
        if constexpr (Sched::GATHER) { _Pragma("unroll") for (int h_ = 0; h_ < 2; ++h_) _Pragma("unroll") for (int i_ = 0; i_ < 2; ++i_) gcur[h_][i_] = gnxt[h_][i_]; }
        if constexpr (ALIGN_EPI) { if (wr == 1) PG8_BAR; }
    }
    PG8_WAIT_V(0);
    if constexpr (!ALIGN_EPI) { if (wr == 0) PG8_BAR; }
    PG8_BAR;
    if constexpr (Epi::AFTER_DRAIN) { E.fused(acc, cur, wr, wc, fr, fq, lds, wid, lane); S.done(cur); }
#undef PG8_SA
#undef PG8_SB
#undef PG8_STAGE
#undef PG8_STAGE_A
#undef PG8_GOFF
#undef PG8_LDA
#undef PG8_LDB
#undef PG8_MMA
#undef PG8_WAIT_V
#undef PG8_WAIT_L
#undef PG8_BAR
#undef PG8_SCHED
}
}
#define XB_TMO      128
#define XB_XCNT(j)  (256  + 64 * (j))
#define XB_XSUB(j)  (1280 + 64 * (j))
#define XB_XGEN(j)  (2304 + 64 * (j))
#define XB_TOP      3328
#define XB_TOPGEN   3392
#define XCD_BAR_WORDS 3456
#define XB_SPIN_CAP (1u << 18)

__device__ __forceinline__ unsigned xb_ld(unsigned* p)              { return __hip_atomic_load(p, __ATOMIC_RELAXED, __HIP_MEMORY_SCOPE_AGENT); }
__device__ __forceinline__ unsigned xb_add(unsigned* p, unsigned v) { return __hip_atomic_fetch_add(p, v, __ATOMIC_RELAXED, __HIP_MEMORY_SCOPE_AGENT); }
__device__ __forceinline__ unsigned xb_xcc_id() { return (unsigned)__builtin_amdgcn_s_getreg((3 << 11) | 20) & 0xFu; }
#define XB_SPIN(cond, bar) do { unsigned _sp = 0; while (cond) { __builtin_amdgcn_s_sleep(1); \
    if ((++_sp & 255u) == 0u) { if (xb_ld(&(bar)[XB_TMO])) break; if (_sp > XB_SPIN_CAP) { atomicAdd(&(bar)[XB_TMO], 1u); break; } } } } while (0)

struct XcdBarrier {
    unsigned* bar; unsigned x; int wv;
    volatile LAS unsigned* st;
};

__device__ __forceinline__ XcdBarrier xcd_barrier_post(unsigned* bar, volatile LAS unsigned* st, int wv) {
    XcdBarrier b; b.bar = bar; b.x = xb_xcc_id(); b.st = st; b.wv = wv;
    if (opaque_tid(wv) == 0) (void)xb_add(&bar[XB_XCNT(b.x)], 1u);
    return b;
}
__device__ __forceinline__ void xcd_barrier_complete(unsigned* bar, unsigned x, unsigned& nloc, unsigned& nx) {
    const unsigned G = gridDim.x * gridDim.y * gridDim.z;
    unsigned sum, cnt, mine, sp = 0u;
    for (;;) {
        sum = 0u; cnt = 0u; mine = 0u;
#pragma unroll
        for (unsigned j = 0; j < 16; ++j) { const unsigned c = xb_ld(&bar[XB_XCNT(j)]); sum += c; cnt += (c > 0u) ? 1u : 0u; mine = (j == x) ? c : mine; }
        if (sum == G) break;
        __builtin_amdgcn_s_sleep(1);
        if ((++sp & 255u) == 0u) { if (xb_ld(&bar[XB_TMO])) break; if (sp > XB_SPIN_CAP) { atomicAdd(&bar[XB_TMO], 1u); break; } }
    }
    nloc = mine > 0u ? mine : 1u; nx = cnt > 0u ? cnt : 1u;
}

__device__ __forceinline__ void xcd_barrier(const XcdBarrier& b) {
    asm volatile("s_waitcnt vmcnt(0)" ::: "memory");
    __syncthreads();
    if (opaque_tid(b.wv) == 0) {
        unsigned* bar = b.bar;
        __builtin_amdgcn_s_waitcnt(0);
        unsigned nloc = b.st[0], nx = b.st[1];
        if (nloc == 0u) { xcd_barrier_complete(bar, b.x, nloc, nx); b.st[0] = nloc; b.st[1] = nx; }
        const unsigned old = xb_add(&bar[XB_XSUB(b.x)], 1u);
        const unsigned gen = old / nloc;
        if (old + 1u == (gen + 1u) * nloc) {
            __builtin_amdgcn_fence(__ATOMIC_RELEASE, "agent");
            asm volatile("s_waitcnt vmcnt(0)" ::: "memory");
            const unsigned og = xb_add(&bar[XB_TOP], 1u);
            const unsigned tg = og / nx;
            if (og + 1u == (tg + 1u) * nx) xb_add(&bar[XB_TOPGEN], 1u);
            else XB_SPIN(xb_ld(&bar[XB_TOPGEN]) == tg, bar);
            __builtin_amdgcn_fence(__ATOMIC_ACQUIRE, "agent");
            xb_add(&bar[XB_XGEN(b.x)], 1u);
            asm volatile("s_waitcnt vmcnt(0)" ::: "memory");
        } else {
            XB_SPIN(xb_ld(&bar[XB_XGEN(b.x)]) == gen, bar);
            __builtin_amdgcn_fence(__ATOMIC_ACQUIRE, "agent");
            asm volatile("s_waitcnt vmcnt(0)" ::: "memory");
        }
    }
    __syncthreads();
}

typedef unsigned short bf16_t;
typedef short bf16x8 __attribute__((ext_vector_type(8)));
typedef short bf16x4 __attribute__((ext_vector_type(4)));
typedef float f32x4 __attribute__((ext_vector_type(4)));
typedef float f32x2 __attribute__((ext_vector_type(2)));
typedef float f32x16 __attribute__((ext_vector_type(16)));
typedef unsigned u32x4 __attribute__((ext_vector_type(4)));
typedef unsigned u32x2 __attribute__((ext_vector_type(2)));

constexpr int NB = 8, T = 4096, D = 1024, M = NB * T;
constexpr int INC = 4296;
constexpr int NIN = 19 * 256;
constexpr float EPS = 1e-6f;
constexpr int NPOS = 73728;
constexpr int NWAVES = 8, NTHR = 512;
constexpr int LDS_BYTES = 163840;

constexpr size_t MiB = 1u << 20;
constexpr size_t WS_CTL = 0, CTL_ZERO_BYTES = 65536;
constexpr size_t WS_WIN = 1 * MiB, WS_WOUT = 11 * MiB, WS_WPB = 13 * MiB, WS_WOV = 14 * MiB, WS_WSB = 16 * MiB, WS_WRT = 16 * MiB + 262144, WS_WGU = 17 * MiB, WS_WD = 49 * MiB;
constexpr size_t WS_A = 65 * MiB;
constexpr size_t WS_B = 129 * MiB;
constexpr size_t WS_GA = 193 * MiB, WS_GB = 257 * MiB;
constexpr size_t WS_C = 321 * MiB;
constexpr size_t WS_DQ = 385 * MiB;
constexpr size_t WS_CKVR = 417 * MiB, WS_CKVB = 433 * MiB, WS_KI = 441 * MiB, WS_WI = 445 * MiB, WS_SEL = 446 * MiB;
constexpr size_t WS_MOE = 462 * MiB;
constexpr size_t WS_END = 464 * MiB;

constexpr int CW_BAR = 4096;
constexpr int CW_CNT = 8192, CW_CUR = 8256;

struct P {
    const float *x, *w_in, *kv_g, *w_uk, *w_uv, *rel_bias, *ln_g, *ln_b, *w_sp, *b_sp, *w_pa, *w_pb, *w_out, *n1g, *n2g, *rg_w, *rg_b, *re_w, *re_b, *w_gate, *w_up, *w_down, *fg;
    float* out;
    unsigned* ctl;
    bf16_t *WinT, *WoutT, *WpbT, *WovT, *WSB, *WguT, *WdT;
    float* WrT;
    bf16_t *HB, *QL, *QI, *CKVB, *KI, *UB, *VB, *GAB, *GBB, *OL, *US, *MB, *MG, *H2B, *H2S, *HE, *YS;
    float *CKVR, *WI, *EW, *IDXROW, *RINV2;
    unsigned short* SEL;
    int *EID, *PTOK, *MOEI, *GU, *DN, *BLKCNT, *CB;
};

__device__ __forceinline__ unsigned f2bf(float f) { unsigned u = __builtin_bit_cast(unsigned, f); return (u + 0x7fffu + ((u >> 16) & 1u)) >> 16; }
__device__ __forceinline__ unsigned pk2(float lo, float hi) { return f2bf(lo) | (f2bf(hi) << 16); }
__device__ __forceinline__ float bflo(unsigned w) { return __builtin_bit_cast(float, w << 16); }
__device__ __forceinline__ float bfhi(unsigned w) { return __builtin_bit_cast(float, w & 0xffff0000u); }
__device__ __forceinline__ float bf2f(unsigned short b) { return __builtin_bit_cast(float, (unsigned)b << 16); }
__device__ __forceinline__ float wave_sum(float v) {
#pragma unroll
    for (int o = 1; o < 64; o <<= 1) v += __shfl_xor(v, o);
    return v;
}
#define LDS_WAIT() asm volatile("s_waitcnt lgkmcnt(0)" ::: "memory")
__device__ __forceinline__ float sigm(float x) { return __builtin_amdgcn_rcpf(1.f + __builtin_amdgcn_exp2f(-1.4426950409f * x)); }
__device__ __forceinline__ float gelu_t(float x) { const float x2 = x * x; return x * __builtin_amdgcn_rcpf(1.f + __builtin_amdgcn_exp2f(x * (-2.3022082f - 0.1029432f * x2))); }
__device__ __forceinline__ unsigned off_b(unsigned row, unsigned ch) { return 256u * row + 16u * (ch ^ (((row & 3) << 2) | ((row >> 2) & 3))); }
__device__ __forceinline__ bf16x4 tr_read(unsigned lds_addr) { bf16x4 r; asm volatile("ds_read_b64_tr_b16 %0, %1\n\ts_waitcnt lgkmcnt(0)" : "=&v"(r) : "v"(lds_addr) : "memory"); return r; }
__device__ __forceinline__ bf16x8 cat4(bf16x4 a, bf16x4 b) { bf16x8 r; r[0] = a[0]; r[1] = a[1]; r[2] = a[2]; r[3] = a[3]; r[4] = b[0]; r[5] = b[1]; r[6] = b[2]; r[7] = b[3]; return r; }
__device__ __forceinline__ unsigned lds_addr_of(LAS unsigned char* p) { return (unsigned)(unsigned long long)p; }

__device__ __forceinline__ void st8bf(bf16_t* p, const pg8::f32x4& a, const pg8::f32x4& b) {
    u32x4 w; w.x = pg8::cvt_pk_bf16(a[0], a[1]); w.y = pg8::cvt_pk_bf16(a[2], a[3]); w.z = pg8::cvt_pk_bf16(b[0], b[1]); w.w = pg8::cvt_pk_bf16(b[2], b[3]);
    *(u32x4*)p = w;
}
__device__ __forceinline__ void ld8bf(const bf16_t* p, pg8::f32x4& a, pg8::f32x4& b) {
    const u32x4 w = *(const u32x4*)p;
    a[0] = bflo(w.x); a[1] = bfhi(w.x); a[2] = bflo(w.y); a[3] = bfhi(w.y); b[0] = bflo(w.z); b[1] = bfhi(w.z); b[2] = bflo(w.w); b[3] = bfhi(w.w);
}

__device__ __forceinline__ void st8f8(unsigned char* p, const pg8::f32x4& a, const pg8::f32x4& b) {
    float v[8];
#pragma unroll
    for (int j = 0; j < 4; ++j) { v[j] = fminf(fmaxf(a[j], -440.f), 440.f); v[4 + j] = fminf(fmaxf(b[j], -440.f), 440.f); }
    u32x2 h;
    h.x = (unsigned)__builtin_amdgcn_cvt_pk_fp8_f32(v[0], v[1], 0, false); h.x = (unsigned)__builtin_amdgcn_cvt_pk_fp8_f32(v[2], v[3], (int)h.x, true);
    h.y = (unsigned)__builtin_amdgcn_cvt_pk_fp8_f32(v[4], v[5], 0, false); h.y = (unsigned)__builtin_amdgcn_cvt_pk_fp8_f32(v[6], v[7], (int)h.y, true);
    *(u32x2*)p = h;
}
__device__ __forceinline__ void st8q(unsigned char* p, const pg8::f32x4& a, const pg8::f32x4& b, const float scale, const int looff) {
    float v[8];
#pragma unroll
    for (int j = 0; j < 4; ++j) { v[j] = fminf(fmaxf(a[j] * scale, -440.f), 440.f); v[4 + j] = fminf(fmaxf(b[j] * scale, -440.f), 440.f); }
    u32x2 h, l;
    h.x = (unsigned)__builtin_amdgcn_cvt_pk_fp8_f32(v[0], v[1], 0, false); h.x = (unsigned)__builtin_amdgcn_cvt_pk_fp8_f32(v[2], v[3], (int)h.x, true);
    h.y = (unsigned)__builtin_amdgcn_cvt_pk_fp8_f32(v[4], v[5], 0, false); h.y = (unsigned)__builtin_amdgcn_cvt_pk_fp8_f32(v[6], v[7], (int)h.y, true);
    const f32x2 b0 = __builtin_amdgcn_cvt_pk_f32_fp8((int)h.x, false), b1 = __builtin_amdgcn_cvt_pk_f32_fp8((int)h.x, true);
    const f32x2 b2 = __builtin_amdgcn_cvt_pk_f32_fp8((int)h.y, false), b3 = __builtin_amdgcn_cvt_pk_f32_fp8((int)h.y, true);
    l.x = (unsigned)__builtin_amdgcn_cvt_pk_fp8_f32(v[0] - b0[0], v[1] - b0[1], 0, false); l.x = (unsigned)__builtin_amdgcn_cvt_pk_fp8_f32(v[2] - b1[0], v[3] - b1[1], (int)l.x, true);
    l.y = (unsigned)__builtin_amdgcn_cvt_pk_fp8_f32(v[4] - b2[0], v[5] - b2[1], 0, false); l.y = (unsigned)__builtin_amdgcn_cvt_pk_fp8_f32(v[6] - b3[0], v[7] - b3[1], (int)l.y, true);
    *(u32x2*)p = h; *(u32x2*)(p + looff) = l;
}
struct EpiIn {
    static constexpr bool PERM = true, AFTER_DRAIN = false;
    bf16_t *QL, *QI, *KI, *UB, *VB, *GAB, *GBB; float *CKVR, *WI;
    __device__ __forceinline__ void operator()(const pg8::f32x4 (&acc)[2][2][4][2], const pg8::Unit& u, int wr, int wc, int fr, int fq) const {
        const int row0 = u.pm * 256 + wr * 64 + fr, pn = u.pn, c8 = wc * 32 + 8 * fq;
        int mode; bf16_t* dst; int ld;
        if (pn < 4)       { mode = 0; dst = QL + pn * 256; ld = 1024; }
        else if (pn < 6)  { mode = 0; dst = QI + (pn - 4) * 256; ld = 512; }
        else if (pn == 6) { mode = 3; dst = KI; ld = 64; }
        else if (pn < 9)  { mode = 1; dst = UB + (pn - 7) * 256; ld = 512; }
        else if (pn < 11) { mode = 1; dst = VB + (pn - 9) * 256; ld = 512; }
        else if (pn < 15) { mode = 2; dst = GAB + (pn - 11) * 256; ld = 1024; }
        else              { mode = 2; dst = GBB + (pn - 15) * 256; ld = 1024; }
#pragma unroll
        for (int ai = 0; ai < 2; ++ai)
#pragma unroll
            for (int m = 0; m < 4; ++m) {
                const size_t row = (size_t)(row0 + ai * 128 + m * 16);
#pragma unroll
                for (int bj = 0; bj < 2; ++bj) {
                    pg8::f32x4 v0 = acc[ai][bj][m][0], v1 = acc[ai][bj][m][1];
                    if (mode == 3) {
                        if (bj == 0) { float* c = CKVR + row * 128 + c8; *(pg8::f32x4*)c = v0; *(pg8::f32x4*)(c + 4) = v1; }
                        else if (c8 < 64) st8f8((unsigned char*)KI + row * 64 + c8, v0, v1);
                        else if (c8 == 64) { float* c = WI + row * 8; *(pg8::f32x4*)c = v0 * 0.044194174f; *(pg8::f32x4*)(c + 4) = v1 * 0.044194174f; }
                    } else {
                        if (mode == 1) {
#pragma unroll
                            for (int j = 0; j < 4; ++j) { v0[j] = gelu_t(v0[j]); v1[j] = gelu_t(v1[j]); }
                        } else if (mode == 2) {
#pragma unroll
                            for (int j = 0; j < 4; ++j) { v0[j] = sigm(v0[j]); v1[j] = sigm(v1[j]); }
                        }
                        if (pn < 4) st8q((unsigned char*)QL + row * 2048 + (pn * 2 + bj) * 256 + c8, v0, v1, 16.f, 128);
                        else if (pn < 6) { const int col = (pn - 4) * 256 + bj * 128 + c8; st8q((unsigned char*)QI + row * 1024 + (col >> 6) * 128 + (col & 63), v0, v1, 1.f, 64); }
                        else st8bf(dst + row * ld + bj * 128 + c8, v0, v1);
                    }
                }
            }
    }
};

struct EpiMB {
    static constexpr bool PERM = true, AFTER_DRAIN = false;
    const bf16_t* G; bf16_t* O;
    __device__ __forceinline__ void operator()(const pg8::f32x4 (&acc)[2][2][4][2], const pg8::Unit& u, int wr, int wc, int fr, int fq) const {
        const int row0 = u.pm * 256 + wr * 64 + fr, col0 = u.pn * 256 + wc * 32 + 8 * fq;
#pragma unroll
        for (int ai = 0; ai < 2; ++ai)
#pragma unroll
            for (int m = 0; m < 4; ++m)
#pragma unroll
                for (int bj = 0; bj < 2; ++bj) {
                    const size_t o = (size_t)(row0 + ai * 128 + m * 16) * 1024 + col0 + bj * 128;
                    pg8::f32x4 g0, g1; ld8bf(G + o, g0, g1);
                    st8bf(O + o, acc[ai][bj][m][0] * g0, acc[ai][bj][m][1] * g1);
                }
    }
};
struct EpiMG {
    static constexpr bool PERM = true, AFTER_DRAIN = false;
    const bf16_t *G, *MBp; bf16_t* O;
    __device__ __forceinline__ void operator()(const pg8::f32x4 (&acc)[2][2][4][2], const pg8::Unit& u, int wr, int wc, int fr, int fq) const {
        const int row0 = u.pm * 256 + wr * 64 + fr, col0 = u.pn * 256 + wc * 32 + 8 * fq;
#pragma unroll
        for (int ai = 0; ai < 2; ++ai)
#pragma unroll
            for (int m = 0; m < 4; ++m)
#pragma unroll
                for (int bj = 0; bj < 2; ++bj) {
                    const size_t o = (size_t)(row0 + ai * 128 + m * 16) * 1024 + col0 + bj * 128;
                    pg8::f32x4 g0, g1, b0, b1; ld8bf(G + o, g0, g1); ld8bf(MBp + o, b0, b1);
                    st8bf(O + o, acc[ai][bj][m][0] * g0 + b0, acc[ai][bj][m][1] * g1 + b1);
                }
    }
};
struct EpiX1 {
    static constexpr bool PERM = true, AFTER_DRAIN = false;
    const float* X; float* O;
    __device__ __forceinline__ void operator()(const pg8::f32x4 (&acc)[2][2][4][2], const pg8::Unit& u, int wr, int wc, int fr, int fq) const {
        const int row0 = u.pm * 256 + wr * 64 + fr, col0 = u.pn * 256 + wc * 32 + 8 * fq;
#pragma unroll
        for (int ai = 0; ai < 2; ++ai)
#pragma unroll
            for (int m = 0; m < 4; ++m)
#pragma unroll
                for (int bj = 0; bj < 2; ++bj) {
                    const size_t o = (size_t)(row0 + ai * 128 + m * 16) * 1024 + col0 + bj * 128;
                    const pg8::f32x4 x0 = *(const pg8::f32x4*)(X + o), x1 = *(const pg8::f32x4*)(X + o + 4);
                    *(pg8::f32x4*)(O + o) = x0 + acc[ai][bj][m][0]; *(pg8::f32x4*)(O + o + 4) = x1 + acc[ai][bj][m][1];
                }
    }
};
struct EpiHE {
    static constexpr bool PERM = true, AFTER_DRAIN = false;
    bf16_t* HE; const int* PTOK; const float* RINV2;
    __device__ __forceinline__ void operator()(const pg8::f32x4 (&acc)[2][2][4][2], const pg8::Unit& u, int wr, int wc, int fr, int fq) const {
        const int row0 = u.pm * 256 + wr * 64 + fr, col0 = (u.pn & 1) * 128 + wc * 32 + 8 * fq;
#pragma unroll
        for (int ai = 0; ai < 2; ++ai) {
            int ts[4]; float ri[4];
#pragma unroll
            for (int m = 0; m < 4; ++m) ts[m] = PTOK[row0 + ai * 128 + m * 16];
#pragma unroll
            for (int m = 0; m < 4; ++m) ri[m] = RINV2[ts[m] < 0 ? 0 : (ts[m] >> 1)];
#pragma unroll
            for (int m = 0; m < 4; ++m) {
                const float r = ts[m] < 0 ? 0.f : ri[m];
                pg8::f32x4 h0, h1;
#pragma unroll
                for (int j = 0; j < 4; ++j) {
                    const float g0 = r * acc[ai][0][m][0][j], g1 = r * acc[ai][0][m][1][j];
                    h0[j] = g0 * sigm(g0) * (r * acc[ai][1][m][0][j]); h1[j] = g1 * sigm(g1) * (r * acc[ai][1][m][1][j]);
                }
                st8bf(HE + (size_t)(row0 + ai * 128 + m * 16) * 256 + col0, h0, h1);
            }
        }
    }
};
struct EpiDown {
    static constexpr bool PERM = true, AFTER_DRAIN = false;
    const int* PTOK; const float* EW; bf16_t* YS;
    __device__ __forceinline__ void operator()(const pg8::f32x4 (&acc)[2][2][4][2], const pg8::Unit& u, int wr, int wc, int fr, int fq) const {
        const int row0 = u.pm * 256 + wr * 64 + fr, col0 = (u.pn & 3) * 256 + wc * 32 + 8 * fq;
#pragma unroll
        for (int ai = 0; ai < 2; ++ai) {
            int ts[4]; float w[4];
#pragma unroll
            for (int m = 0; m < 4; ++m) ts[m] = PTOK[row0 + ai * 128 + m * 16];
#pragma unroll
            for (int m = 0; m < 4; ++m) w[m] = EW[ts[m] < 0 ? 0 : ts[m]];
#pragma unroll
            for (int m = 0; m < 4; ++m) {
                const int t = ts[m];
                if (t >= 0) {
                    bf16_t* d = YS + ((size_t)(t & 1) * M + (size_t)(t >> 1)) * 1024 + col0;
#pragma unroll
                    for (int bj = 0; bj < 2; ++bj) st8bf(d + bj * 128, acc[ai][bj][m][0] * w[m], acc[ai][bj][m][1] * w[m]);
                }
            }
        }
    }
};
constexpr int LDS_TAB_OFF = 155648;
__device__ __forceinline__ void table_prefetch(LAS unsigned char* lds, const int* tab, const int* nunits, int G, int c, int tid) {
    LAS int* lt = (LAS int*)(lds + LDS_TAB_OFF);
    if (tid < 16) { const int idx = (tid >> 1) * G + c; const int n = __builtin_nontemporal_load(nunits); lt[tid] = idx < n ? tab[2 * idx + (tid & 1)] : -1; }
    __syncthreads();
}
struct TableOrder {
    static constexpr bool GATHER = false;
    const int* tab; const int* nunits; int G, c; const LAS int* lt;
    __device__ __forceinline__ int arow(int r) const { return r; }
    __device__ __forceinline__ bool next(int i, pg8::Unit& u) const {
        if (i < 8) { const int a = lt[2 * i]; if (a < 0) return false; u.pm = a; u.pn = lt[2 * i + 1]; return true; }
        const int idx = i * G + c; const int n = __builtin_nontemporal_load(nunits);
        if (idx >= n) return false;
        u.pm = tab[2 * idx]; u.pn = tab[2 * idx + 1]; return true;
    }
    __device__ __forceinline__ void a_ready(const pg8::Unit&) const {}
    __device__ __forceinline__ void done(const pg8::Unit&) const {}
};

struct TableGatherOrder {
    static constexpr bool GATHER = true;
    const int* tab; const int* nunits; const int* ptok; int G, c; const LAS int* lt;
    __device__ __forceinline__ bool next(int i, pg8::Unit& u) const {
        if (i < 8) { const int a = lt[2 * i]; if (a < 0) return false; u.pm = a; u.pn = lt[2 * i + 1]; return true; }
        const int idx = i * G + c; const int n = __builtin_nontemporal_load(nunits);
        if (idx >= n) return false;
        u.pm = tab[2 * idx]; u.pn = tab[2 * idx + 1]; return true;
    }
    __device__ __forceinline__ int arow(int r) const { const int ts = ptok[r]; return ts < 0 ? 0 : (ts >> 1); }
    __device__ __forceinline__ void a_ready(const pg8::Unit&) const {}
    __device__ __forceinline__ void done(const pg8::Unit&) const {}
};

__device__ __forceinline__ void tr_item(const float* src, int ld, int K, int NC, bf16_t* dst, LAS float* scr, int item, int lane) {
    const int nblk = NC / 32, kb = item / nblk, nb = item % nblk, k0 = 64 * kb, n0 = 32 * nb;
    f32x4 tv[8];
    const int tr = lane >> 3, tc = (lane & 7) * 4;
    if ((((size_t)src) & 15) == 0 && (ld & 3) == 0) {
#pragma unroll
        for (int i = 0; i < 8; ++i) tv[i] = *(const f32x4*)(src + (size_t)(k0 + 8 * i + tr) * ld + n0 + tc);
    } else {
#pragma unroll
        for (int i = 0; i < 8; ++i) { const float* q = src + (size_t)(k0 + 8 * i + tr) * ld + n0 + tc; tv[i] = (f32x4){q[0], q[1], q[2], q[3]}; }
    }
#pragma unroll
    for (int i = 0; i < 8; ++i) { LAS float* d = scr + (8 * i + tr) * 33 + tc; d[0] = tv[i].x; d[1] = tv[i].y; d[2] = tv[i].z; d[3] = tv[i].w; }
    LDS_WAIT();
    const int c = lane & 7;
#pragma unroll
    for (int j = 0; j < 4; ++j) { const int n = (lane >> 3) + 8 * j; const LAS float* s = scr + (8 * c) * 33 + n;
        u32x4 o; o.x = pk2(s[0 * 33], s[1 * 33]); o.y = pk2(s[2 * 33], s[3 * 33]); o.z = pk2(s[4 * 33], s[5 * 33]); o.w = pk2(s[6 * 33], s[7 * 33]);
        *(u32x4*)(dst + (size_t)(n0 + n) * K + k0 + 8 * c) = o; }
    LDS_WAIT();
}

__device__ __forceinline__ void prep_gateup(const P& p, LAS unsigned char* lds, int w_idx, int nw, int wave, int lane) {
    LAS float* scr = (LAS float*)(lds + wave * 16384);
    for (int it = w_idx; it < 8192; it += nw) {
        const int sub = it & 63, q = it >> 6, gu = q & 1, j = (q >> 1) & 1, e = q >> 2;
        const float* src = (gu ? p.w_up : p.w_gate) + (size_t)e * 262144 + 128 * j;
        tr_item(src, 256, 1024, 128, p.WguT + ((size_t)e * 512 + j * 256 + gu * 128) * 1024, scr, sub, lane);
    }
}

__device__ __forceinline__ void ph_prep(const P& p, LAS unsigned char* lds, const int wv) {
    const int tid = opaque_tid(wv), lane = tid & 63, wave = __builtin_amdgcn_readfirstlane(tid >> 6);
    LAS float* scr = (LAS float*)(lds + wave * 16384);
    const int gw = blockIdx.x * NWAVES + wave, NGW = gridDim.x * NWAVES;
    const int gt = blockIdx.x * NTHR + tid, NGT = gridDim.x * NTHR;
    for (int i = gt; i < 64 * 1024; i += NGT) { const int j = i >> 10, k = i & 1023; p.WinT[(size_t)(1728 + j) * 1024 + k] = j < 8 ? (bf16_t)f2bf(p.w_in[(size_t)k * INC + 1216 + j]) : (bf16_t)0; }
    for (int i = gt; i < 4 * 128 * 128; i += NGT) { const int jj = i & 127, ii = (i >> 7) & 127; p.WSB[i] = jj <= ii ? (bf16_t)f2bf(p.w_sp[i]) : (bf16_t)0; }
    for (int i = gt; i < 36 * 1024; i += NGT) { const int c = i >> 10, k = i & 1023; p.WrT[i] = c < 4 ? p.rg_w[k * 4 + c] : p.re_w[k * 32 + (c - 4)]; }
    for (int idx = gw; idx < 16992; idx += NGW) {
        if (idx < 1024) {
            const int it = idx;
            const int h = it >> 7, kt = (it >> 2) & 31, rt = it & 3, i = lane & 31, hf = lane >> 5;
            const f32x4* ap = (const f32x4*)(p.w_in + (size_t)(kt * 32 + i) * INC + h * 64 + 32 * hf);
            const f32x4* bp = (const f32x4*)(p.w_uk + (size_t)((rt * 32 + i) * 8 + h) * 64 + 32 * hf);
            f32x4 av[8], bv[8];
#pragma unroll
            for (int j = 0; j < 8; ++j) { av[j] = ap[j]; bv[j] = bp[j]; }
            f32x16 acc;
#pragma unroll
            for (int j = 0; j < 16; ++j) acc[j] = 0.f;
#pragma unroll
            for (int j = 0; j < 8; ++j)
#pragma unroll
                for (int e = 0; e < 4; ++e) acc = __builtin_amdgcn_mfma_f32_32x32x2f32(av[j][e], bv[j][e], acc, 0, 0, 0);
#pragma unroll
            for (int g4 = 0; g4 < 4; ++g4) {
                constexpr float QS = 0.125f * 1.4426950409f;
                u32x2 w; w.x = pk2(QS * acc[4 * g4], QS * acc[4 * g4 + 1]); w.y = pk2(QS * acc[4 * g4 + 2], QS * acc[4 * g4 + 3]);
                *(u32x2*)(p.WinT + (size_t)(h * 128 + rt * 32 + i) * 1024 + kt * 32 + 8 * g4 + 4 * hf) = w;
            }
        } else if (idx < 2048) {
            const int it = idx - 1024;
            const int h = it >> 7, nt = (it >> 2) & 31, rt = it & 3, i = lane & 31, hf = lane >> 5;
            const f32x4* ap = (const f32x4*)(p.w_uv + (size_t)((rt * 32 + i) * 8 + h) * 64 + 32 * hf);
            const float* bp = p.w_pa + (size_t)(h * 64 + 32 * hf) * 1024 + nt * 32 + i;
            f32x4 av[8]; float bv[32];
#pragma unroll
            for (int j = 0; j < 8; ++j) av[j] = ap[j];
#pragma unroll
            for (int j = 0; j < 32; ++j) bv[j] = bp[(size_t)j * 1024];
            f32x16 acc;
#pragma unroll
            for (int j = 0; j < 16; ++j) acc[j] = 0.f;
#pragma unroll
            for (int j = 0; j < 8; ++j)
#pragma unroll
                for (int e = 0; e < 4; ++e) acc = __builtin_amdgcn_mfma_f32_32x32x2f32(av[j][e], bv[4 * j + e], acc, 0, 0, 0);
#pragma unroll
            for (int g4 = 0; g4 < 4; ++g4) {
                u32x2 w; w.x = pk2(acc[4 * g4], acc[4 * g4 + 1]); w.y = pk2(acc[4 * g4 + 2], acc[4 * g4 + 3]);
                *(u32x2*)(p.WovT + (size_t)(nt * 32 + i) * 1024 + h * 128 + rt * 32 + 8 * g4 + 4 * hf) = w;
            }
        } else if (idx < 3936) {
            int it = idx - 2048;
            const int c0s[7] = {640, 512, 1152, 1224, 1736, 2248, 3272};
            const int ncs[7] = {512, 128, 64, 512, 512, 1024, 1024};
            const int r0s[7] = {1024, 1536, 1664, 1792, 2304, 2816, 3840};
            int c0 = 0, nc = 32, r0 = 0; bool got = false;
#pragma unroll
            for (int sg = 0; sg < 7; ++sg) { const int nit = 16 * (ncs[sg] / 32); if (!got) { if (it < nit) { c0 = c0s[sg]; nc = ncs[sg]; r0 = r0s[sg]; got = true; } else it -= nit; } }
            tr_item(p.w_in + c0, INC, 1024, nc, p.WinT + (size_t)r0 * 1024, scr, it, lane);
        } else if (idx < 4448) {
            tr_item(p.w_out, 1024, 1024, 1024, p.WoutT, scr, idx - 3936, lane);
        } else if (idx < 4704) {
            tr_item(p.w_pb, 1024, 512, 1024, p.WpbT, scr, idx - 4448, lane);
        } else if (idx < 8800) {
            const int it = idx - 4704, sub = it & 127, e = it >> 7;
            tr_item(p.w_down + (size_t)e * 262144, 1024, 256, 1024, p.WdT + (size_t)e * 262144, scr, sub, lane);
        } else {
            const int m4 = idx - 8800;
            f32x4 v[4][4]; float ss[4];
#pragma unroll
            for (int r = 0; r < 4; ++r) { const f32x4* xr = (const f32x4*)(p.x + (size_t)(4 * m4 + r) * D) + lane;
#pragma unroll
                for (int j = 0; j < 4; ++j) v[r][j] = xr[64 * j]; }
#pragma unroll
            for (int r = 0; r < 4; ++r) { ss[r] = 0.f;
#pragma unroll
                for (int j = 0; j < 4; ++j) ss[r] += (v[r][j].x * v[r][j].x + v[r][j].y * v[r][j].y) + (v[r][j].z * v[r][j].z + v[r][j].w * v[r][j].w); }
#pragma unroll
            for (int o = 1; o < 64; o <<= 1) {
#pragma unroll
                for (int r = 0; r < 4; ++r) ss[r] += __shfl_xor(ss[r], o);
            }
#pragma unroll
            for (int r = 0; r < 4; ++r) {
                const float rinv = 1.0f / sqrtf(ss[r] * (1.f / D) + EPS);
                unsigned long long* o8 = (unsigned long long*)(p.HB + (size_t)(4 * m4 + r) * D) + lane;
#pragma unroll
                for (int j = 0; j < 4; ++j) { const f32x4 g = ((const f32x4*)p.n1g)[lane + 64 * j]; const f32x4 o = v[r][j] * rinv * g;
                    o8[64 * j] = (unsigned long long)pk2(o.x, o.y) | ((unsigned long long)pk2(o.z, o.w) << 32); }
            }
        }
    }
}

__device__ __forceinline__ void ph_ckvnorm(const P& p, const int wv) {
    const int tid = opaque_tid(wv), lane = tid & 63, wave = tid >> 6;
    const int gw = blockIdx.x * NWAVES + wave, NGW = gridDim.x * NWAVES;
    const float g0 = p.kv_g[2 * lane], g1 = p.kv_g[2 * lane + 1];
    for (int m4 = gw; m4 < M / 4; m4 += NGW) {
        float2 v[4]; float ss[4];
#pragma unroll
        for (int r = 0; r < 4; ++r) v[r] = ((const float2*)(p.CKVR + (size_t)(4 * m4 + r) * 128))[lane];
#pragma unroll
        for (int r = 0; r < 4; ++r) ss[r] = v[r].x * v[r].x + v[r].y * v[r].y;
#pragma unroll
        for (int o = 1; o < 64; o <<= 1) {
#pragma unroll
            for (int r = 0; r < 4; ++r) ss[r] += __shfl_xor(ss[r], o);
        }
#pragma unroll
        for (int r = 0; r < 4; ++r) { const float rinv = 1.0f / sqrtf(ss[r] * (1.f / 128.f) + EPS);
            const float c0 = fminf(fmaxf(v[r].x * rinv * g0, -440.f), 440.f), c1 = fminf(fmaxf(v[r].y * rinv * g1, -440.f), 440.f);
            ((unsigned short*)((unsigned char*)p.CKVB + (size_t)(4 * m4 + r) * 128))[lane] = (unsigned short)__builtin_amdgcn_cvt_pk_fp8_f32(c0, c1, 0, false); }
    }
}

typedef int i32x8 __attribute__((ext_vector_type(8)));
#ifndef ATT_SKEW
#define ATT_SKEW 10
#endif
__device__ __forceinline__ bf16x4 tr16(const LAS unsigned char* a) { return __builtin_amdgcn_ds_read_tr16_b64_v4i16((LAS bf16x4*)a); }
__device__ __forceinline__ unsigned att_f(unsigned row) { return ((row >> 1) & 3u) | ((((row >> 2) ^ (row >> 4)) & 1u) << 2); }
__device__ __forceinline__ float vmax3(float a, float b, float c) { float r; asm("v_max3_f32 %0, %1, %2, %3" : "=v"(r) : "v"(a), "v"(b), "v"(c)); return r; }
__device__ __forceinline__ float vmax2(float a, float b) { float r; asm("v_max_f32 %0, %1, %2" : "=v"(r) : "v"(a), "v"(b)); return r; }
__device__ __forceinline__ float ror8(float x) { return __int_as_float(__builtin_amdgcn_update_dpp(0, __float_as_int(x), 0x128, 0xf, 0xf, false)); }
__device__ __forceinline__ float xmax16(float x) {
    auto a = __builtin_amdgcn_permlane16_swap(__float_as_uint(x), __float_as_uint(x), false, false);
    const float y = vmax2(__uint_as_float(a[0]), __uint_as_float(a[1]));
    auto b = __builtin_amdgcn_permlane32_swap(__float_as_uint(y), __float_as_uint(y), false, false);
    return vmax2(__uint_as_float(b[0]), __uint_as_float(b[1]));
}
template <int STRIP>
__device__ __forceinline__ void ph_attn_t(const P& p, LAS unsigned char* lds, const int wv) {
    const int tid = opaque_tid(wv), lane = tid & 63, wave = __builtin_amdgcn_readfirstlane(tid >> 6);
    LAS unsigned char* buf = lds + wave * 16384;
    LAS unsigned char* selL = lds + 131072 + wave * 3072;
    LAS unsigned char* selT = selL + 1024;
    LAS unsigned char* bias = lds + 155648;
    for (int i = tid; i < 1024; i += NTHR) {
        const int d = i >> 3; int bk = d;
        if (d >= 16) { const float nf = (float)d; bk = 16 + (int)(logf(nf / 16.f) / 2.0794415f * 16.f); if (bk > 31) bk = 31; }
        ((LAS float*)bias)[i] = 1.4426950409f * p.rel_bias[bk * 8 + (i & 7)];
    }
    __syncthreads();
    const int g = lane >> 4, hcol = lane & 15, r8 = lane >> 3, pc = lane & 7;
    const int G = gridDim.x, bx = blockIdx.x, vcu = (G % 8 == 0) ? (bx % 8) * (G / 8) + bx / 8 : bx;
    const unsigned so0 = 16u * ((unsigned)pc ^ att_f((unsigned)r8)), so1 = so0 ^ 64u;
    unsigned qka[2][2], tra[8];
#pragma unroll
    for (int tau = 0; tau < 2; ++tau)
#pragma unroll
        for (int r = 0; r < 2; ++r) { const unsigned row = hcol + 16 * tau; qka[tau][r] = (unsigned)(size_t)buf + row * 128u + 16u * ((2u * g + r) ^ att_f(row)); }
    {   const unsigned q = (lane & 15) >> 1, row = q < 4 ? 4 * g + q : 16 + 4 * g + (q - 4);
#pragma unroll
        for (int rt = 0; rt < 8; ++rt) tra[rt] = (unsigned)(size_t)buf + row * 128u + 16u * ((unsigned)rt ^ att_f(row)) + 8u * (lane & 1);
    }
    const unsigned biasl = (unsigned)(size_t)bias + 4u * (hcol & 7);
    const int hs = hcol >> 3;
    const unsigned qoff = (unsigned)((hcol & 7) * 256 + 32 * g + (hcol >> 3) * 128), svoff = 8u * (unsigned)lane;
    const long ones8 = 0x3838383838383838L;
#define ATT_Q_LOAD(mm) do { const unsigned char* qb = (const unsigned char*)p.QL + (size_t)(mm) * 2048;            \
        asm volatile("global_load_dwordx4 %0, %1, %2" : "=v"(qn0) : "v"(qoff), "s"(qb)); asm volatile("global_load_dwordx4 %0, %1, %2 offset:16" : "=v"(qn1) : "v"(qoff), "s"(qb)); } while (0)
#define ATT_SV_LOAD(mm) do { const unsigned short* sb = p.SEL + (size_t)(mm) * 256; asm volatile("global_load_dwordx2 %0, %1, %2" : "=v"(sv) : "v"(svoff), "s"(sb)); } while (0)
#define ATT_DMA_CHUNK(img_, selt_, c_) do { const u32x4 k4 = *(const LAS u32x4*)((selt_) + 128 * (c_) + 16 * r8);        \
        __builtin_amdgcn_global_load_lds((const unsigned*)(ckb + (k4.x + so0)), (LAS unsigned*)(img_), 16, 0, 0); \
        __builtin_amdgcn_global_load_lds((const unsigned*)(ckb + (k4.y + so0)), (LAS unsigned*)((img_) + 1024), 16, 0, 0); \
        __builtin_amdgcn_global_load_lds((const unsigned*)(ckb + (k4.z + so1)), (LAS unsigned*)((img_) + 2048), 16, 0, 0); \
        __builtin_amdgcn_global_load_lds((const unsigned*)(ckb + (k4.w + so1)), (LAS unsigned*)((img_) + 3072), 16, 0, 0); } while (0)
#define ATT_SEL_WRITE(par_, sv_, tq_) do { \
        const int k0 = (int)((sv_).x & 0xffffu), k1 = (int)((sv_).x >> 16), k2 = (int)((sv_).y & 0xffffu), k3 = (int)((sv_).y >> 16); \
        const int d0 = min((tq_) - k0, 127), d1 = min((tq_) - k1, 127), d2 = min((tq_) - k2, 127), d3 = min((tq_) - k3, 127); \
        u32x2 dw; dw.x = (unsigned)(d0 * 32) | ((unsigned)(d1 * 32) << 16); dw.y = (unsigned)(d2 * 32) | ((unsigned)(d3 * 32) << 16); \
        *(LAS u32x2*)(selL + (par_) * 512 + lane * 8) = dw; \
        LAS unsigned* tq = (LAS unsigned*)(selT + (par_) * 1024) + (lane >> 3) * 32 + (4 * (lane & 1)) * 4 + ((lane & 7) >> 1); \
        tq[0] = (unsigned)k0 * 128u; tq[4] = (unsigned)k1 * 128u; tq[8] = (unsigned)k2 * 128u; tq[12] = (unsigned)k3 * 128u; } while (0)
    for (int qc = vcu; qc < M / 128; qc += G) {
        const int m0 = qc * 128 + wave * 16;
        const size_t mb = (size_t)(m0 >> 12) * T;
        const unsigned char* ckb = (const unsigned char*)p.CKVB + mb * 128;
        u32x2 sv; u32x4 qn0, qn1; i32x8 qh;
        ATT_SV_LOAD(m0);
        ATT_Q_LOAD(m0);
        asm volatile("s_waitcnt vmcnt(0)" ::: "memory");
        asm volatile("" : "+v"(qn0), "+v"(qn1), "+v"(sv));
        ATT_SEL_WRITE(0, sv, m0 & (T - 1));
        LDS_WAIT();
        ATT_DMA_CHUNK(buf, selT, 0);
        ATT_DMA_CHUNK(buf + 4096, selT, 1);
        __builtin_amdgcn_sched_barrier(0);
        ATT_SV_LOAD(m0 + 1);
        f32x4 o[8], ls; float mref = -1e30f;
#pragma unroll
        for (int rt = 0; rt < 8; ++rt) o[rt] = (f32x4){0.f, 0.f, 0.f, 0.f};
        ls = (f32x4){0.f, 0.f, 0.f, 0.f};
#define ATT_BODY(cp_) do { \
            const int m = m0 + qi, t = m & (T - 1); \
            const LAS unsigned char* selc = selL + (qi & 1) * 512; \
            if ((cp_) == 0) qh = (i32x8){(int)qn0.x, (int)qn0.y, (int)qn0.z, (int)qn0.w, (int)qn1.x, (int)qn1.y, (int)qn1.z, (int)qn1.w}; \
            if (STRIP >= 2) { } \
            else if ((cp_) < 3) { ATT_DMA_CHUNK(buf + (((cp_) + 1) & 1) * 8192, selT + (qi & 1) * 1024, 2 * (cp_) + 2); ATT_DMA_CHUNK(buf + (((cp_) + 1) & 1) * 8192 + 4096, selT + (qi & 1) * 1024, 2 * (cp_) + 3); \
                __builtin_amdgcn_sched_barrier(0); \
                if ((cp_) == 0) { if (qi == 0) asm volatile("s_waitcnt vmcnt(8)" ::: "memory"); else asm volatile("s_waitcnt vmcnt(16)" ::: "memory"); } \
                else if ((cp_) == 1) { if (qi < 15) asm volatile("s_waitcnt vmcnt(10)" ::: "memory"); else asm volatile("s_waitcnt vmcnt(8)" ::: "memory"); } \
                else { if (qi < 14) asm volatile("s_waitcnt vmcnt(9)" ::: "memory"); else asm volatile("s_waitcnt vmcnt(8)" ::: "memory"); } } \
            else if (qi < 15) { ATT_DMA_CHUNK(buf, selT + ((qi + 1) & 1) * 1024, 0); ATT_DMA_CHUNK(buf + 4096, selT + ((qi + 1) & 1) * 1024, 1); \
                __builtin_amdgcn_sched_barrier(0); asm volatile("s_waitcnt vmcnt(8)" ::: "memory"); } \
            else { __builtin_amdgcn_sched_barrier(0); asm volatile("s_waitcnt vmcnt(0)" ::: "memory"); } \
            __builtin_amdgcn_sched_barrier(0); \
              \
              \
            if ((cp_) == 2 && qi < 15) asm volatile("" : "+v"(qn0), "+v"(qn1)); \
            if ((cp_) == 3 && qi < 14) asm volatile("" : "+v"(sv)); \
            if (STRIP == 1) break; \
              \
              \
            i32x8 af[2][2]; u32x2 kk[2]; \
            _Pragma("unroll") for (int tau = 0; tau < 2; ++tau) kk[tau] = *(const LAS u32x2*)(selc + 2 * (64 * (cp_) + 32 * hs + 16 * tau + 4 * g)); \
            _Pragma("unroll") for (int h = 0; h < 2; ++h) _Pragma("unroll") for (int tau = 0; tau < 2; ++tau) { \
                const u32x4 a0 = *(const LAS u32x4*)(size_t)(qka[tau][0] + ((cp_) & 1) * 8192 + h * 4096), a1 = *(const LAS u32x4*)(size_t)(qka[tau][1] + ((cp_) & 1) * 8192 + h * 4096); \
                af[h][tau] = (i32x8){(int)a0.x, (int)a0.y, (int)a0.z, (int)a0.w, (int)a1.x, (int)a1.y, (int)a1.z, (int)a1.w}; } \
              \
            long ta[2][8]; \
            _Pragma("unroll") for (int rt = 0; rt < 8; ++rt) { \
                if (((cp_) & 1) == 0) { asm volatile("ds_read_b64_tr_b8 %0, %1" : "=v"(ta[0][rt]) : "v"(tra[rt])); asm volatile("ds_read_b64_tr_b8 %0, %1 offset:4096" : "=v"(ta[1][rt]) : "v"(tra[rt])); } \
                else { asm volatile("ds_read_b64_tr_b8 %0, %1 offset:8192" : "=v"(ta[0][rt]) : "v"(tra[rt])); asm volatile("ds_read_b64_tr_b8 %0, %1 offset:12288" : "=v"(ta[1][rt]) : "v"(tra[rt])); } \
            } \
            float bv[2][4]; \
            _Pragma("unroll") for (int tau = 0; tau < 2; ++tau) { \
                bv[tau][0] = *(const LAS float*)(size_t)(biasl + (kk[tau].x & 0xffffu)); bv[tau][1] = *(const LAS float*)(size_t)(biasl + (kk[tau].x >> 16)); \
                bv[tau][2] = *(const LAS float*)(size_t)(biasl + (kk[tau].y & 0xffffu)); bv[tau][3] = *(const LAS float*)(size_t)(biasl + (kk[tau].y >> 16)); } \
            if ((cp_) == 0 && qi < 15) ATT_Q_LOAD(m + 1); \
            if ((cp_) == 1 && qi < 15) { \
                ATT_SEL_WRITE((qi + 1) & 1, sv, (m + 1) & (T - 1)); \
                if (qi < 14) ATT_SV_LOAD(m + 2); \
            } \
            __builtin_amdgcn_sched_barrier(0); \
            f32x4 acc[2][2]; \
            _Pragma("unroll") for (int h = 0; h < 2; ++h) _Pragma("unroll") for (int tau = 0; tau < 2; ++tau) \
                acc[h][tau] = __builtin_amdgcn_mfma_scale_f32_16x16x128_f8f6f4(af[h][tau], qh, (f32x4){0.f, 0.f, 0.f, 0.f}, 0, 0, 0, 0, 0, 0); \
              \
              \
            float sr[2][4]; \
            asm volatile("s_nop 15\n\ts_nop 3" :: "v"(acc[0][0]), "v"(acc[0][1]), "v"(acc[1][0]), "v"(acc[1][1])); \
            _Pragma("unroll") for (int tau = 0; tau < 2; ++tau) _Pragma("unroll") for (int r = 0; r < 4; ++r) { float d; \
                const float x1 = acc[1][tau][r], x0 = acc[0][tau][r]; \
                asm volatile("v_add_f32_dpp %0, %1, %1 row_ror:8 row_mask:0xf bank_mask:0xc" : "=v"(d) : "v"(x1)); \
                asm volatile("v_add_f32_dpp %0, %1, %1 row_ror:8 row_mask:0xf bank_mask:0x3" : "+v"(d) : "v"(x0)); \
                sr[tau][r] = d; } \
            float sc[2][4]; \
            _Pragma("unroll") for (int tau = 0; tau < 2; ++tau) _Pragma("unroll") for (int r = 0; r < 4; ++r) sc[tau][r] = fmaf(sr[tau][r], 0.0625f, bv[tau][r]); \
            if (t < 255) {                                           \
                _Pragma("unroll") for (int tau = 0; tau < 2; ++tau) _Pragma("unroll") for (int r = 0; r < 4; ++r) \
                    if (64 * (cp_) + 32 * hs + 16 * tau + 4 * g + r > t) sc[tau][r] = -1e30f; \
            } \
            const float mxh = vmax3(vmax3(sc[0][0], sc[0][1], sc[0][2]), vmax3(sc[0][3], sc[1][0], sc[1][1]), vmax2(sc[1][2], sc[1][3])); \
            const float mx = xmax16(vmax2(mxh, ror8(mxh))); \
            if ((cp_) == 0) mref = mx; \
            else if (__builtin_amdgcn_ballot_w64(mx > mref + 3.0f) != 0) {                         \
                const float mn = vmax2(mref, mx), rs = __builtin_amdgcn_exp2f(mref - mn); mref = mn; \
                _Pragma("unroll") for (int rt = 0; rt < 8; ++rt) o[rt] *= rs; \
                ls *= rs; \
            } \
            const float mo = mref - 5.0f; \
            long pf[2]; \
            { float pr[2][4]; \
                _Pragma("unroll") for (int tau = 0; tau < 2; ++tau) _Pragma("unroll") for (int r = 0; r < 4; ++r) pr[tau][r] = __builtin_amdgcn_exp2f(sc[tau][r] - mo); \
                u32x2 pw, px; \
                pw.x = (unsigned)__builtin_amdgcn_cvt_pk_fp8_f32(pr[0][0], pr[0][1], 0, false); pw.x = (unsigned)__builtin_amdgcn_cvt_pk_fp8_f32(pr[0][2], pr[0][3], (int)pw.x, true); \
                pw.y = (unsigned)__builtin_amdgcn_cvt_pk_fp8_f32(pr[1][0], pr[1][1], 0, false); pw.y = (unsigned)__builtin_amdgcn_cvt_pk_fp8_f32(pr[1][2], pr[1][3], (int)pw.y, true); \
                px.x = (unsigned)__builtin_amdgcn_update_dpp(0, (int)pw.x, 0x128, 0xf, 0xf, false); px.y = (unsigned)__builtin_amdgcn_update_dpp(0, (int)pw.y, 0x128, 0xf, 0xf, false); \
                pf[0] = __builtin_bit_cast(long, pw); pf[1] = __builtin_bit_cast(long, px); }        \
            asm volatile("s_waitcnt lgkmcnt(0)" : "+v"(ta[0][0]), "+v"(ta[0][1]), "+v"(ta[0][2]), "+v"(ta[0][3]), "+v"(ta[0][4]), "+v"(ta[0][5]), "+v"(ta[0][6]), "+v"(ta[0][7])); \
            asm volatile("" : "+v"(ta[1][0]), "+v"(ta[1][1]), "+v"(ta[1][2]), "+v"(ta[1][3]), "+v"(ta[1][4]), "+v"(ta[1][5]), "+v"(ta[1][6]), "+v"(ta[1][7])); \
            _Pragma("unroll") for (int h = 0; h < 2; ++h) { \
                _Pragma("unroll") for (int rt = 0; rt < 8; ++rt) o[rt] = __builtin_amdgcn_mfma_f32_16x16x32_fp8_fp8(ta[h][rt], pf[h], o[rt], 0, 0, 0); \
                ls = __builtin_amdgcn_mfma_f32_16x16x32_fp8_fp8(ones8, pf[h], ls, 0, 0, 0); } \
            if ((cp_) == 3) { \
                const float inv = __builtin_amdgcn_rcpf(ls[0]); \
                if (hcol < 8) { \
                    _Pragma("unroll") for (int rt = 0; rt < 8; ++rt) { \
                        u32x2 w; w.x = pg8::cvt_pk_bf16(o[rt][0] * inv, o[rt][1] * inv); w.y = pg8::cvt_pk_bf16(o[rt][2] * inv, o[rt][3] * inv); \
                        *(u32x2*)(p.OL + (size_t)m * 1024 + hcol * 128 + 16 * rt + 4 * g) = w; \
                    } \
                } \
                _Pragma("unroll") for (int rt = 0; rt < 8; ++rt) o[rt] = (f32x4){0.f, 0.f, 0.f, 0.f}; \
                ls = (f32x4){0.f, 0.f, 0.f, 0.f}; \
            } } while (0)
        if (wave >= 4) { __builtin_amdgcn_s_sleep(ATT_SKEW); }
#pragma unroll 1
        for (int qi = 0; qi < 16; ++qi) {
            ATT_BODY(0); ATT_BODY(1); ATT_BODY(2); ATT_BODY(3);
        }
#undef ATT_BODY
        asm volatile("s_waitcnt vmcnt(0)" ::: "memory");
    }
#undef ATT_DMA_CHUNK
#undef ATT_SEL_WRITE
#undef ATT_Q_LOAD
}

__device__ __forceinline__ unsigned q16of(float x) { return (unsigned)(int)__builtin_fminf(__builtin_fmaxf((x + 8.0f) * 4096.0f, 0.0f), 65535.0f); }

__device__ __forceinline__ unsigned wave_incl_scan(unsigned x) {
    x += (unsigned)__builtin_amdgcn_update_dpp(0, (int)x, 0x111, 0xf, 0xf, false);
    x += (unsigned)__builtin_amdgcn_update_dpp(0, (int)x, 0x112, 0xf, 0xf, false);
    x += (unsigned)__builtin_amdgcn_update_dpp(0, (int)x, 0x114, 0xf, 0xf, false);
    x += (unsigned)__builtin_amdgcn_update_dpp(0, (int)x, 0x118, 0xf, 0xf, false);
    x += (unsigned)__builtin_amdgcn_update_dpp(0, (int)x, 0x142, 0xa, 0xf, false);
    x += (unsigned)__builtin_amdgcn_update_dpp(0, (int)x, 0x143, 0xc, 0xf, false);
    return x;
}
__device__ __forceinline__ void select_row7(const LAS unsigned short* row, int n, LAS unsigned* hist, LAS unsigned* h2, unsigned short* out, int lane) {
    if (n <= 256) {
#pragma unroll
        for (int i = 0; i < 4; ++i) { const int k = lane + 64 * i; out[k] = (unsigned short)(k < n ? k : 0); }
#pragma unroll
        for (int i = 0; i < 8; ++i) hist[lane + 64 * i] = 0u;
        return;
    }
    const unsigned long long lt = (1ull << lane) - 1ull;
    unsigned b1, above;
    {
        const int rl = 63 - lane;
        const u32x4 w0 = *(const LAS u32x4*)(hist + 8 * rl), w1 = *(const LAS u32x4*)(hist + 8 * rl + 4);
        unsigned c[16];
        c[0] = w0.x & 0xffffu; c[1] = w0.x >> 16; c[2] = w0.y & 0xffffu; c[3] = w0.y >> 16; c[4] = w0.z & 0xffffu; c[5] = w0.z >> 16; c[6] = w0.w & 0xffffu; c[7] = w0.w >> 16;
        c[8] = w1.x & 0xffffu; c[9] = w1.x >> 16; c[10] = w1.y & 0xffffu; c[11] = w1.y >> 16; c[12] = w1.z & 0xffffu; c[13] = w1.z >> 16; c[14] = w1.w & 0xffffu; c[15] = w1.w >> 16;
        unsigned s = 0;
#pragma unroll
        for (int j = 0; j < 16; ++j) s += c[j];
        const unsigned incl = wave_incl_scan(s), excl = incl - s;
        const bool mine = (excl < 256u) && (incl >= 256u);
        unsigned bin = 0, ab = 0, run = excl, found = 0u;
#pragma unroll
        for (int j = 15; j >= 0; --j) { const unsigned r2 = run + c[j]; const unsigned hit = (found == 0u && r2 >= 256u) ? 1u : 0u;
            bin = hit ? (unsigned)(16 * rl + j) : bin; ab = hit ? run : ab; found |= hit; run = r2; }
        const unsigned long long bm = __ballot(mine);
        const int src = __builtin_amdgcn_readfirstlane(bm ? (int)__builtin_ctzll(bm) : 0);
        b1 = (unsigned)__builtin_amdgcn_readlane((int)bin, src); above = (unsigned)__builtin_amdgcn_readlane((int)ab, src);
    }
    LDS_WAIT();
    int need = 256 - (int)above;
    LAS unsigned short* cand = (LAS unsigned short*)hist;
    const int nblk = (n + 255) >> 8;
    const unsigned thr = b1 << 6;
    int C = 0;
    u32x2 vn = *(const LAS u32x2*)(row + 4 * lane);
    for (int blk = 0; blk < nblk; ++blk) {
        const u32x2 v = vn;
        if (blk + 1 < nblk) vn = *(const LAS u32x2*)(row + (blk + 1) * 256 + 4 * lane);
        const unsigned q[4] = {v.x & 0xffffu, v.x >> 16, v.y & 0xffffu, v.y >> 16};
        bool ge[4]; unsigned long long bl[4];
#pragma unroll
        for (int e = 0; e < 4; ++e) { ge[e] = (blk * 256 + 4 * lane + e < n) && (q[e] >= thr); bl[e] = __ballot(ge[e]); }
        const int below = __builtin_popcountll(bl[0] & lt) + __builtin_popcountll(bl[1] & lt) + __builtin_popcountll(bl[2] & lt) + __builtin_popcountll(bl[3] & lt);
        int pos = C + below;
#pragma unroll
        for (int e = 0; e < 4; ++e) { if (ge[e]) { if (pos < 768) cand[pos] = (unsigned short)(blk * 256 + 4 * lane + e); ++pos; } }
        C += __builtin_popcountll(bl[0]) + __builtin_popcountll(bl[1]) + __builtin_popcountll(bl[2]) + __builtin_popcountll(bl[3]);
    }
    LDS_WAIT();
    LAS unsigned short* outL = cand + 768;
    if (C <= 512) {
        int ci[8]; unsigned cq[8]; bool ceq[8];
#pragma unroll
        for (int k = 0; k < 8; ++k) { const int j = lane + 64 * k; ci[k] = j < C ? (int)cand[j] : -1; }
#pragma unroll
        for (int k = 0; k < 8; ++k) { cq[k] = ci[k] >= 0 ? (unsigned)row[ci[k]] : 0u; ceq[k] = ci[k] >= 0 && (cq[k] >> 6) == b1; }
        h2[lane] = 0u;
        LDS_WAIT();
#pragma unroll
        for (int k = 0; k < 8; ++k) if (ceq[k]) __hip_atomic_fetch_add(h2 + (cq[k] & 63u), 1u, __ATOMIC_RELAXED, __HIP_MEMORY_SCOPE_WORKGROUP);
        LDS_WAIT();
        const unsigned cme = h2[63 - lane];
        const unsigned incl = wave_incl_scan(cme), excl = incl - cme;
        const bool mine = (excl < (unsigned)need) && (incl >= (unsigned)need);
        const unsigned long long bm = __ballot(mine);
        const int src = __builtin_amdgcn_readfirstlane(bm ? (int)__builtin_ctzll(bm) : 0);
        const unsigned Tl = (unsigned)(63 - src);
        need -= __builtin_amdgcn_readlane((int)excl, src);
        const unsigned Tq = (b1 << 6) | Tl;
        int eq_seen = 0, cnt = 0;
#pragma unroll
        for (int k = 0; k < 8; ++k) {
            const bool valid = ci[k] >= 0, eqk = valid && cq[k] == Tq;
            const unsigned long long beq = __ballot(eqk);
            const int eq_rank = eq_seen + __builtin_popcountll(beq & lt);
            const bool take = valid && (cq[k] > Tq || (eqk && eq_rank < need));
            const unsigned long long bt = __ballot(take);
            const int pos = cnt + __builtin_popcountll(bt & lt);
            if (take && pos < 256) outL[pos] = (unsigned short)ci[k];
            cnt += __builtin_popcountll(bt); eq_seen += __builtin_popcountll(beq);
        }
    } else {
        unsigned lo = 0u, hi = 65535u;
        while (lo < hi) {
            const unsigned mid = (lo + hi + 1u) >> 1;
            int cge = 0;
            for (int i = lane; i < n; i += 64) cge += ((unsigned)row[i] >= mid) ? 1 : 0;
#pragma unroll
            for (int o = 1; o < 64; o <<= 1) cge += __shfl_xor(cge, o);
            if (cge >= 256) lo = mid; else hi = mid - 1u;
        }
        const unsigned Tq = lo;
        int cgt = 0;
        for (int i = lane; i < n; i += 64) cgt += ((unsigned)row[i] > Tq) ? 1 : 0;
#pragma unroll
        for (int o = 1; o < 64; o <<= 1) cgt += __shfl_xor(cgt, o);
        const int needq = 256 - cgt;
        int cnt = 0, eq_seen = 0;
        for (int i0 = 0; i0 < n; i0 += 64) {
            const int i = i0 + lane; const bool valid = i < n;
            const unsigned qv = valid ? (unsigned)row[i] : 0u;
            const bool eqk = valid && qv == Tq;
            const unsigned long long beq = __ballot(eqk);
            const int eq_rank = eq_seen + __builtin_popcountll(beq & lt);
            const bool take = valid && (qv > Tq || (eqk && eq_rank < needq));
            const unsigned long long bt = __ballot(take);
            const int pos = cnt + __builtin_popcountll(bt & lt);
            if (take && pos < 256) outL[pos] = (unsigned short)i;
            cnt += __builtin_popcountll(bt); eq_seen += __builtin_popcountll(beq);
        }
    }
    LDS_WAIT();
    *(u32x2*)(out + 4 * lane) = *(const LAS u32x2*)(outL + 4 * lane);
    LDS_WAIT();
#pragma unroll
    for (int i = 0; i < 8; ++i) hist[lane + 64 * i] = 0u;
}

template <int STRIP> __device__ __forceinline__ void ph_index7_t(const P& p, LAS unsigned char* lds, const int wv) {
    LAS unsigned short* Irow = (LAS unsigned short*)lds;
    LAS unsigned* hist = (LAS unsigned*)(lds + 65536);
    LAS unsigned* h2 = (LAS unsigned*)(lds + 81920);
    const int tid = opaque_tid(wv), lane = tid & 63, wave = __builtin_amdgcn_readfirstlane(tid >> 6);
    const int hh = lane >> 5, n = lane & 31;
    const int rho = lane & 31, qlA = 2 * ((rho >> 2) & 1) + (rho >> 4), hdA = (rho & 3) + 4 * ((rho >> 3) & 1);
    const unsigned boff = (unsigned)(n * 64 + 16 * hh);
#pragma unroll
    for (int i = 0; i < 8; ++i) hist[tid + NTHR * i] = 0u;
    i32x8 Ah[2], Al[2]; float wq[2][16]; u32x4 R0a, R0b, R1a, R1b, R2a, R2b, R3a, R3b;
#define IDX8_LOAD(Ra_, Rb_, mb_, kt_) do { const unsigned char* kb_ = (const unsigned char*)p.KI + ((mb_) + (size_t)(kt_) * 32) * 64; \
        asm volatile("global_load_dwordx4 %0, %1, %2" : "=v"(Ra_) : "v"(boff), "s"(kb_)); asm volatile("global_load_dwordx4 %0, %1, %2 offset:32" : "=v"(Rb_) : "v"(boff), "s"(kb_)); } while (0)
#define IDX8_LOAD_UNIT(u_) do { const int b_ = (u_) & 7, t0_ = (511 - ((u_) >> 3)) * 8; const size_t mb_ = (size_t)b_ * T; const int nkt_ = (t0_ + 8 + 31) >> 5; \
        _Pragma("unroll") for (int mt = 0; mt < 2; ++mt) { const unsigned char* src = (const unsigned char*)p.QI + (mb_ + t0_ + mt * 4 + qlA) * 1024 + hdA * 128 + 16 * hh; \
            const u32x4 h0 = *(const u32x4*)src, h1 = *(const u32x4*)(src + 32), l0 = *(const u32x4*)(src + 64), l1 = *(const u32x4*)(src + 96); \
            Ah[mt] = (i32x8){(int)h0.x, (int)h0.y, (int)h0.z, (int)h0.w, (int)h1.x, (int)h1.y, (int)h1.z, (int)h1.w}; \
            Al[mt] = (i32x8){(int)l0.x, (int)l0.y, (int)l0.z, (int)l0.w, (int)l1.x, (int)l1.y, (int)l1.z, (int)l1.w}; \
            _Pragma("unroll") for (int c = 0; c < 2; ++c) { const float* wp = p.WI + (mb_ + t0_ + mt * 4 + 2 * hh + c) * 8; const f32x4 w0 = *(const f32x4*)wp, w1 = *(const f32x4*)(wp + 4); \
                _Pragma("unroll") for (int j = 0; j < 4; ++j) { wq[mt][c * 8 + j] = w0[j]; wq[mt][c * 8 + 4 + j] = w1[j]; } } } \
        __builtin_amdgcn_sched_barrier(0); \
        IDX8_LOAD(R0a, R0b, mb_, min(wave, nkt_ - 1)); IDX8_LOAD(R1a, R1b, mb_, min(wave + NWAVES, nkt_ - 1));            \
        IDX8_LOAD(R2a, R2b, mb_, min(wave + 2 * NWAVES, nkt_ - 1)); IDX8_LOAD(R3a, R3b, mb_, min(wave + 3 * NWAVES, nkt_ - 1)); } while (0)
    if ((int)blockIdx.x < 4096) IDX8_LOAD_UNIT((int)blockIdx.x);
    __syncthreads();
    for (int u = blockIdx.x; u < 4096; u += gridDim.x) {
        const int b = u & 7, tb = 511 - (u >> 3), t0 = tb * 8; const size_t mb = (size_t)b * T;
        const int nkt = (t0 + 8 + 31) >> 5;
#pragma unroll
        for (int mt = 0; mt < 2; ++mt) {
            asm volatile("" :: "v"(Ah[mt]), "v"(Al[mt]));
#pragma unroll
            for (int j = 0; j < 16; ++j) asm volatile("" :: "v"(wq[mt][j]));
        }
        const int last = (nkt - 1 - wave) >> 3;
        f32x16 accE[2], accO[2];
#define IDX8_WAIT(i_) do { const int mx_ = last > 3 ? last : 3; const int yt = mx_ - (i_) < 3 ? mx_ - (i_) : 3; \
            if (yt >= 3) asm volatile("s_waitcnt vmcnt(6)" ::: "memory"); else if (yt == 2) asm volatile("s_waitcnt vmcnt(4)" ::: "memory"); \
            else if (yt == 1) asm volatile("s_waitcnt vmcnt(2)" ::: "memory"); else asm volatile("s_waitcnt vmcnt(0)" ::: "memory"); } while (0)
#define IDX8_MFMA(accd, Ra_, Rb_) do { asm volatile("" : "+v"(Ra_), "+v"(Rb_)); \
            const i32x8 Bf = (i32x8){(int)Ra_.x, (int)Ra_.y, (int)Ra_.z, (int)Ra_.w, (int)Rb_.x, (int)Rb_.y, (int)Rb_.z, (int)Rb_.w}; \
            _Pragma("unroll") for (int mt = 0; mt < 2; ++mt) { \
                _Pragma("unroll") for (int j = 0; j < 16; ++j) accd[mt][j] = 0.f; \
                accd[mt] = __builtin_amdgcn_mfma_scale_f32_32x32x64_f8f6f4(Ah[mt], Bf, accd[mt], 0, 0, 0, 0, 0, 0); \
                accd[mt] = __builtin_amdgcn_mfma_scale_f32_32x32x64_f8f6f4(Al[mt], Bf, accd[mt], 0, 0, 0, 0, 0, 0); } } while (0)
#define IDX8_BODY(kt_, jo_, accs, accn, Rna_, Rnb_) do { const int kt = (kt_); if (kt < nkt) { \
            if (kt + NWAVES < nkt) { IDX8_WAIT((jo_) + 1); IDX8_MFMA(accn, Rna_, Rnb_); \
                __builtin_amdgcn_sched_barrier(0); \
                if (kt + 5 * NWAVES < nkt) IDX8_LOAD(Rna_, Rnb_, mb, kt + 5 * NWAVES); \
                __builtin_amdgcn_sched_barrier(0); } \
            const int key = kt * 32 + n; \
            _Pragma("unroll") for (int mt = 0; mt < 2; ++mt) { \
                _Pragma("unroll") for (int c = 0; c < 2; ++c) { \
                    float v = 0.f; \
                    _Pragma("unroll") for (int h = 0; h < 8; ++h) { const float af = accs[mt][c * 8 + h]; const int ai = __float_as_int(af); v = __builtin_fmaf(wq[mt][c * 8 + h], __int_as_float(ai > 0 ? ai : 0), v); } \
                    const int r = mt * 4 + 2 * hh + c; const unsigned q = q16of(v); \
                    Irow[r * 4096 + key] = (unsigned short)q; \
                    if (key <= t0 + r) { const unsigned bin = q >> 6; __hip_atomic_fetch_add(hist + r * 512 + (bin >> 1), 1u << ((bin & 1u) * 16u), __ATOMIC_RELAXED, __HIP_MEMORY_SCOPE_WORKGROUP); } \
                } \
            } } } while (0)
        if (wave < nkt) { IDX8_WAIT(0); IDX8_MFMA(accE, R0a, R0b); __builtin_amdgcn_sched_barrier(0); if (wave + 4 * NWAVES < nkt) IDX8_LOAD(R0a, R0b, mb, wave + 4 * NWAVES); __builtin_amdgcn_sched_barrier(0); }
#pragma unroll 1
        for (int k0 = wave, j0 = 0; k0 < nkt; k0 += 4 * NWAVES, j0 += 4) {
            IDX8_BODY(k0, j0, accE, accO, R1a, R1b);
            IDX8_BODY(k0 + NWAVES, j0 + 1, accO, accE, R2a, R2b);
            IDX8_BODY(k0 + 2 * NWAVES, j0 + 2, accE, accO, R3a, R3b);
            IDX8_BODY(k0 + 3 * NWAVES, j0 + 3, accO, accE, R0a, R0b);
        }
#undef IDX8_BODY
#undef IDX8_MFMA
#undef IDX8_WAIT
        if (u + (int)gridDim.x < 4096) IDX8_LOAD_UNIT(u + (int)gridDim.x);
        LDS_WAIT(); __builtin_amdgcn_s_barrier();
        if (STRIP != 1) select_row7(Irow + wave * 4096, t0 + wave + 1, hist + wave * 512, h2 + wave * 320, p.SEL + (mb + t0 + wave) * 256, lane);
        else { _Pragma("unroll") for (int i = 0; i < 8; ++i) hist[wave * 512 + lane + 64 * i] = 0u; }
        LDS_WAIT(); __builtin_amdgcn_s_barrier();
    }
#undef IDX8_LOAD
#undef IDX8_LOAD_UNIT
}

__device__ __forceinline__ void ph_index7(const P& p, LAS unsigned char* lds, const int wv) { ph_index7_t<0>(p, lds, wv); }

__device__ __forceinline__ void ph_gmlp(const P& p, LAS unsigned char* lds, const int wv) {
    const int tid = opaque_tid(wv), lane = tid & 63, wave = __builtin_amdgcn_readfirstlane(tid >> 6);
    LAS unsigned char* vt = lds;
    LAS float* st = (LAS float*)(lds + 32768);
    const int g4 = lane >> 4, q4 = (lane & 15) >> 2, p4 = lane & 3, ic = lane & 15;
    for (int u = blockIdx.x; u < 256; u += gridDim.x) {
        const size_t m0 = (size_t)u * 128;
#pragma unroll 1
        for (int r4 = 0; r4 < 4; ++r4) {
            float x[4][8], sm[4];
#pragma unroll
            for (int r = 0; r < 4; ++r) { const u32x4 w = *(const u32x4*)(p.VB + (m0 + 16 * wave + 4 * r4 + r) * 512 + lane * 8);
                x[r][0] = bflo(w.x); x[r][1] = bfhi(w.x); x[r][2] = bflo(w.y); x[r][3] = bfhi(w.y); x[r][4] = bflo(w.z); x[r][5] = bfhi(w.z); x[r][6] = bflo(w.w); x[r][7] = bfhi(w.w); }
#pragma unroll
            for (int r = 0; r < 4; ++r) sm[r] = ((x[r][0] + x[r][1]) + (x[r][2] + x[r][3])) + ((x[r][4] + x[r][5]) + (x[r][6] + x[r][7]));
#pragma unroll
            for (int o = 1; o < 64; o <<= 1) {
#pragma unroll
                for (int r = 0; r < 4; ++r) sm[r] += __shfl_xor(sm[r], o);
            }
            float vr[4];
#pragma unroll
            for (int r = 0; r < 4; ++r) { const float mean = sm[r] * (1.f / 512.f); sm[r] = mean; float a = 0.f;
#pragma unroll
                for (int j = 0; j < 8; ++j) { const float d = x[r][j] - mean; a += d * d; }
                vr[r] = a; }
#pragma unroll
            for (int o = 1; o < 64; o <<= 1) {
#pragma unroll
                for (int r = 0; r < 4; ++r) vr[r] += __shfl_xor(vr[r], o);
            }
            if (lane == 0) {
#pragma unroll
                for (int r = 0; r < 4; ++r) { const int row = 16 * wave + 4 * r4 + r; st[2 * row] = sm[r]; st[2 * row + 1] = 1.0f / sqrtf(vr[r] * (1.f / 512.f) + EPS); }
            }
        }
        __syncthreads();
#pragma unroll 1
        for (int g = 0; g < 4; ++g) {
#pragma unroll
            for (int i = 0; i < 4; ++i) {
                const int piece = i * NTHR + tid, row = piece >> 4, ch = piece & 15;
                const u32x4 w = *(const u32x4*)(p.VB + (m0 + row) * 512 + g * 128 + ch * 8);
                const float mean = st[2 * row], rstd = st[2 * row + 1];
                const f32x4 ga = *(const f32x4*)(p.ln_g + g * 128 + ch * 8), gb = *(const f32x4*)(p.ln_g + g * 128 + ch * 8 + 4);
                const f32x4 ba = *(const f32x4*)(p.ln_b + g * 128 + ch * 8), bb = *(const f32x4*)(p.ln_b + g * 128 + ch * 8 + 4);
                u32x4 o;
                o.x = pk2((bflo(w.x) - mean) * rstd * ga[0] + ba[0], (bfhi(w.x) - mean) * rstd * ga[1] + ba[1]);
                o.y = pk2((bflo(w.y) - mean) * rstd * ga[2] + ba[2], (bfhi(w.y) - mean) * rstd * ga[3] + ba[3]);
                o.z = pk2((bflo(w.z) - mean) * rstd * gb[0] + bb[0], (bfhi(w.z) - mean) * rstd * gb[1] + bb[1]);
                o.w = pk2((bflo(w.w) - mean) * rstd * gb[2] + bb[2], (bfhi(w.w) - mean) * rstd * gb[3] + bb[3]);
                *(LAS u32x4*)(vt + off_b(row, ch)) = o;
            }
            const size_t orow = (m0 + 16 * wave + ic) * 512 + g * 128 + 4 * g4;
            u32x2 uv[8];
#pragma unroll
            for (int et = 0; et < 8; ++et) uv[et] = *(const u32x2*)(p.UB + orow + 16 * et);
            const float bs = p.b_sp[g * 128 + 16 * wave + ic];
            const int nks = ((16 * wave + 15) >> 5) + 1;
            bf16x8 wb[4];
#pragma unroll
            for (int ks = 0; ks < 4; ++ks) wb[ks] = *(const bf16x8*)(p.WSB + ((size_t)g * 128 + 16 * wave + ic) * 128 + 32 * ks + 8 * g4);
            __syncthreads();
            f32x4 acc[8];
#pragma unroll
            for (int et = 0; et < 8; ++et) acc[et] = (f32x4){0.f, 0.f, 0.f, 0.f};
#pragma unroll
            for (int ks = 0; ks < 4; ++ks) {
                if (ks < nks) {
                    bf16x4 ta[8][2];
#pragma unroll
                    for (int et = 0; et < 8; ++et) {
                        const unsigned r0 = 32 * ks + 8 * g4 + q4, ch = 2 * et + (p4 >> 1);
                        ta[et][0] = tr16(vt + off_b(r0, ch) + 8 * (p4 & 1)); ta[et][1] = tr16(vt + off_b(r0 + 4, ch) + 8 * (p4 & 1));
                    }
#pragma unroll
                    for (int et = 0; et < 8; ++et) acc[et] = __builtin_amdgcn_mfma_f32_16x16x32_bf16(cat4(ta[et][0], ta[et][1]), wb[ks], acc[et], 0, 0, 0);
                }
            }
#pragma unroll
            for (int et = 0; et < 8; ++et) {
                u32x2 w;
                w.x = pk2(bflo(uv[et].x) * (acc[et][0] + bs), bfhi(uv[et].x) * (acc[et][1] + bs));
                w.y = pk2(bflo(uv[et].y) * (acc[et][2] + bs), bfhi(uv[et].y) * (acc[et][3] + bs));
                *(u32x2*)(p.US + orow + 16 * et) = w;
            }
            __syncthreads();
        }
    }
}

__device__ __forceinline__ void split2(float a, float b, unsigned& h, unsigned& l) {
    const unsigned ha = f2bf(a), hb = f2bf(b);
    h = ha | (hb << 16); l = pk2(a - __uint_as_float(ha << 16), b - __uint_as_float(hb << 16));
}
__device__ __forceinline__ void split_bf16(const f32x4 a, const f32x4 b, bf16x8& hi, bf16x8& lo) {
    unsigned h0, h1, h2, h3, l0, l1, l2, l3;
    split2(a.x, a.y, h0, l0); split2(a.z, a.w, h1, l1); split2(b.x, b.y, h2, l2); split2(b.z, b.w, h3, l3);
    const u32x4 h = {h0, h1, h2, h3}, l = {l0, l1, l2, l3};
    hi = __builtin_bit_cast(bf16x8, h); lo = __builtin_bit_cast(bf16x8, l);
}
template <int STRIP> __device__ __forceinline__ void ph_router_t(const P& p, LAS unsigned char* lds, const int wv) {
    const int tid = opaque_tid(wv), lane = tid & 63, wave = __builtin_amdgcn_readfirstlane(tid >> 6);
    LAS float* LG = (LAS float*)lds;
    LAS float* SS = (LAS float*)(lds + 26624);
    LAS unsigned* cnt = (LAS unsigned*)(lds + 26624 + 512);
    const int g = lane >> 4, ic = lane & 15;
    const float* X1 = p.out;
    bf16x8 bh[4][3], bl[4][3];
#pragma unroll
    for (int ks = 0; ks < 4; ++ks) {
        const int k0 = 128 * wave + 32 * ks + 8 * g;
#pragma unroll
        for (int nt = 0; nt < 3; ++nt) {
            const int col = 16 * nt + ic; const int cc = col < 36 ? col : 0;
            f32x4 a = *(const f32x4*)(p.WrT + (size_t)cc * 1024 + k0), b = *(const f32x4*)(p.WrT + (size_t)cc * 1024 + k0 + 4);
            if (col >= 36) { a = (f32x4){0.f, 0.f, 0.f, 0.f}; b = a; }
            split_bf16(a, b, bh[ks][nt], bl[ks][nt]);
        }
        if (ks & 1) asm volatile("" ::: "memory");
    }
    for (int c = blockIdx.x; c < M / 128; c += gridDim.x) {
        for (int i = tid; i < 128 * 52 + 128 + 32; i += NTHR) ((LAS float*)lds)[i] = 0.f;
        __syncthreads();
        f32x4 xa[4], xb[4], na[4], nb[4];
#define RT_LOAD(XA_, XB_, rt_) do { const float* xr = X1 + (size_t)(c * 128 + 16 * (rt_) + ic) * D + 128 * wave + 8 * g; \
            _Pragma("unroll") for (int ks = 0; ks < 4; ++ks) { XA_[ks] = *(const f32x4*)(xr + 32 * ks); XB_[ks] = *(const f32x4*)(xr + 32 * ks + 4); } } while (0)
        RT_LOAD(na, nb, 0);
#pragma unroll 1
        for (int rt = 0; rt < 8; ++rt) {
#pragma unroll
            for (int ks = 0; ks < 4; ++ks) { xa[ks] = na[ks]; xb[ks] = nb[ks]; }
            if (rt < 7) RT_LOAD(na, nb, rt + 1);
            __builtin_amdgcn_sched_barrier(0);
            f32x4 acc[3];
#pragma unroll
            for (int nt = 0; nt < 3; ++nt) acc[nt] = (f32x4){0.f, 0.f, 0.f, 0.f};
            float ssq = 0.f;
            bf16_t* hr = p.H2B + (size_t)(c * 128 + 16 * rt + ic) * D + 128 * wave + 8 * g;
#pragma unroll
            for (int ks = 0; ks < 4; ++ks) {
                ssq += (xa[ks].x * xa[ks].x + xa[ks].y * xa[ks].y) + (xa[ks].z * xa[ks].z + xa[ks].w * xa[ks].w) + (xb[ks].x * xb[ks].x + xb[ks].y * xb[ks].y) + (xb[ks].z * xb[ks].z + xb[ks].w * xb[ks].w);
                const f32x4 ga = *(const f32x4*)(p.n2g + 128 * wave + 32 * ks + 8 * g), gb = *(const f32x4*)(p.n2g + 128 * wave + 32 * ks + 8 * g + 4);
                bf16x8 ah, al;
                split_bf16(xa[ks] * ga, xb[ks] * gb, ah, al);
                *(bf16x8*)(hr + 32 * ks) = ah;
                if (STRIP != 1) {
#pragma unroll
                for (int nt = 0; nt < 3; ++nt) {
                    acc[nt] = __builtin_amdgcn_mfma_f32_16x16x32_bf16(ah, bh[ks][nt], acc[nt], 0, 0, 0);
                    acc[nt] = __builtin_amdgcn_mfma_f32_16x16x32_bf16(al, bh[ks][nt], acc[nt], 0, 0, 0);
                    acc[nt] = __builtin_amdgcn_mfma_f32_16x16x32_bf16(ah, bl[ks][nt], acc[nt], 0, 0, 0);
                }
                }
            }
            ssq += __shfl_xor(ssq, 16); ssq += __shfl_xor(ssq, 32);
            LAS float* PT = (LAS float*)(lds + 32768) + ((rt & 1) * 8 + wave) * (16 * 52);
            if (STRIP == 0) {
#pragma unroll
            for (int nt = 0; nt < 3; ++nt)
#pragma unroll
                for (int r = 0; r < 4; ++r) PT[(4 * g + r) * 52 + 16 * nt + ic] = acc[nt][r];
            if (g == 0) PT[ic * 52 + 48] = ssq;
            }
            LDS_WAIT(); __builtin_amdgcn_s_barrier();
            if (STRIP == 0) {
            for (int e = tid; e < 16 * 52; e += NTHR) {
                const LAS float* q = (const LAS float*)(lds + 32768) + (rt & 1) * 8 * (16 * 52) + e;
                float s = 0.f;
#pragma unroll
                for (int w = 0; w < 8; ++w) s += q[w * (16 * 52)];
                LG[16 * rt * 52 + e] = s;
            }
            }
        }
#undef RT_LOAD
        __syncthreads();
        if (tid < 128) {
            const int m = c * 128 + tid;
            const LAS float* lg = LG + tid * 52;
            const float rinv = 1.0f / sqrtf(lg[48] * (1.f / D) + EPS);
            float gl[4];
#pragma unroll
            for (int i = 0; i < 4; ++i) gl[i] = rinv * lg[i] + p.rg_b[i];
            int gi = 0; float gm = gl[0];
#pragma unroll
            for (int i = 1; i < 4; ++i) if (gl[i] > gm) { gm = gl[i]; gi = i; }
            float gs = 0.f;
#pragma unroll
            for (int i = 0; i < 4; ++i) gs += __expf(gl[i] - gm);
            const float gwt = 1.f / gs;
            float el[8];
#pragma unroll
            for (int j = 0; j < 8; ++j) el[j] = rinv * lg[4 + gi * 8 + j] + p.re_b[gi * 8 + j];
            int i1 = 0; float m1 = el[0];
#pragma unroll
            for (int j = 1; j < 8; ++j) if (el[j] > m1) { m1 = el[j]; i1 = j; }
            int i2 = 0; float m2 = -INFINITY;
#pragma unroll
            for (int j = 0; j < 8; ++j) if (j != i1 && el[j] > m2) { m2 = el[j]; i2 = j; }
            const float e2r = __expf(m2 - m1), e1 = 1.f / (1.f + e2r), e2 = e2r * e1;
            const int ea = gi * 8 + i1, eb = gi * 8 + i2;
            p.EID[2 * m] = ea; p.EID[2 * m + 1] = eb;
            p.EW[2 * m] = gwt * e1; p.EW[2 * m + 1] = gwt * e2;
            p.RINV2[m] = rinv;
            __hip_atomic_fetch_add(cnt + ea, 1u, __ATOMIC_RELAXED, __HIP_MEMORY_SCOPE_WORKGROUP);
            __hip_atomic_fetch_add(cnt + eb, 1u, __ATOMIC_RELAXED, __HIP_MEMORY_SCOPE_WORKGROUP);
        }
        __syncthreads();
        if (tid < 32) p.BLKCNT[c * 32 + tid] = (int)cnt[tid];
        __syncthreads();
    }
}

__device__ __forceinline__ void ph_router(const P& p, LAS unsigned char* lds, const int wv) { ph_router_t<0>(p, lds, wv); }

__device__ __forceinline__ void ph_scan(const P& p, LAS unsigned char* lds, const int wv) {}
__device__ __forceinline__ void ph_scatter(const P& p, LAS unsigned char* lds, const int wv) {
    const int tid = opaque_tid(wv);
    LAS int* s = (LAS int*)lds;
    LAS int* se = s + 2048;
    const int e = tid & 31, part = tid >> 5;
    int loc[16]; int sum = 0;
#pragma unroll
    for (int i = 0; i < 16; ++i) { loc[i] = p.BLKCNT[(part * 16 + i) * 32 + e]; sum += loc[i]; }
    s[128 + part * 32 + e] = sum;
    __syncthreads();
    if (tid < 32) { int t = 0; for (int k = 0; k < 16; ++k) { const int v = s[128 + k * 32 + tid]; s[128 + k * 32 + tid] = t; t += v; } s[tid] = t; }
    __syncthreads();
    if (tid == 0) { int off = 0; for (int k = 0; k < 32; ++k) { s[32 + k] = off; off += (s[k] + 255) >> 8; } s[64] = off; }
    __syncthreads();
    if (blockIdx.x == 0) {
        const int ntiles = s[64];
        if (tid < 32) { p.MOEI[tid] = s[32 + tid] * 256; p.MOEI[32 + tid] = s[32 + tid]; }
        if (tid == 0) { p.MOEI[64] = ntiles; p.MOEI[65] = ntiles * 2; p.MOEI[66] = ntiles * 4; }
        for (int rt = tid; rt < ntiles; rt += NTHR) {
            int ex = 0;
            for (int k = 0; k < 32; ++k) { const int tb = s[32 + k], nt = (s[k] + 255) >> 8; if (rt >= tb && rt < tb + nt) ex = k; }
            p.GU[4 * rt + 0] = rt; p.GU[4 * rt + 1] = ex * 2; p.GU[4 * rt + 2] = rt; p.GU[4 * rt + 3] = ex * 2 + 1;
#pragma unroll
            for (int j = 0; j < 4; ++j) { p.DN[8 * rt + 2 * j] = rt; p.DN[8 * rt + 2 * j + 1] = ex * 4 + j; }
        }
        for (int k = 0; k < 32; ++k) {
            const int lo = s[32 + k] * 256 + s[k], hi = (s[32 + k] + ((s[k] + 255) >> 8)) * 256;
            for (int i = lo + tid; i < hi; i += NTHR) p.PTOK[i] = -1;
        }
    }
    for (int c = blockIdx.x; c < M / 128; c += gridDim.x) {
        if (part == (c >> 4)) {
            int run = s[32 + e] * 256 + s[128 + part * 32 + e];
#pragma unroll
            for (int i = 0; i < 16; ++i) run += (i < (c & 15)) ? loc[i] : 0;
            s[1024 + e] = run;
        }
        int ex = 0;
        if (tid < 256) { ex = p.EID[c * 256 + tid]; se[tid] = ex; }
        __syncthreads();
        if (tid < 256) {
            int rank = 0;
            for (int t = 0; t < tid; ++t) rank += (se[t] == ex) ? 1 : 0;
            p.PTOK[s[1024 + ex] + rank] = c * 256 + tid;
        }
        __syncthreads();
    }
}

template <bool DRY> __device__ __forceinline__ void ph_final(const P& p, const int wv) {
    const int tid = opaque_tid(wv), lane = tid & 63, wave = tid >> 6;
    const int gw = blockIdx.x * NWAVES + wave, NGW = gridDim.x * NWAVES;
    for (int m4 = gw; m4 < M / 4; m4 += NGW) {
        f32x4 v[4][4]; float s[4];
#pragma unroll
        for (int rr = 0; rr < 4; ++rr) {
            const int m = 4 * m4 + rr;
            const f32x4* xr = (const f32x4*)(p.out + (size_t)m * D) + lane;
            const u32x2* y0 = (const u32x2*)(p.YS + (size_t)m * D) + lane; const u32x2* y1 = (const u32x2*)(p.YS + ((size_t)M + m) * D) + lane;
            s[rr] = 0.f;
#pragma unroll
            for (int j = 0; j < 4; ++j) {
                v[rr][j] = xr[64 * j]; const u32x2 a = y0[64 * j], b = y1[64 * j];
                v[rr][j].x += bflo(a.x) + bflo(b.x); v[rr][j].y += bfhi(a.x) + bfhi(b.x); v[rr][j].z += bflo(a.y) + bflo(b.y); v[rr][j].w += bfhi(a.y) + bfhi(b.y);
                s[rr] += (v[rr][j].x * v[rr][j].x + v[rr][j].y * v[rr][j].y) + (v[rr][j].z * v[rr][j].z + v[rr][j].w * v[rr][j].w);
            }
        }
#pragma unroll
        for (int rr = 0; rr < 4; ++rr) {
            const float rinv = 1.0f / sqrtf(wave_sum(s[rr]) * (1.f / D) + EPS);
            f32x4* xr = (f32x4*)((DRY ? (float*)p.GBB : p.out) + (size_t)(4 * m4 + rr) * D) + lane;
#pragma unroll
            for (int j = 0; j < 4; ++j) { const f32x4 g = ((const f32x4*)p.fg)[lane + 64 * j]; xr[64 * j] = v[rr][j] * rinv * g; }
        }
    }
}

#ifndef GEMM_SP2
#define GEMM_SP2 true
#endif
__device__ __forceinline__ void ph_gemm_in(const P& p, LAS unsigned char* lds, const int wv) {
    pg8::Gemm g{p.HB, p.WinT, M, NIN, 1024}; pg8::StaticOrder S; S.init(M, NIN, gridDim.x, (int)blockIdx.x);
    EpiIn E{p.QL, p.QI, p.KI, p.UB, p.VB, p.GAB, p.GBB, p.CKVR, p.WI};
    pg8::gemm_phase<EpiIn, pg8::StaticOrder, true, GEMM_SP2>(lds, g, S, E, wv);
    {
        const int G = gridDim.x, nwg = (M / 256) * (NIN / 256), nextra = nwg % G;
        const int c = blockIdx.x, nshort = nextra == 0 ? G : G - nextra;
        if (nextra == 0 || c >= nextra) {
            const int tid = opaque_tid(wv), lane = tid & 63, wave = __builtin_amdgcn_readfirstlane(tid >> 6);
            __syncthreads();
            prep_gateup(p, lds, (nextra == 0 ? c : c - nextra) * NWAVES + wave, nshort * NWAVES, wave, lane);
        }
    }
}
__device__ __forceinline__ void ph_gemm_yb(const P& p, LAS unsigned char* lds, const int wv) {
    pg8::Gemm g{p.US, p.WpbT, M, 1024, 512}; pg8::StaticOrder S; S.init(M, 1024, gridDim.x, (int)blockIdx.x);
    EpiMB E{p.GBB, p.MB};
    pg8::gemm_phase<EpiMB, pg8::StaticOrder, true, GEMM_SP2>(lds, g, S, E, wv);
}
__device__ __forceinline__ void ph_gemm_ya(const P& p, LAS unsigned char* lds, const int wv) {
    pg8::Gemm g{p.OL, p.WovT, M, 1024, 1024}; pg8::StaticOrder S; S.init(M, 1024, gridDim.x, (int)blockIdx.x);
    EpiMG E{p.GAB, p.MB, p.MG};
    pg8::gemm_phase<EpiMG, pg8::StaticOrder, true, GEMM_SP2>(lds, g, S, E, wv);
}
__device__ __forceinline__ void ph_gemm_out(const P& p, LAS unsigned char* lds, const int wv) {
    pg8::Gemm g{p.MG, p.WoutT, M, 1024, 1024}; pg8::StaticOrder S; S.init(M, 1024, gridDim.x, (int)blockIdx.x);
    EpiX1 E{p.x, p.out};
    pg8::gemm_phase<EpiX1, pg8::StaticOrder, true, GEMM_SP2>(lds, g, S, E, wv);
}
__device__ __forceinline__ void ph_gemm_gu(const P& p, LAS unsigned char* lds, const int wv) {
    table_prefetch(lds, p.GU, p.MOEI + 65, (int)gridDim.x, (int)blockIdx.x, opaque_tid(wv));
    pg8::Gemm g{p.H2B, p.WguT, NPOS, 32 * 512, 1024}; TableGatherOrder S{p.GU, p.MOEI + 65, p.PTOK, (int)gridDim.x, (int)blockIdx.x, (const LAS int*)(lds + LDS_TAB_OFF)};
    EpiHE E{p.HE, p.PTOK, p.RINV2};
    pg8::gemm_phase<EpiHE, TableGatherOrder, true, true>(lds, g, S, E, wv);
}
__device__ __forceinline__ void ph_gemm_dn(const P& p, LAS unsigned char* lds, const int wv) {
    table_prefetch(lds, p.DN, p.MOEI + 66, (int)gridDim.x, (int)blockIdx.x, opaque_tid(wv));
    pg8::Gemm g{p.HE, p.WdT, NPOS, 32 * 1024, 256}; TableOrder S{p.DN, p.MOEI + 66, (int)gridDim.x, (int)blockIdx.x, (const LAS int*)(lds + LDS_TAB_OFF)};
    EpiDown E{p.PTOK, p.EW, p.YS};
    pg8::gemm_phase<EpiDown, TableOrder, true, GEMM_SP2>(lds, g, S, E, wv);
}
constexpr int NPHASE = 15;
template <int PH> __device__ __forceinline__ void run_phase(const P& p, LAS unsigned char* lds, const int wv) {
    if constexpr (PH == 0) ph_prep(p, lds, wv);
    if constexpr (PH == 1) ph_gemm_in(p, lds, wv);
    if constexpr (PH == 2) ph_ckvnorm(p, wv);
    if constexpr (PH == 3) ph_index7(p, lds, wv);
    if constexpr (PH == 4) ph_attn_t<0>(p, lds, wv);
    if constexpr (PH == 5) ph_gmlp(p, lds, wv);
    if constexpr (PH == 6) ph_gemm_yb(p, lds, wv);
    if constexpr (PH == 7) ph_gemm_ya(p, lds, wv);
    if constexpr (PH == 8) ph_gemm_out(p, lds, wv);
    if constexpr (PH == 9) ph_router(p, lds, wv);
    if constexpr (PH == 10) ph_scan(p, lds, wv);
    if constexpr (PH == 11) ph_scatter(p, lds, wv);
    if constexpr (PH == 12) ph_gemm_gu(p, lds, wv);
    if constexpr (PH == 13) ph_gemm_dn(p, lds, wv);
    if constexpr (PH == 14) ph_final<false>(p, wv);
}
template <int PH> __global__ void __launch_bounds__(NTHR, 2) k_phase(P p) {
    extern __shared__ __attribute__((aligned(16))) unsigned char lds_raw[];
    run_phase<PH>(p, (LAS unsigned char*)lds_raw, __builtin_amdgcn_readfirstlane(threadIdx.x >> 6));
}

constexpr int MISC_OFF = LDS_BYTES - 256;
__global__ void __launch_bounds__(NTHR, 2) k_mega(P p) {
    extern __shared__ __attribute__((aligned(16))) unsigned char lds_raw[];
    LAS unsigned char* lds = (LAS unsigned char*)lds_raw;
    volatile LAS unsigned* MISC = (volatile LAS unsigned*)(lds + MISC_OFF);
    int wv = __builtin_amdgcn_readfirstlane(threadIdx.x >> 6); asm volatile("" : "+s"(wv));
    if (threadIdx.x < 64) MISC[threadIdx.x] = 0u;
    __syncthreads();
    XcdBarrier bar = xcd_barrier_post(p.ctl + CW_BAR, MISC, wv);
    run_phase<0>(p, lds, wv);
#if defined(DUP0)
    __syncthreads(); run_phase<0>(p, lds, wv);
#endif
    xcd_barrier(bar);
    run_phase<1>(p, lds, wv);
#if defined(DUP1)
    __syncthreads(); run_phase<1>(p, lds, wv);
#endif
    xcd_barrier(bar);
    run_phase<2>(p, lds, wv);
#if defined(DUP2)
    run_phase<2>(p, lds, wv);
#endif
#if defined(PRE3)
    ph_index7_t<PRE3>(p, lds, wv); __syncthreads();
#endif
    run_phase<3>(p, lds, wv);
#if defined(DUP3)
    __syncthreads(); run_phase<3>(p, lds, wv);
#endif
    xcd_barrier(bar);
#if defined(PRE4)
    ph_attn_t<PRE4>(p, lds, wv); __syncthreads();
#endif
    run_phase<4>(p, lds, wv);  __syncthreads();
#if defined(DUP4)
    run_phase<4>(p, lds, wv);  __syncthreads();
#endif
    run_phase<5>(p, lds, wv);
#if defined(DUP5)
    __syncthreads(); run_phase<5>(p, lds, wv);
#endif
    xcd_barrier(bar);
    run_phase<6>(p, lds, wv);
    run_phase<7>(p, lds, wv);  xcd_barrier(bar);
    run_phase<8>(p, lds, wv);
#if defined(DUP678)
    __syncthreads(); run_phase<6>(p, lds, wv); run_phase<7>(p, lds, wv); xcd_barrier(bar); run_phase<8>(p, lds, wv);
#endif
    xcd_barrier(bar);
#if defined(PRE9)
    ph_router_t<PRE9>(p, lds, wv); __syncthreads();
#endif
    run_phase<9>(p, lds, wv);
#if defined(DUP9)
    __syncthreads(); run_phase<9>(p, lds, wv);
#endif

    xcd_barrier(bar);
    run_phase<11>(p, lds, wv);
#if defined(DUP11)
    __syncthreads(); run_phase<11>(p, lds, wv);
#endif
    xcd_barrier(bar);
    run_phase<12>(p, lds, wv);
#if defined(DUP12)
    __syncthreads(); run_phase<12>(p, lds, wv);
#endif
    xcd_barrier(bar);
    run_phase<13>(p, lds, wv);
#if defined(DUP13)
    __syncthreads(); run_phase<13>(p, lds, wv);
#endif
    xcd_barrier(bar);
#if defined(XBAR10)
    for (int i = 0; i < 10; ++i) xcd_barrier(bar);
#endif
#if defined(DUP14)
    ph_final<true>(p, wv); __syncthreads();
#endif
    run_phase<14>(p, lds, wv);
}

extern "C" void kernel_launch(void* const* d_in, const int* in_sizes, int n_in, void* d_out, int out_size, void* d_ws, size_t ws_size, hipStream_t stream) {
    static int grid = 0; static bool first = true;
    if (grid == 0) {
        if (n_in != 23 || in_sizes[0] != M * D || out_size != M * D || ws_size < WS_END) { fprintf(stderr, "kernel_launch: unexpected shapes (n_in %d, in0 %d, out %d, ws %zu)\n", n_in, n_in > 0 ? in_sizes[0] : -1, out_size, ws_size); grid = -1; return; }
        int dev = 0, cus = 0;
        if (hipGetDevice(&dev) != hipSuccess || hipDeviceGetAttribute(&cus, hipDeviceAttributeMultiprocessorCount, dev) != hipSuccess) { grid = -1; return; }
        grid = cus;
    }
    if (grid < 0) return;
    unsigned char* ws = (unsigned char*)d_ws;
    (void)hipMemsetAsync(ws + WS_CTL, 0, CTL_ZERO_BYTES, stream);
    P p{};
    const float* const* in = (const float* const*)d_in;
    p.x = in[0]; p.w_in = in[1]; p.kv_g = in[2]; p.w_uk = in[3]; p.w_uv = in[4]; p.rel_bias = in[5]; p.ln_g = in[6]; p.ln_b = in[7]; p.w_sp = in[8]; p.b_sp = in[9];
    p.w_pa = in[10]; p.w_pb = in[11]; p.w_out = in[12]; p.n1g = in[13]; p.n2g = in[14]; p.rg_w = in[15]; p.rg_b = in[16]; p.re_w = in[17]; p.re_b = in[18];
    p.w_gate = in[19]; p.w_up = in[20]; p.w_down = in[21]; p.fg = in[22];
    p.out = (float*)d_out; p.ctl = (unsigned*)(ws + WS_CTL);
    p.WinT = (bf16_t*)(ws + WS_WIN); p.WoutT = (bf16_t*)(ws + WS_WOUT); p.WpbT = (bf16_t*)(ws + WS_WPB); p.WovT = (bf16_t*)(ws + WS_WOV); p.WSB = (bf16_t*)(ws + WS_WSB);
    p.WguT = (bf16_t*)(ws + WS_WGU); p.WdT = (bf16_t*)(ws + WS_WD); p.WrT = (float*)(ws + WS_WRT);
    p.HB = (bf16_t*)(ws + WS_A); p.OL = (bf16_t*)(ws + WS_A); p.H2B = (bf16_t*)(ws + WS_A);
    p.QL = (bf16_t*)(ws + WS_B); p.MB = (bf16_t*)(ws + WS_B); p.H2S = (bf16_t*)(ws + WS_B); p.YS = (bf16_t*)(ws + WS_B);
    p.GAB = (bf16_t*)(ws + WS_GA); p.GBB = (bf16_t*)(ws + WS_GB);
    p.UB = (bf16_t*)(ws + WS_C); p.VB = (bf16_t*)(ws + WS_C + 32 * MiB); p.MG = (bf16_t*)(ws + WS_C); p.HE = (bf16_t*)(ws + WS_C);
    p.QI = (bf16_t*)(ws + WS_DQ); p.US = (bf16_t*)(ws + WS_DQ);
    p.CKVR = (float*)(ws + WS_CKVR); p.CKVB = (bf16_t*)(ws + WS_CKVB); p.KI = (bf16_t*)(ws + WS_KI); p.WI = (float*)(ws + WS_WI); p.SEL = (unsigned short*)(ws + WS_SEL);
    p.EID = (int*)(ws + WS_MOE); p.EW = (float*)(ws + WS_MOE + 262144); p.PTOK = (int*)(ws + WS_MOE + 524288); p.MOEI = (int*)(ws + WS_MOE + 1048576);
    p.GU = (int*)(ws + WS_MOE + 1048576 + 4096); p.BLKCNT = (int*)(ws + WS_MOE + 1048576 + 65536); p.IDXROW = (float*)(ws + WS_A); p.RINV2 = (float*)(ws + WS_MOE + 1048576 + 262144); p.CB = (int*)(ws + WS_MOE + 1048576 + 131072); p.DN = (int*)(ws + WS_MOE + 1048576 + 4096 + 8192);
    if (first) { (void)hipFuncSetAttribute((const void*)k_mega, hipFuncAttributeMaxDynamicSharedMemorySize, LDS_BYTES); first = false; }
    hipLaunchKernelGGL(k_mega, dim3(grid), dim3(NTHR), LDS_BYTES, stream, p);
}
```
